# Optimizing an MI355X kernel written in HIP

```python
import math
import jax, jax.numpy as jnp
from jax import lax
import numpy as np

D_MODEL = 1024
BATCH = 4
SEQ = 4096
DEPTH = 2

PLE_DIM = 256
CHUNK = 64
D_RNN = D_MODEL // 2
RNN_BLOCKS = 8
RNN_BLOCK_DIM = D_RNN // RNN_BLOCKS
CONV_WIDTH = 4
LRU_C = 8.0
HEAD_DIM = 64
N_ATT_HEADS = (D_MODEL - D_RNN) // HEAD_DIM
D_ATT = N_ATT_HEADS * HEAD_DIM
D_MIX = D_RNN + D_ATT
D_IN = 2 * D_RNN + 3 * D_ATT + N_ATT_HEADS
Q_BLOCK = 128
N_GROUPS = 4
EXPERTS_PER_GROUP = 8
N_EXPERTS = N_GROUPS * EXPERTS_PER_GROUP
TOP_K = 2
D_EXPERT = D_MODEL // 2
EPS = 1e-6

kernel_name = "hybrid_rglru_fox_hmoe_block"


def rmsnorm(x, g):
    xf = x.astype(jnp.float32)
    y = xf * lax.rsqrt(jnp.mean(xf * xf, axis=-1, keepdims=True) + EPS)
    return (y * g.astype(jnp.float32)).astype(x.dtype)


def causal_depthwise_conv(x, w, b):
    c = x.shape[-1]
    y = lax.conv_general_dilated(
        x, w[:, None, :].astype(x.dtype), window_strides=(1,), padding=[(CONV_WIDTH - 1, 0)],
        dimension_numbers=("NWC", "WIO", "NWC"), feature_group_count=c)
    return y + b.astype(x.dtype)


def rg_lru(xc, w_r, b_r, w_i, b_i, lam):
    B, S, _ = xc.shape
    xb = xc.reshape(B, S, RNN_BLOCKS, RNN_BLOCK_DIM)
    r = jax.nn.sigmoid((jnp.einsum('bshi,hij->bshj', xb, w_r).reshape(B, S, D_RNN) + b_r).astype(jnp.float32))
    i = jax.nn.sigmoid((jnp.einsum('bshi,hij->bshj', xb, w_i).reshape(B, S, D_RNN) + b_i).astype(jnp.float32))
    log_a = -LRU_C * r * jax.nn.softplus(-lam.astype(jnp.float32))
    a = jnp.exp(log_a)
    u = jnp.sqrt(-jnp.expm1(2.0 * log_a)) * (i * xc.astype(jnp.float32))

    def combine(left, right):
        a1, b1 = left
        a2, b2 = right
        return a1 * a2, a2 * b1 + b2

    _, h = lax.associative_scan(combine, (a, u), axis=1)
    return h.astype(xc.dtype)


def forgetting_attention(q, k, v, cum_logf):
    S = q.shape[2]
    scale = 1.0 / math.sqrt(HEAD_DIM)
    outs = []
    for qb in range(S // Q_BLOCK):
        lo, hi = qb * Q_BLOCK, (qb + 1) * Q_BLOCK
        s = jnp.einsum('bhqd,bhkd->bhqk', q[:, :, lo:hi], k[:, :, :hi]).astype(jnp.float32) * scale
        s = s + cum_logf[:, :, lo:hi, None] - cum_logf[:, :, None, :hi]
        mask = jnp.arange(hi)[None, :] <= jnp.arange(lo, hi)[:, None]
        s = jnp.where(mask, s, -jnp.inf)
        pr = jax.nn.softmax(s, axis=-1).astype(v.dtype)
        outs.append(jnp.einsum('bhqk,bhkd->bhqd', pr, v[:, :, :hi]))
    return jnp.concatenate(outs, axis=2)


def hierarchical_moe(n, w_group, b_group, w_router, b_router, w_gate, w_up, w_down):
    B, S, D = n.shape
    T = B * S
    xf = n.reshape(T, D)
    g_prob = jax.nn.softmax((xf @ w_group).astype(jnp.float32) + b_group.astype(jnp.float32), axis=-1)
    g_p, g_idx = lax.top_k(g_prob, 1)
    e_logits = ((xf @ w_router).astype(jnp.float32) + b_router.astype(jnp.float32)).reshape(T, N_GROUPS, EXPERTS_PER_GROUP)
    e_logits = jnp.take_along_axis(e_logits, g_idx[:, :, None], axis=1)[:, 0]
    e_top, e_loc = lax.top_k(e_logits, TOP_K)
    e_w = jax.nn.softmax(e_top, axis=-1) * g_p
    flat_id = (g_idx * EXPERTS_PER_GROUP + e_loc).reshape(-1)
    order = jnp.argsort(flat_id)
    tok = order // TOP_K
    sizes = jnp.bincount(flat_id, length=N_EXPERTS).astype(jnp.int32)
    xs = xf[tok]
    hg = lax.ragged_dot(xs, w_gate, sizes)
    hu = lax.ragged_dot(xs, w_up, sizes)
    ys = lax.ragged_dot(jax.nn.silu(hg) * hu, w_down, sizes)
    ws = e_w.reshape(-1)[order].astype(ys.dtype)
    y = jnp.zeros_like(xf).at[tok].add(ys * ws[:, None])
    return y.reshape(B, S, D)


def setup_inputs(seed: int = 0) -> dict:
    key = jax.random.key(seed)
    ks = iter(jax.random.split(key, 40))
    f32 = jnp.float32

    def nrm(shape, scale):
        return jax.random.normal(next(ks), shape, f32) * scale

    def gain(shape):
        return 1.0 + 0.01 * jax.random.normal(next(ks), shape, f32)

    a8 = jax.random.uniform(next(ks), (DEPTH, D_RNN), f32, 0.9, 0.999)
    a_base = a8 ** (1.0 / LRU_C)
    lru_lambda = jnp.log(a_base) - jnp.log1p(-a_base)

    return {
        "x": jax.random.normal(next(ks), (BATCH, SEQ, D_MODEL), f32),
        "p": jax.random.normal(next(ks), (DEPTH, BATCH, SEQ, PLE_DIM), f32),
        "mix_norm": gain((DEPTH, D_MODEL)),
        "w_in": nrm((DEPTH, D_MODEL, D_IN), D_MODEL ** -0.5),
        "b_forget": jax.random.uniform(next(ks), (DEPTH, N_ATT_HEADS), f32, 1.0, 4.0),
        "conv_w": nrm((DEPTH, CONV_WIDTH, D_RNN), CONV_WIDTH ** -0.5),
        "conv_b": nrm((DEPTH, D_RNN), 0.01),
        "w_rgate": nrm((DEPTH, RNN_BLOCKS, RNN_BLOCK_DIM, RNN_BLOCK_DIM), RNN_BLOCK_DIM ** -0.5),
        "b_rgate": nrm((DEPTH, D_RNN), 0.01),
        "w_igate": nrm((DEPTH, RNN_BLOCKS, RNN_BLOCK_DIM, RNN_BLOCK_DIM), RNN_BLOCK_DIM ** -0.5),
        "b_igate": nrm((DEPTH, D_RNN), 0.01),
        "lru_lambda": lru_lambda,
        "q_norm": gain((DEPTH, HEAD_DIM)),
        "k_norm": gain((DEPTH, HEAD_DIM)),
        "lru_out_norm": gain((DEPTH, D_RNN)),
        "att_out_norm": gain((DEPTH, D_ATT)),
        "w_out": nrm((DEPTH, D_MIX, D_MODEL), D_MIX ** -0.5),
        "ffn_norm": gain((DEPTH, D_MODEL)),
        "w_group": nrm((DEPTH, D_MODEL, N_GROUPS), D_MODEL ** -0.5),
        "b_group": nrm((DEPTH, N_GROUPS), 0.01),
        "w_router": nrm((DEPTH, D_MODEL, N_EXPERTS), D_MODEL ** -0.5),
        "b_router": nrm((DEPTH, N_EXPERTS), 0.01),
        "w_exp_gate": nrm((DEPTH, N_EXPERTS, D_MODEL, D_EXPERT), D_MODEL ** -0.5),
        "w_exp_up": nrm((DEPTH, N_EXPERTS, D_MODEL, D_EXPERT), D_MODEL ** -0.5),
        "w_exp_down": nrm((DEPTH, N_EXPERTS, D_EXPERT, D_MODEL), D_EXPERT ** -0.5),
        "ple_norm": gain((DEPTH, D_MODEL)),
        "w_ple_gate": nrm((DEPTH, D_MODEL, D_MODEL), D_MODEL ** -0.5),
        "b_ple_gate": nrm((DEPTH, D_MODEL), 0.01),
        "w_ple_proj": nrm((DEPTH, PLE_DIM, D_MODEL), PLE_DIM ** -0.5),
    }


def reference(x, p, mix_norm, w_in, b_forget, conv_w, conv_b, w_rgate, b_rgate, w_igate, b_igate,
              lru_lambda, q_norm, k_norm, lru_out_norm, att_out_norm, w_out, ffn_norm,
              w_group, b_group, w_router, b_router, w_exp_gate, w_exp_up, w_exp_down,
              ple_norm, w_ple_gate, b_ple_gate, w_ple_proj):
    B, S, _ = x.shape
    splits = np.cumsum([D_RNN, D_RNN, D_ATT, D_ATT, D_ATT]).tolist()
    for i in range(DEPTH):
        n = rmsnorm(x, mix_norm[i])
        z = n @ w_in[i]
        z_x, z_gate, z_q, z_k, z_v, z_f = jnp.split(z, splits, axis=-1)

        xc = causal_depthwise_conv(z_x, conv_w[i], conv_b[i])
        h = rg_lru(xc, w_rgate[i], b_rgate[i], w_igate[i], b_igate[i], lru_lambda[i])
        y_rnn = h * jax.nn.gelu(z_gate)

        q = rmsnorm(z_q.reshape(B, S, N_ATT_HEADS, HEAD_DIM), q_norm[i]).transpose(0, 2, 1, 3)
        k = rmsnorm(z_k.reshape(B, S, N_ATT_HEADS, HEAD_DIM), k_norm[i]).transpose(0, 2, 1, 3)
        v = z_v.reshape(B, S, N_ATT_HEADS, HEAD_DIM).transpose(0, 2, 1, 3)
        logf = jax.nn.log_sigmoid(z_f.astype(jnp.float32) + b_forget[i].astype(jnp.float32))
        cum_logf = jnp.cumsum(logf, axis=1).transpose(0, 2, 1)
        o = forgetting_attention(q, k, v, cum_logf)
        y_att = o.transpose(0, 2, 1, 3).reshape(B, S, D_ATT)

        y_mix = jnp.concatenate([rmsnorm(y_rnn, lru_out_norm[i]), rmsnorm(y_att, att_out_norm[i])], axis=-1)
        x = x + y_mix @ w_out[i]

        x = x + hierarchical_moe(rmsnorm(x, ffn_norm[i]), w_group[i], b_group[i], w_router[i], b_router[i],
                                 w_exp_gate[i], w_exp_up[i], w_exp_down[i])

        gate = jax.nn.sigmoid(rmsnorm(x, ple_norm[i]) @ w_ple_gate[i] + b_ple_gate[i])
        x = x + (p[i] @ w_ple_proj[i]) * gate
    return x
```

```cpp
#include <hip/hip_runtime.h>
#include <cstdio>
#include <cstdint>
#include <cmath>

#ifndef MK_MULTI
#define MK_MULTI 1
#endif

#define GAS __attribute__((address_space(1)))
#define LAS __attribute__((address_space(3)))
typedef unsigned short bf16;
typedef unsigned v4u __attribute__((ext_vector_type(4)));
typedef unsigned v2u __attribute__((ext_vector_type(2)));
typedef float f32x4 __attribute__((ext_vector_type(4)));

constexpr int NB = 4, S = 4096, T = NB * S, D = 1024, DIN = 2568, DR = 512, DA = 512, NH = 8, HD = 64;
constexpr int NE = 32, DE = 512, PLE = 256, DEPTH = 2, NZ = 2560;
constexpr float EPS = 1e-6f, LOG2E = 1.4426950408889634f, C2 = 0.125f * 1.4426950408889634f;
constexpr int CAP = 16384;
constexpr int HROWS = 40960;

constexpr size_t MiB = 1u << 20;
constexpr size_t WS_CTL = 0, CTL_ZERO_BYTES = 1 * MiB;
constexpr size_t WS_LOGF = 1 * MiB;
constexpr size_t WS_C2K = WS_LOGF + MiB / 2;
constexpr size_t WS_SA = 2 * MiB, WS_SH = WS_SA + MiB / 2;
constexpr size_t WS_PAIRW = 3 * MiB;
constexpr size_t WS_ROWPAIR = 4 * MiB;
constexpr size_t WS_WIN = 8 * MiB;
constexpr size_t WS_WOUT = 18 * MiB;
constexpr size_t WS_WPG = 22 * MiB;
constexpr size_t WS_WPP = 26 * MiB;
constexpr size_t WS_WGU = 28 * MiB;
constexpr size_t WS_WDN = 156 * MiB;
constexpr size_t WS_PB = 220 * MiB;
constexpr size_t WS_XN = 236 * MiB;
constexpr size_t WS_X = 268 * MiB;
constexpr size_t WS_R1 = 332 * MiB;
constexpr size_t WS_R2 = 412 * MiB;
constexpr size_t WS_PROJ = 460 * MiB;
constexpr size_t WS_END = 492 * MiB;
constexpr int CW_BAR = 4096;
constexpr int CW_CNT = 8192;

constexpr int RING_BYTES = 131072;
constexpr int MISC_OFF = RING_BYTES + 320;
constexpr int LDS_BYTES = 147456;

__device__ __forceinline__ unsigned f2bf(float f) { unsigned u = __builtin_bit_cast(unsigned, f); return (u + 0x7fffu + ((u >> 16) & 1u)) >> 16; }
__device__ __forceinline__ unsigned pk2(float lo, float hi) { return f2bf(lo) | (f2bf(hi) << 16); }
__device__ __forceinline__ float bf2f(unsigned u) { return __builtin_bit_cast(float, u << 16); }
__device__ __forceinline__ float bflo(unsigned w) { return __builtin_bit_cast(float, w << 16); }
__device__ __forceinline__ float bfhi(unsigned w) { return __builtin_bit_cast(float, w & 0xffff0000u); }
__device__ __forceinline__ float wave_sum(float v) {
#pragma unroll
    for (int o = 1; o < 64; o <<= 1) v += __shfl_xor(v, o);
    return v;
}
__device__ __forceinline__ float wave_max(float v) {
#pragma unroll
    for (int o = 1; o < 64; o <<= 1) v = fmaxf(v, __shfl_xor(v, o));
    return v;
}
__device__ __forceinline__ float sigmoidf_(float v) { return 1.f / (1.f + __expf(-v)); }
__device__ __forceinline__ float gelu_tanh(float v) { return 0.5f * v * (1.f + tanhf(0.7978845608028654f * (v + 0.044715f * v * v * v))); }
__device__ __forceinline__ float log_sigmoid(float v) { return v >= 0.f ? -log1pf(__expf(-v)) : v - log1pf(__expf(v)); }

#define XB_TMO      128
#define XB_XCNT(j)  (256  + 64 * (j))
#define XB_XSUB(j)  (1280 + 64 * (j))
#define XB_XGEN(j)  (2304 + 64 * (j))
#define XB_TOP      3328
#define XB_TOPGEN   3392
#define XCD_BAR_WORDS 3456
#define XB_SPIN_CAP (1u << 26)
__device__ __forceinline__ unsigned xb_ld(unsigned* p)              { return __hip_atomic_load(p, __ATOMIC_RELAXED, __HIP_MEMORY_SCOPE_AGENT); }
__device__ __forceinline__ unsigned xb_add(unsigned* p, unsigned v) { return __hip_atomic_fetch_add(p, v, __ATOMIC_RELAXED, __HIP_MEMORY_SCOPE_AGENT); }
__device__ __forceinline__ unsigned xb_xcc_id() { return (unsigned)__builtin_amdgcn_s_getreg((3 << 11) | 20) & 0xFu; }
#define XB_SPIN(cond, bar) do { unsigned _sp = 0; while (cond) { __builtin_amdgcn_s_sleep(1); \
    if ((++_sp & 255u) == 0u) { if (xb_ld(&(bar)[XB_TMO])) break; if (_sp > XB_SPIN_CAP) { atomicAdd(&(bar)[XB_TMO], 1u); break; } } } } while (0)
struct XcdBarrier { unsigned* bar; unsigned x; volatile LAS unsigned* st; };
__device__ __forceinline__ XcdBarrier xcd_barrier_post(unsigned* bar, volatile LAS unsigned* st) {
    XcdBarrier b; b.bar = bar; b.x = xb_xcc_id(); b.st = st;
    if (threadIdx.x == 0) (void)xb_add(&bar[XB_XCNT(b.x)], 1u);
    return b;
}
__device__ __forceinline__ void xcd_barrier_complete(unsigned* bar, unsigned x, unsigned& nloc, unsigned& nx) {
    const unsigned G = gridDim.x * gridDim.y * gridDim.z;
    unsigned sum, cnt, mine, sp = 0u;
    for (;;) {
        sum = 0u; cnt = 0u; mine = 0u;
#pragma unroll
        for (unsigned j = 0; j < 16; ++j) { const unsigned c = xb_ld(&bar[XB_XCNT(j)]); sum += c; cnt += (c > 0u) ? 1u : 0u; mine = (j == x) ? c : mine; }
        if (sum == G) break;
        __builtin_amdgcn_s_sleep(1);
        if ((++sp & 255u) == 0u) { if (xb_ld(&bar[XB_TMO])) break; if (sp > XB_SPIN_CAP) { atomicAdd(&bar[XB_TMO], 1u); break; } }
    }
    nloc = mine > 0u ? mine : 1u; nx = cnt > 0u ? cnt : 1u;
}
__device__ __forceinline__ void xcd_barrier(const XcdBarrier& b) {
    asm volatile("s_waitcnt vmcnt(0)" ::: "memory");
    __syncthreads();
    if (threadIdx.x == 0) {
        unsigned* bar = b.bar;
        __builtin_amdgcn_s_waitcnt(0);
        unsigned nloc = b.st[0], nx = b.st[1];
        if (nloc == 0u) { xcd_barrier_complete(bar, b.x, nloc, nx); b.st[0] = nloc; b.st[1] = nx; }
        const unsigned old = xb_add(&bar[XB_XSUB(b.x)], 1u);
        const unsigned gen = old / nloc;
        if (old + 1u == (gen + 1u) * nloc) {
            __builtin_amdgcn_fence(__ATOMIC_RELEASE, "agent");
            asm volatile("s_waitcnt vmcnt(0)" ::: "memory");
            const unsigned og = xb_add(&bar[XB_TOP], 1u);
            const unsigned tg = og / nx;
            if (og + 1u == (tg + 1u) * nx) xb_add(&bar[XB_TOPGEN], 1u);
            else XB_SPIN(xb_ld(&bar[XB_TOPGEN]) == tg, bar);
            __builtin_amdgcn_fence(__ATOMIC_ACQUIRE, "agent");
            xb_add(&bar[XB_XGEN(b.x)], 1u);
            asm volatile("s_waitcnt vmcnt(0)" ::: "memory");
        } else {
            XB_SPIN(xb_ld(&bar[XB_XGEN(b.x)]) == gen, bar);
            __builtin_amdgcn_fence(__ATOMIC_ACQUIRE, "agent");
            asm volatile("s_waitcnt vmcnt(0)" ::: "memory");
        }
    }
    __syncthreads();
}

struct Args { const float* in[29]; float* out; unsigned char* ws; int ph_lo, ph_hi; };
typedef const __attribute__((address_space(4))) Args* KA;
__device__ __forceinline__ KA fresh_args() { KA p = (KA)__builtin_amdgcn_kernarg_segment_ptr(); asm volatile("" : "+s"(p)); return p; }
struct Ctx {
    LAS unsigned char* lds;
    int tid, lane, wave, gw, ngw;
    unsigned char* ws;
};
enum { I_X = 0, I_P, I_MIXN, I_WIN, I_BF, I_CONVW, I_CONVB, I_WR, I_BR, I_WI, I_BI, I_LAM, I_QN, I_KN, I_LRUN, I_ATTN, I_WOUT, I_FFNN,
       I_WG, I_BG, I_WRT, I_BRT, I_WEG, I_WEU, I_WED, I_PLEN, I_WPG, I_BPG, I_WPP };

__device__ __forceinline__ void transpose_item(const float* W, int ldw, int K, bf16* WT, int k0, int n0, int c0, LAS float* scr, int lane) {
#pragma unroll 8
    for (int i = 0; i < 32; ++i) { const int kk = 2 * i + (lane >> 5); scr[kk * 33 + (lane & 31)] = W[(size_t)(k0 + kk) * ldw + c0 + (lane & 31)]; }
    asm volatile("s_waitcnt lgkmcnt(0)" ::: "memory");
    const int c = lane & 7;
#pragma unroll
    for (int j = 0; j < 4; ++j) { const int n = (lane >> 3) + 8 * j; const LAS float* s = scr + (8 * c) * 33 + n;
        v4u o; o.x = pk2(s[0 * 33], s[1 * 33]); o.y = pk2(s[2 * 33], s[3 * 33]); o.z = pk2(s[4 * 33], s[5 * 33]); o.w = pk2(s[6 * 33], s[7 * 33]);
        *(v4u*)(WT + (size_t)(n0 + n) * K + k0 + 8 * c) = o; }
    asm volatile("s_waitcnt lgkmcnt(0)" ::: "memory");
}
__device__ __forceinline__ void phase_prologue(Ctx& C, KA AR) {
    LAS float* scr = (LAS float*)(C.lds + C.wave * 16384);
    constexpr int I_IN = 16 * 80, I_OUT = 16 * 32, I_GU = 32 * 16 * 32, I_DN = 32 * 8 * 32, I_PG = 16 * 32, I_PP = 4 * 32;
    constexpr int PER_L = I_IN + I_OUT + I_GU + I_DN + I_PG + I_PP;
    for (int it = C.gw; it < DEPTH * PER_L; it += C.ngw) {
        const int l = it / PER_L; int r = it % PER_L;
        if (r < I_IN) {
            const int kb = r / 80, nb = r % 80, n0 = 32 * nb, pn = n0 >> 8, jl = n0 & 255, bj = jl >> 7, wc = (jl >> 5) & 3;
            transpose_item(AR->in[I_WIN] + (size_t)l * D * DIN, DIN, D, (bf16*)(C.ws + WS_WIN) + (size_t)l * NZ * D, 64 * kb, n0, 256 * pn + 64 * wc + 32 * bj, scr, C.lane); continue; }
        r -= I_IN;
        if (r < I_OUT) { const int kb = r / 32, nb = r % 32;
            transpose_item(AR->in[I_WOUT] + (size_t)l * D * D, D, D, (bf16*)(C.ws + WS_WOUT) + (size_t)l * D * D, 64 * kb, 32 * nb, 32 * nb, scr, C.lane); continue; }
        r -= I_OUT;
        if (r < I_GU) {
            const int e = r / 512, q = r % 512, kb = q / 32, nb = q % 32, n0 = 32 * nb, pn = n0 >> 8, jl = n0 & 255;
            const float* src = (jl < 128 ? AR->in[I_WEG] : AR->in[I_WEU]) + (size_t)(l * NE + e) * D * DE;
            transpose_item(src, DE, D, (bf16*)(C.ws + WS_WGU) + (size_t)(l * NE + e) * 1024 * D, 64 * kb, n0, 128 * pn + (jl & 127), scr, C.lane); continue; }
        r -= I_GU;
        if (r < I_DN) { const int e = r / 256, q = r % 256, kb = q / 32, nb = q % 32;
            transpose_item(AR->in[I_WED] + (size_t)(l * NE + e) * DE * D, D, DE, (bf16*)(C.ws + WS_WDN) + (size_t)(l * NE + e) * D * DE, 64 * kb, 32 * nb, 32 * nb, scr, C.lane); continue; }
        r -= I_DN;
        if (r < I_PG) { const int kb = r / 32, nb = r % 32;
            transpose_item(AR->in[I_WPG] + (size_t)l * D * D, D, D, (bf16*)(C.ws + WS_WPG) + (size_t)l * D * D, 64 * kb, 32 * nb, 32 * nb, scr, C.lane); continue; }
        r -= I_PG;
        { const int kb = r / 32, nb = r % 32;
            transpose_item(AR->in[I_WPP] + (size_t)l * PLE * D, D, PLE, (bf16*)(C.ws + WS_WPP) + (size_t)l * D * PLE, 64 * kb, 32 * nb, 32 * nb, scr, C.lane); }
    }
    const f32x4* ps = (const f32x4*)AR->in[I_P]; v2u* pd = (v2u*)(C.ws + WS_PB);
    const size_t n4 = (size_t)DEPTH * T * PLE / 4;
    for (size_t i = (size_t)blockIdx.x * 512 + C.tid; i < n4; i += (size_t)gridDim.x * 512) { const f32x4 v = ps[i]; v2u o; o.x = pk2(v.x, v.y); o.y = pk2(v.z, v.w); pd[i] = o; }
}

__device__ __forceinline__ void load_row(const float* row, int lane, f32x4 (&v)[4]) {
    const f32x4* xr = (const f32x4*)row + lane;
#pragma unroll
    for (int j = 0; j < 4; ++j) v[j] = xr[64 * j];
}
__device__ __forceinline__ float row_rs(const f32x4 (&v)[4]) {
    float s = 0.f;
#pragma unroll
    for (int j = 0; j < 4; ++j) s += (v[j].x * v[j].x + v[j].y * v[j].y) + (v[j].z * v[j].z + v[j].w * v[j].w);
    return rsqrtf(wave_sum(s) * (1.f / D) + EPS);
}
__device__ __forceinline__ void scale_row(f32x4 (&v)[4], float rs, const float* gain, int lane) {
    const f32x4* g = (const f32x4*)gain + lane;
#pragma unroll
    for (int j = 0; j < 4; ++j) v[j] = v[j] * rs * g[64 * j];
}
__device__ __forceinline__ void store_row_bf16(bf16* row, int lane, const f32x4 (&v)[4]) {
    v2u* o = (v2u*)row + lane;
#pragma unroll
    for (int j = 0; j < 4; ++j) { v2u w; w.x = pk2(v[j].x, v[j].y); w.y = pk2(v[j].z, v[j].w); o[64 * j] = w; }
}

__device__ __forceinline__ void phase_norm1(Ctx& C, KA AR, int l) {
    const float* xs = l == 0 ? AR->in[I_X] : (const float*)(C.ws + WS_X);
    const float* gain = AR->in[I_MIXN] + l * D;
    const float* wf = AR->in[I_WIN] + (size_t)l * D * DIN + NZ;
    const float* bfg = AR->in[I_BF] + l * NH;
    bf16* xn = (bf16*)(C.ws + WS_XN); float* logf = (float*)(C.ws + WS_LOGF);
    for (int t = C.gw; t < T; t += C.ngw) {
        f32x4 v[4]; load_row(xs + (size_t)t * D, C.lane, v);
        const float rs = row_rs(v); scale_row(v, rs, gain, C.lane);
        store_row_bf16(xn + (size_t)t * D, C.lane, v);
        float z[8] = {0.f, 0.f, 0.f, 0.f, 0.f, 0.f, 0.f, 0.f};
#pragma unroll
        for (int j = 0; j < 4; ++j)
#pragma unroll
            for (int e = 0; e < 4; ++e) { const int k = 256 * j + 4 * C.lane + e; const f32x4 w0 = *(const f32x4*)(wf + (size_t)k * DIN), w1 = *(const f32x4*)(wf + (size_t)k * DIN + 4);
                const float a = v[j][e]; z[0] += a * w0.x; z[1] += a * w0.y; z[2] += a * w0.z; z[3] += a * w0.w; z[4] += a * w1.x; z[5] += a * w1.y; z[6] += a * w1.z; z[7] += a * w1.w; }
#pragma unroll
        for (int h = 0; h < 8; ++h) z[h] = wave_sum(z[h]);
        float mine = 0.f;
#pragma unroll
        for (int h = 0; h < 8; ++h) mine = (C.lane == h) ? z[h] : mine;
        if (C.lane < 8) logf[(size_t)t * 8 + C.lane] = log_sigmoid(mine + bfg[C.lane]);
    }
}

template <int NACC, class AR, class BR, class EP>
__device__ __forceinline__ void ngemm_tile(LAS float* sm, int K, AR arow, BR brow, EP epi) {
    LAS float* As = sm; LAS float* Bs = sm + 32 * 68;
    const int tid = threadIdx.x, ty = tid >> 4, tx = tid & 15, lr = tid >> 3, lk = (tid & 7) * 4;
    float acc[NACC][2][4];
#pragma unroll
    for (int a = 0; a < NACC; ++a)
#pragma unroll
        for (int i = 0; i < 2; ++i)
#pragma unroll
            for (int j = 0; j < 4; ++j) acc[a][i][j] = 0.f;
    const bf16* ap = arow(lr); const bf16* bp0 = brow(lr, 0); const bf16* bp1 = NACC > 1 ? brow(lr, 1) : bp0;
    for (int k0 = 0; k0 < K; k0 += 32) {
        __syncthreads();
        { v2u av; av.x = 0u; av.y = 0u; if (ap) av = *(const v2u*)(ap + k0 + lk);
          As[(lk + 0) * 68 + lr] = bflo(av.x); As[(lk + 1) * 68 + lr] = bfhi(av.x); As[(lk + 2) * 68 + lr] = bflo(av.y); As[(lk + 3) * 68 + lr] = bfhi(av.y); }
        { const v2u bv = *(const v2u*)(bp0 + k0 + lk);
          Bs[(lk + 0) * 68 + lr] = bflo(bv.x); Bs[(lk + 1) * 68 + lr] = bfhi(bv.x); Bs[(lk + 2) * 68 + lr] = bflo(bv.y); Bs[(lk + 3) * 68 + lr] = bfhi(bv.y); }
        if (NACC > 1) { const v2u bv = *(const v2u*)(bp1 + k0 + lk); LAS float* B1 = Bs + 32 * 68;
          B1[(lk + 0) * 68 + lr] = bflo(bv.x); B1[(lk + 1) * 68 + lr] = bfhi(bv.x); B1[(lk + 2) * 68 + lr] = bflo(bv.y); B1[(lk + 3) * 68 + lr] = bfhi(bv.y); }
        __syncthreads();
#pragma unroll 8
        for (int kk = 0; kk < 32; ++kk) {
            const float a0 = As[kk * 68 + ty * 2], a1 = As[kk * 68 + ty * 2 + 1];
#pragma unroll
            for (int a = 0; a < NACC; ++a) { const f32x4 b = *(const LAS f32x4*)(Bs + a * 32 * 68 + kk * 68 + tx * 4);
#pragma unroll
                for (int j = 0; j < 4; ++j) { acc[a][0][j] += a0 * b[j]; acc[a][1][j] += a1 * b[j]; } }
        }
    }
#pragma unroll
    for (int i = 0; i < 2; ++i)
#pragma unroll
        for (int j = 0; j < 4; ++j) epi(ty * 2 + i, tx * 4 + j, acc[0][i][j], NACC > 1 ? acc[1][i][j] : 0.f);
}

__device__ __forceinline__ void phase_cumsum(Ctx& C, KA AR) {
    if (C.gw < NB * NH) {
        const int b = C.gw / NH, h = C.gw % NH;
        const float* logf = (const float*)(C.ws + WS_LOGF) + (size_t)b * S * 8 + h; float* c2k = (float*)(C.ws + WS_C2K) + (size_t)C.gw * S;
        float s = 0.f;
        for (int i = 0; i < 64; ++i) s += logf[(size_t)(64 * C.lane + i) * 8];
        float inc = s;
#pragma unroll
        for (int o = 1; o < 64; o <<= 1) { const float v = __shfl_up(inc, o); if (C.lane >= o) inc += v; }
        float run = inc - s;
        for (int i = 0; i < 64; ++i) { run += logf[(size_t)(64 * C.lane + i) * 8]; c2k[64 * C.lane + i] = run * LOG2E; }
    }
}
__device__ __forceinline__ void phase_gemm1_naive(Ctx& C, KA AR, int l) {
    phase_cumsum(C, AR);
    const bf16* A = (const bf16*)(C.ws + WS_XN); const bf16* Bt = (const bf16*)(C.ws + WS_WIN) + (size_t)l * NZ * D;
    bf16* R1 = (bf16*)(C.ws + WS_R1);
    for (int u = blockIdx.x; u < (T / 64) * (NZ / 64); u += gridDim.x) {
        const int mt = u / (NZ / 64), nt = u % (NZ / 64), m0 = 64 * mt, n0 = 64 * nt;
        ngemm_tile<1>((LAS float*)C.lds, D, [=](int r) { return A + (size_t)(m0 + r) * D; }, [=](int c, int) { return Bt + (size_t)(n0 + c) * D; },
            [=](int r, int c, float v, float) {
                const int j = n0 + c, pn = j >> 8, jl = j & 255, bj = jl >> 7, wc = (jl >> 5) & 3, col = 256 * pn + 64 * wc + 32 * bj + (jl & 31);
                const int seg = col >> 9, cc = col & 511;
                const float o = seg == 1 ? gelu_tanh(v) : v;
                R1[(size_t)seg * T * 512 + (size_t)(m0 + r) * 512 + cc] = (bf16)f2bf(o);
            });
    }
}
__device__ __forceinline__ void phase_qknorm_naive(Ctx& C, KA AR, int l) {
    bf16* Q = (bf16*)(C.ws + WS_R1) + (size_t)2 * T * 512; bf16* Kb = Q + (size_t)T * 512;
    const float* gq = AR->in[I_QN] + l * HD; const float* gk = AR->in[I_KN] + l * HD;
    for (int i = C.gw; i < 2 * T; i += C.ngw) {
        const int t = i >> 1, isk = i & 1; bf16* row = (isk ? Kb : Q) + (size_t)t * 512; const float* g = isk ? gk : gq;
        const v4u w = *(const v4u*)(row + 8 * C.lane);
        float x[8] = {bflo(w.x), bfhi(w.x), bflo(w.y), bfhi(w.y), bflo(w.z), bfhi(w.z), bflo(w.w), bfhi(w.w)};
        float s = 0.f;
#pragma unroll
        for (int e = 0; e < 8; ++e) s += x[e] * x[e];
        s += __shfl_xor(s, 1); s += __shfl_xor(s, 2); s += __shfl_xor(s, 4);
        const float rs = rsqrtf(s * (1.f / 64.f) + EPS) * (isk ? 1.f : C2);
        const int d0 = 8 * (C.lane & 7);
#pragma unroll
        for (int e = 0; e < 8; ++e) x[e] = x[e] * rs * g[d0 + e];
        v4u o; o.x = pk2(x[0], x[1]); o.y = pk2(x[2], x[3]); o.z = pk2(x[4], x[5]); o.w = pk2(x[6], x[7]);
        *(v4u*)(row + 8 * C.lane) = o;
    }
}

template <int MODE>
__device__ __forceinline__ void phase_rnn_naive(Ctx& C, KA AR, int l) {
    LAS float* xcs = (LAS float*)C.lds; LAS float* as = xcs + 64 * 65; LAS float* us = as + 64 * 64;
    const bf16* ZX = (const bf16*)(C.ws + WS_R1); const bf16* ZG = ZX + (size_t)T * 512;
    float* SA = (float*)(C.ws + WS_SA); float* SH = (float*)(C.ws + WS_SH); float* YR = (float*)(C.ws + WS_PROJ);
    const float* cw = AR->in[I_CONVW] + l * 4 * DR; const float* cb = AR->in[I_CONVB] + l * DR;
    const float* wr = AR->in[I_WR] + (size_t)l * 8 * 64 * 64; const float* wi = AR->in[I_WI] + (size_t)l * 8 * 64 * 64;
    const float* br = AR->in[I_BR] + l * DR; const float* bi = AR->in[I_BI] + l * DR; const float* lam = AR->in[I_LAM] + l * DR;
    for (int u = blockIdx.x; u < NB * 64 * 8; u += gridDim.x) {
        const int b = u >> 9, cidx = (u >> 3) & 63, blk = u & 7;
        __syncthreads();
#pragma unroll
        for (int i = 0; i < 8; ++i) { const int e = C.tid + 512 * i, t = e >> 6, c = e & 63, ch = blk * 64 + c, tg = cidx * 64 + t;
            float xc = cb[ch];
#pragma unroll
            for (int j = 0; j < 4; ++j) { const int tt = tg - 3 + j; if (tt >= 0) xc += cw[j * DR + ch] * bf2f(ZX[(size_t)(b * S + tt) * 512 + ch]); }
            xcs[t * 65 + c] = xc; }
        __syncthreads();
#pragma unroll
        for (int i = 0; i < 8; ++i) { const int e = C.tid + 512 * i, t = e >> 6, j = e & 63, ch = blk * 64 + j;
            float ar = br[ch], ai = bi[ch];
            for (int k = 0; k < 64; ++k) { const float x = xcs[t * 65 + k]; ar += x * wr[(size_t)(blk * 64 + k) * 64 + j]; ai += x * wi[(size_t)(blk * 64 + k) * 64 + j]; }
            const float r = sigmoidf_(ar), ig = sigmoidf_(ai);
            const float la = -8.f * r * log1pf(__expf(-lam[ch]));
            as[t * 64 + j] = __expf(la); us[t * 64 + j] = sqrtf(-expm1f(2.f * la)) * (ig * xcs[t * 65 + j]); }
        __syncthreads();
        if (C.tid < 64) { const int j = C.tid, ch = blk * 64 + j;
            if (MODE == 0) { float A = 1.f, H = 0.f;
                for (int t = 0; t < 64; ++t) { const float a = as[t * 64 + j]; H = a * H + us[t * 64 + j]; A *= a; }
                SA[(size_t)(b * 64 + cidx) * 512 + ch] = A; SH[(size_t)(b * 64 + cidx) * 512 + ch] = H;
            } else { float h = 0.f;
                for (int c2 = 0; c2 < cidx; ++c2) h = SA[(size_t)(b * 64 + c2) * 512 + ch] * h + SH[(size_t)(b * 64 + c2) * 512 + ch];
                for (int t = 0; t < 64; ++t) { h = as[t * 64 + j] * h + us[t * 64 + j]; as[t * 64 + j] = h; } } }
        if (MODE == 1) { __syncthreads();
#pragma unroll
            for (int i = 0; i < 8; ++i) { const int e = C.tid + 512 * i, t = e >> 6, c = e & 63, ch = blk * 64 + c; const size_t row = (size_t)(b * S + cidx * 64 + t);
                YR[row * 512 + ch] = as[t * 64 + c] * bf2f(ZG[row * 512 + ch]); } }
    }
}

__device__ __forceinline__ void phase_attn_naive(Ctx& C, KA AR, int l) {
    LAS float* Ks = (LAS float*)C.lds; LAS float* Vs = Ks + 64 * 65; LAS float* Qs = Vs + 64 * 65; LAS float* Ps = Qs + 64 * 64; LAS float* cks = Ps + 8 * 64;
    const bf16* Q = (const bf16*)(C.ws + WS_R1) + (size_t)2 * T * 512; const bf16* Kb = Q + (size_t)T * 512; const bf16* Vb = Kb + (size_t)T * 512;
    bf16* O = (bf16*)(C.ws + WS_R2); const float* c2k = (const float*)(C.ws + WS_C2K);
    for (int u = blockIdx.x; u < NB * NH * 64; u += gridDim.x) {
        const int qt = 63 - (u >> 5), bh = u & 31, b = bh >> 3, h = bh & 7, q0 = 64 * qt;
        const float* ck = c2k + (size_t)bh * S;
        __syncthreads();
        for (int e = C.tid; e < 64 * 64; e += 512) { const int r = e >> 6, d = e & 63; Qs[r * 64 + d] = bf2f(Q[(size_t)(b * S + q0 + r) * 512 + h * 64 + d]); }
        float m[8], lsum[8], o[8], cq[8];
#pragma unroll
        for (int i = 0; i < 8; ++i) { m[i] = -INFINITY; lsum[i] = 0.f; o[i] = 0.f; cq[i] = ck[q0 + C.wave * 8 + i]; }
        for (int kt = 0; kt <= qt; ++kt) {
            const int k0 = 64 * kt;
            __syncthreads();
            for (int e = C.tid; e < 64 * 64; e += 512) { const int r = e >> 6, d = e & 63; const size_t g = (size_t)(b * S + k0 + r) * 512 + h * 64 + d; Ks[r * 65 + d] = bf2f(Kb[g]); Vs[r * 65 + d] = bf2f(Vb[g]); }
            if (C.tid < 64) cks[C.tid] = ck[k0 + C.tid];
            __syncthreads();
#pragma unroll
            for (int i = 0; i < 8; ++i) {
                const int q = C.wave * 8 + i, qg = q0 + q;
                float dot = 0.f;
#pragma unroll 16
                for (int d = 0; d < 64; ++d) dot += Qs[q * 64 + d] * Ks[C.lane * 65 + d];
                float s = dot + cq[i] - cks[C.lane];
                if (k0 + C.lane > qg) s = -INFINITY;
                const float mn = fmaxf(m[i], wave_max(s));
                const float alpha = exp2f(m[i] - mn), p = exp2f(s - mn);
                lsum[i] = lsum[i] * alpha + wave_sum(p); m[i] = mn;
                Ps[C.wave * 64 + C.lane] = p;
                asm volatile("s_waitcnt lgkmcnt(0)" ::: "memory");
                float acc = 0.f;
#pragma unroll 16
                for (int k = 0; k < 64; ++k) acc += Ps[C.wave * 64 + k] * Vs[k * 65 + C.lane];
                o[i] = o[i] * alpha + acc;
                asm volatile("s_waitcnt lgkmcnt(0)" ::: "memory");
            }
        }
#pragma unroll
        for (int i = 0; i < 8; ++i) O[(size_t)(b * S + q0 + C.wave * 8 + i) * 512 + h * 64 + C.lane] = (bf16)f2bf(o[i] / lsum[i]);
    }
}

__device__ __forceinline__ void phase_mixnorm_naive(Ctx& C, KA AR, int l) {
    const float* YR = (const float*)(C.ws + WS_PROJ); const bf16* O = (const bf16*)(C.ws + WS_R2); bf16* YM = (bf16*)(C.ws + WS_R2 + 16 * MiB);
    const float* g1 = AR->in[I_LRUN] + l * DR; const float* g2 = AR->in[I_ATTN] + l * DA;
    for (int t = C.gw; t < T; t += C.ngw) {
        f32x4 a[2]; float s = 0.f;
#pragma unroll
        for (int j = 0; j < 2; ++j) { a[j] = *((const f32x4*)(YR + (size_t)t * 512) + C.lane + 64 * j); s += (a[j].x * a[j].x + a[j].y * a[j].y) + (a[j].z * a[j].z + a[j].w * a[j].w); }
        float rs = rsqrtf(wave_sum(s) * (1.f / 512.f) + EPS);
#pragma unroll
        for (int j = 0; j < 2; ++j) { const f32x4 g = *((const f32x4*)g1 + C.lane + 64 * j); const f32x4 v = a[j] * rs * g; v2u w; w.x = pk2(v.x, v.y); w.y = pk2(v.z, v.w);
            *((v2u*)(YM + (size_t)t * D) + C.lane + 64 * j) = w; }
        const v4u w = *(const v4u*)(O + (size_t)t * 512 + 8 * C.lane);
        float x[8] = {bflo(w.x), bfhi(w.x), bflo(w.y), bfhi(w.y), bflo(w.z), bfhi(w.z), bflo(w.w), bfhi(w.w)};
        s = 0.f;
#pragma unroll
        for (int e = 0; e < 8; ++e) s += x[e] * x[e];
        rs = rsqrtf(wave_sum(s) * (1.f / 512.f) + EPS);
#pragma unroll
        for (int e = 0; e < 8; ++e) x[e] = x[e] * rs * g2[8 * C.lane + e];
        v4u o; o.x = pk2(x[0], x[1]); o.y = pk2(x[2], x[3]); o.z = pk2(x[4], x[5]); o.w = pk2(x[6], x[7]);
        *(v4u*)(YM + (size_t)t * D + 512 + 8 * C.lane) = o;
    }
}

__device__ __forceinline__ void phase_wo_naive(Ctx& C, KA AR, int l) {
    const bf16* A = (const bf16*)(C.ws + WS_R2 + 16 * MiB); const bf16* Bt = (const bf16*)(C.ws + WS_WOUT) + (size_t)l * D * D;
    const float* xs = l == 0 ? AR->in[I_X] : (const float*)(C.ws + WS_X); float* X = (float*)(C.ws + WS_X);
    for (int u = blockIdx.x; u < (T / 64) * (D / 64); u += gridDim.x) {
        const int m0 = 64 * (u / (D / 64)), n0 = 64 * (u % (D / 64));
        ngemm_tile<1>((LAS float*)C.lds, D, [=](int r) { return A + (size_t)(m0 + r) * D; }, [=](int c, int) { return Bt + (size_t)(n0 + c) * D; },
            [=](int r, int c, float v, float) { const size_t i = (size_t)(m0 + r) * D + n0 + c; X[i] = xs[i] + v; });
    }
}

__device__ __forceinline__ void phase_router(Ctx& C, KA AR, int l) {
    const float* X = (const float*)(C.ws + WS_X); bf16* xn = (bf16*)(C.ws + WS_XN);
    const float* gain = AR->in[I_FFNN] + l * D; const float* wg = AR->in[I_WG] + (size_t)l * D * 4; const float* bg = AR->in[I_BG] + l * 4;
    const float* wr = AR->in[I_WRT] + (size_t)l * D * NE; const float* brt = AR->in[I_BRT] + l * NE;
    unsigned* cnt = (unsigned*)(C.ws + WS_CTL) + CW_CNT + 64 * l; int* rowpair = (int*)(C.ws + WS_ROWPAIR); float* pairw = (float*)(C.ws + WS_PAIRW);
    for (int t = C.gw; t < T; t += C.ngw) {
        f32x4 v[4]; load_row(X + (size_t)t * D, C.lane, v);
        const float rs = row_rs(v); scale_row(v, rs, gain, C.lane);
        store_row_bf16(xn + (size_t)t * D, C.lane, v);
        LAS float* rowl = (LAS float*)C.lds + C.wave * 1024;
#pragma unroll
        for (int j = 0; j < 4; ++j) *((LAS f32x4*)rowl + C.lane + 64 * j) = v[j];
        asm volatile("s_waitcnt lgkmcnt(0)" ::: "memory");
        float acc = 0.f;
        if (C.lane < 36) {
            const float* wp = C.lane < 32 ? wr + C.lane : wg + (C.lane - 32); const int st = C.lane < 32 ? NE : 4;
#pragma unroll 8
            for (int k = 0; k < D; ++k) acc += rowl[k] * wp[(size_t)k * st];
            acc += C.lane < 32 ? brt[C.lane] : bg[C.lane - 32];
        }
        asm volatile("s_waitcnt lgkmcnt(0)" ::: "memory");
        float gl[4];
#pragma unroll
        for (int i = 0; i < 4; ++i) gl[i] = __shfl(acc, 32 + i);
        int gi = 0; float gm = gl[0];
#pragma unroll
        for (int i = 1; i < 4; ++i) if (gl[i] > gm) { gm = gl[i]; gi = i; }
        float gs = 0.f;
#pragma unroll
        for (int i = 0; i < 4; ++i) gs += __expf(gl[i] - gm);
        const float gp = 1.f / gs;
        float ev[8];
#pragma unroll
        for (int i = 0; i < 8; ++i) ev[i] = __shfl(acc, gi * 8 + i);
        int i0 = 0; float t0 = ev[0];
#pragma unroll
        for (int i = 1; i < 8; ++i) if (ev[i] > t0) { t0 = ev[i]; i0 = i; }
        int i1 = -1; float t1 = -INFINITY;
#pragma unroll
        for (int i = 0; i < 8; ++i) if (i != i0 && ev[i] > t1) { t1 = ev[i]; i1 = i; }
        const float ex = __expf(t1 - t0), w0 = gp / (1.f + ex), w1 = gp * ex / (1.f + ex);
        if (C.lane < 2) { const int e = gi * 8 + (C.lane == 0 ? i0 : i1); const unsigned pos = atomicAdd(cnt + e, 1u);
            rowpair[(size_t)e * CAP + pos] = 2 * t + C.lane; pairw[2 * t + C.lane] = C.lane == 0 ? w0 : w1; }
    }
}

struct ExpTab { int n[NE], hoff[NE], t0[NE + 1]; };
__device__ __forceinline__ void build_exptab(Ctx& C, int l, LAS int* tab) {
    __syncthreads();
    if (C.tid == 0) { const unsigned* cnt = (const unsigned*)(C.ws + WS_CTL) + CW_CNT + 64 * l; int ho = 0, tt = 0;
        for (int e = 0; e < NE; ++e) { const int n = (int)__hip_atomic_load(cnt + e, __ATOMIC_RELAXED, __HIP_MEMORY_SCOPE_AGENT); tab[e] = n; tab[32 + e] = ho; tab[64 + e] = tt; ho += (n + 255) & ~255; tt += (n + 63) >> 6; }
        tab[64 + NE] = tt; }
    __syncthreads();
}
__device__ __forceinline__ void phase_g1_naive(Ctx& C, KA AR, int l) {
    LAS int* tab = (LAS int*)(C.lds + 65536); build_exptab(C, l, tab);
    const bf16* xn = (const bf16*)(C.ws + WS_XN); const int* rowpair = (const int*)(C.ws + WS_ROWPAIR); bf16* Hb = (bf16*)(C.ws + WS_R2);
    const int nmt = tab[64 + NE];
    for (int u = blockIdx.x; u < nmt * 8; u += gridDim.x) {
        const int mtg = u >> 3, nt = u & 7; int e = 0;
        for (int i = 1; i < NE; ++i) if (tab[64 + i] <= mtg) e = i;
        const int mt = mtg - tab[64 + e], ne = tab[e], ho = tab[32 + e], p0 = 64 * mt, c0 = 64 * nt;
        const bf16* Bt = (const bf16*)(C.ws + WS_WGU) + (size_t)(l * NE + e) * 1024 * D; const int* rp = rowpair + (size_t)e * CAP;
        ngemm_tile<2>((LAS float*)C.lds, D,
            [=](int r) { return (p0 + r < ne) ? xn + (size_t)(rp[p0 + r] >> 1) * D : (const bf16*)nullptr; },
            [=](int c, int a) { const int cc = c0 + c; return Bt + (size_t)((cc >> 7) * 256 + (cc & 127) + a * 128) * D; },
            [=](int r, int c, float g, float uu) { if (p0 + r < ne) Hb[(size_t)(ho + p0 + r) * DE + c0 + c] = (bf16)f2bf(g / (1.f + __expf(-g)) * uu); });
    }
}
__device__ __forceinline__ void phase_g2_naive(Ctx& C, KA AR, int l) {
    LAS int* tab = (LAS int*)(C.lds + 65536); build_exptab(C, l, tab);
    const int* rowpair = (const int*)(C.ws + WS_ROWPAIR); const float* pairw = (const float*)(C.ws + WS_PAIRW); const bf16* Hb = (const bf16*)(C.ws + WS_R2); bf16* Y2 = (bf16*)(C.ws + WS_R1);
    const int nmt = tab[64 + NE];
    for (int u = blockIdx.x; u < nmt * 16; u += gridDim.x) {
        const int mtg = u >> 4, nt = u & 15; int e = 0;
        for (int i = 1; i < NE; ++i) if (tab[64 + i] <= mtg) e = i;
        const int mt = mtg - tab[64 + e], ne = tab[e], ho = tab[32 + e], p0 = 64 * mt, c0 = 64 * nt;
        const bf16* Bt = (const bf16*)(C.ws + WS_WDN) + (size_t)(l * NE + e) * D * DE; const int* rp = rowpair + (size_t)e * CAP;
        ngemm_tile<1>((LAS float*)C.lds, DE,
            [=](int r) { return (p0 + r < ne) ? Hb + (size_t)(ho + p0 + r) * DE : (const bf16*)nullptr; },
            [=](int c, int) { return Bt + (size_t)(c0 + c) * DE; },
            [=](int r, int c, float v, float) { if (p0 + r < ne) { const int p = rp[p0 + r]; Y2[(size_t)p * D + c0 + c] = (bf16)f2bf(v * pairw[p]); } });
    }
}

__device__ __forceinline__ void phase_combine(Ctx& C, KA AR, int l) {
    float* X = (float*)(C.ws + WS_X); const bf16* Y2 = (const bf16*)(C.ws + WS_R1); bf16* xn = (bf16*)(C.ws + WS_XN); const float* gain = AR->in[I_PLEN] + l * D;
    for (int t = C.gw; t < T; t += C.ngw) {
        f32x4 v[4]; load_row(X + (size_t)t * D, C.lane, v);
#pragma unroll
        for (int j = 0; j < 4; ++j) { const v2u a = *((const v2u*)(Y2 + (size_t)(2 * t) * D) + C.lane + 64 * j), b = *((const v2u*)(Y2 + (size_t)(2 * t + 1) * D) + C.lane + 64 * j);
            v[j].x += bflo(a.x) + bflo(b.x); v[j].y += bfhi(a.x) + bfhi(b.x); v[j].z += bflo(a.y) + bflo(b.y); v[j].w += bfhi(a.y) + bfhi(b.y);
            *((f32x4*)(X + (size_t)t * D) + C.lane + 64 * j) = v[j]; }
        const float rs = row_rs(v); scale_row(v, rs, gain, C.lane);
        store_row_bf16(xn + (size_t)t * D, C.lane, v);
    }
}

__device__ __forceinline__ void phase_proj_naive(Ctx& C, KA AR, int l) {
    const bf16* A = (const bf16*)(C.ws + WS_PB) + (size_t)l * T * PLE; const bf16* Bt = (const bf16*)(C.ws + WS_WPP) + (size_t)l * D * PLE; bf16* PR = (bf16*)(C.ws + WS_PROJ);
    for (int u = blockIdx.x; u < (T / 64) * (D / 64); u += gridDim.x) {
        const int m0 = 64 * (u / (D / 64)), n0 = 64 * (u % (D / 64));
        ngemm_tile<1>((LAS float*)C.lds, PLE, [=](int r) { return A + (size_t)(m0 + r) * PLE; }, [=](int c, int) { return Bt + (size_t)(n0 + c) * PLE; },
            [=](int r, int c, float v, float) { PR[(size_t)(m0 + r) * D + n0 + c] = (bf16)f2bf(v); });
    }
}
__device__ __forceinline__ void phase_ple_naive(Ctx& C, KA AR, int l) {
    const bf16* A = (const bf16*)(C.ws + WS_XN); const bf16* Bt = (const bf16*)(C.ws + WS_WPG) + (size_t)l * D * D; const bf16* PR = (const bf16*)(C.ws + WS_PROJ);
    const float* X = (const float*)(C.ws + WS_X); float* dst = l == DEPTH - 1 ? AR->out : (float*)(C.ws + WS_X); const float* bias = AR->in[I_BPG] + l * D;
    for (int u = blockIdx.x; u < (T / 64) * (D / 64); u += gridDim.x) {
        const int m0 = 64 * (u / (D / 64)), n0 = 64 * (u % (D / 64));
        ngemm_tile<1>((LAS float*)C.lds, D, [=](int r) { return A + (size_t)(m0 + r) * D; }, [=](int c, int) { return Bt + (size_t)(n0 + c) * D; },
            [=](int r, int c, float v, float) { const size_t i = (size_t)(m0 + r) * D + n0 + c; dst[i] = X[i] + bf2f(PR[i]) * sigmoidf_(v + bias[n0 + c]); });
    }
}

constexpr int NPH = 14;
constexpr int NPHASES = 1 + DEPTH * NPH;
__global__ void __launch_bounds__(512, 2) fwd_kernel(Args args) {
    extern __shared__ __attribute__((aligned(16))) unsigned char lds[];
    Ctx C;
    C.lds = (LAS unsigned char*)lds;
    C.tid = threadIdx.x; C.lane = C.tid & 63; C.wave = __builtin_amdgcn_readfirstlane(C.tid >> 6);
    C.gw = blockIdx.x * 8 + C.wave; C.ngw = gridDim.x * 8;
    C.ws = args.ws;
    volatile LAS unsigned* MISC = (volatile LAS unsigned*)(C.lds + MISC_OFF);
    if (C.tid < 32) MISC[C.tid] = 0u;
    __syncthreads();
    XcdBarrier bar; bar.bar = (unsigned*)(C.ws + WS_CTL) + CW_BAR; bar.x = 0; bar.st = nullptr;
    const int lo = args.ph_lo, hi = args.ph_hi;
    if (hi - lo > 1) bar = xcd_barrier_post((unsigned*)(C.ws + WS_CTL) + CW_BAR, MISC + 8);
#ifndef ONLY
#define ONLY -1
#endif
#define PHON(k) (ONLY < 0 || ONLY == (k))
#define IN(k) (lo <= (k) && (k) < hi)
#define SEAM(k) do { if (IN(k) && IN((k) + 1)) xcd_barrier(bar); } while (0)
    if (PHON(99) && IN(0)) { KA A_ = fresh_args(); C.ws = A_->ws; phase_prologue(C, A_); } SEAM(0);
    for (int l = 0; l < DEPTH; ++l) {
        const int pb = 1 + l * NPH;
        if (PHON(0) && IN(pb + 0)) { KA A_ = fresh_args(); C.ws = A_->ws; phase_norm1(C, A_, l); } SEAM(pb + 0);
        if (PHON(1) && IN(pb + 1)) { KA A_ = fresh_args(); C.ws = A_->ws; phase_gemm1_naive(C, A_, l); } SEAM(pb + 1);
        if (PHON(2) && IN(pb + 2)) { KA A_ = fresh_args(); C.ws = A_->ws; phase_qknorm_naive(C, A_, l); } SEAM(pb + 2);
        if (PHON(3) && IN(pb + 3)) { KA A_ = fresh_args(); C.ws = A_->ws; phase_rnn_naive<0>(C, A_, l); } SEAM(pb + 3);
        if (PHON(4) && IN(pb + 4)) { KA A_ = fresh_args(); C.ws = A_->ws; phase_attn_naive(C, A_, l); } SEAM(pb + 4);
        if (PHON(5) && IN(pb + 5)) { KA A_ = fresh_args(); C.ws = A_->ws; phase_rnn_naive<1>(C, A_, l); } SEAM(pb + 5);
        if (PHON(6) && IN(pb + 6)) { KA A_ = fresh_args(); C.ws = A_->ws; phase_mixnorm_naive(C, A_, l); } SEAM(pb + 6);
        if (PHON(7) && IN(pb + 7)) { KA A_ = fresh_args(); C.ws = A_->ws; phase_wo_naive(C, A_, l); } SEAM(pb + 7);
        if (PHON(8) && IN(pb + 8)) { KA A_ = fresh_args(); C.ws = A_->ws; phase_router(C, A_, l); } SEAM(pb + 8);
        if (PHON(9) && IN(pb + 9)) { KA A_ = fresh_args(); C.ws = A_->ws; phase_g1_naive(C, A_, l); } SEAM(pb + 9);
        if (PHON(10) && IN(pb + 10)) { KA A_ = fresh_args(); C.ws = A_->ws; phase_g2_naive(C, A_, l); } SEAM(pb + 10);
        if (PHON(11) && IN(pb + 11)) { KA A_ = fresh_args(); C.ws = A_->ws; phase_combine(C, A_, l); } SEAM(pb + 11);
        if (PHON(12) && IN(pb + 12)) { KA A_ = fresh_args(); C.ws = A_->ws; phase_proj_naive(C, A_, l); } SEAM(pb + 12);
        if (PHON(13) && IN(pb + 13)) { KA A_ = fresh_args(); C.ws = A_->ws; phase_ple_naive(C, A_, l); } SEAM(pb + 13);
    }
#undef IN
#undef SEAM
}

extern "C" void kernel_launch(void* const* d_in, const int* in_sizes, int n_in, void* d_out, int out_size, void* d_ws, size_t ws_size, hipStream_t stream) {
    static int grid = 0;
    if (grid == 0) {
        if (n_in != 29 || out_size != T * D || ws_size < WS_END) { fprintf(stderr, "kernel_launch: unexpected problem (n_in %d, out %d, ws %zu)\n", n_in, out_size, ws_size); grid = -1; return; }
        int dev = 0, cus = 0, per_cu = 0;
        if (hipGetDevice(&dev) != hipSuccess || hipDeviceGetAttribute(&cus, hipDeviceAttributeMultiprocessorCount, dev) != hipSuccess) { grid = -1; return; }
        if (hipFuncSetAttribute((const void*)fwd_kernel, hipFuncAttributeMaxDynamicSharedMemorySize, LDS_BYTES) != hipSuccess) { fprintf(stderr, "kernel_launch: hipFuncSetAttribute failed\n"); grid = -1; return; }
        if (hipOccupancyMaxActiveBlocksPerMultiprocessor(&per_cu, (const void*)fwd_kernel, 512, LDS_BYTES) != hipSuccess || per_cu < 1) { fprintf(stderr, "kernel_launch: occupancy query says %d\n", per_cu); grid = -1; return; }
        (void)hipGetLastError();
        grid = cus;
    }
    if (grid < 0) return;
    hipMemsetAsync((char*)d_ws + WS_CTL, 0, CTL_ZERO_BYTES, stream);
    Args a{};
    for (int i = 0; i < 29; ++i) a.in[i] = (const float*)d_in[i];
    a.out = (float*)d_out; a.ws = (unsigned char*)d_ws;
#if MK_MULTI
    for (int ph = 0; ph < NPHASES; ++ph) { a.ph_lo = ph; a.ph_hi = ph + 1; hipLaunchKernelGGL(fwd_kernel, dim3(grid), dim3(512), LDS_BYTES, stream, a); }
#else
    a.ph_lo = 0; a.ph_hi = NPHASES;
    hipLaunchKernelGGL(fwd_kernel, dim3(grid), dim3(512), LDS_BYTES, stream, a);
#endif
}
```

```cpp
#include <hip/hip_runtime.h>
#include <cstdio>
#include <cstdint>
#include <cmath>

#ifndef MK_MULTI
#define MK_MULTI 0
#endif

#define GAS __attribute__((address_space(1)))
#define LAS __attribute__((address_space(3)))
typedef unsigned short bf16;
typedef unsigned v4u __attribute__((ext_vector_type(4)));
typedef unsigned v2u __attribute__((ext_vector_type(2)));
typedef float f32x4 __attribute__((ext_vector_type(4)));

constexpr int NB = 4, S = 4096, T = NB * S, D = 1024, DIN = 2568, DR = 512, DA = 512, NH = 8, HD = 64;
constexpr int NE = 32, DE = 512, PLE = 256, DEPTH = 2, NZ = 2560;
constexpr float EPS = 1e-6f, LOG2E = 1.4426950408889634f, C2 = 0.125f * 1.4426950408889634f;
constexpr int CAP = 16384;
constexpr int HROWS = 40960;

constexpr size_t MiB = 1u << 20;
constexpr size_t WS_CTL = 0, CTL_ZERO_BYTES = 1 * MiB;
constexpr size_t WS_LOGF = 1 * MiB;
constexpr size_t WS_C2K = WS_LOGF + MiB / 2;
constexpr size_t WS_SA = 2 * MiB, WS_SH = WS_SA + MiB / 2;
constexpr size_t WS_PAIRW = 3 * MiB;
constexpr size_t WS_ROWPAIR = 4 * MiB;
constexpr size_t WS_WIN = 8 * MiB;
constexpr size_t WS_WOUT = 18 * MiB;
constexpr size_t WS_WPG = 22 * MiB;
constexpr size_t WS_WPP = 26 * MiB;
constexpr size_t WS_WGU = 28 * MiB;
constexpr size_t WS_WDN = 156 * MiB;
constexpr size_t WS_PB = 220 * MiB;
constexpr size_t WS_XN = 236 * MiB;
constexpr size_t WS_X = 268 * MiB;
constexpr size_t WS_R1 = 332 * MiB;
constexpr size_t WS_R2 = 412 * MiB;
constexpr size_t WS_PROJ = 460 * MiB;
constexpr size_t WS_END = 492 * MiB;
constexpr int CW_BAR = 4096;
constexpr int CW_CNT = 8192;

constexpr int RING_BYTES = 131072;
constexpr int MISC_OFF = RING_BYTES + 320;
constexpr int LDS_BYTES = 147456;

__device__ __forceinline__ unsigned f2bf(float f) { unsigned u = __builtin_bit_cast(unsigned, f); return (u + 0x7fffu + ((u >> 16) & 1u)) >> 16; }
__device__ __forceinline__ unsigned pk2(float lo, float hi) { return f2bf(lo) | (f2bf(hi) << 16); }
__device__ __forceinline__ float bf2f(unsigned u) { return __builtin_bit_cast(float, u << 16); }
__device__ __forceinline__ float bflo(unsigned w) { return __builtin_bit_cast(float, w << 16); }
__device__ __forceinline__ float bfhi(unsigned w) { return __builtin_bit_cast(float, w & 0xffff0000u); }
__device__ __forceinline__ float wave_sum(float v) {
#pragma unroll
    for (int o = 1; o < 64; o <<= 1) v += __shfl_xor(v, o);
    return v;
}
__device__ __forceinline__ float wave_max(float v) {
#pragma unroll
    for (int o = 1; o < 64; o <<= 1) v = fmaxf(v, __shfl_xor(v, o));
    return v;
}
__device__ __forceinline__ float sigmoidf_(float v) { return 1.f / (1.f + __expf(-v)); }
__device__ __forceinline__ float gelu_tanh(float v) { return 0.5f * v * (1.f + tanhf(0.7978845608028654f * (v + 0.044715f * v * v * v))); }
__device__ __forceinline__ float log_sigmoid(float v) { return v >= 0.f ? -log1pf(__expf(-v)) : v - log1pf(__expf(v)); }

#define XB_TMO      128
#define XB_XCNT(j)  (256  + 64 * (j))
#define XB_XSUB(j)  (1280 + 64 * (j))
#define XB_XGEN(j)  (2304 + 64 * (j))
#define XB_TOP      3328
#define XB_TOPGEN   3392
#define XCD_BAR_WORDS 3456
#define XB_SPIN_CAP (1u << 26)
__device__ __forceinline__ unsigned xb_ld(unsigned* p)              { return __hip_atomic_load(p, __ATOMIC_RELAXED, __HIP_MEMORY_SCOPE_AGENT); }
__device__ __forceinline__ unsigned xb_add(unsigned* p, unsigned v) { return __hip_atomic_fetch_add(p, v, __ATOMIC_RELAXED, __HIP_MEMORY_SCOPE_AGENT); }
__device__ __forceinline__ unsigned xb_xcc_id() { return (unsigned)__builtin_amdgcn_s_getreg((3 << 11) | 20) & 0xFu; }
#define XB_SPIN(cond, bar) do { unsigned _sp = 0; while (cond) { __builtin_amdgcn_s_sleep(1); \
    if ((++_sp & 255u) == 0u) { if (xb_ld(&(bar)[XB_TMO])) break; if (_sp > XB_SPIN_CAP) { atomicAdd(&(bar)[XB_TMO], 1u); break; } } } } while (0)
struct XcdBarrier { unsigned* bar; unsigned x; volatile LAS unsigned* st; };
__device__ __forceinline__ XcdBarrier xcd_barrier_post(unsigned* bar, volatile LAS unsigned* st) {
    XcdBarrier b; b.bar = bar; b.x = xb_xcc_id(); b.st = st;
    if (threadIdx.x == 0) (void)xb_add(&bar[XB_XCNT(b.x)], 1u);
    return b;
}
__device__ __forceinline__ void xcd_barrier_complete(unsigned* bar, unsigned x, unsigned& nloc, unsigned& nx) {
    const unsigned G = gridDim.x * gridDim.y * gridDim.z;
    unsigned sum, cnt, mine, sp = 0u;
    for (;;) {
        sum = 0u; cnt = 0u; mine = 0u;
#pragma unroll
        for (unsigned j = 0; j < 16; ++j) { const unsigned c = xb_ld(&bar[XB_XCNT(j)]); sum += c; cnt += (c > 0u) ? 1u : 0u; mine = (j == x) ? c : mine; }
        if (sum == G) break;
        __builtin_amdgcn_s_sleep(1);
        if ((++sp & 255u) == 0u) { if (xb_ld(&bar[XB_TMO])) break; if (sp > XB_SPIN_CAP) { atomicAdd(&bar[XB_TMO], 1u); break; } }
    }
    nloc = mine > 0u ? mine : 1u; nx = cnt > 0u ? cnt : 1u;
}
__device__ __forceinline__ void xcd_barrier(const XcdBarrier& b) {
    asm volatile("s_waitcnt vmcnt(0)" ::: "memory");
    __syncthreads();
    if (threadIdx.x == 0) {
        unsigned* bar = b.bar;
        __builtin_amdgcn_s_waitcnt(0);
        unsigned nloc = b.st[0], nx = b.st[1];
        if (nloc == 0u) { xcd_barrier_complete(bar, b.x, nloc, nx); b.st[0] = nloc; b.st[1] = nx; }
        const unsigned old = xb_add(&bar[XB_XSUB(b.x)], 1u);
        const unsigned gen = old / nloc;
        if (old + 1u == (gen + 1u) * nloc) {
            __builtin_amdgcn_fence(__ATOMIC_RELEASE, "agent");
            asm volatile("s_waitcnt vmcnt(0)" ::: "memory");
            const unsigned og = xb_add(&bar[XB_TOP], 1u);
            const unsigned tg = og / nx;
            if (og + 1u == (tg + 1u) * nx) xb_add(&bar[XB_TOPGEN], 1u);
            else XB_SPIN(xb_ld(&bar[XB_TOPGEN]) == tg, bar);
            __builtin_amdgcn_fence(__ATOMIC_ACQUIRE, "agent");
            xb_add(&bar[XB_XGEN(b.x)], 1u);
            asm volatile("s_waitcnt vmcnt(0)" ::: "memory");
        } else {
            XB_SPIN(xb_ld(&bar[XB_XGEN(b.x)]) == gen, bar);
            __builtin_amdgcn_fence(__ATOMIC_ACQUIRE, "agent");
            asm volatile("s_waitcnt vmcnt(0)" ::: "memory");
        }
    }
    __syncthreads();
}

struct Args { const float* in[29]; float* out; unsigned char* ws; int ph_lo, ph_hi; };
typedef const __attribute__((address_space(4))) Args* KA;
__device__ __forceinline__ KA fresh_args() { KA p = (KA)__builtin_amdgcn_kernarg_segment_ptr(); asm volatile("" : "+s"(p)); return p; }
struct Ctx {
    LAS unsigned char* lds;
    int tid, lane, wave, gw, ngw;
    unsigned char* ws;
};
enum { I_X = 0, I_P, I_MIXN, I_WIN, I_BF, I_CONVW, I_CONVB, I_WR, I_BR, I_WI, I_BI, I_LAM, I_QN, I_KN, I_LRUN, I_ATTN, I_WOUT, I_FFNN,
       I_WG, I_BG, I_WRT, I_BRT, I_WEG, I_WEU, I_WED, I_PLEN, I_WPG, I_BPG, I_WPP };

__device__ __forceinline__ void transpose_item(const float* W, int ldw, int K, bf16* WT, int k0, int n0, int c0, LAS float* scr, int lane) {
#pragma unroll 8
    for (int i = 0; i < 32; ++i) { const int kk = 2 * i + (lane >> 5); scr[kk * 33 + (lane & 31)] = W[(size_t)(k0 + kk) * ldw + c0 + (lane & 31)]; }
    asm volatile("s_waitcnt lgkmcnt(0)" ::: "memory");
    const int c = lane & 7;
#pragma unroll
    for (int j = 0; j < 4; ++j) { const int n = (lane >> 3) + 8 * j; const LAS float* s = scr + (8 * c) * 33 + n;
        v4u o; o.x = pk2(s[0 * 33], s[1 * 33]); o.y = pk2(s[2 * 33], s[3 * 33]); o.z = pk2(s[4 * 33], s[5 * 33]); o.w = pk2(s[6 * 33], s[7 * 33]);
        *(v4u*)(WT + (size_t)(n0 + n) * K + k0 + 8 * c) = o; }
    asm volatile("s_waitcnt lgkmcnt(0)" ::: "memory");
}
__device__ __forceinline__ void phase_prologue(Ctx& C, KA AR) {
    LAS float* scr = (LAS float*)(C.lds + C.wave * 16384);
    constexpr int I_IN = 16 * 80, I_OUT = 16 * 32, I_GU = 32 * 16 * 32, I_DN = 32 * 8 * 32, I_PG = 16 * 32, I_PP = 4 * 32;
    constexpr int PER_L = I_IN + I_OUT + I_GU + I_DN + I_PG + I_PP;
    for (int it = C.gw; it < DEPTH * PER_L; it += C.ngw) {
        const int l = it / PER_L; int r = it % PER_L;
        if (r < I_IN) {
            const int kb = r / 80, nb = r % 80, n0 = 32 * nb, pn = n0 >> 8, jl = n0 & 255, bj = jl >> 7, wc = (jl >> 5) & 3;
            transpose_item(AR->in[I_WIN] + (size_t)l * D * DIN, DIN, D, (bf16*)(C.ws + WS_WIN) + (size_t)l * NZ * D, 64 * kb, n0, 256 * pn + 64 * wc + 32 * bj, scr, C.lane); continue; }
        r -= I_IN;
        if (r < I_OUT) { const int kb = r / 32, nb = r % 32;
            transpose_item(AR->in[I_WOUT] + (size_t)l * D * D, D, D, (bf16*)(C.ws + WS_WOUT) + (size_t)l * D * D, 64 * kb, 32 * nb, 32 * nb, scr, C.lane); continue; }
        r -= I_OUT;
        if (r < I_GU) {
            const int e = r / 512, q = r % 512, kb = q / 32, nb = q % 32, n0 = 32 * nb, pn = n0 >> 8, jl = n0 & 255;
            const float* src = (jl < 128 ? AR->in[I_WEG] : AR->in[I_WEU]) + (size_t)(l * NE + e) * D * DE;
            transpose_item(src, DE, D, (bf16*)(C.ws + WS_WGU) + (size_t)(l * NE + e) * 1024 * D, 64 * kb, n0, 128 * pn + (jl & 127), scr, C.lane); continue; }
        r -= I_GU;
        if (r < I_DN) { const int e = r / 256, q = r % 256, kb = q / 32, nb = q % 32;
            transpose_item(AR->in[I_WED] + (size_t)(l * NE + e) * DE * D, D, DE, (bf16*)(C.ws + WS_WDN) + (size_t)(l * NE + e) * D * DE, 64 * kb, 32 * nb, 32 * nb, scr, C.lane); continue; }
        r -= I_DN;
        if (r < I_PG) { const int kb = r / 32, nb = r % 32;
            transpose_item(AR->in[I_WPG] + (size_t)l * D * D, D, D, (bf16*)(C.ws + WS_WPG) + (size_t)l * D * D, 64 * kb, 32 * nb, 32 * nb, scr, C.lane); continue; }
        r -= I_PG;
        { const int kb = r / 32, nb = r % 32;
            transpose_item(AR->in[I_WPP] + (size_t)l * PLE * D, D, PLE, (bf16*)(C.ws + WS_WPP) + (size_t)l * D * PLE, 64 * kb, 32 * nb, 32 * nb, scr, C.lane); }
    }
    const f32x4* ps = (const f32x4*)AR->in[I_P]; v2u* pd = (v2u*)(C.ws + WS_PB);
    const size_t n4 = (size_t)DEPTH * T * PLE / 4;
    for (size_t i = (size_t)blockIdx.x * 512 + C.tid; i < n4; i += (size_t)gridDim.x * 512) { const f32x4 v = ps[i]; v2u o; o.x = pk2(v.x, v.y); o.y = pk2(v.z, v.w); pd[i] = o; }
}

__device__ __forceinline__ void load_row(const float* row, int lane, f32x4 (&v)[4]) {
    const f32x4* xr = (const f32x4*)row + lane;
#pragma unroll
    for (int j = 0; j < 4; ++j) v[j] = xr[64 * j];
}
__device__ __forceinline__ float row_rs(const f32x4 (&v)[4]) {
    float s = 0.f;
#pragma unroll
    for (int j = 0; j < 4; ++j) s += (v[j].x * v[j].x + v[j].y * v[j].y) + (v[j].z * v[j].z + v[j].w * v[j].w);
    return rsqrtf(wave_sum(s) * (1.f / D) + EPS);
}
__device__ __forceinline__ void scale_row(f32x4 (&v)[4], float rs, const float* gain, int lane) {
    const f32x4* g = (const f32x4*)gain + lane;
#pragma unroll
    for (int j = 0; j < 4; ++j) v[j] = v[j] * rs * g[64 * j];
}
__device__ __forceinline__ void store_row_bf16(bf16* row, int lane, const f32x4 (&v)[4]) {
    v2u* o = (v2u*)row + lane;
#pragma unroll
    for (int j = 0; j < 4; ++j) { v2u w; w.x = pk2(v[j].x, v[j].y); w.y = pk2(v[j].z, v[j].w); o[64 * j] = w; }
}

__device__ __forceinline__ void phase_norm1(Ctx& C, KA AR, int l) {
    const float* xs = l == 0 ? AR->in[I_X] : (const float*)(C.ws + WS_X);
    const float* gain = AR->in[I_MIXN] + l * D;
    const float* wf = AR->in[I_WIN] + (size_t)l * D * DIN + NZ;
    const float* bfg = AR->in[I_BF] + l * NH;
    bf16* xn = (bf16*)(C.ws + WS_XN); float* logf = (float*)(C.ws + WS_LOGF);
    for (int t = C.gw; t < T; t += C.ngw) {
        f32x4 v[4]; load_row(xs + (size_t)t * D, C.lane, v);
        const float rs = row_rs(v); scale_row(v, rs, gain, C.lane);
        store_row_bf16(xn + (size_t)t * D, C.lane, v);
        float z[8] = {0.f, 0.f, 0.f, 0.f, 0.f, 0.f, 0.f, 0.f};
#pragma unroll
        for (int j = 0; j < 4; ++j)
#pragma unroll
            for (int e = 0; e < 4; ++e) { const int k = 256 * j + 4 * C.lane + e; const f32x4 w0 = *(const f32x4*)(wf + (size_t)k * DIN), w1 = *(const f32x4*)(wf + (size_t)k * DIN + 4);
                const float a = v[j][e]; z[0] += a * w0.x; z[1] += a * w0.y; z[2] += a * w0.z; z[3] += a * w0.w; z[4] += a * w1.x; z[5] += a * w1.y; z[6] += a * w1.z; z[7] += a * w1.w; }
#pragma unroll
        for (int h = 0; h < 8; ++h) z[h] = wave_sum(z[h]);
        float mine = 0.f;
#pragma unroll
        for (int h = 0; h < 8; ++h) mine = (C.lane == h) ? z[h] : mine;
        if (C.lane < 8) logf[(size_t)t * 8 + C.lane] = log_sigmoid(mine + bfg[C.lane]);
    }
}

template <int NACC, class AR, class BR, class EP>
__device__ __forceinline__ void ngemm_tile(LAS float* sm, int K, AR arow, BR brow, EP epi) {
    LAS float* As = sm; LAS float* Bs = sm + 32 * 68;
    const int tid = threadIdx.x, ty = tid >> 4, tx = tid & 15, lr = tid >> 3, lk = (tid & 7) * 4;
    float acc[NACC][2][4];
#pragma unroll
    for (int a = 0; a < NACC; ++a)
#pragma unroll
        for (int i = 0; i < 2; ++i)
#pragma unroll
            for (int j = 0; j < 4; ++j) acc[a][i][j] = 0.f;
    const bf16* ap = arow(lr); const bf16* bp0 = brow(lr, 0); const bf16* bp1 = NACC > 1 ? brow(lr, 1) : bp0;
    for (int k0 = 0; k0 < K; k0 += 32) {
        __syncthreads();
        { v2u av; av.x = 0u; av.y = 0u; if (ap) av = *(const v2u*)(ap + k0 + lk);
          As[(lk + 0) * 68 + lr] = bflo(av.x); As[(lk + 1) * 68 + lr] = bfhi(av.x); As[(lk + 2) * 68 + lr] = bflo(av.y); As[(lk + 3) * 68 + lr] = bfhi(av.y); }
        { const v2u bv = *(const v2u*)(bp0 + k0 + lk);
          Bs[(lk + 0) * 68 + lr] = bflo(bv.x); Bs[(lk + 1) * 68 + lr] = bfhi(bv.x); Bs[(lk + 2) * 68 + lr] = bflo(bv.y); Bs[(lk + 3) * 68 + lr] = bfhi(bv.y); }
        if (NACC > 1) { const v2u bv = *(const v2u*)(bp1 + k0 + lk); LAS float* B1 = Bs + 32 * 68;
          B1[(lk + 0) * 68 + lr] = bflo(bv.x); B1[(lk + 1) * 68 + lr] = bfhi(bv.x); B1[(lk + 2) * 68 + lr] = bflo(bv.y); B1[(lk + 3) * 68 + lr] = bfhi(bv.y); }
        __syncthreads();
#pragma unroll 8
        for (int kk = 0; kk < 32; ++kk) {
            const float a0 = As[kk * 68 + ty * 2], a1 = As[kk * 68 + ty * 2 + 1];
#pragma unroll
            for (int a = 0; a < NACC; ++a) { const f32x4 b = *(const LAS f32x4*)(Bs + a * 32 * 68 + kk * 68 + tx * 4);
#pragma unroll
                for (int j = 0; j < 4; ++j) { acc[a][0][j] += a0 * b[j]; acc[a][1][j] += a1 * b[j]; } }
        }
    }
#pragma unroll
    for (int i = 0; i < 2; ++i)
#pragma unroll
        for (int j = 0; j < 4; ++j) epi(ty * 2 + i, tx * 4 + j, acc[0][i][j], NACC > 1 ? acc[1][i][j] : 0.f);
}

__device__ __forceinline__ void phase_cumsum(Ctx& C, KA AR) {
    if (C.gw < NB * NH) {
        const int b = C.gw / NH, h = C.gw % NH;
        const float* logf = (const float*)(C.ws + WS_LOGF) + (size_t)b * S * 8 + h; float* c2k = (float*)(C.ws + WS_C2K) + (size_t)C.gw * S;
        float s = 0.f;
        for (int i = 0; i < 64; ++i) s += logf[(size_t)(64 * C.lane + i) * 8];
        float inc = s;
#pragma unroll
        for (int o = 1; o < 64; o <<= 1) { const float v = __shfl_up(inc, o); if (C.lane >= o) inc += v; }
        float run = inc - s;
        for (int i = 0; i < 64; ++i) { run += logf[(size_t)(64 * C.lane + i) * 8]; c2k[64 * C.lane + i] = run * LOG2E; }
    }
}
__device__ __forceinline__ void phase_gemm1_naive(Ctx& C, KA AR, int l) {
    phase_cumsum(C, AR);
    const bf16* A = (const bf16*)(C.ws + WS_XN); const bf16* Bt = (const bf16*)(C.ws + WS_WIN) + (size_t)l * NZ * D;
    bf16* R1 = (bf16*)(C.ws + WS_R1);
    for (int u = blockIdx.x; u < (T / 64) * (NZ / 64); u += gridDim.x) {
        const int mt = u / (NZ / 64), nt = u % (NZ / 64), m0 = 64 * mt, n0 = 64 * nt;
        ngemm_tile<1>((LAS float*)C.lds, D, [=](int r) { return A + (size_t)(m0 + r) * D; }, [=](int c, int) { return Bt + (size_t)(n0 + c) * D; },
            [=](int r, int c, float v, float) {
                const int j = n0 + c, pn = j >> 8, jl = j & 255, bj = jl >> 7, wc = (jl >> 5) & 3, col = 256 * pn + 64 * wc + 32 * bj + (jl & 31);
                const int seg = col >> 9, cc = col & 511;
                const float o = seg == 1 ? gelu_tanh(v) : v;
                R1[(size_t)seg * T * 512 + (size_t)(m0 + r) * 512 + cc] = (bf16)f2bf(o);
            });
    }
}
__device__ __forceinline__ void phase_qknorm_naive(Ctx& C, KA AR, int l) {
    bf16* Q = (bf16*)(C.ws + WS_R1) + (size_t)2 * T * 512; bf16* Kb = Q + (size_t)T * 512;
    const float* gq = AR->in[I_QN] + l * HD; const float* gk = AR->in[I_KN] + l * HD;
    for (int i = C.gw; i < 2 * T; i += C.ngw) {
        const int t = i >> 1, isk = i & 1; bf16* row = (isk ? Kb : Q) + (size_t)t * 512; const float* g = isk ? gk : gq;
        const v4u w = *(const v4u*)(row + 8 * C.lane);
        float x[8] = {bflo(w.x), bfhi(w.x), bflo(w.y), bfhi(w.y), bflo(w.z), bfhi(w.z), bflo(w.w), bfhi(w.w)};
        float s = 0.f;
#pragma unroll
        for (int e = 0; e < 8; ++e) s += x[e] * x[e];
        s += __shfl_xor(s, 1); s += __shfl_xor(s, 2); s += __shfl_xor(s, 4);
        const float rs = rsqrtf(s * (1.f / 64.f) + EPS) * (isk ? 1.f : C2);
        const int d0 = 8 * (C.lane & 7);
#pragma unroll
        for (int e = 0; e < 8; ++e) x[e] = x[e] * rs * g[d0 + e];
        v4u o; o.x = pk2(x[0], x[1]); o.y = pk2(x[2], x[3]); o.z = pk2(x[4], x[5]); o.w = pk2(x[6], x[7]);
        *(v4u*)(row + 8 * C.lane) = o;
    }
}

template <int MODE>
__device__ __forceinline__ void phase_rnn_naive(Ctx& C, KA AR, int l) {
    LAS float* xcs = (LAS float*)C.lds; LAS float* as = xcs + 64 * 65; LAS float* us = as + 64 * 64;
    const bf16* ZX = (const bf16*)(C.ws + WS_R1); const bf16* ZG = ZX + (size_t)T * 512;
    float* SA = (float*)(C.ws + WS_SA); float* SH = (float*)(C.ws + WS_SH); float* YR = (float*)(C.ws + WS_PROJ);
    const float* cw = AR->in[I_CONVW] + l * 4 * DR; const float* cb = AR->in[I_CONVB] + l * DR;
    const float* wr = AR->in[I_WR] + (size_t)l * 8 * 64 * 64; const float* wi = AR->in[I_WI] + (size_t)l * 8 * 64 * 64;
    const float* br = AR->in[I_BR] + l * DR; const float* bi = AR->in[I_BI] + l * DR; const float* lam = AR->in[I_LAM] + l * DR;
    for (int u = blockIdx.x; u < NB * 64 * 8; u += gridDim.x) {
        const int b = u >> 9, cidx = (u >> 3) & 63, blk = u & 7;
        __syncthreads();
#pragma unroll
        for (int i = 0; i < 8; ++i) { const int e = C.tid + 512 * i, t = e >> 6, c = e & 63, ch = blk * 64 + c, tg = cidx * 64 + t;
            float xc = cb[ch];
#pragma unroll
            for (int j = 0; j < 4; ++j) { const int tt = tg - 3 + j; if (tt >= 0) xc += cw[j * DR + ch] * bf2f(ZX[(size_t)(b * S + tt) * 512 + ch]); }
            xcs[t * 65 + c] = xc; }
        __syncthreads();
#pragma unroll
        for (int i = 0; i < 8; ++i) { const int e = C.tid + 512 * i, t = e >> 6, j = e & 63, ch = blk * 64 + j;
            float ar = br[ch], ai = bi[ch];
            for (int k = 0; k < 64; ++k) { const float x = xcs[t * 65 + k]; ar += x * wr[(size_t)(blk * 64 + k) * 64 + j]; ai += x * wi[(size_t)(blk * 64 + k) * 64 + j]; }
            const float r = sigmoidf_(ar), ig = sigmoidf_(ai);
            const float la = -8.f * r * log1pf(__expf(-lam[ch]));
            as[t * 64 + j] = __expf(la); us[t * 64 + j] = sqrtf(-expm1f(2.f * la)) * (ig * xcs[t * 65 + j]); }
        __syncthreads();
        if (C.tid < 64) { const int j = C.tid, ch = blk * 64 + j;
            if (MODE == 0) { float A = 1.f, H = 0.f;
                for (int t = 0; t < 64; ++t) { const float a = as[t * 64 + j]; H = a * H + us[t * 64 + j]; A *= a; }
                SA[(size_t)(b * 64 + cidx) * 512 + ch] = A; SH[(size_t)(b * 64 + cidx) * 512 + ch] = H;
            } else { float h = 0.f;
                for (int c2 = 0; c2 < cidx; ++c2) h = SA[(size_t)(b * 64 + c2) * 512 + ch] * h + SH[(size_t)(b * 64 + c2) * 512 + ch];
                for (int t = 0; t < 64; ++t) { h = as[t * 64 + j] * h + us[t * 64 + j]; as[t * 64 + j] = h; } } }
        if (MODE == 1) { __syncthreads();
#pragma unroll
            for (int i = 0; i < 8; ++i) { const int e = C.tid + 512 * i, t = e >> 6, c = e & 63, ch = blk * 64 + c; const size_t row = (size_t)(b * S + cidx * 64 + t);
                YR[row * 512 + ch] = as[t * 64 + c] * bf2f(ZG[row * 512 + ch]); } }
    }
}

__device__ __forceinline__ void phase_attn_naive(Ctx& C, KA AR, int l) {
    LAS float* Ks = (LAS float*)C.lds; LAS float* Vs = Ks + 64 * 65; LAS float* Qs = Vs + 64 * 65; LAS float* Ps = Qs + 64 * 64; LAS float* cks = Ps + 8 * 64;
    const bf16* Q = (const bf16*)(C.ws + WS_R1) + (size_t)2 * T * 512; const bf16* Kb = Q + (size_t)T * 512; const bf16* Vb = Kb + (size_t)T * 512;
    bf16* O = (bf16*)(C.ws + WS_R2); const float* c2k = (const float*)(C.ws + WS_C2K);
    for (int u = blockIdx.x; u < NB * NH * 64; u += gridDim.x) {
        const int qt = 63 - (u >> 5), bh = u & 31, b = bh >> 3, h = bh & 7, q0 = 64 * qt;
        const float* ck = c2k + (size_t)bh * S;
        __syncthreads();
        for (int e = C.tid; e < 64 * 64; e += 512) { const int r = e >> 6, d = e & 63; Qs[r * 64 + d] = bf2f(Q[(size_t)(b * S + q0 + r) * 512 + h * 64 + d]); }
        float m[8], lsum[8], o[8], cq[8];
#pragma unroll
        for (int i = 0; i < 8; ++i) { m[i] = -INFINITY; lsum[i] = 0.f; o[i] = 0.f; cq[i] = ck[q0 + C.wave * 8 + i]; }
        for (int kt = 0; kt <= qt; ++kt) {
            const int k0 = 64 * kt;
            __syncthreads();
            for (int e = C.tid; e < 64 * 64; e += 512) { const int r = e >> 6, d = e & 63; const size_t g = (size_t)(b * S + k0 + r) * 512 + h * 64 + d; Ks[r * 65 + d] = bf2f(Kb[g]); Vs[r * 65 + d] = bf2f(Vb[g]); }
            if (C.tid < 64) cks[C.tid] = ck[k0 + C.tid];
            __syncthreads();
#pragma unroll
            for (int i = 0; i < 8; ++i) {
                const int q = C.wave * 8 + i, qg = q0 + q;
                float dot = 0.f;
#pragma unroll 16
                for (int d = 0; d < 64; ++d) dot += Qs[q * 64 + d] * Ks[C.lane * 65 + d];
                float s = dot + cq[i] - cks[C.lane];
                if (k0 + C.lane > qg) s = -INFINITY;
                const float mn = fmaxf(m[i], wave_max(s));
                const float alpha = exp2f(m[i] - mn), p = exp2f(s - mn);
                lsum[i] = lsum[i] * alpha + wave_sum(p); m[i] = mn;
                Ps[C.wave * 64 + C.lane] = p;
                asm volatile("s_waitcnt lgkmcnt(0)" ::: "memory");
                float acc = 0.f;
#pragma unroll 16
                for (int k = 0; k < 64; ++k) acc += Ps[C.wave * 64 + k] * Vs[k * 65 + C.lane];
                o[i] = o[i] * alpha + acc;
                asm volatile("s_waitcnt lgkmcnt(0)" ::: "memory");
            }
        }
#pragma unroll
        for (int i = 0; i < 8; ++i) O[(size_t)(b * S + q0 + C.wave * 8 + i) * 512 + h * 64 + C.lane] = (bf16)f2bf(o[i] / lsum[i]);
    }
}

__device__ __forceinline__ void phase_mixnorm_naive(Ctx& C, KA AR, int l) {
    const float* YR = (const float*)(C.ws + WS_PROJ); const bf16* O = (const bf16*)(C.ws + WS_R2); bf16* YM = (bf16*)(C.ws + WS_R2 + 16 * MiB);
    const float* g1 = AR->in[I_LRUN] + l * DR; const float* g2 = AR->in[I_ATTN] + l * DA;
    for (int t = C.gw; t < T; t += C.ngw) {
        f32x4 a[2]; float s = 0.f;
#pragma unroll
        for (int j = 0; j < 2; ++j) { a[j] = *((const f32x4*)(YR + (size_t)t * 512) + C.lane + 64 * j); s += (a[j].x * a[j].x + a[j].y * a[j].y) + (a[j].z * a[j].z + a[j].w * a[j].w); }
        float rs = rsqrtf(wave_sum(s) * (1.f / 512.f) + EPS);
#pragma unroll
        for (int j = 0; j < 2; ++j) { const f32x4 g = *((const f32x4*)g1 + C.lane + 64 * j); const f32x4 v = a[j] * rs * g; v2u w; w.x = pk2(v.x, v.y); w.y = pk2(v.z, v.w);
            *((v2u*)(YM + (size_t)t * D) + C.lane + 64 * j) = w; }
        const v4u w = *(const v4u*)(O + (size_t)t * 512 + 8 * C.lane);
        float x[8] = {bflo(w.x), bfhi(w.x), bflo(w.y), bfhi(w.y), bflo(w.z), bfhi(w.z), bflo(w.w), bfhi(w.w)};
        s = 0.f;
#pragma unroll
        for (int e = 0; e < 8; ++e) s += x[e] * x[e];
        rs = rsqrtf(wave_sum(s) * (1.f / 512.f) + EPS);
#pragma unroll
        for (int e = 0; e < 8; ++e) x[e] = x[e] * rs * g2[8 * C.lane + e];
        v4u o; o.x = pk2(x[0], x[1]); o.y = pk2(x[2], x[3]); o.z = pk2(x[4], x[5]); o.w = pk2(x[6], x[7]);
        *(v4u*)(YM + (size_t)t * D + 512 + 8 * C.lane) = o;
    }
}

__device__ __forceinline__ void phase_wo_naive(Ctx& C, KA AR, int l) {
    const bf16* A = (const bf16*)(C.ws + WS_R2 + 16 * MiB); const bf16* Bt = (const bf16*)(C.ws + WS_WOUT) + (size_t)l * D * D;
    const float* xs = l == 0 ? AR->in[I_X] : (const float*)(C.ws + WS_X); float* X = (float*)(C.ws + WS_X);
    for (int u = blockIdx.x; u < (T / 64) * (D / 64); u += gridDim.x) {
        const int m0 = 64 * (u / (D / 64)), n0 = 64 * (u % (D / 64));
        ngemm_tile<1>((LAS float*)C.lds, D, [=](int r) { return A + (size_t)(m0 + r) * D; }, [=](int c, int) { return Bt + (size_t)(n0 + c) * D; },
            [=](int r, int c, float v, float) { const size_t i = (size_t)(m0 + r) * D + n0 + c; X[i] = xs[i] + v; });
    }
}

__device__ __forceinline__ void phase_router(Ctx& C, KA AR, int l) {
    const float* X = (const float*)(C.ws + WS_X); bf16* xn = (bf16*)(C.ws + WS_XN);
    const float* gain = AR->in[I_FFNN] + l * D; const float* wg = AR->in[I_WG] + (size_t)l * D * 4; const float* bg = AR->in[I_BG] + l * 4;
    const float* wr = AR->in[I_WRT] + (size_t)l * D * NE; const float* brt = AR->in[I_BRT] + l * NE;
    unsigned* cnt = (unsigned*)(C.ws + WS_CTL) + CW_CNT + 64 * l; int* rowpair = (int*)(C.ws + WS_ROWPAIR); float* pairw = (float*)(C.ws + WS_PAIRW);
    for (int t = C.gw; t < T; t += C.ngw) {
        f32x4 v[4]; load_row(X + (size_t)t * D, C.lane, v);
        const float rs = row_rs(v); scale_row(v, rs, gain, C.lane);
        store_row_bf16(xn + (size_t)t * D, C.lane, v);
        LAS float* rowl = (LAS float*)C.lds + C.wave * 1024;
#pragma unroll
        for (int j = 0; j < 4; ++j) *((LAS f32x4*)rowl + C.lane + 64 * j) = v[j];
        asm volatile("s_waitcnt lgkmcnt(0)" ::: "memory");
        float acc = 0.f;
        if (C.lane < 36) {
            const float* wp = C.lane < 32 ? wr + C.lane : wg + (C.lane - 32); const int st = C.lane < 32 ? NE : 4;
#pragma unroll 8
            for (int k = 0; k < D; ++k) acc += rowl[k] * wp[(size_t)k * st];
            acc += C.lane < 32 ? brt[C.lane] : bg[C.lane - 32];
        }
        asm volatile("s_waitcnt lgkmcnt(0)" ::: "memory");
        float gl[4];
#pragma unroll
        for (int i = 0; i < 4; ++i) gl[i] = __shfl(acc, 32 + i);
        int gi = 0; float gm = gl[0];
#pragma unroll
        for (int i = 1; i < 4; ++i) if (gl[i] > gm) { gm = gl[i]; gi = i; }
        float gs = 0.f;
#pragma unroll
        for (int i = 0; i < 4; ++i) gs += __expf(gl[i] - gm);
        const float gp = 1.f / gs;
        float ev[8];
#pragma unroll
        for (int i = 0; i < 8; ++i) ev[i] = __shfl(acc, gi * 8 + i);
        int i0 = 0; float t0 = ev[0];
#pragma unroll
        for (int i = 1; i < 8; ++i) if (ev[i] > t0) { t0 = ev[i]; i0 = i; }
        int i1 = -1; float t1 = -INFINITY;
#pragma unroll
        for (int i = 0; i < 8; ++i) if (i != i0 && ev[i] > t1) { t1 = ev[i]; i1 = i; }
        const float ex = __expf(t1 - t0), w0 = gp / (1.f + ex), w1 = gp * ex / (1.f + ex);
        if (C.lane < 2) { const int e = gi * 8 + (C.lane == 0 ? i0 : i1); const unsigned pos = atomicAdd(cnt + e, 1u);
            rowpair[(size_t)e * CAP + pos] = 2 * t + C.lane; pairw[2 * t + C.lane] = C.lane == 0 ? w0 : w1; }
    }
}

struct ExpTab { int n[NE], hoff[NE], t0[NE + 1]; };
__device__ __forceinline__ void build_exptab(Ctx& C, int l, LAS int* tab) {
    __syncthreads();
    if (C.tid == 0) { const unsigned* cnt = (const unsigned*)(C.ws + WS_CTL) + CW_CNT + 64 * l; int ho = 0, tt = 0;
        for (int e = 0; e < NE; ++e) { const int n = (int)__hip_atomic_load(cnt + e, __ATOMIC_RELAXED, __HIP_MEMORY_SCOPE_AGENT); tab[e] = n; tab[32 + e] = ho; tab[64 + e] = tt; ho += (n + 255) & ~255; tt += (n + 63) >> 6; }
        tab[64 + NE] = tt; }
    __syncthreads();
}
__device__ __forceinline__ void phase_g1_naive(Ctx& C, KA AR, int l) {
    LAS int* tab = (LAS int*)(C.lds + 65536); build_exptab(C, l, tab);
    const bf16* xn = (const bf16*)(C.ws + WS_XN); const int* rowpair = (const int*)(C.ws + WS_ROWPAIR); bf16* Hb = (bf16*)(C.ws + WS_R2);
    const int nmt = tab[64 + NE];
    for (int u = blockIdx.x; u < nmt * 8; u += gridDim.x) {
        const int mtg = u >> 3, nt = u & 7; int e = 0;
        for (int i = 1; i < NE; ++i) if (tab[64 + i] <= mtg) e = i;
        const int mt = mtg - tab[64 + e], ne = tab[e], ho = tab[32 + e], p0 = 64 * mt, c0 = 64 * nt;
        const bf16* Bt = (const bf16*)(C.ws + WS_WGU) + (size_t)(l * NE + e) * 1024 * D; const int* rp = rowpair + (size_t)e * CAP;
        ngemm_tile<2>((LAS float*)C.lds, D,
            [=](int r) { return (p0 + r < ne) ? xn + (size_t)(rp[p0 + r] >> 1) * D : (const bf16*)nullptr; },
            [=](int c, int a) { const int cc = c0 + c; return Bt + (size_t)((cc >> 7) * 256 + (cc & 127) + a * 128) * D; },
            [=](int r, int c, float g, float uu) { if (p0 + r < ne) Hb[(size_t)(ho + p0 + r) * DE + c0 + c] = (bf16)f2bf(g / (1.f + __expf(-g)) * uu); });
    }
}
__device__ __forceinline__ void phase_g2_naive(Ctx& C, KA AR, int l) {
    LAS int* tab = (LAS int*)(C.lds + 65536); build_exptab(C, l, tab);
    const int* rowpair = (const int*)(C.ws + WS_ROWPAIR); const float* pairw = (const float*)(C.ws + WS_PAIRW); const bf16* Hb = (const bf16*)(C.ws + WS_R2); bf16* Y2 = (bf16*)(C.ws + WS_R1);
    const int nmt = tab[64 + NE];
    for (int u = blockIdx.x; u < nmt * 16; u += gridDim.x) {
        const int mtg = u >> 4, nt = u & 15; int e = 0;
        for (int i = 1; i < NE; ++i) if (tab[64 + i] <= mtg) e = i;
        const int mt = mtg - tab[64 + e], ne = tab[e], ho = tab[32 + e], p0 = 64 * mt, c0 = 64 * nt;
        const bf16* Bt = (const bf16*)(C.ws + WS_WDN) + (size_t)(l * NE + e) * D * DE; const int* rp = rowpair + (size_t)e * CAP;
        ngemm_tile<1>((LAS float*)C.lds, DE,
            [=](int r) { return (p0 + r < ne) ? Hb + (size_t)(ho + p0 + r) * DE : (const bf16*)nullptr; },
            [=](int c, int) { return Bt + (size_t)(c0 + c) * DE; },
            [=](int r, int c, float v, float) { if (p0 + r < ne) { const int p = rp[p0 + r]; Y2[(size_t)p * D + c0 + c] = (bf16)f2bf(v * pairw[p]); } });
    }
}

__device__ __forceinline__ void phase_combine(Ctx& C, KA AR, int l) {
    float* X = (float*)(C.ws + WS_X); const bf16* Y2 = (const bf16*)(C.ws + WS_R1); bf16* xn = (bf16*)(C.ws + WS_XN); const float* gain = AR->in[I_PLEN] + l * D;
    for (int t = C.gw; t < T; t += C.ngw) {
        f32x4 v[4]; load_row(X + (size_t)t * D, C.lane, v);
#pragma unroll
        for (int j = 0; j < 4; ++j) { const v2u a = *((const v2u*)(Y2 + (size_t)(2 * t) * D) + C.lane + 64 * j), b = *((const v2u*)(Y2 + (size_t)(2 * t + 1) * D) + C.lane + 64 * j);
            v[j].x += bflo(a.x) + bflo(b.x); v[j].y += bfhi(a.x) + bfhi(b.x); v[j].z += bflo(a.y) + bflo(b.y); v[j].w += bfhi(a.y) + bfhi(b.y);
            *((f32x4*)(X + (size_t)t * D) + C.lane + 64 * j) = v[j]; }
        const float rs = row_rs(v); scale_row(v, rs, gain, C.lane);
        store_row_bf16(xn + (size_t)t * D, C.lane, v);
    }
}

__device__ __forceinline__ void phase_proj_naive(Ctx& C, KA AR, int l) {
    const bf16* A = (const bf16*)(C.ws + WS_PB) + (size_t)l * T * PLE; const bf16* Bt = (const bf16*)(C.ws + WS_WPP) + (size_t)l * D * PLE; bf16* PR = (bf16*)(C.ws + WS_PROJ);
    for (int u = blockIdx.x; u < (T / 64) * (D / 64); u += gridDim.x) {
        const int m0 = 64 * (u / (D / 64)), n0 = 64 * (u % (D / 64));
        ngemm_tile<1>((LAS float*)C.lds, PLE, [=](int r) { return A + (size_t)(m0 + r) * PLE; }, [=](int c, int) { return Bt + (size_t)(n0 + c) * PLE; },
            [=](int r, int c, float v, float) { PR[(size_t)(m0 + r) * D + n0 + c] = (bf16)f2bf(v); });
    }
}
__device__ __forceinline__ void phase_ple_naive(Ctx& C, KA AR, int l) {
    const bf16* A = (const bf16*)(C.ws + WS_XN); const bf16* Bt = (const bf16*)(C.ws + WS_WPG) + (size_t)l * D * D; const bf16* PR = (const bf16*)(C.ws + WS_PROJ);
    const float* X = (const float*)(C.ws + WS_X); float* dst = l == DEPTH - 1 ? AR->out : (float*)(C.ws + WS_X); const float* bias = AR->in[I_BPG] + l * D;
    for (int u = blockIdx.x; u < (T / 64) * (D / 64); u += gridDim.x) {
        const int m0 = 64 * (u / (D / 64)), n0 = 64 * (u % (D / 64));
        ngemm_tile<1>((LAS float*)C.lds, D, [=](int r) { return A + (size_t)(m0 + r) * D; }, [=](int c, int) { return Bt + (size_t)(n0 + c) * D; },
            [=](int r, int c, float v, float) { const size_t i = (size_t)(m0 + r) * D + n0 + c; dst[i] = X[i] + bf2f(PR[i]) * sigmoidf_(v + bias[n0 + c]); });
    }
}

constexpr int NPH = 14;
constexpr int NPHASES = 1 + DEPTH * NPH;
__global__ void __launch_bounds__(512, 2) fwd_kernel(Args args) {
    extern __shared__ __attribute__((aligned(16))) unsigned char lds[];
    Ctx C;
    C.lds = (LAS unsigned char*)lds;
    C.tid = threadIdx.x; C.lane = C.tid & 63; C.wave = __builtin_amdgcn_readfirstlane(C.tid >> 6);
    C.gw = blockIdx.x * 8 + C.wave; C.ngw = gridDim.x * 8;
    C.ws = args.ws;
    volatile LAS unsigned* MISC = (volatile LAS unsigned*)(C.lds + MISC_OFF);
    if (C.tid < 32) MISC[C.tid] = 0u;
    __syncthreads();
    XcdBarrier bar; bar.bar = (unsigned*)(C.ws + WS_CTL) + CW_BAR; bar.x = 0; bar.st = nullptr;
    const int lo = args.ph_lo, hi = args.ph_hi;
    if (hi - lo > 1) bar = xcd_barrier_post((unsigned*)(C.ws + WS_CTL) + CW_BAR, MISC + 8);
#ifndef ONLY
#define ONLY -1
#endif
#define PHON(k) (ONLY < 0 || ONLY == (k))
#define IN(k) (lo <= (k) && (k) < hi)
#define SEAM(k) do { if (IN(k) && IN((k) + 1)) xcd_barrier(bar); } while (0)
    if (PHON(99) && IN(0)) { KA A_ = fresh_args(); C.ws = A_->ws; phase_prologue(C, A_); } SEAM(0);
    for (int l = 0; l < DEPTH; ++l) {
        const int pb = 1 + l * NPH;
        if (PHON(0) && IN(pb + 0)) { KA A_ = fresh_args(); C.ws = A_->ws; phase_norm1(C, A_, l); } SEAM(pb + 0);
        if (PHON(1) && IN(pb + 1)) { KA A_ = fresh_args(); C.ws = A_->ws; phase_gemm1_naive(C, A_, l); } SEAM(pb + 1);
        if (PHON(2) && IN(pb + 2)) { KA A_ = fresh_args(); C.ws = A_->ws; phase_qknorm_naive(C, A_, l); } SEAM(pb + 2);
        if (PHON(3) && IN(pb + 3)) { KA A_ = fresh_args(); C.ws = A_->ws; phase_rnn_naive<0>(C, A_, l); } SEAM(pb + 3);
        if (PHON(4) && IN(pb + 4)) { KA A_ = fresh_args(); C.ws = A_->ws; phase_attn_naive(C, A_, l); } SEAM(pb + 4);
        if (PHON(5) && IN(pb + 5)) { KA A_ = fresh_args(); C.ws = A_->ws; phase_rnn_naive<1>(C, A_, l); } SEAM(pb + 5);
        if (PHON(6) && IN(pb + 6)) { KA A_ = fresh_args(); C.ws = A_->ws; phase_mixnorm_naive(C, A_, l); } SEAM(pb + 6);
        if (PHON(7) && IN(pb + 7)) { KA A_ = fresh_args(); C.ws = A_->ws; phase_wo_naive(C, A_, l); } SEAM(pb + 7);
        if (PHON(8) && IN(pb + 8)) { KA A_ = fresh_args(); C.ws = A_->ws; phase_router(C, A_, l); } SEAM(pb + 8);
        if (PHON(9) && IN(pb + 9)) { KA A_ = fresh_args(); C.ws = A_->ws; phase_g1_naive(C, A_, l); } SEAM(pb + 9);
        if (PHON(10) && IN(pb + 10)) { KA A_ = fresh_args(); C.ws = A_->ws; phase_g2_naive(C, A_, l); } SEAM(pb + 10);
        if (PHON(11) && IN(pb + 11)) { KA A_ = fresh_args(); C.ws = A_->ws; phase_combine(C, A_, l); } SEAM(pb + 11);
        if (PHON(12) && IN(pb + 12)) { KA A_ = fresh_args(); C.ws = A_->ws; phase_proj_naive(C, A_, l); } SEAM(pb + 12);
        if (PHON(13) && IN(pb + 13)) { KA A_ = fresh_args(); C.ws = A_->ws; phase_ple_naive(C, A_, l); } SEAM(pb + 13);
    }
#undef IN
#undef SEAM
}

extern "C" void kernel_launch(void* const* d_in, const int* in_sizes, int n_in, void* d_out, int out_size, void* d_ws, size_t ws_size, hipStream_t stream) {
    static int grid = 0;
    if (grid == 0) {
        if (n_in != 29 || out_size != T * D || ws_size < WS_END) { fprintf(stderr, "kernel_launch: unexpected problem (n_in %d, out %d, ws %zu)\n", n_in, out_size, ws_size); grid = -1; return; }
        int dev = 0, cus = 0, per_cu = 0;
        if (hipGetDevice(&dev) != hipSuccess || hipDeviceGetAttribute(&cus, hipDeviceAttributeMultiprocessorCount, dev) != hipSuccess) { grid = -1; return; }
        if (hipFuncSetAttribute((const void*)fwd_kernel, hipFuncAttributeMaxDynamicSharedMemorySize, LDS_BYTES) != hipSuccess) { fprintf(stderr, "kernel_launch: hipFuncSetAttribute failed\n"); grid = -1; return; }
        if (hipOccupancyMaxActiveBlocksPerMultiprocessor(&per_cu, (const void*)fwd_kernel, 512, LDS_BYTES) != hipSuccess || per_cu < 1) { fprintf(stderr, "kernel_launch: occupancy query says %d\n", per_cu); grid = -1; return; }
        (void)hipGetLastError();
        grid = cus;
    }
    if (grid < 0) return;
    hipMemsetAsync((char*)d_ws + WS_CTL, 0, CTL_ZERO_BYTES, stream);
    Args a{};
    for (int i = 0; i < 29; ++i) a.in[i] = (const float*)d_in[i];
    a.out = (float*)d_out; a.ws = (unsigned char*)d_ws;
#if MK_MULTI
    for (int ph = 0; ph < NPHASES; ++ph) { a.ph_lo = ph; a.ph_hi = ph + 1; hipLaunchKernelGGL(fwd_kernel, dim3(grid), dim3(512), LDS_BYTES, stream, a); }
#else
    a.ph_lo = 0; a.ph_hi = NPHASES;
    hipLaunchKernelGGL(fwd_kernel, dim3(grid), dim3(512), LDS_BYTES, stream, a);
#endif
}
```

```cpp
#include <hip/hip_runtime.h>
#include <cstdio>
#include <cstdint>
#include <cmath>

#define FAST_GEMM1 1
#define FAST_DENSE 1
#define FAST_MOE 1
#ifndef MK_MULTI
#define MK_MULTI 0
#endif

#define GAS __attribute__((address_space(1)))
#define LAS __attribute__((address_space(3)))
typedef unsigned short bf16;
typedef unsigned v4u __attribute__((ext_vector_type(4)));
typedef unsigned v2u __attribute__((ext_vector_type(2)));
typedef float f32x4 __attribute__((ext_vector_type(4)));

constexpr int NB = 4, S = 4096, T = NB * S, D = 1024, DIN = 2568, DR = 512, DA = 512, NH = 8, HD = 64;
constexpr int NE = 32, DE = 512, PLE = 256, DEPTH = 2, NZ = 2560;
constexpr float EPS = 1e-6f, LOG2E = 1.4426950408889634f, C2 = 0.125f * 1.4426950408889634f;
constexpr int CAP = 16384;
constexpr int HROWS = 40960;

constexpr size_t MiB = 1u << 20;
constexpr size_t WS_CTL = 0, CTL_ZERO_BYTES = 1 * MiB;
constexpr size_t WS_LOGF = 1 * MiB;
constexpr size_t WS_C2K = WS_LOGF + MiB / 2;
constexpr size_t WS_SA = 2 * MiB, WS_SH = WS_SA + MiB / 2;
constexpr size_t WS_PAIRW = 3 * MiB;
constexpr size_t WS_ROWPAIR = 4 * MiB;
constexpr size_t WS_WIN = 8 * MiB;
constexpr size_t WS_WOUT = 18 * MiB;
constexpr size_t WS_WPG = 22 * MiB;
constexpr size_t WS_WPP = 26 * MiB;
constexpr size_t WS_WGU = 28 * MiB;
constexpr size_t WS_WDN = 156 * MiB;
constexpr size_t WS_PB = 220 * MiB;
constexpr size_t WS_XN = 236 * MiB;
constexpr size_t WS_X = 268 * MiB;
constexpr size_t WS_R1 = 332 * MiB;
constexpr size_t WS_R2 = 412 * MiB;
constexpr size_t WS_PROJ = 460 * MiB;
constexpr size_t WS_END = 492 * MiB;
constexpr int CW_BAR = 4096;
constexpr int CW_CNT = 8192;

constexpr int RING_BYTES = 131072;
constexpr int MISC_OFF = RING_BYTES + 320;
constexpr int LDS_BYTES = 147456;

__device__ __forceinline__ unsigned f2bf(float f) { unsigned u = __builtin_bit_cast(unsigned, f); return (u + 0x7fffu + ((u >> 16) & 1u)) >> 16; }
__device__ __forceinline__ unsigned pk2(float lo, float hi) { return f2bf(lo) | (f2bf(hi) << 16); }
__device__ __forceinline__ float bf2f(unsigned u) { return __builtin_bit_cast(float, u << 16); }
__device__ __forceinline__ float bflo(unsigned w) { return __builtin_bit_cast(float, w << 16); }
__device__ __forceinline__ float bfhi(unsigned w) { return __builtin_bit_cast(float, w & 0xffff0000u); }
__device__ __forceinline__ float wave_sum(float v) {
#pragma unroll
    for (int o = 1; o < 64; o <<= 1) v += __shfl_xor(v, o);
    return v;
}
__device__ __forceinline__ float wave_max(float v) {
#pragma unroll
    for (int o = 1; o < 64; o <<= 1) v = fmaxf(v, __shfl_xor(v, o));
    return v;
}
__device__ __forceinline__ float sigmoidf_(float v) { return 1.f / (1.f + __expf(-v)); }
__device__ __forceinline__ float gelu_tanh(float v) { return 0.5f * v * (1.f + tanhf(0.7978845608028654f * (v + 0.044715f * v * v * v))); }
__device__ __forceinline__ float log_sigmoid(float v) { return v >= 0.f ? -log1pf(__expf(-v)) : v - log1pf(__expf(v)); }

#define XB_TMO      128
#define XB_XCNT(j)  (256  + 64 * (j))
#define XB_XSUB(j)  (1280 + 64 * (j))
#define XB_XGEN(j)  (2304 + 64 * (j))
#define XB_TOP      3328
#define XB_TOPGEN   3392
#define XCD_BAR_WORDS 3456
#define XB_SPIN_CAP (1u << 26)
__device__ __forceinline__ unsigned xb_ld(unsigned* p)              { return __hip_atomic_load(p, __ATOMIC_RELAXED, __HIP_MEMORY_SCOPE_AGENT); }
__device__ __forceinline__ unsigned xb_add(unsigned* p, unsigned v) { return __hip_atomic_fetch_add(p, v, __ATOMIC_RELAXED, __HIP_MEMORY_SCOPE_AGENT); }
__device__ __forceinline__ unsigned xb_xcc_id() { return (unsigned)__builtin_amdgcn_s_getreg((3 << 11) | 20) & 0xFu; }
#define XB_SPIN(cond, bar) do { unsigned _sp = 0; while (cond) { __builtin_amdgcn_s_sleep(1); \
    if ((++_sp & 255u) == 0u) { if (xb_ld(&(bar)[XB_TMO])) break; if (_sp > XB_SPIN_CAP) { atomicAdd(&(bar)[XB_TMO], 1u); break; } } } } while (0)
struct XcdBarrier { unsigned* bar; unsigned x; volatile LAS unsigned* st; };
__device__ __forceinline__ XcdBarrier xcd_barrier_post(unsigned* bar, volatile LAS unsigned* st) {
    XcdBarrier b; b.bar = bar; b.x = xb_xcc_id(); b.st = st;
    if (threadIdx.x == 0) (void)xb_add(&bar[XB_XCNT(b.x)], 1u);
    return b;
}
__device__ __forceinline__ void xcd_barrier_complete(unsigned* bar, unsigned x, unsigned& nloc, unsigned& nx) {
    const unsigned G = gridDim.x * gridDim.y * gridDim.z;
    unsigned sum, cnt, mine, sp = 0u;
    for (;;) {
        sum = 0u; cnt = 0u; mine = 0u;
#pragma unroll
        for (unsigned j = 0; j < 16; ++j) { const unsigned c = xb_ld(&bar[XB_XCNT(j)]); sum += c; cnt += (c > 0u) ? 1u : 0u; mine = (j == x) ? c : mine; }
        if (sum == G) break;
        __builtin_amdgcn_s_sleep(1);
        if ((++sp & 255u) == 0u) { if (xb_ld(&bar[XB_TMO])) break; if (sp > XB_SPIN_CAP) { atomicAdd(&bar[XB_TMO], 1u); break; } }
    }
    nloc = mine > 0u ? mine : 1u; nx = cnt > 0u ? cnt : 1u;
}
__device__ __forceinline__ void xcd_barrier(const XcdBarrier& b) {
    asm volatile("s_waitcnt vmcnt(0)" ::: "memory");
    __syncthreads();
    if (threadIdx.x == 0) {
        unsigned* bar = b.bar;
        __builtin_amdgcn_s_waitcnt(0);
        unsigned nloc = b.st[0], nx = b.st[1];
        if (nloc == 0u) { xcd_barrier_complete(bar, b.x, nloc, nx); b.st[0] = nloc; b.st[1] = nx; }
        const unsigned old = xb_add(&bar[XB_XSUB(b.x)], 1u);
        const unsigned gen = old / nloc;
        if (old + 1u == (gen + 1u) * nloc) {
            __builtin_amdgcn_fence(__ATOMIC_RELEASE, "agent");
            asm volatile("s_waitcnt vmcnt(0)" ::: "memory");
            const unsigned og = xb_add(&bar[XB_TOP], 1u);
            const unsigned tg = og / nx;
            if (og + 1u == (tg + 1u) * nx) xb_add(&bar[XB_TOPGEN], 1u);
            else XB_SPIN(xb_ld(&bar[XB_TOPGEN]) == tg, bar);
            __builtin_amdgcn_fence(__ATOMIC_ACQUIRE, "agent");
            xb_add(&bar[XB_XGEN(b.x)], 1u);
            asm volatile("s_waitcnt vmcnt(0)" ::: "memory");
        } else {
            XB_SPIN(xb_ld(&bar[XB_XGEN(b.x)]) == gen, bar);
            __builtin_amdgcn_fence(__ATOMIC_ACQUIRE, "agent");
            asm volatile("s_waitcnt vmcnt(0)" ::: "memory");
        }
    }
    __syncthreads();
}

struct Args { const float* in[29]; float* out; unsigned char* ws; int ph_lo, ph_hi; };
typedef const __attribute__((address_space(4))) Args* KA;
__device__ __forceinline__ KA fresh_args() { KA p = (KA)__builtin_amdgcn_kernarg_segment_ptr(); asm volatile("" : "+s"(p)); return p; }
struct Ctx;
struct Ctx {
    LAS unsigned char* lds;
    int tid, lane, wave, gw, ngw;
    unsigned char* ws;
};
__device__ __forceinline__ void enter_phase(Ctx& C, KA A) { int t = threadIdx.x; asm volatile("" : "+v"(t)); C.tid = t; C.lane = t & 63; C.wave = __builtin_amdgcn_readfirstlane(t >> 6);
    C.gw = blockIdx.x * 8 + C.wave; C.ngw = gridDim.x * 8; C.ws = A->ws; }
enum { I_X = 0, I_P, I_MIXN, I_WIN, I_BF, I_CONVW, I_CONVB, I_WR, I_BR, I_WI, I_BI, I_LAM, I_QN, I_KN, I_LRUN, I_ATTN, I_WOUT, I_FFNN,
       I_WG, I_BG, I_WRT, I_BRT, I_WEG, I_WEU, I_WED, I_PLEN, I_WPG, I_BPG, I_WPP };

__device__ __forceinline__ void transpose_item(const float* W, int ldw, int K, bf16* WT, int k0, int n0, int c0, LAS float* scr, int lane) {
#pragma unroll 8
    for (int i = 0; i < 32; ++i) { const int kk = 2 * i + (lane >> 5); scr[kk * 33 + (lane & 31)] = W[(size_t)(k0 + kk) * ldw + c0 + (lane & 31)]; }
    asm volatile("s_waitcnt lgkmcnt(0)" ::: "memory");
    const int c = lane & 7;
#pragma unroll
    for (int j = 0; j < 4; ++j) { const int n = (lane >> 3) + 8 * j; const LAS float* s = scr + (8 * c) * 33 + n;
        v4u o; o.x = pk2(s[0 * 33], s[1 * 33]); o.y = pk2(s[2 * 33], s[3 * 33]); o.z = pk2(s[4 * 33], s[5 * 33]); o.w = pk2(s[6 * 33], s[7 * 33]);
        *(v4u*)(WT + (size_t)(n0 + n) * K + k0 + 8 * c) = o; }
    asm volatile("s_waitcnt lgkmcnt(0)" ::: "memory");
}
__device__ __forceinline__ void phase_prologue(Ctx& C, KA AR) {
    LAS float* scr = (LAS float*)(C.lds + C.wave * 16384);
    constexpr int I_IN = 16 * 80, I_OUT = 16 * 32, I_GU = 32 * 16 * 32, I_DN = 32 * 8 * 32, I_PG = 16 * 32, I_PP = 4 * 32;
    constexpr int PER_L = I_IN + I_OUT + I_GU + I_DN + I_PG + I_PP;
    for (int it = C.gw; it < DEPTH * PER_L; it += C.ngw) {
        const int l = it / PER_L; int r = it % PER_L;
        if (r < I_IN) {
            const int kb = r / 80, nb = r % 80, n0 = 32 * nb, pn = n0 >> 8, jl = n0 & 255, bj = jl >> 7, wc = (jl >> 5) & 3;
            transpose_item(AR->in[I_WIN] + (size_t)l * D * DIN, DIN, D, (bf16*)(C.ws + WS_WIN) + (size_t)l * NZ * D, 64 * kb, n0, 256 * pn + 64 * wc + 32 * bj, scr, C.lane); continue; }
        r -= I_IN;
        if (r < I_OUT) { const int kb = r / 32, nb = r % 32;
            transpose_item(AR->in[I_WOUT] + (size_t)l * D * D, D, D, (bf16*)(C.ws + WS_WOUT) + (size_t)l * D * D, 64 * kb, 32 * nb, 32 * nb, scr, C.lane); continue; }
        r -= I_OUT;
        if (r < I_GU) {
            const int e = r / 512, q = r % 512, kb = q / 32, nb = q % 32, n0 = 32 * nb, pn = n0 >> 8, jl = n0 & 255;
            const float* src = (jl < 128 ? AR->in[I_WEG] : AR->in[I_WEU]) + (size_t)(l * NE + e) * D * DE;
            transpose_item(src, DE, D, (bf16*)(C.ws + WS_WGU) + (size_t)(l * NE + e) * 1024 * D, 64 * kb, n0, 128 * pn + (jl & 127), scr, C.lane); continue; }
        r -= I_GU;
        if (r < I_DN) { const int e = r / 256, q = r % 256, kb = q / 32, nb = q % 32;
            transpose_item(AR->in[I_WED] + (size_t)(l * NE + e) * DE * D, D, DE, (bf16*)(C.ws + WS_WDN) + (size_t)(l * NE + e) * D * DE, 64 * kb, 32 * nb, 32 * nb, scr, C.lane); continue; }
        r -= I_DN;
        if (r < I_PG) { const int kb = r / 32, nb = r % 32;
            transpose_item(AR->in[I_WPG] + (size_t)l * D * D, D, D, (bf16*)(C.ws + WS_WPG) + (size_t)l * D * D, 64 * kb, 32 * nb, 32 * nb, scr, C.lane); continue; }
        r -= I_PG;
        { const int kb = r / 32, nb = r % 32;
            transpose_item(AR->in[I_WPP] + (size_t)l * PLE * D, D, PLE, (bf16*)(C.ws + WS_WPP) + (size_t)l * D * PLE, 64 * kb, 32 * nb, 32 * nb, scr, C.lane); }
    }
    const f32x4* ps = (const f32x4*)AR->in[I_P]; v2u* pd = (v2u*)(C.ws + WS_PB);
    const size_t n4 = (size_t)DEPTH * T * PLE / 4;
    for (size_t i = (size_t)blockIdx.x * 512 + C.tid; i < n4; i += (size_t)gridDim.x * 512) { const f32x4 v = ps[i]; v2u o; o.x = pk2(v.x, v.y); o.y = pk2(v.z, v.w); pd[i] = o; }
}

__device__ __forceinline__ void load_row(const float* row, int lane, f32x4 (&v)[4]) {
    const f32x4* xr = (const f32x4*)row + lane;
#pragma unroll
    for (int j = 0; j < 4; ++j) v[j] = xr[64 * j];
}
__device__ __forceinline__ float row_rs(const f32x4 (&v)[4]) {
    float s = 0.f;
#pragma unroll
    for (int j = 0; j < 4; ++j) s += (v[j].x * v[j].x + v[j].y * v[j].y) + (v[j].z * v[j].z + v[j].w * v[j].w);
    return rsqrtf(wave_sum(s) * (1.f / D) + EPS);
}
__device__ __forceinline__ void scale_row(f32x4 (&v)[4], float rs, const float* gain, int lane) {
    const f32x4* g = (const f32x4*)gain + lane;
#pragma unroll
    for (int j = 0; j < 4; ++j) v[j] = v[j] * rs * g[64 * j];
}
__device__ __forceinline__ void store_row_bf16(bf16* row, int lane, const f32x4 (&v)[4]) {
    v2u* o = (v2u*)row + lane;
#pragma unroll
    for (int j = 0; j < 4; ++j) { v2u w; w.x = pk2(v[j].x, v[j].y); w.y = pk2(v[j].z, v[j].w); o[64 * j] = w; }
}

__device__ __forceinline__ void phase_norm1(Ctx& C, KA AR, int l) {
    const float* xs = l == 0 ? AR->in[I_X] : (const float*)(C.ws + WS_X);
    const float* gain = AR->in[I_MIXN] + l * D;
    const float* wf = AR->in[I_WIN] + (size_t)l * D * DIN + NZ;
    const float* bfg = AR->in[I_BF] + l * NH;
    bf16* xn = (bf16*)(C.ws + WS_XN); float* logf = (float*)(C.ws + WS_LOGF);
    for (int t = C.gw; t < T; t += C.ngw) {
        f32x4 v[4]; load_row(xs + (size_t)t * D, C.lane, v);
        const float rs = row_rs(v); scale_row(v, rs, gain, C.lane);
        store_row_bf16(xn + (size_t)t * D, C.lane, v);
        float z[8] = {0.f, 0.f, 0.f, 0.f, 0.f, 0.f, 0.f, 0.f};
#pragma unroll
        for (int j = 0; j < 4; ++j)
#pragma unroll
            for (int e = 0; e < 4; ++e) { const int k = 256 * j + 4 * C.lane + e; const f32x4 w0 = *(const f32x4*)(wf + (size_t)k * DIN), w1 = *(const f32x4*)(wf + (size_t)k * DIN + 4);
                const float a = v[j][e]; z[0] += a * w0.x; z[1] += a * w0.y; z[2] += a * w0.z; z[3] += a * w0.w; z[4] += a * w1.x; z[5] += a * w1.y; z[6] += a * w1.z; z[7] += a * w1.w; }
#pragma unroll
        for (int h = 0; h < 8; ++h) z[h] = wave_sum(z[h]);
        float mine = 0.f;
#pragma unroll
        for (int h = 0; h < 8; ++h) mine = (C.lane == h) ? z[h] : mine;
        if (C.lane < 8) logf[(size_t)t * 8 + C.lane] = log_sigmoid(mine + bfg[C.lane]);
    }
}

template <int NACC, class AR, class BR, class EP>
__device__ __forceinline__ void ngemm_tile(LAS float* sm, int K, AR arow, BR brow, EP epi, const int tid) {
    LAS float* As = sm; LAS float* Bs = sm + 32 * 68;
    const int ty = tid >> 4, tx = tid & 15, lr = tid >> 3, lk = (tid & 7) * 4;
    float acc[NACC][2][4];
#pragma unroll
    for (int a = 0; a < NACC; ++a)
#pragma unroll
        for (int i = 0; i < 2; ++i)
#pragma unroll
            for (int j = 0; j < 4; ++j) acc[a][i][j] = 0.f;
    const bf16* ap = arow(lr); const bf16* bp0 = brow(lr, 0); const bf16* bp1 = NACC > 1 ? brow(lr, 1) : bp0;
    for (int k0 = 0; k0 < K; k0 += 32) {
        __syncthreads();
        { v2u av; av.x = 0u; av.y = 0u; if (ap) av = *(const v2u*)(ap + k0 + lk);
          As[(lk + 0) * 68 + lr] = bflo(av.x); As[(lk + 1) * 68 + lr] = bfhi(av.x); As[(lk + 2) * 68 + lr] = bflo(av.y); As[(lk + 3) * 68 + lr] = bfhi(av.y); }
        { const v2u bv = *(const v2u*)(bp0 + k0 + lk);
          Bs[(lk + 0) * 68 + lr] = bflo(bv.x); Bs[(lk + 1) * 68 + lr] = bfhi(bv.x); Bs[(lk + 2) * 68 + lr] = bflo(bv.y); Bs[(lk + 3) * 68 + lr] = bfhi(bv.y); }
        if (NACC > 1) { const v2u bv = *(const v2u*)(bp1 + k0 + lk); LAS float* B1 = Bs + 32 * 68;
          B1[(lk + 0) * 68 + lr] = bflo(bv.x); B1[(lk + 1) * 68 + lr] = bfhi(bv.x); B1[(lk + 2) * 68 + lr] = bflo(bv.y); B1[(lk + 3) * 68 + lr] = bfhi(bv.y); }
        __syncthreads();
#pragma unroll 8
        for (int kk = 0; kk < 32; ++kk) {
            const float a0 = As[kk * 68 + ty * 2], a1 = As[kk * 68 + ty * 2 + 1];
#pragma unroll
            for (int a = 0; a < NACC; ++a) { const f32x4 b = *(const LAS f32x4*)(Bs + a * 32 * 68 + kk * 68 + tx * 4);
#pragma unroll
                for (int j = 0; j < 4; ++j) { acc[a][0][j] += a0 * b[j]; acc[a][1][j] += a1 * b[j]; } }
        }
    }
#pragma unroll
    for (int i = 0; i < 2; ++i)
#pragma unroll
        for (int j = 0; j < 4; ++j) epi(ty * 2 + i, tx * 4 + j, acc[0][i][j], NACC > 1 ? acc[1][i][j] : 0.f);
}

__device__ __forceinline__ void phase_cumsum(Ctx& C, KA AR) {
    if (C.gw < NB * NH) {
        const int b = C.gw / NH, h = C.gw % NH;
        const float* logf = (const float*)(C.ws + WS_LOGF) + (size_t)b * S * 8 + h; float* c2k = (float*)(C.ws + WS_C2K) + (size_t)C.gw * S;
        float s = 0.f;
        for (int i = 0; i < 64; ++i) s += logf[(size_t)(64 * C.lane + i) * 8];
        float inc = s;
#pragma unroll
        for (int o = 1; o < 64; o <<= 1) { const float v = __shfl_up(inc, o); if (C.lane >= o) inc += v; }
        float run = inc - s;
        for (int i = 0; i < 64; ++i) { run += logf[(size_t)(64 * C.lane + i) * 8]; c2k[64 * C.lane + i] = run * LOG2E; }
    }
}
__device__ __forceinline__ void phase_gemm1_naive(Ctx& C, KA AR, int l) {
    phase_cumsum(C, AR);
    const bf16* A = (const bf16*)(C.ws + WS_XN); const bf16* Bt = (const bf16*)(C.ws + WS_WIN) + (size_t)l * NZ * D;
    bf16* R1 = (bf16*)(C.ws + WS_R1);
    for (int u = blockIdx.x; u < (T / 64) * (NZ / 64); u += gridDim.x) {
        const int mt = u / (NZ / 64), nt = u % (NZ / 64), m0 = 64 * mt, n0 = 64 * nt;
        ngemm_tile<1>((LAS float*)C.lds, D, [=](int r) { return A + (size_t)(m0 + r) * D; }, [=](int c, int) { return Bt + (size_t)(n0 + c) * D; },
            [=](int r, int c, float v, float) {
                const int j = n0 + c, pn = j >> 8, jl = j & 255, bj = jl >> 7, wc = (jl >> 5) & 3, col = 256 * pn + 64 * wc + 32 * bj + (jl & 31);
                const int seg = col >> 9, cc = col & 511;
                const float o = seg == 1 ? gelu_tanh(v) : v;
                R1[(size_t)seg * T * 512 + (size_t)(m0 + r) * 512 + cc] = (bf16)f2bf(o);
            }, C.tid);
    }
}
__device__ __forceinline__ void phase_qknorm_naive(Ctx& C, KA AR, int l) {
    bf16* Q = (bf16*)(C.ws + WS_R1) + (size_t)2 * T * 512; bf16* Kb = Q + (size_t)T * 512;
    const float* gq = AR->in[I_QN] + l * HD; const float* gk = AR->in[I_KN] + l * HD;
    for (int i = C.gw; i < 2 * T; i += C.ngw) {
        const int t = i >> 1, isk = i & 1; bf16* row = (isk ? Kb : Q) + (size_t)t * 512; const float* g = isk ? gk : gq;
        const v4u w = *(const v4u*)(row + 8 * C.lane);
        float x[8] = {bflo(w.x), bfhi(w.x), bflo(w.y), bfhi(w.y), bflo(w.z), bfhi(w.z), bflo(w.w), bfhi(w.w)};
        float s = 0.f;
#pragma unroll
        for (int e = 0; e < 8; ++e) s += x[e] * x[e];
        s += __shfl_xor(s, 1); s += __shfl_xor(s, 2); s += __shfl_xor(s, 4);
        const float rs = rsqrtf(s * (1.f / 64.f) + EPS) * (isk ? 1.f : C2);
        const int d0 = 8 * (C.lane & 7);
#pragma unroll
        for (int e = 0; e < 8; ++e) x[e] = x[e] * rs * g[d0 + e];
        v4u o; o.x = pk2(x[0], x[1]); o.y = pk2(x[2], x[3]); o.z = pk2(x[4], x[5]); o.w = pk2(x[6], x[7]);
        *(v4u*)(row + 8 * C.lane) = o;
    }
}

template <int MODE>
__device__ __forceinline__ void phase_rnn_naive(Ctx& C, KA AR, int l) {
    LAS float* xcs = (LAS float*)C.lds; LAS float* as = xcs + 64 * 65; LAS float* us = as + 64 * 64;
    const bf16* ZX = (const bf16*)(C.ws + WS_R1); const bf16* ZG = ZX + (size_t)T * 512;
    float* SA = (float*)(C.ws + WS_SA); float* SH = (float*)(C.ws + WS_SH); float* YR = (float*)(C.ws + WS_PROJ);
    const float* cw = AR->in[I_CONVW] + l * 4 * DR; const float* cb = AR->in[I_CONVB] + l * DR;
    const float* wr = AR->in[I_WR] + (size_t)l * 8 * 64 * 64; const float* wi = AR->in[I_WI] + (size_t)l * 8 * 64 * 64;
    const float* br = AR->in[I_BR] + l * DR; const float* bi = AR->in[I_BI] + l * DR; const float* lam = AR->in[I_LAM] + l * DR;
    for (int u = blockIdx.x; u < NB * 64 * 8; u += gridDim.x) {
        const int b = u >> 9, cidx = (u >> 3) & 63, blk = u & 7;
        __syncthreads();
#pragma unroll
        for (int i = 0; i < 8; ++i) { const int e = C.tid + 512 * i, t = e >> 6, c = e & 63, ch = blk * 64 + c, tg = cidx * 64 + t;
            float xc = cb[ch];
#pragma unroll
            for (int j = 0; j < 4; ++j) { const int tt = tg - 3 + j; if (tt >= 0) xc += cw[j * DR + ch] * bf2f(ZX[(size_t)(b * S + tt) * 512 + ch]); }
            xcs[t * 65 + c] = xc; }
        __syncthreads();
#pragma unroll
        for (int i = 0; i < 8; ++i) { const int e = C.tid + 512 * i, t = e >> 6, j = e & 63, ch = blk * 64 + j;
            float ar = br[ch], ai = bi[ch];
            for (int k = 0; k < 64; ++k) { const float x = xcs[t * 65 + k]; ar += x * wr[(size_t)(blk * 64 + k) * 64 + j]; ai += x * wi[(size_t)(blk * 64 + k) * 64 + j]; }
            const float r = sigmoidf_(ar), ig = sigmoidf_(ai);
            const float la = -8.f * r * log1pf(__expf(-lam[ch]));
            as[t * 64 + j] = __expf(la); us[t * 64 + j] = sqrtf(-expm1f(2.f * la)) * (ig * xcs[t * 65 + j]); }
        __syncthreads();
        if (C.tid < 64) { const int j = C.tid, ch = blk * 64 + j;
            if (MODE == 0) { float A = 1.f, H = 0.f;
                for (int t = 0; t < 64; ++t) { const float a = as[t * 64 + j]; H = a * H + us[t * 64 + j]; A *= a; }
                SA[(size_t)(b * 64 + cidx) * 512 + ch] = A; SH[(size_t)(b * 64 + cidx) * 512 + ch] = H;
            } else { float h = 0.f;
                for (int c2 = 0; c2 < cidx; ++c2) h = SA[(size_t)(b * 64 + c2) * 512 + ch] * h + SH[(size_t)(b * 64 + c2) * 512 + ch];
                for (int t = 0; t < 64; ++t) { h = as[t * 64 + j] * h + us[t * 64 + j]; as[t * 64 + j] = h; } } }
        if (MODE == 1) { __syncthreads();
#pragma unroll
            for (int i = 0; i < 8; ++i) { const int e = C.tid + 512 * i, t = e >> 6, c = e & 63, ch = blk * 64 + c; const size_t row = (size_t)(b * S + cidx * 64 + t);
                YR[row * 512 + ch] = as[t * 64 + c] * bf2f(ZG[row * 512 + ch]); } }
    }
}

__device__ __forceinline__ void phase_attn_naive(Ctx& C, KA AR, int l) {
    LAS float* Ks = (LAS float*)C.lds; LAS float* Vs = Ks + 64 * 65; LAS float* Qs = Vs + 64 * 65; LAS float* Ps = Qs + 64 * 64; LAS float* cks = Ps + 8 * 64;
    const bf16* Q = (const bf16*)(C.ws + WS_R1) + (size_t)2 * T * 512; const bf16* Kb = Q + (size_t)T * 512; const bf16* Vb = Kb + (size_t)T * 512;
    bf16* O = (bf16*)(C.ws + WS_R2); const float* c2k = (const float*)(C.ws + WS_C2K);
    for (int u = blockIdx.x; u < NB * NH * 64; u += gridDim.x) {
        const int qt = 63 - (u >> 5), bh = u & 31, b = bh >> 3, h = bh & 7, q0 = 64 * qt;
        const float* ck = c2k + (size_t)bh * S;
        __syncthreads();
        for (int e = C.tid; e < 64 * 64; e += 512) { const int r = e >> 6, d = e & 63; Qs[r * 64 + d] = bf2f(Q[(size_t)(b * S + q0 + r) * 512 + h * 64 + d]); }
        float m[8], lsum[8], o[8], cq[8];
#pragma unroll
        for (int i = 0; i < 8; ++i) { m[i] = -INFINITY; lsum[i] = 0.f; o[i] = 0.f; cq[i] = ck[q0 + C.wave * 8 + i]; }
        for (int kt = 0; kt <= qt; ++kt) {
            const int k0 = 64 * kt;
            __syncthreads();
            for (int e = C.tid; e < 64 * 64; e += 512) { const int r = e >> 6, d = e & 63; const size_t g = (size_t)(b * S + k0 + r) * 512 + h * 64 + d; Ks[r * 65 + d] = bf2f(Kb[g]); Vs[r * 65 + d] = bf2f(Vb[g]); }
            if (C.tid < 64) cks[C.tid] = ck[k0 + C.tid];
            __syncthreads();
#pragma unroll
            for (int i = 0; i < 8; ++i) {
                const int q = C.wave * 8 + i, qg = q0 + q;
                float dot = 0.f;
#pragma unroll 16
                for (int d = 0; d < 64; ++d) dot += Qs[q * 64 + d] * Ks[C.lane * 65 + d];
                float s = dot + cq[i] - cks[C.lane];
                if (k0 + C.lane > qg) s = -INFINITY;
                const float mn = fmaxf(m[i], wave_max(s));
                const float alpha = exp2f(m[i] - mn), p = exp2f(s - mn);
                lsum[i] = lsum[i] * alpha + wave_sum(p); m[i] = mn;
                Ps[C.wave * 64 + C.lane] = p;
                asm volatile("s_waitcnt lgkmcnt(0)" ::: "memory");
                float acc = 0.f;
#pragma unroll 16
                for (int k = 0; k < 64; ++k) acc += Ps[C.wave * 64 + k] * Vs[k * 65 + C.lane];
                o[i] = o[i] * alpha + acc;
                asm volatile("s_waitcnt lgkmcnt(0)" ::: "memory");
            }
        }
#pragma unroll
        for (int i = 0; i < 8; ++i) O[(size_t)(b * S + q0 + C.wave * 8 + i) * 512 + h * 64 + C.lane] = (bf16)f2bf(o[i] / lsum[i]);
    }
}

__device__ __forceinline__ void phase_mixnorm_naive(Ctx& C, KA AR, int l) {
    const float* YR = (const float*)(C.ws + WS_PROJ); const bf16* O = (const bf16*)(C.ws + WS_R2); bf16* YM = (bf16*)(C.ws + WS_R2 + 16 * MiB);
    const float* g1 = AR->in[I_LRUN] + l * DR; const float* g2 = AR->in[I_ATTN] + l * DA;
    for (int t = C.gw; t < T; t += C.ngw) {
        f32x4 a[2]; float s = 0.f;
#pragma unroll
        for (int j = 0; j < 2; ++j) { a[j] = *((const f32x4*)(YR + (size_t)t * 512) + C.lane + 64 * j); s += (a[j].x * a[j].x + a[j].y * a[j].y) + (a[j].z * a[j].z + a[j].w * a[j].w); }
        float rs = rsqrtf(wave_sum(s) * (1.f / 512.f) + EPS);
#pragma unroll
        for (int j = 0; j < 2; ++j) { const f32x4 g = *((const f32x4*)g1 + C.lane + 64 * j); const f32x4 v = a[j] * rs * g; v2u w; w.x = pk2(v.x, v.y); w.y = pk2(v.z, v.w);
            *((v2u*)(YM + (size_t)t * D) + C.lane + 64 * j) = w; }
        const v4u w = *(const v4u*)(O + (size_t)t * 512 + 8 * C.lane);
        float x[8] = {bflo(w.x), bfhi(w.x), bflo(w.y), bfhi(w.y), bflo(w.z), bfhi(w.z), bflo(w.w), bfhi(w.w)};
        s = 0.f;
#pragma unroll
        for (int e = 0; e < 8; ++e) s += x[e] * x[e];
        rs = rsqrtf(wave_sum(s) * (1.f / 512.f) + EPS);
#pragma unroll
        for (int e = 0; e < 8; ++e) x[e] = x[e] * rs * g2[8 * C.lane + e];
        v4u o; o.x = pk2(x[0], x[1]); o.y = pk2(x[2], x[3]); o.z = pk2(x[4], x[5]); o.w = pk2(x[6], x[7]);
        *(v4u*)(YM + (size_t)t * D + 512 + 8 * C.lane) = o;
    }
}

__device__ __forceinline__ void phase_wo_naive(Ctx& C, KA AR, int l) {
    const bf16* A = (const bf16*)(C.ws + WS_R2 + 16 * MiB); const bf16* Bt = (const bf16*)(C.ws + WS_WOUT) + (size_t)l * D * D;
    const float* xs = l == 0 ? AR->in[I_X] : (const float*)(C.ws + WS_X); float* X = (float*)(C.ws + WS_X);
    for (int u = blockIdx.x; u < (T / 64) * (D / 64); u += gridDim.x) {
        const int m0 = 64 * (u / (D / 64)), n0 = 64 * (u % (D / 64));
        ngemm_tile<1>((LAS float*)C.lds, D, [=](int r) { return A + (size_t)(m0 + r) * D; }, [=](int c, int) { return Bt + (size_t)(n0 + c) * D; },
            [=](int r, int c, float v, float) { const size_t i = (size_t)(m0 + r) * D + n0 + c; X[i] = xs[i] + v; }, C.tid);
    }
}

__device__ __forceinline__ void phase_router(Ctx& C, KA AR, int l) {
    const float* X = (const float*)(C.ws + WS_X); bf16* xn = (bf16*)(C.ws + WS_XN);
    const float* gain = AR->in[I_FFNN] + l * D; const float* wg = AR->in[I_WG] + (size_t)l * D * 4; const float* bg = AR->in[I_BG] + l * 4;
    const float* wr = AR->in[I_WRT] + (size_t)l * D * NE; const float* brt = AR->in[I_BRT] + l * NE;
    unsigned* cnt = (unsigned*)(C.ws + WS_CTL) + CW_CNT + 64 * l; int* rowpair = (int*)(C.ws + WS_ROWPAIR); float* pairw = (float*)(C.ws + WS_PAIRW);
    for (int t = C.gw; t < T; t += C.ngw) {
        f32x4 v[4]; load_row(X + (size_t)t * D, C.lane, v);
        const float rs = row_rs(v); scale_row(v, rs, gain, C.lane);
        store_row_bf16(xn + (size_t)t * D, C.lane, v);
        LAS float* rowl = (LAS float*)C.lds + C.wave * 1024;
#pragma unroll
        for (int j = 0; j < 4; ++j) *((LAS f32x4*)rowl + C.lane + 64 * j) = v[j];
        asm volatile("s_waitcnt lgkmcnt(0)" ::: "memory");
        float acc = 0.f;
        if (C.lane < 36) {
            const float* wp = C.lane < 32 ? wr + C.lane : wg + (C.lane - 32); const int st = C.lane < 32 ? NE : 4;
#pragma unroll 8
            for (int k = 0; k < D; ++k) acc += rowl[k] * wp[(size_t)k * st];
            acc += C.lane < 32 ? brt[C.lane] : bg[C.lane - 32];
        }
        asm volatile("s_waitcnt lgkmcnt(0)" ::: "memory");
        float gl[4];
#pragma unroll
        for (int i = 0; i < 4; ++i) gl[i] = __shfl(acc, 32 + i);
        int gi = 0; float gm = gl[0];
#pragma unroll
        for (int i = 1; i < 4; ++i) if (gl[i] > gm) { gm = gl[i]; gi = i; }
        float gs = 0.f;
#pragma unroll
        for (int i = 0; i < 4; ++i) gs += __expf(gl[i] - gm);
        const float gp = 1.f / gs;
        float ev[8];
#pragma unroll
        for (int i = 0; i < 8; ++i) ev[i] = __shfl(acc, gi * 8 + i);
        int i0 = 0; float t0 = ev[0];
#pragma unroll
        for (int i = 1; i < 8; ++i) if (ev[i] > t0) { t0 = ev[i]; i0 = i; }
        int i1 = -1; float t1 = -INFINITY;
#pragma unroll
        for (int i = 0; i < 8; ++i) if (i != i0 && ev[i] > t1) { t1 = ev[i]; i1 = i; }
        const float ex = __expf(t1 - t0), w0 = gp / (1.f + ex), w1 = gp * ex / (1.f + ex);
        if (C.lane < 2) { const int e = gi * 8 + (C.lane == 0 ? i0 : i1); const unsigned pos = atomicAdd(cnt + e, 1u);
            rowpair[(size_t)e * CAP + pos] = 2 * t + C.lane; pairw[2 * t + C.lane] = C.lane == 0 ? w0 : w1; }
    }
}

struct ExpTab { int n[NE], hoff[NE], t0[NE + 1]; };
__device__ __forceinline__ void build_exptab(Ctx& C, int l, LAS int* tab) {
    __syncthreads();
    if (C.tid == 0) { const unsigned* cnt = (const unsigned*)(C.ws + WS_CTL) + CW_CNT + 64 * l; int ho = 0, tt = 0;
        for (int e = 0; e < NE; ++e) { const int n = (int)__hip_atomic_load(cnt + e, __ATOMIC_RELAXED, __HIP_MEMORY_SCOPE_AGENT); tab[e] = n; tab[32 + e] = ho; tab[64 + e] = tt; ho += (n + 255) & ~255; tt += (n + 63) >> 6; }
        tab[64 + NE] = tt; }
    __syncthreads();
}
__device__ __forceinline__ void phase_g1_naive(Ctx& C, KA AR, int l) {
    LAS int* tab = (LAS int*)(C.lds + 65536); build_exptab(C, l, tab);
    const bf16* xn = (const bf16*)(C.ws + WS_XN); const int* rowpair = (const int*)(C.ws + WS_ROWPAIR); bf16* Hb = (bf16*)(C.ws + WS_R2);
    const int nmt = tab[64 + NE];
    for (int u = blockIdx.x; u < nmt * 8; u += gridDim.x) {
        const int mtg = u >> 3, nt = u & 7; int e = 0;
        for (int i = 1; i < NE; ++i) if (tab[64 + i] <= mtg) e = i;
        const int mt = mtg - tab[64 + e], ne = tab[e], ho = tab[32 + e], p0 = 64 * mt, c0 = 64 * nt;
        const bf16* Bt = (const bf16*)(C.ws + WS_WGU) + (size_t)(l * NE + e) * 1024 * D; const int* rp = rowpair + (size_t)e * CAP;
        ngemm_tile<2>((LAS float*)C.lds, D,
            [=](int r) { return (p0 + r < ne) ? xn + (size_t)(rp[p0 + r] >> 1) * D : (const bf16*)nullptr; },
            [=](int c, int a) { const int cc = c0 + c; return Bt + (size_t)((cc >> 7) * 256 + (cc & 127) + a * 128) * D; },
            [=](int r, int c, float g, float uu) { if (p0 + r < ne) Hb[(size_t)(ho + p0 + r) * DE + c0 + c] = (bf16)f2bf(g / (1.f + __expf(-g)) * uu); }, C.tid);
    }
}
__device__ __forceinline__ void phase_g2_naive(Ctx& C, KA AR, int l) {
    LAS int* tab = (LAS int*)(C.lds + 65536); build_exptab(C, l, tab);
    const int* rowpair = (const int*)(C.ws + WS_ROWPAIR); const float* pairw = (const float*)(C.ws + WS_PAIRW); const bf16* Hb = (const bf16*)(C.ws + WS_R2); bf16* Y2 = (bf16*)(C.ws + WS_R1);
    const int nmt = tab[64 + NE];
    for (int u = blockIdx.x; u < nmt * 16; u += gridDim.x) {
        const int mtg = u >> 4, nt = u & 15; int e = 0;
        for (int i = 1; i < NE; ++i) if (tab[64 + i] <= mtg) e = i;
        const int mt = mtg - tab[64 + e], ne = tab[e], ho = tab[32 + e], p0 = 64 * mt, c0 = 64 * nt;
        const bf16* Bt = (const bf16*)(C.ws + WS_WDN) + (size_t)(l * NE + e) * D * DE; const int* rp = rowpair + (size_t)e * CAP;
        ngemm_tile<1>((LAS float*)C.lds, DE,
            [=](int r) { return (p0 + r < ne) ? Hb + (size_t)(ho + p0 + r) * DE : (const bf16*)nullptr; },
            [=](int c, int) { return Bt + (size_t)(c0 + c) * DE; },
            [=](int r, int c, float v, float) { if (p0 + r < ne) { const int p = rp[p0 + r]; Y2[(size_t)p * D + c0 + c] = (bf16)f2bf(v * pairw[p]); } }, C.tid);
    }
}

__device__ __forceinline__ void phase_combine(Ctx& C, KA AR, int l) {
    float* X = (float*)(C.ws + WS_X); const bf16* Y2 = (const bf16*)(C.ws + WS_R1); bf16* xn = (bf16*)(C.ws + WS_XN); const float* gain = AR->in[I_PLEN] + l * D;
    for (int t = C.gw; t < T; t += C.ngw) {
        f32x4 v[4]; load_row(X + (size_t)t * D, C.lane, v);
#pragma unroll
        for (int j = 0; j < 4; ++j) { const v2u a = *((const v2u*)(Y2 + (size_t)(2 * t) * D) + C.lane + 64 * j), b = *((const v2u*)(Y2 + (size_t)(2 * t + 1) * D) + C.lane + 64 * j);
            v[j].x += bflo(a.x) + bflo(b.x); v[j].y += bfhi(a.x) + bfhi(b.x); v[j].z += bflo(a.y) + bflo(b.y); v[j].w += bfhi(a.y) + bfhi(b.y);
            *((f32x4*)(X + (size_t)t * D) + C.lane + 64 * j) = v[j]; }
        const float rs = row_rs(v); scale_row(v, rs, gain, C.lane);
        store_row_bf16(xn + (size_t)t * D, C.lane, v);
    }
}

__device__ __forceinline__ void phase_proj_naive(Ctx& C, KA AR, int l) {
    const bf16* A = (const bf16*)(C.ws + WS_PB) + (size_t)l * T * PLE; const bf16* Bt = (const bf16*)(C.ws + WS_WPP) + (size_t)l * D * PLE; bf16* PR = (bf16*)(C.ws + WS_PROJ);
    for (int u = blockIdx.x; u < (T / 64) * (D / 64); u += gridDim.x) {
        const int m0 = 64 * (u / (D / 64)), n0 = 64 * (u % (D / 64));
        ngemm_tile<1>((LAS float*)C.lds, PLE, [=](int r) { return A + (size_t)(m0 + r) * PLE; }, [=](int c, int) { return Bt + (size_t)(n0 + c) * PLE; },
            [=](int r, int c, float v, float) { PR[(size_t)(m0 + r) * D + n0 + c] = (bf16)f2bf(v); }, C.tid);
    }
}
__device__ __forceinline__ void phase_ple_naive(Ctx& C, KA AR, int l) {
    const bf16* A = (const bf16*)(C.ws + WS_XN); const bf16* Bt = (const bf16*)(C.ws + WS_WPG) + (size_t)l * D * D; const bf16* PR = (const bf16*)(C.ws + WS_PROJ);
    const float* X = (const float*)(C.ws + WS_X); float* dst = l == DEPTH - 1 ? AR->out : (float*)(C.ws + WS_X); const float* bias = AR->in[I_BPG] + l * D;
    for (int u = blockIdx.x; u < (T / 64) * (D / 64); u += gridDim.x) {
        const int m0 = 64 * (u / (D / 64)), n0 = 64 * (u % (D / 64));
        ngemm_tile<1>((LAS float*)C.lds, D, [=](int r) { return A + (size_t)(m0 + r) * D; }, [=](int c, int) { return Bt + (size_t)(n0 + c) * D; },
            [=](int r, int c, float v, float) { const size_t i = (size_t)(m0 + r) * D + n0 + c; dst[i] = X[i] + bf2f(PR[i]) * sigmoidf_(v + bias[n0 + c]); }, C.tid);
    }
}

namespace pg8 {
typedef unsigned short bf16_t;
typedef short bf16x8 __attribute__((ext_vector_type(8)));
typedef unsigned u32x4 __attribute__((ext_vector_type(4)));
constexpr int BM = 256, BK = 64, HALF = 128, HTB = HALF * BK * 2, STAGE_BYTES = 8 * HTB, NXCD = 8, WGM = 8;
__device__ __forceinline__ int lds_byte(int r, int c) { const int st = (r >> 4) * 2 + (c >> 5), rr = r & 15, cc = c & 31, ob = rr * 64 + cc * 2; return st * 1024 + (ob ^ (((ob >> 9) & 1) << 5)); }
__device__ __forceinline__ void stage_rc(int b, int& R, int& C) { const int st = b / 1024, sb = b % 1024, swz = sb ^ (((sb >> 9) & 1) << 5); R = (st >> 1) * 16 + swz / 64; C = (st & 1) * 32 + (swz % 64) / 2; }
__device__ __forceinline__ int perm32(int rho) { const int n = rho >> 4, i = rho & 15; return 8 * (i >> 2) + 4 * n + (i & 3); }
struct Unit { int pm, pn, e, aux, mt; };
struct Gemm { const bf16_t* A; const bf16_t* Bt; int K; };
struct StaticOrder {
    int nM, nN, nwg, G, c;
    __device__ void init(int M, int N, int G_, int c_) { nM = M / BM; nN = N / BM; nwg = nM * nN; G = G_; c = c_; }
    __device__ bool next(int i, Unit& u) const {
        const long L = (long)i * G + c; if (L >= nwg) return false;
        int wgid = (int)L; { const int q = nwg / NXCD, r = nwg % NXCD, xcd = wgid % NXCD, off = wgid / NXCD; wgid = (xcd < r ? xcd * (q + 1) : r * (q + 1) + (xcd - r) * q) + off; }
        const int nig = WGM * nN, gid = wgid / nig, fm = gid * WGM, gsz = (nM - fm) < WGM ? (nM - fm) : WGM;
        u.pm = fm + ((wgid % nig) % gsz); u.pn = (wgid % nig) / gsz; u.e = 0; u.aux = 256; u.mt = 0; return true;
    }
    __device__ __forceinline__ const char* a_base(const Gemm& g, const Unit& u) const { return (const char*)g.A + (size_t)u.pm * 512 * g.K; }
    __device__ __forceinline__ const char* b_base(const Gemm& g, const Unit& u) const { return (const char*)g.Bt + (size_t)u.pn * 512 * g.K; }
    __device__ __forceinline__ int a_row(const Unit&, int) const { return 0; }
};
__device__ __forceinline__ unsigned cvt_pk_bf16(float lo, float hi) { unsigned r; asm volatile("v_cvt_pk_bf16_f32 %0, %1, %2" : "=v"(r) : "v"(lo), "v"(hi)); return r; }

template <class Epi, class Sched, bool ALIGN_EPI, bool GATHER>
__device__ __forceinline__ void gemm_phase(LAS unsigned char* lds, const Gemm g, const Sched& S, const Epi& E, const int tid) {
    const int wid = __builtin_amdgcn_readfirstlane(tid >> 6), lane = tid & 63, wr = wid >> 2, wc = wid & 3, fr = lane & 15, fq = lane >> 4;
    const int K = g.K, nt = K / BK;
    unsigned voffB[2];
#pragma unroll
    for (int i = 0; i < 2; ++i) { int R, C; stage_rc(tid * 16 + i * 8192, R, C); const int Rb = Epi::PERM ? ((R & ~31) + perm32(R & 31)) : R; voffB[i] = (unsigned)(Rb * K + C) * 2u; }
    const size_t kstep = (size_t)(BK * 2);
    const size_t hstep = (size_t)HALF * K * 2;
    const size_t hsA = GATHER ? 0 : hstep;
    const unsigned ldsw = (unsigned)wid * 1024u;
    const int aoff = lds_byte(wr * 64 + fr, fq * 8), boff = lds_byte(wc * 32 + fr, fq * 8);
#define PG8_SA(b, h) (((b) * 2 + (h)) * HTB)
#define PG8_SB(b, h) ((4 + (b) * 2 + (h)) * HTB)
#define PG8_STAGE(bufoff, gbase, voff) do { _Pragma("unroll") for (int _i = 0; _i < 2; ++_i) \
        __builtin_amdgcn_global_load_lds((const unsigned*)((const char*)(gbase) + (voff)[_i]), (LAS unsigned*)(lds + (bufoff) + ldsw + _i * 8192), 16, 0, 0); } while (0)
#define PG8_LDA(dst, b, h) do { _Pragma("unroll") for (int m = 0; m < 4; ++m) _Pragma("unroll") for (int k = 0; k < 2; ++k) dst[m][k] = *(const LAS bf16x8*)(lds + PG8_SA(b, h) + aoff + m * 2048 + k * 1024); } while (0)
#define PG8_LDB(dst, b, h) do { _Pragma("unroll") for (int n = 0; n < 2; ++n) _Pragma("unroll") for (int k = 0; k < 2; ++k) dst[n][k] = *(const LAS bf16x8*)(lds + PG8_SB(b, h) + boff + n * 2048 + k * 1024); } while (0)
#define PG8_MMA(ai, bj, At, Bt) do { __builtin_amdgcn_s_setprio(1); _Pragma("unroll") for (int m = 0; m < 4; ++m) _Pragma("unroll") for (int n = 0; n < 2; ++n) _Pragma("unroll") for (int k = 0; k < 2; ++k) \
        acc[ai][bj][m][n] = __builtin_amdgcn_mfma_f32_16x16x32_bf16(Bt[n][k], At[m][k], acc[ai][bj][m][n], 0, 0, 0); __builtin_amdgcn_s_setprio(0); } while (0)
#define PG8_WAIT_V(n) asm volatile("s_waitcnt vmcnt(" #n ")" ::: "memory")
#define PG8_WAIT_L(n) asm volatile("s_waitcnt lgkmcnt(" #n ")" ::: "memory")
#define PG8_BAR __builtin_amdgcn_s_barrier()
#define PG8_SCHED __builtin_amdgcn_sched_barrier(0)
#define PG8_VOFF(dst, u) do { int t_ = tid; if (GATHER) asm volatile("" : "+v"(t_));   \
        _Pragma("unroll") for (int i_ = 0; i_ < 2; ++i_) { int R_, C_; stage_rc(t_ * 16 + i_ * 8192, R_, C_); _Pragma("unroll") for (int h_ = 0; h_ < 2; ++h_) \
        dst[h_][i_] = GATHER ? (unsigned)(S.a_row(u, h_ * HALF + R_) * K + C_) * 2u : (unsigned)(R_ * K + C_) * 2u; } } while (0)
    Unit cur, nxt; int ui = 0;
    if (!S.next(0, cur)) return;
    f32x4 acc[2][2][4][2];
#pragma unroll
    for (int a = 0; a < 2; ++a)
#pragma unroll
        for (int b = 0; b < 2; ++b)
#pragma unroll
            for (int m = 0; m < 4; ++m)
#pragma unroll
                for (int n = 0; n < 2; ++n) acc[a][b][m][n] = (f32x4){0.f, 0.f, 0.f, 0.f};
    bf16x8 At[4][2], B0[2][2], B1[2][2];
    unsigned vC[2][2], vN[2][2], vX[2][2];
    PG8_VOFF(vC, cur);
    const char* cA = S.a_base(g, cur); const char* cB = S.b_base(g, cur);
    PG8_STAGE(PG8_SB(0, 0), cB, voffB); PG8_STAGE(PG8_SB(0, 1), cB + hstep, voffB); PG8_STAGE(PG8_SA(0, 0), cA, vC[0]); PG8_STAGE(PG8_SA(0, 1), cA + hsA, vC[1]);
    if (wr == 1) PG8_BAR;
    PG8_WAIT_V(2); PG8_BAR;
    PG8_STAGE(PG8_SB(1, 0), cB + kstep, voffB); PG8_STAGE(PG8_SA(1, 0), cA + kstep, vC[0]); PG8_STAGE(PG8_SB(1, 1), cB + hstep + kstep, voffB);
    PG8_WAIT_V(6); PG8_BAR;
    for (;;) {
        const bool has_next = S.next(ui + 1, nxt);
        const char* nA = has_next ? S.a_base(g, nxt) : cA; const char* nB = has_next ? S.b_base(g, nxt) : cB;
        if (GATHER && has_next) { PG8_VOFF(vN, nxt); }
        else {
#pragma unroll
            for (int h_ = 0; h_ < 2; ++h_)
#pragma unroll
                for (int i_ = 0; i_ < 2; ++i_) vN[h_][i_] = vC[h_][i_]; }
#pragma unroll 1
        for (int t = 0; t < nt; t += 2) {
            const bool last = (t == nt - 2);
            const char* a1 = cA + (size_t)(t + 1) * kstep;
            const char* a2 = last ? nA : cA + (size_t)(t + 2) * kstep; const char* b2 = last ? nB : cB + (size_t)(t + 2) * kstep;
            const char* a3 = a2 + kstep; const char* b3 = b2 + kstep;
#pragma unroll
            for (int h_ = 0; h_ < 2; ++h_)
#pragma unroll
                for (int i_ = 0; i_ < 2; ++i_) vX[h_][i_] = (GATHER && last) ? vN[h_][i_] : vC[h_][i_];
            PG8_LDB(B0, 0, 0); PG8_LDB(B1, 0, 1); PG8_SCHED; PG8_LDA(At, 0, 0); PG8_STAGE(PG8_SA(1, 1), a1 + hsA, vC[1]);
            PG8_WAIT_V(8); PG8_WAIT_L(0); PG8_BAR; PG8_MMA(0, 0, At, B0); PG8_MMA(0, 1, At, B1); PG8_BAR; PG8_SCHED;
            PG8_LDA(At, 0, 1); PG8_STAGE(PG8_SB(0, 0), b2, voffB); PG8_STAGE(PG8_SB(0, 1), b2 + hstep, voffB); PG8_STAGE(PG8_SA(0, 0), a2, vX[0]);
            PG8_WAIT_V(8); PG8_WAIT_L(0); PG8_BAR; PG8_MMA(1, 0, At, B0); PG8_MMA(1, 1, At, B1); PG8_BAR; PG8_SCHED;
            PG8_LDB(B0, 1, 0); PG8_LDB(B1, 1, 1); PG8_SCHED; PG8_LDA(At, 1, 0); PG8_STAGE(PG8_SA(0, 1), a2 + hsA, vX[1]);
            PG8_WAIT_V(8); PG8_WAIT_L(0); PG8_BAR; PG8_MMA(0, 0, At, B0); PG8_MMA(0, 1, At, B1); PG8_BAR; PG8_SCHED;
            PG8_LDA(At, 1, 1); PG8_STAGE(PG8_SB(1, 0), b3, voffB); PG8_STAGE(PG8_SB(1, 1), b3 + hstep, voffB); PG8_STAGE(PG8_SA(1, 0), a3, vX[0]);
            PG8_WAIT_V(8); PG8_WAIT_L(0); PG8_BAR; PG8_MMA(1, 0, At, B0); PG8_MMA(1, 1, At, B1); PG8_BAR; PG8_SCHED;
        }
        if constexpr (ALIGN_EPI) { if (wr == 0) PG8_BAR; }
        E(acc, cur, wr, wc, fr, fq);
        if (!has_next) break;
#pragma unroll
        for (int a = 0; a < 2; ++a)
#pragma unroll
            for (int b = 0; b < 2; ++b)
#pragma unroll
                for (int m = 0; m < 4; ++m)
#pragma unroll
                    for (int n = 0; n < 2; ++n) acc[a][b][m][n] = (f32x4){0.f, 0.f, 0.f, 0.f};
        cur = nxt; cA = nA; cB = nB; ++ui;
#pragma unroll
        for (int h_ = 0; h_ < 2; ++h_)
#pragma unroll
            for (int i_ = 0; i_ < 2; ++i_) vC[h_][i_] = vN[h_][i_];
        if constexpr (ALIGN_EPI) { if (wr == 1) PG8_BAR; }
    }
    PG8_WAIT_V(0);
    if constexpr (!ALIGN_EPI) { if (wr == 0) PG8_BAR; }
    PG8_BAR;
#undef PG8_SA
#undef PG8_SB
#undef PG8_STAGE
#undef PG8_LDA
#undef PG8_LDB
#undef PG8_MMA
#undef PG8_WAIT_V
#undef PG8_WAIT_L
#undef PG8_BAR
#undef PG8_SCHED
#undef PG8_VOFF
}
}

__device__ __forceinline__ float gelu_fast(float v) { const float y = 0.7978845608028654f * (v + 0.044715f * v * v * v); return v * __builtin_amdgcn_rcpf(1.f + __expf(-2.f * y)); }
__device__ __forceinline__ float sigmoid_fast(float v) { return __builtin_amdgcn_rcpf(1.f + __expf(-v)); }

struct EpiZ {
    static constexpr bool PERM = true;
    bf16* R1; const float* gq; const float* gk;
    __device__ __forceinline__ void operator()(const f32x4 (&acc)[2][2][4][2], const pg8::Unit& u, int wr, int wc, int fr, int fq) const {
        const int seg = u.pn >> 1;
        bf16* base = R1 + (size_t)seg * T * 512 + (size_t)(u.pm * 256 + wr * 64 + fr) * 512 + (u.pn & 1) * 256 + wc * 64 + 8 * fq;
        if (seg == 2 || seg == 3) {
            const float* g = seg == 2 ? gq : gk; const float sc = seg == 2 ? C2 : 1.f;
            f32x4 gv[2][2];
#pragma unroll
            for (int bj = 0; bj < 2; ++bj)
#pragma unroll
                for (int n = 0; n < 2; ++n) gv[bj][n] = *(const f32x4*)(g + 32 * bj + 8 * fq + 4 * n);
#pragma unroll
            for (int ai = 0; ai < 2; ++ai)
#pragma unroll
                for (int m = 0; m < 4; ++m) {
                    float s = 0.f;
#pragma unroll
                    for (int bj = 0; bj < 2; ++bj)
#pragma unroll
                        for (int n = 0; n < 2; ++n) { const f32x4 x = acc[ai][bj][m][n]; s += (x[0] * x[0] + x[1] * x[1]) + (x[2] * x[2] + x[3] * x[3]); }
                    s += __shfl_xor(s, 16); s += __shfl_xor(s, 32);
                    const float rs = rsqrtf(s * (1.f / 64.f) + EPS) * sc;
#pragma unroll
                    for (int bj = 0; bj < 2; ++bj) { const f32x4 v0 = acc[ai][bj][m][0] * rs * gv[bj][0], v1 = acc[ai][bj][m][1] * rs * gv[bj][1];
                        v4u w; w.x = pg8::cvt_pk_bf16(v0[0], v0[1]); w.y = pg8::cvt_pk_bf16(v0[2], v0[3]); w.z = pg8::cvt_pk_bf16(v1[0], v1[1]); w.w = pg8::cvt_pk_bf16(v1[2], v1[3]);
                        *(v4u*)(base + (size_t)(ai * 128 + m * 16) * 512 + 32 * bj) = w; }
                }
        } else {
#pragma unroll
            for (int ai = 0; ai < 2; ++ai)
#pragma unroll
                for (int m = 0; m < 4; ++m)
#pragma unroll
                    for (int bj = 0; bj < 2; ++bj) { f32x4 v0 = acc[ai][bj][m][0], v1 = acc[ai][bj][m][1];
                        if (seg == 1) { v0 = (f32x4){gelu_fast(v0[0]), gelu_fast(v0[1]), gelu_fast(v0[2]), gelu_fast(v0[3])}; v1 = (f32x4){gelu_fast(v1[0]), gelu_fast(v1[1]), gelu_fast(v1[2]), gelu_fast(v1[3])}; }
                        v4u w; w.x = pg8::cvt_pk_bf16(v0[0], v0[1]); w.y = pg8::cvt_pk_bf16(v0[2], v0[3]); w.z = pg8::cvt_pk_bf16(v1[0], v1[1]); w.w = pg8::cvt_pk_bf16(v1[2], v1[3]);
                        *(v4u*)(base + (size_t)(ai * 128 + m * 16) * 512 + 32 * bj) = w; }
        }
    }
};
__device__ __forceinline__ void phase_gemm1_fast(Ctx& C, KA AR, int l) {
    phase_cumsum(C, AR);
    pg8::Gemm g{(const bf16*)(C.ws + WS_XN), (const bf16*)(C.ws + WS_WIN) + (size_t)l * NZ * D, D};
    pg8::StaticOrder S; S.init(T, NZ, gridDim.x, blockIdx.x);
    EpiZ E{(bf16*)(C.ws + WS_R1), AR->in[I_QN] + l * HD, AR->in[I_KN] + l * HD};
    pg8::gemm_phase<EpiZ, pg8::StaticOrder, true, false>(C.lds, g, S, E, C.tid);
}
struct EpiRes {
    static constexpr bool PERM = false;
    const float* xs; float* X;
    __device__ __forceinline__ void operator()(const f32x4 (&acc)[2][2][4][2], const pg8::Unit& u, int wr, int wc, int fr, int fq) const {
        const size_t off0 = (size_t)(u.pm * 256 + wr * 64 + fr) * D + u.pn * 256 + wc * 32 + 4 * fq;
#pragma unroll
        for (int ai = 0; ai < 2; ++ai)
#pragma unroll
            for (int m = 0; m < 4; ++m)
#pragma unroll
                for (int bj = 0; bj < 2; ++bj)
#pragma unroll
                    for (int n = 0; n < 2; ++n) { const size_t o = off0 + (size_t)(ai * 128 + m * 16) * D + bj * 128 + n * 16; *(f32x4*)(X + o) = *(const f32x4*)(xs + o) + acc[ai][bj][m][n]; }
    }
};
__device__ __forceinline__ void phase_wo_fast(Ctx& C, KA AR, int l) {
    pg8::Gemm g{(const bf16*)(C.ws + WS_R2 + 16 * MiB), (const bf16*)(C.ws + WS_WOUT) + (size_t)l * D * D, D};
    pg8::StaticOrder S; S.init(T, D, gridDim.x, blockIdx.x);
    EpiRes E{l == 0 ? AR->in[I_X] : (const float*)(C.ws + WS_X), (float*)(C.ws + WS_X)};
    pg8::gemm_phase<EpiRes, pg8::StaticOrder, true, false>(C.lds, g, S, E, C.tid);
}
struct EpiProj {
    static constexpr bool PERM = true;
    bf16* PR;
    __device__ __forceinline__ void operator()(const f32x4 (&acc)[2][2][4][2], const pg8::Unit& u, int wr, int wc, int fr, int fq) const {
        bf16* base = PR + (size_t)(u.pm * 256 + wr * 64 + fr) * D + u.pn * 256 + wc * 32 + 8 * fq;
#pragma unroll
        for (int ai = 0; ai < 2; ++ai)
#pragma unroll
            for (int m = 0; m < 4; ++m)
#pragma unroll
                for (int bj = 0; bj < 2; ++bj) { const f32x4 v0 = acc[ai][bj][m][0], v1 = acc[ai][bj][m][1];
                    v4u w; w.x = pg8::cvt_pk_bf16(v0[0], v0[1]); w.y = pg8::cvt_pk_bf16(v0[2], v0[3]); w.z = pg8::cvt_pk_bf16(v1[0], v1[1]); w.w = pg8::cvt_pk_bf16(v1[2], v1[3]);
                    *(v4u*)(base + (size_t)(ai * 128 + m * 16) * D + bj * 128) = w; }
    }
};
__device__ __forceinline__ void phase_proj_fast(Ctx& C, KA AR, int l) {
    pg8::Gemm g{(const bf16*)(C.ws + WS_PB) + (size_t)l * T * PLE, (const bf16*)(C.ws + WS_WPP) + (size_t)l * D * PLE, PLE};
    pg8::StaticOrder S; S.init(T, D, gridDim.x, blockIdx.x);
    EpiProj E{(bf16*)(C.ws + WS_PROJ)};
    pg8::gemm_phase<EpiProj, pg8::StaticOrder, true, false>(C.lds, g, S, E, C.tid);
}
struct EpiPle {
    static constexpr bool PERM = false;
    const float* X; const bf16* PR; const float* bias; float* dst;
    __device__ __forceinline__ void operator()(const f32x4 (&acc)[2][2][4][2], const pg8::Unit& u, int wr, int wc, int fr, int fq) const {
        const int col0 = u.pn * 256 + wc * 32 + 4 * fq;
        const size_t off0 = (size_t)(u.pm * 256 + wr * 64 + fr) * D + col0;
#pragma unroll
        for (int bj = 0; bj < 2; ++bj)
#pragma unroll
            for (int n = 0; n < 2; ++n) { const f32x4 bv = *(const f32x4*)(bias + col0 + bj * 128 + n * 16);
#pragma unroll
                for (int ai = 0; ai < 2; ++ai)
#pragma unroll
                    for (int m = 0; m < 4; ++m) { const size_t o = off0 + (size_t)(ai * 128 + m * 16) * D + bj * 128 + n * 16;
                        const v2u pw = *(const v2u*)(PR + o); const f32x4 a = acc[ai][bj][m][n] + bv; const f32x4 x = *(const f32x4*)(X + o);
                        f32x4 r; r[0] = x[0] + bflo(pw.x) * sigmoid_fast(a[0]); r[1] = x[1] + bfhi(pw.x) * sigmoid_fast(a[1]); r[2] = x[2] + bflo(pw.y) * sigmoid_fast(a[2]); r[3] = x[3] + bfhi(pw.y) * sigmoid_fast(a[3]);
                        *(f32x4*)(dst + o) = r; } }
    }
};
__device__ __forceinline__ void phase_ple_fast(Ctx& C, KA AR, int l) {
    pg8::Gemm g{(const bf16*)(C.ws + WS_XN), (const bf16*)(C.ws + WS_WPG) + (size_t)l * D * D, D};
    pg8::StaticOrder S; S.init(T, D, gridDim.x, blockIdx.x);
    EpiPle E{(const float*)(C.ws + WS_X), (const bf16*)(C.ws + WS_PROJ), AR->in[I_BPG] + l * D, l == DEPTH - 1 ? AR->out : (float*)(C.ws + WS_X)};
    pg8::gemm_phase<EpiPle, pg8::StaticOrder, true, false>(C.lds, g, S, E, C.tid);
}
constexpr int TAB_OFF = MISC_OFF + 128;
struct GroupOrder {
    const LAS int* tab; int G, c; const int* rowpair; const char* hbase; bool is_g2;
    __device__ bool next(int i, pg8::Unit& u) const {
        const int L = i * G + c, mtg = L >> 2; if (mtg >= __builtin_amdgcn_readfirstlane(tab[64 + NE])) return false;
        const int pk = __builtin_amdgcn_readfirstlane(tab[128 + mtg]);
        const int e = pk & 255, mt = pk >> 8; const int ne = __builtin_amdgcn_readfirstlane(tab[e]), ho = __builtin_amdgcn_readfirstlane(tab[32 + e]);
        int nv = ne - 256 * mt; nv = nv > 256 ? 256 : nv;
        u.pm = ho + 256 * mt; u.pn = L & 3; u.e = e; u.aux = nv; u.mt = mt; return true;
    }
    __device__ __forceinline__ const char* a_base(const pg8::Gemm& g, const pg8::Unit& u) const { return is_g2 ? (const char*)g.A + (size_t)u.pm * 2 * g.K : (const char*)g.A; }
    __device__ __forceinline__ const char* b_base(const pg8::Gemm& g, const pg8::Unit& u) const { return (const char*)g.Bt + (size_t)(u.e * 1024 + u.pn * 256) * 2 * g.K; }
    __device__ __forceinline__ int a_row(const pg8::Unit& u, int r) const { return r < u.aux ? (rowpair[(size_t)u.e * CAP + u.mt * 256 + r] >> 1) : 0; }
};
__device__ __forceinline__ void build_exptab256(Ctx& C, int l, LAS int* tab) {
    __syncthreads();
    if (C.tid == 0) { const unsigned* cnt = (const unsigned*)(C.ws + WS_CTL) + CW_CNT + 64 * l; int ho = 0, tt = 0;
        for (int e = 0; e < NE; ++e) { const int n = (int)__hip_atomic_load(cnt + e, __ATOMIC_RELAXED, __HIP_MEMORY_SCOPE_AGENT); tab[e] = n; tab[32 + e] = ho; tab[64 + e] = tt;
            const int nt = (n + 255) >> 8; for (int j = 0; j < nt; ++j) tab[128 + tt + j] = e | (j << 8); ho += nt << 8; tt += nt; }
        tab[64 + NE] = tt; }
    __syncthreads();
}
struct EpiG1 {
    static constexpr bool PERM = true;
    bf16* Hb;
    __device__ __forceinline__ void operator()(const f32x4 (&acc)[2][2][4][2], const pg8::Unit& u, int wr, int wc, int fr, int fq) const {
        bf16* base = Hb + (size_t)(u.pm + wr * 64 + fr) * DE + u.pn * 128 + wc * 32 + 8 * fq;
#pragma unroll
        for (int ai = 0; ai < 2; ++ai)
#pragma unroll
            for (int m = 0; m < 4; ++m) { const int rl = ai * 128 + wr * 64 + m * 16 + fr;
                f32x4 h0, h1;
#pragma unroll
                for (int e = 0; e < 4; ++e) { const float g0 = acc[ai][0][m][0][e], g1 = acc[ai][0][m][1][e]; h0[e] = g0 * sigmoid_fast(g0) * acc[ai][1][m][0][e]; h1[e] = g1 * sigmoid_fast(g1) * acc[ai][1][m][1][e]; }
                v4u w; w.x = pg8::cvt_pk_bf16(h0[0], h0[1]); w.y = pg8::cvt_pk_bf16(h0[2], h0[3]); w.z = pg8::cvt_pk_bf16(h1[0], h1[1]); w.w = pg8::cvt_pk_bf16(h1[2], h1[3]);
                if (rl < u.aux) *(v4u*)(base + (size_t)(ai * 128 + m * 16) * DE) = w; }
    }
};
__device__ __forceinline__ void phase_g1_fast(Ctx& C, KA AR, int l) {
    LAS int* tab = (LAS int*)(C.lds + TAB_OFF); build_exptab256(C, l, tab);
    pg8::Gemm g{(const bf16*)(C.ws + WS_XN), (const bf16*)(C.ws + WS_WGU) + (size_t)l * NE * 1024 * D, D};
    GroupOrder S{tab, (int)gridDim.x, (int)blockIdx.x, (const int*)(C.ws + WS_ROWPAIR), nullptr, false};
    EpiG1 E{(bf16*)(C.ws + WS_R2)};
    pg8::gemm_phase<EpiG1, GroupOrder, true, true>(C.lds, g, S, E, C.tid);
}
struct EpiG2 {
    static constexpr bool PERM = true;
    bf16* Y2; const int* rowpair; const float* pairw;
    __device__ __forceinline__ void operator()(const f32x4 (&acc)[2][2][4][2], const pg8::Unit& u, int wr, int wc, int fr, int fq) const {
        const int* rp = rowpair + (size_t)u.e * CAP + u.mt * 256; const int col0 = u.pn * 256 + wc * 32 + 8 * fq;
#pragma unroll
        for (int ai = 0; ai < 2; ++ai)
#pragma unroll
            for (int m = 0; m < 4; ++m) { const int rl = ai * 128 + wr * 64 + m * 16 + fr;
                if (rl < u.aux) { const int p = rp[rl]; const float w8 = pairw[p]; bf16* row = Y2 + (size_t)p * D + col0;
#pragma unroll
                    for (int bj = 0; bj < 2; ++bj) { const f32x4 v0 = acc[ai][bj][m][0] * w8, v1 = acc[ai][bj][m][1] * w8;
                        v4u w; w.x = pg8::cvt_pk_bf16(v0[0], v0[1]); w.y = pg8::cvt_pk_bf16(v0[2], v0[3]); w.z = pg8::cvt_pk_bf16(v1[0], v1[1]); w.w = pg8::cvt_pk_bf16(v1[2], v1[3]);
                        *(v4u*)(row + bj * 128) = w; } } }
    }
};
__device__ __forceinline__ void phase_g2_fast(Ctx& C, KA AR, int l) {
    LAS int* tab = (LAS int*)(C.lds + TAB_OFF); build_exptab256(C, l, tab);
    pg8::Gemm g{(const bf16*)(C.ws + WS_R2), (const bf16*)(C.ws + WS_WDN) + (size_t)l * NE * D * DE, DE};
    GroupOrder S{tab, (int)gridDim.x, (int)blockIdx.x, (const int*)(C.ws + WS_ROWPAIR), nullptr, true};
    EpiG2 E{(bf16*)(C.ws + WS_R1), (const int*)(C.ws + WS_ROWPAIR), (const float*)(C.ws + WS_PAIRW)};
    pg8::gemm_phase<EpiG2, GroupOrder, true, false>(C.lds, g, S, E, C.tid);
}

constexpr int NPH = 14;
constexpr int NPHASES = 1 + DEPTH * NPH;
__global__ void __launch_bounds__(512, 2) fwd_kernel(Args args) {
    extern __shared__ __attribute__((aligned(16))) unsigned char lds[];
    Ctx C;
    C.lds = (LAS unsigned char*)lds;
    C.tid = threadIdx.x; C.lane = C.tid & 63; C.wave = __builtin_amdgcn_readfirstlane(C.tid >> 6);
    C.gw = blockIdx.x * 8 + C.wave; C.ngw = gridDim.x * 8;
    C.ws = args.ws;
    volatile LAS unsigned* MISC = (volatile LAS unsigned*)(C.lds + MISC_OFF);
    if (C.tid < 32) MISC[C.tid] = 0u;
    __syncthreads();
    XcdBarrier bar; bar.bar = (unsigned*)(C.ws + WS_CTL) + CW_BAR; bar.x = 0; bar.st = nullptr;
    const int lo = args.ph_lo, hi = args.ph_hi;
    if (hi - lo > 1) bar = xcd_barrier_post((unsigned*)(C.ws + WS_CTL) + CW_BAR, MISC + 8);
#ifndef ONLY
#define ONLY -1
#endif
#define PHON(k) (ONLY < 0 || ONLY == (k))
#define IN(k) (lo <= (k) && (k) < hi)
#define SEAM(k) do { if (IN(k) && IN((k) + 1)) xcd_barrier(bar); } while (0)
    if (PHON(99) && IN(0)) { KA A_ = fresh_args(); enter_phase(C, A_); phase_prologue(C, A_); } SEAM(0);
    for (int l = 0; l < DEPTH; ++l) {
        const int pb = 1 + l * NPH;
        if (PHON(0) && IN(pb + 0)) { KA A_ = fresh_args(); enter_phase(C, A_); phase_norm1(C, A_, l); } SEAM(pb + 0);
        if (PHON(1) && IN(pb + 1)) { KA A_ = fresh_args(); enter_phase(C, A_); if (FAST_GEMM1) phase_gemm1_fast(C, A_, l); else phase_gemm1_naive(C, A_, l); } SEAM(pb + 1);
        if (!FAST_GEMM1 && PHON(2) && IN(pb + 2)) { KA A_ = fresh_args(); enter_phase(C, A_); phase_qknorm_naive(C, A_, l); } SEAM(pb + 2);
        if (PHON(3) && IN(pb + 3)) { KA A_ = fresh_args(); enter_phase(C, A_); phase_rnn_naive<0>(C, A_, l); } SEAM(pb + 3);
        if (PHON(4) && IN(pb + 4)) { KA A_ = fresh_args(); enter_phase(C, A_); phase_attn_naive(C, A_, l); } SEAM(pb + 4);
        if (PHON(5) && IN(pb + 5)) { KA A_ = fresh_args(); enter_phase(C, A_); phase_rnn_naive<1>(C, A_, l); } SEAM(pb + 5);
        if (PHON(6) && IN(pb + 6)) { KA A_ = fresh_args(); enter_phase(C, A_); phase_mixnorm_naive(C, A_, l); } SEAM(pb + 6);
        if (PHON(7) && IN(pb + 7)) { KA A_ = fresh_args(); enter_phase(C, A_); if (FAST_DENSE) phase_wo_fast(C, A_, l); else phase_wo_naive(C, A_, l); } SEAM(pb + 7);
        if (PHON(8) && IN(pb + 8)) { KA A_ = fresh_args(); enter_phase(C, A_); phase_router(C, A_, l); } SEAM(pb + 8);
        if (PHON(9) && IN(pb + 9)) { KA A_ = fresh_args(); enter_phase(C, A_); if (FAST_MOE) phase_g1_fast(C, A_, l); else phase_g1_naive(C, A_, l); } SEAM(pb + 9);
        if (PHON(10) && IN(pb + 10)) { KA A_ = fresh_args(); enter_phase(C, A_); if (FAST_MOE) phase_g2_fast(C, A_, l); else phase_g2_naive(C, A_, l); } SEAM(pb + 10);
        if (PHON(11) && IN(pb + 11)) { KA A_ = fresh_args(); enter_phase(C, A_); phase_combine(C, A_, l); } SEAM(pb + 11);
        if (PHON(12) && IN(pb + 12)) { KA A_ = fresh_args(); enter_phase(C, A_); if (FAST_DENSE) phase_proj_fast(C, A_, l); else phase_proj_naive(C, A_, l); } SEAM(pb + 12);
        if (PHON(13) && IN(pb + 13)) { KA A_ = fresh_args(); enter_phase(C, A_); if (FAST_DENSE) phase_ple_fast(C, A_, l); else phase_ple_naive(C, A_, l); } SEAM(pb + 13);
    }
#undef IN
#undef SEAM
}

extern "C" void kernel_launch(void* const* d_in, const int* in_sizes, int n_in, void* d_out, int out_size, void* d_ws, size_t ws_size, hipStream_t stream) {
    static int grid = 0;
    if (grid == 0) {
        if (n_in != 29 || out_size != T * D || ws_size < WS_END) { fprintf(stderr, "kernel_launch: unexpected problem (n_in %d, out %d, ws %zu)\n", n_in, out_size, ws_size); grid = -1; return; }
        int dev = 0, cus = 0, per_cu = 0;
        if (hipGetDevice(&dev) != hipSuccess || hipDeviceGetAttribute(&cus, hipDeviceAttributeMultiprocessorCount, dev) != hipSuccess) { grid = -1; return; }
        if (hipFuncSetAttribute((const void*)fwd_kernel, hipFuncAttributeMaxDynamicSharedMemorySize, LDS_BYTES) != hipSuccess) { fprintf(stderr, "kernel_launch: hipFuncSetAttribute failed\n"); grid = -1; return; }
        if (hipOccupancyMaxActiveBlocksPerMultiprocessor(&per_cu, (const void*)fwd_kernel, 512, LDS_BYTES) != hipSuccess || per_cu < 1) { fprintf(stderr, "kernel_launch: occupancy query says %d\n", per_cu); grid = -1; return; }
        (void)hipGetLastError();
        grid = cus;
    }
    if (grid < 0) return;
    hipMemsetAsync((char*)d_ws + WS_CTL, 0, CTL_ZERO_BYTES, stream);
    Args a{};
    for (int i = 0; i < 29; ++i) a.in[i] = (const float*)d_in[i];
    a.out = (float*)d_out; a.ws = (unsigned char*)d_ws;
#if MK_MULTI
    for (int ph = 0; ph < NPHASES; ++ph) { a.ph_lo = ph; a.ph_hi = ph + 1; hipLaunchKernelGGL(fwd_kernel, dim3(grid), dim3(512), LDS_BYTES, stream, a); }
#else
    a.ph_lo = 0; a.ph_hi = NPHASES;
    hipLaunchKernelGGL(fwd_kernel, dim3(grid), dim3(512), LDS_BYTES, stream, a);
#endif
}
```

```cpp
#include <hip/hip_runtime.h>
#include <cstdio>
#include <cstdint>
#include <cmath>
#include <hip/hip_bf16.h>

#define FAST_GEMM1 1
#define FAST_DENSE 1
#define FAST_MOE 1
#define FAST_ATTN 1
#define FAST_RNN 1
#ifndef MK_MULTI
#define MK_MULTI 0
#endif

#define GAS __attribute__((address_space(1)))
#define LAS __attribute__((address_space(3)))
typedef unsigned short bf16;
typedef unsigned v4u __attribute__((ext_vector_type(4)));
typedef unsigned v2u __attribute__((ext_vector_type(2)));
typedef float f32x4 __attribute__((ext_vector_type(4)));

constexpr int NB = 4, S = 4096, T = NB * S, D = 1024, DIN = 2568, DR = 512, DA = 512, NH = 8, HD = 64;
constexpr int NE = 32, DE = 512, PLE = 256, DEPTH = 2, NZ = 2560;
constexpr float EPS = 1e-6f, LOG2E = 1.4426950408889634f, C2 = 0.125f * 1.4426950408889634f;
constexpr int CAP = 16384;
constexpr int HROWS = 40960;

constexpr size_t MiB = 1u << 20;
constexpr size_t WS_CTL = 0, CTL_ZERO_BYTES = 1 * MiB;
constexpr size_t WS_LOGF = 1 * MiB;
constexpr size_t WS_C2K = WS_LOGF + MiB / 2;
constexpr size_t WS_SA = 6 * MiB, WS_SH = 7 * MiB;
constexpr size_t WS_PAIRW = 3 * MiB;
constexpr size_t WS_ROWPAIR = 4 * MiB;
constexpr size_t WS_WIN = 8 * MiB;
constexpr size_t WS_WOUT = 18 * MiB;
constexpr size_t WS_WPG = 22 * MiB;
constexpr size_t WS_WPP = 26 * MiB;
constexpr size_t WS_WGU = 28 * MiB;
constexpr size_t WS_WDN = 156 * MiB;
constexpr size_t WS_PB = 220 * MiB;
constexpr size_t WS_XN = 236 * MiB;
constexpr size_t WS_X = 268 * MiB;
constexpr size_t WS_R1 = 332 * MiB;
constexpr size_t WS_R2 = 412 * MiB;
constexpr size_t WS_PROJ = 460 * MiB;
constexpr size_t WS_END = 492 * MiB;
constexpr int CW_BAR = 4096;
constexpr int CW_CNT = 8192;

constexpr int RING_BYTES = 131072;
constexpr int MISC_OFF = RING_BYTES + 320;
constexpr int LDS_BYTES = 147456;

__device__ __forceinline__ unsigned f2bf(float f) { unsigned u = __builtin_bit_cast(unsigned, f); return (u + 0x7fffu + ((u >> 16) & 1u)) >> 16; }
__device__ __forceinline__ unsigned pk2(float lo, float hi) { return f2bf(lo) | (f2bf(hi) << 16); }
__device__ __forceinline__ float bf2f(unsigned u) { return __builtin_bit_cast(float, u << 16); }
__device__ __forceinline__ float bflo(unsigned w) { return __builtin_bit_cast(float, w << 16); }
__device__ __forceinline__ float bfhi(unsigned w) { return __builtin_bit_cast(float, w & 0xffff0000u); }
template <int O> __device__ __forceinline__ float lane_xor(float v) {
    if constexpr (O == 32) { const unsigned u = __builtin_bit_cast(unsigned, v); auto rr = __builtin_amdgcn_permlane32_swap(u, u, false, false);
        const unsigned a = rr[0], b = rr[1]; return __builtin_bit_cast(float, a == u ? b : a); }
    else return __builtin_bit_cast(float, __builtin_amdgcn_ds_swizzle(__builtin_bit_cast(int, v), (O << 10) | 0x1f));
}
__device__ __forceinline__ float wave_sum(float v) {
    v += lane_xor<1>(v); v += lane_xor<2>(v); v += lane_xor<4>(v); v += lane_xor<8>(v); v += lane_xor<16>(v);
    { const unsigned u = __builtin_bit_cast(unsigned, v); auto rr = __builtin_amdgcn_permlane32_swap(u, u, false, false); v = __builtin_bit_cast(float, (unsigned)rr[0]) + __builtin_bit_cast(float, (unsigned)rr[1]); }
    return v;
}
__device__ __forceinline__ float wave_max(float v) {
    v = fmaxf(v, lane_xor<1>(v)); v = fmaxf(v, lane_xor<2>(v)); v = fmaxf(v, lane_xor<4>(v)); v = fmaxf(v, lane_xor<8>(v)); v = fmaxf(v, lane_xor<16>(v));
    { const unsigned u = __builtin_bit_cast(unsigned, v); auto rr = __builtin_amdgcn_permlane32_swap(u, u, false, false); v = fmaxf(__builtin_bit_cast(float, (unsigned)rr[0]), __builtin_bit_cast(float, (unsigned)rr[1])); }
    return v;
}
__device__ __forceinline__ float half_sum32(float v) {
    const unsigned u = __builtin_bit_cast(unsigned, v); auto rr = __builtin_amdgcn_permlane32_swap(u, u, false, false); return __builtin_bit_cast(float, (unsigned)rr[0]) + __builtin_bit_cast(float, (unsigned)rr[1]);
}
__device__ __forceinline__ float sigmoidf_(float v) { return 1.f / (1.f + __expf(-v)); }
__device__ __forceinline__ float gelu_tanh(float v) { return 0.5f * v * (1.f + tanhf(0.7978845608028654f * (v + 0.044715f * v * v * v))); }
__device__ __forceinline__ float log_sigmoid(float v) { return v >= 0.f ? -log1pf(__expf(-v)) : v - log1pf(__expf(v)); }

#define XB_TMO      128
#define XB_XCNT(j)  (256  + 64 * (j))
#define XB_XSUB(j)  (1280 + 64 * (j))
#define XB_XGEN(j)  (2304 + 64 * (j))
#define XB_TOP      3328
#define XB_TOPGEN   3392
#define XCD_BAR_WORDS 3456
#define XB_SPIN_CAP (1u << 26)
__device__ __forceinline__ unsigned xb_ld(unsigned* p)              { return __hip_atomic_load(p, __ATOMIC_RELAXED, __HIP_MEMORY_SCOPE_AGENT); }
__device__ __forceinline__ unsigned xb_add(unsigned* p, unsigned v) { return __hip_atomic_fetch_add(p, v, __ATOMIC_RELAXED, __HIP_MEMORY_SCOPE_AGENT); }
__device__ __forceinline__ unsigned xb_xcc_id() { return (unsigned)__builtin_amdgcn_s_getreg((3 << 11) | 20) & 0xFu; }
#define XB_SPIN(cond, bar) do { unsigned _sp = 0; while (cond) { __builtin_amdgcn_s_sleep(1); \
    if ((++_sp & 255u) == 0u) { if (xb_ld(&(bar)[XB_TMO])) break; if (_sp > XB_SPIN_CAP) { atomicAdd(&(bar)[XB_TMO], 1u); break; } } } } while (0)
struct XcdBarrier { unsigned* bar; unsigned x; volatile LAS unsigned* st; };
__device__ __forceinline__ XcdBarrier xcd_barrier_post(unsigned* bar, volatile LAS unsigned* st) {
    XcdBarrier b; b.bar = bar; b.x = xb_xcc_id(); b.st = st;
    if (threadIdx.x == 0) (void)xb_add(&bar[XB_XCNT(b.x)], 1u);
    return b;
}
__device__ __forceinline__ void xcd_barrier_complete(unsigned* bar, unsigned x, unsigned& nloc, unsigned& nx) {
    const unsigned G = gridDim.x * gridDim.y * gridDim.z;
    unsigned sum, cnt, mine, sp = 0u;
    for (;;) {
        sum = 0u; cnt = 0u; mine = 0u;
#pragma unroll
        for (unsigned j = 0; j < 16; ++j) { const unsigned c = xb_ld(&bar[XB_XCNT(j)]); sum += c; cnt += (c > 0u) ? 1u : 0u; mine = (j == x) ? c : mine; }
        if (sum == G) break;
        __builtin_amdgcn_s_sleep(1);
        if ((++sp & 255u) == 0u) { if (xb_ld(&bar[XB_TMO])) break; if (sp > XB_SPIN_CAP) { atomicAdd(&bar[XB_TMO], 1u); break; } }
    }
    nloc = mine > 0u ? mine : 1u; nx = cnt > 0u ? cnt : 1u;
}
__device__ __forceinline__ void xcd_barrier(const XcdBarrier& b, const bool leader  ) {
    asm volatile("s_waitcnt vmcnt(0)" ::: "memory");
    __syncthreads();
    if (leader) {
        unsigned* bar = b.bar;
        __builtin_amdgcn_s_waitcnt(0);
        unsigned nloc = b.st[0], nx = b.st[1];
        if (nloc == 0u) { xcd_barrier_complete(bar, b.x, nloc, nx); b.st[0] = nloc; b.st[1] = nx; }
        const unsigned old = xb_add(&bar[XB_XSUB(b.x)], 1u);
        const unsigned gen = old / nloc;
        if (old + 1u == (gen + 1u) * nloc) {
            __builtin_amdgcn_fence(__ATOMIC_RELEASE, "agent");
            asm volatile("s_waitcnt vmcnt(0)" ::: "memory");
            const unsigned og = xb_add(&bar[XB_TOP], 1u);
            const unsigned tg = og / nx;
            if (og + 1u == (tg + 1u) * nx) xb_add(&bar[XB_TOPGEN], 1u);
            else XB_SPIN(xb_ld(&bar[XB_TOPGEN]) == tg, bar);
            __builtin_amdgcn_fence(__ATOMIC_ACQUIRE, "agent");
            xb_add(&bar[XB_XGEN(b.x)], 1u);
            asm volatile("s_waitcnt vmcnt(0)" ::: "memory");
        } else {
            XB_SPIN(xb_ld(&bar[XB_XGEN(b.x)]) == gen, bar);
            __builtin_amdgcn_fence(__ATOMIC_ACQUIRE, "agent");
            asm volatile("s_waitcnt vmcnt(0)" ::: "memory");
        }
    }
    __syncthreads();
}

struct Args { const float* in[29]; float* out; unsigned char* ws; int ph_lo, ph_hi; };
typedef const __attribute__((address_space(4))) Args* KA;
__device__ __forceinline__ KA fresh_args() { KA p = (KA)__builtin_amdgcn_kernarg_segment_ptr(); asm volatile("" : "+s"(p)); return p; }
struct Ctx;
struct Ctx {
    LAS unsigned char* lds;
    int tid, lane, wave, gw, ngw;
    int wave0;
    unsigned char* ws;
};
__device__ __forceinline__ void enter_phase(Ctx& C, KA A) {
    int t; asm volatile("v_mbcnt_lo_u32_b32 %0, -1, 0\n\tv_mbcnt_hi_u32_b32 %0, -1, %0" : "=v"(t)); t += C.wave0 * 64; C.tid = t; C.lane = t & 63; C.wave = __builtin_amdgcn_readfirstlane(t >> 6);
    C.gw = blockIdx.x * 8 + C.wave; C.ngw = gridDim.x * 8; C.ws = A->ws; }
enum { I_X = 0, I_P, I_MIXN, I_WIN, I_BF, I_CONVW, I_CONVB, I_WR, I_BR, I_WI, I_BI, I_LAM, I_QN, I_KN, I_LRUN, I_ATTN, I_WOUT, I_FFNN,
       I_WG, I_BG, I_WRT, I_BRT, I_WEG, I_WEU, I_WED, I_PLEN, I_WPG, I_BPG, I_WPP };

__device__ __forceinline__ void transpose_item(const float* W, int ldw, int K, bf16* WT, int k0, int n0, int c0, LAS float* scr, int lane) {
#pragma unroll 8
    for (int i = 0; i < 32; ++i) { const int kk = 2 * i + (lane >> 5); scr[kk * 33 + (lane & 31)] = W[(size_t)(k0 + kk) * ldw + c0 + (lane & 31)]; }
    asm volatile("s_waitcnt lgkmcnt(0)" ::: "memory");
    const int c = lane & 7;
#pragma unroll
    for (int j = 0; j < 4; ++j) { const int n = (lane >> 3) + 8 * j; const LAS float* s = scr + (8 * c) * 33 + n;
        v4u o; o.x = pk2(s[0 * 33], s[1 * 33]); o.y = pk2(s[2 * 33], s[3 * 33]); o.z = pk2(s[4 * 33], s[5 * 33]); o.w = pk2(s[6 * 33], s[7 * 33]);
        *(v4u*)(WT + (size_t)(n0 + n) * K + k0 + 8 * c) = o; }
    asm volatile("s_waitcnt lgkmcnt(0)" ::: "memory");
}
__device__ __forceinline__ void phase_prologue(Ctx& C, KA AR) {
    LAS float* scr = (LAS float*)(C.lds + C.wave * 16384);
    constexpr int I_IN = 16 * 80, I_OUT = 16 * 32, I_GU = 32 * 16 * 32, I_DN = 32 * 8 * 32, I_PG = 16 * 32, I_PP = 4 * 32;
    constexpr int PER_L = I_IN + I_OUT + I_GU + I_DN + I_PG + I_PP;
    for (int it = C.gw; it < DEPTH * PER_L; it += C.ngw) {
        const int l = it / PER_L; int r = it % PER_L;
        if (r < I_IN) {
            const int kb = r / 80, nb = r % 80, n0 = 32 * nb, pn = n0 >> 8, jl = n0 & 255, bj = jl >> 7, wc = (jl >> 5) & 3;
            transpose_item(AR->in[I_WIN] + (size_t)l * D * DIN, DIN, D, (bf16*)(C.ws + WS_WIN) + (size_t)l * NZ * D, 64 * kb, n0, 256 * pn + 64 * wc + 32 * bj, scr, C.lane); continue; }
        r -= I_IN;
        if (r < I_OUT) { const int kb = r / 32, nb = r % 32;
            transpose_item(AR->in[I_WOUT] + (size_t)l * D * D, D, D, (bf16*)(C.ws + WS_WOUT) + (size_t)l * D * D, 64 * kb, 32 * nb, 32 * nb, scr, C.lane); continue; }
        r -= I_OUT;
        if (r < I_GU) {
            const int e = r / 512, q = r % 512, kb = q / 32, nb = q % 32, n0 = 32 * nb, pn = n0 >> 8, jl = n0 & 255;
            const float* src = (jl < 128 ? AR->in[I_WEG] : AR->in[I_WEU]) + (size_t)(l * NE + e) * D * DE;
            transpose_item(src, DE, D, (bf16*)(C.ws + WS_WGU) + (size_t)(l * NE + e) * 1024 * D, 64 * kb, n0, 128 * pn + (jl & 127), scr, C.lane); continue; }
        r -= I_GU;
        if (r < I_DN) { const int e = r / 256, q = r % 256, kb = q / 32, nb = q % 32;
            transpose_item(AR->in[I_WED] + (size_t)(l * NE + e) * DE * D, D, DE, (bf16*)(C.ws + WS_WDN) + (size_t)(l * NE + e) * D * DE, 64 * kb, 32 * nb, 32 * nb, scr, C.lane); continue; }
        r -= I_DN;
        if (r < I_PG) { const int kb = r / 32, nb = r % 32;
            transpose_item(AR->in[I_WPG] + (size_t)l * D * D, D, D, (bf16*)(C.ws + WS_WPG) + (size_t)l * D * D, 64 * kb, 32 * nb, 32 * nb, scr, C.lane); continue; }
        r -= I_PG;
        { const int kb = r / 32, nb = r % 32;
            transpose_item(AR->in[I_WPP] + (size_t)l * PLE * D, D, PLE, (bf16*)(C.ws + WS_WPP) + (size_t)l * D * PLE, 64 * kb, 32 * nb, 32 * nb, scr, C.lane); }
    }
    const f32x4* ps = (const f32x4*)AR->in[I_P]; v2u* pd = (v2u*)(C.ws + WS_PB);
    const size_t n4 = (size_t)DEPTH * T * PLE / 4;
    for (size_t i = (size_t)blockIdx.x * 512 + C.tid; i < n4; i += (size_t)gridDim.x * 512) { const f32x4 v = ps[i]; v2u o; o.x = pk2(v.x, v.y); o.y = pk2(v.z, v.w); pd[i] = o; }
}

__device__ __forceinline__ void load_row(const float* row, int lane, f32x4 (&v)[4]) {
    const f32x4* xr = (const f32x4*)row + lane;
#pragma unroll
    for (int j = 0; j < 4; ++j) v[j] = xr[64 * j];
}
__device__ __forceinline__ float row_rs(const f32x4 (&v)[4]) {
    float s = 0.f;
#pragma unroll
    for (int j = 0; j < 4; ++j) s += (v[j].x * v[j].x + v[j].y * v[j].y) + (v[j].z * v[j].z + v[j].w * v[j].w);
    return rsqrtf(wave_sum(s) * (1.f / D) + EPS);
}
__device__ __forceinline__ void scale_row(f32x4 (&v)[4], float rs, const float* gain, int lane) {
    const f32x4* g = (const f32x4*)gain + lane;
#pragma unroll
    for (int j = 0; j < 4; ++j) v[j] = v[j] * rs * g[64 * j];
}
__device__ __forceinline__ void store_row_bf16(bf16* row, int lane, const f32x4 (&v)[4]) {
    v2u* o = (v2u*)row + lane;
#pragma unroll
    for (int j = 0; j < 4; ++j) { v2u w; w.x = pk2(v[j].x, v[j].y); w.y = pk2(v[j].z, v[j].w); o[64 * j] = w; }
}

__device__ __forceinline__ void phase_norm1(Ctx& C, KA AR, int l) {
    const float* xs = l == 0 ? AR->in[I_X] : (const float*)(C.ws + WS_X);
    const float* gain = AR->in[I_MIXN] + l * D;
    const float* wf = AR->in[I_WIN] + (size_t)l * D * DIN + NZ;
    const float* bfg = AR->in[I_BF] + l * NH;
    bf16* xn = (bf16*)(C.ws + WS_XN); float* logf = (float*)(C.ws + WS_LOGF);
    for (int t = C.gw; t < T; t += C.ngw) {
        f32x4 v[4]; load_row(xs + (size_t)t * D, C.lane, v);
        const float rs = row_rs(v); scale_row(v, rs, gain, C.lane);
        store_row_bf16(xn + (size_t)t * D, C.lane, v);
        float z[8] = {0.f, 0.f, 0.f, 0.f, 0.f, 0.f, 0.f, 0.f};
#pragma unroll
        for (int j = 0; j < 4; ++j)
#pragma unroll
            for (int e = 0; e < 4; ++e) { const int k = 256 * j + 4 * C.lane + e; const f32x4 w0 = *(const f32x4*)(wf + (size_t)k * DIN), w1 = *(const f32x4*)(wf + (size_t)k * DIN + 4);
                const float a = v[j][e]; z[0] += a * w0.x; z[1] += a * w0.y; z[2] += a * w0.z; z[3] += a * w0.w; z[4] += a * w1.x; z[5] += a * w1.y; z[6] += a * w1.z; z[7] += a * w1.w; }
#pragma unroll
        for (int h = 0; h < 8; ++h) z[h] = wave_sum(z[h]);
        float mine = 0.f;
#pragma unroll
        for (int h = 0; h < 8; ++h) mine = (C.lane == h) ? z[h] : mine;
        if (C.lane < 8) logf[(size_t)t * 8 + C.lane] = log_sigmoid(mine + bfg[C.lane]);
    }
}

template <int NACC, class AR, class BR, class EP>
__device__ __forceinline__ void ngemm_tile(LAS float* sm, int K, AR arow, BR brow, EP epi, const int tid) {
    LAS float* As = sm; LAS float* Bs = sm + 32 * 68;
    const int ty = tid >> 4, tx = tid & 15, lr = tid >> 3, lk = (tid & 7) * 4;
    float acc[NACC][2][4];
#pragma unroll
    for (int a = 0; a < NACC; ++a)
#pragma unroll
        for (int i = 0; i < 2; ++i)
#pragma unroll
            for (int j = 0; j < 4; ++j) acc[a][i][j] = 0.f;
    const bf16* ap = arow(lr); const bf16* bp0 = brow(lr, 0); const bf16* bp1 = NACC > 1 ? brow(lr, 1) : bp0;
    for (int k0 = 0; k0 < K; k0 += 32) {
        __syncthreads();
        { v2u av; av.x = 0u; av.y = 0u; if (ap) av = *(const v2u*)(ap + k0 + lk);
          As[(lk + 0) * 68 + lr] = bflo(av.x); As[(lk + 1) * 68 + lr] = bfhi(av.x); As[(lk + 2) * 68 + lr] = bflo(av.y); As[(lk + 3) * 68 + lr] = bfhi(av.y); }
        { const v2u bv = *(const v2u*)(bp0 + k0 + lk);
          Bs[(lk + 0) * 68 + lr] = bflo(bv.x); Bs[(lk + 1) * 68 + lr] = bfhi(bv.x); Bs[(lk + 2) * 68 + lr] = bflo(bv.y); Bs[(lk + 3) * 68 + lr] = bfhi(bv.y); }
        if (NACC > 1) { const v2u bv = *(const v2u*)(bp1 + k0 + lk); LAS float* B1 = Bs + 32 * 68;
          B1[(lk + 0) * 68 + lr] = bflo(bv.x); B1[(lk + 1) * 68 + lr] = bfhi(bv.x); B1[(lk + 2) * 68 + lr] = bflo(bv.y); B1[(lk + 3) * 68 + lr] = bfhi(bv.y); }
        __syncthreads();
#pragma unroll 8
        for (int kk = 0; kk < 32; ++kk) {
            const float a0 = As[kk * 68 + ty * 2], a1 = As[kk * 68 + ty * 2 + 1];
#pragma unroll
            for (int a = 0; a < NACC; ++a) { const f32x4 b = *(const LAS f32x4*)(Bs + a * 32 * 68 + kk * 68 + tx * 4);
#pragma unroll
                for (int j = 0; j < 4; ++j) { acc[a][0][j] += a0 * b[j]; acc[a][1][j] += a1 * b[j]; } }
        }
    }
#pragma unroll
    for (int i = 0; i < 2; ++i)
#pragma unroll
        for (int j = 0; j < 4; ++j) epi(ty * 2 + i, tx * 4 + j, acc[0][i][j], NACC > 1 ? acc[1][i][j] : 0.f);
}

__device__ __forceinline__ void phase_cumsum(Ctx& C, KA AR) {
    if (C.gw < NB * NH) {
        const int b = C.gw / NH, h = C.gw % NH;
        const float* logf = (const float*)(C.ws + WS_LOGF) + (size_t)b * S * 8 + h; float* c2k = (float*)(C.ws + WS_C2K) + (size_t)C.gw * S;
        float s = 0.f;
        for (int i = 0; i < 64; ++i) s += logf[(size_t)(64 * C.lane + i) * 8];
        float inc = s;
#pragma unroll
        for (int o = 1; o < 64; o <<= 1) { const float v = __builtin_bit_cast(float, __builtin_amdgcn_ds_bpermute((C.lane - o) << 2, __builtin_bit_cast(int, inc))); if (C.lane >= o) inc += v; }
        float run = inc - s;
        for (int i = 0; i < 64; ++i) { run += logf[(size_t)(64 * C.lane + i) * 8]; c2k[64 * C.lane + i] = run * LOG2E; }
    }
}
__device__ __forceinline__ void phase_gemm1_naive(Ctx& C, KA AR, int l) {
    phase_cumsum(C, AR);
    const bf16* A = (const bf16*)(C.ws + WS_XN); const bf16* Bt = (const bf16*)(C.ws + WS_WIN) + (size_t)l * NZ * D;
    bf16* R1 = (bf16*)(C.ws + WS_R1);
    for (int u = blockIdx.x; u < (T / 64) * (NZ / 64); u += gridDim.x) {
        const int mt = u / (NZ / 64), nt = u % (NZ / 64), m0 = 64 * mt, n0 = 64 * nt;
        ngemm_tile<1>((LAS float*)C.lds, D, [=](int r) { return A + (size_t)(m0 + r) * D; }, [=](int c, int) { return Bt + (size_t)(n0 + c) * D; },
            [=](int r, int c, float v, float) {
                const int j = n0 + c, pn = j >> 8, jl = j & 255, bj = jl >> 7, wc = (jl >> 5) & 3, col = 256 * pn + 64 * wc + 32 * bj + (jl & 31);
                const int seg = col >> 9, cc = col & 511;
                const float o = seg == 1 ? gelu_tanh(v) : v;
                R1[(size_t)seg * T * 512 + (size_t)(m0 + r) * 512 + cc] = (bf16)f2bf(o);
            }, C.tid);
    }
}
__device__ __forceinline__ void phase_qknorm_naive(Ctx& C, KA AR, int l) {
    bf16* Q = (bf16*)(C.ws + WS_R1) + (size_t)2 * T * 512; bf16* Kb = Q + (size_t)T * 512;
    const float* gq = AR->in[I_QN] + l * HD; const float* gk = AR->in[I_KN] + l * HD;
    for (int i = C.gw; i < 2 * T; i += C.ngw) {
        const int t = i >> 1, isk = i & 1; bf16* row = (isk ? Kb : Q) + (size_t)t * 512; const float* g = isk ? gk : gq;
        const v4u w = *(const v4u*)(row + 8 * C.lane);
        float x[8] = {bflo(w.x), bfhi(w.x), bflo(w.y), bfhi(w.y), bflo(w.z), bfhi(w.z), bflo(w.w), bfhi(w.w)};
        float s = 0.f;
#pragma unroll
        for (int e = 0; e < 8; ++e) s += x[e] * x[e];
        s += lane_xor<1>(s); s += lane_xor<2>(s); s += lane_xor<4>(s);
        const float rs = rsqrtf(s * (1.f / 64.f) + EPS) * (isk ? 1.f : C2);
        const int d0 = 8 * (C.lane & 7);
#pragma unroll
        for (int e = 0; e < 8; ++e) x[e] = x[e] * rs * g[d0 + e];
        v4u o; o.x = pk2(x[0], x[1]); o.y = pk2(x[2], x[3]); o.z = pk2(x[4], x[5]); o.w = pk2(x[6], x[7]);
        *(v4u*)(row + 8 * C.lane) = o;
    }
}

template <int MODE>
__device__ __forceinline__ void phase_rnn_naive(Ctx& C, KA AR, int l) {
    LAS float* xcs = (LAS float*)C.lds; LAS float* as = xcs + 64 * 65; LAS float* us = as + 64 * 64;
    const bf16* ZX = (const bf16*)(C.ws + WS_R1); const bf16* ZG = ZX + (size_t)T * 512;
    float* SA = (float*)(C.ws + WS_SA); float* SH = (float*)(C.ws + WS_SH); float* YR = (float*)(C.ws + WS_PROJ);
    const float* cw = AR->in[I_CONVW] + l * 4 * DR; const float* cb = AR->in[I_CONVB] + l * DR;
    const float* wr = AR->in[I_WR] + (size_t)l * 8 * 64 * 64; const float* wi = AR->in[I_WI] + (size_t)l * 8 * 64 * 64;
    const float* br = AR->in[I_BR] + l * DR; const float* bi = AR->in[I_BI] + l * DR; const float* lam = AR->in[I_LAM] + l * DR;
    for (int u = blockIdx.x; u < NB * 64 * 8; u += gridDim.x) {
        const int b = u >> 9, cidx = (u >> 3) & 63, blk = u & 7;
        __syncthreads();
#pragma unroll
        for (int i = 0; i < 8; ++i) { const int e = C.tid + 512 * i, t = e >> 6, c = e & 63, ch = blk * 64 + c, tg = cidx * 64 + t;
            float xc = cb[ch];
#pragma unroll
            for (int j = 0; j < 4; ++j) { const int tt = tg - 3 + j; if (tt >= 0) xc += cw[j * DR + ch] * bf2f(ZX[(size_t)(b * S + tt) * 512 + ch]); }
            xcs[t * 65 + c] = xc; }
        __syncthreads();
#pragma unroll
        for (int i = 0; i < 8; ++i) { const int e = C.tid + 512 * i, t = e >> 6, j = e & 63, ch = blk * 64 + j;
            float ar = br[ch], ai = bi[ch];
            for (int k = 0; k < 64; ++k) { const float x = xcs[t * 65 + k]; ar += x * wr[(size_t)(blk * 64 + k) * 64 + j]; ai += x * wi[(size_t)(blk * 64 + k) * 64 + j]; }
            const float r = sigmoidf_(ar), ig = sigmoidf_(ai);
            const float la = -8.f * r * log1pf(__expf(-lam[ch]));
            as[t * 64 + j] = __expf(la); us[t * 64 + j] = sqrtf(-expm1f(2.f * la)) * (ig * xcs[t * 65 + j]); }
        __syncthreads();
        if (C.tid < 64) { const int j = C.tid, ch = blk * 64 + j;
            if (MODE == 0) { float A = 1.f, H = 0.f;
                for (int t = 0; t < 64; ++t) { const float a = as[t * 64 + j]; H = a * H + us[t * 64 + j]; A *= a; }
                SA[(size_t)(b * 64 + cidx) * 512 + ch] = A; SH[(size_t)(b * 64 + cidx) * 512 + ch] = H;
            } else { float h = 0.f;
                for (int c2 = 0; c2 < cidx; ++c2) h = SA[(size_t)(b * 64 + c2) * 512 + ch] * h + SH[(size_t)(b * 64 + c2) * 512 + ch];
                for (int t = 0; t < 64; ++t) { h = as[t * 64 + j] * h + us[t * 64 + j]; as[t * 64 + j] = h; } } }
        if (MODE == 1) { __syncthreads();
#pragma unroll
            for (int i = 0; i < 8; ++i) { const int e = C.tid + 512 * i, t = e >> 6, c = e & 63, ch = blk * 64 + c; const size_t row = (size_t)(b * S + cidx * 64 + t);
                YR[row * 512 + ch] = as[t * 64 + c] * bf2f(ZG[row * 512 + ch]); } }
    }
}

__device__ __forceinline__ void phase_attn_naive(Ctx& C, KA AR, int l) {
    LAS float* Ks = (LAS float*)C.lds; LAS float* Vs = Ks + 64 * 65; LAS float* Qs = Vs + 64 * 65; LAS float* Ps = Qs + 64 * 64; LAS float* cks = Ps + 8 * 64;
    const bf16* Q = (const bf16*)(C.ws + WS_R1) + (size_t)2 * T * 512; const bf16* Kb = Q + (size_t)T * 512; const bf16* Vb = Kb + (size_t)T * 512;
    bf16* O = (bf16*)(C.ws + WS_R2); const float* c2k = (const float*)(C.ws + WS_C2K);
    for (int u = blockIdx.x; u < NB * NH * 64; u += gridDim.x) {
        const int qt = 63 - (u >> 5), bh = u & 31, b = bh >> 3, h = bh & 7, q0 = 64 * qt;
        const float* ck = c2k + (size_t)bh * S;
        __syncthreads();
        for (int e = C.tid; e < 64 * 64; e += 512) { const int r = e >> 6, d = e & 63; Qs[r * 64 + d] = bf2f(Q[(size_t)(b * S + q0 + r) * 512 + h * 64 + d]); }
        float m[8], lsum[8], o[8], cq[8];
#pragma unroll
        for (int i = 0; i < 8; ++i) { m[i] = -INFINITY; lsum[i] = 0.f; o[i] = 0.f; cq[i] = ck[q0 + C.wave * 8 + i]; }
        for (int kt = 0; kt <= qt; ++kt) {
            const int k0 = 64 * kt;
            __syncthreads();
            for (int e = C.tid; e < 64 * 64; e += 512) { const int r = e >> 6, d = e & 63; const size_t g = (size_t)(b * S + k0 + r) * 512 + h * 64 + d; Ks[r * 65 + d] = bf2f(Kb[g]); Vs[r * 65 + d] = bf2f(Vb[g]); }
            if (C.tid < 64) cks[C.tid] = ck[k0 + C.tid];
            __syncthreads();
#pragma unroll
            for (int i = 0; i < 8; ++i) {
                const int q = C.wave * 8 + i, qg = q0 + q;
                float dot = 0.f;
#pragma unroll 16
                for (int d = 0; d < 64; ++d) dot += Qs[q * 64 + d] * Ks[C.lane * 65 + d];
                float s = dot + cq[i] - cks[C.lane];
                if (k0 + C.lane > qg) s = -INFINITY;
                const float mn = fmaxf(m[i], wave_max(s));
                const float alpha = exp2f(m[i] - mn), p = exp2f(s - mn);
                lsum[i] = lsum[i] * alpha + wave_sum(p); m[i] = mn;
                Ps[C.wave * 64 + C.lane] = p;
                asm volatile("s_waitcnt lgkmcnt(0)" ::: "memory");
                float acc = 0.f;
#pragma unroll 16
                for (int k = 0; k < 64; ++k) acc += Ps[C.wave * 64 + k] * Vs[k * 65 + C.lane];
                o[i] = o[i] * alpha + acc;
                asm volatile("s_waitcnt lgkmcnt(0)" ::: "memory");
            }
        }
#pragma unroll
        for (int i = 0; i < 8; ++i) O[(size_t)(b * S + q0 + C.wave * 8 + i) * 512 + h * 64 + C.lane] = (bf16)f2bf(o[i] / lsum[i]);
    }
}

__device__ __forceinline__ void phase_mixnorm_naive(Ctx& C, KA AR, int l) {
    const float* YR = (const float*)(C.ws + WS_PROJ); const bf16* O = (const bf16*)(C.ws + WS_R2); bf16* YM = (bf16*)(C.ws + WS_R2 + 16 * MiB);
    const float* g1 = AR->in[I_LRUN] + l * DR; const float* g2 = AR->in[I_ATTN] + l * DA;
    for (int t = C.gw; t < T; t += C.ngw) {
        f32x4 a[2]; float s = 0.f;
#pragma unroll
        for (int j = 0; j < 2; ++j) { a[j] = *((const f32x4*)(YR + (size_t)t * 512) + C.lane + 64 * j); s += (a[j].x * a[j].x + a[j].y * a[j].y) + (a[j].z * a[j].z + a[j].w * a[j].w); }
        float rs = rsqrtf(wave_sum(s) * (1.f / 512.f) + EPS);
#pragma unroll
        for (int j = 0; j < 2; ++j) { const f32x4 g = *((const f32x4*)g1 + C.lane + 64 * j); const f32x4 v = a[j] * rs * g; v2u w; w.x = pk2(v.x, v.y); w.y = pk2(v.z, v.w);
            *((v2u*)(YM + (size_t)t * D) + C.lane + 64 * j) = w; }
        const v4u w = *(const v4u*)(O + (size_t)t * 512 + 8 * C.lane);
        float x[8] = {bflo(w.x), bfhi(w.x), bflo(w.y), bfhi(w.y), bflo(w.z), bfhi(w.z), bflo(w.w), bfhi(w.w)};
        s = 0.f;
#pragma unroll
        for (int e = 0; e < 8; ++e) s += x[e] * x[e];
        rs = rsqrtf(wave_sum(s) * (1.f / 512.f) + EPS);
#pragma unroll
        for (int e = 0; e < 8; ++e) x[e] = x[e] * rs * g2[8 * C.lane + e];
        v4u o; o.x = pk2(x[0], x[1]); o.y = pk2(x[2], x[3]); o.z = pk2(x[4], x[5]); o.w = pk2(x[6], x[7]);
        *(v4u*)(YM + (size_t)t * D + 512 + 8 * C.lane) = o;
    }
}

__device__ __forceinline__ void phase_wo_naive(Ctx& C, KA AR, int l) {
    const bf16* A = (const bf16*)(C.ws + WS_R2 + 16 * MiB); const bf16* Bt = (const bf16*)(C.ws + WS_WOUT) + (size_t)l * D * D;
    const float* xs = l == 0 ? AR->in[I_X] : (const float*)(C.ws + WS_X); float* X = (float*)(C.ws + WS_X);
    for (int u = blockIdx.x; u < (T / 64) * (D / 64); u += gridDim.x) {
        const int m0 = 64 * (u / (D / 64)), n0 = 64 * (u % (D / 64));
        ngemm_tile<1>((LAS float*)C.lds, D, [=](int r) { return A + (size_t)(m0 + r) * D; }, [=](int c, int) { return Bt + (size_t)(n0 + c) * D; },
            [=](int r, int c, float v, float) { const size_t i = (size_t)(m0 + r) * D + n0 + c; X[i] = xs[i] + v; }, C.tid);
    }
}

__device__ __forceinline__ void phase_router(Ctx& C, KA AR, int l) {
    const float* X = (const float*)(C.ws + WS_X); bf16* xn = (bf16*)(C.ws + WS_XN);
    const float* gain = AR->in[I_FFNN] + l * D; const float* wg = AR->in[I_WG] + (size_t)l * D * 4; const float* bg = AR->in[I_BG] + l * 4;
    const float* wr = AR->in[I_WRT] + (size_t)l * D * NE; const float* brt = AR->in[I_BRT] + l * NE;
    unsigned* cnt = (unsigned*)(C.ws + WS_CTL) + CW_CNT + 64 * l; int* rowpair = (int*)(C.ws + WS_ROWPAIR); float* pairw = (float*)(C.ws + WS_PAIRW);
    for (int t = C.gw; t < T; t += C.ngw) {
        f32x4 v[4]; load_row(X + (size_t)t * D, C.lane, v);
        const float rs = row_rs(v); scale_row(v, rs, gain, C.lane);
        store_row_bf16(xn + (size_t)t * D, C.lane, v);
        LAS float* rowl = (LAS float*)C.lds + C.wave * 1024;
#pragma unroll
        for (int j = 0; j < 4; ++j) *((LAS f32x4*)rowl + C.lane + 64 * j) = v[j];
        asm volatile("s_waitcnt lgkmcnt(0)" ::: "memory");
        float acc = 0.f;
        if (C.lane < 36) {
            const float* wp = C.lane < 32 ? wr + C.lane : wg + (C.lane - 32); const int st = C.lane < 32 ? NE : 4;
#pragma unroll 8
            for (int k = 0; k < D; ++k) acc += rowl[k] * wp[(size_t)k * st];
            acc += C.lane < 32 ? brt[C.lane] : bg[C.lane - 32];
        }
        asm volatile("s_waitcnt lgkmcnt(0)" ::: "memory");
        float gl[4];
#pragma unroll
        for (int i = 0; i < 4; ++i) gl[i] = __builtin_bit_cast(float, __builtin_amdgcn_readlane(__builtin_bit_cast(int, acc), 32 + i));
        int gi = 0; float gm = gl[0];
#pragma unroll
        for (int i = 1; i < 4; ++i) if (gl[i] > gm) { gm = gl[i]; gi = i; }
        float gs = 0.f;
#pragma unroll
        for (int i = 0; i < 4; ++i) gs += __expf(gl[i] - gm);
        const float gp = 1.f / gs;
        float ev[8];
#pragma unroll
        for (int i = 0; i < 8; ++i) ev[i] = __builtin_bit_cast(float, __builtin_amdgcn_readlane(__builtin_bit_cast(int, acc), __builtin_amdgcn_readfirstlane(gi) * 8 + i));
        int i0 = 0; float t0 = ev[0];
#pragma unroll
        for (int i = 1; i < 8; ++i) if (ev[i] > t0) { t0 = ev[i]; i0 = i; }
        int i1 = -1; float t1 = -INFINITY;
#pragma unroll
        for (int i = 0; i < 8; ++i) if (i != i0 && ev[i] > t1) { t1 = ev[i]; i1 = i; }
        const float ex = __expf(t1 - t0), w0 = gp / (1.f + ex), w1 = gp * ex / (1.f + ex);
        if (C.lane < 2) { const int e = gi * 8 + (C.lane == 0 ? i0 : i1); const unsigned pos = atomicAdd(cnt + e, 1u);
            rowpair[(size_t)e * CAP + pos] = 2 * t + C.lane; pairw[2 * t + C.lane] = C.lane == 0 ? w0 : w1; }
    }
}

struct ExpTab { int n[NE], hoff[NE], t0[NE + 1]; };
__device__ __forceinline__ void build_exptab(Ctx& C, int l, LAS int* tab) {
    __syncthreads();
    if (C.tid == 0) { const unsigned* cnt = (const unsigned*)(C.ws + WS_CTL) + CW_CNT + 64 * l; int ho = 0, tt = 0;
        for (int e = 0; e < NE; ++e) { const int n = (int)__hip_atomic_load(cnt + e, __ATOMIC_RELAXED, __HIP_MEMORY_SCOPE_AGENT); tab[e] = n; tab[32 + e] = ho; tab[64 + e] = tt; ho += (n + 255) & ~255; tt += (n + 63) >> 6; }
        tab[64 + NE] = tt; }
    __syncthreads();
}
__device__ __forceinline__ void phase_g1_naive(Ctx& C, KA AR, int l) {
    LAS int* tab = (LAS int*)(C.lds + 65536); build_exptab(C, l, tab);
    const bf16* xn = (const bf16*)(C.ws + WS_XN); const int* rowpair = (const int*)(C.ws + WS_ROWPAIR); bf16* Hb = (bf16*)(C.ws + WS_R2);
    const int nmt = tab[64 + NE];
    for (int u = blockIdx.x; u < nmt * 8; u += gridDim.x) {
        const int mtg = u >> 3, nt = u & 7; int e = 0;
        for (int i = 1; i < NE; ++i) if (tab[64 + i] <= mtg) e = i;
        const int mt = mtg - tab[64 + e], ne = tab[e], ho = tab[32 + e], p0 = 64 * mt, c0 = 64 * nt;
        const bf16* Bt = (const bf16*)(C.ws + WS_WGU) + (size_t)(l * NE + e) * 1024 * D; const int* rp = rowpair + (size_t)e * CAP;
        ngemm_tile<2>((LAS float*)C.lds, D,
            [=](int r) { return (p0 + r < ne) ? xn + (size_t)(rp[p0 + r] >> 1) * D : (const bf16*)nullptr; },
            [=](int c, int a) { const int cc = c0 + c; return Bt + (size_t)((cc >> 7) * 256 + (cc & 127) + a * 128) * D; },
            [=](int r, int c, float g, float uu) { if (p0 + r < ne) Hb[(size_t)(ho + p0 + r) * DE + c0 + c] = (bf16)f2bf(g / (1.f + __expf(-g)) * uu); }, C.tid);
    }
}
__device__ __forceinline__ void phase_g2_naive(Ctx& C, KA AR, int l) {
    LAS int* tab = (LAS int*)(C.lds + 65536); build_exptab(C, l, tab);
    const int* rowpair = (const int*)(C.ws + WS_ROWPAIR); const float* pairw = (const float*)(C.ws + WS_PAIRW); const bf16* Hb = (const bf16*)(C.ws + WS_R2); bf16* Y2 = (bf16*)(C.ws + WS_R1);
    const int nmt = tab[64 + NE];
    for (int u = blockIdx.x; u < nmt * 16; u += gridDim.x) {
        const int mtg = u >> 4, nt = u & 15; int e = 0;
        for (int i = 1; i < NE; ++i) if (tab[64 + i] <= mtg) e = i;
        const int mt = mtg - tab[64 + e], ne = tab[e], ho = tab[32 + e], p0 = 64 * mt, c0 = 64 * nt;
        const bf16* Bt = (const bf16*)(C.ws + WS_WDN) + (size_t)(l * NE + e) * D * DE; const int* rp = rowpair + (size_t)e * CAP;
        ngemm_tile<1>((LAS float*)C.lds, DE,
            [=](int r) { return (p0 + r < ne) ? Hb + (size_t)(ho + p0 + r) * DE : (const bf16*)nullptr; },
            [=](int c, int) { return Bt + (size_t)(c0 + c) * DE; },
            [=](int r, int c, float v, float) { if (p0 + r < ne) { const int p = rp[p0 + r]; Y2[(size_t)p * D + c0 + c] = (bf16)f2bf(v * pairw[p]); } }, C.tid);
    }
}

__device__ __forceinline__ void phase_combine(Ctx& C, KA AR, int l) {
    float* X = (float*)(C.ws + WS_X); const bf16* Y2 = (const bf16*)(C.ws + WS_R1); bf16* xn = (bf16*)(C.ws + WS_XN); const float* gain = AR->in[I_PLEN] + l * D;
    for (int t = C.gw; t < T; t += C.ngw) {
        f32x4 v[4]; load_row(X + (size_t)t * D, C.lane, v);
#pragma unroll
        for (int j = 0; j < 4; ++j) { const v2u a = *((const v2u*)(Y2 + (size_t)(2 * t) * D) + C.lane + 64 * j), b = *((const v2u*)(Y2 + (size_t)(2 * t + 1) * D) + C.lane + 64 * j);
            v[j].x += bflo(a.x) + bflo(b.x); v[j].y += bfhi(a.x) + bfhi(b.x); v[j].z += bflo(a.y) + bflo(b.y); v[j].w += bfhi(a.y) + bfhi(b.y);
            *((f32x4*)(X + (size_t)t * D) + C.lane + 64 * j) = v[j]; }
        const float rs = row_rs(v); scale_row(v, rs, gain, C.lane);
        store_row_bf16(xn + (size_t)t * D, C.lane, v);
    }
}

__device__ __forceinline__ void phase_proj_naive(Ctx& C, KA AR, int l) {
    const bf16* A = (const bf16*)(C.ws + WS_PB) + (size_t)l * T * PLE; const bf16* Bt = (const bf16*)(C.ws + WS_WPP) + (size_t)l * D * PLE; bf16* PR = (bf16*)(C.ws + WS_PROJ);
    for (int u = blockIdx.x; u < (T / 64) * (D / 64); u += gridDim.x) {
        const int m0 = 64 * (u / (D / 64)), n0 = 64 * (u % (D / 64));
        ngemm_tile<1>((LAS float*)C.lds, PLE, [=](int r) { return A + (size_t)(m0 + r) * PLE; }, [=](int c, int) { return Bt + (size_t)(n0 + c) * PLE; },
            [=](int r, int c, float v, float) { PR[(size_t)(m0 + r) * D + n0 + c] = (bf16)f2bf(v); }, C.tid);
    }
}
__device__ __forceinline__ void phase_ple_naive(Ctx& C, KA AR, int l) {
    const bf16* A = (const bf16*)(C.ws + WS_XN); const bf16* Bt = (const bf16*)(C.ws + WS_WPG) + (size_t)l * D * D; const bf16* PR = (const bf16*)(C.ws + WS_PROJ);
    const float* X = (const float*)(C.ws + WS_X); float* dst = l == DEPTH - 1 ? AR->out : (float*)(C.ws + WS_X); const float* bias = AR->in[I_BPG] + l * D;
    for (int u = blockIdx.x; u < (T / 64) * (D / 64); u += gridDim.x) {
        const int m0 = 64 * (u / (D / 64)), n0 = 64 * (u % (D / 64));
        ngemm_tile<1>((LAS float*)C.lds, D, [=](int r) { return A + (size_t)(m0 + r) * D; }, [=](int c, int) { return Bt + (size_t)(n0 + c) * D; },
            [=](int r, int c, float v, float) { const size_t i = (size_t)(m0 + r) * D + n0 + c; dst[i] = X[i] + bf2f(PR[i]) * sigmoidf_(v + bias[n0 + c]); }, C.tid);
    }
}

namespace pg8 {
typedef unsigned short bf16_t;
typedef short bf16x8 __attribute__((ext_vector_type(8)));
typedef unsigned u32x4 __attribute__((ext_vector_type(4)));
constexpr int BM = 256, BK = 64, HALF = 128, HTB = HALF * BK * 2, STAGE_BYTES = 8 * HTB, NXCD = 8, WGM = 8;
__device__ __forceinline__ int lds_byte(int r, int c) { const int st = (r >> 4) * 2 + (c >> 5), rr = r & 15, cc = c & 31, ob = rr * 64 + cc * 2; return st * 1024 + (ob ^ (((ob >> 9) & 1) << 5)); }
__device__ __forceinline__ void stage_rc(int b, int& R, int& C) { const int st = b / 1024, sb = b % 1024, swz = sb ^ (((sb >> 9) & 1) << 5); R = (st >> 1) * 16 + swz / 64; C = (st & 1) * 32 + (swz % 64) / 2; }
__device__ __forceinline__ int perm32(int rho) { const int n = rho >> 4, i = rho & 15; return 8 * (i >> 2) + 4 * n + (i & 3); }
struct Unit { int pm, pn, e, aux, mt; };
struct Gemm { const bf16_t* A; const bf16_t* Bt; int K; };
struct StaticOrder {
    int nM, nN, nwg, G, c;
    __device__ void init(int M, int N, int G_, int c_) { nM = M / BM; nN = N / BM; nwg = nM * nN; G = G_; c = c_; }
    __device__ bool next(int i, Unit& u) const {
        const long L = (long)i * G + c; if (L >= nwg) return false;
        int wgid = (int)L; { const int q = nwg / NXCD, r = nwg % NXCD, xcd = wgid % NXCD, off = wgid / NXCD; wgid = (xcd < r ? xcd * (q + 1) : r * (q + 1) + (xcd - r) * q) + off; }
        const int nig = WGM * nN, gid = wgid / nig, fm = gid * WGM, gsz = (nM - fm) < WGM ? (nM - fm) : WGM;
        u.pm = fm + ((wgid % nig) % gsz); u.pn = (wgid % nig) / gsz; u.e = 0; u.aux = 256; u.mt = 0; return true;
    }
    __device__ __forceinline__ const char* a_base(const Gemm& g, const Unit& u) const { return (const char*)g.A + (size_t)u.pm * 512 * g.K; }
    __device__ __forceinline__ const char* b_base(const Gemm& g, const Unit& u) const { return (const char*)g.Bt + (size_t)u.pn * 512 * g.K; }
    __device__ __forceinline__ int a_row(const Unit&, int) const { return 0; }
};
__device__ __forceinline__ unsigned cvt_pk_bf16(float lo, float hi) { unsigned r; asm volatile("v_cvt_pk_bf16_f32 %0, %1, %2" : "=v"(r) : "v"(lo), "v"(hi)); return r; }

template <class Epi, class Sched, bool ALIGN_EPI, bool GATHER>
__device__ __forceinline__ void gemm_phase(LAS unsigned char* lds, const Gemm g, const Sched& S, const Epi& E, const int tid) {
    const int wid = __builtin_amdgcn_readfirstlane(tid >> 6), lane = tid & 63, wr = wid >> 2, wc = wid & 3, fr = lane & 15, fq = lane >> 4;
    const int K = g.K, nt = K / BK;
    unsigned voffB[2];
#pragma unroll
    for (int i = 0; i < 2; ++i) { int R, C; stage_rc(tid * 16 + i * 8192, R, C); const int Rb = Epi::PERM ? ((R & ~31) + perm32(R & 31)) : R; voffB[i] = (unsigned)(Rb * K + C) * 2u; }
    const size_t kstep = (size_t)(BK * 2);
    const size_t hstep = (size_t)HALF * K * 2;
    const size_t hsA = GATHER ? 0 : hstep;
    const unsigned ldsw = (unsigned)wid * 1024u;
    const int aoff = lds_byte(wr * 64 + fr, fq * 8), boff = lds_byte(wc * 32 + fr, fq * 8);
#define PG8_SA(b, h) (((b) * 2 + (h)) * HTB)
#define PG8_SB(b, h) ((4 + (b) * 2 + (h)) * HTB)
#define PG8_STAGE(bufoff, gbase, voff) do { _Pragma("unroll") for (int _i = 0; _i < 2; ++_i) \
        __builtin_amdgcn_global_load_lds((const unsigned*)((const char*)(gbase) + (voff)[_i]), (LAS unsigned*)(lds + (bufoff) + ldsw + _i * 8192), 16, 0, 0); } while (0)
#define PG8_LDA(dst, b, h) do { _Pragma("unroll") for (int m = 0; m < 4; ++m) _Pragma("unroll") for (int k = 0; k < 2; ++k) dst[m][k] = *(const LAS bf16x8*)(lds + PG8_SA(b, h) + aoff + m * 2048 + k * 1024); } while (0)
#define PG8_LDB(dst, b, h) do { _Pragma("unroll") for (int n = 0; n < 2; ++n) _Pragma("unroll") for (int k = 0; k < 2; ++k) dst[n][k] = *(const LAS bf16x8*)(lds + PG8_SB(b, h) + boff + n * 2048 + k * 1024); } while (0)
#define PG8_MMA(ai, bj, At, Bt) do { __builtin_amdgcn_s_setprio(1); _Pragma("unroll") for (int m = 0; m < 4; ++m) _Pragma("unroll") for (int n = 0; n < 2; ++n) _Pragma("unroll") for (int k = 0; k < 2; ++k) \
        acc[ai][bj][m][n] = __builtin_amdgcn_mfma_f32_16x16x32_bf16(Bt[n][k], At[m][k], acc[ai][bj][m][n], 0, 0, 0); __builtin_amdgcn_s_setprio(0); } while (0)
#define PG8_WAIT_V(n) asm volatile("s_waitcnt vmcnt(" #n ")" ::: "memory")
#define PG8_WAIT_L(n) asm volatile("s_waitcnt lgkmcnt(" #n ")" ::: "memory")
#define PG8_BAR __builtin_amdgcn_s_barrier()
#define PG8_SCHED __builtin_amdgcn_sched_barrier(0)
#define PG8_VOFF(dst, u) do { int t_ = tid; if (GATHER) asm volatile("" : "+v"(t_));   \
        _Pragma("unroll") for (int i_ = 0; i_ < 2; ++i_) { int R_, C_; stage_rc(t_ * 16 + i_ * 8192, R_, C_); _Pragma("unroll") for (int h_ = 0; h_ < 2; ++h_) \
        dst[h_][i_] = GATHER ? (unsigned)(S.a_row(u, h_ * HALF + R_) * K + C_) * 2u : (unsigned)(R_ * K + C_) * 2u; } } while (0)
    Unit cur, nxt; int ui = 0;
    if (!S.next(0, cur)) return;
    f32x4 acc[2][2][4][2];
#pragma unroll
    for (int a = 0; a < 2; ++a)
#pragma unroll
        for (int b = 0; b < 2; ++b)
#pragma unroll
            for (int m = 0; m < 4; ++m)
#pragma unroll
                for (int n = 0; n < 2; ++n) acc[a][b][m][n] = (f32x4){0.f, 0.f, 0.f, 0.f};
    bf16x8 At[4][2], B0[2][2], B1[2][2];
    unsigned vC[2][2], vN[2][2], vX[2][2];
    PG8_VOFF(vC, cur);
    const char* cA = S.a_base(g, cur); const char* cB = S.b_base(g, cur);
    PG8_STAGE(PG8_SB(0, 0), cB, voffB); PG8_STAGE(PG8_SB(0, 1), cB + hstep, voffB); PG8_STAGE(PG8_SA(0, 0), cA, vC[0]); PG8_STAGE(PG8_SA(0, 1), cA + hsA, vC[1]);
    if (wr == 1) PG8_BAR;
    PG8_WAIT_V(2); PG8_BAR;
    PG8_STAGE(PG8_SB(1, 0), cB + kstep, voffB); PG8_STAGE(PG8_SA(1, 0), cA + kstep, vC[0]); PG8_STAGE(PG8_SB(1, 1), cB + hstep + kstep, voffB);
    PG8_WAIT_V(6); PG8_BAR;
    for (;;) {
        const bool has_next = S.next(ui + 1, nxt);
        const char* nA = has_next ? S.a_base(g, nxt) : cA; const char* nB = has_next ? S.b_base(g, nxt) : cB;
        if (GATHER && has_next) { PG8_VOFF(vN, nxt); }
        else {
#pragma unroll
            for (int h_ = 0; h_ < 2; ++h_)
#pragma unroll
                for (int i_ = 0; i_ < 2; ++i_) vN[h_][i_] = vC[h_][i_]; }
#pragma unroll 1
        for (int t = 0; t < nt; t += 2) {
            const bool last = (t == nt - 2);
            const char* a1 = cA + (size_t)(t + 1) * kstep;
            const char* a2 = last ? nA : cA + (size_t)(t + 2) * kstep; const char* b2 = last ? nB : cB + (size_t)(t + 2) * kstep;
            const char* a3 = a2 + kstep; const char* b3 = b2 + kstep;
#pragma unroll
            for (int h_ = 0; h_ < 2; ++h_)
#pragma unroll
                for (int i_ = 0; i_ < 2; ++i_) vX[h_][i_] = (GATHER && last) ? vN[h_][i_] : vC[h_][i_];
            PG8_LDB(B0, 0, 0); PG8_LDB(B1, 0, 1); PG8_SCHED; PG8_LDA(At, 0, 0); PG8_STAGE(PG8_SA(1, 1), a1 + hsA, vC[1]);
            PG8_WAIT_V(8); PG8_WAIT_L(0); PG8_BAR; PG8_MMA(0, 0, At, B0); PG8_MMA(0, 1, At, B1); PG8_BAR; PG8_SCHED;
            PG8_LDA(At, 0, 1); PG8_STAGE(PG8_SB(0, 0), b2, voffB); PG8_STAGE(PG8_SB(0, 1), b2 + hstep, voffB); PG8_STAGE(PG8_SA(0, 0), a2, vX[0]);
            PG8_WAIT_V(8); PG8_WAIT_L(0); PG8_BAR; PG8_MMA(1, 0, At, B0); PG8_MMA(1, 1, At, B1); PG8_BAR; PG8_SCHED;
            PG8_LDB(B0, 1, 0); PG8_LDB(B1, 1, 1); PG8_SCHED; PG8_LDA(At, 1, 0); PG8_STAGE(PG8_SA(0, 1), a2 + hsA, vX[1]);
            PG8_WAIT_V(8); PG8_WAIT_L(0); PG8_BAR; PG8_MMA(0, 0, At, B0); PG8_MMA(0, 1, At, B1); PG8_BAR; PG8_SCHED;
            PG8_LDA(At, 1, 1); PG8_STAGE(PG8_SB(1, 0), b3, voffB); PG8_STAGE(PG8_SB(1, 1), b3 + hstep, voffB); PG8_STAGE(PG8_SA(1, 0), a3, vX[0]);
            PG8_WAIT_V(8); PG8_WAIT_L(0); PG8_BAR; PG8_MMA(1, 0, At, B0); PG8_MMA(1, 1, At, B1); PG8_BAR; PG8_SCHED;
        }
        if constexpr (ALIGN_EPI) { if (wr == 0) PG8_BAR; }
        E(acc, cur, wr, wc, fr, fq);
        if (!has_next) break;
#pragma unroll
        for (int a = 0; a < 2; ++a)
#pragma unroll
            for (int b = 0; b < 2; ++b)
#pragma unroll
                for (int m = 0; m < 4; ++m)
#pragma unroll
                    for (int n = 0; n < 2; ++n) acc[a][b][m][n] = (f32x4){0.f, 0.f, 0.f, 0.f};
        cur = nxt; cA = nA; cB = nB; ++ui;
#pragma unroll
        for (int h_ = 0; h_ < 2; ++h_)
#pragma unroll
            for (int i_ = 0; i_ < 2; ++i_) vC[h_][i_] = vN[h_][i_];
        if constexpr (ALIGN_EPI) { if (wr == 1) PG8_BAR; }
    }
    PG8_WAIT_V(0);
    if constexpr (!ALIGN_EPI) { if (wr == 0) PG8_BAR; }
    PG8_BAR;
#undef PG8_SA
#undef PG8_SB
#undef PG8_STAGE
#undef PG8_LDA
#undef PG8_LDB
#undef PG8_MMA
#undef PG8_WAIT_V
#undef PG8_WAIT_L
#undef PG8_BAR
#undef PG8_SCHED
#undef PG8_VOFF
}
}

__device__ __forceinline__ float gelu_fast(float v) { const float y = 0.7978845608028654f * (v + 0.044715f * v * v * v); return v * __builtin_amdgcn_rcpf(1.f + __expf(-2.f * y)); }
__device__ __forceinline__ float sigmoid_fast(float v) { return __builtin_amdgcn_rcpf(1.f + __expf(-v)); }

struct EpiZ {
    static constexpr bool PERM = true;
    bf16* R1; const float* gq; const float* gk;
    __device__ __forceinline__ void operator()(const f32x4 (&acc)[2][2][4][2], const pg8::Unit& u, int wr, int wc, int fr, int fq) const {
        const int seg = u.pn >> 1;
        bf16* base = R1 + (size_t)seg * T * 512 + (size_t)(u.pm * 256 + wr * 64 + fr) * 512 + (u.pn & 1) * 256 + wc * 64 + 8 * fq;
        if (seg == 2 || seg == 3) {
            const float* g = seg == 2 ? gq : gk; const float sc = seg == 2 ? C2 : 1.f;
            f32x4 gv[2][2];
#pragma unroll
            for (int bj = 0; bj < 2; ++bj)
#pragma unroll
                for (int n = 0; n < 2; ++n) gv[bj][n] = *(const f32x4*)(g + 32 * bj + 8 * fq + 4 * n);
#pragma unroll
            for (int ai = 0; ai < 2; ++ai)
#pragma unroll
                for (int m = 0; m < 4; ++m) {
                    float s = 0.f;
#pragma unroll
                    for (int bj = 0; bj < 2; ++bj)
#pragma unroll
                        for (int n = 0; n < 2; ++n) { const f32x4 x = acc[ai][bj][m][n]; s += (x[0] * x[0] + x[1] * x[1]) + (x[2] * x[2] + x[3] * x[3]); }
                    s += lane_xor<16>(s); s = half_sum32(s);
                    const float rs = rsqrtf(s * (1.f / 64.f) + EPS) * sc;
#pragma unroll
                    for (int bj = 0; bj < 2; ++bj) { const f32x4 v0 = acc[ai][bj][m][0] * rs * gv[bj][0], v1 = acc[ai][bj][m][1] * rs * gv[bj][1];
                        v4u w; w.x = pg8::cvt_pk_bf16(v0[0], v0[1]); w.y = pg8::cvt_pk_bf16(v0[2], v0[3]); w.z = pg8::cvt_pk_bf16(v1[0], v1[1]); w.w = pg8::cvt_pk_bf16(v1[2], v1[3]);
                        *(v4u*)(base + (size_t)(ai * 128 + m * 16) * 512 + 32 * bj) = w; }
                }
        } else {
#pragma unroll
            for (int ai = 0; ai < 2; ++ai)
#pragma unroll
                for (int m = 0; m < 4; ++m)
#pragma unroll
                    for (int bj = 0; bj < 2; ++bj) { f32x4 v0 = acc[ai][bj][m][0], v1 = acc[ai][bj][m][1];
                        if (seg == 1) { v0 = (f32x4){gelu_fast(v0[0]), gelu_fast(v0[1]), gelu_fast(v0[2]), gelu_fast(v0[3])}; v1 = (f32x4){gelu_fast(v1[0]), gelu_fast(v1[1]), gelu_fast(v1[2]), gelu_fast(v1[3])}; }
                        v4u w; w.x = pg8::cvt_pk_bf16(v0[0], v0[1]); w.y = pg8::cvt_pk_bf16(v0[2], v0[3]); w.z = pg8::cvt_pk_bf16(v1[0], v1[1]); w.w = pg8::cvt_pk_bf16(v1[2], v1[3]);
                        *(v4u*)(base + (size_t)(ai * 128 + m * 16) * 512 + 32 * bj) = w; }
        }
    }
};
__device__ __forceinline__ void phase_gemm1_fast(Ctx& C, KA AR, int l) {
    phase_cumsum(C, AR);
    pg8::Gemm g{(const bf16*)(C.ws + WS_XN), (const bf16*)(C.ws + WS_WIN) + (size_t)l * NZ * D, D};
    pg8::StaticOrder S; S.init(T, NZ, gridDim.x, blockIdx.x);
    EpiZ E{(bf16*)(C.ws + WS_R1), AR->in[I_QN] + l * HD, AR->in[I_KN] + l * HD};
    pg8::gemm_phase<EpiZ, pg8::StaticOrder, true, false>(C.lds, g, S, E, C.tid);
}
struct EpiRes {
    static constexpr bool PERM = false;
    const float* xs; float* X;
    __device__ __forceinline__ void operator()(const f32x4 (&acc)[2][2][4][2], const pg8::Unit& u, int wr, int wc, int fr, int fq) const {
        const size_t off0 = (size_t)(u.pm * 256 + wr * 64 + fr) * D + u.pn * 256 + wc * 32 + 4 * fq;
#pragma unroll
        for (int ai = 0; ai < 2; ++ai)
#pragma unroll
            for (int m = 0; m < 4; ++m)
#pragma unroll
                for (int bj = 0; bj < 2; ++bj)
#pragma unroll
                    for (int n = 0; n < 2; ++n) { const size_t o = off0 + (size_t)(ai * 128 + m * 16) * D + bj * 128 + n * 16; *(f32x4*)(X + o) = *(const f32x4*)(xs + o) + acc[ai][bj][m][n]; }
    }
};
__device__ __forceinline__ void phase_wo_fast(Ctx& C, KA AR, int l) {
    pg8::Gemm g{(const bf16*)(C.ws + WS_R2 + 16 * MiB), (const bf16*)(C.ws + WS_WOUT) + (size_t)l * D * D, D};
    pg8::StaticOrder S; S.init(T, D, gridDim.x, blockIdx.x);
    EpiRes E{l == 0 ? AR->in[I_X] : (const float*)(C.ws + WS_X), (float*)(C.ws + WS_X)};
    pg8::gemm_phase<EpiRes, pg8::StaticOrder, true, false>(C.lds, g, S, E, C.tid);
}
struct EpiProj {
    static constexpr bool PERM = true;
    bf16* PR;
    __device__ __forceinline__ void operator()(const f32x4 (&acc)[2][2][4][2], const pg8::Unit& u, int wr, int wc, int fr, int fq) const {
        bf16* base = PR + (size_t)(u.pm * 256 + wr * 64 + fr) * D + u.pn * 256 + wc * 32 + 8 * fq;
#pragma unroll
        for (int ai = 0; ai < 2; ++ai)
#pragma unroll
            for (int m = 0; m < 4; ++m)
#pragma unroll
                for (int bj = 0; bj < 2; ++bj) { const f32x4 v0 = acc[ai][bj][m][0], v1 = acc[ai][bj][m][1];
                    v4u w; w.x = pg8::cvt_pk_bf16(v0[0], v0[1]); w.y = pg8::cvt_pk_bf16(v0[2], v0[3]); w.z = pg8::cvt_pk_bf16(v1[0], v1[1]); w.w = pg8::cvt_pk_bf16(v1[2], v1[3]);
                    *(v4u*)(base + (size_t)(ai * 128 + m * 16) * D + bj * 128) = w; }
    }
};
__device__ __forceinline__ void phase_proj_fast(Ctx& C, KA AR, int l) {
    pg8::Gemm g{(const bf16*)(C.ws + WS_PB) + (size_t)l * T * PLE, (const bf16*)(C.ws + WS_WPP) + (size_t)l * D * PLE, PLE};
    pg8::StaticOrder S; S.init(T, D, gridDim.x, blockIdx.x);
    EpiProj E{(bf16*)(C.ws + WS_PROJ)};
    pg8::gemm_phase<EpiProj, pg8::StaticOrder, true, false>(C.lds, g, S, E, C.tid);
}
struct EpiPle {
    static constexpr bool PERM = false;
    const float* X; const bf16* PR; const float* bias; float* dst;
    __device__ __forceinline__ void operator()(const f32x4 (&acc)[2][2][4][2], const pg8::Unit& u, int wr, int wc, int fr, int fq) const {
        const int col0 = u.pn * 256 + wc * 32 + 4 * fq;
        const size_t off0 = (size_t)(u.pm * 256 + wr * 64 + fr) * D + col0;
#pragma unroll
        for (int bj = 0; bj < 2; ++bj)
#pragma unroll
            for (int n = 0; n < 2; ++n) { const f32x4 bv = *(const f32x4*)(bias + col0 + bj * 128 + n * 16);
#pragma unroll
                for (int ai = 0; ai < 2; ++ai)
#pragma unroll
                    for (int m = 0; m < 4; ++m) { const size_t o = off0 + (size_t)(ai * 128 + m * 16) * D + bj * 128 + n * 16;
                        const v2u pw = *(const v2u*)(PR + o); const f32x4 a = acc[ai][bj][m][n] + bv; const f32x4 x = *(const f32x4*)(X + o);
                        f32x4 r; r[0] = x[0] + bflo(pw.x) * sigmoid_fast(a[0]); r[1] = x[1] + bfhi(pw.x) * sigmoid_fast(a[1]); r[2] = x[2] + bflo(pw.y) * sigmoid_fast(a[2]); r[3] = x[3] + bfhi(pw.y) * sigmoid_fast(a[3]);
                        *(f32x4*)(dst + o) = r; } }
    }
};
__device__ __forceinline__ void phase_ple_fast(Ctx& C, KA AR, int l) {
    pg8::Gemm g{(const bf16*)(C.ws + WS_XN), (const bf16*)(C.ws + WS_WPG) + (size_t)l * D * D, D};
    pg8::StaticOrder S; S.init(T, D, gridDim.x, blockIdx.x);
    EpiPle E{(const float*)(C.ws + WS_X), (const bf16*)(C.ws + WS_PROJ), AR->in[I_BPG] + l * D, l == DEPTH - 1 ? AR->out : (float*)(C.ws + WS_X)};
    pg8::gemm_phase<EpiPle, pg8::StaticOrder, true, false>(C.lds, g, S, E, C.tid);
}
constexpr int TAB_OFF = MISC_OFF + 128;
struct GroupOrder {
    const LAS int* tab; int G, c; const int* rowpair; const char* hbase; bool is_g2;
    __device__ bool next(int i, pg8::Unit& u) const {
        const int L = i * G + c, mtg = L >> 2; if (mtg >= __builtin_amdgcn_readfirstlane(tab[64 + NE])) return false;
        const int pk = __builtin_amdgcn_readfirstlane(tab[128 + mtg]);
        const int e = pk & 255, mt = pk >> 8; const int ne = __builtin_amdgcn_readfirstlane(tab[e]), ho = __builtin_amdgcn_readfirstlane(tab[32 + e]);
        int nv = ne - 256 * mt; nv = nv > 256 ? 256 : nv;
        u.pm = ho + 256 * mt; u.pn = L & 3; u.e = e; u.aux = nv; u.mt = mt; return true;
    }
    __device__ __forceinline__ const char* a_base(const pg8::Gemm& g, const pg8::Unit& u) const { return is_g2 ? (const char*)g.A + (size_t)u.pm * 2 * g.K : (const char*)g.A; }
    __device__ __forceinline__ const char* b_base(const pg8::Gemm& g, const pg8::Unit& u) const { return (const char*)g.Bt + (size_t)(u.e * 1024 + u.pn * 256) * 2 * g.K; }
    __device__ __forceinline__ int a_row(const pg8::Unit& u, int r) const { return r < u.aux ? (rowpair[(size_t)u.e * CAP + u.mt * 256 + r] >> 1) : 0; }
};
__device__ __forceinline__ void build_exptab256(Ctx& C, int l, LAS int* tab) {
    __syncthreads();
    if (C.tid == 0) { const unsigned* cnt = (const unsigned*)(C.ws + WS_CTL) + CW_CNT + 64 * l; int ho = 0, tt = 0;
        for (int e = 0; e < NE; ++e) { const int n = (int)__hip_atomic_load(cnt + e, __ATOMIC_RELAXED, __HIP_MEMORY_SCOPE_AGENT); tab[e] = n; tab[32 + e] = ho; tab[64 + e] = tt;
            const int nt = (n + 255) >> 8; for (int j = 0; j < nt; ++j) tab[128 + tt + j] = e | (j << 8); ho += nt << 8; tt += nt; }
        tab[64 + NE] = tt; }
    __syncthreads();
}
struct EpiG1 {
    static constexpr bool PERM = true;
    bf16* Hb;
    __device__ __forceinline__ void operator()(const f32x4 (&acc)[2][2][4][2], const pg8::Unit& u, int wr, int wc, int fr, int fq) const {
        bf16* base = Hb + (size_t)(u.pm + wr * 64 + fr) * DE + u.pn * 128 + wc * 32 + 8 * fq;
#pragma unroll
        for (int ai = 0; ai < 2; ++ai)
#pragma unroll
            for (int m = 0; m < 4; ++m) { const int rl = ai * 128 + wr * 64 + m * 16 + fr;
                f32x4 h0, h1;
#pragma unroll
                for (int e = 0; e < 4; ++e) { const float g0 = acc[ai][0][m][0][e], g1 = acc[ai][0][m][1][e]; h0[e] = g0 * sigmoid_fast(g0) * acc[ai][1][m][0][e]; h1[e] = g1 * sigmoid_fast(g1) * acc[ai][1][m][1][e]; }
                v4u w; w.x = pg8::cvt_pk_bf16(h0[0], h0[1]); w.y = pg8::cvt_pk_bf16(h0[2], h0[3]); w.z = pg8::cvt_pk_bf16(h1[0], h1[1]); w.w = pg8::cvt_pk_bf16(h1[2], h1[3]);
                if (rl < u.aux) *(v4u*)(base + (size_t)(ai * 128 + m * 16) * DE) = w; }
    }
};
__device__ __forceinline__ void phase_g1_fast(Ctx& C, KA AR, int l) {
    LAS int* tab = (LAS int*)(C.lds + TAB_OFF); build_exptab256(C, l, tab);
    pg8::Gemm g{(const bf16*)(C.ws + WS_XN), (const bf16*)(C.ws + WS_WGU) + (size_t)l * NE * 1024 * D, D};
    GroupOrder S{tab, (int)gridDim.x, (int)blockIdx.x, (const int*)(C.ws + WS_ROWPAIR), nullptr, false};
    EpiG1 E{(bf16*)(C.ws + WS_R2)};
    pg8::gemm_phase<EpiG1, GroupOrder, true, true>(C.lds, g, S, E, C.tid);
}
struct EpiG2 {
    static constexpr bool PERM = true;
    bf16* Y2; const int* rowpair; const float* pairw;
    __device__ __forceinline__ void operator()(const f32x4 (&acc)[2][2][4][2], const pg8::Unit& u, int wr, int wc, int fr, int fq) const {
        const int* rp = rowpair + (size_t)u.e * CAP + u.mt * 256; const int col0 = u.pn * 256 + wc * 32 + 8 * fq;
#pragma unroll
        for (int ai = 0; ai < 2; ++ai)
#pragma unroll
            for (int m = 0; m < 4; ++m) { const int rl = ai * 128 + wr * 64 + m * 16 + fr;
                if (rl < u.aux) { const int p = rp[rl]; const float w8 = pairw[p]; bf16* row = Y2 + (size_t)p * D + col0;
#pragma unroll
                    for (int bj = 0; bj < 2; ++bj) { const f32x4 v0 = acc[ai][bj][m][0] * w8, v1 = acc[ai][bj][m][1] * w8;
                        v4u w; w.x = pg8::cvt_pk_bf16(v0[0], v0[1]); w.y = pg8::cvt_pk_bf16(v0[2], v0[3]); w.z = pg8::cvt_pk_bf16(v1[0], v1[1]); w.w = pg8::cvt_pk_bf16(v1[2], v1[3]);
                        *(v4u*)(row + bj * 128) = w; } } }
    }
};
__device__ __forceinline__ void phase_g2_fast(Ctx& C, KA AR, int l) {
    LAS int* tab = (LAS int*)(C.lds + TAB_OFF); build_exptab256(C, l, tab);
    pg8::Gemm g{(const bf16*)(C.ws + WS_R2), (const bf16*)(C.ws + WS_WDN) + (size_t)l * NE * D * DE, DE};
    GroupOrder S{tab, (int)gridDim.x, (int)blockIdx.x, (const int*)(C.ws + WS_ROWPAIR), nullptr, true};
    EpiG2 E{(bf16*)(C.ws + WS_R1), (const int*)(C.ws + WS_ROWPAIR), (const float*)(C.ws + WS_PAIRW)};
    pg8::gemm_phase<EpiG2, GroupOrder, true, false>(C.lds, g, S, E, C.tid);
}

#define SBAR() __builtin_amdgcn_sched_barrier(0)
namespace attn_body {
using bf16=__hip_bfloat16;
using bf16x8=__attribute__((ext_vector_type(8)))short;
using s16x4=__attribute__((ext_vector_type(4)))short;
using f32x16=__attribute__((ext_vector_type(16)))float;
using u32x4=__attribute__((ext_vector_type(4)))unsigned;
constexpr int BATCH=4,NHEAD=8,SEQ=4096,D=64,DM=NHEAD*D;
constexpr int NW=8,QBLK=32,QB=QBLK*NW,KVBLK=64,NQB=SEQ/QB;
constexpr int ATTN_PITCH=DM, ATTN_UNIT_ROWS=QB;
__device__ __forceinline__ int crow(int r,int hi){return (r&3)+8*(r>>2)+4*hi;}
#define SBAR() __builtin_amdgcn_sched_barrier(0)
__device__ __forceinline__ void cmask(f32x16&p0,f32x16&p1,int jb,int qrel,int hi){
  const float NEG=-INFINITY; int kb=64*jb+4*hi;
  #pragma unroll
  for(int r=0;r<16;++r){int kv=kb+(r&3)+8*(r>>2); if(kv>qrel)p0[r]=NEG; if(kv+32>qrel)p1[r]=NEG;}
}

constexpr int NSLOT=3, SLOTB=8192;
constexpr int LDS_K=0, LDS_V=NSLOT*SLOTB, LDS_WS=2*NSLOT*SLOTB, LDS_OST=LDS_WS+NW*64*4, LDS_CK=LDS_OST+NW*4096, LDS_BYTES=LDS_CK+SEQ*4;
constexpr float C2=0.125f*1.4426950408889634f;
__device__ __forceinline__ void glds16(const void*gsrc,unsigned lds_dst){unsigned keep;
  asm volatile("s_mov_b32 %0, m0\n\ts_mov_b32 m0, %2\n\ts_nop 0\n\tglobal_load_lds_dwordx4 %1, off\n\ts_mov_b32 m0, %0":"=&s"(keep):"v"(gsrc),"s"(lds_dst):"memory");}
__device__ __forceinline__ float max3f(float a,float b,float c){float r;asm("v_max3_f32 %0, %1, %2, %3":"=v"(r):"v"(a),"v"(b),"v"(c));return r;}
__device__ __forceinline__ float max2f(float a,float b){float r;asm("v_max_f32_e32 %0, %1, %2":"=v"(r):"v"(a),"v"(b));return r;}
__device__ __forceinline__ float fadd_s(float a,float b){float r;asm("v_add_f32_e32 %0, %1, %2":"=v"(r):"v"(a),"v"(b));return r;}
__device__ __forceinline__ float fsub_s(float a,float b){float r;asm("v_sub_f32_e32 %0, %1, %2":"=v"(r):"v"(a),"v"(b));return r;}
typedef float f32x2_t __attribute__((ext_vector_type(2))); typedef __bf16 bf16x2_t __attribute__((ext_vector_type(2)));
__device__ __forceinline__ unsigned cvtpk_s(float lo,float hi){f32x2_t v={lo,hi};bf16x2_t b=__builtin_convertvector(v,bf16x2_t);return __builtin_bit_cast(unsigned,b);}
#define WAIT_BAR(N) asm volatile("s_waitcnt vmcnt(" #N ") lgkmcnt(0)\n\ts_barrier":::"memory")

__device__ __forceinline__ void qkt(f32x16&p0,f32x16&p1,const char*Kslot,const bf16x8*qr,const f32x16&negm,int r32,int hi){
  const char*kb=Kslot+hi*1024+r32*16;
  #pragma unroll
  for(int d0=0;d0<4;++d0){
    const bf16x8 b0=*reinterpret_cast<const bf16x8*>(kb+d0*2048);
    const bf16x8 b1=*reinterpret_cast<const bf16x8*>(kb+d0*2048+512);
    if(d0==0){p0=__builtin_amdgcn_mfma_f32_32x32x16_bf16(b0,qr[0],negm,0,0,0);p1=__builtin_amdgcn_mfma_f32_32x32x16_bf16(b1,qr[0],negm,0,0,0);}
    else{p0=__builtin_amdgcn_mfma_f32_32x32x16_bf16(b0,qr[d0],p0,0,0,0);p1=__builtin_amdgcn_mfma_f32_32x32x16_bf16(b1,qr[d0],p1,0,0,0);}}
}
typedef __attribute__((address_space(3))) const char* lds_cptr;
typedef short v4i16_t __attribute__((ext_vector_type(4)));
__device__ __forceinline__ void kload8(bf16x8*kf,lds_cptr kp){
  kf[0]=*(const __attribute__((address_space(3))) bf16x8*)(kp);      kf[1]=*(const __attribute__((address_space(3))) bf16x8*)(kp+512);
  kf[2]=*(const __attribute__((address_space(3))) bf16x8*)(kp+2048); kf[3]=*(const __attribute__((address_space(3))) bf16x8*)(kp+2560);
  kf[4]=*(const __attribute__((address_space(3))) bf16x8*)(kp+4096); kf[5]=*(const __attribute__((address_space(3))) bf16x8*)(kp+4608);
  kf[6]=*(const __attribute__((address_space(3))) bf16x8*)(kp+6144); kf[7]=*(const __attribute__((address_space(3))) bf16x8*)(kp+6656);
}
__device__ __forceinline__ void kload2(bf16x8*kf,lds_cptr kp,int j){ kf[2*j]=*(const __attribute__((address_space(3))) bf16x8*)(kp+j*2048); kf[2*j+1]=*(const __attribute__((address_space(3))) bf16x8*)(kp+j*2048+512); }
__device__ __forceinline__ s16x4 vtr(lds_cptr p){ return __builtin_bit_cast(s16x4,__builtin_amdgcn_ds_read_tr16_b64_v4i16((__attribute__((address_space(3))) v4i16_t*)p)); }
__device__ __forceinline__ float rowmax(const f32x16&p0,const f32x16&p1){
  float a=max3f(p0[0],p0[1],p1[0]),b=max3f(p0[2],p0[3],p1[1]);a=max3f(a,p1[2],p1[3]);
  #pragma unroll
  for(int r=4;r<16;r+=4){a=max3f(a,p0[r],p0[r+1]);b=max3f(b,p0[r+2],p0[r+3]);a=max3f(a,p1[r],p1[r+1]);b=max3f(b,p1[r+2],p1[r+3]);}
  const float m=max2f(a,b);
  auto rr=__builtin_amdgcn_permlane32_swap(__float_as_uint(m),__float_as_uint(m),false,false);
  return max2f(__uint_as_float(rr[0]),__uint_as_float(rr[1]));
}
__device__ __forceinline__ void pv(f32x16*o,int vb,bf16x8 pa0,bf16x8 pa1,bf16x8 pa2,bf16x8 pa3){
  #pragma unroll
  for(int d0=0;d0<2;++d0){s16x4 lo[4],hi[4];
    #pragma unroll
    for(int ks=0;ks<4;++ks){
      asm volatile("ds_read_b64_tr_b16 %0,%1 offset:%c2":"=&v"(lo[ks]):"v"(vb),"i"(d0*4096+ks*1024):"memory");
      asm volatile("ds_read_b64_tr_b16 %0,%1 offset:%c2":"=&v"(hi[ks]):"v"(vb),"i"(d0*4096+ks*1024+512):"memory");}
    asm volatile("s_waitcnt lgkmcnt(0)":::"memory");SBAR();
    #define PK(k) (bf16x8){lo[k][0],lo[k][1],lo[k][2],lo[k][3],hi[k][0],hi[k][1],hi[k][2],hi[k][3]}
    o[d0]=__builtin_amdgcn_mfma_f32_32x32x16_bf16(pa0,PK(0),o[d0],0,0,0);
    o[d0]=__builtin_amdgcn_mfma_f32_32x32x16_bf16(pa1,PK(1),o[d0],0,0,0);
    o[d0]=__builtin_amdgcn_mfma_f32_32x32x16_bf16(pa2,PK(2),o[d0],0,0,0);
    o[d0]=__builtin_amdgcn_mfma_f32_32x32x16_bf16(pa3,PK(3),o[d0],0,0,0);
    #undef PK
  }
}

#ifndef ATTN_STORE16
#define ATTN_STORE16(p,v) (*(u32x4*)(p)=(v))
#endif
template<int THRL> __device__ __forceinline__ void attn_unit(int b,int h,int qb,const bf16*Q,const bf16*__restrict__ K,const bf16*__restrict__ V,bf16*O,const float*__restrict__ C2K,char*shm,const int tid){
  const int lane=tid&63,r32=lane&31,hi=lane>>5; const int wid=__builtin_amdgcn_readfirstlane(tid>>6);
  const long rowbase=(long)b*SEQ; const int q0=qb*QB;
  const bf16*Qw=Q+(rowbase+q0+wid*QBLK)*DM+h*D;
  const bf16*Kh=K+rowbase*DM+h*D,*Vh=V+rowbase*DM+h*D;
  const int NT=(q0+QB)/KVBLK;
  const float*ckg=C2K+(long)(b*NHEAD+h)*SEQ; float base=ckg[q0+(tid>>6)*QBLK+r32];
  typedef __attribute__((address_space(3))) float lds_f32; typedef float f32x4_t __attribute__((ext_vector_type(4)));
  lds_f32*const nbl=(lds_f32*)((__attribute__((address_space(3))) char*)shm+LDS_CK);
  for(int i=tid;i<NT*KVBLK;i+=NW*64)nbl[i]=-ckg[i];
  const unsigned lds0=(unsigned)(uintptr_t)shm;
  float*wsf=(float*)(shm+LDS_WS)+wid*64;
  const bf16*ksrc=Kh+(long)lane*DM+wid*8;
  const bf16*vsrc=Vh+(long)(16*(wid&3)+(lane>>2))*DM+(wid>>2)*32+(lane&3)*8;
  const unsigned kdst=lds0+LDS_K+wid*1024, vdst=lds0+LDS_V+wid*1024;
  #define DMA_K(t,slot) glds16(ksrc+(long)(t)*KVBLK*DM,(unsigned)__builtin_amdgcn_readfirstlane(kdst+(slot)))
  #define DMA_V(t,slot) glds16(vsrc+(long)(t)*KVBLK*DM,(unsigned)__builtin_amdgcn_readfirstlane(vdst+(slot)))
  const int vb0=(int)(lds0+LDS_V)+((lane>>4)&1)*32+(lane&3)*8+(4*hi+((lane&15)>>2))*64;
  const char*Kbase=shm+LDS_K; bf16x8 kf[8];
  const lds_cptr shm3=(lds_cptr)shm; const lds_cptr kp0=shm3+LDS_K+hi*1024+r32*16; const lds_cptr vp0=shm3+LDS_V+((lane>>4)&1)*32+(lane&3)*8+(4*hi+((lane&15)>>2))*64;
  DMA_K(0,0);DMA_V(0,0);DMA_K(1,SLOTB);
  bf16x8 qr[4];
  #pragma unroll
  for(int d0=0;d0<4;++d0)qr[d0]=*reinterpret_cast<const bf16x8*>(&Qw[(long)r32*DM+d0*16+hi*8]);
  float l_reg=0.f;f32x16 o[2];o[0]=f32x16{};o[1]=f32x16{};const f32x16 negm=f32x16{};
  const int qrel=wid*QBLK+r32;
  #define CMASK(P0,P1,t) do{int jb_=(t)-(NT-4); if(jb_>=0)cmask(P0,P1,jb_,qrel,hi);}while(0)
  #define KBIAS(P0,P1,t) do{ const lds_f32*nb_=nbl+64*(t)+4*hi; _Pragma("unroll") for(int g_=0;g_<4;++g_){ \
    { const f32x4_t b0_=*(const __attribute__((address_space(3))) f32x4_t*)(nb_+8*g_); _Pragma("unroll") for(int j_=0;j_<4;++j_)P0[4*g_+j_]+=(b0_[j_]+base); } SBAR(); \
    { const f32x4_t b1_=*(const __attribute__((address_space(3))) f32x4_t*)(nb_+32+8*g_); _Pragma("unroll") for(int j_=0;j_<4;++j_)P1[4*g_+j_]+=(b1_[j_]+base); } SBAR(); } }while(0)
  bool resc=false;
  #define START(P0,P1) do{ const float rm=rowmax(P0,P1); resc=false; \
    { const float dl=rm; base=fsub_s(base,dl); \
      _Pragma("unroll") for(int r=0;r<16;++r){P0[r]=fsub_s(P0[r],dl);P1[r]=fsub_s(P1[r],dl);} \
      } \
    _Pragma("unroll") for(int r=0;r<16;++r)P0[r]=__builtin_amdgcn_exp2f(P0[r]); }while(0)
  #define RESC() do{ if(resc){ asm volatile("s_waitcnt lgkmcnt(0)":::"memory"); \
      _Pragma("unroll") for(int d_=0;d_<2;++d_) _Pragma("unroll") for(int r=0;r<16;++r)o[d_][r]*=wsf[crow(r,hi)]; } }while(0)
  f32x16 pA0,pA1,pB0,pB1;
  int sl_prev=0,sl_cur=0,sl_next=SLOTB;
  #define ROT() do{sl_prev=sl_cur;sl_cur=sl_next;sl_next=(sl_next==(NSLOT-1)*SLOTB)?0:sl_next+SLOTB;}while(0)
  DMA_K(2,2*SLOTB);
  WAIT_BAR(3);
  qkt(pA0,pA1,Kbase,qr,negm,r32,hi);asm volatile("s_nop 15\n\ts_nop 7":"+v"(pA0),"+v"(pA1));KBIAS(pA0,pA1,0);CMASK(pA0,pA1,0);
  START(pA0,pA1);
  _Pragma("unroll") for(int r=0;r<16;++r)pA1[r]=__builtin_amdgcn_exp2f(pA1[r]);
  WAIT_BAR(0);
  DMA_K(3,0);DMA_V(1,SLOTB);
  ROT();
  kload8(kf,kp0+sl_cur);
  WAIT_BAR(2);
  s16x4 vlo[8],vhi[8]; u32x4 pw0,pw1,pw2,pw3;
  #define PKW(P,B) cvtpk_s(P[B],P[B+1])
  #define PAF(k) __builtin_bit_cast(bf16x8,pw##k)
  #define VFR(i) (bf16x8){vlo[i][0],vlo[i][1],vlo[i][2],vlo[i][3],vhi[i][0],vhi[i][1],vhi[i][2],vhi[i][3]}
  #define PIN(x) asm volatile("":"+v"(x))
  #define MX3(a,b,c) __builtin_fmaxf(__builtin_fmaxf((a),(b)),(c))
  #define GAPA(MF,A0,A1,A2,A3,W0,W1,PW) do{ MF; sacc+=A0; sacc+=A1; sacc+=A2; sacc+=A3; PIN(sacc); W0; W1; PIN(PW); SBAR(); }while(0)
  #define EX(v) __builtin_amdgcn_exp2f(v)
  #define GAPB(MF,X,B) do{ MF; X[B]=EX(X[B]); X[B+1]=EX(X[B+1]); X[B+2]=EX(X[B+2]); X[B+3]=EX(X[B+3]); PIN(X); SBAR(); }while(0)
  #define VRD(i) do{ vlo[i]=vtr(vp_+(((i)>>2)*4096+((i)&3)*1024)); vhi[i]=vtr(vp_+(((i)>>2)*4096+((i)&3)*1024+512)); }while(0)
  #define KRD(G,j) do{ if(G){ kload2(kf,kp0+sl_next,j); SBAR(); } }while(0)
  #define STEP(C0,C1,P0,P1,t,GK,GV,GL) do{ SBAR(); \
    const lds_cptr vp_=vp0+sl_prev; \
    VRD(0); SBAR(); float sacc=(P0[0]+P0[1]); \
    GAPA(C0=__builtin_amdgcn_mfma_f32_32x32x16_bf16(kf[0],qr[0],negm,0,0,0), P0[2],P0[3],P0[4],P0[5],     pw0[0]=PKW(P0,0), pw0[1]=PKW(P0,2), pw0); \
    VRD(4); SBAR(); GAPA(C1=__builtin_amdgcn_mfma_f32_32x32x16_bf16(kf[1],qr[0],negm,0,0,0), P0[6],P0[7],P0[8],P0[9],     pw0[2]=PKW(P0,4), pw0[3]=PKW(P0,6), pw0); \
    VRD(1); SBAR(); GAPA(C0=__builtin_amdgcn_mfma_f32_32x32x16_bf16(kf[2],qr[1],C0,0,0,0),   P0[10],P0[11],P0[12],P0[13], pw1[0]=PKW(P0,8), pw1[1]=PKW(P0,10), pw1); \
    VRD(5); SBAR(); GAPA(C1=__builtin_amdgcn_mfma_f32_32x32x16_bf16(kf[3],qr[1],C1,0,0,0),   P0[14],P0[15],P1[0],P1[1],   pw1[2]=PKW(P0,12),pw1[3]=PKW(P0,14), pw1); \
    VRD(2); SBAR(); GAPA(C0=__builtin_amdgcn_mfma_f32_32x32x16_bf16(kf[4],qr[2],C0,0,0,0),   P1[2],P1[3],P1[4],P1[5],     pw2[0]=PKW(P1,0), pw2[1]=PKW(P1,2), pw2); \
    VRD(6); SBAR(); GAPA(C1=__builtin_amdgcn_mfma_f32_32x32x16_bf16(kf[5],qr[2],C1,0,0,0),   P1[6],P1[7],P1[8],P1[9],     pw2[2]=PKW(P1,4), pw2[3]=PKW(P1,6), pw2); \
    VRD(3); SBAR(); GAPA(C0=__builtin_amdgcn_mfma_f32_32x32x16_bf16(kf[6],qr[3],C0,0,0,0),   P1[10],P1[11],P1[12],P1[13], pw3[0]=PKW(P1,8), pw3[1]=PKW(P1,10), pw3); \
    VRD(7); SBAR(); GAPA(C1=__builtin_amdgcn_mfma_f32_32x32x16_bf16(kf[7],qr[3],C1,0,0,0),   P1[14],P1[15],0.f,0.f,       pw3[2]=PKW(P1,12),pw3[3]=PKW(P1,14), pw3); \
    l_reg+=sacc; \
    if(GK){DMA_K((t)+3,sl_cur);} if(GV){DMA_V((t)+1,sl_next);} \
    KBIAS(C0,C1,t); \
    CMASK(C0,C1,t); \
    { float a=MX3(C0[0],C0[1],C1[0]),b=MX3(C0[2],C0[3],C1[1]); a=MX3(a,C1[2],C1[3]); \
      _Pragma("unroll") for(int r=4;r<16;r+=4){a=MX3(a,C0[r],C0[r+1]);b=MX3(b,C0[r+2],C0[r+3]);a=MX3(a,C1[r],C1[r+1]);b=MX3(b,C1[r+2],C1[r+3]);} \
      float rm=__builtin_fmaxf(a,b); { auto rr=__builtin_amdgcn_permlane32_swap(__float_as_uint(rm),__float_as_uint(rm),false,false); rm=__builtin_fmaxf(__uint_as_float(rr[0]),__uint_as_float(rr[1])); } \
      resc=false; \
      if(__builtin_expect(__any(rm>(float)THRL),0)){ const float dl=__builtin_fmaxf(rm,0.f); base-=dl; \
        _Pragma("unroll") for(int r=0;r<16;++r){C0[r]-=dl;C1[r]-=dl;} \
        const float f=__builtin_amdgcn_exp2f(-dl); l_reg*=f; if(hi==0)wsf[r32]=f; resc=true; } } \
    SBAR(); \
    GAPB(o[0]=__builtin_amdgcn_mfma_f32_32x32x16_bf16(PAF(0),VFR(0),o[0],0,0,0), C0,0); \
    GAPB(o[1]=__builtin_amdgcn_mfma_f32_32x32x16_bf16(PAF(0),VFR(4),o[1],0,0,0), C0,4); \
    KRD(GL,0); GAPB(o[0]=__builtin_amdgcn_mfma_f32_32x32x16_bf16(PAF(1),VFR(1),o[0],0,0,0), C0,8); \
    KRD(GL,1); GAPB(o[1]=__builtin_amdgcn_mfma_f32_32x32x16_bf16(PAF(1),VFR(5),o[1],0,0,0), C0,12); \
    KRD(GL,2); GAPB(o[0]=__builtin_amdgcn_mfma_f32_32x32x16_bf16(PAF(2),VFR(2),o[0],0,0,0), C1,0); \
    KRD(GL,3); GAPB(o[1]=__builtin_amdgcn_mfma_f32_32x32x16_bf16(PAF(2),VFR(6),o[1],0,0,0), C1,4); \
    GAPB(o[0]=__builtin_amdgcn_mfma_f32_32x32x16_bf16(PAF(3),VFR(3),o[0],0,0,0), C1,8); \
    GAPB(o[1]=__builtin_amdgcn_mfma_f32_32x32x16_bf16(PAF(3),VFR(7),o[1],0,0,0), C1,12); \
    }while(0)
  int t=1;
  #undef CMASK
  #define CMASK(P0,P1,t) do{}while(0)
  for(;t+5<NT;t+=2){
    STEP(pB0,pB1,pA0,pA1,t,true,true,true);     WAIT_BAR(2); RESC(); ROT();
    STEP(pA0,pA1,pB0,pB1,t+1,true,true,true);   WAIT_BAR(2); RESC(); ROT();
  }
  #undef CMASK
  #define CMASK(P0,P1,t) do{int jb_=(t)-(NT-4); if(jb_>=0)cmask(P0,P1,jb_,qrel,hi);}while(0)
  #define ENDW(tt) do{ if((tt)+3<NT){WAIT_BAR(2);} else if((tt)+2<NT){WAIT_BAR(1);} else {WAIT_BAR(0);} }while(0)
  for(;t+1<NT;t+=2){
    STEP(pB0,pB1,pA0,pA1,t,(t+3<NT),(t+1<NT),(t+1<NT));       ENDW(t);   RESC(); ROT();
    STEP(pA0,pA1,pB0,pB1,t+1,(t+4<NT),(t+2<NT),(t+2<NT));     ENDW(t+1); RESC(); ROT();
  }
  STEP(pB0,pB1,pA0,pA1,NT-1,false,false,false); RESC();
  { float sacc=pB0[0]+pB0[1]; _Pragma("unroll") for(int r=2;r<16;++r)sacc+=pB0[r]; _Pragma("unroll") for(int r=0;r<16;++r)sacc+=pB1[r]; l_reg+=sacc;
    pw0=(u32x4){PKW(pB0,0),PKW(pB0,2),PKW(pB0,4),PKW(pB0,6)};pw1=(u32x4){PKW(pB0,8),PKW(pB0,10),PKW(pB0,12),PKW(pB0,14)};pw2=(u32x4){PKW(pB1,0),PKW(pB1,2),PKW(pB1,4),PKW(pB1,6)};pw3=(u32x4){PKW(pB1,8),PKW(pB1,10),PKW(pB1,12),PKW(pB1,14)};
    SBAR(); pv(o,vb0+sl_cur,PAF(0),PAF(1),PAF(2),PAF(3)); }
  #undef PKW
  #undef PAF
  #undef VFR
  #undef PIN
  #undef MX3
  #undef GAPA
  #undef GAPB
  #undef EX
  #undef VRD
  #undef KRD
  #undef STEP
  #undef ENDW
  {auto rr=__builtin_amdgcn_permlane32_swap(__float_as_uint(l_reg),__float_as_uint(l_reg),false,false);l_reg=__uint_as_float(rr[0])+__uint_as_float(rr[1]);}
  if(hi==0)wsf[32+r32]=l_reg;asm volatile("s_waitcnt lgkmcnt(0)":::"memory");
  float rli[16];
  #pragma unroll
  for(int r=0;r<16;++r)rli[r]=__builtin_amdgcn_rcpf(wsf[32+crow(r,hi)]);
  bf16*Ow=O+(rowbase+q0+wid*QBLK)*DM+h*D;
  { bf16*stg=(bf16*)(shm+LDS_OST)+wid*2048;
    #pragma unroll
    for(int r=0;r<16;++r){const int orow=crow(r,hi);
      #pragma unroll
      for(int d0=0;d0<2;++d0)stg[orow*64+d0*32+r32]=__float2bfloat16(o[d0][r]*rli[r]);}
    asm volatile("s_waitcnt lgkmcnt(0)":::"memory");
    #pragma unroll
    for(int i=0;i<4;++i){const int row=i*8+(lane>>3),ch=lane&7; const u32x4 v=*(const u32x4*)(stg+row*64+ch*8); ATTN_STORE16(Ow+(long)row*DM+ch*8,v);} }
  asm volatile("s_waitcnt lgkmcnt(0)\n\ts_barrier":::"memory");
  #undef DMA_K
  #undef DMA_V
  #undef CMASK
  #undef KBIAS
  #undef START
  #undef RESC
  #undef ROT
}
constexpr int ATTN_LDS_BYTES=LDS_BYTES;
struct AttnTensors { const bf16* Q; const bf16* K; const bf16* V; bf16* O; const float* C2K; };
struct AttnUnit { int bh; int qb; };
struct StaticOrder {
  int vcu;
  __device__ __forceinline__ explicit StaticOrder(int grid,int block):vcu((block%8)*(grid/8)+block/8){}
  __device__ __forceinline__ bool next(int i,AttnUnit&u)const{ if(i>=2||vcu>=256)return false; const int s=vcu&7; u.bh=vcu>>3; u.qb=(i==0)?s:15-s; return true; }
  __device__ __forceinline__ void a_ready(const AttnUnit&)const{}
  __device__ __forceinline__ void done(const AttnUnit&)const{}
};
template<class Sched,int THRL=8> __device__ __forceinline__ void attn_phase(char*lds,const AttnTensors&T,const Sched&S,const int tid){
  AttnUnit u;
  for(int i=0;S.next(i,u);++i){ S.a_ready(u); attn_unit<THRL>(u.bh/NHEAD,u.bh%NHEAD,u.qb,T.Q,T.K,T.V,T.O,T.C2K,lds,tid); S.done(u); }
}
#undef SBAR
#undef WAIT_BAR
}
__device__ __forceinline__ void phase_attn_fast(Ctx& C, KA AR, int l, char* ldsg) {
    const attn_body::bf16* Q = (const attn_body::bf16*)(C.ws + WS_R1) + (size_t)2 * T * 512;
    const attn_body::AttnTensors AT{Q, Q + (size_t)T * 512, Q + (size_t)2 * T * 512, (attn_body::bf16*)(C.ws + WS_R2), (const float*)(C.ws + WS_C2K)};
    const attn_body::StaticOrder S((int)gridDim.x, (int)blockIdx.x);
    attn_body::attn_phase<attn_body::StaticOrder>(ldsg, AT, S, C.tid);
}

constexpr int RCH = 32, NCH = S / RCH;
__device__ __forceinline__ float one_minus_sq_exp(float la, float a) {
    const float x = 2.f * la;
    float p = 1.f / 5040.f; p = p * x + 1.f / 720.f; p = p * x + 1.f / 120.f; p = p * x + 1.f / 24.f; p = p * x + 1.f / 6.f; p = p * x + 0.5f; p = p * x + 1.f; p = -(p * x);
    return x > -0.25f ? p : 1.f - a * a;
}
template <int MODE>
__device__ __forceinline__ void phase_rnn_fast(Ctx& C, KA AR, int l) {
    typedef short bf16x8 __attribute__((ext_vector_type(8)));
    const int blk = C.wave, lane = C.lane, fr = lane & 15, fq = lane >> 4;
    LAS float* Ab = (LAS float*)C.lds + C.wave * 4096; LAS float* Ub = Ab + 2048;
    LAS float* SS = (LAS float*)(C.lds + TAB_OFF); LAS float* RSW = SS + 256 + C.wave * 32;
    const bf16* ZX = (const bf16*)(C.ws + WS_R1); const bf16* ZG = ZX + (size_t)T * 512;
    float* SA = (float*)(C.ws + WS_SA); float* SH = (float*)(C.ws + WS_SH);
    const bf16* O = (const bf16*)(C.ws + WS_R2); bf16* YM = (bf16*)(C.ws + WS_R2 + 16 * MiB);
    const float* cw = AR->in[I_CONVW] + l * 4 * DR; const float* cb = AR->in[I_CONVB] + l * DR;
    const float* wr = AR->in[I_WR] + (size_t)(l * 8 + blk) * 64 * 64; const float* wi = AR->in[I_WI] + (size_t)(l * 8 + blk) * 64 * 64;
    bf16x8 Br[4][2], Bi[4][2]; float brj[4], bij[4], spj[4];
#pragma unroll
    for (int n = 0; n < 4; ++n) { const int j = n * 16 + fr, ch = blk * 64 + j;
        brj[n] = AR->in[I_BR][l * DR + ch]; bij[n] = AR->in[I_BI][l * DR + ch]; spj[n] = log1pf(__expf(-AR->in[I_LAM][l * DR + ch]));
#pragma unroll
        for (int ks = 0; ks < 2; ++ks)
#pragma unroll
            for (int e = 0; e < 8; ++e) { const int k = ks * 32 + fq * 8 + e; Br[n][ks][e] = (short)f2bf(wr[k * 64 + j]); Bi[n][ks][e] = (short)f2bf(wi[k * 64 + j]); } }
    for (int u = blockIdx.x; u < NB * NCH; u += gridDim.x) {
        const int b = u / NCH, c = u % NCH, t0 = c * RCH;
        if (MODE == 1) __syncthreads();
        bf16x8 Af[2][2];
#pragma unroll
        for (int ks = 0; ks < 2; ++ks) {
            const int ch0 = blk * 64 + ks * 32 + fq * 8;
            f32x4 w[4][2], bb[2];
#pragma unroll
            for (int j = 0; j < 4; ++j) { w[j][0] = *(const f32x4*)(cw + j * DR + ch0); w[j][1] = *(const f32x4*)(cw + j * DR + ch0 + 4); }
            bb[0] = *(const f32x4*)(cb + ch0); bb[1] = *(const f32x4*)(cb + ch0 + 4);
#pragma unroll
            for (int m = 0; m < 2; ++m) {
                const int tok = m * 16 + fr, tg = t0 + tok;
                f32x4 x0 = bb[0], x1 = bb[1];
#pragma unroll
                for (int j = 0; j < 4; ++j) { const int tt = tg - 3 + j;
                    if (tt >= 0) { const v4u z = *(const v4u*)(ZX + (size_t)(b * S + tt) * 512 + ch0);
                        x0[0] += w[j][0][0] * bflo(z.x); x0[1] += w[j][0][1] * bfhi(z.x); x0[2] += w[j][0][2] * bflo(z.y); x0[3] += w[j][0][3] * bfhi(z.y);
                        x1[0] += w[j][1][0] * bflo(z.z); x1[1] += w[j][1][1] * bfhi(z.z); x1[2] += w[j][1][2] * bflo(z.w); x1[3] += w[j][1][3] * bfhi(z.w); } }
                *(LAS f32x4*)(Ub + tok * 64 + ks * 32 + fq * 8) = x0; *(LAS f32x4*)(Ub + tok * 64 + ks * 32 + fq * 8 + 4) = x1;
                v4u pk; pk.x = pk2(x0[0], x0[1]); pk.y = pk2(x0[2], x0[3]); pk.z = pk2(x1[0], x1[1]); pk.w = pk2(x1[2], x1[3]);
                Af[m][ks] = __builtin_bit_cast(bf16x8, pk);
            }
        }
        f32x4 aR[2][4], aI[2][4];
#pragma unroll
        for (int m = 0; m < 2; ++m)
#pragma unroll
            for (int n = 0; n < 4; ++n) { aR[m][n] = (f32x4){0.f, 0.f, 0.f, 0.f}; aI[m][n] = (f32x4){0.f, 0.f, 0.f, 0.f};
#pragma unroll
                for (int ks = 0; ks < 2; ++ks) { aR[m][n] = __builtin_amdgcn_mfma_f32_16x16x32_bf16(Af[m][ks], Br[n][ks], aR[m][n], 0, 0, 0); aI[m][n] = __builtin_amdgcn_mfma_f32_16x16x32_bf16(Af[m][ks], Bi[n][ks], aI[m][n], 0, 0, 0); } }
        asm volatile("s_waitcnt lgkmcnt(0)" ::: "memory");
#pragma unroll
        for (int m = 0; m < 2; ++m)
#pragma unroll
            for (int n = 0; n < 4; ++n)
#pragma unroll
                for (int i = 0; i < 4; ++i) { const int idx = (m * 16 + 4 * fq + i) * 64 + n * 16 + fr;
                    const float xcv = Ub[idx], r = sigmoid_fast(aR[m][n][i] + brj[n]), ig = sigmoid_fast(aI[m][n][i] + bij[n]);
                    const float la = -8.f * r * spj[n], a = __expf(la);
                    Ab[idx] = a; Ub[idx] = sqrtf(one_minus_sq_exp(la, a)) * (ig * xcv); }
        asm volatile("s_waitcnt lgkmcnt(0)" ::: "memory");
        const int ch = blk * 64 + lane;
        if (MODE == 0) { float At = 1.f, h = 0.f;
#pragma unroll 8
            for (int t = 0; t < RCH; ++t) { const float a = Ab[t * 64 + lane]; h = a * h + Ub[t * 64 + lane]; At *= a; }
            SA[(size_t)(b * NCH + c) * 512 + ch] = At; SH[(size_t)(b * NCH + c) * 512 + ch] = h;
        } else {
            float h = 0.f;
            for (int c2 = 0; c2 < c; ++c2) h = SA[(size_t)(b * NCH + c2) * 512 + ch] * h + SH[(size_t)(b * NCH + c2) * 512 + ch];
            const bf16* zg = ZG + (size_t)(b * S + t0) * 512 + ch;
#pragma unroll 8
            for (int t = 0; t < RCH; ++t) { h = Ab[t * 64 + lane] * h + Ub[t * 64 + lane]; Ab[t * 64 + lane] = h * bf2f(zg[(size_t)t * 512]); }
            asm volatile("s_waitcnt lgkmcnt(0)" ::: "memory");
            { const int t = lane & 31, hf = lane >> 5; float s = 0.f;
#pragma unroll 8
              for (int k = 0; k < 32; ++k) { const float y = Ab[t * 64 + hf * 32 + ((k + t) & 31)]; s += y * y; }
              s = half_sum32(s); if (lane < 32) SS[C.wave * 32 + lane] = s; }
            __syncthreads();
            { const int t = lane & 31; float tot = 0.f;
#pragma unroll
              for (int w8 = 0; w8 < 8; ++w8) tot += SS[w8 * 32 + t];
              RSW[t] = rsqrtf(tot * (1.f / 512.f) + EPS); }
            asm volatile("s_waitcnt lgkmcnt(0)" ::: "memory");
            { const int oct = lane & 7; const float* g1 = AR->in[I_LRUN] + l * DR + blk * 64 + oct * 8; const f32x4 ga = *(const f32x4*)g1, gb = *(const f32x4*)(g1 + 4);
#pragma unroll
              for (int q = 0; q < 4; ++q) { const int t = q * 8 + (lane >> 3); const float rs = RSW[t];
                  const f32x4 y0 = *(const LAS f32x4*)(Ab + t * 64 + oct * 8) * rs * ga, y1 = *(const LAS f32x4*)(Ab + t * 64 + oct * 8 + 4) * rs * gb;
                  v4u pk; pk.x = pk2(y0[0], y0[1]); pk.y = pk2(y0[2], y0[3]); pk.z = pk2(y1[0], y1[1]); pk.w = pk2(y1[2], y1[3]);
                  *(v4u*)(YM + (size_t)(b * S + t0 + t) * D + blk * 64 + oct * 8) = pk; } }
            { const float* g2 = AR->in[I_ATTN] + l * DA + 8 * lane; const f32x4 ga = *(const f32x4*)g2, gb = *(const f32x4*)(g2 + 4);
#pragma unroll
              for (int q = 0; q < 4; ++q) { const size_t row = (size_t)(b * S + t0 + C.wave * 4 + q);
                  const v4u w = *(const v4u*)(O + row * 512 + 8 * lane);
                  f32x4 x0 = {bflo(w.x), bfhi(w.x), bflo(w.y), bfhi(w.y)}, x1 = {bflo(w.z), bfhi(w.z), bflo(w.w), bfhi(w.w)};
                  float s = (x0[0] * x0[0] + x0[1] * x0[1]) + (x0[2] * x0[2] + x0[3] * x0[3]) + (x1[0] * x1[0] + x1[1] * x1[1]) + (x1[2] * x1[2] + x1[3] * x1[3]);
                  const float rs = rsqrtf(wave_sum(s) * (1.f / 512.f) + EPS);
                  x0 = x0 * rs * ga; x1 = x1 * rs * gb;
                  v4u pk; pk.x = pk2(x0[0], x0[1]); pk.y = pk2(x0[2], x0[3]); pk.z = pk2(x1[0], x1[1]); pk.w = pk2(x1[2], x1[3]);
                  *(v4u*)(YM + row * D + 512 + 8 * lane) = pk; } }
        }
    }
}

constexpr int NPH = 14;
constexpr int NPHASES = 1 + DEPTH * NPH;
__global__ void __launch_bounds__(512, 2) fwd_kernel(Args args) {
    extern __shared__ __attribute__((aligned(16))) unsigned char lds[];
    Ctx C;
    C.lds = (LAS unsigned char*)lds;
    C.wave0 = __builtin_amdgcn_readfirstlane((int)threadIdx.x >> 6); asm volatile("" : "+s"(C.wave0));
    C.tid = threadIdx.x; C.lane = C.tid & 63; C.wave = C.wave0;
    C.gw = blockIdx.x * 8 + C.wave; C.ngw = gridDim.x * 8;
    C.ws = args.ws;
    volatile LAS unsigned* MISC = (volatile LAS unsigned*)(C.lds + MISC_OFF);
    if (C.tid < 32) MISC[C.tid] = 0u;
    __syncthreads();
    XcdBarrier bar; bar.bar = (unsigned*)(C.ws + WS_CTL) + CW_BAR; bar.x = 0; bar.st = nullptr;
    if (args.ph_hi - args.ph_lo > 1) bar = xcd_barrier_post((unsigned*)(C.ws + WS_CTL) + CW_BAR, MISC + 8);
#ifndef ONLY
#define ONLY -1
#endif
#define PHON(k) (ONLY < 0 || ONLY == (k))
#if MK_MULTI
#define IN(k) (fresh_args()->ph_lo <= (k) && (k) < fresh_args()->ph_hi)
#else
#define IN(k) true
#endif
#define SEAM(k) do { if (IN(k) && IN((k) + 1)) { XcdBarrier b_; b_.bar = (unsigned*)(fresh_args()->ws + WS_CTL) + CW_BAR; b_.x = xb_xcc_id(); b_.st = (volatile LAS unsigned*)(C.lds + MISC_OFF) + 8;     \
        xcd_barrier(b_, C.tid == 0); } } while (0)
    if (PHON(99) && IN(0)) { KA A_ = fresh_args(); enter_phase(C, A_); phase_prologue(C, A_); } SEAM(0);
    for (int l = 0; l < DEPTH; ++l) {
        const int pb = 1 + l * NPH;
        if (PHON(0) && IN(pb + 0)) { KA A_ = fresh_args(); enter_phase(C, A_); phase_norm1(C, A_, l); } SEAM(pb + 0);
        if (PHON(1) && IN(pb + 1)) { KA A_ = fresh_args(); enter_phase(C, A_); if (FAST_GEMM1) phase_gemm1_fast(C, A_, l); else phase_gemm1_naive(C, A_, l); } SEAM(pb + 1);
        if (!FAST_GEMM1 && PHON(2) && IN(pb + 2)) { KA A_ = fresh_args(); enter_phase(C, A_); phase_qknorm_naive(C, A_, l); } SEAM(pb + 2);
        if (PHON(3) && IN(pb + 3)) { KA A_ = fresh_args(); enter_phase(C, A_); if (FAST_RNN) phase_rnn_fast<0>(C, A_, l); else phase_rnn_naive<0>(C, A_, l); } SEAM(pb + 3);
        if (PHON(4) && IN(pb + 4)) { KA A_ = fresh_args(); enter_phase(C, A_); if (FAST_ATTN) phase_attn_fast(C, A_, l, (char*)lds); else phase_attn_naive(C, A_, l); } SEAM(pb + 4);
        if (PHON(5) && IN(pb + 5)) { KA A_ = fresh_args(); enter_phase(C, A_); if (FAST_RNN) phase_rnn_fast<1>(C, A_, l); else phase_rnn_naive<1>(C, A_, l); } SEAM(pb + 5);
        if (!FAST_RNN && PHON(6) && IN(pb + 6)) { KA A_ = fresh_args(); enter_phase(C, A_); phase_mixnorm_naive(C, A_, l); } SEAM(pb + 6);
        if (PHON(7) && IN(pb + 7)) { KA A_ = fresh_args(); enter_phase(C, A_); if (FAST_DENSE) phase_wo_fast(C, A_, l); else phase_wo_naive(C, A_, l); } SEAM(pb + 7);
        if (PHON(8) && IN(pb + 8)) { KA A_ = fresh_args(); enter_phase(C, A_); phase_router(C, A_, l); } SEAM(pb + 8);
        if (PHON(9) && IN(pb + 9)) { KA A_ = fresh_args(); enter_phase(C, A_); if (FAST_MOE) phase_g1_fast(C, A_, l); else phase_g1_naive(C, A_, l); } SEAM(pb + 9);
        if (PHON(10) && IN(pb + 10)) { KA A_ = fresh_args(); enter_phase(C, A_); if (FAST_MOE) phase_g2_fast(C, A_, l); else phase_g2_naive(C, A_, l); } SEAM(pb + 10);
        if (PHON(11) && IN(pb + 11)) { KA A_ = fresh_args(); enter_phase(C, A_); phase_combine(C, A_, l); } SEAM(pb + 11);
        if (PHON(12) && IN(pb + 12)) { KA A_ = fresh_args(); enter_phase(C, A_); if (FAST_DENSE) phase_proj_fast(C, A_, l); else phase_proj_naive(C, A_, l); } SEAM(pb + 12);
        if (PHON(13) && IN(pb + 13)) { KA A_ = fresh_args(); enter_phase(C, A_); if (FAST_DENSE) phase_ple_fast(C, A_, l); else phase_ple_naive(C, A_, l); } if (l + 1 < DEPTH) SEAM(pb + 13);
    }
#undef IN
#undef SEAM
}

extern "C" void kernel_launch(void* const* d_in, const int* in_sizes, int n_in, void* d_out, int out_size, void* d_ws, size_t ws_size, hipStream_t stream) {
    static int grid = 0;
    if (grid == 0) {
        if (n_in != 29 || out_size != T * D || ws_size < WS_END) { fprintf(stderr, "kernel_launch: unexpected problem (n_in %d, out %d, ws %zu)\n", n_in, out_size, ws_size); grid = -1; return; }
        int dev = 0, cus = 0, per_cu = 0;
        if (hipGetDevice(&dev) != hipSuccess || hipDeviceGetAttribute(&cus, hipDeviceAttributeMultiprocessorCount, dev) != hipSuccess) { grid = -1; return; }
        if (hipFuncSetAttribute((const void*)fwd_kernel, hipFuncAttributeMaxDynamicSharedMemorySize, LDS_BYTES) != hipSuccess) { fprintf(stderr, "kernel_launch: hipFuncSetAttribute failed\n"); grid = -1; return; }
        if (hipOccupancyMaxActiveBlocksPerMultiprocessor(&per_cu, (const void*)fwd_kernel, 512, LDS_BYTES) != hipSuccess || per_cu < 1) { fprintf(stderr, "kernel_launch: occupancy query says %d\n", per_cu); grid = -1; return; }
        (void)hipGetLastError();
        grid = cus;
    }
    if (grid < 0) return;
    hipMemsetAsync((char*)d_ws + WS_CTL, 0, CTL_ZERO_BYTES, stream);
    Args a{};
    for (int i = 0; i < 29; ++i) a.in[i] = (const float*)d_in[i];
    a.out = (float*)d_out; a.ws = (unsigned char*)d_ws;
#if MK_MULTI
    for (int ph = 0; ph < NPHASES; ++ph) { a.ph_lo = ph; a.ph_hi = ph + 1; hipLaunchKernelGGL(fwd_kernel, dim3(grid), dim3(512), LDS_BYTES, stream, a); }
#else
    a.ph_lo = 0; a.ph_hi = NPHASES;
    hipLaunchKernelGGL(fwd_kernel, dim3(grid), dim3(512), LDS_BYTES, stream, a);
#endif
}
```

```cpp
#include <hip/hip_runtime.h>
#include <cstdio>
#include <cstdint>
#include <cmath>
#include <hip/hip_bf16.h>

#define FAST_GEMM1 1
#define FAST_DENSE 1
#define FAST_MOE 1
#define FAST_ATTN 1
#define FAST_RNN 1
#define FAST_NORM 1
#ifndef PROBE_TIMING
#define PROBE_TIMING 0
#endif
#ifndef PROBE_LO
#define PROBE_LO 0
#define PROBE_HI 1
#endif
#ifndef PROBE_REP
#define PROBE_REP -1
#define PROBE_REPN 0
#endif
#define REPS(k) ((PROBE_REP == (k)) ? (1 + PROBE_REPN) : 1)
#define REPSL(k) ((((k) == 7 && l != 0) || ((k) == 13 && l != DEPTH - 1)) ? 1 : REPS(k))
#ifndef MK_MULTI
#define MK_MULTI 0
#endif

#define GAS __attribute__((address_space(1)))
#define LAS __attribute__((address_space(3)))
typedef unsigned short bf16;
typedef unsigned v4u __attribute__((ext_vector_type(4)));
typedef unsigned v2u __attribute__((ext_vector_type(2)));
typedef float f32x4 __attribute__((ext_vector_type(4)));

constexpr int NB = 4, S = 4096, T = NB * S, D = 1024, DIN = 2568, DR = 512, DA = 512, NH = 8, HD = 64;
constexpr int NE = 32, DE = 512, PLE = 256, DEPTH = 2, NZ = 2560;
constexpr float EPS = 1e-6f, LOG2E = 1.4426950408889634f, C2 = 0.125f * 1.4426950408889634f;
constexpr int CAP = 16384;
constexpr int HROWS = 40960;

constexpr size_t MiB = 1u << 20;
constexpr size_t WS_CTL = 0, CTL_ZERO_BYTES = 1 * MiB;
constexpr size_t WS_LOGF = 1 * MiB;
constexpr size_t WS_C2K = WS_LOGF + MiB / 2;
constexpr size_t WS_SA = 6 * MiB, WS_SH = 7 * MiB;
constexpr size_t WS_PAIRW = 3 * MiB;
constexpr size_t WS_ROWPAIR = 4 * MiB;
constexpr size_t WS_WIN = 8 * MiB;
constexpr size_t WS_WOUT = 18 * MiB;
constexpr size_t WS_WPG = 22 * MiB;
constexpr size_t WS_WPP = 26 * MiB;
constexpr size_t WS_WGU = 28 * MiB;
constexpr size_t WS_WDN = 156 * MiB;
constexpr size_t WS_PB = 220 * MiB;
constexpr size_t WS_XN = 236 * MiB;
constexpr size_t WS_X = 268 * MiB;
constexpr size_t WS_R1 = 332 * MiB;
constexpr size_t WS_R2 = 412 * MiB;
constexpr size_t WS_PROJ = 460 * MiB;
constexpr size_t WS_END = 492 * MiB;
constexpr int CW_BAR = 4096;
constexpr int CW_TS = 12288;
constexpr int CW_ATT = 11264;
constexpr int CW_CNT = 8192;

constexpr int RING_BYTES = 131072;
constexpr int MISC_OFF = RING_BYTES + 320;
constexpr int LDS_BYTES = 147456;

__device__ __forceinline__ unsigned f2bf(float f) { unsigned u = __builtin_bit_cast(unsigned, f); return (u + 0x7fffu + ((u >> 16) & 1u)) >> 16; }
__device__ __forceinline__ unsigned pk2(float lo, float hi) { return f2bf(lo) | (f2bf(hi) << 16); }
__device__ __forceinline__ float bf2f(unsigned u) { return __builtin_bit_cast(float, u << 16); }
__device__ __forceinline__ float bflo(unsigned w) { return __builtin_bit_cast(float, w << 16); }
__device__ __forceinline__ float bfhi(unsigned w) { return __builtin_bit_cast(float, w & 0xffff0000u); }
template <int O> __device__ __forceinline__ float lane_xor(float v) {
    if constexpr (O == 32) { const unsigned u = __builtin_bit_cast(unsigned, v); auto rr = __builtin_amdgcn_permlane32_swap(u, u, false, false);
        const unsigned a = rr[0], b = rr[1]; return __builtin_bit_cast(float, a == u ? b : a); }
    else return __builtin_bit_cast(float, __builtin_amdgcn_ds_swizzle(__builtin_bit_cast(int, v), (O << 10) | 0x1f));
}
__device__ __forceinline__ float wave_sum(float v) {
    v += lane_xor<1>(v); v += lane_xor<2>(v); v += lane_xor<4>(v); v += lane_xor<8>(v); v += lane_xor<16>(v);
    { const unsigned u = __builtin_bit_cast(unsigned, v); auto rr = __builtin_amdgcn_permlane32_swap(u, u, false, false); v = __builtin_bit_cast(float, (unsigned)rr[0]) + __builtin_bit_cast(float, (unsigned)rr[1]); }
    return v;
}
__device__ __forceinline__ float wave_max(float v) {
    v = fmaxf(v, lane_xor<1>(v)); v = fmaxf(v, lane_xor<2>(v)); v = fmaxf(v, lane_xor<4>(v)); v = fmaxf(v, lane_xor<8>(v)); v = fmaxf(v, lane_xor<16>(v));
    { const unsigned u = __builtin_bit_cast(unsigned, v); auto rr = __builtin_amdgcn_permlane32_swap(u, u, false, false); v = fmaxf(__builtin_bit_cast(float, (unsigned)rr[0]), __builtin_bit_cast(float, (unsigned)rr[1])); }
    return v;
}
__device__ __forceinline__ float half_sum32(float v) {
    const unsigned u = __builtin_bit_cast(unsigned, v); auto rr = __builtin_amdgcn_permlane32_swap(u, u, false, false); return __builtin_bit_cast(float, (unsigned)rr[0]) + __builtin_bit_cast(float, (unsigned)rr[1]);
}
__device__ __forceinline__ float sigmoidf_(float v) { return 1.f / (1.f + __expf(-v)); }
__device__ __forceinline__ float gelu_tanh(float v) { return 0.5f * v * (1.f + tanhf(0.7978845608028654f * (v + 0.044715f * v * v * v))); }
__device__ __forceinline__ float log_sigmoid(float v) { return v >= 0.f ? -log1pf(__expf(-v)) : v - log1pf(__expf(v)); }

#define XB_TMO      128
#define XB_XCNT(j)  (256  + 64 * (j))
#define XB_XSUB(j)  (1280 + 64 * (j))
#define XB_XGEN(j)  (2304 + 64 * (j))
#define XB_TOP      3328
#define XB_TOPGEN   3392
#define XCD_BAR_WORDS 3456
#define XB_SPIN_CAP (1u << 26)
__device__ __forceinline__ unsigned xb_ld(unsigned* p)              { return __hip_atomic_load(p, __ATOMIC_RELAXED, __HIP_MEMORY_SCOPE_AGENT); }
__device__ __forceinline__ unsigned xb_add(unsigned* p, unsigned v) { return __hip_atomic_fetch_add(p, v, __ATOMIC_RELAXED, __HIP_MEMORY_SCOPE_AGENT); }
__device__ __forceinline__ unsigned xb_xcc_id() { return (unsigned)__builtin_amdgcn_s_getreg((3 << 11) | 20) & 0xFu; }
#define XB_SPIN(cond, bar) do { unsigned _sp = 0; while (cond) { __builtin_amdgcn_s_sleep(1); \
    if ((++_sp & 255u) == 0u) { if (xb_ld(&(bar)[XB_TMO])) break; if (_sp > XB_SPIN_CAP) { atomicAdd(&(bar)[XB_TMO], 1u); break; } } } } while (0)
struct XcdBarrier { unsigned* bar; unsigned x; volatile LAS unsigned* st; };
__device__ __forceinline__ XcdBarrier xcd_barrier_post(unsigned* bar, volatile LAS unsigned* st) {
    XcdBarrier b; b.bar = bar; b.x = xb_xcc_id(); b.st = st;
    if (threadIdx.x == 0) (void)xb_add(&bar[XB_XCNT(b.x)], 1u);
    return b;
}
__device__ __forceinline__ void xcd_barrier_complete(unsigned* bar, unsigned x, unsigned& nloc, unsigned& nx) {
    const unsigned G = gridDim.x * gridDim.y * gridDim.z;
    unsigned sum, cnt, mine, sp = 0u;
    for (;;) {
        sum = 0u; cnt = 0u; mine = 0u;
#pragma unroll
        for (unsigned j = 0; j < 16; ++j) { const unsigned c = xb_ld(&bar[XB_XCNT(j)]); sum += c; cnt += (c > 0u) ? 1u : 0u; mine = (j == x) ? c : mine; }
        if (sum == G) break;
        __builtin_amdgcn_s_sleep(1);
        if ((++sp & 255u) == 0u) { if (xb_ld(&bar[XB_TMO])) break; if (sp > XB_SPIN_CAP) { atomicAdd(&bar[XB_TMO], 1u); break; } }
    }
    nloc = mine > 0u ? mine : 1u; nx = cnt > 0u ? cnt : 1u;
}
__device__ __forceinline__ void xcd_barrier(const XcdBarrier& b, const bool leader  ) {
    asm volatile("s_waitcnt vmcnt(0)" ::: "memory");
    __syncthreads();
    if (leader) {
        unsigned* bar = b.bar;
        __builtin_amdgcn_s_waitcnt(0);
        unsigned nloc = b.st[0], nx = b.st[1];
        if (nloc == 0u) { xcd_barrier_complete(bar, b.x, nloc, nx); b.st[0] = nloc; b.st[1] = nx; }
        const unsigned old = xb_add(&bar[XB_XSUB(b.x)], 1u);
        const unsigned gen = old / nloc;
        if (old + 1u == (gen + 1u) * nloc) {
            __builtin_amdgcn_fence(__ATOMIC_RELEASE, "agent");
            asm volatile("s_waitcnt vmcnt(0)" ::: "memory");
            const unsigned og = xb_add(&bar[XB_TOP], 1u);
            const unsigned tg = og / nx;
            if (og + 1u == (tg + 1u) * nx) xb_add(&bar[XB_TOPGEN], 1u);
            else XB_SPIN(xb_ld(&bar[XB_TOPGEN]) == tg, bar);
            __builtin_amdgcn_fence(__ATOMIC_ACQUIRE, "agent");
            xb_add(&bar[XB_XGEN(b.x)], 1u);
            asm volatile("s_waitcnt vmcnt(0)" ::: "memory");
        } else {
            XB_SPIN(xb_ld(&bar[XB_XGEN(b.x)]) == gen, bar);
            __builtin_amdgcn_fence(__ATOMIC_ACQUIRE, "agent");
            asm volatile("s_waitcnt vmcnt(0)" ::: "memory");
        }
    }
    __syncthreads();
}

struct Args { const float* in[29]; float* out; unsigned char* ws; int ph_lo, ph_hi; };
typedef const __attribute__((address_space(4))) Args* KA;
__device__ __forceinline__ KA fresh_args() { KA p = (KA)__builtin_amdgcn_kernarg_segment_ptr(); asm volatile("" : "+s"(p)); return p; }
struct Ctx;
struct Ctx {
    LAS unsigned char* lds;
    int tid, lane, wave, gw, ngw;
    int wave0;
    unsigned char* ws;
};
__device__ __forceinline__ void enter_phase(Ctx& C, KA A) {
    int t; asm volatile("v_mbcnt_lo_u32_b32 %0, -1, 0\n\tv_mbcnt_hi_u32_b32 %0, -1, %0" : "=v"(t)); t += C.wave0 * 64; C.tid = t; C.lane = t & 63; C.wave = __builtin_amdgcn_readfirstlane(t >> 6);
    C.gw = blockIdx.x * 8 + C.wave; C.ngw = gridDim.x * 8; C.ws = A->ws; }
enum { I_X = 0, I_P, I_MIXN, I_WIN, I_BF, I_CONVW, I_CONVB, I_WR, I_BR, I_WI, I_BI, I_LAM, I_QN, I_KN, I_LRUN, I_ATTN, I_WOUT, I_FFNN,
       I_WG, I_BG, I_WRT, I_BRT, I_WEG, I_WEU, I_WED, I_PLEN, I_WPG, I_BPG, I_WPP };

__device__ __forceinline__ void transpose_item(const float* W, int ldw, int K, bf16* WT, int k0, int n0, int c0, LAS float* scr, int lane) {
#pragma unroll 8
    for (int i = 0; i < 32; ++i) { const int kk = 2 * i + (lane >> 5); scr[kk * 33 + (lane & 31)] = W[(size_t)(k0 + kk) * ldw + c0 + (lane & 31)]; }
    asm volatile("s_waitcnt lgkmcnt(0)" ::: "memory");
    const int c = lane & 7;
#pragma unroll
    for (int j = 0; j < 4; ++j) { const int n = (lane >> 3) + 8 * j; const LAS float* s = scr + (8 * c) * 33 + n;
        v4u o; o.x = pk2(s[0 * 33], s[1 * 33]); o.y = pk2(s[2 * 33], s[3 * 33]); o.z = pk2(s[4 * 33], s[5 * 33]); o.w = pk2(s[6 * 33], s[7 * 33]);
        *(v4u*)(WT + (size_t)(n0 + n) * K + k0 + 8 * c) = o; }
    asm volatile("s_waitcnt lgkmcnt(0)" ::: "memory");
}
__device__ __forceinline__ void phase_prologue(Ctx& C, KA AR) {
    LAS float* scr = (LAS float*)(C.lds + C.wave * 16384);
    constexpr int I_IN = 16 * 80, I_OUT = 16 * 32, I_GU = 32 * 16 * 32, I_DN = 32 * 8 * 32, I_PG = 16 * 32, I_PP = 4 * 32;
    constexpr int PER_L = I_IN + I_OUT + I_GU + I_DN + I_PG + I_PP;
    for (int it = C.gw; it < DEPTH * PER_L; it += C.ngw) {
        const int l = it / PER_L; int r = it % PER_L;
        if (r < I_IN) {
            const int kb = r / 80, nb = r % 80, n0 = 32 * nb, pn = n0 >> 8, jl = n0 & 255, bj = jl >> 7, wc = (jl >> 5) & 3;
            transpose_item(AR->in[I_WIN] + (size_t)l * D * DIN, DIN, D, (bf16*)(C.ws + WS_WIN) + (size_t)l * NZ * D, 64 * kb, n0, 256 * pn + 64 * wc + 32 * bj, scr, C.lane); continue; }
        r -= I_IN;
        if (r < I_OUT) { const int kb = r / 32, nb = r % 32;
            transpose_item(AR->in[I_WOUT] + (size_t)l * D * D, D, D, (bf16*)(C.ws + WS_WOUT) + (size_t)l * D * D, 64 * kb, 32 * nb, 32 * nb, scr, C.lane); continue; }
        r -= I_OUT;
        if (r < I_GU) {
            const int e = r / 512, q = r % 512, kb = q / 32, nb = q % 32, n0 = 32 * nb, pn = n0 >> 8, jl = n0 & 255;
            const float* src = (jl < 128 ? AR->in[I_WEG] : AR->in[I_WEU]) + (size_t)(l * NE + e) * D * DE;
            transpose_item(src, DE, D, (bf16*)(C.ws + WS_WGU) + (size_t)(l * NE + e) * 1024 * D, 64 * kb, n0, 128 * pn + (jl & 127), scr, C.lane); continue; }
        r -= I_GU;
        if (r < I_DN) { const int e = r / 256, q = r % 256, kb = q / 32, nb = q % 32;
            transpose_item(AR->in[I_WED] + (size_t)(l * NE + e) * DE * D, D, DE, (bf16*)(C.ws + WS_WDN) + (size_t)(l * NE + e) * D * DE, 64 * kb, 32 * nb, 32 * nb, scr, C.lane); continue; }
        r -= I_DN;
        if (r < I_PG) { const int kb = r / 32, nb = r % 32;
            transpose_item(AR->in[I_WPG] + (size_t)l * D * D, D, D, (bf16*)(C.ws + WS_WPG) + (size_t)l * D * D, 64 * kb, 32 * nb, 32 * nb, scr, C.lane); continue; }
        r -= I_PG;
        { const int kb = r / 32, nb = r % 32;
            transpose_item(AR->in[I_WPP] + (size_t)l * PLE * D, D, PLE, (bf16*)(C.ws + WS_WPP) + (size_t)l * D * PLE, 64 * kb, 32 * nb, 32 * nb, scr, C.lane); }
    }
    const f32x4* ps = (const f32x4*)AR->in[I_P]; v2u* pd = (v2u*)(C.ws + WS_PB);
    const size_t n4 = (size_t)DEPTH * T * PLE / 4;
    for (size_t i = (size_t)blockIdx.x * 512 + C.tid; i < n4; i += (size_t)gridDim.x * 512) { const f32x4 v = ps[i]; v2u o; o.x = pk2(v.x, v.y); o.y = pk2(v.z, v.w); pd[i] = o; }
}

__device__ __forceinline__ void load_row(const float* row, int lane, f32x4 (&v)[4]) {
    const f32x4* xr = (const f32x4*)row + lane;
#pragma unroll
    for (int j = 0; j < 4; ++j) v[j] = xr[64 * j];
}
__device__ __forceinline__ float row_rs(const f32x4 (&v)[4]) {
    float s = 0.f;
#pragma unroll
    for (int j = 0; j < 4; ++j) s += (v[j].x * v[j].x + v[j].y * v[j].y) + (v[j].z * v[j].z + v[j].w * v[j].w);
    return rsqrtf(wave_sum(s) * (1.f / D) + EPS);
}
__device__ __forceinline__ void scale_row(f32x4 (&v)[4], float rs, const float* gain, int lane) {
    const f32x4* g = (const f32x4*)gain + lane;
#pragma unroll
    for (int j = 0; j < 4; ++j) v[j] = v[j] * rs * g[64 * j];
}
__device__ __forceinline__ void store_row_bf16(bf16* row, int lane, const f32x4 (&v)[4]) {
    v2u* o = (v2u*)row + lane;
#pragma unroll
    for (int j = 0; j < 4; ++j) { v2u w; w.x = pk2(v[j].x, v[j].y); w.y = pk2(v[j].z, v[j].w); o[64 * j] = w; }
}

__device__ __forceinline__ void phase_norm1(Ctx& C, KA AR, int l) {
    const float* xs = l == 0 ? AR->in[I_X] : (const float*)(C.ws + WS_X);
    const float* gain = AR->in[I_MIXN] + l * D;
    const float* wf = AR->in[I_WIN] + (size_t)l * D * DIN + NZ;
    const float* bfg = AR->in[I_BF] + l * NH;
    bf16* xn = (bf16*)(C.ws + WS_XN); float* logf = (float*)(C.ws + WS_LOGF);
    for (int t = C.gw; t < T; t += C.ngw) {
        f32x4 v[4]; load_row(xs + (size_t)t * D, C.lane, v);
        const float rs = row_rs(v); scale_row(v, rs, gain, C.lane);
        store_row_bf16(xn + (size_t)t * D, C.lane, v);
        float z[8] = {0.f, 0.f, 0.f, 0.f, 0.f, 0.f, 0.f, 0.f};
#pragma unroll
        for (int j = 0; j < 4; ++j)
#pragma unroll
            for (int e = 0; e < 4; ++e) { const int k = 256 * j + 4 * C.lane + e; const f32x4 w0 = *(const f32x4*)(wf + (size_t)k * DIN), w1 = *(const f32x4*)(wf + (size_t)k * DIN + 4);
                const float a = v[j][e]; z[0] += a * w0.x; z[1] += a * w0.y; z[2] += a * w0.z; z[3] += a * w0.w; z[4] += a * w1.x; z[5] += a * w1.y; z[6] += a * w1.z; z[7] += a * w1.w; }
#pragma unroll
        for (int h = 0; h < 8; ++h) z[h] = wave_sum(z[h]);
        float mine = 0.f;
#pragma unroll
        for (int h = 0; h < 8; ++h) mine = (C.lane == h) ? z[h] : mine;
        if (C.lane < 8) logf[(size_t)t * 8 + C.lane] = log_sigmoid(mine + bfg[C.lane]);
    }
}

template <int NACC, class AR, class BR, class EP>
__device__ __forceinline__ void ngemm_tile(LAS float* sm, int K, AR arow, BR brow, EP epi, const int tid) {
    LAS float* As = sm; LAS float* Bs = sm + 32 * 68;
    const int ty = tid >> 4, tx = tid & 15, lr = tid >> 3, lk = (tid & 7) * 4;
    float acc[NACC][2][4];
#pragma unroll
    for (int a = 0; a < NACC; ++a)
#pragma unroll
        for (int i = 0; i < 2; ++i)
#pragma unroll
            for (int j = 0; j < 4; ++j) acc[a][i][j] = 0.f;
    const bf16* ap = arow(lr); const bf16* bp0 = brow(lr, 0); const bf16* bp1 = NACC > 1 ? brow(lr, 1) : bp0;
    for (int k0 = 0; k0 < K; k0 += 32) {
        __syncthreads();
        { v2u av; av.x = 0u; av.y = 0u; if (ap) av = *(const v2u*)(ap + k0 + lk);
          As[(lk + 0) * 68 + lr] = bflo(av.x); As[(lk + 1) * 68 + lr] = bfhi(av.x); As[(lk + 2) * 68 + lr] = bflo(av.y); As[(lk + 3) * 68 + lr] = bfhi(av.y); }
        { const v2u bv = *(const v2u*)(bp0 + k0 + lk);
          Bs[(lk + 0) * 68 + lr] = bflo(bv.x); Bs[(lk + 1) * 68 + lr] = bfhi(bv.x); Bs[(lk + 2) * 68 + lr] = bflo(bv.y); Bs[(lk + 3) * 68 + lr] = bfhi(bv.y); }
        if (NACC > 1) { const v2u bv = *(const v2u*)(bp1 + k0 + lk); LAS float* B1 = Bs + 32 * 68;
          B1[(lk + 0) * 68 + lr] = bflo(bv.x); B1[(lk + 1) * 68 + lr] = bfhi(bv.x); B1[(lk + 2) * 68 + lr] = bflo(bv.y); B1[(lk + 3) * 68 + lr] = bfhi(bv.y); }
        __syncthreads();
#pragma unroll 8
        for (int kk = 0; kk < 32; ++kk) {
            const float a0 = As[kk * 68 + ty * 2], a1 = As[kk * 68 + ty * 2 + 1];
#pragma unroll
            for (int a = 0; a < NACC; ++a) { const f32x4 b = *(const LAS f32x4*)(Bs + a * 32 * 68 + kk * 68 + tx * 4);
#pragma unroll
                for (int j = 0; j < 4; ++j) { acc[a][0][j] += a0 * b[j]; acc[a][1][j] += a1 * b[j]; } }
        }
    }
#pragma unroll
    for (int i = 0; i < 2; ++i)
#pragma unroll
        for (int j = 0; j < 4; ++j) epi(ty * 2 + i, tx * 4 + j, acc[0][i][j], NACC > 1 ? acc[1][i][j] : 0.f);
}

__device__ __forceinline__ void phase_cumsum(Ctx& C, KA AR) {
    if (C.gw < NB * NH) {
        const int b = C.gw / NH, h = C.gw % NH;
        const float* logf = (const float*)(C.ws + WS_LOGF) + (size_t)b * S * 8 + h; float* c2k = (float*)(C.ws + WS_C2K) + (size_t)C.gw * S;
        float s = 0.f;
        for (int i = 0; i < 64; ++i) s += logf[(size_t)(64 * C.lane + i) * 8];
        float inc = s;
#pragma unroll
        for (int o = 1; o < 64; o <<= 1) { const float v = __builtin_bit_cast(float, __builtin_amdgcn_ds_bpermute((C.lane - o) << 2, __builtin_bit_cast(int, inc))); if (C.lane >= o) inc += v; }
        float run = inc - s;
        for (int i = 0; i < 64; ++i) { run += logf[(size_t)(64 * C.lane + i) * 8]; c2k[64 * C.lane + i] = run * LOG2E; }
    }
}
__device__ __forceinline__ void phase_gemm1_naive(Ctx& C, KA AR, int l) {
    phase_cumsum(C, AR);
    const bf16* A = (const bf16*)(C.ws + WS_XN); const bf16* Bt = (const bf16*)(C.ws + WS_WIN) + (size_t)l * NZ * D;
    bf16* R1 = (bf16*)(C.ws + WS_R1);
    for (int u = blockIdx.x; u < (T / 64) * (NZ / 64); u += gridDim.x) {
        const int mt = u / (NZ / 64), nt = u % (NZ / 64), m0 = 64 * mt, n0 = 64 * nt;
        ngemm_tile<1>((LAS float*)C.lds, D, [=](int r) { return A + (size_t)(m0 + r) * D; }, [=](int c, int) { return Bt + (size_t)(n0 + c) * D; },
            [=](int r, int c, float v, float) {
                const int j = n0 + c, pn = j >> 8, jl = j & 255, bj = jl >> 7, wc = (jl >> 5) & 3, col = 256 * pn + 64 * wc + 32 * bj + (jl & 31);
                const int seg = col >> 9, cc = col & 511;
                const float o = seg == 1 ? gelu_tanh(v) : v;
                R1[(size_t)seg * T * 512 + (size_t)(m0 + r) * 512 + cc] = (bf16)f2bf(o);
            }, C.tid);
    }
}
__device__ __forceinline__ void phase_qknorm_naive(Ctx& C, KA AR, int l) {
    bf16* Q = (bf16*)(C.ws + WS_R1) + (size_t)2 * T * 512; bf16* Kb = Q + (size_t)T * 512;
    const float* gq = AR->in[I_QN] + l * HD; const float* gk = AR->in[I_KN] + l * HD;
    for (int i = C.gw; i < 2 * T; i += C.ngw) {
        const int t = i >> 1, isk = i & 1; bf16* row = (isk ? Kb : Q) + (size_t)t * 512; const float* g = isk ? gk : gq;
        const v4u w = *(const v4u*)(row + 8 * C.lane);
        float x[8] = {bflo(w.x), bfhi(w.x), bflo(w.y), bfhi(w.y), bflo(w.z), bfhi(w.z), bflo(w.w), bfhi(w.w)};
        float s = 0.f;
#pragma unroll
        for (int e = 0; e < 8; ++e) s += x[e] * x[e];
        s += lane_xor<1>(s); s += lane_xor<2>(s); s += lane_xor<4>(s);
        const float rs = rsqrtf(s * (1.f / 64.f) + EPS) * (isk ? 1.f : C2);
        const int d0 = 8 * (C.lane & 7);
#pragma unroll
        for (int e = 0; e < 8; ++e) x[e] = x[e] * rs * g[d0 + e];
        v4u o; o.x = pk2(x[0], x[1]); o.y = pk2(x[2], x[3]); o.z = pk2(x[4], x[5]); o.w = pk2(x[6], x[7]);
        *(v4u*)(row + 8 * C.lane) = o;
    }
}

template <int MODE>
__device__ __forceinline__ void phase_rnn_naive(Ctx& C, KA AR, int l) {
    LAS float* xcs = (LAS float*)C.lds; LAS float* as = xcs + 64 * 65; LAS float* us = as + 64 * 64;
    const bf16* ZX = (const bf16*)(C.ws + WS_R1); const bf16* ZG = ZX + (size_t)T * 512;
    float* SA = (float*)(C.ws + WS_SA); float* SH = (float*)(C.ws + WS_SH); float* YR = (float*)(C.ws + WS_PROJ);
    const float* cw = AR->in[I_CONVW] + l * 4 * DR; const float* cb = AR->in[I_CONVB] + l * DR;
    const float* wr = AR->in[I_WR] + (size_t)l * 8 * 64 * 64; const float* wi = AR->in[I_WI] + (size_t)l * 8 * 64 * 64;
    const float* br = AR->in[I_BR] + l * DR; const float* bi = AR->in[I_BI] + l * DR; const float* lam = AR->in[I_LAM] + l * DR;
    for (int u = blockIdx.x; u < NB * 64 * 8; u += gridDim.x) {
        const int b = u >> 9, cidx = (u >> 3) & 63, blk = u & 7;
        __syncthreads();
#pragma unroll
        for (int i = 0; i < 8; ++i) { const int e = C.tid + 512 * i, t = e >> 6, c = e & 63, ch = blk * 64 + c, tg = cidx * 64 + t;
            float xc = cb[ch];
#pragma unroll
            for (int j = 0; j < 4; ++j) { const int tt = tg - 3 + j; if (tt >= 0) xc += cw[j * DR + ch] * bf2f(ZX[(size_t)(b * S + tt) * 512 + ch]); }
            xcs[t * 65 + c] = xc; }
        __syncthreads();
#pragma unroll
        for (int i = 0; i < 8; ++i) { const int e = C.tid + 512 * i, t = e >> 6, j = e & 63, ch = blk * 64 + j;
            float ar = br[ch], ai = bi[ch];
            for (int k = 0; k < 64; ++k) { const float x = xcs[t * 65 + k]; ar += x * wr[(size_t)(blk * 64 + k) * 64 + j]; ai += x * wi[(size_t)(blk * 64 + k) * 64 + j]; }
            const float r = sigmoidf_(ar), ig = sigmoidf_(ai);
            const float la = -8.f * r * log1pf(__expf(-lam[ch]));
            as[t * 64 + j] = __expf(la); us[t * 64 + j] = sqrtf(-expm1f(2.f * la)) * (ig * xcs[t * 65 + j]); }
        __syncthreads();
        if (C.tid < 64) { const int j = C.tid, ch = blk * 64 + j;
            if (MODE == 0) { float A = 1.f, H = 0.f;
                for (int t = 0; t < 64; ++t) { const float a = as[t * 64 + j]; H = a * H + us[t * 64 + j]; A *= a; }
                SA[(size_t)(b * 64 + cidx) * 512 + ch] = A; SH[(size_t)(b * 64 + cidx) * 512 + ch] = H;
            } else { float h = 0.f;
                for (int c2 = 0; c2 < cidx; ++c2) h = SA[(size_t)(b * 64 + c2) * 512 + ch] * h + SH[(size_t)(b * 64 + c2) * 512 + ch];
                for (int t = 0; t < 64; ++t) { h = as[t * 64 + j] * h + us[t * 64 + j]; as[t * 64 + j] = h; } } }
        if (MODE == 1) { __syncthreads();
#pragma unroll
            for (int i = 0; i < 8; ++i) { const int e = C.tid + 512 * i, t = e >> 6, c = e & 63, ch = blk * 64 + c; const size_t row = (size_t)(b * S + cidx * 64 + t);
                YR[row * 512 + ch] = as[t * 64 + c] * bf2f(ZG[row * 512 + ch]); } }
    }
}

__device__ __forceinline__ void phase_attn_naive(Ctx& C, KA AR, int l) {
    LAS float* Ks = (LAS float*)C.lds; LAS float* Vs = Ks + 64 * 65; LAS float* Qs = Vs + 64 * 65; LAS float* Ps = Qs + 64 * 64; LAS float* cks = Ps + 8 * 64;
    const bf16* Q = (const bf16*)(C.ws + WS_R1) + (size_t)2 * T * 512; const bf16* Kb = Q + (size_t)T * 512; const bf16* Vb = Kb + (size_t)T * 512;
    bf16* O = (bf16*)(C.ws + WS_R2); const float* c2k = (const float*)(C.ws + WS_C2K);
    for (int u = blockIdx.x; u < NB * NH * 64; u += gridDim.x) {
        const int qt = 63 - (u >> 5), bh = u & 31, b = bh >> 3, h = bh & 7, q0 = 64 * qt;
        const float* ck = c2k + (size_t)bh * S;
        __syncthreads();
        for (int e = C.tid; e < 64 * 64; e += 512) { const int r = e >> 6, d = e & 63; Qs[r * 64 + d] = bf2f(Q[(size_t)(b * S + q0 + r) * 512 + h * 64 + d]); }
        float m[8], lsum[8], o[8], cq[8];
#pragma unroll
        for (int i = 0; i < 8; ++i) { m[i] = -INFINITY; lsum[i] = 0.f; o[i] = 0.f; cq[i] = ck[q0 + C.wave * 8 + i]; }
        for (int kt = 0; kt <= qt; ++kt) {
            const int k0 = 64 * kt;
            __syncthreads();
            for (int e = C.tid; e < 64 * 64; e += 512) { const int r = e >> 6, d = e & 63; const size_t g = (size_t)(b * S + k0 + r) * 512 + h * 64 + d; Ks[r * 65 + d] = bf2f(Kb[g]); Vs[r * 65 + d] = bf2f(Vb[g]); }
            if (C.tid < 64) cks[C.tid] = ck[k0 + C.tid];
            __syncthreads();
#pragma unroll
            for (int i = 0; i < 8; ++i) {
                const int q = C.wave * 8 + i, qg = q0 + q;
                float dot = 0.f;
#pragma unroll 16
                for (int d = 0; d < 64; ++d) dot += Qs[q * 64 + d] * Ks[C.lane * 65 + d];
                float s = dot + cq[i] - cks[C.lane];
                if (k0 + C.lane > qg) s = -INFINITY;
                const float mn = fmaxf(m[i], wave_max(s));
                const float alpha = exp2f(m[i] - mn), p = exp2f(s - mn);
                lsum[i] = lsum[i] * alpha + wave_sum(p); m[i] = mn;
                Ps[C.wave * 64 + C.lane] = p;
                asm volatile("s_waitcnt lgkmcnt(0)" ::: "memory");
                float acc = 0.f;
#pragma unroll 16
                for (int k = 0; k < 64; ++k) acc += Ps[C.wave * 64 + k] * Vs[k * 65 + C.lane];
                o[i] = o[i] * alpha + acc;
                asm volatile("s_waitcnt lgkmcnt(0)" ::: "memory");
            }
        }
#pragma unroll
        for (int i = 0; i < 8; ++i) O[(size_t)(b * S + q0 + C.wave * 8 + i) * 512 + h * 64 + C.lane] = (bf16)f2bf(o[i] / lsum[i]);
    }
}

__device__ __forceinline__ void phase_mixnorm_naive(Ctx& C, KA AR, int l) {
    const float* YR = (const float*)(C.ws + WS_PROJ); const bf16* O = (const bf16*)(C.ws + WS_R2); bf16* YM = (bf16*)(C.ws + WS_R2 + 16 * MiB);
    const float* g1 = AR->in[I_LRUN] + l * DR; const float* g2 = AR->in[I_ATTN] + l * DA;
    for (int t = C.gw; t < T; t += C.ngw) {
        f32x4 a[2]; float s = 0.f;
#pragma unroll
        for (int j = 0; j < 2; ++j) { a[j] = *((const f32x4*)(YR + (size_t)t * 512) + C.lane + 64 * j); s += (a[j].x * a[j].x + a[j].y * a[j].y) + (a[j].z * a[j].z + a[j].w * a[j].w); }
        float rs = rsqrtf(wave_sum(s) * (1.f / 512.f) + EPS);
#pragma unroll
        for (int j = 0; j < 2; ++j) { const f32x4 g = *((const f32x4*)g1 + C.lane + 64 * j); const f32x4 v = a[j] * rs * g; v2u w; w.x = pk2(v.x, v.y); w.y = pk2(v.z, v.w);
            *((v2u*)(YM + (size_t)t * D) + C.lane + 64 * j) = w; }
        const v4u w = *(const v4u*)(O + (size_t)t * 512 + 8 * C.lane);
        float x[8] = {bflo(w.x), bfhi(w.x), bflo(w.y), bfhi(w.y), bflo(w.z), bfhi(w.z), bflo(w.w), bfhi(w.w)};
        s = 0.f;
#pragma unroll
        for (int e = 0; e < 8; ++e) s += x[e] * x[e];
        rs = rsqrtf(wave_sum(s) * (1.f / 512.f) + EPS);
#pragma unroll
        for (int e = 0; e < 8; ++e) x[e] = x[e] * rs * g2[8 * C.lane + e];
        v4u o; o.x = pk2(x[0], x[1]); o.y = pk2(x[2], x[3]); o.z = pk2(x[4], x[5]); o.w = pk2(x[6], x[7]);
        *(v4u*)(YM + (size_t)t * D + 512 + 8 * C.lane) = o;
    }
}

__device__ __forceinline__ void phase_wo_naive(Ctx& C, KA AR, int l) {
    const bf16* A = (const bf16*)(C.ws + WS_R2 + 16 * MiB); const bf16* Bt = (const bf16*)(C.ws + WS_WOUT) + (size_t)l * D * D;
    const float* xs = l == 0 ? AR->in[I_X] : (const float*)(C.ws + WS_X); float* X = (float*)(C.ws + WS_X);
    for (int u = blockIdx.x; u < (T / 64) * (D / 64); u += gridDim.x) {
        const int m0 = 64 * (u / (D / 64)), n0 = 64 * (u % (D / 64));
        ngemm_tile<1>((LAS float*)C.lds, D, [=](int r) { return A + (size_t)(m0 + r) * D; }, [=](int c, int) { return Bt + (size_t)(n0 + c) * D; },
            [=](int r, int c, float v, float) { const size_t i = (size_t)(m0 + r) * D + n0 + c; X[i] = xs[i] + v; }, C.tid);
    }
}

__device__ __forceinline__ void phase_router(Ctx& C, KA AR, int l) {
    const float* X = (const float*)(C.ws + WS_X); bf16* xn = (bf16*)(C.ws + WS_XN);
    const float* gain = AR->in[I_FFNN] + l * D; const float* wg = AR->in[I_WG] + (size_t)l * D * 4; const float* bg = AR->in[I_BG] + l * 4;
    const float* wr = AR->in[I_WRT] + (size_t)l * D * NE; const float* brt = AR->in[I_BRT] + l * NE;
    unsigned* cnt = (unsigned*)(C.ws + WS_CTL) + CW_CNT + 64 * l; int* rowpair = (int*)(C.ws + WS_ROWPAIR); float* pairw = (float*)(C.ws + WS_PAIRW);
    for (int t = C.gw; t < T; t += C.ngw) {
        f32x4 v[4]; load_row(X + (size_t)t * D, C.lane, v);
        const float rs = row_rs(v); scale_row(v, rs, gain, C.lane);
        store_row_bf16(xn + (size_t)t * D, C.lane, v);
        LAS float* rowl = (LAS float*)C.lds + C.wave * 1024;
#pragma unroll
        for (int j = 0; j < 4; ++j) *((LAS f32x4*)rowl + C.lane + 64 * j) = v[j];
        asm volatile("s_waitcnt lgkmcnt(0)" ::: "memory");
        float acc = 0.f;
        if (C.lane < 36) {
            const float* wp = C.lane < 32 ? wr + C.lane : wg + (C.lane - 32); const int st = C.lane < 32 ? NE : 4;
#pragma unroll 8
            for (int k = 0; k < D; ++k) acc += rowl[k] * wp[(size_t)k * st];
            acc += C.lane < 32 ? brt[C.lane] : bg[C.lane - 32];
        }
        asm volatile("s_waitcnt lgkmcnt(0)" ::: "memory");
        float gl[4];
#pragma unroll
        for (int i = 0; i < 4; ++i) gl[i] = __builtin_bit_cast(float, __builtin_amdgcn_readlane(__builtin_bit_cast(int, acc), 32 + i));
        int gi = 0; float gm = gl[0];
#pragma unroll
        for (int i = 1; i < 4; ++i) if (gl[i] > gm) { gm = gl[i]; gi = i; }
        float gs = 0.f;
#pragma unroll
        for (int i = 0; i < 4; ++i) gs += __expf(gl[i] - gm);
        const float gp = 1.f / gs;
        float ev[8];
#pragma unroll
        for (int i = 0; i < 8; ++i) ev[i] = __builtin_bit_cast(float, __builtin_amdgcn_readlane(__builtin_bit_cast(int, acc), __builtin_amdgcn_readfirstlane(gi) * 8 + i));
        int i0 = 0; float t0 = ev[0];
#pragma unroll
        for (int i = 1; i < 8; ++i) if (ev[i] > t0) { t0 = ev[i]; i0 = i; }
        int i1 = -1; float t1 = -INFINITY;
#pragma unroll
        for (int i = 0; i < 8; ++i) if (i != i0 && ev[i] > t1) { t1 = ev[i]; i1 = i; }
        const float ex = __expf(t1 - t0), w0 = gp / (1.f + ex), w1 = gp * ex / (1.f + ex);
        if (C.lane < 2) { const int e = gi * 8 + (C.lane == 0 ? i0 : i1); const unsigned pos = atomicAdd(cnt + e, 1u);
            rowpair[(size_t)e * CAP + pos] = 2 * t + C.lane; pairw[2 * t + C.lane] = C.lane == 0 ? w0 : w1; }
    }
}

struct ExpTab { int n[NE], hoff[NE], t0[NE + 1]; };
__device__ __forceinline__ void build_exptab(Ctx& C, int l, LAS int* tab) {
    __syncthreads();
    if (C.tid == 0) { const unsigned* cnt = (const unsigned*)(C.ws + WS_CTL) + CW_CNT + 64 * l; int ho = 0, tt = 0;
        for (int e = 0; e < NE; ++e) { const int n = (int)__hip_atomic_load(cnt + e, __ATOMIC_RELAXED, __HIP_MEMORY_SCOPE_AGENT); tab[e] = n; tab[32 + e] = ho; tab[64 + e] = tt; ho += (n + 255) & ~255; tt += (n + 63) >> 6; }
        tab[64 + NE] = tt; }
    __syncthreads();
}
__device__ __forceinline__ void phase_g1_naive(Ctx& C, KA AR, int l) {
    LAS int* tab = (LAS int*)(C.lds + 65536); build_exptab(C, l, tab);
    const bf16* xn = (const bf16*)(C.ws + WS_XN); const int* rowpair = (const int*)(C.ws + WS_ROWPAIR); bf16* Hb = (bf16*)(C.ws + WS_R2);
    const int nmt = tab[64 + NE];
    for (int u = blockIdx.x; u < nmt * 8; u += gridDim.x) {
        const int mtg = u >> 3, nt = u & 7; int e = 0;
        for (int i = 1; i < NE; ++i) if (tab[64 + i] <= mtg) e = i;
        const int mt = mtg - tab[64 + e], ne = tab[e], ho = tab[32 + e], p0 = 64 * mt, c0 = 64 * nt;
        const bf16* Bt = (const bf16*)(C.ws + WS_WGU) + (size_t)(l * NE + e) * 1024 * D; const int* rp = rowpair + (size_t)e * CAP;
        ngemm_tile<2>((LAS float*)C.lds, D,
            [=](int r) { return (p0 + r < ne) ? xn + (size_t)(rp[p0 + r] >> 1) * D : (const bf16*)nullptr; },
            [=](int c, int a) { const int cc = c0 + c; return Bt + (size_t)((cc >> 7) * 256 + (cc & 127) + a * 128) * D; },
            [=](int r, int c, float g, float uu) { if (p0 + r < ne) Hb[(size_t)(ho + p0 + r) * DE + c0 + c] = (bf16)f2bf(g / (1.f + __expf(-g)) * uu); }, C.tid);
    }
}
__device__ __forceinline__ void phase_g2_naive(Ctx& C, KA AR, int l) {
    LAS int* tab = (LAS int*)(C.lds + 65536); build_exptab(C, l, tab);
    const int* rowpair = (const int*)(C.ws + WS_ROWPAIR); const float* pairw = (const float*)(C.ws + WS_PAIRW); const bf16* Hb = (const bf16*)(C.ws + WS_R2); bf16* Y2 = (bf16*)(C.ws + WS_R1);
    const int nmt = tab[64 + NE];
    for (int u = blockIdx.x; u < nmt * 16; u += gridDim.x) {
        const int mtg = u >> 4, nt = u & 15; int e = 0;
        for (int i = 1; i < NE; ++i) if (tab[64 + i] <= mtg) e = i;
        const int mt = mtg - tab[64 + e], ne = tab[e], ho = tab[32 + e], p0 = 64 * mt, c0 = 64 * nt;
        const bf16* Bt = (const bf16*)(C.ws + WS_WDN) + (size_t)(l * NE + e) * D * DE; const int* rp = rowpair + (size_t)e * CAP;
        ngemm_tile<1>((LAS float*)C.lds, DE,
            [=](int r) { return (p0 + r < ne) ? Hb + (size_t)(ho + p0 + r) * DE : (const bf16*)nullptr; },
            [=](int c, int) { return Bt + (size_t)(c0 + c) * DE; },
            [=](int r, int c, float v, float) { if (p0 + r < ne) { const int p = rp[p0 + r]; Y2[(size_t)p * D + c0 + c] = (bf16)f2bf(v * pairw[p]); } }, C.tid);
    }
}

__device__ __forceinline__ void phase_combine(Ctx& C, KA AR, int l) {
    float* X = (float*)(C.ws + WS_X); const bf16* Y2 = (const bf16*)(C.ws + WS_R1); bf16* xn = (bf16*)(C.ws + WS_XN); const float* gain = AR->in[I_PLEN] + l * D;
    for (int t = C.gw; t < T; t += C.ngw) {
        f32x4 v[4]; load_row(X + (size_t)t * D, C.lane, v);
#pragma unroll
        for (int j = 0; j < 4; ++j) { const v2u a = *((const v2u*)(Y2 + (size_t)(2 * t) * D) + C.lane + 64 * j), b = *((const v2u*)(Y2 + (size_t)(2 * t + 1) * D) + C.lane + 64 * j);
            v[j].x += bflo(a.x) + bflo(b.x); v[j].y += bfhi(a.x) + bfhi(b.x); v[j].z += bflo(a.y) + bflo(b.y); v[j].w += bfhi(a.y) + bfhi(b.y);
            *((f32x4*)(X + (size_t)t * D) + C.lane + 64 * j) = v[j]; }
        const float rs = row_rs(v); scale_row(v, rs, gain, C.lane);
        store_row_bf16(xn + (size_t)t * D, C.lane, v);
    }
}

__device__ __forceinline__ void phase_proj_naive(Ctx& C, KA AR, int l) {
    const bf16* A = (const bf16*)(C.ws + WS_PB) + (size_t)l * T * PLE; const bf16* Bt = (const bf16*)(C.ws + WS_WPP) + (size_t)l * D * PLE; bf16* PR = (bf16*)(C.ws + WS_PROJ);
    for (int u = blockIdx.x; u < (T / 64) * (D / 64); u += gridDim.x) {
        const int m0 = 64 * (u / (D / 64)), n0 = 64 * (u % (D / 64));
        ngemm_tile<1>((LAS float*)C.lds, PLE, [=](int r) { return A + (size_t)(m0 + r) * PLE; }, [=](int c, int) { return Bt + (size_t)(n0 + c) * PLE; },
            [=](int r, int c, float v, float) { PR[(size_t)(m0 + r) * D + n0 + c] = (bf16)f2bf(v); }, C.tid);
    }
}
__device__ __forceinline__ void phase_ple_naive(Ctx& C, KA AR, int l) {
    const bf16* A = (const bf16*)(C.ws + WS_XN); const bf16* Bt = (const bf16*)(C.ws + WS_WPG) + (size_t)l * D * D; const bf16* PR = (const bf16*)(C.ws + WS_PROJ);
    const float* X = (const float*)(C.ws + WS_X); float* dst = l == DEPTH - 1 ? AR->out : (float*)(C.ws + WS_X); const float* bias = AR->in[I_BPG] + l * D;
    for (int u = blockIdx.x; u < (T / 64) * (D / 64); u += gridDim.x) {
        const int m0 = 64 * (u / (D / 64)), n0 = 64 * (u % (D / 64));
        ngemm_tile<1>((LAS float*)C.lds, D, [=](int r) { return A + (size_t)(m0 + r) * D; }, [=](int c, int) { return Bt + (size_t)(n0 + c) * D; },
            [=](int r, int c, float v, float) { const size_t i = (size_t)(m0 + r) * D + n0 + c; dst[i] = X[i] + bf2f(PR[i]) * sigmoidf_(v + bias[n0 + c]); }, C.tid);
    }
}

namespace pg8 {
typedef unsigned short bf16_t;
typedef short bf16x8 __attribute__((ext_vector_type(8)));
typedef unsigned u32x4 __attribute__((ext_vector_type(4)));
constexpr int BM = 256, BK = 64, HALF = 128, HTB = HALF * BK * 2, STAGE_BYTES = 8 * HTB, NXCD = 8, WGM = 8;
__device__ __forceinline__ int lds_byte(int r, int c) { const int st = (r >> 4) * 2 + (c >> 5), rr = r & 15, cc = c & 31, ob = rr * 64 + cc * 2; return st * 1024 + (ob ^ (((ob >> 9) & 1) << 5)); }
__device__ __forceinline__ void stage_rc(int b, int& R, int& C) { const int st = b / 1024, sb = b % 1024, swz = sb ^ (((sb >> 9) & 1) << 5); R = (st >> 1) * 16 + swz / 64; C = (st & 1) * 32 + (swz % 64) / 2; }
__device__ __forceinline__ int perm32(int rho) { const int n = rho >> 4, i = rho & 15; return 8 * (i >> 2) + 4 * n + (i & 3); }
struct Unit { int pm, pn, e, aux, mt; };
struct Gemm { const bf16_t* A; const bf16_t* Bt; int K; };
struct StaticOrder {
    int nM, nN, nwg, G, c;
    __device__ void init(int M, int N, int G_, int c_) { nM = M / BM; nN = N / BM; nwg = nM * nN; G = G_; c = c_; }
    __device__ bool next(int i, Unit& u) const {
        const long L = (long)i * G + c; if (L >= nwg) return false;
        int wgid = (int)L; { const int q = nwg / NXCD, r = nwg % NXCD, xcd = wgid % NXCD, off = wgid / NXCD; wgid = (xcd < r ? xcd * (q + 1) : r * (q + 1) + (xcd - r) * q) + off; }
        const int nig = WGM * nN, gid = wgid / nig, fm = gid * WGM, gsz = (nM - fm) < WGM ? (nM - fm) : WGM;
        u.pm = fm + ((wgid % nig) % gsz); u.pn = (wgid % nig) / gsz; u.e = 0; u.aux = 256; u.mt = 0; return true;
    }
    __device__ __forceinline__ const char* a_base(const Gemm& g, const Unit& u) const { return (const char*)g.A + (size_t)u.pm * 512 * g.K; }
    __device__ __forceinline__ const char* b_base(const Gemm& g, const Unit& u) const { return (const char*)g.Bt + (size_t)u.pn * 512 * g.K; }
    __device__ __forceinline__ int a_row(const Unit&, int) const { return 0; }
};
__device__ __forceinline__ unsigned cvt_pk_bf16(float lo, float hi) { unsigned r; asm volatile("v_cvt_pk_bf16_f32 %0, %1, %2" : "=v"(r) : "v"(lo), "v"(hi)); return r; }

template <class Epi, class Sched, bool ALIGN_EPI, bool GATHER>
__device__ __forceinline__ void gemm_phase(LAS unsigned char* lds, const Gemm g, const Sched& S, const Epi& E, const int tid) {
    const int wid = __builtin_amdgcn_readfirstlane(tid >> 6), lane = tid & 63, wr = wid >> 2, wc = wid & 3, fr = lane & 15, fq = lane >> 4;
    const int K = g.K, nt = K / BK;
    unsigned voffB[2];
#pragma unroll
    for (int i = 0; i < 2; ++i) { int R, C; stage_rc(tid * 16 + i * 8192, R, C); const int Rb = Epi::PERM ? ((R & ~31) + perm32(R & 31)) : R; voffB[i] = (unsigned)(Rb * K + C) * 2u; }
    const size_t kstep = (size_t)(BK * 2);
    const size_t hstep = (size_t)HALF * K * 2;
    const size_t hsA = GATHER ? 0 : hstep;
    const unsigned ldsw = (unsigned)wid * 1024u;
    const int aoff = lds_byte(wr * 64 + fr, fq * 8), boff = lds_byte(wc * 32 + fr, fq * 8);
#define PG8_SA(b, h) (((b) * 2 + (h)) * HTB)
#define PG8_SB(b, h) ((4 + (b) * 2 + (h)) * HTB)
#define PG8_STAGE(bufoff, gbase, voff) do { _Pragma("unroll") for (int _i = 0; _i < 2; ++_i) \
        __builtin_amdgcn_global_load_lds((const unsigned*)((const char*)(gbase) + (voff)[_i]), (LAS unsigned*)(lds + (bufoff) + ldsw + _i * 8192), 16, 0, 0); } while (0)
#define PG8_LDA(dst, b, h) do { _Pragma("unroll") for (int m = 0; m < 4; ++m) _Pragma("unroll") for (int k = 0; k < 2; ++k) dst[m][k] = *(const LAS bf16x8*)(lds + PG8_SA(b, h) + aoff + m * 2048 + k * 1024); } while (0)
#define PG8_LDB(dst, b, h) do { _Pragma("unroll") for (int n = 0; n < 2; ++n) _Pragma("unroll") for (int k = 0; k < 2; ++k) dst[n][k] = *(const LAS bf16x8*)(lds + PG8_SB(b, h) + boff + n * 2048 + k * 1024); } while (0)
#define PG8_MMA(ai, bj, At, Bt) do { __builtin_amdgcn_s_setprio(1); _Pragma("unroll") for (int m = 0; m < 4; ++m) _Pragma("unroll") for (int n = 0; n < 2; ++n) _Pragma("unroll") for (int k = 0; k < 2; ++k) \
        acc[ai][bj][m][n] = __builtin_amdgcn_mfma_f32_16x16x32_bf16(Bt[n][k], At[m][k], acc[ai][bj][m][n], 0, 0, 0); __builtin_amdgcn_s_setprio(0); } while (0)
#define PG8_WAIT_V(n) asm volatile("s_waitcnt vmcnt(" #n ")" ::: "memory")
#define PG8_WAIT_L(n) asm volatile("s_waitcnt lgkmcnt(" #n ")" ::: "memory")
#define PG8_BAR __builtin_amdgcn_s_barrier()
#define PG8_SCHED __builtin_amdgcn_sched_barrier(0)
#define PG8_VOFF(dst, u) do { int t_ = tid; if (GATHER) asm volatile("" : "+v"(t_));   \
        _Pragma("unroll") for (int i_ = 0; i_ < 2; ++i_) { int R_, C_; stage_rc(t_ * 16 + i_ * 8192, R_, C_); _Pragma("unroll") for (int h_ = 0; h_ < 2; ++h_) \
        dst[h_][i_] = GATHER ? (unsigned)(S.a_row(u, h_ * HALF + R_) * K + C_) * 2u : (unsigned)(R_ * K + C_) * 2u; } } while (0)
    Unit cur, nxt; int ui = 0;
    if (!S.next(0, cur)) return;
    f32x4 acc[2][2][4][2];
#pragma unroll
    for (int a = 0; a < 2; ++a)
#pragma unroll
        for (int b = 0; b < 2; ++b)
#pragma unroll
            for (int m = 0; m < 4; ++m)
#pragma unroll
                for (int n = 0; n < 2; ++n) acc[a][b][m][n] = (f32x4){0.f, 0.f, 0.f, 0.f};
    bf16x8 At[4][2], B0[2][2], B1[2][2];
    unsigned vC[2][2], vN[2][2], vX[2][2];
    PG8_VOFF(vC, cur);
    const char* cA = S.a_base(g, cur); const char* cB = S.b_base(g, cur);
    PG8_STAGE(PG8_SB(0, 0), cB, voffB); PG8_STAGE(PG8_SB(0, 1), cB + hstep, voffB); PG8_STAGE(PG8_SA(0, 0), cA, vC[0]); PG8_STAGE(PG8_SA(0, 1), cA + hsA, vC[1]);
    if (wr == 1) PG8_BAR;
    PG8_WAIT_V(2); PG8_BAR;
    PG8_STAGE(PG8_SB(1, 0), cB + kstep, voffB); PG8_STAGE(PG8_SA(1, 0), cA + kstep, vC[0]); PG8_STAGE(PG8_SB(1, 1), cB + hstep + kstep, voffB);
    PG8_WAIT_V(6); PG8_BAR;
    for (;;) {
        const bool has_next = S.next(ui + 1, nxt);
        const char* nA = has_next ? S.a_base(g, nxt) : cA; const char* nB = has_next ? S.b_base(g, nxt) : cB;
        if (GATHER && has_next) { PG8_VOFF(vN, nxt); }
        else {
#pragma unroll
            for (int h_ = 0; h_ < 2; ++h_)
#pragma unroll
                for (int i_ = 0; i_ < 2; ++i_) vN[h_][i_] = vC[h_][i_]; }
#pragma unroll 1
        for (int t = 0; t < nt; t += 2) {
            const bool last = (t == nt - 2);
            const char* a1 = cA + (size_t)(t + 1) * kstep;
            const char* a2 = last ? nA : cA + (size_t)(t + 2) * kstep; const char* b2 = last ? nB : cB + (size_t)(t + 2) * kstep;
            const char* a3 = a2 + kstep; const char* b3 = b2 + kstep;
#pragma unroll
            for (int h_ = 0; h_ < 2; ++h_)
#pragma unroll
                for (int i_ = 0; i_ < 2; ++i_) vX[h_][i_] = (GATHER && last) ? vN[h_][i_] : vC[h_][i_];
            PG8_LDB(B0, 0, 0); PG8_LDB(B1, 0, 1); PG8_SCHED; PG8_LDA(At, 0, 0); PG8_STAGE(PG8_SA(1, 1), a1 + hsA, vC[1]);
            PG8_WAIT_V(8); PG8_WAIT_L(0); PG8_BAR; PG8_MMA(0, 0, At, B0); PG8_MMA(0, 1, At, B1); PG8_BAR; PG8_SCHED;
            PG8_LDA(At, 0, 1); PG8_STAGE(PG8_SB(0, 0), b2, voffB); PG8_STAGE(PG8_SB(0, 1), b2 + hstep, voffB); PG8_STAGE(PG8_SA(0, 0), a2, vX[0]);
            PG8_WAIT_V(8); PG8_WAIT_L(0); PG8_BAR; PG8_MMA(1, 0, At, B0); PG8_MMA(1, 1, At, B1); PG8_BAR; PG8_SCHED;
            PG8_LDB(B0, 1, 0); PG8_LDB(B1, 1, 1); PG8_SCHED; PG8_LDA(At, 1, 0); PG8_STAGE(PG8_SA(0, 1), a2 + hsA, vX[1]);
            PG8_WAIT_V(8); PG8_WAIT_L(0); PG8_BAR; PG8_MMA(0, 0, At, B0); PG8_MMA(0, 1, At, B1); PG8_BAR; PG8_SCHED;
            PG8_LDA(At, 1, 1); PG8_STAGE(PG8_SB(1, 0), b3, voffB); PG8_STAGE(PG8_SB(1, 1), b3 + hstep, voffB); PG8_STAGE(PG8_SA(1, 0), a3, vX[0]);
            PG8_WAIT_V(8); PG8_WAIT_L(0); PG8_BAR; PG8_MMA(1, 0, At, B0); PG8_MMA(1, 1, At, B1); PG8_BAR; PG8_SCHED;
        }
        if constexpr (ALIGN_EPI) { if (wr == 0) PG8_BAR; }
        E(acc, cur, wr, wc, fr, fq);
        if (!has_next) break;
#pragma unroll
        for (int a = 0; a < 2; ++a)
#pragma unroll
            for (int b = 0; b < 2; ++b)
#pragma unroll
                for (int m = 0; m < 4; ++m)
#pragma unroll
                    for (int n = 0; n < 2; ++n) acc[a][b][m][n] = (f32x4){0.f, 0.f, 0.f, 0.f};
        cur = nxt; cA = nA; cB = nB; ++ui;
#pragma unroll
        for (int h_ = 0; h_ < 2; ++h_)
#pragma unroll
            for (int i_ = 0; i_ < 2; ++i_) vC[h_][i_] = vN[h_][i_];
        if constexpr (ALIGN_EPI) { if (wr == 1) PG8_BAR; }
    }
    PG8_WAIT_V(0);
    if constexpr (!ALIGN_EPI) { if (wr == 0) PG8_BAR; }
    PG8_BAR;
#undef PG8_SA
#undef PG8_SB
#undef PG8_STAGE
#undef PG8_LDA
#undef PG8_LDB
#undef PG8_MMA
#undef PG8_WAIT_V
#undef PG8_WAIT_L
#undef PG8_BAR
#undef PG8_SCHED
#undef PG8_VOFF
}
}

__device__ __forceinline__ float gelu_fast(float v) { const float y = 0.7978845608028654f * (v + 0.044715f * v * v * v); return v * __builtin_amdgcn_rcpf(1.f + __expf(-2.f * y)); }
__device__ __forceinline__ float sigmoid_fast(float v) { return __builtin_amdgcn_rcpf(1.f + __expf(-v)); }

struct EpiZ {
    static constexpr bool PERM = true;
    bf16* R1; const float* gq; const float* gk;
    __device__ __forceinline__ void operator()(const f32x4 (&acc)[2][2][4][2], const pg8::Unit& u, int wr, int wc, int fr, int fq) const {
        const int seg = u.pn >> 1;
        bf16* base = R1 + (size_t)seg * T * 512 + (size_t)(u.pm * 256 + wr * 64 + fr) * 512 + (u.pn & 1) * 256 + wc * 64 + 8 * fq;
        if (seg == 2 || seg == 3) {
            const float* g = seg == 2 ? gq : gk; const float sc = seg == 2 ? C2 : 1.f;
            f32x4 gv[2][2];
#pragma unroll
            for (int bj = 0; bj < 2; ++bj)
#pragma unroll
                for (int n = 0; n < 2; ++n) gv[bj][n] = *(const f32x4*)(g + 32 * bj + 8 * fq + 4 * n);
#pragma unroll
            for (int ai = 0; ai < 2; ++ai)
#pragma unroll
                for (int m = 0; m < 4; ++m) {
                    float s = 0.f;
#pragma unroll
                    for (int bj = 0; bj < 2; ++bj)
#pragma unroll
                        for (int n = 0; n < 2; ++n) { const f32x4 x = acc[ai][bj][m][n]; s += (x[0] * x[0] + x[1] * x[1]) + (x[2] * x[2] + x[3] * x[3]); }
                    s += lane_xor<16>(s); s = half_sum32(s);
                    const float rs = rsqrtf(s * (1.f / 64.f) + EPS) * sc;
#pragma unroll
                    for (int bj = 0; bj < 2; ++bj) { const f32x4 v0 = acc[ai][bj][m][0] * rs * gv[bj][0], v1 = acc[ai][bj][m][1] * rs * gv[bj][1];
                        v4u w; w.x = pg8::cvt_pk_bf16(v0[0], v0[1]); w.y = pg8::cvt_pk_bf16(v0[2], v0[3]); w.z = pg8::cvt_pk_bf16(v1[0], v1[1]); w.w = pg8::cvt_pk_bf16(v1[2], v1[3]);
                        *(v4u*)(base + (size_t)(ai * 128 + m * 16) * 512 + 32 * bj) = w; }
                }
        } else {
#pragma unroll
            for (int ai = 0; ai < 2; ++ai)
#pragma unroll
                for (int m = 0; m < 4; ++m)
#pragma unroll
                    for (int bj = 0; bj < 2; ++bj) { f32x4 v0 = acc[ai][bj][m][0], v1 = acc[ai][bj][m][1];
                        if (seg == 1) { v0 = (f32x4){gelu_fast(v0[0]), gelu_fast(v0[1]), gelu_fast(v0[2]), gelu_fast(v0[3])}; v1 = (f32x4){gelu_fast(v1[0]), gelu_fast(v1[1]), gelu_fast(v1[2]), gelu_fast(v1[3])}; }
                        v4u w; w.x = pg8::cvt_pk_bf16(v0[0], v0[1]); w.y = pg8::cvt_pk_bf16(v0[2], v0[3]); w.z = pg8::cvt_pk_bf16(v1[0], v1[1]); w.w = pg8::cvt_pk_bf16(v1[2], v1[3]);
                        *(v4u*)(base + (size_t)(ai * 128 + m * 16) * 512 + 32 * bj) = w; }
        }
    }
};
__device__ __forceinline__ void phase_gemm1_fast(Ctx& C, KA AR, int l) {
    phase_cumsum(C, AR);
    pg8::Gemm g{(const bf16*)(C.ws + WS_XN), (const bf16*)(C.ws + WS_WIN) + (size_t)l * NZ * D, D};
    pg8::StaticOrder S; S.init(T, NZ, gridDim.x, blockIdx.x);
    EpiZ E{(bf16*)(C.ws + WS_R1), AR->in[I_QN] + l * HD, AR->in[I_KN] + l * HD};
    pg8::gemm_phase<EpiZ, pg8::StaticOrder, true, false>(C.lds, g, S, E, C.tid);
}
struct EpiRes {
    static constexpr bool PERM = false;
    const float* xs; float* X;
    __device__ __forceinline__ void operator()(const f32x4 (&acc)[2][2][4][2], const pg8::Unit& u, int wr, int wc, int fr, int fq) const {
        const size_t off0 = (size_t)(u.pm * 256 + wr * 64 + fr) * D + u.pn * 256 + wc * 32 + 4 * fq;
#pragma unroll
        for (int ai = 0; ai < 2; ++ai)
#pragma unroll
            for (int m = 0; m < 4; ++m)
#pragma unroll
                for (int bj = 0; bj < 2; ++bj)
#pragma unroll
                    for (int n = 0; n < 2; ++n) { const size_t o = off0 + (size_t)(ai * 128 + m * 16) * D + bj * 128 + n * 16; *(f32x4*)(X + o) = *(const f32x4*)(xs + o) + acc[ai][bj][m][n]; }
    }
};
__device__ __forceinline__ void phase_wo_fast(Ctx& C, KA AR, int l) {
    pg8::Gemm g{(const bf16*)(C.ws + WS_R2 + 16 * MiB), (const bf16*)(C.ws + WS_WOUT) + (size_t)l * D * D, D};
    pg8::StaticOrder S; S.init(T, D, gridDim.x, blockIdx.x);
    EpiRes E{l == 0 ? AR->in[I_X] : (const float*)(C.ws + WS_X), (float*)(C.ws + WS_X)};
    pg8::gemm_phase<EpiRes, pg8::StaticOrder, true, false>(C.lds, g, S, E, C.tid);
}
struct EpiProj {
    static constexpr bool PERM = true;
    bf16* PR;
    __device__ __forceinline__ void operator()(const f32x4 (&acc)[2][2][4][2], const pg8::Unit& u, int wr, int wc, int fr, int fq) const {
        bf16* base = PR + (size_t)(u.pm * 256 + wr * 64 + fr) * D + u.pn * 256 + wc * 32 + 8 * fq;
#pragma unroll
        for (int ai = 0; ai < 2; ++ai)
#pragma unroll
            for (int m = 0; m < 4; ++m)
#pragma unroll
                for (int bj = 0; bj < 2; ++bj) { const f32x4 v0 = acc[ai][bj][m][0], v1 = acc[ai][bj][m][1];
                    v4u w; w.x = pg8::cvt_pk_bf16(v0[0], v0[1]); w.y = pg8::cvt_pk_bf16(v0[2], v0[3]); w.z = pg8::cvt_pk_bf16(v1[0], v1[1]); w.w = pg8::cvt_pk_bf16(v1[2], v1[3]);
                    *(v4u*)(base + (size_t)(ai * 128 + m * 16) * D + bj * 128) = w; }
    }
};
__device__ __forceinline__ void phase_proj_fast(Ctx& C, KA AR, int l) {
    pg8::Gemm g{(const bf16*)(C.ws + WS_PB) + (size_t)l * T * PLE, (const bf16*)(C.ws + WS_WPP) + (size_t)l * D * PLE, PLE};
    pg8::StaticOrder S;
    { const int G = gridDim.x, hb = G / 2; if ((int)blockIdx.x >= hb) S.init(T, D, G - hb, (int)blockIdx.x - hb); else S.init(T, D, G - hb, T); }
    EpiProj E{(bf16*)(C.ws + WS_PROJ)};
    pg8::gemm_phase<EpiProj, pg8::StaticOrder, true, false>(C.lds, g, S, E, C.tid);
}
struct EpiPle {
    static constexpr bool PERM = false;
    const float* X; const bf16* PR; const float* bias; float* dst; float pscale;
    __device__ __forceinline__ void operator()(const f32x4 (&acc)[2][2][4][2], const pg8::Unit& u, int wr, int wc, int fr, int fq) const {
        const int col0 = u.pn * 256 + wc * 32 + 4 * fq;
        const size_t off0 = (size_t)(u.pm * 256 + wr * 64 + fr) * D + col0;
#pragma unroll
        for (int bj = 0; bj < 2; ++bj)
#pragma unroll
            for (int n = 0; n < 2; ++n) { const f32x4 bv = *(const f32x4*)(bias + col0 + bj * 128 + n * 16);
#pragma unroll
                for (int ai = 0; ai < 2; ++ai)
#pragma unroll
                    for (int m = 0; m < 4; ++m) { const size_t o = off0 + (size_t)(ai * 128 + m * 16) * D + bj * 128 + n * 16;
                        const v2u pw = *(const v2u*)(PR + o); const f32x4 a = acc[ai][bj][m][n] + bv; const f32x4 x = *(const f32x4*)(X + o);
                        f32x4 r; r[0] = x[0] + bflo(pw.x) * sigmoid_fast(a[0]); r[1] = x[1] + bfhi(pw.x) * sigmoid_fast(a[1]); r[2] = x[2] + bflo(pw.y) * sigmoid_fast(a[2]); r[3] = x[3] + bfhi(pw.y) * sigmoid_fast(a[3]);
                        if (PROBE_TIMING) r = r * pscale;
                        *(f32x4*)(dst + o) = r; } }
    }
};
__device__ __forceinline__ void phase_ple_fast(Ctx& C, KA AR, int l) {
    pg8::Gemm g{(const bf16*)(C.ws + WS_XN), (const bf16*)(C.ws + WS_WPG) + (size_t)l * D * D, D};
    pg8::StaticOrder S; S.init(T, D, gridDim.x, blockIdx.x);
    float pscale = 1.f;
    if (PROBE_TIMING && l == DEPTH - 1) { const unsigned long long* ts = (const unsigned long long*)((const unsigned*)(C.ws + WS_CTL) + CW_TS); pscale = 1.f + (float)(ts[PROBE_HI] - ts[PROBE_LO]) * 1e-5f; }
    EpiPle E{(const float*)(C.ws + WS_X), (const bf16*)(C.ws + WS_PROJ), AR->in[I_BPG] + l * D, l == DEPTH - 1 ? AR->out : (float*)(C.ws + WS_X), pscale};
    pg8::gemm_phase<EpiPle, pg8::StaticOrder, true, false>(C.lds, g, S, E, C.tid);
}
constexpr int TAB_OFF = MISC_OFF + 128;
struct GroupOrder {
    const LAS int* tab; int G, c; const int* rowpair; const char* hbase; bool is_g2;
    __device__ bool next(int i, pg8::Unit& u) const {
        const int L = i * G + c, mtg = L >> 2; if (mtg >= __builtin_amdgcn_readfirstlane(tab[64 + NE])) return false;
        const int pk = __builtin_amdgcn_readfirstlane(tab[128 + mtg]);
        const int e = pk & 255, mt = pk >> 8; const int ne = __builtin_amdgcn_readfirstlane(tab[e]), ho = __builtin_amdgcn_readfirstlane(tab[32 + e]);
        int nv = ne - 256 * mt; nv = nv > 256 ? 256 : nv;
        u.pm = ho + 256 * mt; u.pn = L & 3; u.e = e; u.aux = nv; u.mt = mt; return true;
    }
    __device__ __forceinline__ const char* a_base(const pg8::Gemm& g, const pg8::Unit& u) const { return is_g2 ? (const char*)g.A + (size_t)u.pm * 2 * g.K : (const char*)g.A; }
    __device__ __forceinline__ const char* b_base(const pg8::Gemm& g, const pg8::Unit& u) const { return (const char*)g.Bt + (size_t)(u.e * 1024 + u.pn * 256) * 2 * g.K; }
    __device__ __forceinline__ int a_row(const pg8::Unit& u, int r) const { return r < u.aux ? (rowpair[(size_t)u.e * CAP + u.mt * 256 + r] >> 1) : 0; }
};
__device__ __forceinline__ void build_exptab256(Ctx& C, int l, LAS int* tab) {
    __syncthreads();
    if (C.tid == 0) { const unsigned* cnt = (const unsigned*)(C.ws + WS_CTL) + CW_CNT + 64 * l; int ho = 0, tt = 0;
        for (int e = 0; e < NE; ++e) { const int n = (int)__hip_atomic_load(cnt + e, __ATOMIC_RELAXED, __HIP_MEMORY_SCOPE_AGENT); tab[e] = n; tab[32 + e] = ho; tab[64 + e] = tt;
            const int nt = (n + 255) >> 8; for (int j = 0; j < nt; ++j) tab[128 + tt + j] = e | (j << 8); ho += nt << 8; tt += nt; }
        tab[64 + NE] = tt; }
    __syncthreads();
}
struct EpiG1 {
    static constexpr bool PERM = true;
    bf16* Hb;
    __device__ __forceinline__ void operator()(const f32x4 (&acc)[2][2][4][2], const pg8::Unit& u, int wr, int wc, int fr, int fq) const {
        bf16* base = Hb + (size_t)(u.pm + wr * 64 + fr) * DE + u.pn * 128 + wc * 32 + 8 * fq;
#pragma unroll
        for (int ai = 0; ai < 2; ++ai)
#pragma unroll
            for (int m = 0; m < 4; ++m) { const int rl = ai * 128 + wr * 64 + m * 16 + fr;
                f32x4 h0, h1;
#pragma unroll
                for (int e = 0; e < 4; ++e) { const float g0 = acc[ai][0][m][0][e], g1 = acc[ai][0][m][1][e]; h0[e] = g0 * sigmoid_fast(g0) * acc[ai][1][m][0][e]; h1[e] = g1 * sigmoid_fast(g1) * acc[ai][1][m][1][e]; }
                v4u w; w.x = pg8::cvt_pk_bf16(h0[0], h0[1]); w.y = pg8::cvt_pk_bf16(h0[2], h0[3]); w.z = pg8::cvt_pk_bf16(h1[0], h1[1]); w.w = pg8::cvt_pk_bf16(h1[2], h1[3]);
                if (rl < u.aux) *(v4u*)(base + (size_t)(ai * 128 + m * 16) * DE) = w; }
    }
};
__device__ __forceinline__ void phase_g1_fast(Ctx& C, KA AR, int l) {
    LAS int* tab = (LAS int*)(C.lds + TAB_OFF); build_exptab256(C, l, tab);
    pg8::Gemm g{(const bf16*)(C.ws + WS_XN), (const bf16*)(C.ws + WS_WGU) + (size_t)l * NE * 1024 * D, D};
    GroupOrder S{tab, (int)gridDim.x, (int)blockIdx.x, (const int*)(C.ws + WS_ROWPAIR), nullptr, false};
    EpiG1 E{(bf16*)(C.ws + WS_R2)};
    pg8::gemm_phase<EpiG1, GroupOrder, true, true>(C.lds, g, S, E, C.tid);
}
struct EpiG2 {
    static constexpr bool PERM = true;
    bf16* Y2; const int* rowpair; const float* pairw;
    __device__ __forceinline__ void operator()(const f32x4 (&acc)[2][2][4][2], const pg8::Unit& u, int wr, int wc, int fr, int fq) const {
        const int* rp = rowpair + (size_t)u.e * CAP + u.mt * 256; const int col0 = u.pn * 256 + wc * 32 + 8 * fq;
#pragma unroll
        for (int ai = 0; ai < 2; ++ai)
#pragma unroll
            for (int m = 0; m < 4; ++m) { const int rl = ai * 128 + wr * 64 + m * 16 + fr;
                if (rl < u.aux) { const int p = rp[rl]; const float w8 = pairw[p]; bf16* row = Y2 + (size_t)p * D + col0;
#pragma unroll
                    for (int bj = 0; bj < 2; ++bj) { const f32x4 v0 = acc[ai][bj][m][0] * w8, v1 = acc[ai][bj][m][1] * w8;
                        v4u w; w.x = pg8::cvt_pk_bf16(v0[0], v0[1]); w.y = pg8::cvt_pk_bf16(v0[2], v0[3]); w.z = pg8::cvt_pk_bf16(v1[0], v1[1]); w.w = pg8::cvt_pk_bf16(v1[2], v1[3]);
                        *(v4u*)(row + bj * 128) = w; } } }
    }
};
__device__ __forceinline__ void phase_g2_fast(Ctx& C, KA AR, int l) {
    LAS int* tab = (LAS int*)(C.lds + TAB_OFF); build_exptab256(C, l, tab);
    pg8::Gemm g{(const bf16*)(C.ws + WS_R2), (const bf16*)(C.ws + WS_WDN) + (size_t)l * NE * D * DE, DE};
    GroupOrder S{tab, (int)gridDim.x, (int)blockIdx.x, (const int*)(C.ws + WS_ROWPAIR), nullptr, true};
    EpiG2 E{(bf16*)(C.ws + WS_R1), (const int*)(C.ws + WS_ROWPAIR), (const float*)(C.ws + WS_PAIRW)};
    pg8::gemm_phase<EpiG2, GroupOrder, true, false>(C.lds, g, S, E, C.tid);
}

#define SBAR() __builtin_amdgcn_sched_barrier(0)
namespace attn_body {
using bf16=__hip_bfloat16;
using bf16x8=__attribute__((ext_vector_type(8)))short;
using s16x4=__attribute__((ext_vector_type(4)))short;
using f32x16=__attribute__((ext_vector_type(16)))float;
using u32x4=__attribute__((ext_vector_type(4)))unsigned;
constexpr int BATCH=4,NHEAD=8,SEQ=4096,D=64,DM=NHEAD*D;
constexpr int NW=8,QBLK=32,QB=QBLK*NW,KVBLK=64,NQB=SEQ/QB;
constexpr int ATTN_PITCH=DM, ATTN_UNIT_ROWS=QB;
__device__ __forceinline__ int crow(int r,int hi){return (r&3)+8*(r>>2)+4*hi;}
#define SBAR() __builtin_amdgcn_sched_barrier(0)
__device__ __forceinline__ void cmask(f32x16&p0,f32x16&p1,int jb,int qrel,int hi){
  const float NEG=-INFINITY; int kb=64*jb+4*hi;
  #pragma unroll
  for(int r=0;r<16;++r){int kv=kb+(r&3)+8*(r>>2); if(kv>qrel)p0[r]=NEG; if(kv+32>qrel)p1[r]=NEG;}
}

constexpr int NSLOT=3, SLOTB=8192;
constexpr int LDS_K=0, LDS_V=NSLOT*SLOTB, LDS_WS=2*NSLOT*SLOTB, LDS_OST=LDS_WS+NW*64*4, LDS_CK=LDS_OST+NW*4096, LDS_BYTES=LDS_CK+SEQ*4;
constexpr float C2=0.125f*1.4426950408889634f;
__device__ __forceinline__ void glds16(const void*gsrc,unsigned lds_dst){unsigned keep;
  asm volatile("s_mov_b32 %0, m0\n\ts_mov_b32 m0, %2\n\ts_nop 0\n\tglobal_load_lds_dwordx4 %1, off\n\ts_mov_b32 m0, %0":"=&s"(keep):"v"(gsrc),"s"(lds_dst):"memory");}
__device__ __forceinline__ float max3f(float a,float b,float c){float r;asm("v_max3_f32 %0, %1, %2, %3":"=v"(r):"v"(a),"v"(b),"v"(c));return r;}
__device__ __forceinline__ float max2f(float a,float b){float r;asm("v_max_f32_e32 %0, %1, %2":"=v"(r):"v"(a),"v"(b));return r;}
__device__ __forceinline__ float fadd_s(float a,float b){float r;asm("v_add_f32_e32 %0, %1, %2":"=v"(r):"v"(a),"v"(b));return r;}
__device__ __forceinline__ float fsub_s(float a,float b){float r;asm("v_sub_f32_e32 %0, %1, %2":"=v"(r):"v"(a),"v"(b));return r;}
typedef float f32x2_t __attribute__((ext_vector_type(2))); typedef __bf16 bf16x2_t __attribute__((ext_vector_type(2)));
__device__ __forceinline__ unsigned cvtpk_s(float lo,float hi){f32x2_t v={lo,hi};bf16x2_t b=__builtin_convertvector(v,bf16x2_t);return __builtin_bit_cast(unsigned,b);}
#define WAIT_BAR(N) asm volatile("s_waitcnt vmcnt(" #N ") lgkmcnt(0)\n\ts_barrier":::"memory")

__device__ __forceinline__ void qkt(f32x16&p0,f32x16&p1,const char*Kslot,const bf16x8*qr,const f32x16&negm,int r32,int hi){
  const char*kb=Kslot+hi*1024+r32*16;
  #pragma unroll
  for(int d0=0;d0<4;++d0){
    const bf16x8 b0=*reinterpret_cast<const bf16x8*>(kb+d0*2048);
    const bf16x8 b1=*reinterpret_cast<const bf16x8*>(kb+d0*2048+512);
    if(d0==0){p0=__builtin_amdgcn_mfma_f32_32x32x16_bf16(b0,qr[0],negm,0,0,0);p1=__builtin_amdgcn_mfma_f32_32x32x16_bf16(b1,qr[0],negm,0,0,0);}
    else{p0=__builtin_amdgcn_mfma_f32_32x32x16_bf16(b0,qr[d0],p0,0,0,0);p1=__builtin_amdgcn_mfma_f32_32x32x16_bf16(b1,qr[d0],p1,0,0,0);}}
}
typedef __attribute__((address_space(3))) const char* lds_cptr;
typedef short v4i16_t __attribute__((ext_vector_type(4)));
__device__ __forceinline__ void kload8(bf16x8*kf,lds_cptr kp){
  kf[0]=*(const __attribute__((address_space(3))) bf16x8*)(kp);      kf[1]=*(const __attribute__((address_space(3))) bf16x8*)(kp+512);
  kf[2]=*(const __attribute__((address_space(3))) bf16x8*)(kp+2048); kf[3]=*(const __attribute__((address_space(3))) bf16x8*)(kp+2560);
  kf[4]=*(const __attribute__((address_space(3))) bf16x8*)(kp+4096); kf[5]=*(const __attribute__((address_space(3))) bf16x8*)(kp+4608);
  kf[6]=*(const __attribute__((address_space(3))) bf16x8*)(kp+6144); kf[7]=*(const __attribute__((address_space(3))) bf16x8*)(kp+6656);
}
__device__ __forceinline__ void kload2(bf16x8*kf,lds_cptr kp,int j){ kf[2*j]=*(const __attribute__((address_space(3))) bf16x8*)(kp+j*2048); kf[2*j+1]=*(const __attribute__((address_space(3))) bf16x8*)(kp+j*2048+512); }
__device__ __forceinline__ s16x4 vtr(lds_cptr p){ return __builtin_bit_cast(s16x4,__builtin_amdgcn_ds_read_tr16_b64_v4i16((__attribute__((address_space(3))) v4i16_t*)p)); }
__device__ __forceinline__ float rowmax(const f32x16&p0,const f32x16&p1){
  float a=max3f(p0[0],p0[1],p1[0]),b=max3f(p0[2],p0[3],p1[1]);a=max3f(a,p1[2],p1[3]);
  #pragma unroll
  for(int r=4;r<16;r+=4){a=max3f(a,p0[r],p0[r+1]);b=max3f(b,p0[r+2],p0[r+3]);a=max3f(a,p1[r],p1[r+1]);b=max3f(b,p1[r+2],p1[r+3]);}
  const float m=max2f(a,b);
  auto rr=__builtin_amdgcn_permlane32_swap(__float_as_uint(m),__float_as_uint(m),false,false);
  return max2f(__uint_as_float(rr[0]),__uint_as_float(rr[1]));
}
__device__ __forceinline__ void pv(f32x16*o,int vb,bf16x8 pa0,bf16x8 pa1,bf16x8 pa2,bf16x8 pa3){
  #pragma unroll
  for(int d0=0;d0<2;++d0){s16x4 lo[4],hi[4];
    #pragma unroll
    for(int ks=0;ks<4;++ks){
      asm volatile("ds_read_b64_tr_b16 %0,%1 offset:%c2":"=&v"(lo[ks]):"v"(vb),"i"(d0*4096+ks*1024):"memory");
      asm volatile("ds_read_b64_tr_b16 %0,%1 offset:%c2":"=&v"(hi[ks]):"v"(vb),"i"(d0*4096+ks*1024+512):"memory");}
    asm volatile("s_waitcnt lgkmcnt(0)":::"memory");SBAR();
    #define PK(k) (bf16x8){lo[k][0],lo[k][1],lo[k][2],lo[k][3],hi[k][0],hi[k][1],hi[k][2],hi[k][3]}
    o[d0]=__builtin_amdgcn_mfma_f32_32x32x16_bf16(pa0,PK(0),o[d0],0,0,0);
    o[d0]=__builtin_amdgcn_mfma_f32_32x32x16_bf16(pa1,PK(1),o[d0],0,0,0);
    o[d0]=__builtin_amdgcn_mfma_f32_32x32x16_bf16(pa2,PK(2),o[d0],0,0,0);
    o[d0]=__builtin_amdgcn_mfma_f32_32x32x16_bf16(pa3,PK(3),o[d0],0,0,0);
    #undef PK
  }
}

#ifndef ATTN_STORE16
#define ATTN_STORE16(p,v) (*(u32x4*)(p)=(v))
#endif
template<int THRL> __device__ __forceinline__ void attn_unit(int b,int h,int qb,const bf16*Q,const bf16*__restrict__ K,const bf16*__restrict__ V,bf16*O,const float*__restrict__ C2K,const float thr2,char*shm,const int tid){
  const int lane=tid&63,r32=lane&31,hi=lane>>5; const int wid=__builtin_amdgcn_readfirstlane(tid>>6);
  const long rowbase=(long)b*SEQ; const int q0=qb*QB;
  const bf16*Qw=Q+(rowbase+q0+wid*QBLK)*DM+h*D;
  const int NT0=(q0+QB)/KVBLK;
  const float*ckg0=C2K+(long)(b*NHEAD+h)*SEQ; float base=ckg0[q0+(tid>>6)*QBLK+r32];
  int ts; { const float cl=lane<NT0?ckg0[KVBLK*lane+KVBLK-1]:ckg0[q0]; const unsigned long long mk=__builtin_amdgcn_ballot_w64(lane<NT0&&(ckg0[q0]-cl>=-thr2));
    ts=mk?(int)__builtin_ctzll(mk):NT0-4; ts&=~1; ts=ts>NT0-4?NT0-4:ts; ts=__builtin_amdgcn_readfirstlane(ts); }
  const int NT=NT0-ts;
  const bf16*Kh=K+(rowbase+(long)ts*KVBLK)*DM+h*D,*Vh=V+(rowbase+(long)ts*KVBLK)*DM+h*D; const float*ckg=ckg0+ts*KVBLK;
  typedef __attribute__((address_space(3))) float lds_f32; typedef float f32x4_t __attribute__((ext_vector_type(4)));
  lds_f32*const nbl=(lds_f32*)((__attribute__((address_space(3))) char*)shm+LDS_CK);
  for(int i=tid;i<NT*KVBLK;i+=NW*64)nbl[i]=-ckg[i];
  const unsigned lds0=(unsigned)(uintptr_t)shm;
  float*wsf=(float*)(shm+LDS_WS)+wid*64;
  const bf16*ksrc=Kh+(long)lane*DM+wid*8;
  const bf16*vsrc=Vh+(long)(16*(wid&3)+(lane>>2))*DM+(wid>>2)*32+(lane&3)*8;
  const unsigned kdst=lds0+LDS_K+wid*1024, vdst=lds0+LDS_V+wid*1024;
  #define DMA_K(t,slot) glds16(ksrc+(long)(t)*KVBLK*DM,(unsigned)__builtin_amdgcn_readfirstlane(kdst+(slot)))
  #define DMA_V(t,slot) glds16(vsrc+(long)(t)*KVBLK*DM,(unsigned)__builtin_amdgcn_readfirstlane(vdst+(slot)))
  const int vb0=(int)(lds0+LDS_V)+((lane>>4)&1)*32+(lane&3)*8+(4*hi+((lane&15)>>2))*64;
  const char*Kbase=shm+LDS_K; bf16x8 kf[8];
  const lds_cptr shm3=(lds_cptr)shm; const lds_cptr kp0=shm3+LDS_K+hi*1024+r32*16; const lds_cptr vp0=shm3+LDS_V+((lane>>4)&1)*32+(lane&3)*8+(4*hi+((lane&15)>>2))*64;
  DMA_K(0,0);DMA_V(0,0);DMA_K(1,SLOTB);
  bf16x8 qr[4];
  #pragma unroll
  for(int d0=0;d0<4;++d0)qr[d0]=*reinterpret_cast<const bf16x8*>(&Qw[(long)r32*DM+d0*16+hi*8]);
  float l_reg=0.f;f32x16 o[2];o[0]=f32x16{};o[1]=f32x16{};const f32x16 negm=f32x16{};
  const int qrel=wid*QBLK+r32;
  #define CMASK(P0,P1,t) do{int jb_=(t)-(NT-4); if(jb_>=0)cmask(P0,P1,jb_,qrel,hi);}while(0)
  #define KBIAS(P0,P1,t) do{ const lds_f32*nb_=nbl+64*(t)+4*hi; _Pragma("unroll") for(int g_=0;g_<4;++g_){ \
    { const f32x4_t b0_=*(const __attribute__((address_space(3))) f32x4_t*)(nb_+8*g_); _Pragma("unroll") for(int j_=0;j_<4;++j_)P0[4*g_+j_]+=(b0_[j_]+base); } SBAR(); \
    { const f32x4_t b1_=*(const __attribute__((address_space(3))) f32x4_t*)(nb_+32+8*g_); _Pragma("unroll") for(int j_=0;j_<4;++j_)P1[4*g_+j_]+=(b1_[j_]+base); } SBAR(); } }while(0)
  bool resc=false;
  #define START(P0,P1) do{ const float rm=rowmax(P0,P1); resc=false; \
    { const float dl=rm; base=fsub_s(base,dl); \
      _Pragma("unroll") for(int r=0;r<16;++r){P0[r]=fsub_s(P0[r],dl);P1[r]=fsub_s(P1[r],dl);} \
      } \
    _Pragma("unroll") for(int r=0;r<16;++r)P0[r]=__builtin_amdgcn_exp2f(P0[r]); }while(0)
  #define RESC() do{ if(resc){ asm volatile("s_waitcnt lgkmcnt(0)":::"memory"); \
      _Pragma("unroll") for(int d_=0;d_<2;++d_) _Pragma("unroll") for(int r=0;r<16;++r)o[d_][r]*=wsf[crow(r,hi)]; } }while(0)
  f32x16 pA0,pA1,pB0,pB1;
  int sl_prev=0,sl_cur=0,sl_next=SLOTB;
  #define ROT() do{sl_prev=sl_cur;sl_cur=sl_next;sl_next=(sl_next==(NSLOT-1)*SLOTB)?0:sl_next+SLOTB;}while(0)
  DMA_K(2,2*SLOTB);
  WAIT_BAR(3);
  qkt(pA0,pA1,Kbase,qr,negm,r32,hi);asm volatile("s_nop 15\n\ts_nop 7":"+v"(pA0),"+v"(pA1));KBIAS(pA0,pA1,0);CMASK(pA0,pA1,0);
  START(pA0,pA1);
  _Pragma("unroll") for(int r=0;r<16;++r)pA1[r]=__builtin_amdgcn_exp2f(pA1[r]);
  WAIT_BAR(0);
  DMA_K(3,0);DMA_V(1,SLOTB);
  ROT();
  kload8(kf,kp0+sl_cur);
  WAIT_BAR(2);
  s16x4 vlo[8],vhi[8]; u32x4 pw0,pw1,pw2,pw3;
  #define PKW(P,B) cvtpk_s(P[B],P[B+1])
  #define PAF(k) __builtin_bit_cast(bf16x8,pw##k)
  #define VFR(i) (bf16x8){vlo[i][0],vlo[i][1],vlo[i][2],vlo[i][3],vhi[i][0],vhi[i][1],vhi[i][2],vhi[i][3]}
  #define PIN(x) asm volatile("":"+v"(x))
  #define MX3(a,b,c) __builtin_fmaxf(__builtin_fmaxf((a),(b)),(c))
  #define GAPA(MF,A0,A1,A2,A3,W0,W1,PW) do{ MF; sacc+=A0; sacc+=A1; sacc+=A2; sacc+=A3; PIN(sacc); W0; W1; PIN(PW); SBAR(); }while(0)
  #define EX(v) __builtin_amdgcn_exp2f(v)
  #define GAPB(MF,X,B) do{ MF; X[B]=EX(X[B]); X[B+1]=EX(X[B+1]); X[B+2]=EX(X[B+2]); X[B+3]=EX(X[B+3]); PIN(X); SBAR(); }while(0)
  #define VRD(i) do{ vlo[i]=vtr(vp_+(((i)>>2)*4096+((i)&3)*1024)); vhi[i]=vtr(vp_+(((i)>>2)*4096+((i)&3)*1024+512)); }while(0)
  #define KRD(G,j) do{ if(G){ kload2(kf,kp0+sl_next,j); SBAR(); } }while(0)
  #define STEP(C0,C1,P0,P1,t,GK,GV,GL) do{ SBAR(); \
    const lds_cptr vp_=vp0+sl_prev; \
    VRD(0); SBAR(); float sacc=(P0[0]+P0[1]); \
    GAPA(C0=__builtin_amdgcn_mfma_f32_32x32x16_bf16(kf[0],qr[0],negm,0,0,0), P0[2],P0[3],P0[4],P0[5],     pw0[0]=PKW(P0,0), pw0[1]=PKW(P0,2), pw0); \
    VRD(4); SBAR(); GAPA(C1=__builtin_amdgcn_mfma_f32_32x32x16_bf16(kf[1],qr[0],negm,0,0,0), P0[6],P0[7],P0[8],P0[9],     pw0[2]=PKW(P0,4), pw0[3]=PKW(P0,6), pw0); \
    VRD(1); SBAR(); GAPA(C0=__builtin_amdgcn_mfma_f32_32x32x16_bf16(kf[2],qr[1],C0,0,0,0),   P0[10],P0[11],P0[12],P0[13], pw1[0]=PKW(P0,8), pw1[1]=PKW(P0,10), pw1); \
    VRD(5); SBAR(); GAPA(C1=__builtin_amdgcn_mfma_f32_32x32x16_bf16(kf[3],qr[1],C1,0,0,0),   P0[14],P0[15],P1[0],P1[1],   pw1[2]=PKW(P0,12),pw1[3]=PKW(P0,14), pw1); \
    VRD(2); SBAR(); GAPA(C0=__builtin_amdgcn_mfma_f32_32x32x16_bf16(kf[4],qr[2],C0,0,0,0),   P1[2],P1[3],P1[4],P1[5],     pw2[0]=PKW(P1,0), pw2[1]=PKW(P1,2), pw2); \
    VRD(6); SBAR(); GAPA(C1=__builtin_amdgcn_mfma_f32_32x32x16_bf16(kf[5],qr[2],C1,0,0,0),   P1[6],P1[7],P1[8],P1[9],     pw2[2]=PKW(P1,4), pw2[3]=PKW(P1,6), pw2); \
    VRD(3); SBAR(); GAPA(C0=__builtin_amdgcn_mfma_f32_32x32x16_bf16(kf[6],qr[3],C0,0,0,0),   P1[10],P1[11],P1[12],P1[13], pw3[0]=PKW(P1,8), pw3[1]=PKW(P1,10), pw3); \
    VRD(7); SBAR(); GAPA(C1=__builtin_amdgcn_mfma_f32_32x32x16_bf16(kf[7],qr[3],C1,0,0,0),   P1[14],P1[15],0.f,0.f,       pw3[2]=PKW(P1,12),pw3[3]=PKW(P1,14), pw3); \
    l_reg+=sacc; \
    if(GK){DMA_K((t)+3,sl_cur);} if(GV){DMA_V((t)+1,sl_next);} \
    KBIAS(C0,C1,t); \
    CMASK(C0,C1,t); \
    { float a=MX3(C0[0],C0[1],C1[0]),b=MX3(C0[2],C0[3],C1[1]); a=MX3(a,C1[2],C1[3]); \
      _Pragma("unroll") for(int r=4;r<16;r+=4){a=MX3(a,C0[r],C0[r+1]);b=MX3(b,C0[r+2],C0[r+3]);a=MX3(a,C1[r],C1[r+1]);b=MX3(b,C1[r+2],C1[r+3]);} \
      float rm=__builtin_fmaxf(a,b); { auto rr=__builtin_amdgcn_permlane32_swap(__float_as_uint(rm),__float_as_uint(rm),false,false); rm=__builtin_fmaxf(__uint_as_float(rr[0]),__uint_as_float(rr[1])); } \
      resc=false; \
      if(__builtin_expect(__any(rm>(float)THRL),0)){ const float dl=__builtin_fmaxf(rm,0.f); base-=dl; \
        _Pragma("unroll") for(int r=0;r<16;++r){C0[r]-=dl;C1[r]-=dl;} \
        const float f=__builtin_amdgcn_exp2f(-dl); l_reg*=f; if(hi==0)wsf[r32]=f; resc=true; } } \
    SBAR(); \
    GAPB(o[0]=__builtin_amdgcn_mfma_f32_32x32x16_bf16(PAF(0),VFR(0),o[0],0,0,0), C0,0); \
    GAPB(o[1]=__builtin_amdgcn_mfma_f32_32x32x16_bf16(PAF(0),VFR(4),o[1],0,0,0), C0,4); \
    KRD(GL,0); GAPB(o[0]=__builtin_amdgcn_mfma_f32_32x32x16_bf16(PAF(1),VFR(1),o[0],0,0,0), C0,8); \
    KRD(GL,1); GAPB(o[1]=__builtin_amdgcn_mfma_f32_32x32x16_bf16(PAF(1),VFR(5),o[1],0,0,0), C0,12); \
    KRD(GL,2); GAPB(o[0]=__builtin_amdgcn_mfma_f32_32x32x16_bf16(PAF(2),VFR(2),o[0],0,0,0), C1,0); \
    KRD(GL,3); GAPB(o[1]=__builtin_amdgcn_mfma_f32_32x32x16_bf16(PAF(2),VFR(6),o[1],0,0,0), C1,4); \
    GAPB(o[0]=__builtin_amdgcn_mfma_f32_32x32x16_bf16(PAF(3),VFR(3),o[0],0,0,0), C1,8); \
    GAPB(o[1]=__builtin_amdgcn_mfma_f32_32x32x16_bf16(PAF(3),VFR(7),o[1],0,0,0), C1,12); \
    }while(0)
  int t=1;
  #undef CMASK
  #define CMASK(P0,P1,t) do{}while(0)
  for(;t+5<NT;t+=2){
    STEP(pB0,pB1,pA0,pA1,t,true,true,true);     WAIT_BAR(2); RESC(); ROT();
    STEP(pA0,pA1,pB0,pB1,t+1,true,true,true);   WAIT_BAR(2); RESC(); ROT();
  }
  #undef CMASK
  #define CMASK(P0,P1,t) do{int jb_=(t)-(NT-4); if(jb_>=0)cmask(P0,P1,jb_,qrel,hi);}while(0)
  #define ENDW(tt) do{ if((tt)+3<NT){WAIT_BAR(2);} else if((tt)+2<NT){WAIT_BAR(1);} else {WAIT_BAR(0);} }while(0)
  for(;t+1<NT;t+=2){
    STEP(pB0,pB1,pA0,pA1,t,(t+3<NT),(t+1<NT),(t+1<NT));       ENDW(t);   RESC(); ROT();
    STEP(pA0,pA1,pB0,pB1,t+1,(t+4<NT),(t+2<NT),(t+2<NT));     ENDW(t+1); RESC(); ROT();
  }
  STEP(pB0,pB1,pA0,pA1,NT-1,false,false,false); RESC();
  { float sacc=pB0[0]+pB0[1]; _Pragma("unroll") for(int r=2;r<16;++r)sacc+=pB0[r]; _Pragma("unroll") for(int r=0;r<16;++r)sacc+=pB1[r]; l_reg+=sacc;
    pw0=(u32x4){PKW(pB0,0),PKW(pB0,2),PKW(pB0,4),PKW(pB0,6)};pw1=(u32x4){PKW(pB0,8),PKW(pB0,10),PKW(pB0,12),PKW(pB0,14)};pw2=(u32x4){PKW(pB1,0),PKW(pB1,2),PKW(pB1,4),PKW(pB1,6)};pw3=(u32x4){PKW(pB1,8),PKW(pB1,10),PKW(pB1,12),PKW(pB1,14)};
    SBAR(); pv(o,vb0+sl_cur,PAF(0),PAF(1),PAF(2),PAF(3)); }
  #undef PKW
  #undef PAF
  #undef VFR
  #undef PIN
  #undef MX3
  #undef GAPA
  #undef GAPB
  #undef EX
  #undef VRD
  #undef KRD
  #undef STEP
  #undef ENDW
  {auto rr=__builtin_amdgcn_permlane32_swap(__float_as_uint(l_reg),__float_as_uint(l_reg),false,false);l_reg=__uint_as_float(rr[0])+__uint_as_float(rr[1]);}
  if(hi==0)wsf[32+r32]=l_reg;asm volatile("s_waitcnt lgkmcnt(0)":::"memory");
  float rli[16];
  #pragma unroll
  for(int r=0;r<16;++r)rli[r]=__builtin_amdgcn_rcpf(wsf[32+crow(r,hi)]);
  bf16*Ow=O+(rowbase+q0+wid*QBLK)*DM+h*D;
  { bf16*stg=(bf16*)(shm+LDS_OST)+wid*2048;
    #pragma unroll
    for(int r=0;r<16;++r){const int orow=crow(r,hi);
      #pragma unroll
      for(int d0=0;d0<2;++d0)stg[orow*64+d0*32+r32]=__float2bfloat16(o[d0][r]*rli[r]);}
    asm volatile("s_waitcnt lgkmcnt(0)":::"memory");
    #pragma unroll
    for(int i=0;i<4;++i){const int row=i*8+(lane>>3),ch=lane&7; const u32x4 v=*(const u32x4*)(stg+row*64+ch*8); ATTN_STORE16(Ow+(long)row*DM+ch*8,v);} }
  asm volatile("s_waitcnt lgkmcnt(0)\n\ts_barrier":::"memory");
  #undef DMA_K
  #undef DMA_V
  #undef CMASK
  #undef KBIAS
  #undef START
  #undef RESC
  #undef ROT
}
constexpr int ATTN_LDS_BYTES=LDS_BYTES;
struct AttnTensors { const bf16* Q; const bf16* K; const bf16* V; bf16* O; const float* C2K; float thr2; };
struct AttnUnit { int bh; int qb; };
struct StaticOrder {
  int vcu;
  __device__ __forceinline__ explicit StaticOrder(int grid,int block):vcu((block%8)*(grid/8)+block/8){}
  __device__ __forceinline__ bool next(int i,AttnUnit&u)const{ if(i>=2||vcu>=256)return false; const int s=vcu&7; u.bh=vcu>>3; u.qb=(i==0)?s:15-s; return true; }
  __device__ __forceinline__ void a_ready(const AttnUnit&)const{}
  __device__ __forceinline__ void done(const AttnUnit&)const{}
};
template<class Sched,int THRL=8> __device__ __forceinline__ void attn_phase(char*lds,const AttnTensors&T,const Sched&S,const int tid){
  AttnUnit u;
  for(int i=0;S.next(i,u);++i){ S.a_ready(u); attn_unit<THRL>(u.bh/NHEAD,u.bh%NHEAD,u.qb,T.Q,T.K,T.V,T.O,T.C2K,T.thr2,lds,tid); S.done(u); }
}
#undef SBAR
#undef WAIT_BAR
}
__device__ __forceinline__ void phase_attn_fast(Ctx& C, KA AR, int l, char* ldsg) {
    const attn_body::bf16* Q = (const attn_body::bf16*)(C.ws + WS_R1) + (size_t)2 * T * 512;
    const float bq = 64.f * C2 * wave_max(fabsf(AR->in[I_QN][l * HD + C.lane])) * wave_max(fabsf(AR->in[I_KN][l * HD + C.lane]));
    const attn_body::AttnTensors AT{Q, Q + (size_t)T * 512, Q + (size_t)2 * T * 512, (attn_body::bf16*)(C.ws + WS_R2), (const float*)(C.ws + WS_C2K), 2.f * bq + 40.f};
    unsigned* qctr = (unsigned*)(C.ws + WS_CTL) + CW_ATT + 64 * l;
    volatile LAS unsigned* slot = (volatile LAS unsigned*)(C.lds + MISC_OFF) + 16;
    for (;;) {
        __syncthreads();
        if (C.tid == 0) slot[0] = atomicAdd(qctr, 1u);
        __syncthreads();
        const int idx = __builtin_amdgcn_readfirstlane((int)slot[0]);
        if (idx >= NB * NH * 16) break;
        const int qb = 15 - (idx >> 5), bh = idx & 31;
        attn_body::attn_unit<8>(bh >> 3, bh & 7, qb, AT.Q, AT.K, AT.V, AT.O, AT.C2K, AT.thr2, ldsg, C.tid);
    }
}

constexpr int RCH = 32, NCH = S / RCH;
__device__ __forceinline__ float one_minus_sq_exp(float la, float a) {
    const float x = 2.f * la;
    float p = 1.f / 5040.f; p = p * x + 1.f / 720.f; p = p * x + 1.f / 120.f; p = p * x + 1.f / 24.f; p = p * x + 1.f / 6.f; p = p * x + 0.5f; p = p * x + 1.f; p = -(p * x);
    return x > -0.25f ? p : 1.f - a * a;
}
template <int MODE>
__device__ __forceinline__ void phase_rnn_fast(Ctx& C, KA AR, int l) {
    typedef short bf16x8 __attribute__((ext_vector_type(8)));
    const int blk = C.wave, lane = C.lane, fr = lane & 15, fq = lane >> 4;
    LAS float* Ab = (LAS float*)C.lds + C.wave * 4096; LAS float* Ub = Ab + 2048;
    LAS float* SS = (LAS float*)(C.lds + TAB_OFF); LAS float* RSW = SS + 256 + C.wave * 32;
    const bf16* ZX = (const bf16*)(C.ws + WS_R1); const bf16* ZG = ZX + (size_t)T * 512;
    float* SA = (float*)(C.ws + WS_SA); float* SH = (float*)(C.ws + WS_SH);
    const bf16* O = (const bf16*)(C.ws + WS_R2); bf16* YM = (bf16*)(C.ws + WS_R2 + 16 * MiB);
    const float* cw = AR->in[I_CONVW] + l * 4 * DR; const float* cb = AR->in[I_CONVB] + l * DR;
    const float* wr = AR->in[I_WR] + (size_t)(l * 8 + blk) * 64 * 64; const float* wi = AR->in[I_WI] + (size_t)(l * 8 + blk) * 64 * 64;
    bf16x8 Br[4][2], Bi[4][2]; float brj[4], bij[4], spj[4];
#pragma unroll
    for (int n = 0; n < 4; ++n) { const int j = n * 16 + fr, ch = blk * 64 + j;
        brj[n] = AR->in[I_BR][l * DR + ch]; bij[n] = AR->in[I_BI][l * DR + ch]; spj[n] = log1pf(__expf(-AR->in[I_LAM][l * DR + ch]));
#pragma unroll
        for (int ks = 0; ks < 2; ++ks)
#pragma unroll
            for (int e = 0; e < 8; ++e) { const int k = ks * 32 + fq * 8 + e; Br[n][ks][e] = (short)f2bf(wr[k * 64 + j]); Bi[n][ks][e] = (short)f2bf(wi[k * 64 + j]); } }
    for (int u = blockIdx.x; u < NB * NCH; u += gridDim.x) {
        const int b = u / NCH; int c = u % NCH; if (MODE == 1 && ((u / (int)gridDim.x) & 1)) c = NCH - 1 - c;
        const int t0 = c * RCH;
        if (MODE == 1) __syncthreads();
        bf16x8 Af[2][2];
#pragma unroll
        for (int ks = 0; ks < 2; ++ks) {
            const int ch0 = blk * 64 + ks * 32 + fq * 8;
            f32x4 w[4][2], bb[2];
#pragma unroll
            for (int j = 0; j < 4; ++j) { w[j][0] = *(const f32x4*)(cw + j * DR + ch0); w[j][1] = *(const f32x4*)(cw + j * DR + ch0 + 4); }
            bb[0] = *(const f32x4*)(cb + ch0); bb[1] = *(const f32x4*)(cb + ch0 + 4);
#pragma unroll
            for (int m = 0; m < 2; ++m) {
                const int tok = m * 16 + fr, tg = t0 + tok;
                f32x4 x0 = bb[0], x1 = bb[1];
#pragma unroll
                for (int j = 0; j < 4; ++j) { const int tt = tg - 3 + j;
                    if (tt >= 0) { const v4u z = *(const v4u*)(ZX + (size_t)(b * S + tt) * 512 + ch0);
                        x0[0] += w[j][0][0] * bflo(z.x); x0[1] += w[j][0][1] * bfhi(z.x); x0[2] += w[j][0][2] * bflo(z.y); x0[3] += w[j][0][3] * bfhi(z.y);
                        x1[0] += w[j][1][0] * bflo(z.z); x1[1] += w[j][1][1] * bfhi(z.z); x1[2] += w[j][1][2] * bflo(z.w); x1[3] += w[j][1][3] * bfhi(z.w); } }
                *(LAS f32x4*)(Ub + tok * 64 + ks * 32 + fq * 8) = x0; *(LAS f32x4*)(Ub + tok * 64 + ks * 32 + fq * 8 + 4) = x1;
                v4u pk; pk.x = pk2(x0[0], x0[1]); pk.y = pk2(x0[2], x0[3]); pk.z = pk2(x1[0], x1[1]); pk.w = pk2(x1[2], x1[3]);
                Af[m][ks] = __builtin_bit_cast(bf16x8, pk);
            }
        }
        f32x4 aR[2][4], aI[2][4];
#pragma unroll
        for (int m = 0; m < 2; ++m)
#pragma unroll
            for (int n = 0; n < 4; ++n) { aR[m][n] = (f32x4){0.f, 0.f, 0.f, 0.f}; aI[m][n] = (f32x4){0.f, 0.f, 0.f, 0.f};
#pragma unroll
                for (int ks = 0; ks < 2; ++ks) { aR[m][n] = __builtin_amdgcn_mfma_f32_16x16x32_bf16(Af[m][ks], Br[n][ks], aR[m][n], 0, 0, 0); aI[m][n] = __builtin_amdgcn_mfma_f32_16x16x32_bf16(Af[m][ks], Bi[n][ks], aI[m][n], 0, 0, 0); } }
        asm volatile("s_waitcnt lgkmcnt(0)" ::: "memory");
#pragma unroll
        for (int m = 0; m < 2; ++m)
#pragma unroll
            for (int n = 0; n < 4; ++n)
#pragma unroll
                for (int i = 0; i < 4; ++i) { const int idx = (m * 16 + 4 * fq + i) * 64 + n * 16 + fr;
                    const float xcv = Ub[idx], r = sigmoid_fast(aR[m][n][i] + brj[n]), ig = sigmoid_fast(aI[m][n][i] + bij[n]);
                    const float la = -8.f * r * spj[n], a = __expf(la);
                    Ab[idx] = a; Ub[idx] = sqrtf(one_minus_sq_exp(la, a)) * (ig * xcv); }
        asm volatile("s_waitcnt lgkmcnt(0)" ::: "memory");
        const int ch = blk * 64 + lane;
        if (MODE == 0) { float At = 1.f, h = 0.f;
#pragma unroll 8
            for (int t = 0; t < RCH; ++t) { const float a = Ab[t * 64 + lane]; h = a * h + Ub[t * 64 + lane]; At *= a; }
            SA[(size_t)(b * NCH + c) * 512 + ch] = At; SH[(size_t)(b * NCH + c) * 512 + ch] = h;
        } else {
            float h = 0.f;
            { const float* sa = SA + (size_t)b * NCH * 512 + ch; const float* sh = SH + (size_t)b * NCH * 512 + ch; int c2 = 0;
              for (; c2 + 8 <= c; c2 += 8) { float a8[8], h8[8];
#pragma unroll
                  for (int q = 0; q < 8; ++q) { a8[q] = sa[(size_t)(c2 + q) * 512]; h8[q] = sh[(size_t)(c2 + q) * 512]; }
#pragma unroll
                  for (int q = 0; q < 8; ++q) h = a8[q] * h + h8[q]; }
              for (; c2 < c; ++c2) h = sa[(size_t)c2 * 512] * h + sh[(size_t)c2 * 512]; }
            const bf16* zg = ZG + (size_t)(b * S + t0) * 512 + ch;
#pragma unroll 8
            for (int t = 0; t < RCH; ++t) { h = Ab[t * 64 + lane] * h + Ub[t * 64 + lane]; Ab[t * 64 + lane] = h * bf2f(zg[(size_t)t * 512]); }
            asm volatile("s_waitcnt lgkmcnt(0)" ::: "memory");
            { const int t = lane & 31, hf = lane >> 5; float s = 0.f;
#pragma unroll 8
              for (int k = 0; k < 32; ++k) { const float y = Ab[t * 64 + hf * 32 + ((k + t) & 31)]; s += y * y; }
              s = half_sum32(s); if (lane < 32) SS[C.wave * 32 + lane] = s; }
            __syncthreads();
            { const int t = lane & 31; float tot = 0.f;
#pragma unroll
              for (int w8 = 0; w8 < 8; ++w8) tot += SS[w8 * 32 + t];
              RSW[t] = rsqrtf(tot * (1.f / 512.f) + EPS); }
            asm volatile("s_waitcnt lgkmcnt(0)" ::: "memory");
            { const int oct = lane & 7; const float* g1 = AR->in[I_LRUN] + l * DR + blk * 64 + oct * 8; const f32x4 ga = *(const f32x4*)g1, gb = *(const f32x4*)(g1 + 4);
#pragma unroll
              for (int q = 0; q < 4; ++q) { const int t = q * 8 + (lane >> 3); const float rs = RSW[t];
                  const f32x4 y0 = *(const LAS f32x4*)(Ab + t * 64 + oct * 8) * rs * ga, y1 = *(const LAS f32x4*)(Ab + t * 64 + oct * 8 + 4) * rs * gb;
                  v4u pk; pk.x = pk2(y0[0], y0[1]); pk.y = pk2(y0[2], y0[3]); pk.z = pk2(y1[0], y1[1]); pk.w = pk2(y1[2], y1[3]);
                  *(v4u*)(YM + (size_t)(b * S + t0 + t) * D + blk * 64 + oct * 8) = pk; } }
            { const float* g2 = AR->in[I_ATTN] + l * DA + 8 * lane; const f32x4 ga = *(const f32x4*)g2, gb = *(const f32x4*)(g2 + 4);
#pragma unroll
              for (int q = 0; q < 4; ++q) { const size_t row = (size_t)(b * S + t0 + C.wave * 4 + q);
                  const v4u w = *(const v4u*)(O + row * 512 + 8 * lane);
                  f32x4 x0 = {bflo(w.x), bfhi(w.x), bflo(w.y), bfhi(w.y)}, x1 = {bflo(w.z), bfhi(w.z), bflo(w.w), bfhi(w.w)};
                  float s = (x0[0] * x0[0] + x0[1] * x0[1]) + (x0[2] * x0[2] + x0[3] * x0[3]) + (x1[0] * x1[0] + x1[1] * x1[1]) + (x1[2] * x1[2] + x1[3] * x1[3]);
                  const float rs = rsqrtf(wave_sum(s) * (1.f / 512.f) + EPS);
                  x0 = x0 * rs * ga; x1 = x1 * rs * gb;
                  v4u pk; pk.x = pk2(x0[0], x0[1]); pk.y = pk2(x0[2], x0[3]); pk.z = pk2(x1[0], x1[1]); pk.w = pk2(x1[2], x1[3]);
                  *(v4u*)(YM + row * D + 512 + 8 * lane) = pk; } }
        }
    }
}

template <int NT, class WF>
__device__ __forceinline__ float norm_proj_tile(const float* X, const float* gain, bf16* xn, int t0, WF wf, LAS float* Lw, int lane) {
    const int fr = lane & 15, fq = lane >> 4;
    f32x4 acc[NT];
#pragma unroll
    for (int n = 0; n < NT; ++n) acc[n] = (f32x4){0.f, 0.f, 0.f, 0.f};
    float ssq = 0.f;
    const float* xr = X + (size_t)(t0 + fr) * D + 4 * fq; const float* gr = gain + 4 * fq;
#pragma unroll 2
    for (int s = 0; s < 64; ++s) {
        const f32x4 xv = *(const f32x4*)(xr + 16 * s); const f32x4 gv = *(const f32x4*)(gr + 16 * s);
        ssq += (xv[0] * xv[0] + xv[1] * xv[1]) + (xv[2] * xv[2] + xv[3] * xv[3]);
        const f32x4 xg = xv * gv;
#pragma unroll
        for (int e = 0; e < 4; ++e)
#pragma unroll
            for (int n = 0; n < NT; ++n) acc[n] = __builtin_amdgcn_mfma_f32_16x16x4f32(wf(n, 16 * s + 4 * fq + e, fr), xg[e], acc[n], 0, 0, 0);
    }
    ssq += lane_xor<16>(ssq); ssq = half_sum32(ssq);
    const float rs = rsqrtf(ssq * (1.f / D) + EPS);
#pragma unroll
    for (int n = 0; n < NT; ++n)
#pragma unroll
        for (int r = 0; r < 4; ++r) Lw[fr * (16 * NT) + 16 * n + 4 * fq + r] = acc[n][r] * rs;
#pragma unroll
    for (int tok = 0; tok < 16; ++tok) {
        const float rst = __builtin_bit_cast(float, __builtin_amdgcn_readlane(__builtin_bit_cast(int, rs), tok));
        f32x4 v[4]; load_row(X + (size_t)(t0 + tok) * D, lane, v); scale_row(v, rst, gain, lane); store_row_bf16(xn + (size_t)(t0 + tok) * D, lane, v);
    }
    asm volatile("s_waitcnt lgkmcnt(0)" ::: "memory");
    return rs;
}
__device__ __forceinline__ void phase_norm1_fast(Ctx& C, KA AR, int l) {
    const float* xs = l == 0 ? AR->in[I_X] : (const float*)(C.ws + WS_X);
    const float* gain = AR->in[I_MIXN] + l * D; const float* wf = AR->in[I_WIN] + (size_t)l * D * DIN + NZ; const float* bfg = AR->in[I_BF] + l * NH;
    bf16* xn = (bf16*)(C.ws + WS_XN); float* logf = (float*)(C.ws + WS_LOGF);
    LAS float* Lw = (LAS float*)C.lds + C.wave * 1024;
    if (C.wave < 4)
        for (int tile = blockIdx.x * 4 + C.wave; tile < T / 16; tile += gridDim.x * 4) {
            const int t0 = 16 * tile;
            norm_proj_tile<1>(xs, gain, xn, t0, [=](int, int k, int i) { return i < 8 ? wf[(size_t)k * DIN + i] : 0.f; }, Lw, C.lane);
            const int tok = C.lane & 15, h0 = (C.lane >> 4) * 2;
            logf[(size_t)(t0 + tok) * 8 + h0] = log_sigmoid(Lw[tok * 16 + h0] + bfg[h0]); logf[(size_t)(t0 + tok) * 8 + h0 + 1] = log_sigmoid(Lw[tok * 16 + h0 + 1] + bfg[h0 + 1]);
            asm volatile("s_waitcnt lgkmcnt(0)" ::: "memory");
        }
}
__device__ __forceinline__ void phase_router_fast(Ctx& C, KA AR, int l) {
    const float* X = (const float*)(C.ws + WS_X); bf16* xn = (bf16*)(C.ws + WS_XN);
    const float* gain = AR->in[I_FFNN] + l * D; const float* wg = AR->in[I_WG] + (size_t)l * D * 4; const float* bg = AR->in[I_BG] + l * 4;
    const float* wr = AR->in[I_WRT] + (size_t)l * D * NE; const float* brt = AR->in[I_BRT] + l * NE;
    unsigned* cnt = (unsigned*)(C.ws + WS_CTL) + CW_CNT + 64 * l; int* rowpair = (int*)(C.ws + WS_ROWPAIR); float* pairw = (float*)(C.ws + WS_PAIRW);
    LAS float* Lw = (LAS float*)C.lds + C.wave * 1024;
    if (C.wave < 4)
        for (int tile = blockIdx.x * 4 + C.wave; tile < T / 16; tile += gridDim.x * 4) {
            const int t0 = 16 * tile;
            norm_proj_tile<3>(X, gain, xn, t0, [=](int n, int k, int i) { return n < 2 ? wr[(size_t)k * NE + 16 * n + i] : (i < 4 ? wg[(size_t)k * 4 + i] : 0.f); }, Lw, C.lane);
            if (C.lane < 16) {
                const LAS float* L = Lw + C.lane * 48; const int t = t0 + C.lane;
                float gl[4];
#pragma unroll
                for (int i = 0; i < 4; ++i) gl[i] = L[32 + i] + bg[i];
                int gi = 0; float gm = gl[0];
#pragma unroll
                for (int i = 1; i < 4; ++i) if (gl[i] > gm) { gm = gl[i]; gi = i; }
                float gs = 0.f;
#pragma unroll
                for (int i = 0; i < 4; ++i) gs += __expf(gl[i] - gm);
                const float gp = 1.f / gs;
                float ev[8];
#pragma unroll
                for (int i = 0; i < 8; ++i) ev[i] = L[gi * 8 + i] + brt[gi * 8 + i];
                int i0 = 0; float t0v = ev[0];
#pragma unroll
                for (int i = 1; i < 8; ++i) if (ev[i] > t0v) { t0v = ev[i]; i0 = i; }
                int i1 = -1; float t1v = -INFINITY;
#pragma unroll
                for (int i = 0; i < 8; ++i) if (i != i0 && ev[i] > t1v) { t1v = ev[i]; i1 = i; }
                const float ex = __expf(t1v - t0v), w0 = gp / (1.f + ex), w1 = gp * ex / (1.f + ex);
                const int e0 = gi * 8 + i0, e1 = gi * 8 + i1;
                const unsigned p0 = atomicAdd(cnt + e0, 1u), p1 = atomicAdd(cnt + e1, 1u);
                rowpair[(size_t)e0 * CAP + p0] = 2 * t; rowpair[(size_t)e1 * CAP + p1] = 2 * t + 1; pairw[2 * t] = w0; pairw[2 * t + 1] = w1;
            }
            asm volatile("s_waitcnt lgkmcnt(0)" ::: "memory");
        }
}

constexpr int NPH = 14;
constexpr int NPHASES = 1 + DEPTH * NPH;
__global__ void __launch_bounds__(512, 2) fwd_kernel(Args args) {
    extern __shared__ __attribute__((aligned(16))) unsigned char lds[];
    Ctx C;
    C.lds = (LAS unsigned char*)lds;
    C.wave0 = __builtin_amdgcn_readfirstlane((int)threadIdx.x >> 6); asm volatile("" : "+s"(C.wave0));
    C.tid = threadIdx.x; C.lane = C.tid & 63; C.wave = C.wave0;
    C.gw = blockIdx.x * 8 + C.wave; C.ngw = gridDim.x * 8;
    C.ws = args.ws;
    volatile LAS unsigned* MISC = (volatile LAS unsigned*)(C.lds + MISC_OFF);
    if (C.tid < 32) MISC[C.tid] = 0u;
    __syncthreads();
    XcdBarrier bar; bar.bar = (unsigned*)(C.ws + WS_CTL) + CW_BAR; bar.x = 0; bar.st = nullptr;
    if (args.ph_hi - args.ph_lo > 1) bar = xcd_barrier_post((unsigned*)(C.ws + WS_CTL) + CW_BAR, MISC + 8);
#ifndef ONLY
#define ONLY -1
#endif
#define PHON(k) (ONLY < 0 || ONLY == (k))
#if MK_MULTI
#define IN(k) (fresh_args()->ph_lo <= (k) && (k) < fresh_args()->ph_hi)
#else
#define IN(k) true
#endif
    if (PROBE_TIMING && blockIdx.x == 0 && threadIdx.x == 0) ((unsigned long long*)((unsigned*)(args.ws + WS_CTL) + CW_TS))[0] = __builtin_amdgcn_s_memrealtime();
#define SEAM(k) do { if (IN(k) && IN((k) + 1)) { XcdBarrier b_; b_.bar = (unsigned*)(fresh_args()->ws + WS_CTL) + CW_BAR; b_.x = xb_xcc_id(); b_.st = (volatile LAS unsigned*)(C.lds + MISC_OFF) + 8;     \
        xcd_barrier(b_, C.tid == 0); if (PROBE_TIMING && blockIdx.x == 0 && C.tid == 0) { ((unsigned long long*)((unsigned*)(fresh_args()->ws + WS_CTL) + CW_TS))[(k) + 1] = __builtin_amdgcn_s_memrealtime(); } } } while (0)
    for (int rp_ = 0; rp_ < REPS(99); ++rp_) { if (PHON(99) && IN(0)) { KA A_ = fresh_args(); enter_phase(C, A_); phase_prologue(C, A_); } SEAM(0); }
    for (int l = 0; l < DEPTH; ++l) {
        const int pb = 1 + l * NPH;
        for (int rp_ = 0; rp_ < REPSL(0); ++rp_) { if (PHON(0) && IN(pb + 0)) { KA A_ = fresh_args(); enter_phase(C, A_); if (FAST_NORM) phase_norm1_fast(C, A_, l); else phase_norm1(C, A_, l); } SEAM(pb + 0); }
        for (int rp_ = 0; rp_ < REPSL(1); ++rp_) { if (PHON(1) && IN(pb + 1)) { KA A_ = fresh_args(); enter_phase(C, A_); if (FAST_GEMM1) { phase_gemm1_fast(C, A_, l); phase_proj_fast(C, A_, l); } else phase_gemm1_naive(C, A_, l); } SEAM(pb + 1); }
        for (int rp_ = 0; rp_ < REPSL(2); ++rp_) { if (!FAST_GEMM1 && PHON(2) && IN(pb + 2)) { KA A_ = fresh_args(); enter_phase(C, A_); phase_qknorm_naive(C, A_, l); } if (!FAST_GEMM1) SEAM(pb + 2); }
        for (int rp_ = 0; rp_ < REPSL(3); ++rp_) { if (!(FAST_RNN && FAST_ATTN) && PHON(3) && IN(pb + 3)) { KA A_ = fresh_args(); enter_phase(C, A_); if (FAST_RNN) phase_rnn_fast<0>(C, A_, l); else phase_rnn_naive<0>(C, A_, l); } if (!(FAST_RNN && FAST_ATTN)) SEAM(pb + 3); }
        for (int rp_ = 0; rp_ < REPSL(4); ++rp_) { if (PHON(4) && IN(pb + 4)) { KA A_ = fresh_args(); enter_phase(C, A_); if (FAST_RNN && FAST_ATTN) { phase_rnn_fast<0>(C, A_, l); __syncthreads(); } if (FAST_ATTN) phase_attn_fast(C, A_, l, (char*)lds); else phase_attn_naive(C, A_, l); } SEAM(pb + 4); }
        for (int rp_ = 0; rp_ < REPSL(5); ++rp_) { if (PHON(5) && IN(pb + 5)) { KA A_ = fresh_args(); enter_phase(C, A_); if (FAST_RNN) phase_rnn_fast<1>(C, A_, l); else phase_rnn_naive<1>(C, A_, l); } SEAM(pb + 5); }
        for (int rp_ = 0; rp_ < REPSL(6); ++rp_) { if (!FAST_RNN && PHON(6) && IN(pb + 6)) { KA A_ = fresh_args(); enter_phase(C, A_); phase_mixnorm_naive(C, A_, l); } if (!FAST_RNN) SEAM(pb + 6); }
        for (int rp_ = 0; rp_ < REPSL(7); ++rp_) { if (PHON(7) && IN(pb + 7)) { KA A_ = fresh_args(); enter_phase(C, A_); if (FAST_DENSE) phase_wo_fast(C, A_, l); else phase_wo_naive(C, A_, l); } SEAM(pb + 7); }
        for (int rp_ = 0; rp_ < REPSL(8); ++rp_) { if (PHON(8) && IN(pb + 8)) { KA A_ = fresh_args(); enter_phase(C, A_); if (FAST_NORM) phase_router_fast(C, A_, l); else phase_router(C, A_, l); } SEAM(pb + 8); }
        for (int rp_ = 0; rp_ < REPSL(9); ++rp_) { if (PHON(9) && IN(pb + 9)) { KA A_ = fresh_args(); enter_phase(C, A_); if (FAST_MOE) phase_g1_fast(C, A_, l); else phase_g1_naive(C, A_, l); } SEAM(pb + 9); }
        for (int rp_ = 0; rp_ < REPSL(10); ++rp_) { if (PHON(10) && IN(pb + 10)) { KA A_ = fresh_args(); enter_phase(C, A_); if (FAST_MOE) phase_g2_fast(C, A_, l); else phase_g2_naive(C, A_, l); } SEAM(pb + 10); }
        for (int rp_ = 0; rp_ < REPSL(11); ++rp_) { if (PHON(11) && IN(pb + 11)) { KA A_ = fresh_args(); enter_phase(C, A_); phase_combine(C, A_, l); } SEAM(pb + 11); }
        for (int rp_ = 0; rp_ < REPSL(12); ++rp_) { if (!FAST_GEMM1 && PHON(12) && IN(pb + 12)) { KA A_ = fresh_args(); enter_phase(C, A_); if (FAST_DENSE) phase_proj_fast(C, A_, l); else phase_proj_naive(C, A_, l); } if (!FAST_GEMM1) SEAM(pb + 12); }
        for (int rp_ = 0; rp_ < REPSL(13); ++rp_) { if (PHON(13) && IN(pb + 13)) { KA A_ = fresh_args(); enter_phase(C, A_); if (FAST_DENSE) phase_ple_fast(C, A_, l); else phase_ple_naive(C, A_, l); } if (l + 1 < DEPTH) SEAM(pb + 13); }
    }
#undef IN
#undef SEAM
}

extern "C" void kernel_launch(void* const* d_in, const int* in_sizes, int n_in, void* d_out, int out_size, void* d_ws, size_t ws_size, hipStream_t stream) {
    static int grid = 0;
    if (grid == 0) {
        if (n_in != 29 || out_size != T * D || ws_size < WS_END) { fprintf(stderr, "kernel_launch: unexpected problem (n_in %d, out %d, ws %zu)\n", n_in, out_size, ws_size); grid = -1; return; }
        int dev = 0, cus = 0, per_cu = 0;
        if (hipGetDevice(&dev) != hipSuccess || hipDeviceGetAttribute(&cus, hipDeviceAttributeMultiprocessorCount, dev) != hipSuccess) { grid = -1; return; }
        if (hipFuncSetAttribute((const void*)fwd_kernel, hipFuncAttributeMaxDynamicSharedMemorySize, LDS_BYTES) != hipSuccess) { fprintf(stderr, "kernel_launch: hipFuncSetAttribute failed\n"); grid = -1; return; }
        if (hipOccupancyMaxActiveBlocksPerMultiprocessor(&per_cu, (const void*)fwd_kernel, 512, LDS_BYTES) != hipSuccess || per_cu < 1) { fprintf(stderr, "kernel_launch: occupancy query says %d\n", per_cu); grid = -1; return; }
        (void)hipGetLastError();
        grid = cus;
    }
    if (grid < 0) return;
    hipMemsetAsync((char*)d_ws + WS_CTL, 0, CTL_ZERO_BYTES, stream);
    Args a{};
    for (int i = 0; i < 29; ++i) a.in[i] = (const float*)d_in[i];
    a.out = (float*)d_out; a.ws = (unsigned char*)d_ws;
#if MK_MULTI
    for (int ph = 0; ph < NPHASES; ++ph) { a.ph_lo = ph; a.ph_hi = ph + 1; hipLaunchKernelGGL(fwd_kernel, dim3(grid), dim3(512), LDS_BYTES, stream, a); }
#else
    a.ph_lo = 0; a.ph_hi = NPHASES;
    hipLaunchKernelGGL(fwd_kernel, dim3(grid), dim3(512), LDS_BYTES, stream, a);
#endif
}
```

```cpp
#include <hip/hip_runtime.h>
#include <cstdio>
#include <cstdint>
#include <cmath>
#include <hip/hip_bf16.h>

#define FAST_GEMM1 1
#define FAST_DENSE 1
#define FAST_MOE 1
#define FAST_ATTN 1
#define FAST_RNN 1
#define FAST_NORM 1
#ifndef PROBE_TIMING
#define PROBE_TIMING 0
#endif
#ifndef PROBE_LO
#define PROBE_LO 0
#define PROBE_HI 1
#endif
#ifndef PROBE_REP
#define PROBE_REP -1
#define PROBE_REPN 0
#endif
#define REPS(k) ((PROBE_REP == (k)) ? (1 + PROBE_REPN) : 1)
#define REPSL(k) ((((k) == 7 && l != 0) || ((k) == 13 && l != DEPTH - 1)) ? 1 : REPS(k))
#ifndef MK_MULTI
#define MK_MULTI 0
#endif

#define GAS __attribute__((address_space(1)))
#define LAS __attribute__((address_space(3)))
typedef unsigned short bf16;
typedef unsigned v4u __attribute__((ext_vector_type(4)));
typedef unsigned v2u __attribute__((ext_vector_type(2)));
typedef float f32x4 __attribute__((ext_vector_type(4)));

constexpr int NB = 4, S = 4096, T = NB * S, D = 1024, DIN = 2568, DR = 512, DA = 512, NH = 8, HD = 64;
constexpr int NE = 32, DE = 512, PLE = 256, DEPTH = 2, NZ = 2560;
constexpr float EPS = 1e-6f, LOG2E = 1.4426950408889634f, C2 = 0.125f * 1.4426950408889634f;
constexpr int CAP = 16384;
constexpr int HROWS = 40960;

constexpr size_t MiB = 1u << 20;
constexpr size_t WS_CTL = 0, CTL_ZERO_BYTES = 1 * MiB;
constexpr size_t WS_LOGF = 1 * MiB;
constexpr size_t WS_C2K = WS_LOGF + MiB / 2;
constexpr size_t WS_SA = 6 * MiB, WS_SH = 7 * MiB;
constexpr size_t WS_PAIRW = 3 * MiB;
constexpr size_t WS_ROWPAIR = 4 * MiB;
constexpr size_t WS_WIN = 8 * MiB;
constexpr size_t WS_WOUT = 18 * MiB;
constexpr size_t WS_WPG = 22 * MiB;
constexpr size_t WS_WPP = 26 * MiB;
constexpr size_t WS_WGU = 28 * MiB;
constexpr size_t WS_WDN = 156 * MiB;
constexpr size_t WS_PB = 220 * MiB;
constexpr size_t WS_XN = 236 * MiB;
constexpr size_t WS_X = 268 * MiB;
constexpr size_t WS_R1 = 332 * MiB;
constexpr size_t WS_R2 = 412 * MiB;
constexpr size_t WS_PROJ = 460 * MiB;
constexpr size_t WS_END = 492 * MiB;
constexpr int CW_BAR = 4096;
constexpr int CW_TS = 20480;
constexpr int CW_ATT = 16384;
constexpr int CW_CNT = 8192, CNT_STRIDE = 64;

constexpr int RING_BYTES = 131072;
constexpr int LDS_BYTES = 163840;
constexpr int MISC_OFF = LDS_BYTES - 1024;
constexpr int WPROJ_BYTES = 147456;

__device__ __forceinline__ unsigned f2bf(float f) { unsigned u = __builtin_bit_cast(unsigned, f); return (u + 0x7fffu + ((u >> 16) & 1u)) >> 16; }
__device__ __forceinline__ unsigned pk2(float lo, float hi) { return f2bf(lo) | (f2bf(hi) << 16); }
__device__ __forceinline__ float bf2f(unsigned u) { return __builtin_bit_cast(float, u << 16); }
__device__ __forceinline__ float bflo(unsigned w) { return __builtin_bit_cast(float, w << 16); }
__device__ __forceinline__ float bfhi(unsigned w) { return __builtin_bit_cast(float, w & 0xffff0000u); }
template <int O> __device__ __forceinline__ float lane_xor(float v) {
    if constexpr (O == 32) { const unsigned u = __builtin_bit_cast(unsigned, v); auto rr = __builtin_amdgcn_permlane32_swap(u, u, false, false);
        const unsigned a = rr[0], b = rr[1]; return __builtin_bit_cast(float, a == u ? b : a); }
    else return __builtin_bit_cast(float, __builtin_amdgcn_ds_swizzle(__builtin_bit_cast(int, v), (O << 10) | 0x1f));
}
__device__ __forceinline__ float wave_sum(float v) {
    v += lane_xor<1>(v); v += lane_xor<2>(v); v += lane_xor<4>(v); v += lane_xor<8>(v); v += lane_xor<16>(v);
    { const unsigned u = __builtin_bit_cast(unsigned, v); auto rr = __builtin_amdgcn_permlane32_swap(u, u, false, false); v = __builtin_bit_cast(float, (unsigned)rr[0]) + __builtin_bit_cast(float, (unsigned)rr[1]); }
    return v;
}
__device__ __forceinline__ float wave_max(float v) {
    v = fmaxf(v, lane_xor<1>(v)); v = fmaxf(v, lane_xor<2>(v)); v = fmaxf(v, lane_xor<4>(v)); v = fmaxf(v, lane_xor<8>(v)); v = fmaxf(v, lane_xor<16>(v));
    { const unsigned u = __builtin_bit_cast(unsigned, v); auto rr = __builtin_amdgcn_permlane32_swap(u, u, false, false); v = fmaxf(__builtin_bit_cast(float, (unsigned)rr[0]), __builtin_bit_cast(float, (unsigned)rr[1])); }
    return v;
}
__device__ __forceinline__ float half_sum32(float v) {
    const unsigned u = __builtin_bit_cast(unsigned, v); auto rr = __builtin_amdgcn_permlane32_swap(u, u, false, false); return __builtin_bit_cast(float, (unsigned)rr[0]) + __builtin_bit_cast(float, (unsigned)rr[1]);
}
__device__ __forceinline__ float sigmoidf_(float v) { return 1.f / (1.f + __expf(-v)); }
__device__ __forceinline__ float gelu_tanh(float v) { return 0.5f * v * (1.f + tanhf(0.7978845608028654f * (v + 0.044715f * v * v * v))); }
__device__ __forceinline__ float log_sigmoid(float v) { return v >= 0.f ? -log1pf(__expf(-v)) : v - log1pf(__expf(v)); }

#define XB_TMO      128
#define XB_XCNT(j)  (256  + 64 * (j))
#define XB_XSUB(j)  (1280 + 64 * (j))
#define XB_XGEN(j)  (2304 + 64 * (j))
#define XB_TOP      3328
#define XB_TOPGEN   3392
#define XCD_BAR_WORDS 3456
#define XB_SPIN_CAP (1u << 26)
__device__ __forceinline__ unsigned xb_ld(unsigned* p)              { return __hip_atomic_load(p, __ATOMIC_RELAXED, __HIP_MEMORY_SCOPE_AGENT); }
__device__ __forceinline__ unsigned xb_add(unsigned* p, unsigned v) { return __hip_atomic_fetch_add(p, v, __ATOMIC_RELAXED, __HIP_MEMORY_SCOPE_AGENT); }
__device__ __forceinline__ unsigned xb_xcc_id() { return (unsigned)__builtin_amdgcn_s_getreg((3 << 11) | 20) & 0xFu; }
#define XB_SPIN(cond, bar) do { unsigned _sp = 0; while (cond) { __builtin_amdgcn_s_sleep(1); \
    if ((++_sp & 255u) == 0u) { if (xb_ld(&(bar)[XB_TMO])) break; if (_sp > XB_SPIN_CAP) { atomicAdd(&(bar)[XB_TMO], 1u); break; } } } } while (0)
struct XcdBarrier { unsigned* bar; unsigned x; volatile LAS unsigned* st; };
__device__ __forceinline__ XcdBarrier xcd_barrier_post(unsigned* bar, volatile LAS unsigned* st) {
    XcdBarrier b; b.bar = bar; b.x = xb_xcc_id(); b.st = st;
    if (threadIdx.x == 0) (void)xb_add(&bar[XB_XCNT(b.x)], 1u);
    return b;
}
__device__ __forceinline__ void xcd_barrier_complete(unsigned* bar, unsigned x, unsigned& nloc, unsigned& nx) {
    const unsigned G = gridDim.x * gridDim.y * gridDim.z;
    unsigned sum, cnt, mine, sp = 0u;
    for (;;) {
        sum = 0u; cnt = 0u; mine = 0u;
#pragma unroll
        for (unsigned j = 0; j < 16; ++j) { const unsigned c = xb_ld(&bar[XB_XCNT(j)]); sum += c; cnt += (c > 0u) ? 1u : 0u; mine = (j == x) ? c : mine; }
        if (sum == G) break;
        __builtin_amdgcn_s_sleep(1);
        if ((++sp & 255u) == 0u) { if (xb_ld(&bar[XB_TMO])) break; if (sp > XB_SPIN_CAP) { atomicAdd(&bar[XB_TMO], 1u); break; } }
    }
    nloc = mine > 0u ? mine : 1u; nx = cnt > 0u ? cnt : 1u;
}
__device__ __forceinline__ void xcd_barrier(const XcdBarrier& b, const bool leader  ) {
    asm volatile("s_waitcnt vmcnt(0)" ::: "memory");
    __syncthreads();
    if (leader) {
        unsigned* bar = b.bar;
        __builtin_amdgcn_s_waitcnt(0);
        unsigned nloc = b.st[0], nx = b.st[1];
        if (nloc == 0u) { xcd_barrier_complete(bar, b.x, nloc, nx); b.st[0] = nloc; b.st[1] = nx; }
        const unsigned old = xb_add(&bar[XB_XSUB(b.x)], 1u);
        const unsigned gen = old / nloc;
        if (old + 1u == (gen + 1u) * nloc) {
            __builtin_amdgcn_fence(__ATOMIC_RELEASE, "agent");
            asm volatile("s_waitcnt vmcnt(0)" ::: "memory");
            const unsigned og = xb_add(&bar[XB_TOP], 1u);
            const unsigned tg = og / nx;
            if (og + 1u == (tg + 1u) * nx) xb_add(&bar[XB_TOPGEN], 1u);
            else XB_SPIN(xb_ld(&bar[XB_TOPGEN]) == tg, bar);
            __builtin_amdgcn_fence(__ATOMIC_ACQUIRE, "agent");
            xb_add(&bar[XB_XGEN(b.x)], 1u);
            asm volatile("s_waitcnt vmcnt(0)" ::: "memory");
        } else {
            XB_SPIN(xb_ld(&bar[XB_XGEN(b.x)]) == gen, bar);
            __builtin_amdgcn_fence(__ATOMIC_ACQUIRE, "agent");
            asm volatile("s_waitcnt vmcnt(0)" ::: "memory");
        }
    }
    __syncthreads();
}

struct Args { const float* in[29]; float* out; unsigned char* ws; int ph_lo, ph_hi; };
typedef const __attribute__((address_space(4))) Args* KA;
__device__ __forceinline__ KA fresh_args() { KA p = (KA)__builtin_amdgcn_kernarg_segment_ptr(); asm volatile("" : "+s"(p)); return p; }
struct Ctx;
struct Ctx {
    LAS unsigned char* lds;
    int tid, lane, wave, gw, ngw;
    int wave0;
    unsigned char* ws;
};
__device__ __forceinline__ void enter_phase(Ctx& C, KA A) {
    int t; asm volatile("v_mbcnt_lo_u32_b32 %0, -1, 0\n\tv_mbcnt_hi_u32_b32 %0, -1, %0" : "=v"(t)); t += C.wave0 * 64; C.tid = t; C.lane = t & 63; C.wave = __builtin_amdgcn_readfirstlane(t >> 6);
    C.gw = blockIdx.x * 8 + C.wave; C.ngw = gridDim.x * 8; C.ws = A->ws; }
enum { I_X = 0, I_P, I_MIXN, I_WIN, I_BF, I_CONVW, I_CONVB, I_WR, I_BR, I_WI, I_BI, I_LAM, I_QN, I_KN, I_LRUN, I_ATTN, I_WOUT, I_FFNN,
       I_WG, I_BG, I_WRT, I_BRT, I_WEG, I_WEU, I_WED, I_PLEN, I_WPG, I_BPG, I_WPP };

__device__ __forceinline__ void transpose_item(const float* W, int ldw, int K, bf16* WT, int k0, int n0, int c0, LAS float* scr, int lane) {
#pragma unroll 8
    for (int i = 0; i < 32; ++i) { const int kk = 2 * i + (lane >> 5); scr[kk * 33 + (lane & 31)] = W[(size_t)(k0 + kk) * ldw + c0 + (lane & 31)]; }
    asm volatile("s_waitcnt lgkmcnt(0)" ::: "memory");
    const int c = lane & 7;
#pragma unroll
    for (int j = 0; j < 4; ++j) { const int n = (lane >> 3) + 8 * j; const LAS float* s = scr + (8 * c) * 33 + n;
        v4u o; o.x = pk2(s[0 * 33], s[1 * 33]); o.y = pk2(s[2 * 33], s[3 * 33]); o.z = pk2(s[4 * 33], s[5 * 33]); o.w = pk2(s[6 * 33], s[7 * 33]);
        *(v4u*)(WT + (size_t)(n0 + n) * K + k0 + 8 * c) = o; }
    asm volatile("s_waitcnt lgkmcnt(0)" ::: "memory");
}
__device__ __forceinline__ void phase_prologue(Ctx& C, KA AR) {
    LAS float* scr = (LAS float*)(C.lds + C.wave * 16384);
    constexpr int I_IN = 16 * 80, I_OUT = 16 * 32, I_GU = 32 * 16 * 32, I_DN = 32 * 8 * 32, I_PG = 16 * 32, I_PP = 4 * 32;
    constexpr int PER_L = I_IN + I_OUT + I_GU + I_DN + I_PG + I_PP;
    for (int it = C.gw; it < DEPTH * PER_L; it += C.ngw) {
        const int l = it / PER_L; int r = it % PER_L;
        if (r < I_IN) {
            const int kb = r / 80, nb = r % 80, n0 = 32 * nb, pn = n0 >> 8, jl = n0 & 255, bj = jl >> 7, wc = (jl >> 5) & 3;
            transpose_item(AR->in[I_WIN] + (size_t)l * D * DIN, DIN, D, (bf16*)(C.ws + WS_WIN) + (size_t)l * NZ * D, 64 * kb, n0, 256 * pn + 64 * wc + 32 * bj, scr, C.lane); continue; }
        r -= I_IN;
        if (r < I_OUT) { const int kb = r / 32, nb = r % 32;
            transpose_item(AR->in[I_WOUT] + (size_t)l * D * D, D, D, (bf16*)(C.ws + WS_WOUT) + (size_t)l * D * D, 64 * kb, 32 * nb, 32 * nb, scr, C.lane); continue; }
        r -= I_OUT;
        if (r < I_GU) {
            const int e = r / 512, q = r % 512, kb = q / 32, nb = q % 32, n0 = 32 * nb, pn = n0 >> 8, jl = n0 & 255;
            const float* src = (jl < 128 ? AR->in[I_WEG] : AR->in[I_WEU]) + (size_t)(l * NE + e) * D * DE;
            transpose_item(src, DE, D, (bf16*)(C.ws + WS_WGU) + (size_t)(l * NE + e) * 1024 * D, 64 * kb, n0, 128 * pn + (jl & 127), scr, C.lane); continue; }
        r -= I_GU;
        if (r < I_DN) { const int e = r / 256, q = r % 256, kb = q / 32, nb = q % 32;
            transpose_item(AR->in[I_WED] + (size_t)(l * NE + e) * DE * D, D, DE, (bf16*)(C.ws + WS_WDN) + (size_t)(l * NE + e) * D * DE, 64 * kb, 32 * nb, 32 * nb, scr, C.lane); continue; }
        r -= I_DN;
        if (r < I_PG) { const int kb = r / 32, nb = r % 32;
            transpose_item(AR->in[I_WPG] + (size_t)l * D * D, D, D, (bf16*)(C.ws + WS_WPG) + (size_t)l * D * D, 64 * kb, 32 * nb, 32 * nb, scr, C.lane); continue; }
        r -= I_PG;
        { const int kb = r / 32, nb = r % 32;
            transpose_item(AR->in[I_WPP] + (size_t)l * PLE * D, D, PLE, (bf16*)(C.ws + WS_WPP) + (size_t)l * D * PLE, 64 * kb, 32 * nb, 32 * nb, scr, C.lane); }
    }
    const f32x4* ps = (const f32x4*)AR->in[I_P]; v2u* pd = (v2u*)(C.ws + WS_PB);
    const size_t n4 = (size_t)DEPTH * T * PLE / 4;
    for (size_t i = (size_t)blockIdx.x * 512 + C.tid; i < n4; i += (size_t)gridDim.x * 512) { const f32x4 v = ps[i]; v2u o; o.x = pk2(v.x, v.y); o.y = pk2(v.z, v.w); pd[i] = o; }
}

__device__ __forceinline__ void load_row(const float* row, int lane, f32x4 (&v)[4]) {
    const f32x4* xr = (const f32x4*)row + lane;
#pragma unroll
    for (int j = 0; j < 4; ++j) v[j] = xr[64 * j];
}
__device__ __forceinline__ float row_rs(const f32x4 (&v)[4]) {
    float s = 0.f;
#pragma unroll
    for (int j = 0; j < 4; ++j) s += (v[j].x * v[j].x + v[j].y * v[j].y) + (v[j].z * v[j].z + v[j].w * v[j].w);
    return rsqrtf(wave_sum(s) * (1.f / D) + EPS);
}
__device__ __forceinline__ void scale_row(f32x4 (&v)[4], float rs, const float* gain, int lane) {
    const f32x4* g = (const f32x4*)gain + lane;
#pragma unroll
    for (int j = 0; j < 4; ++j) v[j] = v[j] * rs * g[64 * j];
}
__device__ __forceinline__ void store_row_bf16(bf16* row, int lane, const f32x4 (&v)[4]) {
    v2u* o = (v2u*)row + lane;
#pragma unroll
    for (int j = 0; j < 4; ++j) { v2u w; w.x = pk2(v[j].x, v[j].y); w.y = pk2(v[j].z, v[j].w); o[64 * j] = w; }
}

__device__ __forceinline__ void phase_norm1(Ctx& C, KA AR, int l) {
    const float* xs = l == 0 ? AR->in[I_X] : (const float*)(C.ws + WS_X);
    const float* gain = AR->in[I_MIXN] + l * D;
    const float* wf = AR->in[I_WIN] + (size_t)l * D * DIN + NZ;
    const float* bfg = AR->in[I_BF] + l * NH;
    bf16* xn = (bf16*)(C.ws + WS_XN); float* logf = (float*)(C.ws + WS_LOGF);
    for (int t = C.gw; t < T; t += C.ngw) {
        f32x4 v[4]; load_row(xs + (size_t)t * D, C.lane, v);
        const float rs = row_rs(v); scale_row(v, rs, gain, C.lane);
        store_row_bf16(xn + (size_t)t * D, C.lane, v);
        float z[8] = {0.f, 0.f, 0.f, 0.f, 0.f, 0.f, 0.f, 0.f};
#pragma unroll
        for (int j = 0; j < 4; ++j)
#pragma unroll
            for (int e = 0; e < 4; ++e) { const int k = 256 * j + 4 * C.lane + e; const f32x4 w0 = *(const f32x4*)(wf + (size_t)k * DIN), w1 = *(const f32x4*)(wf + (size_t)k * DIN + 4);
                const float a = v[j][e]; z[0] += a * w0.x; z[1] += a * w0.y; z[2] += a * w0.z; z[3] += a * w0.w; z[4] += a * w1.x; z[5] += a * w1.y; z[6] += a * w1.z; z[7] += a * w1.w; }
#pragma unroll
        for (int h = 0; h < 8; ++h) z[h] = wave_sum(z[h]);
        float mine = 0.f;
#pragma unroll
        for (int h = 0; h < 8; ++h) mine = (C.lane == h) ? z[h] : mine;
        if (C.lane < 8) logf[(size_t)t * 8 + C.lane] = log_sigmoid(mine + bfg[C.lane]);
    }
}

template <int NACC, class AR, class BR, class EP>
__device__ __forceinline__ void ngemm_tile(LAS float* sm, int K, AR arow, BR brow, EP epi, const int tid) {
    LAS float* As = sm; LAS float* Bs = sm + 32 * 68;
    const int ty = tid >> 4, tx = tid & 15, lr = tid >> 3, lk = (tid & 7) * 4;
    float acc[NACC][2][4];
#pragma unroll
    for (int a = 0; a < NACC; ++a)
#pragma unroll
        for (int i = 0; i < 2; ++i)
#pragma unroll
            for (int j = 0; j < 4; ++j) acc[a][i][j] = 0.f;
    const bf16* ap = arow(lr); const bf16* bp0 = brow(lr, 0); const bf16* bp1 = NACC > 1 ? brow(lr, 1) : bp0;
    for (int k0 = 0; k0 < K; k0 += 32) {
        __syncthreads();
        { v2u av; av.x = 0u; av.y = 0u; if (ap) av = *(const v2u*)(ap + k0 + lk);
          As[(lk + 0) * 68 + lr] = bflo(av.x); As[(lk + 1) * 68 + lr] = bfhi(av.x); As[(lk + 2) * 68 + lr] = bflo(av.y); As[(lk + 3) * 68 + lr] = bfhi(av.y); }
        { const v2u bv = *(const v2u*)(bp0 + k0 + lk);
          Bs[(lk + 0) * 68 + lr] = bflo(bv.x); Bs[(lk + 1) * 68 + lr] = bfhi(bv.x); Bs[(lk + 2) * 68 + lr] = bflo(bv.y); Bs[(lk + 3) * 68 + lr] = bfhi(bv.y); }
        if (NACC > 1) { const v2u bv = *(const v2u*)(bp1 + k0 + lk); LAS float* B1 = Bs + 32 * 68;
          B1[(lk + 0) * 68 + lr] = bflo(bv.x); B1[(lk + 1) * 68 + lr] = bfhi(bv.x); B1[(lk + 2) * 68 + lr] = bflo(bv.y); B1[(lk + 3) * 68 + lr] = bfhi(bv.y); }
        __syncthreads();
#pragma unroll 8
        for (int kk = 0; kk < 32; ++kk) {
            const float a0 = As[kk * 68 + ty * 2], a1 = As[kk * 68 + ty * 2 + 1];
#pragma unroll
            for (int a = 0; a < NACC; ++a) { const f32x4 b = *(const LAS f32x4*)(Bs + a * 32 * 68 + kk * 68 + tx * 4);
#pragma unroll
                for (int j = 0; j < 4; ++j) { acc[a][0][j] += a0 * b[j]; acc[a][1][j] += a1 * b[j]; } }
        }
    }
#pragma unroll
    for (int i = 0; i < 2; ++i)
#pragma unroll
        for (int j = 0; j < 4; ++j) epi(ty * 2 + i, tx * 4 + j, acc[0][i][j], NACC > 1 ? acc[1][i][j] : 0.f);
}

__device__ __forceinline__ void phase_cumsum(Ctx& C, KA AR) {
    if (C.gw < NB * NH) {
        const int b = C.gw / NH, h = C.gw % NH;
        const float* logf = (const float*)(C.ws + WS_LOGF) + (size_t)b * S * 8 + h; float* c2k = (float*)(C.ws + WS_C2K) + (size_t)C.gw * S;
        float s = 0.f;
        for (int i = 0; i < 64; ++i) s += logf[(size_t)(64 * C.lane + i) * 8];
        float inc = s;
#pragma unroll
        for (int o = 1; o < 64; o <<= 1) { const float v = __builtin_bit_cast(float, __builtin_amdgcn_ds_bpermute((C.lane - o) << 2, __builtin_bit_cast(int, inc))); if (C.lane >= o) inc += v; }
        float run = inc - s;
        for (int i = 0; i < 64; ++i) { run += logf[(size_t)(64 * C.lane + i) * 8]; c2k[64 * C.lane + i] = run * LOG2E; }
    }
}
__device__ __forceinline__ void phase_cumsum_fast(Ctx& C, KA AR) {
    const int row = (int)blockIdx.x - (int)gridDim.x / 2;
    if (C.wave == 0 && row >= 0 && row < NB * NH) {
        const float* src = (const float*)(C.ws + WS_LOGF) + (size_t)row * S + C.lane; float* dst = (float*)(C.ws + WS_C2K) + (size_t)row * S + C.lane;
        float run = 0.f;
        for (int it = 0; it < S / 64; it += 8) {
            float v[8];
#pragma unroll
            for (int q = 0; q < 8; ++q) v[q] = src[(it + q) * 64];
#pragma unroll
            for (int q = 0; q < 8; ++q) { float x = v[q];
#pragma unroll
                for (int o = 1; o < 64; o <<= 1) { const float y = __builtin_bit_cast(float, __builtin_amdgcn_ds_bpermute((C.lane - o) << 2, __builtin_bit_cast(int, x))); if (C.lane >= o) x += y; }
                dst[(it + q) * 64] = (run + x) * LOG2E;
                run += __builtin_bit_cast(float, __builtin_amdgcn_readlane(__builtin_bit_cast(int, x), 63)); }
        }
    }
}
__device__ __forceinline__ void phase_gemm1_naive(Ctx& C, KA AR, int l) {
    phase_cumsum(C, AR);
    const bf16* A = (const bf16*)(C.ws + WS_XN); const bf16* Bt = (const bf16*)(C.ws + WS_WIN) + (size_t)l * NZ * D;
    bf16* R1 = (bf16*)(C.ws + WS_R1);
    for (int u = blockIdx.x; u < (T / 64) * (NZ / 64); u += gridDim.x) {
        const int mt = u / (NZ / 64), nt = u % (NZ / 64), m0 = 64 * mt, n0 = 64 * nt;
        ngemm_tile<1>((LAS float*)C.lds, D, [=](int r) { return A + (size_t)(m0 + r) * D; }, [=](int c, int) { return Bt + (size_t)(n0 + c) * D; },
            [=](int r, int c, float v, float) {
                const int j = n0 + c, pn = j >> 8, jl = j & 255, bj = jl >> 7, wc = (jl >> 5) & 3, col = 256 * pn + 64 * wc + 32 * bj + (jl & 31);
                const int seg = col >> 9, cc = col & 511;
                const float o = seg == 1 ? gelu_tanh(v) : v;
                R1[(size_t)seg * T * 512 + (size_t)(m0 + r) * 512 + cc] = (bf16)f2bf(o);
            }, C.tid);
    }
}
__device__ __forceinline__ void phase_qknorm_naive(Ctx& C, KA AR, int l) {
    bf16* Q = (bf16*)(C.ws + WS_R1) + (size_t)2 * T * 512; bf16* Kb = Q + (size_t)T * 512;
    const float* gq = AR->in[I_QN] + l * HD; const float* gk = AR->in[I_KN] + l * HD;
    for (int i = C.gw; i < 2 * T; i += C.ngw) {
        const int t = i >> 1, isk = i & 1; bf16* row = (isk ? Kb : Q) + (size_t)t * 512; const float* g = isk ? gk : gq;
        const v4u w = *(const v4u*)(row + 8 * C.lane);
        float x[8] = {bflo(w.x), bfhi(w.x), bflo(w.y), bfhi(w.y), bflo(w.z), bfhi(w.z), bflo(w.w), bfhi(w.w)};
        float s = 0.f;
#pragma unroll
        for (int e = 0; e < 8; ++e) s += x[e] * x[e];
        s += lane_xor<1>(s); s += lane_xor<2>(s); s += lane_xor<4>(s);
        const float rs = rsqrtf(s * (1.f / 64.f) + EPS) * (isk ? 1.f : C2);
        const int d0 = 8 * (C.lane & 7);
#pragma unroll
        for (int e = 0; e < 8; ++e) x[e] = x[e] * rs * g[d0 + e];
        v4u o; o.x = pk2(x[0], x[1]); o.y = pk2(x[2], x[3]); o.z = pk2(x[4], x[5]); o.w = pk2(x[6], x[7]);
        *(v4u*)(row + 8 * C.lane) = o;
    }
}

template <int MODE>
__device__ __forceinline__ void phase_rnn_naive(Ctx& C, KA AR, int l) {
    LAS float* xcs = (LAS float*)C.lds; LAS float* as = xcs + 64 * 65; LAS float* us = as + 64 * 64;
    const bf16* ZX = (const bf16*)(C.ws + WS_R1); const bf16* ZG = ZX + (size_t)T * 512;
    float* SA = (float*)(C.ws + WS_SA); float* SH = (float*)(C.ws + WS_SH); float* YR = (float*)(C.ws + WS_PROJ);
    const float* cw = AR->in[I_CONVW] + l * 4 * DR; const float* cb = AR->in[I_CONVB] + l * DR;
    const float* wr = AR->in[I_WR] + (size_t)l * 8 * 64 * 64; const float* wi = AR->in[I_WI] + (size_t)l * 8 * 64 * 64;
    const float* br = AR->in[I_BR] + l * DR; const float* bi = AR->in[I_BI] + l * DR; const float* lam = AR->in[I_LAM] + l * DR;
    for (int u = blockIdx.x; u < NB * 64 * 8; u += gridDim.x) {
        const int b = u >> 9, cidx = (u >> 3) & 63, blk = u & 7;
        __syncthreads();
#pragma unroll
        for (int i = 0; i < 8; ++i) { const int e = C.tid + 512 * i, t = e >> 6, c = e & 63, ch = blk * 64 + c, tg = cidx * 64 + t;
            float xc = cb[ch];
#pragma unroll
            for (int j = 0; j < 4; ++j) { const int tt = tg - 3 + j; if (tt >= 0) xc += cw[j * DR + ch] * bf2f(ZX[(size_t)(b * S + tt) * 512 + ch]); }
            xcs[t * 65 + c] = xc; }
        __syncthreads();
#pragma unroll
        for (int i = 0; i < 8; ++i) { const int e = C.tid + 512 * i, t = e >> 6, j = e & 63, ch = blk * 64 + j;
            float ar = br[ch], ai = bi[ch];
            for (int k = 0; k < 64; ++k) { const float x = xcs[t * 65 + k]; ar += x * wr[(size_t)(blk * 64 + k) * 64 + j]; ai += x * wi[(size_t)(blk * 64 + k) * 64 + j]; }
            const float r = sigmoidf_(ar), ig = sigmoidf_(ai);
            const float la = -8.f * r * log1pf(__expf(-lam[ch]));
            as[t * 64 + j] = __expf(la); us[t * 64 + j] = sqrtf(-expm1f(2.f * la)) * (ig * xcs[t * 65 + j]); }
        __syncthreads();
        if (C.tid < 64) { const int j = C.tid, ch = blk * 64 + j;
            if (MODE == 0) { float A = 1.f, H = 0.f;
                for (int t = 0; t < 64; ++t) { const float a = as[t * 64 + j]; H = a * H + us[t * 64 + j]; A *= a; }
                SA[(size_t)(b * 64 + cidx) * 512 + ch] = A; SH[(size_t)(b * 64 + cidx) * 512 + ch] = H;
            } else { float h = 0.f;
                for (int c2 = 0; c2 < cidx; ++c2) h = SA[(size_t)(b * 64 + c2) * 512 + ch] * h + SH[(size_t)(b * 64 + c2) * 512 + ch];
                for (int t = 0; t < 64; ++t) { h = as[t * 64 + j] * h + us[t * 64 + j]; as[t * 64 + j] = h; } } }
        if (MODE == 1) { __syncthreads();
#pragma unroll
            for (int i = 0; i < 8; ++i) { const int e = C.tid + 512 * i, t = e >> 6, c = e & 63, ch = blk * 64 + c; const size_t row = (size_t)(b * S + cidx * 64 + t);
                YR[row * 512 + ch] = as[t * 64 + c] * bf2f(ZG[row * 512 + ch]); } }
    }
}

__device__ __forceinline__ void phase_attn_naive(Ctx& C, KA AR, int l) {
    LAS float* Ks = (LAS float*)C.lds; LAS float* Vs = Ks + 64 * 65; LAS float* Qs = Vs + 64 * 65; LAS float* Ps = Qs + 64 * 64; LAS float* cks = Ps + 8 * 64;
    const bf16* Q = (const bf16*)(C.ws + WS_R1) + (size_t)2 * T * 512; const bf16* Kb = Q + (size_t)T * 512; const bf16* Vb = Kb + (size_t)T * 512;
    bf16* O = (bf16*)(C.ws + WS_R2); const float* c2k = (const float*)(C.ws + WS_C2K);
    for (int u = blockIdx.x; u < NB * NH * 64; u += gridDim.x) {
        const int qt = 63 - (u >> 5), bh = u & 31, b = bh >> 3, h = bh & 7, q0 = 64 * qt;
        const float* ck = c2k + (size_t)bh * S;
        __syncthreads();
        for (int e = C.tid; e < 64 * 64; e += 512) { const int r = e >> 6, d = e & 63; Qs[r * 64 + d] = bf2f(Q[(size_t)(b * S + q0 + r) * 512 + h * 64 + d]); }
        float m[8], lsum[8], o[8], cq[8];
#pragma unroll
        for (int i = 0; i < 8; ++i) { m[i] = -INFINITY; lsum[i] = 0.f; o[i] = 0.f; cq[i] = ck[q0 + C.wave * 8 + i]; }
        for (int kt = 0; kt <= qt; ++kt) {
            const int k0 = 64 * kt;
            __syncthreads();
            for (int e = C.tid; e < 64 * 64; e += 512) { const int r = e >> 6, d = e & 63; const size_t g = (size_t)(b * S + k0 + r) * 512 + h * 64 + d; Ks[r * 65 + d] = bf2f(Kb[g]); Vs[r * 65 + d] = bf2f(Vb[g]); }
            if (C.tid < 64) cks[C.tid] = ck[k0 + C.tid];
            __syncthreads();
#pragma unroll
            for (int i = 0; i < 8; ++i) {
                const int q = C.wave * 8 + i, qg = q0 + q;
                float dot = 0.f;
#pragma unroll 16
                for (int d = 0; d < 64; ++d) dot += Qs[q * 64 + d] * Ks[C.lane * 65 + d];
                float s = dot + cq[i] - cks[C.lane];
                if (k0 + C.lane > qg) s = -INFINITY;
                const float mn = fmaxf(m[i], wave_max(s));
                const float alpha = exp2f(m[i] - mn), p = exp2f(s - mn);
                lsum[i] = lsum[i] * alpha + wave_sum(p); m[i] = mn;
                Ps[C.wave * 64 + C.lane] = p;
                asm volatile("s_waitcnt lgkmcnt(0)" ::: "memory");
                float acc = 0.f;
#pragma unroll 16
                for (int k = 0; k < 64; ++k) acc += Ps[C.wave * 64 + k] * Vs[k * 65 + C.lane];
                o[i] = o[i] * alpha + acc;
                asm volatile("s_waitcnt lgkmcnt(0)" ::: "memory");
            }
        }
#pragma unroll
        for (int i = 0; i < 8; ++i) O[(size_t)(b * S + q0 + C.wave * 8 + i) * 512 + h * 64 + C.lane] = (bf16)f2bf(o[i] / lsum[i]);
    }
}

__device__ __forceinline__ void phase_mixnorm_naive(Ctx& C, KA AR, int l) {
    const float* YR = (const float*)(C.ws + WS_PROJ); const bf16* O = (const bf16*)(C.ws + WS_R2); bf16* YM = (bf16*)(C.ws + WS_R2 + 16 * MiB);
    const float* g1 = AR->in[I_LRUN] + l * DR; const float* g2 = AR->in[I_ATTN] + l * DA;
    for (int t = C.gw; t < T; t += C.ngw) {
        f32x4 a[2]; float s = 0.f;
#pragma unroll
        for (int j = 0; j < 2; ++j) { a[j] = *((const f32x4*)(YR + (size_t)t * 512) + C.lane + 64 * j); s += (a[j].x * a[j].x + a[j].y * a[j].y) + (a[j].z * a[j].z + a[j].w * a[j].w); }
        float rs = rsqrtf(wave_sum(s) * (1.f / 512.f) + EPS);
#pragma unroll
        for (int j = 0; j < 2; ++j) { const f32x4 g = *((const f32x4*)g1 + C.lane + 64 * j); const f32x4 v = a[j] * rs * g; v2u w; w.x = pk2(v.x, v.y); w.y = pk2(v.z, v.w);
            *((v2u*)(YM + (size_t)t * D) + C.lane + 64 * j) = w; }
        const v4u w = *(const v4u*)(O + (size_t)t * 512 + 8 * C.lane);
        float x[8] = {bflo(w.x), bfhi(w.x), bflo(w.y), bfhi(w.y), bflo(w.z), bfhi(w.z), bflo(w.w), bfhi(w.w)};
        s = 0.f;
#pragma unroll
        for (int e = 0; e < 8; ++e) s += x[e] * x[e];
        rs = rsqrtf(wave_sum(s) * (1.f / 512.f) + EPS);
#pragma unroll
        for (int e = 0; e < 8; ++e) x[e] = x[e] * rs * g2[8 * C.lane + e];
        v4u o; o.x = pk2(x[0], x[1]); o.y = pk2(x[2], x[3]); o.z = pk2(x[4], x[5]); o.w = pk2(x[6], x[7]);
        *(v4u*)(YM + (size_t)t * D + 512 + 8 * C.lane) = o;
    }
}

__device__ __forceinline__ void phase_wo_naive(Ctx& C, KA AR, int l) {
    const bf16* A = (const bf16*)(C.ws + WS_R2 + 16 * MiB); const bf16* Bt = (const bf16*)(C.ws + WS_WOUT) + (size_t)l * D * D;
    const float* xs = l == 0 ? AR->in[I_X] : (const float*)(C.ws + WS_X); float* X = (float*)(C.ws + WS_X);
    for (int u = blockIdx.x; u < (T / 64) * (D / 64); u += gridDim.x) {
        const int m0 = 64 * (u / (D / 64)), n0 = 64 * (u % (D / 64));
        ngemm_tile<1>((LAS float*)C.lds, D, [=](int r) { return A + (size_t)(m0 + r) * D; }, [=](int c, int) { return Bt + (size_t)(n0 + c) * D; },
            [=](int r, int c, float v, float) { const size_t i = (size_t)(m0 + r) * D + n0 + c; X[i] = xs[i] + v; }, C.tid);
    }
}

__device__ __forceinline__ void phase_router(Ctx& C, KA AR, int l) {
    const float* X = (const float*)(C.ws + WS_X); bf16* xn = (bf16*)(C.ws + WS_XN);
    const float* gain = AR->in[I_FFNN] + l * D; const float* wg = AR->in[I_WG] + (size_t)l * D * 4; const float* bg = AR->in[I_BG] + l * 4;
    const float* wr = AR->in[I_WRT] + (size_t)l * D * NE; const float* brt = AR->in[I_BRT] + l * NE;
    unsigned* cnt = (unsigned*)(C.ws + WS_CTL) + CW_CNT + 32 * CNT_STRIDE * l; int* rowpair = (int*)(C.ws + WS_ROWPAIR); float* pairw = (float*)(C.ws + WS_PAIRW);
    for (int t = C.gw; t < T; t += C.ngw) {
        f32x4 v[4]; load_row(X + (size_t)t * D, C.lane, v);
        const float rs = row_rs(v); scale_row(v, rs, gain, C.lane);
        store_row_bf16(xn + (size_t)t * D, C.lane, v);
        LAS float* rowl = (LAS float*)C.lds + C.wave * 1024;
#pragma unroll
        for (int j = 0; j < 4; ++j) *((LAS f32x4*)rowl + C.lane + 64 * j) = v[j];
        asm volatile("s_waitcnt lgkmcnt(0)" ::: "memory");
        float acc = 0.f;
        if (C.lane < 36) {
            const float* wp = C.lane < 32 ? wr + C.lane : wg + (C.lane - 32); const int st = C.lane < 32 ? NE : 4;
#pragma unroll 8
            for (int k = 0; k < D; ++k) acc += rowl[k] * wp[(size_t)k * st];
            acc += C.lane < 32 ? brt[C.lane] : bg[C.lane - 32];
        }
        asm volatile("s_waitcnt lgkmcnt(0)" ::: "memory");
        float gl[4];
#pragma unroll
        for (int i = 0; i < 4; ++i) gl[i] = __builtin_bit_cast(float, __builtin_amdgcn_readlane(__builtin_bit_cast(int, acc), 32 + i));
        int gi = 0; float gm = gl[0];
#pragma unroll
        for (int i = 1; i < 4; ++i) if (gl[i] > gm) { gm = gl[i]; gi = i; }
        float gs = 0.f;
#pragma unroll
        for (int i = 0; i < 4; ++i) gs += __expf(gl[i] - gm);
        const float gp = 1.f / gs;
        float ev[8];
#pragma unroll
        for (int i = 0; i < 8; ++i) ev[i] = __builtin_bit_cast(float, __builtin_amdgcn_readlane(__builtin_bit_cast(int, acc), __builtin_amdgcn_readfirstlane(gi) * 8 + i));
        int i0 = 0; float t0 = ev[0];
#pragma unroll
        for (int i = 1; i < 8; ++i) if (ev[i] > t0) { t0 = ev[i]; i0 = i; }
        int i1 = -1; float t1 = -INFINITY;
#pragma unroll
        for (int i = 0; i < 8; ++i) if (i != i0 && ev[i] > t1) { t1 = ev[i]; i1 = i; }
        const float ex = __expf(t1 - t0), w0 = gp / (1.f + ex), w1 = gp * ex / (1.f + ex);
        if (C.lane < 2) { const int e = gi * 8 + (C.lane == 0 ? i0 : i1); const unsigned pos = atomicAdd(cnt + e * CNT_STRIDE, 1u);
            rowpair[(size_t)e * CAP + pos] = 2 * t + C.lane; pairw[2 * t + C.lane] = C.lane == 0 ? w0 : w1; }
    }
}

struct ExpTab { int n[NE], hoff[NE], t0[NE + 1]; };
__device__ __forceinline__ void build_exptab(Ctx& C, int l, LAS int* tab) {
    __syncthreads();
    if (C.tid == 0) { const unsigned* cnt = (const unsigned*)(C.ws + WS_CTL) + CW_CNT + 32 * CNT_STRIDE * l; int ho = 0, tt = 0;
        for (int e = 0; e < NE; ++e) { const int n = (int)__hip_atomic_load(cnt + e * CNT_STRIDE, __ATOMIC_RELAXED, __HIP_MEMORY_SCOPE_AGENT); tab[e] = n; tab[32 + e] = ho; tab[64 + e] = tt; ho += (n + 255) & ~255; tt += (n + 63) >> 6; }
        tab[64 + NE] = tt; }
    __syncthreads();
}
__device__ __forceinline__ void phase_g1_naive(Ctx& C, KA AR, int l) {
    LAS int* tab = (LAS int*)(C.lds + 65536); build_exptab(C, l, tab);
    const bf16* xn = (const bf16*)(C.ws + WS_XN); const int* rowpair = (const int*)(C.ws + WS_ROWPAIR); bf16* Hb = (bf16*)(C.ws + WS_R2);
    const int nmt = tab[64 + NE];
    for (int u = blockIdx.x; u < nmt * 8; u += gridDim.x) {
        const int mtg = u >> 3, nt = u & 7; int e = 0;
        for (int i = 1; i < NE; ++i) if (tab[64 + i] <= mtg) e = i;
        const int mt = mtg - tab[64 + e], ne = tab[e], ho = tab[32 + e], p0 = 64 * mt, c0 = 64 * nt;
        const bf16* Bt = (const bf16*)(C.ws + WS_WGU) + (size_t)(l * NE + e) * 1024 * D; const int* rp = rowpair + (size_t)e * CAP;
        ngemm_tile<2>((LAS float*)C.lds, D,
            [=](int r) { return (p0 + r < ne) ? xn + (size_t)(rp[p0 + r] >> 1) * D : (const bf16*)nullptr; },
            [=](int c, int a) { const int cc = c0 + c; return Bt + (size_t)((cc >> 7) * 256 + (cc & 127) + a * 128) * D; },
            [=](int r, int c, float g, float uu) { if (p0 + r < ne) Hb[(size_t)(ho + p0 + r) * DE + c0 + c] = (bf16)f2bf(g / (1.f + __expf(-g)) * uu); }, C.tid);
    }
}
__device__ __forceinline__ void phase_g2_naive(Ctx& C, KA AR, int l) {
    LAS int* tab = (LAS int*)(C.lds + 65536); build_exptab(C, l, tab);
    const int* rowpair = (const int*)(C.ws + WS_ROWPAIR); const float* pairw = (const float*)(C.ws + WS_PAIRW); const bf16* Hb = (const bf16*)(C.ws + WS_R2); bf16* Y2 = (bf16*)(C.ws + WS_R1);
    const int nmt = tab[64 + NE];
    for (int u = blockIdx.x; u < nmt * 16; u += gridDim.x) {
        const int mtg = u >> 4, nt = u & 15; int e = 0;
        for (int i = 1; i < NE; ++i) if (tab[64 + i] <= mtg) e = i;
        const int mt = mtg - tab[64 + e], ne = tab[e], ho = tab[32 + e], p0 = 64 * mt, c0 = 64 * nt;
        const bf16* Bt = (const bf16*)(C.ws + WS_WDN) + (size_t)(l * NE + e) * D * DE; const int* rp = rowpair + (size_t)e * CAP;
        ngemm_tile<1>((LAS float*)C.lds, DE,
            [=](int r) { return (p0 + r < ne) ? Hb + (size_t)(ho + p0 + r) * DE : (const bf16*)nullptr; },
            [=](int c, int) { return Bt + (size_t)(c0 + c) * DE; },
            [=](int r, int c, float v, float) { if (p0 + r < ne) { const int p = rp[p0 + r]; Y2[(size_t)p * D + c0 + c] = (bf16)f2bf(v * pairw[p]); } }, C.tid);
    }
}

__device__ __forceinline__ void phase_combine(Ctx& C, KA AR, int l) {
    float* X = (float*)(C.ws + WS_X); const bf16* Y2 = (const bf16*)(C.ws + WS_R1); bf16* xn = (bf16*)(C.ws + WS_XN); const float* gain = AR->in[I_PLEN] + l * D;
    for (int t = C.gw; t < T; t += C.ngw) {
        f32x4 v[4]; load_row(X + (size_t)t * D, C.lane, v);
#pragma unroll
        for (int j = 0; j < 4; ++j) { const v2u a = *((const v2u*)(Y2 + (size_t)(2 * t) * D) + C.lane + 64 * j), b = *((const v2u*)(Y2 + (size_t)(2 * t + 1) * D) + C.lane + 64 * j);
            v[j].x += bflo(a.x) + bflo(b.x); v[j].y += bfhi(a.x) + bfhi(b.x); v[j].z += bflo(a.y) + bflo(b.y); v[j].w += bfhi(a.y) + bfhi(b.y);
            *((f32x4*)(X + (size_t)t * D) + C.lane + 64 * j) = v[j]; }
        const float rs = row_rs(v); scale_row(v, rs, gain, C.lane);
        store_row_bf16(xn + (size_t)t * D, C.lane, v);
    }
}

__device__ __forceinline__ void phase_proj_naive(Ctx& C, KA AR, int l) {
    const bf16* A = (const bf16*)(C.ws + WS_PB) + (size_t)l * T * PLE; const bf16* Bt = (const bf16*)(C.ws + WS_WPP) + (size_t)l * D * PLE; bf16* PR = (bf16*)(C.ws + WS_PROJ);
    for (int u = blockIdx.x; u < (T / 64) * (D / 64); u += gridDim.x) {
        const int m0 = 64 * (u / (D / 64)), n0 = 64 * (u % (D / 64));
        ngemm_tile<1>((LAS float*)C.lds, PLE, [=](int r) { return A + (size_t)(m0 + r) * PLE; }, [=](int c, int) { return Bt + (size_t)(n0 + c) * PLE; },
            [=](int r, int c, float v, float) { PR[(size_t)(m0 + r) * D + n0 + c] = (bf16)f2bf(v); }, C.tid);
    }
}
__device__ __forceinline__ void phase_ple_naive(Ctx& C, KA AR, int l) {
    const bf16* A = (const bf16*)(C.ws + WS_XN); const bf16* Bt = (const bf16*)(C.ws + WS_WPG) + (size_t)l * D * D; const bf16* PR = (const bf16*)(C.ws + WS_PROJ);
    const float* X = (const float*)(C.ws + WS_X); float* dst = l == DEPTH - 1 ? AR->out : (float*)(C.ws + WS_X); const float* bias = AR->in[I_BPG] + l * D;
    for (int u = blockIdx.x; u < (T / 64) * (D / 64); u += gridDim.x) {
        const int m0 = 64 * (u / (D / 64)), n0 = 64 * (u % (D / 64));
        ngemm_tile<1>((LAS float*)C.lds, D, [=](int r) { return A + (size_t)(m0 + r) * D; }, [=](int c, int) { return Bt + (size_t)(n0 + c) * D; },
            [=](int r, int c, float v, float) { const size_t i = (size_t)(m0 + r) * D + n0 + c; dst[i] = X[i] + bf2f(PR[i]) * sigmoidf_(v + bias[n0 + c]); }, C.tid);
    }
}

namespace pg8 {
typedef unsigned short bf16_t;
typedef short bf16x8 __attribute__((ext_vector_type(8)));
typedef unsigned u32x4 __attribute__((ext_vector_type(4)));
constexpr int BM = 256, BK = 64, HALF = 128, HTB = HALF * BK * 2, STAGE_BYTES = 8 * HTB, NXCD = 8, WGM = 8;
__device__ __forceinline__ int lds_byte(int r, int c) { const int st = (r >> 4) * 2 + (c >> 5), rr = r & 15, cc = c & 31, ob = rr * 64 + cc * 2; return st * 1024 + (ob ^ (((ob >> 9) & 1) << 5)); }
__device__ __forceinline__ void stage_rc(int b, int& R, int& C) { const int st = b / 1024, sb = b % 1024, swz = sb ^ (((sb >> 9) & 1) << 5); R = (st >> 1) * 16 + swz / 64; C = (st & 1) * 32 + (swz % 64) / 2; }
__device__ __forceinline__ int perm32(int rho) { const int n = rho >> 4, i = rho & 15; return 8 * (i >> 2) + 4 * n + (i & 3); }
struct Unit { int pm, pn, e, aux, mt; };
struct Gemm { const bf16_t* A; const bf16_t* Bt; int K; };
struct StaticOrder {
    int nM, nN, nwg, G, c;
    __device__ void init(int M, int N, int G_, int c_) { nM = M / BM; nN = N / BM; nwg = nM * nN; G = G_; c = c_; }
    __device__ bool next(int i, Unit& u) const {
        const long L = (long)i * G + c; if (L >= nwg) return false;
        int wgid = (int)L; { const int q = nwg / NXCD, r = nwg % NXCD, xcd = wgid % NXCD, off = wgid / NXCD; wgid = (xcd < r ? xcd * (q + 1) : r * (q + 1) + (xcd - r) * q) + off; }
        const int nig = WGM * nN, gid = wgid / nig, fm = gid * WGM, gsz = (nM - fm) < WGM ? (nM - fm) : WGM;
        u.pm = fm + ((wgid % nig) % gsz); u.pn = (wgid % nig) / gsz; u.e = 0; u.aux = 256; u.mt = 0; return true;
    }
    __device__ __forceinline__ const char* a_base(const Gemm& g, const Unit& u) const { return (const char*)g.A + (size_t)u.pm * 512 * g.K; }
    __device__ __forceinline__ const char* b_base(const Gemm& g, const Unit& u) const { return (const char*)g.Bt + (size_t)u.pn * 512 * g.K; }
    __device__ __forceinline__ int a_row(const Unit&, int) const { return 0; }
};
__device__ __forceinline__ unsigned cvt_pk_bf16(float lo, float hi) { unsigned r; asm volatile("v_cvt_pk_bf16_f32 %0, %1, %2" : "=v"(r) : "v"(lo), "v"(hi)); return r; }

template <class Epi, class Sched, bool ALIGN_EPI, bool GATHER>
__device__ __forceinline__ void gemm_phase(LAS unsigned char* lds, const Gemm g, const Sched& S, const Epi& E, const int tid) {
    const int wid = __builtin_amdgcn_readfirstlane(tid >> 6), lane = tid & 63, wr = wid >> 2, wc = wid & 3, fr = lane & 15, fq = lane >> 4;
    const int K = g.K, nt = K / BK;
    unsigned voffB[2];
#pragma unroll
    for (int i = 0; i < 2; ++i) { int R, C; stage_rc(tid * 16 + i * 8192, R, C); const int Rb = Epi::PERM ? ((R & ~31) + perm32(R & 31)) : R; voffB[i] = (unsigned)(Rb * K + C) * 2u; }
    const size_t kstep = (size_t)(BK * 2);
    const size_t hstep = (size_t)HALF * K * 2;
    const size_t hsA = GATHER ? 0 : hstep;
    const unsigned ldsw = (unsigned)wid * 1024u;
    const int aoff = lds_byte(wr * 64 + fr, fq * 8), boff = lds_byte(wc * 32 + fr, fq * 8);
#define PG8_SA(b, h) (((b) * 2 + (h)) * HTB)
#define PG8_SB(b, h) ((4 + (b) * 2 + (h)) * HTB)
#define PG8_STAGE(bufoff, gbase, voff) do { _Pragma("unroll") for (int _i = 0; _i < 2; ++_i) \
        __builtin_amdgcn_global_load_lds((const unsigned*)((const char*)(gbase) + (voff)[_i]), (LAS unsigned*)(lds + (bufoff) + ldsw + _i * 8192), 16, 0, 0); } while (0)
#define PG8_LDA(dst, b, h) do { _Pragma("unroll") for (int m = 0; m < 4; ++m) _Pragma("unroll") for (int k = 0; k < 2; ++k) dst[m][k] = *(const LAS bf16x8*)(lds + PG8_SA(b, h) + aoff + m * 2048 + k * 1024); } while (0)
#define PG8_LDB(dst, b, h) do { _Pragma("unroll") for (int n = 0; n < 2; ++n) _Pragma("unroll") for (int k = 0; k < 2; ++k) dst[n][k] = *(const LAS bf16x8*)(lds + PG8_SB(b, h) + boff + n * 2048 + k * 1024); } while (0)
#define PG8_MMA(ai, bj, At, Bt) do { __builtin_amdgcn_s_setprio(1); _Pragma("unroll") for (int m = 0; m < 4; ++m) _Pragma("unroll") for (int n = 0; n < 2; ++n) _Pragma("unroll") for (int k = 0; k < 2; ++k) \
        acc[ai][bj][m][n] = __builtin_amdgcn_mfma_f32_16x16x32_bf16(Bt[n][k], At[m][k], acc[ai][bj][m][n], 0, 0, 0); __builtin_amdgcn_s_setprio(0); } while (0)
#define PG8_WAIT_V(n) asm volatile("s_waitcnt vmcnt(" #n ")" ::: "memory")
#define PG8_WAIT_L(n) asm volatile("s_waitcnt lgkmcnt(" #n ")" ::: "memory")
#define PG8_BAR __builtin_amdgcn_s_barrier()
#define PG8_SCHED __builtin_amdgcn_sched_barrier(0)
#define PG8_VOFF(dst, u) do { int t_ = tid; if (GATHER) asm volatile("" : "+v"(t_));   \
        _Pragma("unroll") for (int i_ = 0; i_ < 2; ++i_) { int R_, C_; stage_rc(t_ * 16 + i_ * 8192, R_, C_); _Pragma("unroll") for (int h_ = 0; h_ < 2; ++h_) \
        dst[h_][i_] = GATHER ? (unsigned)(S.a_row(u, h_ * HALF + R_) * K + C_) * 2u : (unsigned)(R_ * K + C_) * 2u; } } while (0)
    Unit cur, nxt; int ui = 0;
    if (!S.next(0, cur)) return;
    f32x4 acc[2][2][4][2];
#pragma unroll
    for (int a = 0; a < 2; ++a)
#pragma unroll
        for (int b = 0; b < 2; ++b)
#pragma unroll
            for (int m = 0; m < 4; ++m)
#pragma unroll
                for (int n = 0; n < 2; ++n) acc[a][b][m][n] = (f32x4){0.f, 0.f, 0.f, 0.f};
    bf16x8 At[4][2], B0[2][2], B1[2][2];
    unsigned vC[2][2], vN[2][2], vX[2][2];
    PG8_VOFF(vC, cur);
    const char* cA = S.a_base(g, cur); const char* cB = S.b_base(g, cur);
    PG8_STAGE(PG8_SB(0, 0), cB, voffB); PG8_STAGE(PG8_SB(0, 1), cB + hstep, voffB); PG8_STAGE(PG8_SA(0, 0), cA, vC[0]); PG8_STAGE(PG8_SA(0, 1), cA + hsA, vC[1]);
    if (wr == 1) PG8_BAR;
    PG8_WAIT_V(2); PG8_BAR;
    PG8_STAGE(PG8_SB(1, 0), cB + kstep, voffB); PG8_STAGE(PG8_SA(1, 0), cA + kstep, vC[0]); PG8_STAGE(PG8_SB(1, 1), cB + hstep + kstep, voffB);
    PG8_WAIT_V(6); PG8_BAR;
    for (;;) {
        const bool has_next = S.next(ui + 1, nxt);
        const char* nA = has_next ? S.a_base(g, nxt) : cA; const char* nB = has_next ? S.b_base(g, nxt) : cB;
        if (GATHER && has_next) { PG8_VOFF(vN, nxt); }
        else {
#pragma unroll
            for (int h_ = 0; h_ < 2; ++h_)
#pragma unroll
                for (int i_ = 0; i_ < 2; ++i_) vN[h_][i_] = vC[h_][i_]; }
#pragma unroll 1
        for (int t = 0; t < nt; t += 2) {
            const bool last = (t == nt - 2);
            const char* a1 = cA + (size_t)(t + 1) * kstep;
            const char* a2 = last ? nA : cA + (size_t)(t + 2) * kstep; const char* b2 = last ? nB : cB + (size_t)(t + 2) * kstep;
            const char* a3 = a2 + kstep; const char* b3 = b2 + kstep;
#pragma unroll
            for (int h_ = 0; h_ < 2; ++h_)
#pragma unroll
                for (int i_ = 0; i_ < 2; ++i_) vX[h_][i_] = (GATHER && last) ? vN[h_][i_] : vC[h_][i_];
            PG8_LDB(B0, 0, 0); PG8_LDB(B1, 0, 1); PG8_SCHED; PG8_LDA(At, 0, 0); PG8_STAGE(PG8_SA(1, 1), a1 + hsA, vC[1]);
            PG8_WAIT_V(8); PG8_WAIT_L(0); PG8_BAR; PG8_MMA(0, 0, At, B0); PG8_MMA(0, 1, At, B1); PG8_BAR; PG8_SCHED;
            PG8_LDA(At, 0, 1); PG8_STAGE(PG8_SB(0, 0), b2, voffB); PG8_STAGE(PG8_SB(0, 1), b2 + hstep, voffB); PG8_STAGE(PG8_SA(0, 0), a2, vX[0]);
            PG8_WAIT_V(8); PG8_WAIT_L(0); PG8_BAR; PG8_MMA(1, 0, At, B0); PG8_MMA(1, 1, At, B1); PG8_BAR; PG8_SCHED;
            PG8_LDB(B0, 1, 0); PG8_LDB(B1, 1, 1); PG8_SCHED; PG8_LDA(At, 1, 0); PG8_STAGE(PG8_SA(0, 1), a2 + hsA, vX[1]);
            PG8_WAIT_V(8); PG8_WAIT_L(0); PG8_BAR; PG8_MMA(0, 0, At, B0); PG8_MMA(0, 1, At, B1); PG8_BAR; PG8_SCHED;
            PG8_LDA(At, 1, 1); PG8_STAGE(PG8_SB(1, 0), b3, voffB); PG8_STAGE(PG8_SB(1, 1), b3 + hstep, voffB); PG8_STAGE(PG8_SA(1, 0), a3, vX[0]);
            PG8_WAIT_V(8); PG8_WAIT_L(0); PG8_BAR; PG8_MMA(1, 0, At, B0); PG8_MMA(1, 1, At, B1); PG8_BAR; PG8_SCHED;
        }
        if constexpr (ALIGN_EPI) { if (wr == 0) PG8_BAR; }
        E(acc, cur, wr, wc, fr, fq);
        if (!has_next) break;
#pragma unroll
        for (int a = 0; a < 2; ++a)
#pragma unroll
            for (int b = 0; b < 2; ++b)
#pragma unroll
                for (int m = 0; m < 4; ++m)
#pragma unroll
                    for (int n = 0; n < 2; ++n) acc[a][b][m][n] = (f32x4){0.f, 0.f, 0.f, 0.f};
        cur = nxt; cA = nA; cB = nB; ++ui;
#pragma unroll
        for (int h_ = 0; h_ < 2; ++h_)
#pragma unroll
            for (int i_ = 0; i_ < 2; ++i_) vC[h_][i_] = vN[h_][i_];
        if constexpr (ALIGN_EPI) { if (wr == 1) PG8_BAR; }
    }
    PG8_WAIT_V(0);
    if constexpr (!ALIGN_EPI) { if (wr == 0) PG8_BAR; }
    PG8_BAR;
#undef PG8_SA
#undef PG8_SB
#undef PG8_STAGE
#undef PG8_LDA
#undef PG8_LDB
#undef PG8_MMA
#undef PG8_WAIT_V
#undef PG8_WAIT_L
#undef PG8_BAR
#undef PG8_SCHED
#undef PG8_VOFF
}
}

__device__ __forceinline__ float gelu_fast(float v) { const float y = 0.7978845608028654f * (v + 0.044715f * v * v * v); return v * __builtin_amdgcn_rcpf(1.f + __expf(-2.f * y)); }
__device__ __forceinline__ float sigmoid_fast(float v) { return __builtin_amdgcn_rcpf(1.f + __expf(-v)); }

struct EpiZ {
    static constexpr bool PERM = true;
    bf16* R1; const float* gq; const float* gk;
    __device__ __forceinline__ void operator()(const f32x4 (&acc)[2][2][4][2], const pg8::Unit& u, int wr, int wc, int fr, int fq) const {
        const int seg = u.pn >> 1;
        bf16* base = R1 + (size_t)seg * T * 512 + (size_t)(u.pm * 256 + wr * 64 + fr) * 512 + (u.pn & 1) * 256 + wc * 64 + 8 * fq;
        if (seg == 2 || seg == 3) {
            const float* g = seg == 2 ? gq : gk; const float sc = seg == 2 ? C2 : 1.f;
            f32x4 gv[2][2];
#pragma unroll
            for (int bj = 0; bj < 2; ++bj)
#pragma unroll
                for (int n = 0; n < 2; ++n) gv[bj][n] = *(const f32x4*)(g + 32 * bj + 8 * fq + 4 * n);
#pragma unroll
            for (int ai = 0; ai < 2; ++ai)
#pragma unroll
                for (int m = 0; m < 4; ++m) {
                    float s = 0.f;
#pragma unroll
                    for (int bj = 0; bj < 2; ++bj)
#pragma unroll
                        for (int n = 0; n < 2; ++n) { const f32x4 x = acc[ai][bj][m][n]; s += (x[0] * x[0] + x[1] * x[1]) + (x[2] * x[2] + x[3] * x[3]); }
                    s += lane_xor<16>(s); s = half_sum32(s);
                    const float rs = rsqrtf(s * (1.f / 64.f) + EPS) * sc;
#pragma unroll
                    for (int bj = 0; bj < 2; ++bj) { const f32x4 v0 = acc[ai][bj][m][0] * rs * gv[bj][0], v1 = acc[ai][bj][m][1] * rs * gv[bj][1];
                        v4u w; w.x = pg8::cvt_pk_bf16(v0[0], v0[1]); w.y = pg8::cvt_pk_bf16(v0[2], v0[3]); w.z = pg8::cvt_pk_bf16(v1[0], v1[1]); w.w = pg8::cvt_pk_bf16(v1[2], v1[3]);
                        *(v4u*)(base + (size_t)(ai * 128 + m * 16) * 512 + 32 * bj) = w; }
                }
        } else {
#pragma unroll
            for (int ai = 0; ai < 2; ++ai)
#pragma unroll
                for (int m = 0; m < 4; ++m)
#pragma unroll
                    for (int bj = 0; bj < 2; ++bj) { f32x4 v0 = acc[ai][bj][m][0], v1 = acc[ai][bj][m][1];
                        if (seg == 1) { v0 = (f32x4){gelu_fast(v0[0]), gelu_fast(v0[1]), gelu_fast(v0[2]), gelu_fast(v0[3])}; v1 = (f32x4){gelu_fast(v1[0]), gelu_fast(v1[1]), gelu_fast(v1[2]), gelu_fast(v1[3])}; }
                        v4u w; w.x = pg8::cvt_pk_bf16(v0[0], v0[1]); w.y = pg8::cvt_pk_bf16(v0[2], v0[3]); w.z = pg8::cvt_pk_bf16(v1[0], v1[1]); w.w = pg8::cvt_pk_bf16(v1[2], v1[3]);
                        *(v4u*)(base + (size_t)(ai * 128 + m * 16) * 512 + 32 * bj) = w; }
        }
    }
};
__device__ __forceinline__ void phase_gemm1_fast(Ctx& C, KA AR, int l) {
    phase_cumsum_fast(C, AR);
    pg8::Gemm g{(const bf16*)(C.ws + WS_XN), (const bf16*)(C.ws + WS_WIN) + (size_t)l * NZ * D, D};
    pg8::StaticOrder S; S.init(T, NZ, gridDim.x, blockIdx.x);
    EpiZ E{(bf16*)(C.ws + WS_R1), AR->in[I_QN] + l * HD, AR->in[I_KN] + l * HD};
    pg8::gemm_phase<EpiZ, pg8::StaticOrder, true, false>(C.lds, g, S, E, C.tid);
}
struct EpiRes {
    static constexpr bool PERM = false;
    const float* xs; float* X;
    __device__ __forceinline__ void operator()(const f32x4 (&acc)[2][2][4][2], const pg8::Unit& u, int wr, int wc, int fr, int fq) const {
        const size_t off0 = (size_t)(u.pm * 256 + wr * 64 + fr) * D + u.pn * 256 + wc * 32 + 4 * fq;
#pragma unroll
        for (int ai = 0; ai < 2; ++ai)
#pragma unroll
            for (int m = 0; m < 4; ++m)
#pragma unroll
                for (int bj = 0; bj < 2; ++bj)
#pragma unroll
                    for (int n = 0; n < 2; ++n) { const size_t o = off0 + (size_t)(ai * 128 + m * 16) * D + bj * 128 + n * 16; *(f32x4*)(X + o) = *(const f32x4*)(xs + o) + acc[ai][bj][m][n]; }
    }
};
__device__ __forceinline__ void phase_wo_fast(Ctx& C, KA AR, int l) {
    pg8::Gemm g{(const bf16*)(C.ws + WS_R2 + 16 * MiB), (const bf16*)(C.ws + WS_WOUT) + (size_t)l * D * D, D};
    pg8::StaticOrder S; S.init(T, D, gridDim.x, blockIdx.x);
    EpiRes E{l == 0 ? AR->in[I_X] : (const float*)(C.ws + WS_X), (float*)(C.ws + WS_X)};
    pg8::gemm_phase<EpiRes, pg8::StaticOrder, true, false>(C.lds, g, S, E, C.tid);
}
struct EpiProj {
    static constexpr bool PERM = true;
    bf16* PR;
    __device__ __forceinline__ void operator()(const f32x4 (&acc)[2][2][4][2], const pg8::Unit& u, int wr, int wc, int fr, int fq) const {
        bf16* base = PR + (size_t)(u.pm * 256 + wr * 64 + fr) * D + u.pn * 256 + wc * 32 + 8 * fq;
#pragma unroll
        for (int ai = 0; ai < 2; ++ai)
#pragma unroll
            for (int m = 0; m < 4; ++m)
#pragma unroll
                for (int bj = 0; bj < 2; ++bj) { const f32x4 v0 = acc[ai][bj][m][0], v1 = acc[ai][bj][m][1];
                    v4u w; w.x = pg8::cvt_pk_bf16(v0[0], v0[1]); w.y = pg8::cvt_pk_bf16(v0[2], v0[3]); w.z = pg8::cvt_pk_bf16(v1[0], v1[1]); w.w = pg8::cvt_pk_bf16(v1[2], v1[3]);
                    *(v4u*)(base + (size_t)(ai * 128 + m * 16) * D + bj * 128) = w; }
    }
};
__device__ __forceinline__ void phase_proj_fast(Ctx& C, KA AR, int l) {
    pg8::Gemm g{(const bf16*)(C.ws + WS_PB) + (size_t)l * T * PLE, (const bf16*)(C.ws + WS_WPP) + (size_t)l * D * PLE, PLE};
    pg8::StaticOrder S;
    { const int G = gridDim.x, hb = G / 2; if ((int)blockIdx.x >= hb) S.init(T, D, G - hb, (int)blockIdx.x - hb); else S.init(T, D, G - hb, T); }
    EpiProj E{(bf16*)(C.ws + WS_PROJ)};
    pg8::gemm_phase<EpiProj, pg8::StaticOrder, true, false>(C.lds, g, S, E, C.tid);
}
struct EpiPle {
    static constexpr bool PERM = false;
    const float* X; const bf16* PR; const float* bias; float* dst; float pscale;
    __device__ __forceinline__ void operator()(const f32x4 (&acc)[2][2][4][2], const pg8::Unit& u, int wr, int wc, int fr, int fq) const {
        const int col0 = u.pn * 256 + wc * 32 + 4 * fq;
        const size_t off0 = (size_t)(u.pm * 256 + wr * 64 + fr) * D + col0;
#pragma unroll
        for (int bj = 0; bj < 2; ++bj)
#pragma unroll
            for (int n = 0; n < 2; ++n) { const f32x4 bv = *(const f32x4*)(bias + col0 + bj * 128 + n * 16);
#pragma unroll
                for (int ai = 0; ai < 2; ++ai)
#pragma unroll
                    for (int m = 0; m < 4; ++m) { const size_t o = off0 + (size_t)(ai * 128 + m * 16) * D + bj * 128 + n * 16;
                        const v2u pw = *(const v2u*)(PR + o); const f32x4 a = acc[ai][bj][m][n] + bv; const f32x4 x = *(const f32x4*)(X + o);
                        f32x4 r; r[0] = x[0] + bflo(pw.x) * sigmoid_fast(a[0]); r[1] = x[1] + bfhi(pw.x) * sigmoid_fast(a[1]); r[2] = x[2] + bflo(pw.y) * sigmoid_fast(a[2]); r[3] = x[3] + bfhi(pw.y) * sigmoid_fast(a[3]);
                        if (PROBE_TIMING) r = r * pscale;
                        *(f32x4*)(dst + o) = r; } }
    }
};
__device__ __forceinline__ void phase_ple_fast(Ctx& C, KA AR, int l) {
    pg8::Gemm g{(const bf16*)(C.ws + WS_XN), (const bf16*)(C.ws + WS_WPG) + (size_t)l * D * D, D};
    pg8::StaticOrder S; S.init(T, D, gridDim.x, blockIdx.x);
    float pscale = 1.f;
    if (PROBE_TIMING && l == DEPTH - 1) { const unsigned long long* ts = (const unsigned long long*)((const unsigned*)(C.ws + WS_CTL) + CW_TS); pscale = 1.f + (float)(ts[PROBE_HI] - ts[PROBE_LO]) * 1.5e-6f; }
    EpiPle E{(const float*)(C.ws + WS_X), (const bf16*)(C.ws + WS_PROJ), AR->in[I_BPG] + l * D, l == DEPTH - 1 ? AR->out : (float*)(C.ws + WS_X), pscale};
    pg8::gemm_phase<EpiPle, pg8::StaticOrder, true, false>(C.lds, g, S, E, C.tid);
}
constexpr int TAB_OFF = MISC_OFF - 4096;
struct GroupOrder {
    const LAS int* tab; int G, c; const int* rowpair; const char* hbase; bool is_g2;
    __device__ bool next(int i, pg8::Unit& u) const {
        int j = i * (G >> 3) + (c >> 3);
#pragma unroll
        for (int q = 0; q < 4; ++q) { const int e = (c & 7) + 8 * q;
            const int t0 = __builtin_amdgcn_readfirstlane(tab[64 + e]), t1 = __builtin_amdgcn_readfirstlane(tab[64 + e + 1]), nu = (t1 - t0) * 4;
            if (j < nu) { const int mt = j >> 2; const int ne = __builtin_amdgcn_readfirstlane(tab[e]), ho = __builtin_amdgcn_readfirstlane(tab[32 + e]);
                int nv = ne - 256 * mt; nv = nv > 256 ? 256 : nv;
                u.pm = ho + 256 * mt; u.pn = j & 3; u.e = e; u.aux = nv; u.mt = mt; return true; }
            j -= nu; }
        return false;
    }
    __device__ __forceinline__ const char* a_base(const pg8::Gemm& g, const pg8::Unit& u) const { return is_g2 ? (const char*)g.A + (size_t)u.pm * 2 * g.K : (const char*)g.A; }
    __device__ __forceinline__ const char* b_base(const pg8::Gemm& g, const pg8::Unit& u) const { return (const char*)g.Bt + (size_t)(u.e * 1024 + u.pn * 256) * 2 * g.K; }
    __device__ __forceinline__ int a_row(const pg8::Unit& u, int r) const { return r < u.aux ? (rowpair[(size_t)u.e * CAP + u.mt * 256 + r] >> 1) : 0; }
};
__device__ __forceinline__ void build_exptab256(Ctx& C, int l, LAS int* tab) {
    __syncthreads();
    if (C.tid == 0) { const unsigned* cnt = (const unsigned*)(C.ws + WS_CTL) + CW_CNT + 32 * CNT_STRIDE * l; int ho = 0, tt = 0;
        for (int e = 0; e < NE; ++e) { const int n = (int)__hip_atomic_load(cnt + e * CNT_STRIDE, __ATOMIC_RELAXED, __HIP_MEMORY_SCOPE_AGENT); tab[e] = n; tab[32 + e] = ho; tab[64 + e] = tt;
            const int nt = (n + 255) >> 8; for (int j = 0; j < nt; ++j) tab[128 + tt + j] = e | (j << 8); ho += nt << 8; tt += nt; }
        tab[64 + NE] = tt; }
    __syncthreads();
}
struct EpiG1 {
    static constexpr bool PERM = true;
    bf16* Hb;
    __device__ __forceinline__ void operator()(const f32x4 (&acc)[2][2][4][2], const pg8::Unit& u, int wr, int wc, int fr, int fq) const {
        bf16* base = Hb + (size_t)(u.pm + wr * 64 + fr) * DE + u.pn * 128 + wc * 32 + 8 * fq;
#pragma unroll
        for (int ai = 0; ai < 2; ++ai)
#pragma unroll
            for (int m = 0; m < 4; ++m) { const int rl = ai * 128 + wr * 64 + m * 16 + fr;
                f32x4 h0, h1;
#pragma unroll
                for (int e = 0; e < 4; ++e) { const float g0 = acc[ai][0][m][0][e], g1 = acc[ai][0][m][1][e]; h0[e] = g0 * sigmoid_fast(g0) * acc[ai][1][m][0][e]; h1[e] = g1 * sigmoid_fast(g1) * acc[ai][1][m][1][e]; }
                v4u w; w.x = pg8::cvt_pk_bf16(h0[0], h0[1]); w.y = pg8::cvt_pk_bf16(h0[2], h0[3]); w.z = pg8::cvt_pk_bf16(h1[0], h1[1]); w.w = pg8::cvt_pk_bf16(h1[2], h1[3]);
                if (rl < u.aux) *(v4u*)(base + (size_t)(ai * 128 + m * 16) * DE) = w; }
    }
};
__device__ __forceinline__ void phase_g1_fast(Ctx& C, KA AR, int l) {
    LAS int* tab = (LAS int*)(C.lds + TAB_OFF); build_exptab256(C, l, tab);
    pg8::Gemm g{(const bf16*)(C.ws + WS_XN), (const bf16*)(C.ws + WS_WGU) + (size_t)l * NE * 1024 * D, D};
    GroupOrder S{tab, (int)gridDim.x, (int)blockIdx.x, (const int*)(C.ws + WS_ROWPAIR), nullptr, false};
    EpiG1 E{(bf16*)(C.ws + WS_R2)};
    pg8::gemm_phase<EpiG1, GroupOrder, true, true>(C.lds, g, S, E, C.tid);
}
struct EpiG2 {
    static constexpr bool PERM = true;
    bf16* Y2; const int* rowpair; const float* pairw;
    __device__ __forceinline__ void operator()(const f32x4 (&acc)[2][2][4][2], const pg8::Unit& u, int wr, int wc, int fr, int fq) const {
        const int* rp = rowpair + (size_t)u.e * CAP + u.mt * 256; const int col0 = u.pn * 256 + wc * 32 + 8 * fq;
#pragma unroll
        for (int ai = 0; ai < 2; ++ai)
#pragma unroll
            for (int m = 0; m < 4; ++m) { const int rl = ai * 128 + wr * 64 + m * 16 + fr;
                if (rl < u.aux) { const int p = rp[rl]; const float w8 = pairw[p]; bf16* row = Y2 + (size_t)p * D + col0;
#pragma unroll
                    for (int bj = 0; bj < 2; ++bj) { const f32x4 v0 = acc[ai][bj][m][0] * w8, v1 = acc[ai][bj][m][1] * w8;
                        v4u w; w.x = pg8::cvt_pk_bf16(v0[0], v0[1]); w.y = pg8::cvt_pk_bf16(v0[2], v0[3]); w.z = pg8::cvt_pk_bf16(v1[0], v1[1]); w.w = pg8::cvt_pk_bf16(v1[2], v1[3]);
                        *(v4u*)(row + bj * 128) = w; } } }
    }
};
__device__ __forceinline__ void phase_g2_fast(Ctx& C, KA AR, int l) {
    LAS int* tab = (LAS int*)(C.lds + TAB_OFF); build_exptab256(C, l, tab);
    pg8::Gemm g{(const bf16*)(C.ws + WS_R2), (const bf16*)(C.ws + WS_WDN) + (size_t)l * NE * D * DE, DE};
    GroupOrder S{tab, (int)gridDim.x, (int)blockIdx.x, (const int*)(C.ws + WS_ROWPAIR), nullptr, true};
    EpiG2 E{(bf16*)(C.ws + WS_R1), (const int*)(C.ws + WS_ROWPAIR), (const float*)(C.ws + WS_PAIRW)};
    pg8::gemm_phase<EpiG2, GroupOrder, true, false>(C.lds, g, S, E, C.tid);
}

#define SBAR() __builtin_amdgcn_sched_barrier(0)
namespace attn_body {
using bf16=__hip_bfloat16;
using bf16x8=__attribute__((ext_vector_type(8)))short;
using s16x4=__attribute__((ext_vector_type(4)))short;
using f32x16=__attribute__((ext_vector_type(16)))float;
using u32x4=__attribute__((ext_vector_type(4)))unsigned;
constexpr int BATCH=4,NHEAD=8,SEQ=4096,D=64,DM=NHEAD*D;
constexpr int NW=8,QBLK=32,QB=QBLK*NW,KVBLK=64,NQB=SEQ/QB;
constexpr int ATTN_PITCH=DM, ATTN_UNIT_ROWS=QB;
__device__ __forceinline__ int crow(int r,int hi){return (r&3)+8*(r>>2)+4*hi;}
#define SBAR() __builtin_amdgcn_sched_barrier(0)
__device__ __forceinline__ void cmask(f32x16&p0,f32x16&p1,int jb,int qrel,int hi){
  const float NEG=-INFINITY; int kb=64*jb+4*hi;
  #pragma unroll
  for(int r=0;r<16;++r){int kv=kb+(r&3)+8*(r>>2); if(kv>qrel)p0[r]=NEG; if(kv+32>qrel)p1[r]=NEG;}
}

constexpr int NSLOT=3, SLOTB=8192;
constexpr int LDS_K=0, LDS_V=NSLOT*SLOTB, LDS_WS=2*NSLOT*SLOTB, LDS_OST=LDS_WS+NW*64*4, LDS_CK=LDS_OST+NW*4096, LDS_BYTES=LDS_CK+SEQ*4;
constexpr float C2=0.125f*1.4426950408889634f;
__device__ __forceinline__ void glds16(const void*gsrc,unsigned lds_dst){unsigned keep;
  asm volatile("s_mov_b32 %0, m0\n\ts_mov_b32 m0, %2\n\ts_nop 0\n\tglobal_load_lds_dwordx4 %1, off\n\ts_mov_b32 m0, %0":"=&s"(keep):"v"(gsrc),"s"(lds_dst):"memory");}
__device__ __forceinline__ float max3f(float a,float b,float c){float r;asm("v_max3_f32 %0, %1, %2, %3":"=v"(r):"v"(a),"v"(b),"v"(c));return r;}
__device__ __forceinline__ float max2f(float a,float b){float r;asm("v_max_f32_e32 %0, %1, %2":"=v"(r):"v"(a),"v"(b));return r;}
__device__ __forceinline__ float fadd_s(float a,float b){float r;asm("v_add_f32_e32 %0, %1, %2":"=v"(r):"v"(a),"v"(b));return r;}
__device__ __forceinline__ float fsub_s(float a,float b){float r;asm("v_sub_f32_e32 %0, %1, %2":"=v"(r):"v"(a),"v"(b));return r;}
typedef float f32x2_t __attribute__((ext_vector_type(2))); typedef __bf16 bf16x2_t __attribute__((ext_vector_type(2)));
__device__ __forceinline__ unsigned cvtpk_s(float lo,float hi){f32x2_t v={lo,hi};bf16x2_t b=__builtin_convertvector(v,bf16x2_t);return __builtin_bit_cast(unsigned,b);}
#define WAIT_BAR(N) asm volatile("s_waitcnt vmcnt(" #N ") lgkmcnt(0)\n\ts_barrier":::"memory")

__device__ __forceinline__ void qkt(f32x16&p0,f32x16&p1,const char*Kslot,const bf16x8*qr,const f32x16&negm,int r32,int hi){
  const char*kb=Kslot+hi*1024+r32*16;
  #pragma unroll
  for(int d0=0;d0<4;++d0){
    const bf16x8 b0=*reinterpret_cast<const bf16x8*>(kb+d0*2048);
    const bf16x8 b1=*reinterpret_cast<const bf16x8*>(kb+d0*2048+512);
    if(d0==0){p0=__builtin_amdgcn_mfma_f32_32x32x16_bf16(b0,qr[0],negm,0,0,0);p1=__builtin_amdgcn_mfma_f32_32x32x16_bf16(b1,qr[0],negm,0,0,0);}
    else{p0=__builtin_amdgcn_mfma_f32_32x32x16_bf16(b0,qr[d0],p0,0,0,0);p1=__builtin_amdgcn_mfma_f32_32x32x16_bf16(b1,qr[d0],p1,0,0,0);}}
}
typedef __attribute__((address_space(3))) const char* lds_cptr;
typedef short v4i16_t __attribute__((ext_vector_type(4)));
__device__ __forceinline__ void kload8(bf16x8*kf,lds_cptr kp){
  kf[0]=*(const __attribute__((address_space(3))) bf16x8*)(kp);      kf[1]=*(const __attribute__((address_space(3))) bf16x8*)(kp+512);
  kf[2]=*(const __attribute__((address_space(3))) bf16x8*)(kp+2048); kf[3]=*(const __attribute__((address_space(3))) bf16x8*)(kp+2560);
  kf[4]=*(const __attribute__((address_space(3))) bf16x8*)(kp+4096); kf[5]=*(const __attribute__((address_space(3))) bf16x8*)(kp+4608);
  kf[6]=*(const __attribute__((address_space(3))) bf16x8*)(kp+6144); kf[7]=*(const __attribute__((address_space(3))) bf16x8*)(kp+6656);
}
__device__ __forceinline__ void kload2(bf16x8*kf,lds_cptr kp,int j){ kf[2*j]=*(const __attribute__((address_space(3))) bf16x8*)(kp+j*2048); kf[2*j+1]=*(const __attribute__((address_space(3))) bf16x8*)(kp+j*2048+512); }
__device__ __forceinline__ s16x4 vtr(lds_cptr p){ return __builtin_bit_cast(s16x4,__builtin_amdgcn_ds_read_tr16_b64_v4i16((__attribute__((address_space(3))) v4i16_t*)p)); }
__device__ __forceinline__ float rowmax(const f32x16&p0,const f32x16&p1){
  float a=max3f(p0[0],p0[1],p1[0]),b=max3f(p0[2],p0[3],p1[1]);a=max3f(a,p1[2],p1[3]);
  #pragma unroll
  for(int r=4;r<16;r+=4){a=max3f(a,p0[r],p0[r+1]);b=max3f(b,p0[r+2],p0[r+3]);a=max3f(a,p1[r],p1[r+1]);b=max3f(b,p1[r+2],p1[r+3]);}
  const float m=max2f(a,b);
  auto rr=__builtin_amdgcn_permlane32_swap(__float_as_uint(m),__float_as_uint(m),false,false);
  return max2f(__uint_as_float(rr[0]),__uint_as_float(rr[1]));
}
__device__ __forceinline__ void pv(f32x16*o,int vb,bf16x8 pa0,bf16x8 pa1,bf16x8 pa2,bf16x8 pa3){
  #pragma unroll
  for(int d0=0;d0<2;++d0){s16x4 lo[4],hi[4];
    #pragma unroll
    for(int ks=0;ks<4;++ks){
      asm volatile("ds_read_b64_tr_b16 %0,%1 offset:%c2":"=&v"(lo[ks]):"v"(vb),"i"(d0*4096+ks*1024):"memory");
      asm volatile("ds_read_b64_tr_b16 %0,%1 offset:%c2":"=&v"(hi[ks]):"v"(vb),"i"(d0*4096+ks*1024+512):"memory");}
    asm volatile("s_waitcnt lgkmcnt(0)":::"memory");SBAR();
    #define PK(k) (bf16x8){lo[k][0],lo[k][1],lo[k][2],lo[k][3],hi[k][0],hi[k][1],hi[k][2],hi[k][3]}
    o[d0]=__builtin_amdgcn_mfma_f32_32x32x16_bf16(pa0,PK(0),o[d0],0,0,0);
    o[d0]=__builtin_amdgcn_mfma_f32_32x32x16_bf16(pa1,PK(1),o[d0],0,0,0);
    o[d0]=__builtin_amdgcn_mfma_f32_32x32x16_bf16(pa2,PK(2),o[d0],0,0,0);
    o[d0]=__builtin_amdgcn_mfma_f32_32x32x16_bf16(pa3,PK(3),o[d0],0,0,0);
    #undef PK
  }
}

#ifndef ATTN_STORE16
#define ATTN_STORE16(p,v) (*(u32x4*)(p)=(v))
#endif
template<int THRL> __device__ __forceinline__ void attn_unit(int b,int h,int qb,const bf16*Q,const bf16*__restrict__ K,const bf16*__restrict__ V,bf16*O,const float*__restrict__ C2K,const float thr2,char*shm,const int tid){
  const int lane=tid&63,r32=lane&31,hi=lane>>5; const int wid=__builtin_amdgcn_readfirstlane(tid>>6);
  const long rowbase=(long)b*SEQ; const int q0=qb*QB;
  const bf16*Qw=Q+(rowbase+q0+wid*QBLK)*DM+h*D;
  const int NT0=(q0+QB)/KVBLK;
  const float*ckg0=C2K+(long)(b*NHEAD+h)*SEQ; float base=ckg0[q0+(tid>>6)*QBLK+r32];
  int ts; { const float cl=lane<NT0?ckg0[KVBLK*lane+KVBLK-1]:ckg0[q0]; const unsigned long long mk=__builtin_amdgcn_ballot_w64(lane<NT0&&(ckg0[q0]-cl>=-thr2));
    ts=mk?(int)__builtin_ctzll(mk):NT0-4; ts&=~1; ts=ts>NT0-4?NT0-4:ts; ts=__builtin_amdgcn_readfirstlane(ts); }
  const int NT=NT0-ts;
  const bf16*Kh=K+(rowbase+(long)ts*KVBLK)*DM+h*D,*Vh=V+(rowbase+(long)ts*KVBLK)*DM+h*D; const float*ckg=ckg0+ts*KVBLK;
  typedef __attribute__((address_space(3))) float lds_f32; typedef float f32x4_t __attribute__((ext_vector_type(4)));
  lds_f32*const nbl=(lds_f32*)((__attribute__((address_space(3))) char*)shm+LDS_CK);
  for(int i=tid;i<NT*KVBLK;i+=NW*64)nbl[i]=-ckg[i];
  const unsigned lds0=(unsigned)(uintptr_t)shm;
  float*wsf=(float*)(shm+LDS_WS)+wid*64;
  const bf16*ksrc=Kh+(long)lane*DM+wid*8;
  const bf16*vsrc=Vh+(long)(16*(wid&3)+(lane>>2))*DM+(wid>>2)*32+(lane&3)*8;
  const unsigned kdst=lds0+LDS_K+wid*1024, vdst=lds0+LDS_V+wid*1024;
  #define DMA_K(t,slot) glds16(ksrc+(long)(t)*KVBLK*DM,(unsigned)__builtin_amdgcn_readfirstlane(kdst+(slot)))
  #define DMA_V(t,slot) glds16(vsrc+(long)(t)*KVBLK*DM,(unsigned)__builtin_amdgcn_readfirstlane(vdst+(slot)))
  const int vb0=(int)(lds0+LDS_V)+((lane>>4)&1)*32+(lane&3)*8+(4*hi+((lane&15)>>2))*64;
  const char*Kbase=shm+LDS_K; bf16x8 kf[8];
  const lds_cptr shm3=(lds_cptr)shm; const lds_cptr kp0=shm3+LDS_K+hi*1024+r32*16; const lds_cptr vp0=shm3+LDS_V+((lane>>4)&1)*32+(lane&3)*8+(4*hi+((lane&15)>>2))*64;
  DMA_K(0,0);DMA_V(0,0);DMA_K(1,SLOTB);
  bf16x8 qr[4];
  #pragma unroll
  for(int d0=0;d0<4;++d0)qr[d0]=*reinterpret_cast<const bf16x8*>(&Qw[(long)r32*DM+d0*16+hi*8]);
  float l_reg=0.f;f32x16 o[2];o[0]=f32x16{};o[1]=f32x16{};const f32x16 negm=f32x16{};
  const int qrel=wid*QBLK+r32;
  #define CMASK(P0,P1,t) do{int jb_=(t)-(NT-4); if(jb_>=0)cmask(P0,P1,jb_,qrel,hi);}while(0)
  #define KBIAS(P0,P1,t) do{ const lds_f32*nb_=nbl+64*(t)+4*hi; _Pragma("unroll") for(int g_=0;g_<4;++g_){ \
    { const f32x4_t b0_=*(const __attribute__((address_space(3))) f32x4_t*)(nb_+8*g_); _Pragma("unroll") for(int j_=0;j_<4;++j_)P0[4*g_+j_]+=(b0_[j_]+base); } SBAR(); \
    { const f32x4_t b1_=*(const __attribute__((address_space(3))) f32x4_t*)(nb_+32+8*g_); _Pragma("unroll") for(int j_=0;j_<4;++j_)P1[4*g_+j_]+=(b1_[j_]+base); } SBAR(); } }while(0)
  bool resc=false;
  #define START(P0,P1) do{ const float rm=rowmax(P0,P1); resc=false; \
    { const float dl=rm; base=fsub_s(base,dl); \
      _Pragma("unroll") for(int r=0;r<16;++r){P0[r]=fsub_s(P0[r],dl);P1[r]=fsub_s(P1[r],dl);} \
      } \
    _Pragma("unroll") for(int r=0;r<16;++r)P0[r]=__builtin_amdgcn_exp2f(P0[r]); }while(0)
  #define RESC() do{ if(resc){ asm volatile("s_waitcnt lgkmcnt(0)":::"memory"); \
      _Pragma("unroll") for(int d_=0;d_<2;++d_) _Pragma("unroll") for(int r=0;r<16;++r)o[d_][r]*=wsf[crow(r,hi)]; } }while(0)
  f32x16 pA0,pA1,pB0,pB1;
  int sl_prev=0,sl_cur=0,sl_next=SLOTB;
  #define ROT() do{sl_prev=sl_cur;sl_cur=sl_next;sl_next=(sl_next==(NSLOT-1)*SLOTB)?0:sl_next+SLOTB;}while(0)
  DMA_K(2,2*SLOTB);
  WAIT_BAR(3);
  qkt(pA0,pA1,Kbase,qr,negm,r32,hi);asm volatile("s_nop 15\n\ts_nop 7":"+v"(pA0),"+v"(pA1));KBIAS(pA0,pA1,0);CMASK(pA0,pA1,0);
  START(pA0,pA1);
  _Pragma("unroll") for(int r=0;r<16;++r)pA1[r]=__builtin_amdgcn_exp2f(pA1[r]);
  WAIT_BAR(0);
  DMA_K(3,0);DMA_V(1,SLOTB);
  ROT();
  kload8(kf,kp0+sl_cur);
  WAIT_BAR(2);
  s16x4 vlo[8],vhi[8]; u32x4 pw0,pw1,pw2,pw3;
  #define PKW(P,B) cvtpk_s(P[B],P[B+1])
  #define PAF(k) __builtin_bit_cast(bf16x8,pw##k)
  #define VFR(i) (bf16x8){vlo[i][0],vlo[i][1],vlo[i][2],vlo[i][3],vhi[i][0],vhi[i][1],vhi[i][2],vhi[i][3]}
  #define PIN(x) asm volatile("":"+v"(x))
  #define MX3(a,b,c) __builtin_fmaxf(__builtin_fmaxf((a),(b)),(c))
  #define GAPA(MF,A0,A1,A2,A3,W0,W1,PW) do{ MF; sacc+=A0; sacc+=A1; sacc+=A2; sacc+=A3; PIN(sacc); W0; W1; PIN(PW); SBAR(); }while(0)
  #define EX(v) __builtin_amdgcn_exp2f(v)
  #define GAPB(MF,X,B) do{ MF; X[B]=EX(X[B]); X[B+1]=EX(X[B+1]); X[B+2]=EX(X[B+2]); X[B+3]=EX(X[B+3]); PIN(X); SBAR(); }while(0)
  #define VRD(i) do{ vlo[i]=vtr(vp_+(((i)>>2)*4096+((i)&3)*1024)); vhi[i]=vtr(vp_+(((i)>>2)*4096+((i)&3)*1024+512)); }while(0)
  #define KRD(G,j) do{ if(G){ kload2(kf,kp0+sl_next,j); SBAR(); } }while(0)
  #define STEP(C0,C1,P0,P1,t,GK,GV,GL) do{ SBAR(); \
    const lds_cptr vp_=vp0+sl_prev; \
    VRD(0); SBAR(); float sacc=(P0[0]+P0[1]); \
    GAPA(C0=__builtin_amdgcn_mfma_f32_32x32x16_bf16(kf[0],qr[0],negm,0,0,0), P0[2],P0[3],P0[4],P0[5],     pw0[0]=PKW(P0,0), pw0[1]=PKW(P0,2), pw0); \
    VRD(4); SBAR(); GAPA(C1=__builtin_amdgcn_mfma_f32_32x32x16_bf16(kf[1],qr[0],negm,0,0,0), P0[6],P0[7],P0[8],P0[9],     pw0[2]=PKW(P0,4), pw0[3]=PKW(P0,6), pw0); \
    VRD(1); SBAR(); GAPA(C0=__builtin_amdgcn_mfma_f32_32x32x16_bf16(kf[2],qr[1],C0,0,0,0),   P0[10],P0[11],P0[12],P0[13], pw1[0]=PKW(P0,8), pw1[1]=PKW(P0,10), pw1); \
    VRD(5); SBAR(); GAPA(C1=__builtin_amdgcn_mfma_f32_32x32x16_bf16(kf[3],qr[1],C1,0,0,0),   P0[14],P0[15],P1[0],P1[1],   pw1[2]=PKW(P0,12),pw1[3]=PKW(P0,14), pw1); \
    VRD(2); SBAR(); GAPA(C0=__builtin_amdgcn_mfma_f32_32x32x16_bf16(kf[4],qr[2],C0,0,0,0),   P1[2],P1[3],P1[4],P1[5],     pw2[0]=PKW(P1,0), pw2[1]=PKW(P1,2), pw2); \
    VRD(6); SBAR(); GAPA(C1=__builtin_amdgcn_mfma_f32_32x32x16_bf16(kf[5],qr[2],C1,0,0,0),   P1[6],P1[7],P1[8],P1[9],     pw2[2]=PKW(P1,4), pw2[3]=PKW(P1,6), pw2); \
    VRD(3); SBAR(); GAPA(C0=__builtin_amdgcn_mfma_f32_32x32x16_bf16(kf[6],qr[3],C0,0,0,0),   P1[10],P1[11],P1[12],P1[13], pw3[0]=PKW(P1,8), pw3[1]=PKW(P1,10), pw3); \
    VRD(7); SBAR(); GAPA(C1=__builtin_amdgcn_mfma_f32_32x32x16_bf16(kf[7],qr[3],C1,0,0,0),   P1[14],P1[15],0.f,0.f,       pw3[2]=PKW(P1,12),pw3[3]=PKW(P1,14), pw3); \
    l_reg+=sacc; \
    if(GK){DMA_K((t)+3,sl_cur);} if(GV){DMA_V((t)+1,sl_next);} \
    KBIAS(C0,C1,t); \
    CMASK(C0,C1,t); \
    { float a=MX3(C0[0],C0[1],C1[0]),b=MX3(C0[2],C0[3],C1[1]); a=MX3(a,C1[2],C1[3]); \
      _Pragma("unroll") for(int r=4;r<16;r+=4){a=MX3(a,C0[r],C0[r+1]);b=MX3(b,C0[r+2],C0[r+3]);a=MX3(a,C1[r],C1[r+1]);b=MX3(b,C1[r+2],C1[r+3]);} \
      float rm=__builtin_fmaxf(a,b); { auto rr=__builtin_amdgcn_permlane32_swap(__float_as_uint(rm),__float_as_uint(rm),false,false); rm=__builtin_fmaxf(__uint_as_float(rr[0]),__uint_as_float(rr[1])); } \
      resc=false; \
      if(__builtin_expect(__any(rm>(float)THRL),0)){ const float dl=__builtin_fmaxf(rm,0.f); base-=dl; \
        _Pragma("unroll") for(int r=0;r<16;++r){C0[r]-=dl;C1[r]-=dl;} \
        const float f=__builtin_amdgcn_exp2f(-dl); l_reg*=f; if(hi==0)wsf[r32]=f; resc=true; } } \
    SBAR(); \
    GAPB(o[0]=__builtin_amdgcn_mfma_f32_32x32x16_bf16(PAF(0),VFR(0),o[0],0,0,0), C0,0); \
    GAPB(o[1]=__builtin_amdgcn_mfma_f32_32x32x16_bf16(PAF(0),VFR(4),o[1],0,0,0), C0,4); \
    KRD(GL,0); GAPB(o[0]=__builtin_amdgcn_mfma_f32_32x32x16_bf16(PAF(1),VFR(1),o[0],0,0,0), C0,8); \
    KRD(GL,1); GAPB(o[1]=__builtin_amdgcn_mfma_f32_32x32x16_bf16(PAF(1),VFR(5),o[1],0,0,0), C0,12); \
    KRD(GL,2); GAPB(o[0]=__builtin_amdgcn_mfma_f32_32x32x16_bf16(PAF(2),VFR(2),o[0],0,0,0), C1,0); \
    KRD(GL,3); GAPB(o[1]=__builtin_amdgcn_mfma_f32_32x32x16_bf16(PAF(2),VFR(6),o[1],0,0,0), C1,4); \
    GAPB(o[0]=__builtin_amdgcn_mfma_f32_32x32x16_bf16(PAF(3),VFR(3),o[0],0,0,0), C1,8); \
    GAPB(o[1]=__builtin_amdgcn_mfma_f32_32x32x16_bf16(PAF(3),VFR(7),o[1],0,0,0), C1,12); \
    }while(0)
  int t=1;
  #undef CMASK
  #define CMASK(P0,P1,t) do{}while(0)
  for(;t+5<NT;t+=2){
    STEP(pB0,pB1,pA0,pA1,t,true,true,true);     WAIT_BAR(2); RESC(); ROT();
    STEP(pA0,pA1,pB0,pB1,t+1,true,true,true);   WAIT_BAR(2); RESC(); ROT();
  }
  #undef CMASK
  #define CMASK(P0,P1,t) do{int jb_=(t)-(NT-4); if(jb_>=0)cmask(P0,P1,jb_,qrel,hi);}while(0)
  #define ENDW(tt) do{ if((tt)+3<NT){WAIT_BAR(2);} else if((tt)+2<NT){WAIT_BAR(1);} else {WAIT_BAR(0);} }while(0)
  for(;t+1<NT;t+=2){
    STEP(pB0,pB1,pA0,pA1,t,(t+3<NT),(t+1<NT),(t+1<NT));       ENDW(t);   RESC(); ROT();
    STEP(pA0,pA1,pB0,pB1,t+1,(t+4<NT),(t+2<NT),(t+2<NT));     ENDW(t+1); RESC(); ROT();
  }
  STEP(pB0,pB1,pA0,pA1,NT-1,false,false,false); RESC();
  { float sacc=pB0[0]+pB0[1]; _Pragma("unroll") for(int r=2;r<16;++r)sacc+=pB0[r]; _Pragma("unroll") for(int r=0;r<16;++r)sacc+=pB1[r]; l_reg+=sacc;
    pw0=(u32x4){PKW(pB0,0),PKW(pB0,2),PKW(pB0,4),PKW(pB0,6)};pw1=(u32x4){PKW(pB0,8),PKW(pB0,10),PKW(pB0,12),PKW(pB0,14)};pw2=(u32x4){PKW(pB1,0),PKW(pB1,2),PKW(pB1,4),PKW(pB1,6)};pw3=(u32x4){PKW(pB1,8),PKW(pB1,10),PKW(pB1,12),PKW(pB1,14)};
    SBAR(); pv(o,vb0+sl_cur,PAF(0),PAF(1),PAF(2),PAF(3)); }
  #undef PKW
  #undef PAF
  #undef VFR
  #undef PIN
  #undef MX3
  #undef GAPA
  #undef GAPB
  #undef EX
  #undef VRD
  #undef KRD
  #undef STEP
  #undef ENDW
  {auto rr=__builtin_amdgcn_permlane32_swap(__float_as_uint(l_reg),__float_as_uint(l_reg),false,false);l_reg=__uint_as_float(rr[0])+__uint_as_float(rr[1]);}
  if(hi==0)wsf[32+r32]=l_reg;asm volatile("s_waitcnt lgkmcnt(0)":::"memory");
  float rli[16];
  #pragma unroll
  for(int r=0;r<16;++r)rli[r]=__builtin_amdgcn_rcpf(wsf[32+crow(r,hi)]);
  bf16*Ow=O+(rowbase+q0+wid*QBLK)*DM+h*D;
  { bf16*stg=(bf16*)(shm+LDS_OST)+wid*2048;
    #pragma unroll
    for(int r=0;r<16;++r){const int orow=crow(r,hi);
      #pragma unroll
      for(int d0=0;d0<2;++d0)stg[orow*64+d0*32+r32]=__float2bfloat16(o[d0][r]*rli[r]);}
    asm volatile("s_waitcnt lgkmcnt(0)":::"memory");
    #pragma unroll
    for(int i=0;i<4;++i){const int row=i*8+(lane>>3),ch=lane&7; const u32x4 v=*(const u32x4*)(stg+row*64+ch*8); ATTN_STORE16(Ow+(long)row*DM+ch*8,v);} }
  asm volatile("s_waitcnt lgkmcnt(0)\n\ts_barrier":::"memory");
  #undef DMA_K
  #undef DMA_V
  #undef CMASK
  #undef KBIAS
  #undef START
  #undef RESC
  #undef ROT
}
constexpr int ATTN_LDS_BYTES=LDS_BYTES;
struct AttnTensors { const bf16* Q; const bf16* K; const bf16* V; bf16* O; const float* C2K; float thr2; };
struct AttnUnit { int bh; int qb; };
struct StaticOrder {
  int vcu;
  __device__ __forceinline__ explicit StaticOrder(int grid,int block):vcu((block%8)*(grid/8)+block/8){}
  __device__ __forceinline__ bool next(int i,AttnUnit&u)const{ if(i>=2||vcu>=256)return false; const int s=vcu&7; u.bh=vcu>>3; u.qb=(i==0)?s:15-s; return true; }
  __device__ __forceinline__ void a_ready(const AttnUnit&)const{}
  __device__ __forceinline__ void done(const AttnUnit&)const{}
};
template<class Sched,int THRL=8> __device__ __forceinline__ void attn_phase(char*lds,const AttnTensors&T,const Sched&S,const int tid){
  AttnUnit u;
  for(int i=0;S.next(i,u);++i){ S.a_ready(u); attn_unit<THRL>(u.bh/NHEAD,u.bh%NHEAD,u.qb,T.Q,T.K,T.V,T.O,T.C2K,T.thr2,lds,tid); S.done(u); }
}
#undef SBAR
#undef WAIT_BAR
}
__device__ __forceinline__ void phase_attn_fast(Ctx& C, KA AR, int l, char* ldsg) {
    const attn_body::bf16* Q = (const attn_body::bf16*)(C.ws + WS_R1) + (size_t)2 * T * 512;
    const float bq = 64.f * C2 * wave_max(fabsf(AR->in[I_QN][l * HD + C.lane])) * wave_max(fabsf(AR->in[I_KN][l * HD + C.lane]));
    const attn_body::AttnTensors AT{Q, Q + (size_t)T * 512, Q + (size_t)2 * T * 512, (attn_body::bf16*)(C.ws + WS_R2), (const float*)(C.ws + WS_C2K), 2.f * bq + 40.f};
    unsigned* qctr = (unsigned*)(C.ws + WS_CTL) + CW_ATT + 64 * l;
    volatile LAS unsigned* slot = (volatile LAS unsigned*)(C.lds + MISC_OFF) + 16;
    for (;;) {
        __syncthreads();
        if (C.tid == 0) slot[0] = atomicAdd(qctr, 1u);
        __syncthreads();
        const int idx = __builtin_amdgcn_readfirstlane((int)slot[0]);
        if (idx >= NB * NH * 16) break;
        const int qb = 15 - (idx >> 5), bh = idx & 31;
        attn_body::attn_unit<8>(bh >> 3, bh & 7, qb, AT.Q, AT.K, AT.V, AT.O, AT.C2K, AT.thr2, ldsg, C.tid);
    }
}

constexpr int RCH = 32, NCH = S / RCH;
__device__ __forceinline__ float one_minus_sq_exp(float la, float a) {
    const float x = 2.f * la;
    float p = 1.f / 5040.f; p = p * x + 1.f / 720.f; p = p * x + 1.f / 120.f; p = p * x + 1.f / 24.f; p = p * x + 1.f / 6.f; p = p * x + 0.5f; p = p * x + 1.f; p = -(p * x);
    return x > -0.25f ? p : 1.f - a * a;
}
template <int MODE>
__device__ __forceinline__ void phase_rnn_fast(Ctx& C, KA AR, int l) {
    typedef short bf16x8 __attribute__((ext_vector_type(8)));
    const int blk = C.wave, lane = C.lane, fr = lane & 15, fq = lane >> 4;
    LAS float* Ab = (LAS float*)C.lds + C.wave * 4096; LAS float* Ub = Ab + 2048;
    LAS float* SS = (LAS float*)(C.lds + TAB_OFF); LAS float* RSW = SS + 256 + C.wave * 32;
    const bf16* ZX = (const bf16*)(C.ws + WS_R1); const bf16* ZG = ZX + (size_t)T * 512;
    float* SA = (float*)(C.ws + WS_SA); float* SH = (float*)(C.ws + WS_SH);
    const bf16* O = (const bf16*)(C.ws + WS_R2); bf16* YM = (bf16*)(C.ws + WS_R2 + 16 * MiB);
    const float* cw = AR->in[I_CONVW] + l * 4 * DR; const float* cb = AR->in[I_CONVB] + l * DR;
    const float* wr = AR->in[I_WR] + (size_t)(l * 8 + blk) * 64 * 64; const float* wi = AR->in[I_WI] + (size_t)(l * 8 + blk) * 64 * 64;
    bf16x8 Br[4][2], Bi[4][2]; float brj[4], bij[4], spj[4];
#pragma unroll
    for (int n = 0; n < 4; ++n) { const int j = n * 16 + fr, ch = blk * 64 + j;
        brj[n] = AR->in[I_BR][l * DR + ch]; bij[n] = AR->in[I_BI][l * DR + ch]; spj[n] = log1pf(__expf(-AR->in[I_LAM][l * DR + ch]));
#pragma unroll
        for (int ks = 0; ks < 2; ++ks)
#pragma unroll
            for (int e = 0; e < 8; ++e) { const int k = ks * 32 + fq * 8 + e; Br[n][ks][e] = (short)f2bf(wr[k * 64 + j]); Bi[n][ks][e] = (short)f2bf(wi[k * 64 + j]); } }
    for (int u = blockIdx.x; u < NB * NCH; u += gridDim.x) {
        const int b = u / NCH; int c = u % NCH; if (MODE == 1 && ((u / (int)gridDim.x) & 1)) c = NCH - 1 - c;
        const int t0 = c * RCH;
        if (MODE == 1) __syncthreads();
        bf16x8 Af[2][2];
#pragma unroll
        for (int ks = 0; ks < 2; ++ks) {
            const int ch0 = blk * 64 + ks * 32 + fq * 8;
            f32x4 w[4][2], bb[2];
#pragma unroll
            for (int j = 0; j < 4; ++j) { w[j][0] = *(const f32x4*)(cw + j * DR + ch0); w[j][1] = *(const f32x4*)(cw + j * DR + ch0 + 4); }
            bb[0] = *(const f32x4*)(cb + ch0); bb[1] = *(const f32x4*)(cb + ch0 + 4);
#pragma unroll
            for (int m = 0; m < 2; ++m) {
                const int tok = m * 16 + fr, tg = t0 + tok;
                f32x4 x0 = bb[0], x1 = bb[1];
#pragma unroll
                for (int j = 0; j < 4; ++j) { const int tt = tg - 3 + j;
                    if (tt >= 0) { const v4u z = *(const v4u*)(ZX + (size_t)(b * S + tt) * 512 + ch0);
                        x0[0] += w[j][0][0] * bflo(z.x); x0[1] += w[j][0][1] * bfhi(z.x); x0[2] += w[j][0][2] * bflo(z.y); x0[3] += w[j][0][3] * bfhi(z.y);
                        x1[0] += w[j][1][0] * bflo(z.z); x1[1] += w[j][1][1] * bfhi(z.z); x1[2] += w[j][1][2] * bflo(z.w); x1[3] += w[j][1][3] * bfhi(z.w); } }
                *(LAS f32x4*)(Ub + tok * 64 + ks * 32 + fq * 8) = x0; *(LAS f32x4*)(Ub + tok * 64 + ks * 32 + fq * 8 + 4) = x1;
                v4u pk; pk.x = pk2(x0[0], x0[1]); pk.y = pk2(x0[2], x0[3]); pk.z = pk2(x1[0], x1[1]); pk.w = pk2(x1[2], x1[3]);
                Af[m][ks] = __builtin_bit_cast(bf16x8, pk);
            }
        }
        f32x4 aR[2][4], aI[2][4];
#pragma unroll
        for (int m = 0; m < 2; ++m)
#pragma unroll
            for (int n = 0; n < 4; ++n) { aR[m][n] = (f32x4){0.f, 0.f, 0.f, 0.f}; aI[m][n] = (f32x4){0.f, 0.f, 0.f, 0.f};
#pragma unroll
                for (int ks = 0; ks < 2; ++ks) { aR[m][n] = __builtin_amdgcn_mfma_f32_16x16x32_bf16(Af[m][ks], Br[n][ks], aR[m][n], 0, 0, 0); aI[m][n] = __builtin_amdgcn_mfma_f32_16x16x32_bf16(Af[m][ks], Bi[n][ks], aI[m][n], 0, 0, 0); } }
        asm volatile("s_waitcnt lgkmcnt(0)" ::: "memory");
#pragma unroll
        for (int m = 0; m < 2; ++m)
#pragma unroll
            for (int n = 0; n < 4; ++n)
#pragma unroll
                for (int i = 0; i < 4; ++i) { const int idx = (m * 16 + 4 * fq + i) * 64 + n * 16 + fr;
                    const float xcv = Ub[idx], r = sigmoid_fast(aR[m][n][i] + brj[n]), ig = sigmoid_fast(aI[m][n][i] + bij[n]);
                    const float la = -8.f * r * spj[n], a = __expf(la);
                    Ab[idx] = a; Ub[idx] = sqrtf(one_minus_sq_exp(la, a)) * (ig * xcv); }
        asm volatile("s_waitcnt lgkmcnt(0)" ::: "memory");
        const int ch = blk * 64 + lane;
        if (MODE == 0) { float At = 1.f, h = 0.f;
#pragma unroll 8
            for (int t = 0; t < RCH; ++t) { const float a = Ab[t * 64 + lane]; h = a * h + Ub[t * 64 + lane]; At *= a; }
            SA[(size_t)(b * NCH + c) * 512 + ch] = At; SH[(size_t)(b * NCH + c) * 512 + ch] = h;
        } else {
            float h = 0.f;
            { const float* sa = SA + (size_t)b * NCH * 512 + ch; const float* sh = SH + (size_t)b * NCH * 512 + ch; int c2 = 0;
              for (; c2 + 8 <= c; c2 += 8) { float a8[8], h8[8];
#pragma unroll
                  for (int q = 0; q < 8; ++q) { a8[q] = sa[(size_t)(c2 + q) * 512]; h8[q] = sh[(size_t)(c2 + q) * 512]; }
#pragma unroll
                  for (int q = 0; q < 8; ++q) h = a8[q] * h + h8[q]; }
              for (; c2 < c; ++c2) h = sa[(size_t)c2 * 512] * h + sh[(size_t)c2 * 512]; }
            const bf16* zg = ZG + (size_t)(b * S + t0) * 512 + ch;
#pragma unroll 8
            for (int t = 0; t < RCH; ++t) { h = Ab[t * 64 + lane] * h + Ub[t * 64 + lane]; Ab[t * 64 + lane] = h * bf2f(zg[(size_t)t * 512]); }
            asm volatile("s_waitcnt lgkmcnt(0)" ::: "memory");
            { const int t = lane & 31, hf = lane >> 5; float s = 0.f;
#pragma unroll 8
              for (int k = 0; k < 32; ++k) { const float y = Ab[t * 64 + hf * 32 + ((k + t) & 31)]; s += y * y; }
              s = half_sum32(s); if (lane < 32) SS[C.wave * 32 + lane] = s; }
            __syncthreads();
            { const int t = lane & 31; float tot = 0.f;
#pragma unroll
              for (int w8 = 0; w8 < 8; ++w8) tot += SS[w8 * 32 + t];
              RSW[t] = rsqrtf(tot * (1.f / 512.f) + EPS); }
            asm volatile("s_waitcnt lgkmcnt(0)" ::: "memory");
            { const int oct = lane & 7; const float* g1 = AR->in[I_LRUN] + l * DR + blk * 64 + oct * 8; const f32x4 ga = *(const f32x4*)g1, gb = *(const f32x4*)(g1 + 4);
#pragma unroll
              for (int q = 0; q < 4; ++q) { const int t = q * 8 + (lane >> 3); const float rs = RSW[t];
                  const f32x4 y0 = *(const LAS f32x4*)(Ab + t * 64 + oct * 8) * rs * ga, y1 = *(const LAS f32x4*)(Ab + t * 64 + oct * 8 + 4) * rs * gb;
                  v4u pk; pk.x = pk2(y0[0], y0[1]); pk.y = pk2(y0[2], y0[3]); pk.z = pk2(y1[0], y1[1]); pk.w = pk2(y1[2], y1[3]);
                  *(v4u*)(YM + (size_t)(b * S + t0 + t) * D + blk * 64 + oct * 8) = pk; } }
            { const float* g2 = AR->in[I_ATTN] + l * DA + 8 * lane; const f32x4 ga = *(const f32x4*)g2, gb = *(const f32x4*)(g2 + 4);
#pragma unroll
              for (int q = 0; q < 4; ++q) { const size_t row = (size_t)(b * S + t0 + C.wave * 4 + q);
                  const v4u w = *(const v4u*)(O + row * 512 + 8 * lane);
                  f32x4 x0 = {bflo(w.x), bfhi(w.x), bflo(w.y), bfhi(w.y)}, x1 = {bflo(w.z), bfhi(w.z), bflo(w.w), bfhi(w.w)};
                  float s = (x0[0] * x0[0] + x0[1] * x0[1]) + (x0[2] * x0[2] + x0[3] * x0[3]) + (x1[0] * x1[0] + x1[1] * x1[1]) + (x1[2] * x1[2] + x1[3] * x1[3]);
                  const float rs = rsqrtf(wave_sum(s) * (1.f / 512.f) + EPS);
                  x0 = x0 * rs * ga; x1 = x1 * rs * gb;
                  v4u pk; pk.x = pk2(x0[0], x0[1]); pk.y = pk2(x0[2], x0[3]); pk.z = pk2(x1[0], x1[1]); pk.w = pk2(x1[2], x1[3]);
                  *(v4u*)(YM + row * D + 512 + 8 * lane) = pk; } }
        }
    }
}

template <int NT, class WF>
__device__ __forceinline__ void norm_proj_tile(const float* X, const float* gain, bf16* xn, int t0, WF wf, LAS float* Lw, int lane, int kh) {
    const int fr = lane & 15, fq = lane >> 4;
    f32x4 acc[NT];
#pragma unroll
    for (int n = 0; n < NT; ++n) acc[n] = (f32x4){0.f, 0.f, 0.f, 0.f};
    float ssq = 0.f;
    const float* xr = X + (size_t)(t0 + fr) * D + 4 * fq; const float* gr = gain + 4 * fq;
    for (int sb = 2 * kh; sb < 2 * kh + 2; ++sb) {
        f32x4 xv[16];
#pragma unroll
        for (int i = 0; i < 16; ++i) xv[i] = *(const f32x4*)(xr + 16 * (16 * sb + i));
#pragma unroll
        for (int i = 0; i < 16; ++i) { const int s = 16 * sb + i; const f32x4 gv = *(const f32x4*)(gr + 16 * s);
            ssq += (xv[i][0] * xv[i][0] + xv[i][1] * xv[i][1]) + (xv[i][2] * xv[i][2] + xv[i][3] * xv[i][3]);
            const f32x4 xg = xv[i] * gv;
#pragma unroll
            for (int e = 0; e < 4; ++e)
#pragma unroll
                for (int n = 0; n < NT; ++n) acc[n] = __builtin_amdgcn_mfma_f32_16x16x4f32(wf(n, 16 * s + 4 * fq + e, fr), xg[e], acc[n], 0, 0, 0); }
    }
    constexpr int PW = 4 * NT + 1;
    if (kh == 1) {
#pragma unroll
        for (int n = 0; n < NT; ++n)
#pragma unroll
            for (int r = 0; r < 4; ++r) Lw[lane * PW + 4 * n + r] = acc[n][r];
        Lw[lane * PW + 4 * NT] = ssq;
    }
    __syncthreads();
    if (kh == 0) {
#pragma unroll
        for (int n = 0; n < NT; ++n)
#pragma unroll
            for (int r = 0; r < 4; ++r) acc[n][r] += Lw[lane * PW + 4 * n + r];
        ssq += Lw[lane * PW + 4 * NT];
        ssq += lane_xor<16>(ssq); ssq = half_sum32(ssq);
        const float rs = rsqrtf(ssq * (1.f / D) + EPS);
        asm volatile("s_waitcnt lgkmcnt(0)" ::: "memory");
#pragma unroll
        for (int n = 0; n < NT; ++n)
#pragma unroll
            for (int r = 0; r < 4; ++r) Lw[fr * (16 * NT) + 16 * n + 4 * fq + r] = acc[n][r] * rs;
        if (lane < 16) Lw[16 * 16 * NT + lane] = rs;
    }
    __syncthreads();
#pragma unroll
    for (int q = 0; q < 8; ++q) { const int tok = 8 * kh + q; const float rst = Lw[16 * 16 * NT + tok];
        f32x4 v[4]; load_row(X + (size_t)(t0 + tok) * D, lane, v); scale_row(v, rst, gain, lane); store_row_bf16(xn + (size_t)(t0 + tok) * D, lane, v); }
}
__device__ __forceinline__ void phase_norm1_fast(Ctx& C, KA AR, int l) {
    const float* xs = l == 0 ? AR->in[I_X] : (const float*)(C.ws + WS_X);
    const float* gain = AR->in[I_MIXN] + l * D; const float* wf = AR->in[I_WIN] + (size_t)l * D * DIN + NZ; const float* bfg = AR->in[I_BF] + l * NH;
    bf16* xn = (bf16*)(C.ws + WS_XN); float* logf = (float*)(C.ws + WS_LOGF);
    LAS float* Wl = (LAS float*)C.lds; LAS float* Lw = (LAS float*)(C.lds + 32768 + 1024) + (C.wave & 3) * 1024; const int kh = C.wave >> 2;
    { f32x4 t[4];
#pragma unroll
      for (int j = 0; j < 4; ++j) { const int i = C.tid + 512 * j; t[j] = *(const f32x4*)(wf + (size_t)(i >> 1) * DIN + 4 * (i & 1)); }
#pragma unroll
      for (int j = 0; j < 4; ++j) *(LAS f32x4*)(Wl + 4 * (C.tid + 512 * j)) = t[j]; }
    if (C.tid < 8) Wl[D * 8 + C.tid] = 0.f;
    __syncthreads();
        for (int tile = blockIdx.x * 4 + (C.wave & 3); tile < T / 16; tile += gridDim.x * 4) {
            const int t0 = 16 * tile;
            __syncthreads();
            norm_proj_tile<1>(xs, gain, xn, t0, [=](int, int k, int i) { return Wl[k * 8 + i]; }, Lw, C.lane, kh);
            if (kh == 0) {
            const int tok = C.lane & 15, h0 = (C.lane >> 4) * 2;
            { const int r = t0 + tok, bb = r / S, tt = r % S;
              logf[(size_t)(bb * NH + h0) * S + tt] = log_sigmoid(Lw[tok * 16 + h0] + bfg[h0]); logf[(size_t)(bb * NH + h0 + 1) * S + tt] = log_sigmoid(Lw[tok * 16 + h0 + 1] + bfg[h0 + 1]); }
            }
            asm volatile("s_waitcnt lgkmcnt(0)" ::: "memory");
        }
}
__device__ __forceinline__ void phase_router_fast(Ctx& C, KA AR, int l) {
    const float* X = (const float*)(C.ws + WS_X); bf16* xn = (bf16*)(C.ws + WS_XN);
    const float* gain = AR->in[I_FFNN] + l * D; const float* wg = AR->in[I_WG] + (size_t)l * D * 4; const float* bg = AR->in[I_BG] + l * 4;
    const float* wr = AR->in[I_WRT] + (size_t)l * D * NE; const float* brt = AR->in[I_BRT] + l * NE;
    unsigned* cnt = (unsigned*)(C.ws + WS_CTL) + CW_CNT + 32 * CNT_STRIDE * l; int* rowpair = (int*)(C.ws + WS_ROWPAIR); float* pairw = (float*)(C.ws + WS_PAIRW);
    LAS float* Wl = (LAS float*)C.lds; LAS float* Lw = (LAS float*)(C.lds + WPROJ_BYTES + 64) + (C.wave & 3) * 832; const int kh = C.wave >> 2;
    { f32x4 t[16], u[2];
#pragma unroll
      for (int j = 0; j < 16; ++j) t[j] = *(const f32x4*)(wr + 4 * (C.tid + 512 * j));
#pragma unroll
      for (int j = 0; j < 2; ++j) u[j] = *(const f32x4*)(wg + 4 * (C.tid + 512 * j));
#pragma unroll
      for (int j = 0; j < 16; ++j) { const int i = C.tid + 512 * j; *(LAS f32x4*)(Wl + (i >> 3) * 36 + 4 * (i & 7)) = t[j]; }
#pragma unroll
      for (int j = 0; j < 2; ++j) *(LAS f32x4*)(Wl + (C.tid + 512 * j) * 36 + 32) = u[j]; }
    if (C.tid < 16) Wl[D * 36 + C.tid] = 0.f;
    __syncthreads();
        for (int tile = blockIdx.x * 4 + (C.wave & 3); tile < T / 16; tile += gridDim.x * 4) {
            const int t0 = 16 * tile;
            __syncthreads();
            norm_proj_tile<3>(X, gain, xn, t0, [=](int n, int k, int i) { return Wl[k * 36 + 16 * n + i]; }, Lw, C.lane, kh);
            if (kh == 0 && C.lane < 16) {
                const LAS float* L = Lw + C.lane * 48; const int t = t0 + C.lane;
                float gl[4];
#pragma unroll
                for (int i = 0; i < 4; ++i) gl[i] = L[32 + i] + bg[i];
                int gi = 0; float gm = gl[0];
#pragma unroll
                for (int i = 1; i < 4; ++i) if (gl[i] > gm) { gm = gl[i]; gi = i; }
                float gs = 0.f;
#pragma unroll
                for (int i = 0; i < 4; ++i) gs += __expf(gl[i] - gm);
                const float gp = 1.f / gs;
                float ev[8];
#pragma unroll
                for (int i = 0; i < 8; ++i) ev[i] = L[gi * 8 + i] + brt[gi * 8 + i];
                int i0 = 0; float t0v = ev[0];
#pragma unroll
                for (int i = 1; i < 8; ++i) if (ev[i] > t0v) { t0v = ev[i]; i0 = i; }
                int i1 = -1; float t1v = -INFINITY;
#pragma unroll
                for (int i = 0; i < 8; ++i) if (i != i0 && ev[i] > t1v) { t1v = ev[i]; i1 = i; }
                const float ex = __expf(t1v - t0v), w0 = gp / (1.f + ex), w1 = gp * ex / (1.f + ex);
                const int e0 = gi * 8 + i0, e1 = gi * 8 + i1;
                const unsigned p0 = atomicAdd(cnt + e0 * CNT_STRIDE, 1u), p1 = atomicAdd(cnt + e1 * CNT_STRIDE, 1u);
                rowpair[(size_t)e0 * CAP + p0] = 2 * t; rowpair[(size_t)e1 * CAP + p1] = 2 * t + 1; pairw[2 * t] = w0; pairw[2 * t + 1] = w1;
            }
            asm volatile("s_waitcnt lgkmcnt(0)" ::: "memory");
        }
}

constexpr int NPH = 14;
constexpr int NPHASES = 1 + DEPTH * NPH;
__global__ void __launch_bounds__(512, 2) fwd_kernel(Args args) {
    extern __shared__ __attribute__((aligned(16))) unsigned char lds[];
    Ctx C;
    C.lds = (LAS unsigned char*)lds;
    C.wave0 = __builtin_amdgcn_readfirstlane((int)threadIdx.x >> 6); asm volatile("" : "+s"(C.wave0));
    C.tid = threadIdx.x; C.lane = C.tid & 63; C.wave = C.wave0;
    C.gw = blockIdx.x * 8 + C.wave; C.ngw = gridDim.x * 8;
    C.ws = args.ws;
    volatile LAS unsigned* MISC = (volatile LAS unsigned*)(C.lds + MISC_OFF);
    if (C.tid < 32) MISC[C.tid] = 0u;
    __syncthreads();
    XcdBarrier bar; bar.bar = (unsigned*)(C.ws + WS_CTL) + CW_BAR; bar.x = 0; bar.st = nullptr;
    if (args.ph_hi - args.ph_lo > 1) bar = xcd_barrier_post((unsigned*)(C.ws + WS_CTL) + CW_BAR, MISC + 8);
#ifndef ONLY
#define ONLY -1
#endif
#define PHON(k) (ONLY < 0 || ONLY == (k))
#if MK_MULTI
#define IN(k) (fresh_args()->ph_lo <= (k) && (k) < fresh_args()->ph_hi)
#else
#define IN(k) true
#endif
    if (PROBE_TIMING && blockIdx.x == 0 && threadIdx.x == 0) ((unsigned long long*)((unsigned*)(args.ws + WS_CTL) + CW_TS))[0] = __builtin_amdgcn_s_memrealtime();
#define SEAM(k) do { if (IN(k) && IN((k) + 1)) { XcdBarrier b_; b_.bar = (unsigned*)(fresh_args()->ws + WS_CTL) + CW_BAR; b_.x = xb_xcc_id(); b_.st = (volatile LAS unsigned*)(C.lds + MISC_OFF) + 8;     \
        xcd_barrier(b_, C.tid == 0); if (PROBE_TIMING && blockIdx.x == 0 && C.tid == 0) { ((unsigned long long*)((unsigned*)(fresh_args()->ws + WS_CTL) + CW_TS))[(k) + 1] = __builtin_amdgcn_s_memrealtime(); } } } while (0)
    for (int rp_ = 0; rp_ < REPS(99); ++rp_) { if (PHON(99) && IN(0)) { KA A_ = fresh_args(); enter_phase(C, A_); phase_prologue(C, A_); } SEAM(0); }
    for (int l = 0; l < DEPTH; ++l) {
        const int pb = 1 + l * NPH;
        for (int rp_ = 0; rp_ < REPSL(0); ++rp_) { if (PHON(0) && IN(pb + 0)) { KA A_ = fresh_args(); enter_phase(C, A_); if (FAST_NORM) phase_norm1_fast(C, A_, l); else phase_norm1(C, A_, l); } SEAM(pb + 0); }
        for (int rp_ = 0; rp_ < REPSL(1); ++rp_) { if (PHON(1) && IN(pb + 1)) { KA A_ = fresh_args(); enter_phase(C, A_); if (FAST_GEMM1) { phase_gemm1_fast(C, A_, l); phase_proj_fast(C, A_, l); } else phase_gemm1_naive(C, A_, l); } SEAM(pb + 1); }
        for (int rp_ = 0; rp_ < REPSL(2); ++rp_) { if (!FAST_GEMM1 && PHON(2) && IN(pb + 2)) { KA A_ = fresh_args(); enter_phase(C, A_); phase_qknorm_naive(C, A_, l); } if (!FAST_GEMM1) SEAM(pb + 2); }
        for (int rp_ = 0; rp_ < REPSL(3); ++rp_) { if (!(FAST_RNN && FAST_ATTN) && PHON(3) && IN(pb + 3)) { KA A_ = fresh_args(); enter_phase(C, A_); if (FAST_RNN) phase_rnn_fast<0>(C, A_, l); else phase_rnn_naive<0>(C, A_, l); } if (!(FAST_RNN && FAST_ATTN)) SEAM(pb + 3); }
        for (int rp_ = 0; rp_ < REPSL(4); ++rp_) { if (PHON(4) && IN(pb + 4)) { KA A_ = fresh_args(); enter_phase(C, A_); if (FAST_RNN && FAST_ATTN) { phase_rnn_fast<0>(C, A_, l); __syncthreads(); } if (FAST_ATTN) phase_attn_fast(C, A_, l, (char*)lds); else phase_attn_naive(C, A_, l); } SEAM(pb + 4); }
        for (int rp_ = 0; rp_ < REPSL(5); ++rp_) { if (PHON(5) && IN(pb + 5)) { KA A_ = fresh_args(); enter_phase(C, A_); if (FAST_RNN) phase_rnn_fast<1>(C, A_, l); else phase_rnn_naive<1>(C, A_, l); } SEAM(pb + 5); }
        for (int rp_ = 0; rp_ < REPSL(6); ++rp_) { if (!FAST_RNN && PHON(6) && IN(pb + 6)) { KA A_ = fresh_args(); enter_phase(C, A_); phase_mixnorm_naive(C, A_, l); } if (!FAST_RNN) SEAM(pb + 6); }
        for (int rp_ = 0; rp_ < REPSL(7); ++rp_) { if (PHON(7) && IN(pb + 7)) { KA A_ = fresh_args(); enter_phase(C, A_); if (FAST_DENSE) phase_wo_fast(C, A_, l); else phase_wo_naive(C, A_, l); } SEAM(pb + 7); }
        for (int rp_ = 0; rp_ < REPSL(8); ++rp_) { if (PHON(8) && IN(pb + 8)) { KA A_ = fresh_args(); enter_phase(C, A_); if (FAST_NORM) phase_router_fast(C, A_, l); else phase_router(C, A_, l); } SEAM(pb + 8); }
        for (int rp_ = 0; rp_ < REPSL(9); ++rp_) { if (PHON(9) && IN(pb + 9)) { KA A_ = fresh_args(); enter_phase(C, A_); if (FAST_MOE) phase_g1_fast(C, A_, l); else phase_g1_naive(C, A_, l); } SEAM(pb + 9); }
        for (int rp_ = 0; rp_ < REPSL(10); ++rp_) { if (PHON(10) && IN(pb + 10)) { KA A_ = fresh_args(); enter_phase(C, A_); if (FAST_MOE) phase_g2_fast(C, A_, l); else phase_g2_naive(C, A_, l); } SEAM(pb + 10); }
        for (int rp_ = 0; rp_ < REPSL(11); ++rp_) { if (PHON(11) && IN(pb + 11)) { KA A_ = fresh_args(); enter_phase(C, A_); phase_combine(C, A_, l); } SEAM(pb + 11); }
        for (int rp_ = 0; rp_ < REPSL(12); ++rp_) { if (!FAST_GEMM1 && PHON(12) && IN(pb + 12)) { KA A_ = fresh_args(); enter_phase(C, A_); if (FAST_DENSE) phase_proj_fast(C, A_, l); else phase_proj_naive(C, A_, l); } if (!FAST_GEMM1) SEAM(pb + 12); }
        for (int rp_ = 0; rp_ < REPSL(13); ++rp_) { if (PHON(13) && IN(pb + 13)) { KA A_ = fresh_args(); enter_phase(C, A_); if (FAST_DENSE) phase_ple_fast(C, A_, l); else phase_ple_naive(C, A_, l); } if (l + 1 < DEPTH) SEAM(pb + 13); }
    }
#undef IN
#undef SEAM
}

extern "C" void kernel_launch(void* const* d_in, const int* in_sizes, int n_in, void* d_out, int out_size, void* d_ws, size_t ws_size, hipStream_t stream) {
    static int grid = 0;
    if (grid == 0) {
        if (n_in != 29 || out_size != T * D || ws_size < WS_END) { fprintf(stderr, "kernel_launch: unexpected problem (n_in %d, out %d, ws %zu)\n", n_in, out_size, ws_size); grid = -1; return; }
        int dev = 0, cus = 0, per_cu = 0;
        if (hipGetDevice(&dev) != hipSuccess || hipDeviceGetAttribute(&cus, hipDeviceAttributeMultiprocessorCount, dev) != hipSuccess) { grid = -1; return; }
        if (hipFuncSetAttribute((const void*)fwd_kernel, hipFuncAttributeMaxDynamicSharedMemorySize, LDS_BYTES) != hipSuccess) { fprintf(stderr, "kernel_launch: hipFuncSetAttribute failed\n"); grid = -1; return; }
        if (hipOccupancyMaxActiveBlocksPerMultiprocessor(&per_cu, (const void*)fwd_kernel, 512, LDS_BYTES) != hipSuccess || per_cu < 1) { fprintf(stderr, "kernel_launch: occupancy query says %d\n", per_cu); grid = -1; return; }
        (void)hipGetLastError();
        grid = cus;
    }
    if (grid < 0) return;
    hipMemsetAsync((char*)d_ws + WS_CTL, 0, CTL_ZERO_BYTES, stream);
    Args a{};
    for (int i = 0; i < 29; ++i) a.in[i] = (const float*)d_in[i];
    a.out = (float*)d_out; a.ws = (unsigned char*)d_ws;
#if MK_MULTI
    for (int ph = 0; ph < NPHASES; ++ph) { a.ph_lo = ph; a.ph_hi = ph + 1; hipLaunchKernelGGL(fwd_kernel, dim3(grid), dim3(512), LDS_BYTES, stream, a); }
#else
    a.ph_lo = 0; a.ph_hi = NPHASES;
    hipLaunchKernelGGL(fwd_kernel, dim3(grid), dim3(512), LDS_BYTES, stream, a);
#endif
}
```

```cpp
#include <hip/hip_runtime.h>
#include <cstdio>
#include <cstdint>
#include <cmath>
#include <hip/hip_bf16.h>

#define FAST_GEMM1 1
#define FAST_DENSE 1
#define FAST_MOE 1
#define FAST_ATTN 1
#define FAST_RNN 1
#define FAST_NORM 1
#ifndef PROBE_TIMING
#define PROBE_TIMING 0
#endif
#ifndef PROBE_LO
#define PROBE_LO 0
#define PROBE_HI 1
#endif
#ifndef PROBE_REP
#define PROBE_REP -1
#define PROBE_REPN 0
#endif
#define REPS(k) ((PROBE_REP == (k)) ? (1 + PROBE_REPN) : 1)
#define REPSL(k) ((((k) == 7 && l != 0) || ((k) == 13 && l != DEPTH - 1)) ? 1 : REPS(k))
#ifndef MK_MULTI
#define MK_MULTI 0
#endif

#define GAS __attribute__((address_space(1)))
#define LAS __attribute__((address_space(3)))
typedef unsigned short bf16;
typedef unsigned v4u __attribute__((ext_vector_type(4)));
typedef unsigned v2u __attribute__((ext_vector_type(2)));
typedef float f32x4 __attribute__((ext_vector_type(4)));

constexpr int NB = 4, S = 4096, T = NB * S, D = 1024, DIN = 2568, DR = 512, DA = 512, NH = 8, HD = 64;
constexpr int NE = 32, DE = 512, PLE = 256, DEPTH = 2, NZ = 2560;
constexpr float EPS = 1e-6f, LOG2E = 1.4426950408889634f, C2 = 0.125f * 1.4426950408889634f;
constexpr int CAP = 16384;
constexpr int HROWS = 40960;

constexpr size_t MiB = 1u << 20;
constexpr size_t WS_CTL = 0, CTL_ZERO_BYTES = 1 * MiB;
constexpr size_t WS_LOGF = 1 * MiB;
constexpr size_t WS_C2K = WS_LOGF + MiB / 2;
constexpr size_t WS_SA = 6 * MiB, WS_SH = 7 * MiB;
constexpr size_t WS_PAIRW = 3 * MiB;
constexpr size_t WS_ROWPAIR = 4 * MiB;
constexpr size_t WS_WIN = 8 * MiB;
constexpr size_t WS_WOUT = 18 * MiB;
constexpr size_t WS_WPG = 22 * MiB;
constexpr size_t WS_WPP = 26 * MiB;
constexpr size_t WS_WGU = 28 * MiB;
constexpr size_t WS_WDN = 156 * MiB;
constexpr size_t WS_PB = 220 * MiB;
constexpr size_t WS_XN = 236 * MiB;
constexpr size_t WS_X = 268 * MiB;
constexpr size_t WS_R1 = 332 * MiB;
constexpr size_t WS_R2 = 412 * MiB;
constexpr size_t WS_PROJ = 460 * MiB;
constexpr size_t WS_END = 492 * MiB;
constexpr int CW_BAR = 4096;
constexpr int CW_TS = 20480;
constexpr int CW_ATT = 16384;
constexpr int CW_CNT = 8192, CNT_STRIDE = 64;

constexpr int RING_BYTES = 131072;
constexpr int LDS_BYTES = 163840;
constexpr int MISC_OFF = LDS_BYTES - 1024;
constexpr int WPROJ_BYTES = 147456;

__device__ __forceinline__ unsigned f2bf(float f) { unsigned u = __builtin_bit_cast(unsigned, f); return (u + 0x7fffu + ((u >> 16) & 1u)) >> 16; }
__device__ __forceinline__ unsigned pk2(float lo, float hi) { return f2bf(lo) | (f2bf(hi) << 16); }
__device__ __forceinline__ float bf2f(unsigned u) { return __builtin_bit_cast(float, u << 16); }
__device__ __forceinline__ float bflo(unsigned w) { return __builtin_bit_cast(float, w << 16); }
__device__ __forceinline__ float bfhi(unsigned w) { return __builtin_bit_cast(float, w & 0xffff0000u); }
template <int O> __device__ __forceinline__ float lane_xor(float v) {
    if constexpr (O == 32) { const unsigned u = __builtin_bit_cast(unsigned, v); auto rr = __builtin_amdgcn_permlane32_swap(u, u, false, false);
        const unsigned a = rr[0], b = rr[1]; return __builtin_bit_cast(float, a == u ? b : a); }
    else return __builtin_bit_cast(float, __builtin_amdgcn_ds_swizzle(__builtin_bit_cast(int, v), (O << 10) | 0x1f));
}
__device__ __forceinline__ float wave_sum(float v) {
    v += lane_xor<1>(v); v += lane_xor<2>(v); v += lane_xor<4>(v); v += lane_xor<8>(v); v += lane_xor<16>(v);
    { const unsigned u = __builtin_bit_cast(unsigned, v); auto rr = __builtin_amdgcn_permlane32_swap(u, u, false, false); v = __builtin_bit_cast(float, (unsigned)rr[0]) + __builtin_bit_cast(float, (unsigned)rr[1]); }
    return v;
}
__device__ __forceinline__ float wave_max(float v) {
    v = fmaxf(v, lane_xor<1>(v)); v = fmaxf(v, lane_xor<2>(v)); v = fmaxf(v, lane_xor<4>(v)); v = fmaxf(v, lane_xor<8>(v)); v = fmaxf(v, lane_xor<16>(v));
    { const unsigned u = __builtin_bit_cast(unsigned, v); auto rr = __builtin_amdgcn_permlane32_swap(u, u, false, false); v = fmaxf(__builtin_bit_cast(float, (unsigned)rr[0]), __builtin_bit_cast(float, (unsigned)rr[1])); }
    return v;
}
__device__ __forceinline__ float half_sum32(float v) {
    const unsigned u = __builtin_bit_cast(unsigned, v); auto rr = __builtin_amdgcn_permlane32_swap(u, u, false, false); return __builtin_bit_cast(float, (unsigned)rr[0]) + __builtin_bit_cast(float, (unsigned)rr[1]);
}
__device__ __forceinline__ float sigmoidf_(float v) { return 1.f / (1.f + __expf(-v)); }
__device__ __forceinline__ float gelu_tanh(float v) { return 0.5f * v * (1.f + tanhf(0.7978845608028654f * (v + 0.044715f * v * v * v))); }
__device__ __forceinline__ float log_sigmoid(float v) { return v >= 0.f ? -log1pf(__expf(-v)) : v - log1pf(__expf(v)); }

#define XB_TMO      128
#define XB_XCNT(j)  (256  + 64 * (j))
#define XB_XSUB(j)  (1280 + 64 * (j))
#define XB_XGEN(j)  (2304 + 64 * (j))
#define XB_TOP      3328
#define XB_TOPGEN   3392
#define XCD_BAR_WORDS 3456
#define XB_SPIN_CAP (1u << 26)
__device__ __forceinline__ unsigned xb_ld(unsigned* p)              { return __hip_atomic_load(p, __ATOMIC_RELAXED, __HIP_MEMORY_SCOPE_AGENT); }
__device__ __forceinline__ unsigned xb_add(unsigned* p, unsigned v) { return __hip_atomic_fetch_add(p, v, __ATOMIC_RELAXED, __HIP_MEMORY_SCOPE_AGENT); }
__device__ __forceinline__ unsigned xb_xcc_id() { return (unsigned)__builtin_amdgcn_s_getreg((3 << 11) | 20) & 0xFu; }
#define XB_SPIN(cond, bar) do { unsigned _sp = 0; while (cond) { __builtin_amdgcn_s_sleep(1); \
    if ((++_sp & 255u) == 0u) { if (xb_ld(&(bar)[XB_TMO])) break; if (_sp > XB_SPIN_CAP) { atomicAdd(&(bar)[XB_TMO], 1u); break; } } } } while (0)
struct XcdBarrier { unsigned* bar; unsigned x; volatile LAS unsigned* st; };
__device__ __forceinline__ XcdBarrier xcd_barrier_post(unsigned* bar, volatile LAS unsigned* st) {
    XcdBarrier b; b.bar = bar; b.x = xb_xcc_id(); b.st = st;
    if (threadIdx.x == 0) (void)xb_add(&bar[XB_XCNT(b.x)], 1u);
    return b;
}
__device__ __forceinline__ void xcd_barrier_complete(unsigned* bar, unsigned x, unsigned& nloc, unsigned& nx) {
    const unsigned G = gridDim.x * gridDim.y * gridDim.z;
    unsigned sum, cnt, mine, sp = 0u;
    for (;;) {
        sum = 0u; cnt = 0u; mine = 0u;
#pragma unroll
        for (unsigned j = 0; j < 16; ++j) { const unsigned c = xb_ld(&bar[XB_XCNT(j)]); sum += c; cnt += (c > 0u) ? 1u : 0u; mine = (j == x) ? c : mine; }
        if (sum == G) break;
        __builtin_amdgcn_s_sleep(1);
        if ((++sp & 255u) == 0u) { if (xb_ld(&bar[XB_TMO])) break; if (sp > XB_SPIN_CAP) { atomicAdd(&bar[XB_TMO], 1u); break; } }
    }
    nloc = mine > 0u ? mine : 1u; nx = cnt > 0u ? cnt : 1u;
}
__device__ __forceinline__ void xcd_barrier(const XcdBarrier& b, const bool leader  ) {
    asm volatile("s_waitcnt vmcnt(0)" ::: "memory");
    __syncthreads();
    if (leader) {
        unsigned* bar = b.bar;
        __builtin_amdgcn_s_waitcnt(0);
        unsigned nloc = b.st[0], nx = b.st[1];
        if (nloc == 0u) { xcd_barrier_complete(bar, b.x, nloc, nx); b.st[0] = nloc; b.st[1] = nx; }
        const unsigned old = xb_add(&bar[XB_XSUB(b.x)], 1u);
        const unsigned gen = old / nloc;
        if (old + 1u == (gen + 1u) * nloc) {
            __builtin_amdgcn_fence(__ATOMIC_RELEASE, "agent");
            asm volatile("s_waitcnt vmcnt(0)" ::: "memory");
            const unsigned og = xb_add(&bar[XB_TOP], 1u);
            const unsigned tg = og / nx;
            if (og + 1u == (tg + 1u) * nx) xb_add(&bar[XB_TOPGEN], 1u);
            else XB_SPIN(xb_ld(&bar[XB_TOPGEN]) == tg, bar);
            __builtin_amdgcn_fence(__ATOMIC_ACQUIRE, "agent");
            xb_add(&bar[XB_XGEN(b.x)], 1u);
            asm volatile("s_waitcnt vmcnt(0)" ::: "memory");
        } else {
            XB_SPIN(xb_ld(&bar[XB_XGEN(b.x)]) == gen, bar);
            __builtin_amdgcn_fence(__ATOMIC_ACQUIRE, "agent");
            asm volatile("s_waitcnt vmcnt(0)" ::: "memory");
        }
    }
    __syncthreads();
}

struct Args { const float* in[29]; float* out; unsigned char* ws; int ph_lo, ph_hi; };
typedef const __attribute__((address_space(4))) Args* KA;
__device__ __forceinline__ KA fresh_args() { KA p = (KA)__builtin_amdgcn_kernarg_segment_ptr(); asm volatile("" : "+s"(p)); return p; }
struct Ctx;
struct Ctx {
    LAS unsigned char* lds;
    int tid, lane, wave, gw, ngw;
    int wave0;
    unsigned char* ws;
};
__device__ __forceinline__ void enter_phase(Ctx& C, KA A) {
    int t; asm volatile("v_mbcnt_lo_u32_b32 %0, -1, 0\n\tv_mbcnt_hi_u32_b32 %0, -1, %0" : "=v"(t)); t += C.wave0 * 64; C.tid = t; C.lane = t & 63; C.wave = __builtin_amdgcn_readfirstlane(t >> 6);
    C.gw = blockIdx.x * 8 + C.wave; C.ngw = gridDim.x * 8; C.ws = A->ws; }
enum { I_X = 0, I_P, I_MIXN, I_WIN, I_BF, I_CONVW, I_CONVB, I_WR, I_BR, I_WI, I_BI, I_LAM, I_QN, I_KN, I_LRUN, I_ATTN, I_WOUT, I_FFNN,
       I_WG, I_BG, I_WRT, I_BRT, I_WEG, I_WEU, I_WED, I_PLEN, I_WPG, I_BPG, I_WPP };

__device__ __forceinline__ void transpose_item(const float* W, int ldw, int K, bf16* WT, int k0, int n0, int c0, LAS float* scr, int lane) {
    { float t[32];
#pragma unroll
      for (int i = 0; i < 32; ++i) t[i] = W[(size_t)(k0 + 2 * i + (lane >> 5)) * ldw + c0 + (lane & 31)];
#pragma unroll
      for (int i = 0; i < 32; ++i) scr[(2 * i + (lane >> 5)) * 33 + (lane & 31)] = t[i]; }
    asm volatile("s_waitcnt lgkmcnt(0)" ::: "memory");
    const int c = lane & 7;
#pragma unroll
    for (int j = 0; j < 4; ++j) { const int n = (lane >> 3) + 8 * j; const LAS float* s = scr + (8 * c) * 33 + n;
        v4u o; o.x = pk2(s[0 * 33], s[1 * 33]); o.y = pk2(s[2 * 33], s[3 * 33]); o.z = pk2(s[4 * 33], s[5 * 33]); o.w = pk2(s[6 * 33], s[7 * 33]);
        *(v4u*)(WT + (size_t)(n0 + n) * K + k0 + 8 * c) = o; }
    asm volatile("s_waitcnt lgkmcnt(0)" ::: "memory");
}
__device__ __forceinline__ void phase_prologue(Ctx& C, KA AR) {
    LAS float* scr = (LAS float*)(C.lds + C.wave * 16384);
    constexpr int I_IN = 16 * 80, I_OUT = 16 * 32, I_GU = 32 * 16 * 32, I_DN = 32 * 8 * 32, I_PG = 16 * 32, I_PP = 4 * 32;
    constexpr int PER_L = I_IN + I_OUT + I_GU + I_DN + I_PG + I_PP;
    for (int it = C.gw; it < DEPTH * PER_L; it += C.ngw) {
        const int l = it / PER_L; int r = it % PER_L;
        if (r < I_IN) {
            const int kb = r / 80, nb = r % 80, n0 = 32 * nb, pn = n0 >> 8, jl = n0 & 255, bj = jl >> 7, wc = (jl >> 5) & 3;
            transpose_item(AR->in[I_WIN] + (size_t)l * D * DIN, DIN, D, (bf16*)(C.ws + WS_WIN) + (size_t)l * NZ * D, 64 * kb, n0, 256 * pn + 64 * wc + 32 * bj, scr, C.lane); continue; }
        r -= I_IN;
        if (r < I_OUT) { const int kb = r / 32, nb = r % 32;
            transpose_item(AR->in[I_WOUT] + (size_t)l * D * D, D, D, (bf16*)(C.ws + WS_WOUT) + (size_t)l * D * D, 64 * kb, 32 * nb, 32 * nb, scr, C.lane); continue; }
        r -= I_OUT;
        if (r < I_GU) {
            const int e = r / 512, q = r % 512, kb = q / 32, nb = q % 32, n0 = 32 * nb, pn = n0 >> 8, jl = n0 & 255;
            const float* src = (jl < 128 ? AR->in[I_WEG] : AR->in[I_WEU]) + (size_t)(l * NE + e) * D * DE;
            transpose_item(src, DE, D, (bf16*)(C.ws + WS_WGU) + (size_t)(l * NE + e) * 1024 * D, 64 * kb, n0, 128 * pn + (jl & 127), scr, C.lane); continue; }
        r -= I_GU;
        if (r < I_DN) { const int e = r / 256, q = r % 256, kb = q / 32, nb = q % 32;
            transpose_item(AR->in[I_WED] + (size_t)(l * NE + e) * DE * D, D, DE, (bf16*)(C.ws + WS_WDN) + (size_t)(l * NE + e) * D * DE, 64 * kb, 32 * nb, 32 * nb, scr, C.lane); continue; }
        r -= I_DN;
        if (r < I_PG) { const int kb = r / 32, nb = r % 32;
            transpose_item(AR->in[I_WPG] + (size_t)l * D * D, D, D, (bf16*)(C.ws + WS_WPG) + (size_t)l * D * D, 64 * kb, 32 * nb, 32 * nb, scr, C.lane); continue; }
        r -= I_PG;
        { const int kb = r / 32, nb = r % 32;
            transpose_item(AR->in[I_WPP] + (size_t)l * PLE * D, D, PLE, (bf16*)(C.ws + WS_WPP) + (size_t)l * D * PLE, 64 * kb, 32 * nb, 32 * nb, scr, C.lane); }
    }
    const f32x4* ps = (const f32x4*)AR->in[I_P]; v2u* pd = (v2u*)(C.ws + WS_PB);
    const size_t n4 = (size_t)DEPTH * T * PLE / 4;
    { const size_t st = (size_t)gridDim.x * 512; size_t i = (size_t)blockIdx.x * 512 + C.tid;
      for (; i + 7 * st < n4; i += 8 * st) { f32x4 v[8];
#pragma unroll
          for (int q = 0; q < 8; ++q) v[q] = ps[i + q * st];
#pragma unroll
          for (int q = 0; q < 8; ++q) { v2u o; o.x = pk2(v[q].x, v[q].y); o.y = pk2(v[q].z, v[q].w); pd[i + q * st] = o; } }
      for (; i < n4; i += st) { const f32x4 v = ps[i]; v2u o; o.x = pk2(v.x, v.y); o.y = pk2(v.z, v.w); pd[i] = o; } }
}

__device__ __forceinline__ void load_row(const float* row, int lane, f32x4 (&v)[4]) {
    const f32x4* xr = (const f32x4*)row + lane;
#pragma unroll
    for (int j = 0; j < 4; ++j) v[j] = xr[64 * j];
}
__device__ __forceinline__ float row_rs(const f32x4 (&v)[4]) {
    float s = 0.f;
#pragma unroll
    for (int j = 0; j < 4; ++j) s += (v[j].x * v[j].x + v[j].y * v[j].y) + (v[j].z * v[j].z + v[j].w * v[j].w);
    return rsqrtf(wave_sum(s) * (1.f / D) + EPS);
}
__device__ __forceinline__ void scale_row(f32x4 (&v)[4], float rs, const float* gain, int lane) {
    const f32x4* g = (const f32x4*)gain + lane;
#pragma unroll
    for (int j = 0; j < 4; ++j) v[j] = v[j] * rs * g[64 * j];
}
__device__ __forceinline__ void store_row_bf16(bf16* row, int lane, const f32x4 (&v)[4]) {
    v2u* o = (v2u*)row + lane;
#pragma unroll
    for (int j = 0; j < 4; ++j) { v2u w; w.x = pk2(v[j].x, v[j].y); w.y = pk2(v[j].z, v[j].w); o[64 * j] = w; }
}

__device__ __forceinline__ void phase_norm1(Ctx& C, KA AR, int l) {
    const float* xs = l == 0 ? AR->in[I_X] : (const float*)(C.ws + WS_X);
    const float* gain = AR->in[I_MIXN] + l * D;
    const float* wf = AR->in[I_WIN] + (size_t)l * D * DIN + NZ;
    const float* bfg = AR->in[I_BF] + l * NH;
    bf16* xn = (bf16*)(C.ws + WS_XN); float* logf = (float*)(C.ws + WS_LOGF);
    for (int t = C.gw; t < T; t += C.ngw) {
        f32x4 v[4]; load_row(xs + (size_t)t * D, C.lane, v);
        const float rs = row_rs(v); scale_row(v, rs, gain, C.lane);
        store_row_bf16(xn + (size_t)t * D, C.lane, v);
        float z[8] = {0.f, 0.f, 0.f, 0.f, 0.f, 0.f, 0.f, 0.f};
#pragma unroll
        for (int j = 0; j < 4; ++j)
#pragma unroll
            for (int e = 0; e < 4; ++e) { const int k = 256 * j + 4 * C.lane + e; const f32x4 w0 = *(const f32x4*)(wf + (size_t)k * DIN), w1 = *(const f32x4*)(wf + (size_t)k * DIN + 4);
                const float a = v[j][e]; z[0] += a * w0.x; z[1] += a * w0.y; z[2] += a * w0.z; z[3] += a * w0.w; z[4] += a * w1.x; z[5] += a * w1.y; z[6] += a * w1.z; z[7] += a * w1.w; }
#pragma unroll
        for (int h = 0; h < 8; ++h) z[h] = wave_sum(z[h]);
        float mine = 0.f;
#pragma unroll
        for (int h = 0; h < 8; ++h) mine = (C.lane == h) ? z[h] : mine;
        if (C.lane < 8) logf[(size_t)t * 8 + C.lane] = log_sigmoid(mine + bfg[C.lane]);
    }
}

template <int NACC, class AR, class BR, class EP>
__device__ __forceinline__ void ngemm_tile(LAS float* sm, int K, AR arow, BR brow, EP epi, const int tid) {
    LAS float* As = sm; LAS float* Bs = sm + 32 * 68;
    const int ty = tid >> 4, tx = tid & 15, lr = tid >> 3, lk = (tid & 7) * 4;
    float acc[NACC][2][4];
#pragma unroll
    for (int a = 0; a < NACC; ++a)
#pragma unroll
        for (int i = 0; i < 2; ++i)
#pragma unroll
            for (int j = 0; j < 4; ++j) acc[a][i][j] = 0.f;
    const bf16* ap = arow(lr); const bf16* bp0 = brow(lr, 0); const bf16* bp1 = NACC > 1 ? brow(lr, 1) : bp0;
    for (int k0 = 0; k0 < K; k0 += 32) {
        __syncthreads();
        { v2u av; av.x = 0u; av.y = 0u; if (ap) av = *(const v2u*)(ap + k0 + lk);
          As[(lk + 0) * 68 + lr] = bflo(av.x); As[(lk + 1) * 68 + lr] = bfhi(av.x); As[(lk + 2) * 68 + lr] = bflo(av.y); As[(lk + 3) * 68 + lr] = bfhi(av.y); }
        { const v2u bv = *(const v2u*)(bp0 + k0 + lk);
          Bs[(lk + 0) * 68 + lr] = bflo(bv.x); Bs[(lk + 1) * 68 + lr] = bfhi(bv.x); Bs[(lk + 2) * 68 + lr] = bflo(bv.y); Bs[(lk + 3) * 68 + lr] = bfhi(bv.y); }
        if (NACC > 1) { const v2u bv = *(const v2u*)(bp1 + k0 + lk); LAS float* B1 = Bs + 32 * 68;
          B1[(lk + 0) * 68 + lr] = bflo(bv.x); B1[(lk + 1) * 68 + lr] = bfhi(bv.x); B1[(lk + 2) * 68 + lr] = bflo(bv.y); B1[(lk + 3) * 68 + lr] = bfhi(bv.y); }
        __syncthreads();
#pragma unroll 8
        for (int kk = 0; kk < 32; ++kk) {
            const float a0 = As[kk * 68 + ty * 2], a1 = As[kk * 68 + ty * 2 + 1];
#pragma unroll
            for (int a = 0; a < NACC; ++a) { const f32x4 b = *(const LAS f32x4*)(Bs + a * 32 * 68 + kk * 68 + tx * 4);
#pragma unroll
                for (int j = 0; j < 4; ++j) { acc[a][0][j] += a0 * b[j]; acc[a][1][j] += a1 * b[j]; } }
        }
    }
#pragma unroll
    for (int i = 0; i < 2; ++i)
#pragma unroll
        for (int j = 0; j < 4; ++j) epi(ty * 2 + i, tx * 4 + j, acc[0][i][j], NACC > 1 ? acc[1][i][j] : 0.f);
}

__device__ __forceinline__ void phase_cumsum(Ctx& C, KA AR) {
    if (C.gw < NB * NH) {
        const int b = C.gw / NH, h = C.gw % NH;
        const float* logf = (const float*)(C.ws + WS_LOGF) + (size_t)b * S * 8 + h; float* c2k = (float*)(C.ws + WS_C2K) + (size_t)C.gw * S;
        float s = 0.f;
        for (int i = 0; i < 64; ++i) s += logf[(size_t)(64 * C.lane + i) * 8];
        float inc = s;
#pragma unroll
        for (int o = 1; o < 64; o <<= 1) { const float v = __builtin_bit_cast(float, __builtin_amdgcn_ds_bpermute((C.lane - o) << 2, __builtin_bit_cast(int, inc))); if (C.lane >= o) inc += v; }
        float run = inc - s;
        for (int i = 0; i < 64; ++i) { run += logf[(size_t)(64 * C.lane + i) * 8]; c2k[64 * C.lane + i] = run * LOG2E; }
    }
}
__device__ __forceinline__ void phase_cumsum_fast(Ctx& C, KA AR) {
    const int row = (int)blockIdx.x - (int)gridDim.x / 2;
    if (C.wave == 0 && row >= 0 && row < NB * NH) {
        const float* src = (const float*)(C.ws + WS_LOGF) + (size_t)row * S + C.lane; float* dst = (float*)(C.ws + WS_C2K) + (size_t)row * S + C.lane;
        float run = 0.f;
        for (int it = 0; it < S / 64; it += 8) {
            float v[8];
#pragma unroll
            for (int q = 0; q < 8; ++q) v[q] = src[(it + q) * 64];
#pragma unroll
            for (int q = 0; q < 8; ++q) { float x = v[q];
#pragma unroll
                for (int o = 1; o < 64; o <<= 1) { const float y = __builtin_bit_cast(float, __builtin_amdgcn_ds_bpermute((C.lane - o) << 2, __builtin_bit_cast(int, x))); if (C.lane >= o) x += y; }
                dst[(it + q) * 64] = (run + x) * LOG2E;
                run += __builtin_bit_cast(float, __builtin_amdgcn_readlane(__builtin_bit_cast(int, x), 63)); }
        }
    }
}
__device__ __forceinline__ void phase_gemm1_naive(Ctx& C, KA AR, int l) {
    phase_cumsum(C, AR);
    const bf16* A = (const bf16*)(C.ws + WS_XN); const bf16* Bt = (const bf16*)(C.ws + WS_WIN) + (size_t)l * NZ * D;
    bf16* R1 = (bf16*)(C.ws + WS_R1);
    for (int u = blockIdx.x; u < (T / 64) * (NZ / 64); u += gridDim.x) {
        const int mt = u / (NZ / 64), nt = u % (NZ / 64), m0 = 64 * mt, n0 = 64 * nt;
        ngemm_tile<1>((LAS float*)C.lds, D, [=](int r) { return A + (size_t)(m0 + r) * D; }, [=](int c, int) { return Bt + (size_t)(n0 + c) * D; },
            [=](int r, int c, float v, float) {
                const int j = n0 + c, pn = j >> 8, jl = j & 255, bj = jl >> 7, wc = (jl >> 5) & 3, col = 256 * pn + 64 * wc + 32 * bj + (jl & 31);
                const int seg = col >> 9, cc = col & 511;
                const float o = seg == 1 ? gelu_tanh(v) : v;
                R1[(size_t)seg * T * 512 + (size_t)(m0 + r) * 512 + cc] = (bf16)f2bf(o);
            }, C.tid);
    }
}
__device__ __forceinline__ void phase_qknorm_naive(Ctx& C, KA AR, int l) {
    bf16* Q = (bf16*)(C.ws + WS_R1) + (size_t)2 * T * 512; bf16* Kb = Q + (size_t)T * 512;
    const float* gq = AR->in[I_QN] + l * HD; const float* gk = AR->in[I_KN] + l * HD;
    for (int i = C.gw; i < 2 * T; i += C.ngw) {
        const int t = i >> 1, isk = i & 1; bf16* row = (isk ? Kb : Q) + (size_t)t * 512; const float* g = isk ? gk : gq;
        const v4u w = *(const v4u*)(row + 8 * C.lane);
        float x[8] = {bflo(w.x), bfhi(w.x), bflo(w.y), bfhi(w.y), bflo(w.z), bfhi(w.z), bflo(w.w), bfhi(w.w)};
        float s = 0.f;
#pragma unroll
        for (int e = 0; e < 8; ++e) s += x[e] * x[e];
        s += lane_xor<1>(s); s += lane_xor<2>(s); s += lane_xor<4>(s);
        const float rs = rsqrtf(s * (1.f / 64.f) + EPS) * (isk ? 1.f : C2);
        const int d0 = 8 * (C.lane & 7);
#pragma unroll
        for (int e = 0; e < 8; ++e) x[e] = x[e] * rs * g[d0 + e];
        v4u o; o.x = pk2(x[0], x[1]); o.y = pk2(x[2], x[3]); o.z = pk2(x[4], x[5]); o.w = pk2(x[6], x[7]);
        *(v4u*)(row + 8 * C.lane) = o;
    }
}

template <int MODE>
__device__ __forceinline__ void phase_rnn_naive(Ctx& C, KA AR, int l) {
    LAS float* xcs = (LAS float*)C.lds; LAS float* as = xcs + 64 * 65; LAS float* us = as + 64 * 64;
    const bf16* ZX = (const bf16*)(C.ws + WS_R1); const bf16* ZG = ZX + (size_t)T * 512;
    float* SA = (float*)(C.ws + WS_SA); float* SH = (float*)(C.ws + WS_SH); float* YR = (float*)(C.ws + WS_PROJ);
    const float* cw = AR->in[I_CONVW] + l * 4 * DR; const float* cb = AR->in[I_CONVB] + l * DR;
    const float* wr = AR->in[I_WR] + (size_t)l * 8 * 64 * 64; const float* wi = AR->in[I_WI] + (size_t)l * 8 * 64 * 64;
    const float* br = AR->in[I_BR] + l * DR; const float* bi = AR->in[I_BI] + l * DR; const float* lam = AR->in[I_LAM] + l * DR;
    for (int u = blockIdx.x; u < NB * 64 * 8; u += gridDim.x) {
        const int b = u >> 9, cidx = (u >> 3) & 63, blk = u & 7;
        __syncthreads();
#pragma unroll
        for (int i = 0; i < 8; ++i) { const int e = C.tid + 512 * i, t = e >> 6, c = e & 63, ch = blk * 64 + c, tg = cidx * 64 + t;
            float xc = cb[ch];
#pragma unroll
            for (int j = 0; j < 4; ++j) { const int tt = tg - 3 + j; if (tt >= 0) xc += cw[j * DR + ch] * bf2f(ZX[(size_t)(b * S + tt) * 512 + ch]); }
            xcs[t * 65 + c] = xc; }
        __syncthreads();
#pragma unroll
        for (int i = 0; i < 8; ++i) { const int e = C.tid + 512 * i, t = e >> 6, j = e & 63, ch = blk * 64 + j;
            float ar = br[ch], ai = bi[ch];
            for (int k = 0; k < 64; ++k) { const float x = xcs[t * 65 + k]; ar += x * wr[(size_t)(blk * 64 + k) * 64 + j]; ai += x * wi[(size_t)(blk * 64 + k) * 64 + j]; }
            const float r = sigmoidf_(ar), ig = sigmoidf_(ai);
            const float la = -8.f * r * log1pf(__expf(-lam[ch]));
            as[t * 64 + j] = __expf(la); us[t * 64 + j] = sqrtf(-expm1f(2.f * la)) * (ig * xcs[t * 65 + j]); }
        __syncthreads();
        if (C.tid < 64) { const int j = C.tid, ch = blk * 64 + j;
            if (MODE == 0) { float A = 1.f, H = 0.f;
                for (int t = 0; t < 64; ++t) { const float a = as[t * 64 + j]; H = a * H + us[t * 64 + j]; A *= a; }
                SA[(size_t)(b * 64 + cidx) * 512 + ch] = A; SH[(size_t)(b * 64 + cidx) * 512 + ch] = H;
            } else { float h = 0.f;
                for (int c2 = 0; c2 < cidx; ++c2) h = SA[(size_t)(b * 64 + c2) * 512 + ch] * h + SH[(size_t)(b * 64 + c2) * 512 + ch];
                for (int t = 0; t < 64; ++t) { h = as[t * 64 + j] * h + us[t * 64 + j]; as[t * 64 + j] = h; } } }
        if (MODE == 1) { __syncthreads();
#pragma unroll
            for (int i = 0; i < 8; ++i) { const int e = C.tid + 512 * i, t = e >> 6, c = e & 63, ch = blk * 64 + c; const size_t row = (size_t)(b * S + cidx * 64 + t);
                YR[row * 512 + ch] = as[t * 64 + c] * bf2f(ZG[row * 512 + ch]); } }
    }
}

__device__ __forceinline__ void phase_attn_naive(Ctx& C, KA AR, int l) {
    LAS float* Ks = (LAS float*)C.lds; LAS float* Vs = Ks + 64 * 65; LAS float* Qs = Vs + 64 * 65; LAS float* Ps = Qs + 64 * 64; LAS float* cks = Ps + 8 * 64;
    const bf16* Q = (const bf16*)(C.ws + WS_R1) + (size_t)2 * T * 512; const bf16* Kb = Q + (size_t)T * 512; const bf16* Vb = Kb + (size_t)T * 512;
    bf16* O = (bf16*)(C.ws + WS_R2); const float* c2k = (const float*)(C.ws + WS_C2K);
    for (int u = blockIdx.x; u < NB * NH * 64; u += gridDim.x) {
        const int qt = 63 - (u >> 5), bh = u & 31, b = bh >> 3, h = bh & 7, q0 = 64 * qt;
        const float* ck = c2k + (size_t)bh * S;
        __syncthreads();
        for (int e = C.tid; e < 64 * 64; e += 512) { const int r = e >> 6, d = e & 63; Qs[r * 64 + d] = bf2f(Q[(size_t)(b * S + q0 + r) * 512 + h * 64 + d]); }
        float m[8], lsum[8], o[8], cq[8];
#pragma unroll
        for (int i = 0; i < 8; ++i) { m[i] = -INFINITY; lsum[i] = 0.f; o[i] = 0.f; cq[i] = ck[q0 + C.wave * 8 + i]; }
        for (int kt = 0; kt <= qt; ++kt) {
            const int k0 = 64 * kt;
            __syncthreads();
            for (int e = C.tid; e < 64 * 64; e += 512) { const int r = e >> 6, d = e & 63; const size_t g = (size_t)(b * S + k0 + r) * 512 + h * 64 + d; Ks[r * 65 + d] = bf2f(Kb[g]); Vs[r * 65 + d] = bf2f(Vb[g]); }
            if (C.tid < 64) cks[C.tid] = ck[k0 + C.tid];
            __syncthreads();
#pragma unroll
            for (int i = 0; i < 8; ++i) {
                const int q = C.wave * 8 + i, qg = q0 + q;
                float dot = 0.f;
#pragma unroll 16
                for (int d = 0; d < 64; ++d) dot += Qs[q * 64 + d] * Ks[C.lane * 65 + d];
                float s = dot + cq[i] - cks[C.lane];
                if (k0 + C.lane > qg) s = -INFINITY;
                const float mn = fmaxf(m[i], wave_max(s));
                const float alpha = exp2f(m[i] - mn), p = exp2f(s - mn);
                lsum[i] = lsum[i] * alpha + wave_sum(p); m[i] = mn;
                Ps[C.wave * 64 + C.lane] = p;
                asm volatile("s_waitcnt lgkmcnt(0)" ::: "memory");
                float acc = 0.f;
#pragma unroll 16
                for (int k = 0; k < 64; ++k) acc += Ps[C.wave * 64 + k] * Vs[k * 65 + C.lane];
                o[i] = o[i] * alpha + acc;
                asm volatile("s_waitcnt lgkmcnt(0)" ::: "memory");
            }
        }
#pragma unroll
        for (int i = 0; i < 8; ++i) O[(size_t)(b * S + q0 + C.wave * 8 + i) * 512 + h * 64 + C.lane] = (bf16)f2bf(o[i] / lsum[i]);
    }
}

__device__ __forceinline__ void phase_mixnorm_naive(Ctx& C, KA AR, int l) {
    const float* YR = (const float*)(C.ws + WS_PROJ); const bf16* O = (const bf16*)(C.ws + WS_R2); bf16* YM = (bf16*)(C.ws + WS_R2 + 16 * MiB);
    const float* g1 = AR->in[I_LRUN] + l * DR; const float* g2 = AR->in[I_ATTN] + l * DA;
    for (int t = C.gw; t < T; t += C.ngw) {
        f32x4 a[2]; float s = 0.f;
#pragma unroll
        for (int j = 0; j < 2; ++j) { a[j] = *((const f32x4*)(YR + (size_t)t * 512) + C.lane + 64 * j); s += (a[j].x * a[j].x + a[j].y * a[j].y) + (a[j].z * a[j].z + a[j].w * a[j].w); }
        float rs = rsqrtf(wave_sum(s) * (1.f / 512.f) + EPS);
#pragma unroll
        for (int j = 0; j < 2; ++j) { const f32x4 g = *((const f32x4*)g1 + C.lane + 64 * j); const f32x4 v = a[j] * rs * g; v2u w; w.x = pk2(v.x, v.y); w.y = pk2(v.z, v.w);
            *((v2u*)(YM + (size_t)t * D) + C.lane + 64 * j) = w; }
        const v4u w = *(const v4u*)(O + (size_t)t * 512 + 8 * C.lane);
        float x[8] = {bflo(w.x), bfhi(w.x), bflo(w.y), bfhi(w.y), bflo(w.z), bfhi(w.z), bflo(w.w), bfhi(w.w)};
        s = 0.f;
#pragma unroll
        for (int e = 0; e < 8; ++e) s += x[e] * x[e];
        rs = rsqrtf(wave_sum(s) * (1.f / 512.f) + EPS);
#pragma unroll
        for (int e = 0; e < 8; ++e) x[e] = x[e] * rs * g2[8 * C.lane + e];
        v4u o; o.x = pk2(x[0], x[1]); o.y = pk2(x[2], x[3]); o.z = pk2(x[4], x[5]); o.w = pk2(x[6], x[7]);
        *(v4u*)(YM + (size_t)t * D + 512 + 8 * C.lane) = o;
    }
}

__device__ __forceinline__ void phase_wo_naive(Ctx& C, KA AR, int l) {
    const bf16* A = (const bf16*)(C.ws + WS_R2 + 16 * MiB); const bf16* Bt = (const bf16*)(C.ws + WS_WOUT) + (size_t)l * D * D;
    const float* xs = l == 0 ? AR->in[I_X] : (const float*)(C.ws + WS_X); float* X = (float*)(C.ws + WS_X);
    for (int u = blockIdx.x; u < (T / 64) * (D / 64); u += gridDim.x) {
        const int m0 = 64 * (u / (D / 64)), n0 = 64 * (u % (D / 64));
        ngemm_tile<1>((LAS float*)C.lds, D, [=](int r) { return A + (size_t)(m0 + r) * D; }, [=](int c, int) { return Bt + (size_t)(n0 + c) * D; },
            [=](int r, int c, float v, float) { const size_t i = (size_t)(m0 + r) * D + n0 + c; X[i] = xs[i] + v; }, C.tid);
    }
}

__device__ __forceinline__ void phase_router(Ctx& C, KA AR, int l) {
    const float* X = (const float*)(C.ws + WS_X); bf16* xn = (bf16*)(C.ws + WS_XN);
    const float* gain = AR->in[I_FFNN] + l * D; const float* wg = AR->in[I_WG] + (size_t)l * D * 4; const float* bg = AR->in[I_BG] + l * 4;
    const float* wr = AR->in[I_WRT] + (size_t)l * D * NE; const float* brt = AR->in[I_BRT] + l * NE;
    unsigned* cnt = (unsigned*)(C.ws + WS_CTL) + CW_CNT + 32 * CNT_STRIDE * l; int* rowpair = (int*)(C.ws + WS_ROWPAIR); float* pairw = (float*)(C.ws + WS_PAIRW);
    for (int t = C.gw; t < T; t += C.ngw) {
        f32x4 v[4]; load_row(X + (size_t)t * D, C.lane, v);
        const float rs = row_rs(v); scale_row(v, rs, gain, C.lane);
        store_row_bf16(xn + (size_t)t * D, C.lane, v);
        LAS float* rowl = (LAS float*)C.lds + C.wave * 1024;
#pragma unroll
        for (int j = 0; j < 4; ++j) *((LAS f32x4*)rowl + C.lane + 64 * j) = v[j];
        asm volatile("s_waitcnt lgkmcnt(0)" ::: "memory");
        float acc = 0.f;
        if (C.lane < 36) {
            const float* wp = C.lane < 32 ? wr + C.lane : wg + (C.lane - 32); const int st = C.lane < 32 ? NE : 4;
#pragma unroll 8
            for (int k = 0; k < D; ++k) acc += rowl[k] * wp[(size_t)k * st];
            acc += C.lane < 32 ? brt[C.lane] : bg[C.lane - 32];
        }
        asm volatile("s_waitcnt lgkmcnt(0)" ::: "memory");
        float gl[4];
#pragma unroll
        for (int i = 0; i < 4; ++i) gl[i] = __builtin_bit_cast(float, __builtin_amdgcn_readlane(__builtin_bit_cast(int, acc), 32 + i));
        int gi = 0; float gm = gl[0];
#pragma unroll
        for (int i = 1; i < 4; ++i) if (gl[i] > gm) { gm = gl[i]; gi = i; }
        float gs = 0.f;
#pragma unroll
        for (int i = 0; i < 4; ++i) gs += __expf(gl[i] - gm);
        const float gp = 1.f / gs;
        float ev[8];
#pragma unroll
        for (int i = 0; i < 8; ++i) ev[i] = __builtin_bit_cast(float, __builtin_amdgcn_readlane(__builtin_bit_cast(int, acc), __builtin_amdgcn_readfirstlane(gi) * 8 + i));
        int i0 = 0; float t0 = ev[0];
#pragma unroll
        for (int i = 1; i < 8; ++i) if (ev[i] > t0) { t0 = ev[i]; i0 = i; }
        int i1 = -1; float t1 = -INFINITY;
#pragma unroll
        for (int i = 0; i < 8; ++i) if (i != i0 && ev[i] > t1) { t1 = ev[i]; i1 = i; }
        const float ex = __expf(t1 - t0), w0 = gp / (1.f + ex), w1 = gp * ex / (1.f + ex);
        if (C.lane < 2) { const int e = gi * 8 + (C.lane == 0 ? i0 : i1); const unsigned pos = atomicAdd(cnt + e * CNT_STRIDE, 1u);
            rowpair[(size_t)e * CAP + pos] = 2 * t + C.lane; pairw[2 * t + C.lane] = C.lane == 0 ? w0 : w1; }
    }
}

struct ExpTab { int n[NE], hoff[NE], t0[NE + 1]; };
__device__ __forceinline__ void build_exptab(Ctx& C, int l, LAS int* tab) {
    __syncthreads();
    if (C.tid == 0) { const unsigned* cnt = (const unsigned*)(C.ws + WS_CTL) + CW_CNT + 32 * CNT_STRIDE * l; int ho = 0, tt = 0;
        for (int e = 0; e < NE; ++e) { const int n = (int)__hip_atomic_load(cnt + e * CNT_STRIDE, __ATOMIC_RELAXED, __HIP_MEMORY_SCOPE_AGENT); tab[e] = n; tab[32 + e] = ho; tab[64 + e] = tt; ho += (n + 255) & ~255; tt += (n + 63) >> 6; }
        tab[64 + NE] = tt; }
    __syncthreads();
}
__device__ __forceinline__ void phase_g1_naive(Ctx& C, KA AR, int l) {
    LAS int* tab = (LAS int*)(C.lds + 65536); build_exptab(C, l, tab);
    const bf16* xn = (const bf16*)(C.ws + WS_XN); const int* rowpair = (const int*)(C.ws + WS_ROWPAIR); bf16* Hb = (bf16*)(C.ws + WS_R2);
    const int nmt = tab[64 + NE];
    for (int u = blockIdx.x; u < nmt * 8; u += gridDim.x) {
        const int mtg = u >> 3, nt = u & 7; int e = 0;
        for (int i = 1; i < NE; ++i) if (tab[64 + i] <= mtg) e = i;
        const int mt = mtg - tab[64 + e], ne = tab[e], ho = tab[32 + e], p0 = 64 * mt, c0 = 64 * nt;
        const bf16* Bt = (const bf16*)(C.ws + WS_WGU) + (size_t)(l * NE + e) * 1024 * D; const int* rp = rowpair + (size_t)e * CAP;
        ngemm_tile<2>((LAS float*)C.lds, D,
            [=](int r) { return (p0 + r < ne) ? xn + (size_t)(rp[p0 + r] >> 1) * D : (const bf16*)nullptr; },
            [=](int c, int a) { const int cc = c0 + c; return Bt + (size_t)((cc >> 7) * 256 + (cc & 127) + a * 128) * D; },
            [=](int r, int c, float g, float uu) { if (p0 + r < ne) Hb[(size_t)(ho + p0 + r) * DE + c0 + c] = (bf16)f2bf(g / (1.f + __expf(-g)) * uu); }, C.tid);
    }
}
__device__ __forceinline__ void phase_g2_naive(Ctx& C, KA AR, int l) {
    LAS int* tab = (LAS int*)(C.lds + 65536); build_exptab(C, l, tab);
    const int* rowpair = (const int*)(C.ws + WS_ROWPAIR); const float* pairw = (const float*)(C.ws + WS_PAIRW); const bf16* Hb = (const bf16*)(C.ws + WS_R2); bf16* Y2 = (bf16*)(C.ws + WS_R1);
    const int nmt = tab[64 + NE];
    for (int u = blockIdx.x; u < nmt * 16; u += gridDim.x) {
        const int mtg = u >> 4, nt = u & 15; int e = 0;
        for (int i = 1; i < NE; ++i) if (tab[64 + i] <= mtg) e = i;
        const int mt = mtg - tab[64 + e], ne = tab[e], ho = tab[32 + e], p0 = 64 * mt, c0 = 64 * nt;
        const bf16* Bt = (const bf16*)(C.ws + WS_WDN) + (size_t)(l * NE + e) * D * DE; const int* rp = rowpair + (size_t)e * CAP;
        ngemm_tile<1>((LAS float*)C.lds, DE,
            [=](int r) { return (p0 + r < ne) ? Hb + (size_t)(ho + p0 + r) * DE : (const bf16*)nullptr; },
            [=](int c, int) { return Bt + (size_t)(c0 + c) * DE; },
            [=](int r, int c, float v, float) { if (p0 + r < ne) { const int p = rp[p0 + r]; Y2[(size_t)p * D + c0 + c] = (bf16)f2bf(v * pairw[p]); } }, C.tid);
    }
}

__device__ __forceinline__ void phase_combine(Ctx& C, KA AR, int l) {
    float* X = (float*)(C.ws + WS_X); const bf16* Y2 = (const bf16*)(C.ws + WS_R1); bf16* xn = (bf16*)(C.ws + WS_XN); const float* gain = AR->in[I_PLEN] + l * D;
    for (int t = 2 * C.gw; t < T; t += 2 * C.ngw) {
        f32x4 v[2][4]; v2u ya[2][4], yb[2][4];
#pragma unroll
        for (int q = 0; q < 2; ++q) { load_row(X + (size_t)(t + q) * D, C.lane, v[q]);
#pragma unroll
            for (int j = 0; j < 4; ++j) { ya[q][j] = *((const v2u*)(Y2 + (size_t)(2 * (t + q)) * D) + C.lane + 64 * j); yb[q][j] = *((const v2u*)(Y2 + (size_t)(2 * (t + q) + 1) * D) + C.lane + 64 * j); } }
#pragma unroll
        for (int q = 0; q < 2; ++q) {
#pragma unroll
            for (int j = 0; j < 4; ++j) { const v2u a = ya[q][j], b = yb[q][j];
                v[q][j].x += bflo(a.x) + bflo(b.x); v[q][j].y += bfhi(a.x) + bfhi(b.x); v[q][j].z += bflo(a.y) + bflo(b.y); v[q][j].w += bfhi(a.y) + bfhi(b.y);
                *((f32x4*)(X + (size_t)(t + q) * D) + C.lane + 64 * j) = v[q][j]; }
            const float rs = row_rs(v[q]); scale_row(v[q], rs, gain, C.lane);
            store_row_bf16(xn + (size_t)(t + q) * D, C.lane, v[q]); }
    }
}

__device__ __forceinline__ void phase_proj_naive(Ctx& C, KA AR, int l) {
    const bf16* A = (const bf16*)(C.ws + WS_PB) + (size_t)l * T * PLE; const bf16* Bt = (const bf16*)(C.ws + WS_WPP) + (size_t)l * D * PLE; bf16* PR = (bf16*)(C.ws + WS_PROJ);
    for (int u = blockIdx.x; u < (T / 64) * (D / 64); u += gridDim.x) {
        const int m0 = 64 * (u / (D / 64)), n0 = 64 * (u % (D / 64));
        ngemm_tile<1>((LAS float*)C.lds, PLE, [=](int r) { return A + (size_t)(m0 + r) * PLE; }, [=](int c, int) { return Bt + (size_t)(n0 + c) * PLE; },
            [=](int r, int c, float v, float) { PR[(size_t)(m0 + r) * D + n0 + c] = (bf16)f2bf(v); }, C.tid);
    }
}
__device__ __forceinline__ void phase_ple_naive(Ctx& C, KA AR, int l) {
    const bf16* A = (const bf16*)(C.ws + WS_XN); const bf16* Bt = (const bf16*)(C.ws + WS_WPG) + (size_t)l * D * D; const bf16* PR = (const bf16*)(C.ws + WS_PROJ);
    const float* X = (const float*)(C.ws + WS_X); float* dst = l == DEPTH - 1 ? AR->out : (float*)(C.ws + WS_X); const float* bias = AR->in[I_BPG] + l * D;
    for (int u = blockIdx.x; u < (T / 64) * (D / 64); u += gridDim.x) {
        const int m0 = 64 * (u / (D / 64)), n0 = 64 * (u % (D / 64));
        ngemm_tile<1>((LAS float*)C.lds, D, [=](int r) { return A + (size_t)(m0 + r) * D; }, [=](int c, int) { return Bt + (size_t)(n0 + c) * D; },
            [=](int r, int c, float v, float) { const size_t i = (size_t)(m0 + r) * D + n0 + c; dst[i] = X[i] + bf2f(PR[i]) * sigmoidf_(v + bias[n0 + c]); }, C.tid);
    }
}

namespace pg8 {
typedef unsigned short bf16_t;
typedef short bf16x8 __attribute__((ext_vector_type(8)));
typedef unsigned u32x4 __attribute__((ext_vector_type(4)));
constexpr int BM = 256, BK = 64, HALF = 128, HTB = HALF * BK * 2, STAGE_BYTES = 8 * HTB, NXCD = 8, WGM = 8;
__device__ __forceinline__ int lds_byte(int r, int c) { const int st = (r >> 4) * 2 + (c >> 5), rr = r & 15, cc = c & 31, ob = rr * 64 + cc * 2; return st * 1024 + (ob ^ (((ob >> 9) & 1) << 5)); }
__device__ __forceinline__ void stage_rc(int b, int& R, int& C) { const int st = b / 1024, sb = b % 1024, swz = sb ^ (((sb >> 9) & 1) << 5); R = (st >> 1) * 16 + swz / 64; C = (st & 1) * 32 + (swz % 64) / 2; }
__device__ __forceinline__ int perm32(int rho) { const int n = rho >> 4, i = rho & 15; return 8 * (i >> 2) + 4 * n + (i & 3); }
struct Unit { int pm, pn, e, aux, mt; };
struct Gemm { const bf16_t* A; const bf16_t* Bt; int K; };
struct StaticOrder {
    int nM, nN, nwg, G, c;
    __device__ void init(int M, int N, int G_, int c_) { nM = M / BM; nN = N / BM; nwg = nM * nN; G = G_; c = c_; }
    __device__ bool next(int i, Unit& u) const {
        const long L = (long)i * G + c; if (L >= nwg) return false;
        int wgid = (int)L; { const int q = nwg / NXCD, r = nwg % NXCD, xcd = wgid % NXCD, off = wgid / NXCD; wgid = (xcd < r ? xcd * (q + 1) : r * (q + 1) + (xcd - r) * q) + off; }
        const int nig = WGM * nN, gid = wgid / nig, fm = gid * WGM, gsz = (nM - fm) < WGM ? (nM - fm) : WGM;
        u.pm = fm + ((wgid % nig) % gsz); u.pn = (wgid % nig) / gsz; u.e = 0; u.aux = 256; u.mt = 0; return true;
    }
    __device__ __forceinline__ const char* a_base(const Gemm& g, const Unit& u) const { return (const char*)g.A + (size_t)u.pm * 512 * g.K; }
    __device__ __forceinline__ const char* b_base(const Gemm& g, const Unit& u) const { return (const char*)g.Bt + (size_t)u.pn * 512 * g.K; }
    __device__ __forceinline__ int a_row(const Unit&, int) const { return 0; }
};
__device__ __forceinline__ unsigned cvt_pk_bf16(float lo, float hi) { unsigned r; asm volatile("v_cvt_pk_bf16_f32 %0, %1, %2" : "=v"(r) : "v"(lo), "v"(hi)); return r; }

template <class Epi, class Sched, bool ALIGN_EPI, bool GATHER>
__device__ __forceinline__ void gemm_phase(LAS unsigned char* lds, const Gemm g, const Sched& S, const Epi& E, const int tid) {
    const int wid = __builtin_amdgcn_readfirstlane(tid >> 6), lane = tid & 63, wr = wid >> 2, wc = wid & 3, fr = lane & 15, fq = lane >> 4;
    const int K = g.K, nt = K / BK;
    unsigned voffB[2];
#pragma unroll
    for (int i = 0; i < 2; ++i) { int R, C; stage_rc(tid * 16 + i * 8192, R, C); const int Rb = Epi::PERM ? ((R & ~31) + perm32(R & 31)) : R; voffB[i] = (unsigned)(Rb * K + C) * 2u; }
    const size_t kstep = (size_t)(BK * 2);
    const size_t hstep = (size_t)HALF * K * 2;
    const size_t hsA = GATHER ? 0 : hstep;
    const unsigned ldsw = (unsigned)wid * 1024u;
    const int aoff = lds_byte(wr * 64 + fr, fq * 8), boff = lds_byte(wc * 32 + fr, fq * 8);
#define PG8_SA(b, h) (((b) * 2 + (h)) * HTB)
#define PG8_SB(b, h) ((4 + (b) * 2 + (h)) * HTB)
#define PG8_STAGE(bufoff, gbase, voff) do { _Pragma("unroll") for (int _i = 0; _i < 2; ++_i) \
        __builtin_amdgcn_global_load_lds((const unsigned*)((const char*)(gbase) + (voff)[_i]), (LAS unsigned*)(lds + (bufoff) + ldsw + _i * 8192), 16, 0, 0); } while (0)
#define PG8_LDA(dst, b, h) do { _Pragma("unroll") for (int m = 0; m < 4; ++m) _Pragma("unroll") for (int k = 0; k < 2; ++k) dst[m][k] = *(const LAS bf16x8*)(lds + PG8_SA(b, h) + aoff + m * 2048 + k * 1024); } while (0)
#define PG8_LDB(dst, b, h) do { _Pragma("unroll") for (int n = 0; n < 2; ++n) _Pragma("unroll") for (int k = 0; k < 2; ++k) dst[n][k] = *(const LAS bf16x8*)(lds + PG8_SB(b, h) + boff + n * 2048 + k * 1024); } while (0)
#define PG8_MMA(ai, bj, At, Bt) do { __builtin_amdgcn_s_setprio(1); _Pragma("unroll") for (int m = 0; m < 4; ++m) _Pragma("unroll") for (int n = 0; n < 2; ++n) _Pragma("unroll") for (int k = 0; k < 2; ++k) \
        acc[ai][bj][m][n] = __builtin_amdgcn_mfma_f32_16x16x32_bf16(Bt[n][k], At[m][k], acc[ai][bj][m][n], 0, 0, 0); __builtin_amdgcn_s_setprio(0); } while (0)
#define PG8_WAIT_V(n) asm volatile("s_waitcnt vmcnt(" #n ")" ::: "memory")
#define PG8_WAIT_L(n) asm volatile("s_waitcnt lgkmcnt(" #n ")" ::: "memory")
#define PG8_BAR __builtin_amdgcn_s_barrier()
#define PG8_SCHED __builtin_amdgcn_sched_barrier(0)
#define PG8_VOFF(dst, u) do { int t_ = tid; if (GATHER) asm volatile("" : "+v"(t_));   \
        _Pragma("unroll") for (int i_ = 0; i_ < 2; ++i_) { int R_, C_; stage_rc(t_ * 16 + i_ * 8192, R_, C_); _Pragma("unroll") for (int h_ = 0; h_ < 2; ++h_) \
        dst[h_][i_] = GATHER ? (unsigned)(S.a_row(u, h_ * HALF + R_) * K + C_) * 2u : (unsigned)(R_ * K + C_) * 2u; } } while (0)
    Unit cur, nxt; int ui = 0;
    if (!S.next(0, cur)) return;
    f32x4 acc[2][2][4][2];
#pragma unroll
    for (int a = 0; a < 2; ++a)
#pragma unroll
        for (int b = 0; b < 2; ++b)
#pragma unroll
            for (int m = 0; m < 4; ++m)
#pragma unroll
                for (int n = 0; n < 2; ++n) acc[a][b][m][n] = (f32x4){0.f, 0.f, 0.f, 0.f};
    bf16x8 At[4][2], B0[2][2], B1[2][2];
    unsigned vC[2][2], vN[2][2], vX[2][2];
    PG8_VOFF(vC, cur);
    const char* cA = S.a_base(g, cur); const char* cB = S.b_base(g, cur);
    PG8_STAGE(PG8_SB(0, 0), cB, voffB); PG8_STAGE(PG8_SB(0, 1), cB + hstep, voffB); PG8_STAGE(PG8_SA(0, 0), cA, vC[0]); PG8_STAGE(PG8_SA(0, 1), cA + hsA, vC[1]);
    if (wr == 1) PG8_BAR;
    PG8_WAIT_V(2); PG8_BAR;
    PG8_STAGE(PG8_SB(1, 0), cB + kstep, voffB); PG8_STAGE(PG8_SA(1, 0), cA + kstep, vC[0]); PG8_STAGE(PG8_SB(1, 1), cB + hstep + kstep, voffB);
    PG8_WAIT_V(6); PG8_BAR;
    for (;;) {
        const bool has_next = S.next(ui + 1, nxt);
        const char* nA = has_next ? S.a_base(g, nxt) : cA; const char* nB = has_next ? S.b_base(g, nxt) : cB;
        if (GATHER && has_next) { PG8_VOFF(vN, nxt); }
        else {
#pragma unroll
            for (int h_ = 0; h_ < 2; ++h_)
#pragma unroll
                for (int i_ = 0; i_ < 2; ++i_) vN[h_][i_] = vC[h_][i_]; }
#pragma unroll 1
        for (int t = 0; t < nt; t += 2) {
            const bool last = (t == nt - 2);
            const char* a1 = cA + (size_t)(t + 1) * kstep;
            const char* a2 = last ? nA : cA + (size_t)(t + 2) * kstep; const char* b2 = last ? nB : cB + (size_t)(t + 2) * kstep;
            const char* a3 = a2 + kstep; const char* b3 = b2 + kstep;
#pragma unroll
            for (int h_ = 0; h_ < 2; ++h_)
#pragma unroll
                for (int i_ = 0; i_ < 2; ++i_) vX[h_][i_] = (GATHER && last) ? vN[h_][i_] : vC[h_][i_];
            PG8_LDB(B0, 0, 0); PG8_LDB(B1, 0, 1); PG8_SCHED; PG8_LDA(At, 0, 0); PG8_STAGE(PG8_SA(1, 1), a1 + hsA, vC[1]);
            PG8_WAIT_V(8); PG8_WAIT_L(0); PG8_BAR; PG8_MMA(0, 0, At, B0); PG8_MMA(0, 1, At, B1); PG8_BAR; PG8_SCHED;
            PG8_LDA(At, 0, 1); PG8_STAGE(PG8_SB(0, 0), b2, voffB); PG8_STAGE(PG8_SB(0, 1), b2 + hstep, voffB); PG8_STAGE(PG8_SA(0, 0), a2, vX[0]);
            PG8_WAIT_V(8); PG8_WAIT_L(0); PG8_BAR; PG8_MMA(1, 0, At, B0); PG8_MMA(1, 1, At, B1); PG8_BAR; PG8_SCHED;
            PG8_LDB(B0, 1, 0); PG8_LDB(B1, 1, 1); PG8_SCHED; PG8_LDA(At, 1, 0); PG8_STAGE(PG8_SA(0, 1), a2 + hsA, vX[1]);
            PG8_WAIT_V(8); PG8_WAIT_L(0); PG8_BAR; PG8_MMA(0, 0, At, B0); PG8_MMA(0, 1, At, B1); PG8_BAR; PG8_SCHED;
            PG8_LDA(At, 1, 1); PG8_STAGE(PG8_SB(1, 0), b3, voffB); PG8_STAGE(PG8_SB(1, 1), b3 + hstep, voffB); PG8_STAGE(PG8_SA(1, 0), a3, vX[0]);
            PG8_WAIT_V(8); PG8_WAIT_L(0); PG8_BAR; PG8_MMA(1, 0, At, B0); PG8_MMA(1, 1, At, B1); PG8_BAR; PG8_SCHED;
        }
        if constexpr (ALIGN_EPI) { if (wr == 0) PG8_BAR; }
        E(acc, cur, wr, wc, fr, fq);
        if (!has_next) break;
#pragma unroll
        for (int a = 0; a < 2; ++a)
#pragma unroll
            for (int b = 0; b < 2; ++b)
#pragma unroll
                for (int m = 0; m < 4; ++m)
#pragma unroll
                    for (int n = 0; n < 2; ++n) acc[a][b][m][n] = (f32x4){0.f, 0.f, 0.f, 0.f};
        cur = nxt; cA = nA; cB = nB; ++ui;
#pragma unroll
        for (int h_ = 0; h_ < 2; ++h_)
#pragma unroll
            for (int i_ = 0; i_ < 2; ++i_) vC[h_][i_] = vN[h_][i_];
        if constexpr (ALIGN_EPI) { if (wr == 1) PG8_BAR; }
    }
    PG8_WAIT_V(0);
    if constexpr (!ALIGN_EPI) { if (wr == 0) PG8_BAR; }
    PG8_BAR;
#undef PG8_SA
#undef PG8_SB
#undef PG8_STAGE
#undef PG8_LDA
#undef PG8_LDB
#undef PG8_MMA
#undef PG8_WAIT_V
#undef PG8_WAIT_L
#undef PG8_BAR
#undef PG8_SCHED
#undef PG8_VOFF
}
}

__device__ __forceinline__ float gelu_fast(float v) { const float y = 0.7978845608028654f * (v + 0.044715f * v * v * v); return v * __builtin_amdgcn_rcpf(1.f + __expf(-2.f * y)); }
__device__ __forceinline__ float sigmoid_fast(float v) { return __builtin_amdgcn_rcpf(1.f + __expf(-v)); }

struct EpiZ {
    static constexpr bool PERM = true;
    bf16* R1; const float* gq; const float* gk;
    __device__ __forceinline__ void operator()(const f32x4 (&acc)[2][2][4][2], const pg8::Unit& u, int wr, int wc, int fr, int fq) const {
        const int seg = u.pn >> 1;
        bf16* base = R1 + (size_t)seg * T * 512 + (size_t)(u.pm * 256 + wr * 64 + fr) * 512 + (u.pn & 1) * 256 + wc * 64 + 8 * fq;
        if (seg == 2 || seg == 3) {
            const float* g = seg == 2 ? gq : gk; const float sc = seg == 2 ? C2 : 1.f;
            f32x4 gv[2][2];
#pragma unroll
            for (int bj = 0; bj < 2; ++bj)
#pragma unroll
                for (int n = 0; n < 2; ++n) gv[bj][n] = *(const f32x4*)(g + 32 * bj + 8 * fq + 4 * n);
#pragma unroll
            for (int ai = 0; ai < 2; ++ai)
#pragma unroll
                for (int m = 0; m < 4; ++m) {
                    float s = 0.f;
#pragma unroll
                    for (int bj = 0; bj < 2; ++bj)
#pragma unroll
                        for (int n = 0; n < 2; ++n) { const f32x4 x = acc[ai][bj][m][n]; s += (x[0] * x[0] + x[1] * x[1]) + (x[2] * x[2] + x[3] * x[3]); }
                    s += lane_xor<16>(s); s = half_sum32(s);
                    const float rs = rsqrtf(s * (1.f / 64.f) + EPS) * sc;
#pragma unroll
                    for (int bj = 0; bj < 2; ++bj) { const f32x4 v0 = acc[ai][bj][m][0] * rs * gv[bj][0], v1 = acc[ai][bj][m][1] * rs * gv[bj][1];
                        v4u w; w.x = pg8::cvt_pk_bf16(v0[0], v0[1]); w.y = pg8::cvt_pk_bf16(v0[2], v0[3]); w.z = pg8::cvt_pk_bf16(v1[0], v1[1]); w.w = pg8::cvt_pk_bf16(v1[2], v1[3]);
                        *(v4u*)(base + (size_t)(ai * 128 + m * 16) * 512 + 32 * bj) = w; }
                }
        } else {
#pragma unroll
            for (int ai = 0; ai < 2; ++ai)
#pragma unroll
                for (int m = 0; m < 4; ++m)
#pragma unroll
                    for (int bj = 0; bj < 2; ++bj) { f32x4 v0 = acc[ai][bj][m][0], v1 = acc[ai][bj][m][1];
                        if (seg == 1) { v0 = (f32x4){gelu_fast(v0[0]), gelu_fast(v0[1]), gelu_fast(v0[2]), gelu_fast(v0[3])}; v1 = (f32x4){gelu_fast(v1[0]), gelu_fast(v1[1]), gelu_fast(v1[2]), gelu_fast(v1[3])}; }
                        v4u w; w.x = pg8::cvt_pk_bf16(v0[0], v0[1]); w.y = pg8::cvt_pk_bf16(v0[2], v0[3]); w.z = pg8::cvt_pk_bf16(v1[0], v1[1]); w.w = pg8::cvt_pk_bf16(v1[2], v1[3]);
                        *(v4u*)(base + (size_t)(ai * 128 + m * 16) * 512 + 32 * bj) = w; }
        }
    }
};
__device__ __forceinline__ void phase_gemm1_fast(Ctx& C, KA AR, int l) {
    phase_cumsum_fast(C, AR);
    pg8::Gemm g{(const bf16*)(C.ws + WS_XN), (const bf16*)(C.ws + WS_WIN) + (size_t)l * NZ * D, D};
    pg8::StaticOrder S; S.init(T, NZ, gridDim.x, blockIdx.x);
    EpiZ E{(bf16*)(C.ws + WS_R1), AR->in[I_QN] + l * HD, AR->in[I_KN] + l * HD};
    pg8::gemm_phase<EpiZ, pg8::StaticOrder, true, false>(C.lds, g, S, E, C.tid);
}
struct EpiRes {
    static constexpr bool PERM = false;
    const float* xs; float* X;
    __device__ __forceinline__ void operator()(const f32x4 (&acc)[2][2][4][2], const pg8::Unit& u, int wr, int wc, int fr, int fq) const {
        const size_t off0 = (size_t)(u.pm * 256 + wr * 64 + fr) * D + u.pn * 256 + wc * 32 + 4 * fq;
#pragma unroll
        for (int ai = 0; ai < 2; ++ai)
#pragma unroll
            for (int m = 0; m < 4; ++m)
#pragma unroll
                for (int bj = 0; bj < 2; ++bj)
#pragma unroll
                    for (int n = 0; n < 2; ++n) { const size_t o = off0 + (size_t)(ai * 128 + m * 16) * D + bj * 128 + n * 16; *(f32x4*)(X + o) = *(const f32x4*)(xs + o) + acc[ai][bj][m][n]; }
    }
};
__device__ __forceinline__ void phase_wo_fast(Ctx& C, KA AR, int l) {
    pg8::Gemm g{(const bf16*)(C.ws + WS_R2 + 16 * MiB), (const bf16*)(C.ws + WS_WOUT) + (size_t)l * D * D, D};
    pg8::StaticOrder S; S.init(T, D, gridDim.x, blockIdx.x);
    EpiRes E{l == 0 ? AR->in[I_X] : (const float*)(C.ws + WS_X), (float*)(C.ws + WS_X)};
    pg8::gemm_phase<EpiRes, pg8::StaticOrder, true, false>(C.lds, g, S, E, C.tid);
}
struct EpiProj {
    static constexpr bool PERM = true;
    bf16* PR;
    __device__ __forceinline__ void operator()(const f32x4 (&acc)[2][2][4][2], const pg8::Unit& u, int wr, int wc, int fr, int fq) const {
        bf16* base = PR + (size_t)(u.pm * 256 + wr * 64 + fr) * D + u.pn * 256 + wc * 32 + 8 * fq;
#pragma unroll
        for (int ai = 0; ai < 2; ++ai)
#pragma unroll
            for (int m = 0; m < 4; ++m)
#pragma unroll
                for (int bj = 0; bj < 2; ++bj) { const f32x4 v0 = acc[ai][bj][m][0], v1 = acc[ai][bj][m][1];
                    v4u w; w.x = pg8::cvt_pk_bf16(v0[0], v0[1]); w.y = pg8::cvt_pk_bf16(v0[2], v0[3]); w.z = pg8::cvt_pk_bf16(v1[0], v1[1]); w.w = pg8::cvt_pk_bf16(v1[2], v1[3]);
                    *(v4u*)(base + (size_t)(ai * 128 + m * 16) * D + bj * 128) = w; }
    }
};
__device__ __forceinline__ void phase_proj_fast(Ctx& C, KA AR, int l) {
    pg8::Gemm g{(const bf16*)(C.ws + WS_PB) + (size_t)l * T * PLE, (const bf16*)(C.ws + WS_WPP) + (size_t)l * D * PLE, PLE};
    pg8::StaticOrder S;
    { const int G = gridDim.x, hb = G / 2; if ((int)blockIdx.x >= hb) S.init(T, D, G - hb, (int)blockIdx.x - hb); else S.init(T, D, G - hb, T); }
    EpiProj E{(bf16*)(C.ws + WS_PROJ)};
    pg8::gemm_phase<EpiProj, pg8::StaticOrder, true, false>(C.lds, g, S, E, C.tid);
}
struct EpiPle {
    static constexpr bool PERM = false;
    const float* X; const bf16* PR; const float* bias; float* dst; float pscale;
    __device__ __forceinline__ void operator()(const f32x4 (&acc)[2][2][4][2], const pg8::Unit& u, int wr, int wc, int fr, int fq) const {
        const int col0 = u.pn * 256 + wc * 32 + 4 * fq;
        const size_t off0 = (size_t)(u.pm * 256 + wr * 64 + fr) * D + col0;
#pragma unroll
        for (int bj = 0; bj < 2; ++bj)
#pragma unroll
            for (int n = 0; n < 2; ++n) { const f32x4 bv = *(const f32x4*)(bias + col0 + bj * 128 + n * 16);
#pragma unroll
                for (int ai = 0; ai < 2; ++ai)
#pragma unroll
                    for (int m = 0; m < 4; ++m) { const size_t o = off0 + (size_t)(ai * 128 + m * 16) * D + bj * 128 + n * 16;
                        const v2u pw = *(const v2u*)(PR + o); const f32x4 a = acc[ai][bj][m][n] + bv; const f32x4 x = *(const f32x4*)(X + o);
                        f32x4 r; r[0] = x[0] + bflo(pw.x) * sigmoid_fast(a[0]); r[1] = x[1] + bfhi(pw.x) * sigmoid_fast(a[1]); r[2] = x[2] + bflo(pw.y) * sigmoid_fast(a[2]); r[3] = x[3] + bfhi(pw.y) * sigmoid_fast(a[3]);
                        if (PROBE_TIMING) r = r * pscale;
                        *(f32x4*)(dst + o) = r; } }
    }
};
__device__ __forceinline__ void phase_ple_fast(Ctx& C, KA AR, int l) {
    pg8::Gemm g{(const bf16*)(C.ws + WS_XN), (const bf16*)(C.ws + WS_WPG) + (size_t)l * D * D, D};
    pg8::StaticOrder S; S.init(T, D, gridDim.x, blockIdx.x);
    float pscale = 1.f;
    if (PROBE_TIMING && l == DEPTH - 1) { const unsigned long long* ts = (const unsigned long long*)((const unsigned*)(C.ws + WS_CTL) + CW_TS); pscale = 1.f + (float)(ts[PROBE_HI] - ts[PROBE_LO]) * 1.5e-6f; }
    EpiPle E{(const float*)(C.ws + WS_X), (const bf16*)(C.ws + WS_PROJ), AR->in[I_BPG] + l * D, l == DEPTH - 1 ? AR->out : (float*)(C.ws + WS_X), pscale};
    pg8::gemm_phase<EpiPle, pg8::StaticOrder, true, false>(C.lds, g, S, E, C.tid);
}
constexpr int TAB_OFF = MISC_OFF - 4096;
struct GroupOrder {
    const LAS int* tab; int G, c; const int* rowpair; const char* hbase; bool is_g2;
    __device__ bool next(int i, pg8::Unit& u) const {
        int j = i * (G >> 3) + (c >> 3);
#pragma unroll
        for (int q = 0; q < 4; ++q) { const int e = (c & 7) + 8 * q;
            const int t0 = __builtin_amdgcn_readfirstlane(tab[64 + e]), t1 = __builtin_amdgcn_readfirstlane(tab[64 + e + 1]), nu = (t1 - t0) * 4;
            if (j < nu) { const int mt = j >> 2; const int ne = __builtin_amdgcn_readfirstlane(tab[e]), ho = __builtin_amdgcn_readfirstlane(tab[32 + e]);
                int nv = ne - 256 * mt; nv = nv > 256 ? 256 : nv;
                u.pm = ho + 256 * mt; u.pn = j & 3; u.e = e; u.aux = nv; u.mt = mt; return true; }
            j -= nu; }
        return false;
    }
    __device__ __forceinline__ const char* a_base(const pg8::Gemm& g, const pg8::Unit& u) const { return is_g2 ? (const char*)g.A + (size_t)u.pm * 2 * g.K : (const char*)g.A; }
    __device__ __forceinline__ const char* b_base(const pg8::Gemm& g, const pg8::Unit& u) const { return (const char*)g.Bt + (size_t)(u.e * 1024 + u.pn * 256) * 2 * g.K; }
    __device__ __forceinline__ int a_row(const pg8::Unit& u, int r) const { return r < u.aux ? (rowpair[(size_t)u.e * CAP + u.mt * 256 + r] >> 1) : 0; }
};
__device__ __forceinline__ void build_exptab256(Ctx& C, int l, LAS int* tab) {
    __syncthreads();
    if (C.tid == 0) { const unsigned* cnt = (const unsigned*)(C.ws + WS_CTL) + CW_CNT + 32 * CNT_STRIDE * l; int ho = 0, tt = 0;
        for (int e = 0; e < NE; ++e) { const int n = (int)__hip_atomic_load(cnt + e * CNT_STRIDE, __ATOMIC_RELAXED, __HIP_MEMORY_SCOPE_AGENT); tab[e] = n; tab[32 + e] = ho; tab[64 + e] = tt;
            const int nt = (n + 255) >> 8; for (int j = 0; j < nt; ++j) tab[128 + tt + j] = e | (j << 8); ho += nt << 8; tt += nt; }
        tab[64 + NE] = tt; }
    __syncthreads();
}
struct EpiG1 {
    static constexpr bool PERM = true;
    bf16* Hb;
    __device__ __forceinline__ void operator()(const f32x4 (&acc)[2][2][4][2], const pg8::Unit& u, int wr, int wc, int fr, int fq) const {
        bf16* base = Hb + (size_t)(u.pm + wr * 64 + fr) * DE + u.pn * 128 + wc * 32 + 8 * fq;
#pragma unroll
        for (int ai = 0; ai < 2; ++ai)
#pragma unroll
            for (int m = 0; m < 4; ++m) { const int rl = ai * 128 + wr * 64 + m * 16 + fr;
                f32x4 h0, h1;
#pragma unroll
                for (int e = 0; e < 4; ++e) { const float g0 = acc[ai][0][m][0][e], g1 = acc[ai][0][m][1][e]; h0[e] = g0 * sigmoid_fast(g0) * acc[ai][1][m][0][e]; h1[e] = g1 * sigmoid_fast(g1) * acc[ai][1][m][1][e]; }
                v4u w; w.x = pg8::cvt_pk_bf16(h0[0], h0[1]); w.y = pg8::cvt_pk_bf16(h0[2], h0[3]); w.z = pg8::cvt_pk_bf16(h1[0], h1[1]); w.w = pg8::cvt_pk_bf16(h1[2], h1[3]);
                if (rl < u.aux) *(v4u*)(base + (size_t)(ai * 128 + m * 16) * DE) = w; }
    }
};
__device__ __forceinline__ void phase_g1_fast(Ctx& C, KA AR, int l) {
    LAS int* tab = (LAS int*)(C.lds + TAB_OFF); build_exptab256(C, l, tab);
    pg8::Gemm g{(const bf16*)(C.ws + WS_XN), (const bf16*)(C.ws + WS_WGU) + (size_t)l * NE * 1024 * D, D};
    GroupOrder S{tab, (int)gridDim.x, (int)blockIdx.x, (const int*)(C.ws + WS_ROWPAIR), nullptr, false};
    EpiG1 E{(bf16*)(C.ws + WS_R2)};
    pg8::gemm_phase<EpiG1, GroupOrder, true, true>(C.lds, g, S, E, C.tid);
}
struct EpiG2 {
    static constexpr bool PERM = true;
    bf16* Y2; const int* rowpair; const float* pairw;
    __device__ __forceinline__ void operator()(const f32x4 (&acc)[2][2][4][2], const pg8::Unit& u, int wr, int wc, int fr, int fq) const {
        const int* rp = rowpair + (size_t)u.e * CAP + u.mt * 256; const int col0 = u.pn * 256 + wc * 32 + 8 * fq;
        int pr[2][4]; float wv[2][4];
#pragma unroll
        for (int ai = 0; ai < 2; ++ai)
#pragma unroll
            for (int m = 0; m < 4; ++m) { const int rl = ai * 128 + wr * 64 + m * 16 + fr; pr[ai][m] = rl < u.aux ? rp[rl] : 0; }
#pragma unroll
        for (int ai = 0; ai < 2; ++ai)
#pragma unroll
            for (int m = 0; m < 4; ++m) wv[ai][m] = pairw[pr[ai][m]];
#pragma unroll
        for (int ai = 0; ai < 2; ++ai)
#pragma unroll
            for (int m = 0; m < 4; ++m) { const int rl = ai * 128 + wr * 64 + m * 16 + fr;
                if (rl < u.aux) { const float w8 = wv[ai][m]; bf16* row = Y2 + (size_t)pr[ai][m] * D + col0;
#pragma unroll
                    for (int bj = 0; bj < 2; ++bj) { const f32x4 v0 = acc[ai][bj][m][0] * w8, v1 = acc[ai][bj][m][1] * w8;
                        v4u w; w.x = pg8::cvt_pk_bf16(v0[0], v0[1]); w.y = pg8::cvt_pk_bf16(v0[2], v0[3]); w.z = pg8::cvt_pk_bf16(v1[0], v1[1]); w.w = pg8::cvt_pk_bf16(v1[2], v1[3]);
                        *(v4u*)(row + bj * 128) = w; } } }
    }
};
__device__ __forceinline__ void phase_g2_fast(Ctx& C, KA AR, int l) {
    LAS int* tab = (LAS int*)(C.lds + TAB_OFF); build_exptab256(C, l, tab);
    pg8::Gemm g{(const bf16*)(C.ws + WS_R2), (const bf16*)(C.ws + WS_WDN) + (size_t)l * NE * D * DE, DE};
    GroupOrder S{tab, (int)gridDim.x, (int)blockIdx.x, (const int*)(C.ws + WS_ROWPAIR), nullptr, true};
    EpiG2 E{(bf16*)(C.ws + WS_R1), (const int*)(C.ws + WS_ROWPAIR), (const float*)(C.ws + WS_PAIRW)};
    pg8::gemm_phase<EpiG2, GroupOrder, true, false>(C.lds, g, S, E, C.tid);
}

#define SBAR() __builtin_amdgcn_sched_barrier(0)
namespace attn_body {
using bf16=__hip_bfloat16;
using bf16x8=__attribute__((ext_vector_type(8)))short;
using s16x4=__attribute__((ext_vector_type(4)))short;
using f32x16=__attribute__((ext_vector_type(16)))float;
using u32x4=__attribute__((ext_vector_type(4)))unsigned;
constexpr int BATCH=4,NHEAD=8,SEQ=4096,D=64,DM=NHEAD*D;
constexpr int NW=8,QBLK=32,QB=QBLK*NW,KVBLK=64,NQB=SEQ/QB;
constexpr int ATTN_PITCH=DM, ATTN_UNIT_ROWS=QB;
__device__ __forceinline__ int crow(int r,int hi){return (r&3)+8*(r>>2)+4*hi;}
#define SBAR() __builtin_amdgcn_sched_barrier(0)
__device__ __forceinline__ void cmask(f32x16&p0,f32x16&p1,int jb,int qrel,int hi){
  const float NEG=-INFINITY; int kb=64*jb+4*hi;
  #pragma unroll
  for(int r=0;r<16;++r){int kv=kb+(r&3)+8*(r>>2); if(kv>qrel)p0[r]=NEG; if(kv+32>qrel)p1[r]=NEG;}
}

constexpr int NSLOT=3, SLOTB=8192;
constexpr int LDS_K=0, LDS_V=NSLOT*SLOTB, LDS_WS=2*NSLOT*SLOTB, LDS_OST=LDS_WS+NW*64*4, LDS_CK=LDS_OST+NW*4096, LDS_BYTES=LDS_CK+SEQ*4;
constexpr float C2=0.125f*1.4426950408889634f;
__device__ __forceinline__ void glds16(const void*gsrc,unsigned lds_dst){unsigned keep;
  asm volatile("s_mov_b32 %0, m0\n\ts_mov_b32 m0, %2\n\ts_nop 0\n\tglobal_load_lds_dwordx4 %1, off\n\ts_mov_b32 m0, %0":"=&s"(keep):"v"(gsrc),"s"(lds_dst):"memory");}
__device__ __forceinline__ float max3f(float a,float b,float c){float r;asm("v_max3_f32 %0, %1, %2, %3":"=v"(r):"v"(a),"v"(b),"v"(c));return r;}
__device__ __forceinline__ float max2f(float a,float b){float r;asm("v_max_f32_e32 %0, %1, %2":"=v"(r):"v"(a),"v"(b));return r;}
__device__ __forceinline__ float fadd_s(float a,float b){float r;asm("v_add_f32_e32 %0, %1, %2":"=v"(r):"v"(a),"v"(b));return r;}
__device__ __forceinline__ float fsub_s(float a,float b){float r;asm("v_sub_f32_e32 %0, %1, %2":"=v"(r):"v"(a),"v"(b));return r;}
typedef float f32x2_t __attribute__((ext_vector_type(2))); typedef __bf16 bf16x2_t __attribute__((ext_vector_type(2)));
__device__ __forceinline__ unsigned cvtpk_s(float lo,float hi){f32x2_t v={lo,hi};bf16x2_t b=__builtin_convertvector(v,bf16x2_t);return __builtin_bit_cast(unsigned,b);}
#define WAIT_BAR(N) asm volatile("s_waitcnt vmcnt(" #N ") lgkmcnt(0)\n\ts_barrier":::"memory")

__device__ __forceinline__ void qkt(f32x16&p0,f32x16&p1,const char*Kslot,const bf16x8*qr,const f32x16&negm,int r32,int hi){
  const char*kb=Kslot+hi*1024+r32*16;
  #pragma unroll
  for(int d0=0;d0<4;++d0){
    const bf16x8 b0=*reinterpret_cast<const bf16x8*>(kb+d0*2048);
    const bf16x8 b1=*reinterpret_cast<const bf16x8*>(kb+d0*2048+512);
    if(d0==0){p0=__builtin_amdgcn_mfma_f32_32x32x16_bf16(b0,qr[0],negm,0,0,0);p1=__builtin_amdgcn_mfma_f32_32x32x16_bf16(b1,qr[0],negm,0,0,0);}
    else{p0=__builtin_amdgcn_mfma_f32_32x32x16_bf16(b0,qr[d0],p0,0,0,0);p1=__builtin_amdgcn_mfma_f32_32x32x16_bf16(b1,qr[d0],p1,0,0,0);}}
}
typedef __attribute__((address_space(3))) const char* lds_cptr;
typedef short v4i16_t __attribute__((ext_vector_type(4)));
__device__ __forceinline__ void kload8(bf16x8*kf,lds_cptr kp){
  kf[0]=*(const __attribute__((address_space(3))) bf16x8*)(kp);      kf[1]=*(const __attribute__((address_space(3))) bf16x8*)(kp+512);
  kf[2]=*(const __attribute__((address_space(3))) bf16x8*)(kp+2048); kf[3]=*(const __attribute__((address_space(3))) bf16x8*)(kp+2560);
  kf[4]=*(const __attribute__((address_space(3))) bf16x8*)(kp+4096); kf[5]=*(const __attribute__((address_space(3))) bf16x8*)(kp+4608);
  kf[6]=*(const __attribute__((address_space(3))) bf16x8*)(kp+6144); kf[7]=*(const __attribute__((address_space(3))) bf16x8*)(kp+6656);
}
__device__ __forceinline__ void kload2(bf16x8*kf,lds_cptr kp,int j){ kf[2*j]=*(const __attribute__((address_space(3))) bf16x8*)(kp+j*2048); kf[2*j+1]=*(const __attribute__((address_space(3))) bf16x8*)(kp+j*2048+512); }
__device__ __forceinline__ s16x4 vtr(lds_cptr p){ return __builtin_bit_cast(s16x4,__builtin_amdgcn_ds_read_tr16_b64_v4i16((__attribute__((address_space(3))) v4i16_t*)p)); }
__device__ __forceinline__ float rowmax(const f32x16&p0,const f32x16&p1){
  float a=max3f(p0[0],p0[1],p1[0]),b=max3f(p0[2],p0[3],p1[1]);a=max3f(a,p1[2],p1[3]);
  #pragma unroll
  for(int r=4;r<16;r+=4){a=max3f(a,p0[r],p0[r+1]);b=max3f(b,p0[r+2],p0[r+3]);a=max3f(a,p1[r],p1[r+1]);b=max3f(b,p1[r+2],p1[r+3]);}
  const float m=max2f(a,b);
  auto rr=__builtin_amdgcn_permlane32_swap(__float_as_uint(m),__float_as_uint(m),false,false);
  return max2f(__uint_as_float(rr[0]),__uint_as_float(rr[1]));
}
__device__ __forceinline__ void pv(f32x16*o,int vb,bf16x8 pa0,bf16x8 pa1,bf16x8 pa2,bf16x8 pa3){
  #pragma unroll
  for(int d0=0;d0<2;++d0){s16x4 lo[4],hi[4];
    #pragma unroll
    for(int ks=0;ks<4;++ks){
      asm volatile("ds_read_b64_tr_b16 %0,%1 offset:%c2":"=&v"(lo[ks]):"v"(vb),"i"(d0*4096+ks*1024):"memory");
      asm volatile("ds_read_b64_tr_b16 %0,%1 offset:%c2":"=&v"(hi[ks]):"v"(vb),"i"(d0*4096+ks*1024+512):"memory");}
    asm volatile("s_waitcnt lgkmcnt(0)":::"memory");SBAR();
    #define PK(k) (bf16x8){lo[k][0],lo[k][1],lo[k][2],lo[k][3],hi[k][0],hi[k][1],hi[k][2],hi[k][3]}
    o[d0]=__builtin_amdgcn_mfma_f32_32x32x16_bf16(pa0,PK(0),o[d0],0,0,0);
    o[d0]=__builtin_amdgcn_mfma_f32_32x32x16_bf16(pa1,PK(1),o[d0],0,0,0);
    o[d0]=__builtin_amdgcn_mfma_f32_32x32x16_bf16(pa2,PK(2),o[d0],0,0,0);
    o[d0]=__builtin_amdgcn_mfma_f32_32x32x16_bf16(pa3,PK(3),o[d0],0,0,0);
    #undef PK
  }
}

#ifndef ATTN_STORE16
#define ATTN_STORE16(p,v) (*(u32x4*)(p)=(v))
#endif
template<int THRL> __device__ __forceinline__ void attn_unit(int b,int h,int qb,const bf16*Q,const bf16*__restrict__ K,const bf16*__restrict__ V,bf16*O,const float*__restrict__ C2K,const float thr2,char*shm,const int tid){
  const int lane=tid&63,r32=lane&31,hi=lane>>5; const int wid=__builtin_amdgcn_readfirstlane(tid>>6);
  const long rowbase=(long)b*SEQ; const int q0=qb*QB;
  const bf16*Qw=Q+(rowbase+q0+wid*QBLK)*DM+h*D;
  const int NT0=(q0+QB)/KVBLK;
  const float*ckg0=C2K+(long)(b*NHEAD+h)*SEQ; float base=ckg0[q0+(tid>>6)*QBLK+r32];
  int ts; { const float cl=lane<NT0?ckg0[KVBLK*lane+KVBLK-1]:ckg0[q0]; const unsigned long long mk=__builtin_amdgcn_ballot_w64(lane<NT0&&(ckg0[q0]-cl>=-thr2));
    ts=mk?(int)__builtin_ctzll(mk):NT0-4; ts&=~1; ts=ts>NT0-4?NT0-4:ts; ts=__builtin_amdgcn_readfirstlane(ts); }
  const int NT=NT0-ts;
  const bf16*Kh=K+(rowbase+(long)ts*KVBLK)*DM+h*D,*Vh=V+(rowbase+(long)ts*KVBLK)*DM+h*D; const float*ckg=ckg0+ts*KVBLK;
  typedef __attribute__((address_space(3))) float lds_f32; typedef float f32x4_t __attribute__((ext_vector_type(4)));
  lds_f32*const nbl=(lds_f32*)((__attribute__((address_space(3))) char*)shm+LDS_CK);
  for(int i=tid;i<NT*KVBLK;i+=NW*64)nbl[i]=-ckg[i];
  const unsigned lds0=(unsigned)(uintptr_t)shm;
  float*wsf=(float*)(shm+LDS_WS)+wid*64;
  const bf16*ksrc=Kh+(long)lane*DM+wid*8;
  const bf16*vsrc=Vh+(long)(16*(wid&3)+(lane>>2))*DM+(wid>>2)*32+(lane&3)*8;
  const unsigned kdst=lds0+LDS_K+wid*1024, vdst=lds0+LDS_V+wid*1024;
  #define DMA_K(t,slot) glds16(ksrc+(long)(t)*KVBLK*DM,(unsigned)__builtin_amdgcn_readfirstlane(kdst+(slot)))
  #define DMA_V(t,slot) glds16(vsrc+(long)(t)*KVBLK*DM,(unsigned)__builtin_amdgcn_readfirstlane(vdst+(slot)))
  const int vb0=(int)(lds0+LDS_V)+((lane>>4)&1)*32+(lane&3)*8+(4*hi+((lane&15)>>2))*64;
  const char*Kbase=shm+LDS_K; bf16x8 kf[8];
  const lds_cptr shm3=(lds_cptr)shm; const lds_cptr kp0=shm3+LDS_K+hi*1024+r32*16; const lds_cptr vp0=shm3+LDS_V+((lane>>4)&1)*32+(lane&3)*8+(4*hi+((lane&15)>>2))*64;
  DMA_K(0,0);DMA_V(0,0);DMA_K(1,SLOTB);
  bf16x8 qr[4];
  #pragma unroll
  for(int d0=0;d0<4;++d0)qr[d0]=*reinterpret_cast<const bf16x8*>(&Qw[(long)r32*DM+d0*16+hi*8]);
  float l_reg=0.f;f32x16 o[2];o[0]=f32x16{};o[1]=f32x16{};const f32x16 negm=f32x16{};
  const int qrel=wid*QBLK+r32;
  #define CMASK(P0,P1,t) do{int jb_=(t)-(NT-4); if(jb_>=0)cmask(P0,P1,jb_,qrel,hi);}while(0)
  #define KBIAS(P0,P1,t) do{ const lds_f32*nb_=nbl+64*(t)+4*hi; _Pragma("unroll") for(int g_=0;g_<4;++g_){ \
    { const f32x4_t b0_=*(const __attribute__((address_space(3))) f32x4_t*)(nb_+8*g_); _Pragma("unroll") for(int j_=0;j_<4;++j_)P0[4*g_+j_]+=(b0_[j_]+base); } SBAR(); \
    { const f32x4_t b1_=*(const __attribute__((address_space(3))) f32x4_t*)(nb_+32+8*g_); _Pragma("unroll") for(int j_=0;j_<4;++j_)P1[4*g_+j_]+=(b1_[j_]+base); } SBAR(); } }while(0)
  bool resc=false;
  #define START(P0,P1) do{ const float rm=rowmax(P0,P1); resc=false; \
    { const float dl=rm; base=fsub_s(base,dl); \
      _Pragma("unroll") for(int r=0;r<16;++r){P0[r]=fsub_s(P0[r],dl);P1[r]=fsub_s(P1[r],dl);} \
      } \
    _Pragma("unroll") for(int r=0;r<16;++r)P0[r]=__builtin_amdgcn_exp2f(P0[r]); }while(0)
  #define RESC() do{ if(resc){ asm volatile("s_waitcnt lgkmcnt(0)":::"memory"); \
      _Pragma("unroll") for(int d_=0;d_<2;++d_) _Pragma("unroll") for(int r=0;r<16;++r)o[d_][r]*=wsf[crow(r,hi)]; } }while(0)
  f32x16 pA0,pA1,pB0,pB1;
  int sl_prev=0,sl_cur=0,sl_next=SLOTB;
  #define ROT() do{sl_prev=sl_cur;sl_cur=sl_next;sl_next=(sl_next==(NSLOT-1)*SLOTB)?0:sl_next+SLOTB;}while(0)
  DMA_K(2,2*SLOTB);
  WAIT_BAR(3);
  qkt(pA0,pA1,Kbase,qr,negm,r32,hi);asm volatile("s_nop 15\n\ts_nop 7":"+v"(pA0),"+v"(pA1));KBIAS(pA0,pA1,0);CMASK(pA0,pA1,0);
  START(pA0,pA1);
  _Pragma("unroll") for(int r=0;r<16;++r)pA1[r]=__builtin_amdgcn_exp2f(pA1[r]);
  WAIT_BAR(0);
  DMA_K(3,0);DMA_V(1,SLOTB);
  ROT();
  kload8(kf,kp0+sl_cur);
  WAIT_BAR(2);
  s16x4 vlo[8],vhi[8]; u32x4 pw0,pw1,pw2,pw3;
  #define PKW(P,B) cvtpk_s(P[B],P[B+1])
  #define PAF(k) __builtin_bit_cast(bf16x8,pw##k)
  #define VFR(i) (bf16x8){vlo[i][0],vlo[i][1],vlo[i][2],vlo[i][3],vhi[i][0],vhi[i][1],vhi[i][2],vhi[i][3]}
  #define PIN(x) asm volatile("":"+v"(x))
  #define MX3(a,b,c) __builtin_fmaxf(__builtin_fmaxf((a),(b)),(c))
  #define GAPA(MF,A0,A1,A2,A3,W0,W1,PW) do{ MF; sacc+=A0; sacc+=A1; sacc+=A2; sacc+=A3; PIN(sacc); W0; W1; PIN(PW); SBAR(); }while(0)
  #define EX(v) __builtin_amdgcn_exp2f(v)
  #define GAPB(MF,X,B) do{ MF; X[B]=EX(X[B]); X[B+1]=EX(X[B+1]); X[B+2]=EX(X[B+2]); X[B+3]=EX(X[B+3]); PIN(X); SBAR(); }while(0)
  #define VRD(i) do{ vlo[i]=vtr(vp_+(((i)>>2)*4096+((i)&3)*1024)); vhi[i]=vtr(vp_+(((i)>>2)*4096+((i)&3)*1024+512)); }while(0)
  #define KRD(G,j) do{ if(G){ kload2(kf,kp0+sl_next,j); SBAR(); } }while(0)
  #define STEP(C0,C1,P0,P1,t,GK,GV,GL) do{ SBAR(); \
    const lds_cptr vp_=vp0+sl_prev; \
    VRD(0); SBAR(); float sacc=(P0[0]+P0[1]); \
    GAPA(C0=__builtin_amdgcn_mfma_f32_32x32x16_bf16(kf[0],qr[0],negm,0,0,0), P0[2],P0[3],P0[4],P0[5],     pw0[0]=PKW(P0,0), pw0[1]=PKW(P0,2), pw0); \
    VRD(4); SBAR(); GAPA(C1=__builtin_amdgcn_mfma_f32_32x32x16_bf16(kf[1],qr[0],negm,0,0,0), P0[6],P0[7],P0[8],P0[9],     pw0[2]=PKW(P0,4), pw0[3]=PKW(P0,6), pw0); \
    VRD(1); SBAR(); GAPA(C0=__builtin_amdgcn_mfma_f32_32x32x16_bf16(kf[2],qr[1],C0,0,0,0),   P0[10],P0[11],P0[12],P0[13], pw1[0]=PKW(P0,8), pw1[1]=PKW(P0,10), pw1); \
    VRD(5); SBAR(); GAPA(C1=__builtin_amdgcn_mfma_f32_32x32x16_bf16(kf[3],qr[1],C1,0,0,0),   P0[14],P0[15],P1[0],P1[1],   pw1[2]=PKW(P0,12),pw1[3]=PKW(P0,14), pw1); \
    VRD(2); SBAR(); GAPA(C0=__builtin_amdgcn_mfma_f32_32x32x16_bf16(kf[4],qr[2],C0,0,0,0),   P1[2],P1[3],P1[4],P1[5],     pw2[0]=PKW(P1,0), pw2[1]=PKW(P1,2), pw2); \
    VRD(6); SBAR(); GAPA(C1=__builtin_amdgcn_mfma_f32_32x32x16_bf16(kf[5],qr[2],C1,0,0,0),   P1[6],P1[7],P1[8],P1[9],     pw2[2]=PKW(P1,4), pw2[3]=PKW(P1,6), pw2); \
    VRD(3); SBAR(); GAPA(C0=__builtin_amdgcn_mfma_f32_32x32x16_bf16(kf[6],qr[3],C0,0,0,0),   P1[10],P1[11],P1[12],P1[13], pw3[0]=PKW(P1,8), pw3[1]=PKW(P1,10), pw3); \
    VRD(7); SBAR(); GAPA(C1=__builtin_amdgcn_mfma_f32_32x32x16_bf16(kf[7],qr[3],C1,0,0,0),   P1[14],P1[15],0.f,0.f,       pw3[2]=PKW(P1,12),pw3[3]=PKW(P1,14), pw3); \
    l_reg+=sacc; \
    if(GK){DMA_K((t)+3,sl_cur);} if(GV){DMA_V((t)+1,sl_next);} \
    KBIAS(C0,C1,t); \
    CMASK(C0,C1,t); \
    { float a=MX3(C0[0],C0[1],C1[0]),b=MX3(C0[2],C0[3],C1[1]); a=MX3(a,C1[2],C1[3]); \
      _Pragma("unroll") for(int r=4;r<16;r+=4){a=MX3(a,C0[r],C0[r+1]);b=MX3(b,C0[r+2],C0[r+3]);a=MX3(a,C1[r],C1[r+1]);b=MX3(b,C1[r+2],C1[r+3]);} \
      float rm=__builtin_fmaxf(a,b); { auto rr=__builtin_amdgcn_permlane32_swap(__float_as_uint(rm),__float_as_uint(rm),false,false); rm=__builtin_fmaxf(__uint_as_float(rr[0]),__uint_as_float(rr[1])); } \
      resc=false; \
      if(__builtin_expect(__any(rm>(float)THRL),0)){ const float dl=__builtin_fmaxf(rm,0.f); base-=dl; \
        _Pragma("unroll") for(int r=0;r<16;++r){C0[r]-=dl;C1[r]-=dl;} \
        const float f=__builtin_amdgcn_exp2f(-dl); l_reg*=f; if(hi==0)wsf[r32]=f; resc=true; } } \
    SBAR(); \
    GAPB(o[0]=__builtin_amdgcn_mfma_f32_32x32x16_bf16(PAF(0),VFR(0),o[0],0,0,0), C0,0); \
    GAPB(o[1]=__builtin_amdgcn_mfma_f32_32x32x16_bf16(PAF(0),VFR(4),o[1],0,0,0), C0,4); \
    KRD(GL,0); GAPB(o[0]=__builtin_amdgcn_mfma_f32_32x32x16_bf16(PAF(1),VFR(1),o[0],0,0,0), C0,8); \
    KRD(GL,1); GAPB(o[1]=__builtin_amdgcn_mfma_f32_32x32x16_bf16(PAF(1),VFR(5),o[1],0,0,0), C0,12); \
    KRD(GL,2); GAPB(o[0]=__builtin_amdgcn_mfma_f32_32x32x16_bf16(PAF(2),VFR(2),o[0],0,0,0), C1,0); \
    KRD(GL,3); GAPB(o[1]=__builtin_amdgcn_mfma_f32_32x32x16_bf16(PAF(2),VFR(6),o[1],0,0,0), C1,4); \
    GAPB(o[0]=__builtin_amdgcn_mfma_f32_32x32x16_bf16(PAF(3),VFR(3),o[0],0,0,0), C1,8); \
    GAPB(o[1]=__builtin_amdgcn_mfma_f32_32x32x16_bf16(PAF(3),VFR(7),o[1],0,0,0), C1,12); \
    }while(0)
  int t=1;
  #undef CMASK
  #define CMASK(P0,P1,t) do{}while(0)
  for(;t+5<NT;t+=2){
    STEP(pB0,pB1,pA0,pA1,t,true,true,true);     WAIT_BAR(2); RESC(); ROT();
    STEP(pA0,pA1,pB0,pB1,t+1,true,true,true);   WAIT_BAR(2); RESC(); ROT();
  }
  #undef CMASK
  #define CMASK(P0,P1,t) do{int jb_=(t)-(NT-4); if(jb_>=0)cmask(P0,P1,jb_,qrel,hi);}while(0)
  #define ENDW(tt) do{ if((tt)+3<NT){WAIT_BAR(2);} else if((tt)+2<NT){WAIT_BAR(1);} else {WAIT_BAR(0);} }while(0)
  for(;t+1<NT;t+=2){
    STEP(pB0,pB1,pA0,pA1,t,(t+3<NT),(t+1<NT),(t+1<NT));       ENDW(t);   RESC(); ROT();
    STEP(pA0,pA1,pB0,pB1,t+1,(t+4<NT),(t+2<NT),(t+2<NT));     ENDW(t+1); RESC(); ROT();
  }
  STEP(pB0,pB1,pA0,pA1,NT-1,false,false,false); RESC();
  { float sacc=pB0[0]+pB0[1]; _Pragma("unroll") for(int r=2;r<16;++r)sacc+=pB0[r]; _Pragma("unroll") for(int r=0;r<16;++r)sacc+=pB1[r]; l_reg+=sacc;
    pw0=(u32x4){PKW(pB0,0),PKW(pB0,2),PKW(pB0,4),PKW(pB0,6)};pw1=(u32x4){PKW(pB0,8),PKW(pB0,10),PKW(pB0,12),PKW(pB0,14)};pw2=(u32x4){PKW(pB1,0),PKW(pB1,2),PKW(pB1,4),PKW(pB1,6)};pw3=(u32x4){PKW(pB1,8),PKW(pB1,10),PKW(pB1,12),PKW(pB1,14)};
    SBAR(); pv(o,vb0+sl_cur,PAF(0),PAF(1),PAF(2),PAF(3)); }
  #undef PKW
  #undef PAF
  #undef VFR
  #undef PIN
  #undef MX3
  #undef GAPA
  #undef GAPB
  #undef EX
  #undef VRD
  #undef KRD
  #undef STEP
  #undef ENDW
  {auto rr=__builtin_amdgcn_permlane32_swap(__float_as_uint(l_reg),__float_as_uint(l_reg),false,false);l_reg=__uint_as_float(rr[0])+__uint_as_float(rr[1]);}
  if(hi==0)wsf[32+r32]=l_reg;asm volatile("s_waitcnt lgkmcnt(0)":::"memory");
  float rli[16];
  #pragma unroll
  for(int r=0;r<16;++r)rli[r]=__builtin_amdgcn_rcpf(wsf[32+crow(r,hi)]);
  bf16*Ow=O+(rowbase+q0+wid*QBLK)*DM+h*D;
  { bf16*stg=(bf16*)(shm+LDS_OST)+wid*2048;
    #pragma unroll
    for(int r=0;r<16;++r){const int orow=crow(r,hi);
      #pragma unroll
      for(int d0=0;d0<2;++d0)stg[orow*64+d0*32+r32]=__float2bfloat16(o[d0][r]*rli[r]);}
    asm volatile("s_waitcnt lgkmcnt(0)":::"memory");
    #pragma unroll
    for(int i=0;i<4;++i){const int row=i*8+(lane>>3),ch=lane&7; const u32x4 v=*(const u32x4*)(stg+row*64+ch*8); ATTN_STORE16(Ow+(long)row*DM+ch*8,v);} }
  asm volatile("s_waitcnt lgkmcnt(0)\n\ts_barrier":::"memory");
  #undef DMA_K
  #undef DMA_V
  #undef CMASK
  #undef KBIAS
  #undef START
  #undef RESC
  #undef ROT
}
constexpr int ATTN_LDS_BYTES=LDS_BYTES;
struct AttnTensors { const bf16* Q; const bf16* K; const bf16* V; bf16* O; const float* C2K; float thr2; };
struct AttnUnit { int bh; int qb; };
struct StaticOrder {
  int vcu;
  __device__ __forceinline__ explicit StaticOrder(int grid,int block):vcu((block%8)*(grid/8)+block/8){}
  __device__ __forceinline__ bool next(int i,AttnUnit&u)const{ if(i>=2||vcu>=256)return false; const int s=vcu&7; u.bh=vcu>>3; u.qb=(i==0)?s:15-s; return true; }
  __device__ __forceinline__ void a_ready(const AttnUnit&)const{}
  __device__ __forceinline__ void done(const AttnUnit&)const{}
};
template<class Sched,int THRL=8> __device__ __forceinline__ void attn_phase(char*lds,const AttnTensors&T,const Sched&S,const int tid){
  AttnUnit u;
  for(int i=0;S.next(i,u);++i){ S.a_ready(u); attn_unit<THRL>(u.bh/NHEAD,u.bh%NHEAD,u.qb,T.Q,T.K,T.V,T.O,T.C2K,T.thr2,lds,tid); S.done(u); }
}
#undef SBAR
#undef WAIT_BAR
}
__device__ __forceinline__ void phase_attn_fast(Ctx& C, KA AR, int l, char* ldsg) {
    const attn_body::bf16* Q = (const attn_body::bf16*)(C.ws + WS_R1) + (size_t)2 * T * 512;
    const float bq = 64.f * C2 * wave_max(fabsf(AR->in[I_QN][l * HD + C.lane])) * wave_max(fabsf(AR->in[I_KN][l * HD + C.lane]));
    const attn_body::AttnTensors AT{Q, Q + (size_t)T * 512, Q + (size_t)2 * T * 512, (attn_body::bf16*)(C.ws + WS_R2), (const float*)(C.ws + WS_C2K), 2.f * bq + 40.f};
    unsigned* qctr = (unsigned*)(C.ws + WS_CTL) + CW_ATT + 64 * l;
    volatile LAS unsigned* slot = (volatile LAS unsigned*)(C.lds + MISC_OFF) + 16;
    for (;;) {
        __syncthreads();
        if (C.tid == 0) slot[0] = atomicAdd(qctr, 1u);
        __syncthreads();
        const int idx = __builtin_amdgcn_readfirstlane((int)slot[0]);
        if (idx >= NB * NH * 16) break;
        const int qb = 15 - (idx >> 5), bh = idx & 31;
        attn_body::attn_unit<8>(bh >> 3, bh & 7, qb, AT.Q, AT.K, AT.V, AT.O, AT.C2K, AT.thr2, ldsg, C.tid);
    }
}

constexpr int RCH = 32, NCH = S / RCH;
__device__ __forceinline__ float one_minus_sq_exp(float la, float a) {
    const float x = 2.f * la;
    float p = 1.f / 5040.f; p = p * x + 1.f / 720.f; p = p * x + 1.f / 120.f; p = p * x + 1.f / 24.f; p = p * x + 1.f / 6.f; p = p * x + 0.5f; p = p * x + 1.f; p = -(p * x);
    return x > -0.25f ? p : 1.f - a * a;
}
template <int MODE>
__device__ __forceinline__ void phase_rnn_fast(Ctx& C, KA AR, int l) {
    typedef short bf16x8 __attribute__((ext_vector_type(8)));
    const int blk = C.wave, lane = C.lane, fr = lane & 15, fq = lane >> 4;
    LAS float* Ab = (LAS float*)C.lds + C.wave * 4096; LAS float* Ub = Ab + 2048;
    LAS float* SS = (LAS float*)(C.lds + TAB_OFF); LAS float* RSW = SS + 256 + C.wave * 32;
    const bf16* ZX = (const bf16*)(C.ws + WS_R1); const bf16* ZG = ZX + (size_t)T * 512;
    float* SA = (float*)(C.ws + WS_SA); float* SH = (float*)(C.ws + WS_SH);
    const bf16* O = (const bf16*)(C.ws + WS_R2); bf16* YM = (bf16*)(C.ws + WS_R2 + 16 * MiB);
    const float* cw = AR->in[I_CONVW] + l * 4 * DR; const float* cb = AR->in[I_CONVB] + l * DR;
    const float* wr = AR->in[I_WR] + (size_t)(l * 8 + blk) * 64 * 64; const float* wi = AR->in[I_WI] + (size_t)(l * 8 + blk) * 64 * 64;
    bf16x8 Br[4][2], Bi[4][2]; float brj[4], bij[4], spj[4];
#pragma unroll
    for (int n = 0; n < 4; ++n) { const int j = n * 16 + fr, ch = blk * 64 + j;
        brj[n] = AR->in[I_BR][l * DR + ch]; bij[n] = AR->in[I_BI][l * DR + ch]; spj[n] = log1pf(__expf(-AR->in[I_LAM][l * DR + ch]));
#pragma unroll
        for (int ks = 0; ks < 2; ++ks)
#pragma unroll
            for (int e = 0; e < 8; ++e) { const int k = ks * 32 + fq * 8 + e; Br[n][ks][e] = (short)f2bf(wr[k * 64 + j]); Bi[n][ks][e] = (short)f2bf(wi[k * 64 + j]); } }
    for (int u = blockIdx.x; u < NB * NCH; u += gridDim.x) {
        const int b = u / NCH; int c = u % NCH; if (MODE == 1 && ((u / (int)gridDim.x) & 1)) c = NCH - 1 - c;
        const int t0 = c * RCH;
        if (MODE == 1) __syncthreads();
        bf16x8 Af[2][2];
#pragma unroll
        for (int ks = 0; ks < 2; ++ks) {
            const int ch0 = blk * 64 + ks * 32 + fq * 8;
            f32x4 w[4][2], bb[2];
#pragma unroll
            for (int j = 0; j < 4; ++j) { w[j][0] = *(const f32x4*)(cw + j * DR + ch0); w[j][1] = *(const f32x4*)(cw + j * DR + ch0 + 4); }
            bb[0] = *(const f32x4*)(cb + ch0); bb[1] = *(const f32x4*)(cb + ch0 + 4);
#pragma unroll
            for (int m = 0; m < 2; ++m) {
                const int tok = m * 16 + fr, tg = t0 + tok;
                f32x4 x0 = bb[0], x1 = bb[1];
#pragma unroll
                for (int j = 0; j < 4; ++j) { const int tt = tg - 3 + j;
                    if (tt >= 0) { const v4u z = *(const v4u*)(ZX + (size_t)(b * S + tt) * 512 + ch0);
                        x0[0] += w[j][0][0] * bflo(z.x); x0[1] += w[j][0][1] * bfhi(z.x); x0[2] += w[j][0][2] * bflo(z.y); x0[3] += w[j][0][3] * bfhi(z.y);
                        x1[0] += w[j][1][0] * bflo(z.z); x1[1] += w[j][1][1] * bfhi(z.z); x1[2] += w[j][1][2] * bflo(z.w); x1[3] += w[j][1][3] * bfhi(z.w); } }
                *(LAS f32x4*)(Ub + tok * 64 + ks * 32 + fq * 8) = x0; *(LAS f32x4*)(Ub + tok * 64 + ks * 32 + fq * 8 + 4) = x1;
                v4u pk; pk.x = pk2(x0[0], x0[1]); pk.y = pk2(x0[2], x0[3]); pk.z = pk2(x1[0], x1[1]); pk.w = pk2(x1[2], x1[3]);
                Af[m][ks] = __builtin_bit_cast(bf16x8, pk);
            }
        }
        f32x4 aR[2][4], aI[2][4];
#pragma unroll
        for (int m = 0; m < 2; ++m)
#pragma unroll
            for (int n = 0; n < 4; ++n) { aR[m][n] = (f32x4){0.f, 0.f, 0.f, 0.f}; aI[m][n] = (f32x4){0.f, 0.f, 0.f, 0.f};
#pragma unroll
                for (int ks = 0; ks < 2; ++ks) { aR[m][n] = __builtin_amdgcn_mfma_f32_16x16x32_bf16(Af[m][ks], Br[n][ks], aR[m][n], 0, 0, 0); aI[m][n] = __builtin_amdgcn_mfma_f32_16x16x32_bf16(Af[m][ks], Bi[n][ks], aI[m][n], 0, 0, 0); } }
        asm volatile("s_waitcnt lgkmcnt(0)" ::: "memory");
#pragma unroll
        for (int m = 0; m < 2; ++m)
#pragma unroll
            for (int n = 0; n < 4; ++n)
#pragma unroll
                for (int i = 0; i < 4; ++i) { const int idx = (m * 16 + 4 * fq + i) * 64 + n * 16 + fr;
                    const float xcv = Ub[idx], r = sigmoid_fast(aR[m][n][i] + brj[n]), ig = sigmoid_fast(aI[m][n][i] + bij[n]);
                    const float la = -8.f * r * spj[n], a = __expf(la);
                    Ab[idx] = a; Ub[idx] = sqrtf(one_minus_sq_exp(la, a)) * (ig * xcv); }
        asm volatile("s_waitcnt lgkmcnt(0)" ::: "memory");
        const int ch = blk * 64 + lane;
        if (MODE == 0) { float At = 1.f, h = 0.f;
#pragma unroll 8
            for (int t = 0; t < RCH; ++t) { const float a = Ab[t * 64 + lane]; h = a * h + Ub[t * 64 + lane]; At *= a; }
            SA[(size_t)(b * NCH + c) * 512 + ch] = At; SH[(size_t)(b * NCH + c) * 512 + ch] = h;
        } else {
            float h = 0.f;
            { const float* sa = SA + (size_t)b * NCH * 512 + ch; const float* sh = SH + (size_t)b * NCH * 512 + ch; int c2 = 0;
              for (; c2 + 16 <= c; c2 += 16) { float a8[16], h8[16];
#pragma unroll
                  for (int q = 0; q < 16; ++q) { a8[q] = sa[(size_t)(c2 + q) * 512]; h8[q] = sh[(size_t)(c2 + q) * 512]; }
#pragma unroll
                  for (int q = 0; q < 16; ++q) h = a8[q] * h + h8[q]; }
              for (; c2 < c; ++c2) h = sa[(size_t)c2 * 512] * h + sh[(size_t)c2 * 512]; }
            const bf16* zg = ZG + (size_t)(b * S + t0) * 512 + ch;
#pragma unroll 8
            for (int t = 0; t < RCH; ++t) { h = Ab[t * 64 + lane] * h + Ub[t * 64 + lane]; Ab[t * 64 + lane] = h * bf2f(zg[(size_t)t * 512]); }
            asm volatile("s_waitcnt lgkmcnt(0)" ::: "memory");
            { const int t = lane & 31, hf = lane >> 5; float s = 0.f;
#pragma unroll 8
              for (int k = 0; k < 32; ++k) { const float y = Ab[t * 64 + hf * 32 + ((k + t) & 31)]; s += y * y; }
              s = half_sum32(s); if (lane < 32) SS[C.wave * 32 + lane] = s; }
            __syncthreads();
            { const int t = lane & 31; float tot = 0.f;
#pragma unroll
              for (int w8 = 0; w8 < 8; ++w8) tot += SS[w8 * 32 + t];
              RSW[t] = rsqrtf(tot * (1.f / 512.f) + EPS); }
            asm volatile("s_waitcnt lgkmcnt(0)" ::: "memory");
            { const int oct = lane & 7; const float* g1 = AR->in[I_LRUN] + l * DR + blk * 64 + oct * 8; const f32x4 ga = *(const f32x4*)g1, gb = *(const f32x4*)(g1 + 4);
#pragma unroll
              for (int q = 0; q < 4; ++q) { const int t = q * 8 + (lane >> 3); const float rs = RSW[t];
                  const f32x4 y0 = *(const LAS f32x4*)(Ab + t * 64 + oct * 8) * rs * ga, y1 = *(const LAS f32x4*)(Ab + t * 64 + oct * 8 + 4) * rs * gb;
                  v4u pk; pk.x = pk2(y0[0], y0[1]); pk.y = pk2(y0[2], y0[3]); pk.z = pk2(y1[0], y1[1]); pk.w = pk2(y1[2], y1[3]);
                  *(v4u*)(YM + (size_t)(b * S + t0 + t) * D + blk * 64 + oct * 8) = pk; } }
            { const float* g2 = AR->in[I_ATTN] + l * DA + 8 * lane; const f32x4 ga = *(const f32x4*)g2, gb = *(const f32x4*)(g2 + 4);
              const size_t row0 = (size_t)(b * S + t0 + C.wave * 4); v4u w4[4];
#pragma unroll
              for (int q = 0; q < 4; ++q) w4[q] = *(const v4u*)(O + (row0 + q) * 512 + 8 * lane);
#pragma unroll
              for (int q = 0; q < 4; ++q) { const v4u w = w4[q];
                  f32x4 x0 = {bflo(w.x), bfhi(w.x), bflo(w.y), bfhi(w.y)}, x1 = {bflo(w.z), bfhi(w.z), bflo(w.w), bfhi(w.w)};
                  float s = (x0[0] * x0[0] + x0[1] * x0[1]) + (x0[2] * x0[2] + x0[3] * x0[3]) + (x1[0] * x1[0] + x1[1] * x1[1]) + (x1[2] * x1[2] + x1[3] * x1[3]);
                  const float rs = rsqrtf(wave_sum(s) * (1.f / 512.f) + EPS);
                  x0 = x0 * rs * ga; x1 = x1 * rs * gb;
                  v4u pk; pk.x = pk2(x0[0], x0[1]); pk.y = pk2(x0[2], x0[3]); pk.z = pk2(x1[0], x1[1]); pk.w = pk2(x1[2], x1[3]);
                  *(v4u*)(YM + (row0 + q) * D + 512 + 8 * lane) = pk; } }
        }
    }
}

template <int NT, class WF>
__device__ __forceinline__ void norm_proj_tile(const float* X, const float* gain, bf16* xn, int t0, WF wf, LAS float* Lw, int lane, int kh) {
    const int fr = lane & 15, fq = lane >> 4;
    f32x4 acc[NT];
#pragma unroll
    for (int n = 0; n < NT; ++n) acc[n] = (f32x4){0.f, 0.f, 0.f, 0.f};
    float ssq = 0.f;
    const float* xr = X + (size_t)(t0 + fr) * D + 4 * fq; const float* gr = gain + 4 * fq;
    for (int sb = 2 * kh; sb < 2 * kh + 2; ++sb) {
        f32x4 xv[16];
#pragma unroll
        for (int i = 0; i < 16; ++i) xv[i] = *(const f32x4*)(xr + 16 * (16 * sb + i));
#pragma unroll
        for (int i = 0; i < 16; ++i) { const int s = 16 * sb + i; const f32x4 gv = *(const f32x4*)(gr + 16 * s);
            ssq += (xv[i][0] * xv[i][0] + xv[i][1] * xv[i][1]) + (xv[i][2] * xv[i][2] + xv[i][3] * xv[i][3]);
            const f32x4 xg = xv[i] * gv;
#pragma unroll
            for (int e = 0; e < 4; ++e)
#pragma unroll
                for (int n = 0; n < NT; ++n) acc[n] = __builtin_amdgcn_mfma_f32_16x16x4f32(wf(n, 16 * s + 4 * fq + e, fr), xg[e], acc[n], 0, 0, 0); }
    }
    constexpr int PW = 4 * NT + 1;
    if (kh == 1) {
#pragma unroll
        for (int n = 0; n < NT; ++n)
#pragma unroll
            for (int r = 0; r < 4; ++r) Lw[lane * PW + 4 * n + r] = acc[n][r];
        Lw[lane * PW + 4 * NT] = ssq;
    }
    __syncthreads();
    if (kh == 0) {
#pragma unroll
        for (int n = 0; n < NT; ++n)
#pragma unroll
            for (int r = 0; r < 4; ++r) acc[n][r] += Lw[lane * PW + 4 * n + r];
        ssq += Lw[lane * PW + 4 * NT];
        ssq += lane_xor<16>(ssq); ssq = half_sum32(ssq);
        const float rs = rsqrtf(ssq * (1.f / D) + EPS);
        asm volatile("s_waitcnt lgkmcnt(0)" ::: "memory");
#pragma unroll
        for (int n = 0; n < NT; ++n)
#pragma unroll
            for (int r = 0; r < 4; ++r) Lw[fr * (16 * NT) + 16 * n + 4 * fq + r] = acc[n][r] * rs;
        if (lane < 16) Lw[16 * 16 * NT + lane] = rs;
    }
    __syncthreads();
#pragma unroll
    for (int q = 0; q < 8; ++q) { const int tok = 8 * kh + q; const float rst = Lw[16 * 16 * NT + tok];
        f32x4 v[4]; load_row(X + (size_t)(t0 + tok) * D, lane, v); scale_row(v, rst, gain, lane); store_row_bf16(xn + (size_t)(t0 + tok) * D, lane, v); }
}
__device__ __forceinline__ void phase_norm1_fast(Ctx& C, KA AR, int l) {
    const float* xs = l == 0 ? AR->in[I_X] : (const float*)(C.ws + WS_X);
    const float* gain = AR->in[I_MIXN] + l * D; const float* wf = AR->in[I_WIN] + (size_t)l * D * DIN + NZ; const float* bfg = AR->in[I_BF] + l * NH;
    bf16* xn = (bf16*)(C.ws + WS_XN); float* logf = (float*)(C.ws + WS_LOGF);
    LAS float* Wl = (LAS float*)C.lds; LAS float* Lw = (LAS float*)(C.lds + 32768 + 1024) + (C.wave & 3) * 1024; const int kh = C.wave >> 2;
    { f32x4 t[4];
#pragma unroll
      for (int j = 0; j < 4; ++j) { const int i = C.tid + 512 * j; t[j] = *(const f32x4*)(wf + (size_t)(i >> 1) * DIN + 4 * (i & 1)); }
#pragma unroll
      for (int j = 0; j < 4; ++j) *(LAS f32x4*)(Wl + 4 * (C.tid + 512 * j)) = t[j]; }
    if (C.tid < 8) Wl[D * 8 + C.tid] = 0.f;
    __syncthreads();
        for (int tile = blockIdx.x * 4 + (C.wave & 3); tile < T / 16; tile += gridDim.x * 4) {
            const int t0 = 16 * tile;
            __syncthreads();
            norm_proj_tile<1>(xs, gain, xn, t0, [=](int, int k, int i) { return Wl[k * 8 + i]; }, Lw, C.lane, kh);
            if (kh == 0) {
            const int tok = C.lane & 15, h0 = (C.lane >> 4) * 2;
            { const int r = t0 + tok, bb = r / S, tt = r % S;
              logf[(size_t)(bb * NH + h0) * S + tt] = log_sigmoid(Lw[tok * 16 + h0] + bfg[h0]); logf[(size_t)(bb * NH + h0 + 1) * S + tt] = log_sigmoid(Lw[tok * 16 + h0 + 1] + bfg[h0 + 1]); }
            }
            asm volatile("s_waitcnt lgkmcnt(0)" ::: "memory");
        }
}
__device__ __forceinline__ void phase_router_fast(Ctx& C, KA AR, int l) {
    const float* X = (const float*)(C.ws + WS_X); bf16* xn = (bf16*)(C.ws + WS_XN);
    const float* gain = AR->in[I_FFNN] + l * D; const float* wg = AR->in[I_WG] + (size_t)l * D * 4; const float* bg = AR->in[I_BG] + l * 4;
    const float* wr = AR->in[I_WRT] + (size_t)l * D * NE; const float* brt = AR->in[I_BRT] + l * NE;
    unsigned* cnt = (unsigned*)(C.ws + WS_CTL) + CW_CNT + 32 * CNT_STRIDE * l; int* rowpair = (int*)(C.ws + WS_ROWPAIR); float* pairw = (float*)(C.ws + WS_PAIRW);
    LAS float* Wl = (LAS float*)C.lds; LAS float* Lw = (LAS float*)(C.lds + WPROJ_BYTES + 64) + (C.wave & 3) * 832; const int kh = C.wave >> 2;
    { f32x4 t[16], u[2];
#pragma unroll
      for (int j = 0; j < 16; ++j) t[j] = *(const f32x4*)(wr + 4 * (C.tid + 512 * j));
#pragma unroll
      for (int j = 0; j < 2; ++j) u[j] = *(const f32x4*)(wg + 4 * (C.tid + 512 * j));
#pragma unroll
      for (int j = 0; j < 16; ++j) { const int i = C.tid + 512 * j; *(LAS f32x4*)(Wl + (i >> 3) * 36 + 4 * (i & 7)) = t[j]; }
#pragma unroll
      for (int j = 0; j < 2; ++j) *(LAS f32x4*)(Wl + (C.tid + 512 * j) * 36 + 32) = u[j]; }
    if (C.tid < 16) Wl[D * 36 + C.tid] = 0.f;
    volatile LAS unsigned* lcnt = (volatile LAS unsigned*)(C.lds + MISC_OFF - 512);
    if (C.tid < 64) lcnt[C.tid] = 0u;
    __syncthreads();
        for (int tile = blockIdx.x * 4 + (C.wave & 3); tile < T / 16; tile += gridDim.x * 4) {
            const int t0 = 16 * tile;
            __syncthreads();
            norm_proj_tile<3>(X, gain, xn, t0, [=](int n, int k, int i) { return Wl[k * 36 + 16 * n + i]; }, Lw, C.lane, kh);
            int e0 = 0, e1 = 0; unsigned lp0 = 0, lp1 = 0; float w0r = 0.f, w1r = 0.f;
            if (kh == 0 && C.lane < 16) {
                const LAS float* L = Lw + C.lane * 48;
                float gl[4];
#pragma unroll
                for (int i = 0; i < 4; ++i) gl[i] = L[32 + i] + bg[i];
                int gi = 0; float gm = gl[0];
#pragma unroll
                for (int i = 1; i < 4; ++i) if (gl[i] > gm) { gm = gl[i]; gi = i; }
                float gs = 0.f;
#pragma unroll
                for (int i = 0; i < 4; ++i) gs += __expf(gl[i] - gm);
                const float gp = 1.f / gs;
                float ev[8];
#pragma unroll
                for (int i = 0; i < 8; ++i) ev[i] = L[gi * 8 + i] + brt[gi * 8 + i];
                int i0 = 0; float t0v = ev[0];
#pragma unroll
                for (int i = 1; i < 8; ++i) if (ev[i] > t0v) { t0v = ev[i]; i0 = i; }
                int i1 = -1; float t1v = -INFINITY;
#pragma unroll
                for (int i = 0; i < 8; ++i) if (i != i0 && ev[i] > t1v) { t1v = ev[i]; i1 = i; }
                const float ex = __expf(t1v - t0v), w0 = gp / (1.f + ex), w1 = gp * ex / (1.f + ex);
                e0 = gi * 8 + i0; e1 = gi * 8 + i1; w0r = w0; w1r = w1;
                lp0 = __hip_atomic_fetch_add((LAS unsigned*)lcnt + e0, 1u, __ATOMIC_RELAXED, __HIP_MEMORY_SCOPE_WORKGROUP); lp1 = __hip_atomic_fetch_add((LAS unsigned*)lcnt + e1, 1u, __ATOMIC_RELAXED, __HIP_MEMORY_SCOPE_WORKGROUP);
            }
            __syncthreads();
            if (C.wave == 0 && C.lane < NE) { const unsigned n = lcnt[C.lane]; lcnt[32 + C.lane] = n ? atomicAdd(cnt + C.lane * CNT_STRIDE, n) : 0u; }
            __syncthreads();
            if (kh == 0 && C.lane < 16) { const int t = t0 + C.lane; const unsigned p0 = lcnt[32 + e0] + lp0, p1 = lcnt[32 + e1] + lp1;
                rowpair[(size_t)e0 * CAP + p0] = 2 * t; rowpair[(size_t)e1 * CAP + p1] = 2 * t + 1; pairw[2 * t] = w0r; pairw[2 * t + 1] = w1r; }
            __syncthreads();
            if (C.tid < 64) lcnt[C.tid] = 0u;
            asm volatile("s_waitcnt lgkmcnt(0)" ::: "memory");
        }
}

constexpr int NPH = 14;
constexpr int NPHASES = 1 + DEPTH * NPH;
__global__ void __launch_bounds__(512, 2) fwd_kernel(Args args) {
    extern __shared__ __attribute__((aligned(16))) unsigned char lds[];
    Ctx C;
    C.lds = (LAS unsigned char*)lds;
    C.wave0 = __builtin_amdgcn_readfirstlane((int)threadIdx.x >> 6); asm volatile("" : "+s"(C.wave0));
    C.tid = threadIdx.x; C.lane = C.tid & 63; C.wave = C.wave0;
    C.gw = blockIdx.x * 8 + C.wave; C.ngw = gridDim.x * 8;
    C.ws = args.ws;
    volatile LAS unsigned* MISC = (volatile LAS unsigned*)(C.lds + MISC_OFF);
    if (C.tid < 32) MISC[C.tid] = 0u;
    __syncthreads();
    XcdBarrier bar; bar.bar = (unsigned*)(C.ws + WS_CTL) + CW_BAR; bar.x = 0; bar.st = nullptr;
    if (args.ph_hi - args.ph_lo > 1) bar = xcd_barrier_post((unsigned*)(C.ws + WS_CTL) + CW_BAR, MISC + 8);
#ifndef ONLY
#define ONLY -1
#endif
#define PHON(k) (ONLY < 0 || ONLY == (k))
#if MK_MULTI
#define IN(k) (fresh_args()->ph_lo <= (k) && (k) < fresh_args()->ph_hi)
#else
#define IN(k) true
#endif
    if (PROBE_TIMING && blockIdx.x == 0 && threadIdx.x == 0) ((unsigned long long*)((unsigned*)(args.ws + WS_CTL) + CW_TS))[0] = __builtin_amdgcn_s_memrealtime();
#define SEAM(k) do { if (IN(k) && IN((k) + 1)) { XcdBarrier b_; b_.bar = (unsigned*)(fresh_args()->ws + WS_CTL) + CW_BAR; b_.x = xb_xcc_id(); b_.st = (volatile LAS unsigned*)(C.lds + MISC_OFF) + 8;     \
        xcd_barrier(b_, C.tid == 0); if (PROBE_TIMING && blockIdx.x == 0 && C.tid == 0) { ((unsigned long long*)((unsigned*)(fresh_args()->ws + WS_CTL) + CW_TS))[(k) + 1] = __builtin_amdgcn_s_memrealtime(); } } } while (0)
    for (int rp_ = 0; rp_ < REPS(99); ++rp_) { if (PHON(99) && IN(0)) { KA A_ = fresh_args(); enter_phase(C, A_); phase_prologue(C, A_); } SEAM(0); }
    for (int l = 0; l < DEPTH; ++l) {
        const int pb = 1 + l * NPH;
        for (int rp_ = 0; rp_ < REPSL(0); ++rp_) { if (PHON(0) && IN(pb + 0)) { KA A_ = fresh_args(); enter_phase(C, A_); if (FAST_NORM) phase_norm1_fast(C, A_, l); else phase_norm1(C, A_, l); } SEAM(pb + 0); }
        for (int rp_ = 0; rp_ < REPSL(1); ++rp_) { if (PHON(1) && IN(pb + 1)) { KA A_ = fresh_args(); enter_phase(C, A_); if (FAST_GEMM1) { phase_gemm1_fast(C, A_, l); phase_proj_fast(C, A_, l); } else phase_gemm1_naive(C, A_, l); } SEAM(pb + 1); }
        for (int rp_ = 0; rp_ < REPSL(2); ++rp_) { if (!FAST_GEMM1 && PHON(2) && IN(pb + 2)) { KA A_ = fresh_args(); enter_phase(C, A_); phase_qknorm_naive(C, A_, l); } if (!FAST_GEMM1) SEAM(pb + 2); }
        for (int rp_ = 0; rp_ < REPSL(3); ++rp_) { if (!(FAST_RNN && FAST_ATTN) && PHON(3) && IN(pb + 3)) { KA A_ = fresh_args(); enter_phase(C, A_); if (FAST_RNN) phase_rnn_fast<0>(C, A_, l); else phase_rnn_naive<0>(C, A_, l); } if (!(FAST_RNN && FAST_ATTN)) SEAM(pb + 3); }
        for (int rp_ = 0; rp_ < REPSL(4); ++rp_) { if (PHON(4) && IN(pb + 4)) { KA A_ = fresh_args(); enter_phase(C, A_); if (FAST_RNN && FAST_ATTN) { phase_rnn_fast<0>(C, A_, l); __syncthreads(); } if (FAST_ATTN) phase_attn_fast(C, A_, l, (char*)lds); else phase_attn_naive(C, A_, l); } SEAM(pb + 4); }
        for (int rp_ = 0; rp_ < REPSL(5); ++rp_) { if (PHON(5) && IN(pb + 5)) { KA A_ = fresh_args(); enter_phase(C, A_); if (FAST_RNN) phase_rnn_fast<1>(C, A_, l); else phase_rnn_naive<1>(C, A_, l); } SEAM(pb + 5); }
        for (int rp_ = 0; rp_ < REPSL(6); ++rp_) { if (!FAST_RNN && PHON(6) && IN(pb + 6)) { KA A_ = fresh_args(); enter_phase(C, A_); phase_mixnorm_naive(C, A_, l); } if (!FAST_RNN) SEAM(pb + 6); }
        for (int rp_ = 0; rp_ < REPSL(7); ++rp_) { if (PHON(7) && IN(pb + 7)) { KA A_ = fresh_args(); enter_phase(C, A_); if (FAST_DENSE) phase_wo_fast(C, A_, l); else phase_wo_naive(C, A_, l); } SEAM(pb + 7); }
        for (int rp_ = 0; rp_ < REPSL(8); ++rp_) { if (PHON(8) && IN(pb + 8)) { KA A_ = fresh_args(); enter_phase(C, A_); if (FAST_NORM) phase_router_fast(C, A_, l); else phase_router(C, A_, l); } SEAM(pb + 8); }
        for (int rp_ = 0; rp_ < REPSL(9); ++rp_) { if (PHON(9) && IN(pb + 9)) { KA A_ = fresh_args(); enter_phase(C, A_); if (FAST_MOE) phase_g1_fast(C, A_, l); else phase_g1_naive(C, A_, l); } SEAM(pb + 9); }
        for (int rp_ = 0; rp_ < REPSL(10); ++rp_) { if (PHON(10) && IN(pb + 10)) { KA A_ = fresh_args(); enter_phase(C, A_); if (FAST_MOE) phase_g2_fast(C, A_, l); else phase_g2_naive(C, A_, l); } SEAM(pb + 10); }
        for (int rp_ = 0; rp_ < REPSL(11); ++rp_) { if (PHON(11) && IN(pb + 11)) { KA A_ = fresh_args(); enter_phase(C, A_); phase_combine(C, A_, l); } SEAM(pb + 11); }
        for (int rp_ = 0; rp_ < REPSL(12); ++rp_) { if (!FAST_GEMM1 && PHON(12) && IN(pb + 12)) { KA A_ = fresh_args(); enter_phase(C, A_); if (FAST_DENSE) phase_proj_fast(C, A_, l); else phase_proj_naive(C, A_, l); } if (!FAST_GEMM1) SEAM(pb + 12); }
        for (int rp_ = 0; rp_ < REPSL(13); ++rp_) { if (PHON(13) && IN(pb + 13)) { KA A_ = fresh_args(); enter_phase(C, A_); if (FAST_DENSE) phase_ple_fast(C, A_, l); else phase_ple_naive(C, A_, l); } if (l + 1 < DEPTH) SEAM(pb + 13); }
    }
#undef IN
#undef SEAM
}

extern "C" void kernel_launch(void* const* d_in, const int* in_sizes, int n_in, void* d_out, int out_size, void* d_ws, size_t ws_size, hipStream_t stream) {
    static int grid = 0;
    if (grid == 0) {
        if (n_in != 29 || out_size != T * D || ws_size < WS_END) { fprintf(stderr, "kernel_launch: unexpected problem (n_in %d, out %d, ws %zu)\n", n_in, out_size, ws_size); grid = -1; return; }
        int dev = 0, cus = 0, per_cu = 0;
        if (hipGetDevice(&dev) != hipSuccess || hipDeviceGetAttribute(&cus, hipDeviceAttributeMultiprocessorCount, dev) != hipSuccess) { grid = -1; return; }
        if (hipFuncSetAttribute((const void*)fwd_kernel, hipFuncAttributeMaxDynamicSharedMemorySize, LDS_BYTES) != hipSuccess) { fprintf(stderr, "kernel_launch: hipFuncSetAttribute failed\n"); grid = -1; return; }
        if (hipOccupancyMaxActiveBlocksPerMultiprocessor(&per_cu, (const void*)fwd_kernel, 512, LDS_BYTES) != hipSuccess || per_cu < 1) { fprintf(stderr, "kernel_launch: occupancy query says %d\n", per_cu); grid = -1; return; }
        (void)hipGetLastError();
        grid = cus;
    }
    if (grid < 0) return;
    hipMemsetAsync((char*)d_ws + WS_CTL, 0, CTL_ZERO_BYTES, stream);
    Args a{};
    for (int i = 0; i < 29; ++i) a.in[i] = (const float*)d_in[i];
    a.out = (float*)d_out; a.ws = (unsigned char*)d_ws;
#if MK_MULTI
    for (int ph = 0; ph < NPHASES; ++ph) { a.ph_lo = ph; a.ph_hi = ph + 1; hipLaunchKernelGGL(fwd_kernel, dim3(grid), dim3(512), LDS_BYTES, stream, a); }
#else
    a.ph_lo = 0; a.ph_hi = NPHASES;
    hipLaunchKernelGGL(fwd_kernel, dim3(grid), dim3(512), LDS_BYTES, stream, a);
#endif
}
```

```cpp
#include <hip/hip_runtime.h>
#include <cstdio>
#include <cstdint>
#include <cmath>
#include <hip/hip_bf16.h>

#define FAST_GEMM1 1
#define FAST_DENSE 1
#define FAST_MOE 1
#define FAST_ATTN 1
#define FAST_RNN 1
#define FAST_NORM 1
#ifndef PROBE_TIMING
#define PROBE_TIMING 0
#endif
#ifndef PROBE_LO
#define PROBE_LO 0
#define PROBE_HI 1
#endif
#ifndef PROBE_REP
#define PROBE_REP -1
#define PROBE_REPN 0
#endif
#define REPS(k) ((PROBE_REP == (k)) ? (1 + PROBE_REPN) : 1)
#define REPSL(k) ((((k) == 7 && l != 0) || ((k) == 13 && l != DEPTH - 1)) ? 1 : REPS(k))
#ifndef MK_MULTI
#define MK_MULTI 0
#endif

#define GAS __attribute__((address_space(1)))
#define LAS __attribute__((address_space(3)))
typedef unsigned short bf16;
typedef unsigned v4u __attribute__((ext_vector_type(4)));
typedef unsigned v2u __attribute__((ext_vector_type(2)));
typedef float f32x4 __attribute__((ext_vector_type(4)));

constexpr int NB = 4, S = 4096, T = NB * S, D = 1024, DIN = 2568, DR = 512, DA = 512, NH = 8, HD = 64;
constexpr int NE = 32, DE = 512, PLE = 256, DEPTH = 2, NZ = 2560;
constexpr float EPS = 1e-6f, LOG2E = 1.4426950408889634f, C2 = 0.125f * 1.4426950408889634f;
constexpr int CAP = 16384;
constexpr int HROWS = 40960;

constexpr size_t MiB = 1u << 20;
constexpr size_t WS_CTL = 0, CTL_ZERO_BYTES = 1 * MiB;
constexpr size_t WS_LOGF = 1 * MiB;
constexpr size_t WS_C2K = WS_LOGF + MiB / 2;
constexpr size_t WS_SA = 6 * MiB, WS_SH = 7 * MiB;
constexpr size_t WS_PAIRW = 3 * MiB;
constexpr size_t WS_ROWPAIR = 4 * MiB;
constexpr size_t WS_WIN = 8 * MiB;
constexpr size_t WS_WOUT = 18 * MiB;
constexpr size_t WS_WPG = 22 * MiB;
constexpr size_t WS_WPP = 26 * MiB;
constexpr size_t WS_WGU = 28 * MiB;
constexpr size_t WS_WDN = 156 * MiB;
constexpr size_t WS_PB = 220 * MiB;
constexpr size_t WS_XN = 236 * MiB;
constexpr size_t WS_X = 268 * MiB;
constexpr size_t WS_R1 = 332 * MiB;
constexpr size_t WS_R2 = 412 * MiB;
constexpr size_t WS_PROJ = 460 * MiB;
constexpr size_t WS_END = 492 * MiB;
constexpr int CW_BAR = 4096;
constexpr int CW_TS = 20480;
constexpr int CW_ATT = 16384;
constexpr int CW_CNT = 8192, CNT_STRIDE = 64;

constexpr int RING_BYTES = 131072;
constexpr int LDS_BYTES = 163840;
constexpr int MISC_OFF = LDS_BYTES - 1024;
constexpr int WPROJ_BYTES = 147456;

__device__ __forceinline__ unsigned f2bf(float f) { unsigned u = __builtin_bit_cast(unsigned, f); return (u + 0x7fffu + ((u >> 16) & 1u)) >> 16; }
__device__ __forceinline__ unsigned pk2(float lo, float hi) { return f2bf(lo) | (f2bf(hi) << 16); }
__device__ __forceinline__ float bf2f(unsigned u) { return __builtin_bit_cast(float, u << 16); }
__device__ __forceinline__ float bflo(unsigned w) { return __builtin_bit_cast(float, w << 16); }
__device__ __forceinline__ float bfhi(unsigned w) { return __builtin_bit_cast(float, w & 0xffff0000u); }
template <int O> __device__ __forceinline__ float lane_xor(float v) {
    if constexpr (O == 32) { const unsigned u = __builtin_bit_cast(unsigned, v); auto rr = __builtin_amdgcn_permlane32_swap(u, u, false, false);
        const unsigned a = rr[0], b = rr[1]; return __builtin_bit_cast(float, a == u ? b : a); }
    else return __builtin_bit_cast(float, __builtin_amdgcn_ds_swizzle(__builtin_bit_cast(int, v), (O << 10) | 0x1f));
}
__device__ __forceinline__ float wave_sum(float v) {
    v += lane_xor<1>(v); v += lane_xor<2>(v); v += lane_xor<4>(v); v += lane_xor<8>(v); v += lane_xor<16>(v);
    { const unsigned u = __builtin_bit_cast(unsigned, v); auto rr = __builtin_amdgcn_permlane32_swap(u, u, false, false); v = __builtin_bit_cast(float, (unsigned)rr[0]) + __builtin_bit_cast(float, (unsigned)rr[1]); }
    return v;
}
__device__ __forceinline__ float wave_max(float v) {
    v = fmaxf(v, lane_xor<1>(v)); v = fmaxf(v, lane_xor<2>(v)); v = fmaxf(v, lane_xor<4>(v)); v = fmaxf(v, lane_xor<8>(v)); v = fmaxf(v, lane_xor<16>(v));
    { const unsigned u = __builtin_bit_cast(unsigned, v); auto rr = __builtin_amdgcn_permlane32_swap(u, u, false, false); v = fmaxf(__builtin_bit_cast(float, (unsigned)rr[0]), __builtin_bit_cast(float, (unsigned)rr[1])); }
    return v;
}
__device__ __forceinline__ float half_sum32(float v) {
    const unsigned u = __builtin_bit_cast(unsigned, v); auto rr = __builtin_amdgcn_permlane32_swap(u, u, false, false); return __builtin_bit_cast(float, (unsigned)rr[0]) + __builtin_bit_cast(float, (unsigned)rr[1]);
}
__device__ __forceinline__ float sigmoidf_(float v) { return 1.f / (1.f + __expf(-v)); }
__device__ __forceinline__ float gelu_tanh(float v) { return 0.5f * v * (1.f + tanhf(0.7978845608028654f * (v + 0.044715f * v * v * v))); }
__device__ __forceinline__ float log_sigmoid(float v) { return v >= 0.f ? -log1pf(__expf(-v)) : v - log1pf(__expf(v)); }

#define XB_TMO      128
#define XB_XCNT(j)  (256  + 64 * (j))
#define XB_XSUB(j)  (1280 + 64 * (j))
#define XB_XGEN(j)  (2304 + 64 * (j))
#define XB_TOP      3328
#define XB_TOPGEN   3392
#define XCD_BAR_WORDS 3456
#define XB_SPIN_CAP (1u << 26)
__device__ __forceinline__ unsigned xb_ld(unsigned* p)              { return __hip_atomic_load(p, __ATOMIC_RELAXED, __HIP_MEMORY_SCOPE_AGENT); }
__device__ __forceinline__ unsigned xb_add(unsigned* p, unsigned v) { return __hip_atomic_fetch_add(p, v, __ATOMIC_RELAXED, __HIP_MEMORY_SCOPE_AGENT); }
__device__ __forceinline__ unsigned xb_xcc_id() { return (unsigned)__builtin_amdgcn_s_getreg((3 << 11) | 20) & 0xFu; }
#define XB_SPIN(cond, bar) do { unsigned _sp = 0; while (cond) { __builtin_amdgcn_s_sleep(1); \
    if ((++_sp & 255u) == 0u) { if (xb_ld(&(bar)[XB_TMO])) break; if (_sp > XB_SPIN_CAP) { atomicAdd(&(bar)[XB_TMO], 1u); break; } } } } while (0)
struct XcdBarrier { unsigned* bar; unsigned x; volatile LAS unsigned* st; };
__device__ __forceinline__ XcdBarrier xcd_barrier_post(unsigned* bar, volatile LAS unsigned* st) {
    XcdBarrier b; b.bar = bar; b.x = xb_xcc_id(); b.st = st;
    if (threadIdx.x == 0) (void)xb_add(&bar[XB_XCNT(b.x)], 1u);
    return b;
}
__device__ __forceinline__ void xcd_barrier_complete(unsigned* bar, unsigned x, unsigned& nloc, unsigned& nx) {
    const unsigned G = gridDim.x * gridDim.y * gridDim.z;
    unsigned sum, cnt, mine, sp = 0u;
    for (;;) {
        sum = 0u; cnt = 0u; mine = 0u;
#pragma unroll
        for (unsigned j = 0; j < 16; ++j) { const unsigned c = xb_ld(&bar[XB_XCNT(j)]); sum += c; cnt += (c > 0u) ? 1u : 0u; mine = (j == x) ? c : mine; }
        if (sum == G) break;
        __builtin_amdgcn_s_sleep(1);
        if ((++sp & 255u) == 0u) { if (xb_ld(&bar[XB_TMO])) break; if (sp > XB_SPIN_CAP) { atomicAdd(&bar[XB_TMO], 1u); break; } }
    }
    nloc = mine > 0u ? mine : 1u; nx = cnt > 0u ? cnt : 1u;
}
__device__ __forceinline__ void xcd_barrier(const XcdBarrier& b, const bool leader  ) {
    asm volatile("s_waitcnt vmcnt(0)" ::: "memory");
    __syncthreads();
    if (leader) {
        unsigned* bar = b.bar;
        __builtin_amdgcn_s_waitcnt(0);
        unsigned nloc = b.st[0], nx = b.st[1];
        if (nloc == 0u) { xcd_barrier_complete(bar, b.x, nloc, nx); b.st[0] = nloc; b.st[1] = nx; }
        const unsigned old = xb_add(&bar[XB_XSUB(b.x)], 1u);
        const unsigned gen = old / nloc;
        if (old + 1u == (gen + 1u) * nloc) {
            __builtin_amdgcn_fence(__ATOMIC_RELEASE, "agent");
            asm volatile("s_waitcnt vmcnt(0)" ::: "memory");
            const unsigned og = xb_add(&bar[XB_TOP], 1u);
            const unsigned tg = og / nx;
            if (og + 1u == (tg + 1u) * nx) xb_add(&bar[XB_TOPGEN], 1u);
            else XB_SPIN(xb_ld(&bar[XB_TOPGEN]) == tg, bar);
            __builtin_amdgcn_fence(__ATOMIC_ACQUIRE, "agent");
            xb_add(&bar[XB_XGEN(b.x)], 1u);
            asm volatile("s_waitcnt vmcnt(0)" ::: "memory");
        } else {
            XB_SPIN(xb_ld(&bar[XB_XGEN(b.x)]) == gen, bar);
            __builtin_amdgcn_fence(__ATOMIC_ACQUIRE, "agent");
            asm volatile("s_waitcnt vmcnt(0)" ::: "memory");
        }
    }
    __syncthreads();
}

struct Args { const float* in[29]; float* out; unsigned char* ws; int ph_lo, ph_hi; };
typedef const __attribute__((address_space(4))) Args* KA;
__device__ __forceinline__ KA fresh_args() { KA p = (KA)__builtin_amdgcn_kernarg_segment_ptr(); asm volatile("" : "+s"(p)); return p; }
struct Ctx;
struct Ctx {
    LAS unsigned char* lds;
    int tid, lane, wave, gw, ngw;
    int wave0;
    unsigned char* ws;
};
__device__ __forceinline__ void enter_phase(Ctx& C, KA A) {
    int t; asm volatile("v_mbcnt_lo_u32_b32 %0, -1, 0\n\tv_mbcnt_hi_u32_b32 %0, -1, %0" : "=v"(t)); t += C.wave0 * 64; C.tid = t; C.lane = t & 63; C.wave = __builtin_amdgcn_readfirstlane(t >> 6);
    C.gw = blockIdx.x * 8 + C.wave; C.ngw = gridDim.x * 8; C.ws = A->ws; }
enum { I_X = 0, I_P, I_MIXN, I_WIN, I_BF, I_CONVW, I_CONVB, I_WR, I_BR, I_WI, I_BI, I_LAM, I_QN, I_KN, I_LRUN, I_ATTN, I_WOUT, I_FFNN,
       I_WG, I_BG, I_WRT, I_BRT, I_WEG, I_WEU, I_WED, I_PLEN, I_WPG, I_BPG, I_WPP };

__device__ __forceinline__ void transpose_item(const float* W, int ldw, int K, bf16* WT, int k0, int n0, int c0, LAS float* scr, int lane) {
    { float t[32];
#pragma unroll
      for (int i = 0; i < 32; ++i) t[i] = W[(size_t)(k0 + 2 * i + (lane >> 5)) * ldw + c0 + (lane & 31)];
#pragma unroll
      for (int i = 0; i < 32; ++i) scr[(2 * i + (lane >> 5)) * 33 + (lane & 31)] = t[i]; }
    asm volatile("s_waitcnt lgkmcnt(0)" ::: "memory");
    const int c = lane & 7;
#pragma unroll
    for (int j = 0; j < 4; ++j) { const int n = (lane >> 3) + 8 * j; const LAS float* s = scr + (8 * c) * 33 + n;
        v4u o; o.x = pk2(s[0 * 33], s[1 * 33]); o.y = pk2(s[2 * 33], s[3 * 33]); o.z = pk2(s[4 * 33], s[5 * 33]); o.w = pk2(s[6 * 33], s[7 * 33]);
        *(v4u*)(WT + (size_t)(n0 + n) * K + k0 + 8 * c) = o; }
    asm volatile("s_waitcnt lgkmcnt(0)" ::: "memory");
}
__device__ __forceinline__ void phase_prologue(Ctx& C, KA AR) {
    LAS float* scr = (LAS float*)(C.lds + C.wave * 16384);
    constexpr int I_IN = 16 * 80, I_OUT = 16 * 32, I_GU = 32 * 16 * 32, I_DN = 32 * 8 * 32, I_PG = 16 * 32, I_PP = 4 * 32;
    constexpr int PER_L = I_IN + I_OUT + I_GU + I_DN + I_PG + I_PP;
    for (int it = C.gw; it < DEPTH * PER_L; it += C.ngw) {
        const int l = it / PER_L; int r = it % PER_L;
        if (r < I_IN) {
            const int kb = r / 80, nb = r % 80, n0 = 32 * nb, pn = n0 >> 8, jl = n0 & 255, bj = jl >> 7, wc = (jl >> 5) & 3;
            transpose_item(AR->in[I_WIN] + (size_t)l * D * DIN, DIN, D, (bf16*)(C.ws + WS_WIN) + (size_t)l * NZ * D, 64 * kb, n0, 256 * pn + 64 * wc + 32 * bj, scr, C.lane); continue; }
        r -= I_IN;
        if (r < I_OUT) { const int kb = r / 32, nb = r % 32;
            transpose_item(AR->in[I_WOUT] + (size_t)l * D * D, D, D, (bf16*)(C.ws + WS_WOUT) + (size_t)l * D * D, 64 * kb, 32 * nb, 32 * nb, scr, C.lane); continue; }
        r -= I_OUT;
        if (r < I_GU) {
            const int e = r / 512, q = r % 512, kb = q / 32, nb = q % 32, n0 = 32 * nb, pn = n0 >> 8, jl = n0 & 255;
            const float* src = (jl < 128 ? AR->in[I_WEG] : AR->in[I_WEU]) + (size_t)(l * NE + e) * D * DE;
            transpose_item(src, DE, D, (bf16*)(C.ws + WS_WGU) + (size_t)(l * NE + e) * 1024 * D, 64 * kb, n0, 128 * pn + (jl & 127), scr, C.lane); continue; }
        r -= I_GU;
        if (r < I_DN) { const int e = r / 256, q = r % 256, kb = q / 32, nb = q % 32;
            transpose_item(AR->in[I_WED] + (size_t)(l * NE + e) * DE * D, D, DE, (bf16*)(C.ws + WS_WDN) + (size_t)(l * NE + e) * D * DE, 64 * kb, 32 * nb, 32 * nb, scr, C.lane); continue; }
        r -= I_DN;
        if (r < I_PG) { const int kb = r / 32, nb = r % 32;
            transpose_item(AR->in[I_WPG] + (size_t)l * D * D, D, D, (bf16*)(C.ws + WS_WPG) + (size_t)l * D * D, 64 * kb, 32 * nb, 32 * nb, scr, C.lane); continue; }
        r -= I_PG;
        { const int kb = r / 32, nb = r % 32;
            transpose_item(AR->in[I_WPP] + (size_t)l * PLE * D, D, PLE, (bf16*)(C.ws + WS_WPP) + (size_t)l * D * PLE, 64 * kb, 32 * nb, 32 * nb, scr, C.lane); }
    }
    const f32x4* ps = (const f32x4*)AR->in[I_P]; v2u* pd = (v2u*)(C.ws + WS_PB);
    const size_t n4 = (size_t)DEPTH * T * PLE / 4;
    { const size_t st = (size_t)gridDim.x * 512; size_t i = (size_t)blockIdx.x * 512 + C.tid;
      for (; i + 7 * st < n4; i += 8 * st) { f32x4 v[8];
#pragma unroll
          for (int q = 0; q < 8; ++q) v[q] = ps[i + q * st];
#pragma unroll
          for (int q = 0; q < 8; ++q) { v2u o; o.x = pk2(v[q].x, v[q].y); o.y = pk2(v[q].z, v[q].w); pd[i + q * st] = o; } }
      for (; i < n4; i += st) { const f32x4 v = ps[i]; v2u o; o.x = pk2(v.x, v.y); o.y = pk2(v.z, v.w); pd[i] = o; } }
}

__device__ __forceinline__ void load_row(const float* row, int lane, f32x4 (&v)[4]) {
    const f32x4* xr = (const f32x4*)row + lane;
#pragma unroll
    for (int j = 0; j < 4; ++j) v[j] = xr[64 * j];
}
__device__ __forceinline__ float row_rs(const f32x4 (&v)[4]) {
    float s = 0.f;
#pragma unroll
    for (int j = 0; j < 4; ++j) s += (v[j].x * v[j].x + v[j].y * v[j].y) + (v[j].z * v[j].z + v[j].w * v[j].w);
    return rsqrtf(wave_sum(s) * (1.f / D) + EPS);
}
__device__ __forceinline__ void scale_row(f32x4 (&v)[4], float rs, const float* gain, int lane) {
    const f32x4* g = (const f32x4*)gain + lane;
#pragma unroll
    for (int j = 0; j < 4; ++j) v[j] = v[j] * rs * g[64 * j];
}
__device__ __forceinline__ void store_row_bf16(bf16* row, int lane, const f32x4 (&v)[4]) {
    v2u* o = (v2u*)row + lane;
#pragma unroll
    for (int j = 0; j < 4; ++j) { v2u w; w.x = pk2(v[j].x, v[j].y); w.y = pk2(v[j].z, v[j].w); o[64 * j] = w; }
}

__device__ __forceinline__ void phase_norm1(Ctx& C, KA AR, int l) {
    const float* xs = l == 0 ? AR->in[I_X] : (const float*)(C.ws + WS_X);
    const float* gain = AR->in[I_MIXN] + l * D;
    const float* wf = AR->in[I_WIN] + (size_t)l * D * DIN + NZ;
    const float* bfg = AR->in[I_BF] + l * NH;
    bf16* xn = (bf16*)(C.ws + WS_XN); float* logf = (float*)(C.ws + WS_LOGF);
    for (int t = C.gw; t < T; t += C.ngw) {
        f32x4 v[4]; load_row(xs + (size_t)t * D, C.lane, v);
        const float rs = row_rs(v); scale_row(v, rs, gain, C.lane);
        store_row_bf16(xn + (size_t)t * D, C.lane, v);
        float z[8] = {0.f, 0.f, 0.f, 0.f, 0.f, 0.f, 0.f, 0.f};
#pragma unroll
        for (int j = 0; j < 4; ++j)
#pragma unroll
            for (int e = 0; e < 4; ++e) { const int k = 256 * j + 4 * C.lane + e; const f32x4 w0 = *(const f32x4*)(wf + (size_t)k * DIN), w1 = *(const f32x4*)(wf + (size_t)k * DIN + 4);
                const float a = v[j][e]; z[0] += a * w0.x; z[1] += a * w0.y; z[2] += a * w0.z; z[3] += a * w0.w; z[4] += a * w1.x; z[5] += a * w1.y; z[6] += a * w1.z; z[7] += a * w1.w; }
#pragma unroll
        for (int h = 0; h < 8; ++h) z[h] = wave_sum(z[h]);
        float mine = 0.f;
#pragma unroll
        for (int h = 0; h < 8; ++h) mine = (C.lane == h) ? z[h] : mine;
        if (C.lane < 8) logf[(size_t)t * 8 + C.lane] = log_sigmoid(mine + bfg[C.lane]);
    }
}

template <int NACC, class AR, class BR, class EP>
__device__ __forceinline__ void ngemm_tile(LAS float* sm, int K, AR arow, BR brow, EP epi, const int tid) {
    LAS float* As = sm; LAS float* Bs = sm + 32 * 68;
    const int ty = tid >> 4, tx = tid & 15, lr = tid >> 3, lk = (tid & 7) * 4;
    float acc[NACC][2][4];
#pragma unroll
    for (int a = 0; a < NACC; ++a)
#pragma unroll
        for (int i = 0; i < 2; ++i)
#pragma unroll
            for (int j = 0; j < 4; ++j) acc[a][i][j] = 0.f;
    const bf16* ap = arow(lr); const bf16* bp0 = brow(lr, 0); const bf16* bp1 = NACC > 1 ? brow(lr, 1) : bp0;
    for (int k0 = 0; k0 < K; k0 += 32) {
        __syncthreads();
        { v2u av; av.x = 0u; av.y = 0u; if (ap) av = *(const v2u*)(ap + k0 + lk);
          As[(lk + 0) * 68 + lr] = bflo(av.x); As[(lk + 1) * 68 + lr] = bfhi(av.x); As[(lk + 2) * 68 + lr] = bflo(av.y); As[(lk + 3) * 68 + lr] = bfhi(av.y); }
        { const v2u bv = *(const v2u*)(bp0 + k0 + lk);
          Bs[(lk + 0) * 68 + lr] = bflo(bv.x); Bs[(lk + 1) * 68 + lr] = bfhi(bv.x); Bs[(lk + 2) * 68 + lr] = bflo(bv.y); Bs[(lk + 3) * 68 + lr] = bfhi(bv.y); }
        if (NACC > 1) { const v2u bv = *(const v2u*)(bp1 + k0 + lk); LAS float* B1 = Bs + 32 * 68;
          B1[(lk + 0) * 68 + lr] = bflo(bv.x); B1[(lk + 1) * 68 + lr] = bfhi(bv.x); B1[(lk + 2) * 68 + lr] = bflo(bv.y); B1[(lk + 3) * 68 + lr] = bfhi(bv.y); }
        __syncthreads();
#pragma unroll 8
        for (int kk = 0; kk < 32; ++kk) {
            const float a0 = As[kk * 68 + ty * 2], a1 = As[kk * 68 + ty * 2 + 1];
#pragma unroll
            for (int a = 0; a < NACC; ++a) { const f32x4 b = *(const LAS f32x4*)(Bs + a * 32 * 68 + kk * 68 + tx * 4);
#pragma unroll
                for (int j = 0; j < 4; ++j) { acc[a][0][j] += a0 * b[j]; acc[a][1][j] += a1 * b[j]; } }
        }
    }
#pragma unroll
    for (int i = 0; i < 2; ++i)
#pragma unroll
        for (int j = 0; j < 4; ++j) epi(ty * 2 + i, tx * 4 + j, acc[0][i][j], NACC > 1 ? acc[1][i][j] : 0.f);
}

__device__ __forceinline__ void phase_cumsum(Ctx& C, KA AR) {
    if (C.gw < NB * NH) {
        const int b = C.gw / NH, h = C.gw % NH;
        const float* logf = (const float*)(C.ws + WS_LOGF) + (size_t)b * S * 8 + h; float* c2k = (float*)(C.ws + WS_C2K) + (size_t)C.gw * S;
        float s = 0.f;
        for (int i = 0; i < 64; ++i) s += logf[(size_t)(64 * C.lane + i) * 8];
        float inc = s;
#pragma unroll
        for (int o = 1; o < 64; o <<= 1) { const float v = __builtin_bit_cast(float, __builtin_amdgcn_ds_bpermute((C.lane - o) << 2, __builtin_bit_cast(int, inc))); if (C.lane >= o) inc += v; }
        float run = inc - s;
        for (int i = 0; i < 64; ++i) { run += logf[(size_t)(64 * C.lane + i) * 8]; c2k[64 * C.lane + i] = run * LOG2E; }
    }
}
__device__ __forceinline__ void phase_cumsum_fast(Ctx& C, KA AR) {
    const int row = (int)blockIdx.x - (int)gridDim.x / 2;
    if (C.wave == 0 && row >= 0 && row < NB * NH) {
        const float* src = (const float*)(C.ws + WS_LOGF) + (size_t)row * S + C.lane; float* dst = (float*)(C.ws + WS_C2K) + (size_t)row * S + C.lane;
        float run = 0.f;
        for (int it = 0; it < S / 64; it += 8) {
            float v[8];
#pragma unroll
            for (int q = 0; q < 8; ++q) v[q] = src[(it + q) * 64];
#pragma unroll
            for (int q = 0; q < 8; ++q) { float x = v[q];
#pragma unroll
                for (int o = 1; o < 64; o <<= 1) { const float y = __builtin_bit_cast(float, __builtin_amdgcn_ds_bpermute((C.lane - o) << 2, __builtin_bit_cast(int, x))); if (C.lane >= o) x += y; }
                dst[(it + q) * 64] = (run + x) * LOG2E;
                run += __builtin_bit_cast(float, __builtin_amdgcn_readlane(__builtin_bit_cast(int, x), 63)); }
        }
    }
}
__device__ __forceinline__ void phase_gemm1_naive(Ctx& C, KA AR, int l) {
    phase_cumsum(C, AR);
    const bf16* A = (const bf16*)(C.ws + WS_XN); const bf16* Bt = (const bf16*)(C.ws + WS_WIN) + (size_t)l * NZ * D;
    bf16* R1 = (bf16*)(C.ws + WS_R1);
    for (int u = blockIdx.x; u < (T / 64) * (NZ / 64); u += gridDim.x) {
        const int mt = u / (NZ / 64), nt = u % (NZ / 64), m0 = 64 * mt, n0 = 64 * nt;
        ngemm_tile<1>((LAS float*)C.lds, D, [=](int r) { return A + (size_t)(m0 + r) * D; }, [=](int c, int) { return Bt + (size_t)(n0 + c) * D; },
            [=](int r, int c, float v, float) {
                const int j = n0 + c, pn = j >> 8, jl = j & 255, bj = jl >> 7, wc = (jl >> 5) & 3, col = 256 * pn + 64 * wc + 32 * bj + (jl & 31);
                const int seg = col >> 9, cc = col & 511;
                const float o = seg == 1 ? gelu_tanh(v) : v;
                R1[(size_t)seg * T * 512 + (size_t)(m0 + r) * 512 + cc] = (bf16)f2bf(o);
            }, C.tid);
    }
}
__device__ __forceinline__ void phase_qknorm_naive(Ctx& C, KA AR, int l) {
    bf16* Q = (bf16*)(C.ws + WS_R1) + (size_t)2 * T * 512; bf16* Kb = Q + (size_t)T * 512;
    const float* gq = AR->in[I_QN] + l * HD; const float* gk = AR->in[I_KN] + l * HD;
    for (int i = C.gw; i < 2 * T; i += C.ngw) {
        const int t = i >> 1, isk = i & 1; bf16* row = (isk ? Kb : Q) + (size_t)t * 512; const float* g = isk ? gk : gq;
        const v4u w = *(const v4u*)(row + 8 * C.lane);
        float x[8] = {bflo(w.x), bfhi(w.x), bflo(w.y), bfhi(w.y), bflo(w.z), bfhi(w.z), bflo(w.w), bfhi(w.w)};
        float s = 0.f;
#pragma unroll
        for (int e = 0; e < 8; ++e) s += x[e] * x[e];
        s += lane_xor<1>(s); s += lane_xor<2>(s); s += lane_xor<4>(s);
        const float rs = rsqrtf(s * (1.f / 64.f) + EPS) * (isk ? 1.f : C2);
        const int d0 = 8 * (C.lane & 7);
#pragma unroll
        for (int e = 0; e < 8; ++e) x[e] = x[e] * rs * g[d0 + e];
        v4u o; o.x = pk2(x[0], x[1]); o.y = pk2(x[2], x[3]); o.z = pk2(x[4], x[5]); o.w = pk2(x[6], x[7]);
        *(v4u*)(row + 8 * C.lane) = o;
    }
}

template <int MODE>
__device__ __forceinline__ void phase_rnn_naive(Ctx& C, KA AR, int l) {
    LAS float* xcs = (LAS float*)C.lds; LAS float* as = xcs + 64 * 65; LAS float* us = as + 64 * 64;
    const bf16* ZX = (const bf16*)(C.ws + WS_R1); const bf16* ZG = ZX + (size_t)T * 512;
    float* SA = (float*)(C.ws + WS_SA); float* SH = (float*)(C.ws + WS_SH); float* YR = (float*)(C.ws + WS_PROJ);
    const float* cw = AR->in[I_CONVW] + l * 4 * DR; const float* cb = AR->in[I_CONVB] + l * DR;
    const float* wr = AR->in[I_WR] + (size_t)l * 8 * 64 * 64; const float* wi = AR->in[I_WI] + (size_t)l * 8 * 64 * 64;
    const float* br = AR->in[I_BR] + l * DR; const float* bi = AR->in[I_BI] + l * DR; const float* lam = AR->in[I_LAM] + l * DR;
    for (int u = blockIdx.x; u < NB * 64 * 8; u += gridDim.x) {
        const int b = u >> 9, cidx = (u >> 3) & 63, blk = u & 7;
        __syncthreads();
#pragma unroll
        for (int i = 0; i < 8; ++i) { const int e = C.tid + 512 * i, t = e >> 6, c = e & 63, ch = blk * 64 + c, tg = cidx * 64 + t;
            float xc = cb[ch];
#pragma unroll
            for (int j = 0; j < 4; ++j) { const int tt = tg - 3 + j; if (tt >= 0) xc += cw[j * DR + ch] * bf2f(ZX[(size_t)(b * S + tt) * 512 + ch]); }
            xcs[t * 65 + c] = xc; }
        __syncthreads();
#pragma unroll
        for (int i = 0; i < 8; ++i) { const int e = C.tid + 512 * i, t = e >> 6, j = e & 63, ch = blk * 64 + j;
            float ar = br[ch], ai = bi[ch];
            for (int k = 0; k < 64; ++k) { const float x = xcs[t * 65 + k]; ar += x * wr[(size_t)(blk * 64 + k) * 64 + j]; ai += x * wi[(size_t)(blk * 64 + k) * 64 + j]; }
            const float r = sigmoidf_(ar), ig = sigmoidf_(ai);
            const float la = -8.f * r * log1pf(__expf(-lam[ch]));
            as[t * 64 + j] = __expf(la); us[t * 64 + j] = sqrtf(-expm1f(2.f * la)) * (ig * xcs[t * 65 + j]); }
        __syncthreads();
        if (C.tid < 64) { const int j = C.tid, ch = blk * 64 + j;
            if (MODE == 0) { float A = 1.f, H = 0.f;
                for (int t = 0; t < 64; ++t) { const float a = as[t * 64 + j]; H = a * H + us[t * 64 + j]; A *= a; }
                SA[(size_t)(b * 64 + cidx) * 512 + ch] = A; SH[(size_t)(b * 64 + cidx) * 512 + ch] = H;
            } else { float h = 0.f;
                for (int c2 = 0; c2 < cidx; ++c2) h = SA[(size_t)(b * 64 + c2) * 512 + ch] * h + SH[(size_t)(b * 64 + c2) * 512 + ch];
                for (int t = 0; t < 64; ++t) { h = as[t * 64 + j] * h + us[t * 64 + j]; as[t * 64 + j] = h; } } }
        if (MODE == 1) { __syncthreads();
#pragma unroll
            for (int i = 0; i < 8; ++i) { const int e = C.tid + 512 * i, t = e >> 6, c = e & 63, ch = blk * 64 + c; const size_t row = (size_t)(b * S + cidx * 64 + t);
                YR[row * 512 + ch] = as[t * 64 + c] * bf2f(ZG[row * 512 + ch]); } }
    }
}

__device__ __forceinline__ void phase_attn_naive(Ctx& C, KA AR, int l) {
    LAS float* Ks = (LAS float*)C.lds; LAS float* Vs = Ks + 64 * 65; LAS float* Qs = Vs + 64 * 65; LAS float* Ps = Qs + 64 * 64; LAS float* cks = Ps + 8 * 64;
    const bf16* Q = (const bf16*)(C.ws + WS_R1) + (size_t)2 * T * 512; const bf16* Kb = Q + (size_t)T * 512; const bf16* Vb = Kb + (size_t)T * 512;
    bf16* O = (bf16*)(C.ws + WS_R2); const float* c2k = (const float*)(C.ws + WS_C2K);
    for (int u = blockIdx.x; u < NB * NH * 64; u += gridDim.x) {
        const int qt = 63 - (u >> 5), bh = u & 31, b = bh >> 3, h = bh & 7, q0 = 64 * qt;
        const float* ck = c2k + (size_t)bh * S;
        __syncthreads();
        for (int e = C.tid; e < 64 * 64; e += 512) { const int r = e >> 6, d = e & 63; Qs[r * 64 + d] = bf2f(Q[(size_t)(b * S + q0 + r) * 512 + h * 64 + d]); }
        float m[8], lsum[8], o[8], cq[8];
#pragma unroll
        for (int i = 0; i < 8; ++i) { m[i] = -INFINITY; lsum[i] = 0.f; o[i] = 0.f; cq[i] = ck[q0 + C.wave * 8 + i]; }
        for (int kt = 0; kt <= qt; ++kt) {
            const int k0 = 64 * kt;
            __syncthreads();
            for (int e = C.tid; e < 64 * 64; e += 512) { const int r = e >> 6, d = e & 63; const size_t g = (size_t)(b * S + k0 + r) * 512 + h * 64 + d; Ks[r * 65 + d] = bf2f(Kb[g]); Vs[r * 65 + d] = bf2f(Vb[g]); }
            if (C.tid < 64) cks[C.tid] = ck[k0 + C.tid];
            __syncthreads();
#pragma unroll
            for (int i = 0; i < 8; ++i) {
                const int q = C.wave * 8 + i, qg = q0 + q;
                float dot = 0.f;
#pragma unroll 16
                for (int d = 0; d < 64; ++d) dot += Qs[q * 64 + d] * Ks[C.lane * 65 + d];
                float s = dot + cq[i] - cks[C.lane];
                if (k0 + C.lane > qg) s = -INFINITY;
                const float mn = fmaxf(m[i], wave_max(s));
                const float alpha = exp2f(m[i] - mn), p = exp2f(s - mn);
                lsum[i] = lsum[i] * alpha + wave_sum(p); m[i] = mn;
                Ps[C.wave * 64 + C.lane] = p;
                asm volatile("s_waitcnt lgkmcnt(0)" ::: "memory");
                float acc = 0.f;
#pragma unroll 16
                for (int k = 0; k < 64; ++k) acc += Ps[C.wave * 64 + k] * Vs[k * 65 + C.lane];
                o[i] = o[i] * alpha + acc;
                asm volatile("s_waitcnt lgkmcnt(0)" ::: "memory");
            }
        }
#pragma unroll
        for (int i = 0; i < 8; ++i) O[(size_t)(b * S + q0 + C.wave * 8 + i) * 512 + h * 64 + C.lane] = (bf16)f2bf(o[i] / lsum[i]);
    }
}

__device__ __forceinline__ void phase_mixnorm_naive(Ctx& C, KA AR, int l) {
    const float* YR = (const float*)(C.ws + WS_PROJ); const bf16* O = (const bf16*)(C.ws + WS_R2); bf16* YM = (bf16*)(C.ws + WS_R2 + 16 * MiB);
    const float* g1 = AR->in[I_LRUN] + l * DR; const float* g2 = AR->in[I_ATTN] + l * DA;
    for (int t = C.gw; t < T; t += C.ngw) {
        f32x4 a[2]; float s = 0.f;
#pragma unroll
        for (int j = 0; j < 2; ++j) { a[j] = *((const f32x4*)(YR + (size_t)t * 512) + C.lane + 64 * j); s += (a[j].x * a[j].x + a[j].y * a[j].y) + (a[j].z * a[j].z + a[j].w * a[j].w); }
        float rs = rsqrtf(wave_sum(s) * (1.f / 512.f) + EPS);
#pragma unroll
        for (int j = 0; j < 2; ++j) { const f32x4 g = *((const f32x4*)g1 + C.lane + 64 * j); const f32x4 v = a[j] * rs * g; v2u w; w.x = pk2(v.x, v.y); w.y = pk2(v.z, v.w);
            *((v2u*)(YM + (size_t)t * D) + C.lane + 64 * j) = w; }
        const v4u w = *(const v4u*)(O + (size_t)t * 512 + 8 * C.lane);
        float x[8] = {bflo(w.x), bfhi(w.x), bflo(w.y), bfhi(w.y), bflo(w.z), bfhi(w.z), bflo(w.w), bfhi(w.w)};
        s = 0.f;
#pragma unroll
        for (int e = 0; e < 8; ++e) s += x[e] * x[e];
        rs = rsqrtf(wave_sum(s) * (1.f / 512.f) + EPS);
#pragma unroll
        for (int e = 0; e < 8; ++e) x[e] = x[e] * rs * g2[8 * C.lane + e];
        v4u o; o.x = pk2(x[0], x[1]); o.y = pk2(x[2], x[3]); o.z = pk2(x[4], x[5]); o.w = pk2(x[6], x[7]);
        *(v4u*)(YM + (size_t)t * D + 512 + 8 * C.lane) = o;
    }
}

__device__ __forceinline__ void phase_wo_naive(Ctx& C, KA AR, int l) {
    const bf16* A = (const bf16*)(C.ws + WS_R2 + 16 * MiB); const bf16* Bt = (const bf16*)(C.ws + WS_WOUT) + (size_t)l * D * D;
    const float* xs = l == 0 ? AR->in[I_X] : (const float*)(C.ws + WS_X); float* X = (float*)(C.ws + WS_X);
    for (int u = blockIdx.x; u < (T / 64) * (D / 64); u += gridDim.x) {
        const int m0 = 64 * (u / (D / 64)), n0 = 64 * (u % (D / 64));
        ngemm_tile<1>((LAS float*)C.lds, D, [=](int r) { return A + (size_t)(m0 + r) * D; }, [=](int c, int) { return Bt + (size_t)(n0 + c) * D; },
            [=](int r, int c, float v, float) { const size_t i = (size_t)(m0 + r) * D + n0 + c; X[i] = xs[i] + v; }, C.tid);
    }
}

__device__ __forceinline__ void phase_router(Ctx& C, KA AR, int l) {
    const float* X = (const float*)(C.ws + WS_X); bf16* xn = (bf16*)(C.ws + WS_XN);
    const float* gain = AR->in[I_FFNN] + l * D; const float* wg = AR->in[I_WG] + (size_t)l * D * 4; const float* bg = AR->in[I_BG] + l * 4;
    const float* wr = AR->in[I_WRT] + (size_t)l * D * NE; const float* brt = AR->in[I_BRT] + l * NE;
    unsigned* cnt = (unsigned*)(C.ws + WS_CTL) + CW_CNT + 32 * CNT_STRIDE * l; int* rowpair = (int*)(C.ws + WS_ROWPAIR); float* pairw = (float*)(C.ws + WS_PAIRW);
    for (int t = C.gw; t < T; t += C.ngw) {
        f32x4 v[4]; load_row(X + (size_t)t * D, C.lane, v);
        const float rs = row_rs(v); scale_row(v, rs, gain, C.lane);
        store_row_bf16(xn + (size_t)t * D, C.lane, v);
        LAS float* rowl = (LAS float*)C.lds + C.wave * 1024;
#pragma unroll
        for (int j = 0; j < 4; ++j) *((LAS f32x4*)rowl + C.lane + 64 * j) = v[j];
        asm volatile("s_waitcnt lgkmcnt(0)" ::: "memory");
        float acc = 0.f;
        if (C.lane < 36) {
            const float* wp = C.lane < 32 ? wr + C.lane : wg + (C.lane - 32); const int st = C.lane < 32 ? NE : 4;
#pragma unroll 8
            for (int k = 0; k < D; ++k) acc += rowl[k] * wp[(size_t)k * st];
            acc += C.lane < 32 ? brt[C.lane] : bg[C.lane - 32];
        }
        asm volatile("s_waitcnt lgkmcnt(0)" ::: "memory");
        float gl[4];
#pragma unroll
        for (int i = 0; i < 4; ++i) gl[i] = __builtin_bit_cast(float, __builtin_amdgcn_readlane(__builtin_bit_cast(int, acc), 32 + i));
        int gi = 0; float gm = gl[0];
#pragma unroll
        for (int i = 1; i < 4; ++i) if (gl[i] > gm) { gm = gl[i]; gi = i; }
        float gs = 0.f;
#pragma unroll
        for (int i = 0; i < 4; ++i) gs += __expf(gl[i] - gm);
        const float gp = 1.f / gs;
        float ev[8];
#pragma unroll
        for (int i = 0; i < 8; ++i) ev[i] = __builtin_bit_cast(float, __builtin_amdgcn_readlane(__builtin_bit_cast(int, acc), __builtin_amdgcn_readfirstlane(gi) * 8 + i));
        int i0 = 0; float t0 = ev[0];
#pragma unroll
        for (int i = 1; i < 8; ++i) if (ev[i] > t0) { t0 = ev[i]; i0 = i; }
        int i1 = -1; float t1 = -INFINITY;
#pragma unroll
        for (int i = 0; i < 8; ++i) if (i != i0 && ev[i] > t1) { t1 = ev[i]; i1 = i; }
        const float ex = __expf(t1 - t0), w0 = gp / (1.f + ex), w1 = gp * ex / (1.f + ex);
        if (C.lane < 2) { const int e = gi * 8 + (C.lane == 0 ? i0 : i1); const unsigned pos = atomicAdd(cnt + e * CNT_STRIDE, 1u);
            rowpair[(size_t)e * CAP + pos] = 2 * t + C.lane; pairw[2 * t + C.lane] = C.lane == 0 ? w0 : w1; }
    }
}

struct ExpTab { int n[NE], hoff[NE], t0[NE + 1]; };
__device__ __forceinline__ void build_exptab(Ctx& C, int l, LAS int* tab) {
    __syncthreads();
    if (C.tid == 0) { const unsigned* cnt = (const unsigned*)(C.ws + WS_CTL) + CW_CNT + 32 * CNT_STRIDE * l; int ho = 0, tt = 0;
        for (int e = 0; e < NE; ++e) { const int n = (int)__hip_atomic_load(cnt + e * CNT_STRIDE, __ATOMIC_RELAXED, __HIP_MEMORY_SCOPE_AGENT); tab[e] = n; tab[32 + e] = ho; tab[64 + e] = tt; ho += (n + 255) & ~255; tt += (n + 63) >> 6; }
        tab[64 + NE] = tt; }
    __syncthreads();
}
__device__ __forceinline__ void phase_g1_naive(Ctx& C, KA AR, int l) {
    LAS int* tab = (LAS int*)(C.lds + 65536); build_exptab(C, l, tab);
    const bf16* xn = (const bf16*)(C.ws + WS_XN); const int* rowpair = (const int*)(C.ws + WS_ROWPAIR); bf16* Hb = (bf16*)(C.ws + WS_R2);
    const int nmt = tab[64 + NE];
    for (int u = blockIdx.x; u < nmt * 8; u += gridDim.x) {
        const int mtg = u >> 3, nt = u & 7; int e = 0;
        for (int i = 1; i < NE; ++i) if (tab[64 + i] <= mtg) e = i;
        const int mt = mtg - tab[64 + e], ne = tab[e], ho = tab[32 + e], p0 = 64 * mt, c0 = 64 * nt;
        const bf16* Bt = (const bf16*)(C.ws + WS_WGU) + (size_t)(l * NE + e) * 1024 * D; const int* rp = rowpair + (size_t)e * CAP;
        ngemm_tile<2>((LAS float*)C.lds, D,
            [=](int r) { return (p0 + r < ne) ? xn + (size_t)(rp[p0 + r] >> 1) * D : (const bf16*)nullptr; },
            [=](int c, int a) { const int cc = c0 + c; return Bt + (size_t)((cc >> 7) * 256 + (cc & 127) + a * 128) * D; },
            [=](int r, int c, float g, float uu) { if (p0 + r < ne) Hb[(size_t)(ho + p0 + r) * DE + c0 + c] = (bf16)f2bf(g / (1.f + __expf(-g)) * uu); }, C.tid);
    }
}
__device__ __forceinline__ void phase_g2_naive(Ctx& C, KA AR, int l) {
    LAS int* tab = (LAS int*)(C.lds + 65536); build_exptab(C, l, tab);
    const int* rowpair = (const int*)(C.ws + WS_ROWPAIR); const float* pairw = (const float*)(C.ws + WS_PAIRW); const bf16* Hb = (const bf16*)(C.ws + WS_R2); bf16* Y2 = (bf16*)(C.ws + WS_R1);
    const int nmt = tab[64 + NE];
    for (int u = blockIdx.x; u < nmt * 16; u += gridDim.x) {
        const int mtg = u >> 4, nt = u & 15; int e = 0;
        for (int i = 1; i < NE; ++i) if (tab[64 + i] <= mtg) e = i;
        const int mt = mtg - tab[64 + e], ne = tab[e], ho = tab[32 + e], p0 = 64 * mt, c0 = 64 * nt;
        const bf16* Bt = (const bf16*)(C.ws + WS_WDN) + (size_t)(l * NE + e) * D * DE; const int* rp = rowpair + (size_t)e * CAP;
        ngemm_tile<1>((LAS float*)C.lds, DE,
            [=](int r) { return (p0 + r < ne) ? Hb + (size_t)(ho + p0 + r) * DE : (const bf16*)nullptr; },
            [=](int c, int) { return Bt + (size_t)(c0 + c) * DE; },
            [=](int r, int c, float v, float) { if (p0 + r < ne) { const int p = rp[p0 + r]; Y2[(size_t)p * D + c0 + c] = (bf16)f2bf(v * pairw[p]); } }, C.tid);
    }
}

__device__ __forceinline__ void phase_combine(Ctx& C, KA AR, int l) {
    float* X = (float*)(C.ws + WS_X); const bf16* Y2 = (const bf16*)(C.ws + WS_R1); bf16* xn = (bf16*)(C.ws + WS_XN); const float* gain = AR->in[I_PLEN] + l * D;
    for (int t = 2 * C.gw; t < T; t += 2 * C.ngw) {
        f32x4 v[2][4]; v2u ya[2][4], yb[2][4];
#pragma unroll
        for (int q = 0; q < 2; ++q) { load_row(X + (size_t)(t + q) * D, C.lane, v[q]);
#pragma unroll
            for (int j = 0; j < 4; ++j) { ya[q][j] = *((const v2u*)(Y2 + (size_t)(2 * (t + q)) * D) + C.lane + 64 * j); yb[q][j] = *((const v2u*)(Y2 + (size_t)(2 * (t + q) + 1) * D) + C.lane + 64 * j); } }
#pragma unroll
        for (int q = 0; q < 2; ++q) {
#pragma unroll
            for (int j = 0; j < 4; ++j) { const v2u a = ya[q][j], b = yb[q][j];
                v[q][j].x += bflo(a.x) + bflo(b.x); v[q][j].y += bfhi(a.x) + bfhi(b.x); v[q][j].z += bflo(a.y) + bflo(b.y); v[q][j].w += bfhi(a.y) + bfhi(b.y);
                *((f32x4*)(X + (size_t)(t + q) * D) + C.lane + 64 * j) = v[q][j]; }
            const float rs = row_rs(v[q]); scale_row(v[q], rs, gain, C.lane);
            store_row_bf16(xn + (size_t)(t + q) * D, C.lane, v[q]); }
    }
}

__device__ __forceinline__ void phase_proj_naive(Ctx& C, KA AR, int l) {
    const bf16* A = (const bf16*)(C.ws + WS_PB) + (size_t)l * T * PLE; const bf16* Bt = (const bf16*)(C.ws + WS_WPP) + (size_t)l * D * PLE; bf16* PR = (bf16*)(C.ws + WS_PROJ);
    for (int u = blockIdx.x; u < (T / 64) * (D / 64); u += gridDim.x) {
        const int m0 = 64 * (u / (D / 64)), n0 = 64 * (u % (D / 64));
        ngemm_tile<1>((LAS float*)C.lds, PLE, [=](int r) { return A + (size_t)(m0 + r) * PLE; }, [=](int c, int) { return Bt + (size_t)(n0 + c) * PLE; },
            [=](int r, int c, float v, float) { PR[(size_t)(m0 + r) * D + n0 + c] = (bf16)f2bf(v); }, C.tid);
    }
}
__device__ __forceinline__ void phase_ple_naive(Ctx& C, KA AR, int l) {
    const bf16* A = (const bf16*)(C.ws + WS_XN); const bf16* Bt = (const bf16*)(C.ws + WS_WPG) + (size_t)l * D * D; const bf16* PR = (const bf16*)(C.ws + WS_PROJ);
    const float* X = (const float*)(C.ws + WS_X); float* dst = l == DEPTH - 1 ? AR->out : (float*)(C.ws + WS_X); const float* bias = AR->in[I_BPG] + l * D;
    for (int u = blockIdx.x; u < (T / 64) * (D / 64); u += gridDim.x) {
        const int m0 = 64 * (u / (D / 64)), n0 = 64 * (u % (D / 64));
        ngemm_tile<1>((LAS float*)C.lds, D, [=](int r) { return A + (size_t)(m0 + r) * D; }, [=](int c, int) { return Bt + (size_t)(n0 + c) * D; },
            [=](int r, int c, float v, float) { const size_t i = (size_t)(m0 + r) * D + n0 + c; dst[i] = X[i] + bf2f(PR[i]) * sigmoidf_(v + bias[n0 + c]); }, C.tid);
    }
}

namespace pg8 {
typedef unsigned short bf16_t;
typedef short bf16x8 __attribute__((ext_vector_type(8)));
typedef unsigned u32x4 __attribute__((ext_vector_type(4)));
constexpr int BM = 256, BK = 64, HALF = 128, HTB = HALF * BK * 2, STAGE_BYTES = 8 * HTB, NXCD = 8, WGM = 8;
__device__ __forceinline__ int lds_byte(int r, int c) { const int st = (r >> 4) * 2 + (c >> 5), rr = r & 15, cc = c & 31, ob = rr * 64 + cc * 2; return st * 1024 + (ob ^ (((ob >> 9) & 1) << 5)); }
__device__ __forceinline__ void stage_rc(int b, int& R, int& C) { const int st = b / 1024, sb = b % 1024, swz = sb ^ (((sb >> 9) & 1) << 5); R = (st >> 1) * 16 + swz / 64; C = (st & 1) * 32 + (swz % 64) / 2; }
__device__ __forceinline__ int perm32(int rho) { const int n = rho >> 4, i = rho & 15; return 8 * (i >> 2) + 4 * n + (i & 3); }
struct Unit { int pm, pn, e, aux, mt; };
struct Gemm { const bf16_t* A; const bf16_t* Bt; int K; };
struct StaticOrder {
    int nM, nN, nwg, G, c;
    __device__ void init(int M, int N, int G_, int c_) { nM = M / BM; nN = N / BM; nwg = nM * nN; G = G_; c = c_; }
    __device__ bool next(int i, Unit& u) const {
        const long L = (long)i * G + c; if (L >= nwg) return false;
        int wgid = (int)L; { const int q = nwg / NXCD, r = nwg % NXCD, xcd = wgid % NXCD, off = wgid / NXCD; wgid = (xcd < r ? xcd * (q + 1) : r * (q + 1) + (xcd - r) * q) + off; }
        const int nig = WGM * nN, gid = wgid / nig, fm = gid * WGM, gsz = (nM - fm) < WGM ? (nM - fm) : WGM;
        u.pm = fm + ((wgid % nig) % gsz); u.pn = (wgid % nig) / gsz; u.e = 0; u.aux = 256; u.mt = 0; return true;
    }
    __device__ __forceinline__ const char* a_base(const Gemm& g, const Unit& u) const { return (const char*)g.A + (size_t)u.pm * 512 * g.K; }
    __device__ __forceinline__ const char* b_base(const Gemm& g, const Unit& u) const { return (const char*)g.Bt + (size_t)u.pn * 512 * g.K; }
    __device__ __forceinline__ int a_row(const Unit&, int) const { return 0; }
};
__device__ __forceinline__ unsigned cvt_pk_bf16(float lo, float hi) { unsigned r; asm volatile("v_cvt_pk_bf16_f32 %0, %1, %2" : "=v"(r) : "v"(lo), "v"(hi)); return r; }

template <class Epi, class Sched, bool ALIGN_EPI, bool GATHER>
__device__ __forceinline__ void gemm_phase(LAS unsigned char* lds, const Gemm g, const Sched& S, const Epi& E, const int tid) {
    const int wid = __builtin_amdgcn_readfirstlane(tid >> 6), lane = tid & 63, wr = wid >> 2, wc = wid & 3, fr = lane & 15, fq = lane >> 4;
    const int K = g.K, nt = K / BK;
    unsigned voffB[2];
#pragma unroll
    for (int i = 0; i < 2; ++i) { int R, C; stage_rc(tid * 16 + i * 8192, R, C); const int Rb = Epi::PERM ? ((R & ~31) + perm32(R & 31)) : R; voffB[i] = (unsigned)(Rb * K + C) * 2u; }
    const size_t kstep = (size_t)(BK * 2);
    const size_t hstep = (size_t)HALF * K * 2;
    const size_t hsA = GATHER ? 0 : hstep;
    const unsigned ldsw = (unsigned)wid * 1024u;
    const int aoff = lds_byte(wr * 64 + fr, fq * 8), boff = lds_byte(wc * 32 + fr, fq * 8);
#define PG8_SA(b, h) (((b) * 2 + (h)) * HTB)
#define PG8_SB(b, h) ((4 + (b) * 2 + (h)) * HTB)
#define PG8_STAGE(bufoff, gbase, voff) do { _Pragma("unroll") for (int _i = 0; _i < 2; ++_i) \
        __builtin_amdgcn_global_load_lds((const unsigned*)((const char*)(gbase) + (voff)[_i]), (LAS unsigned*)(lds + (bufoff) + ldsw + _i * 8192), 16, 0, 0); } while (0)
#define PG8_LDA(dst, b, h) do { _Pragma("unroll") for (int m = 0; m < 4; ++m) _Pragma("unroll") for (int k = 0; k < 2; ++k) dst[m][k] = *(const LAS bf16x8*)(lds + PG8_SA(b, h) + aoff + m * 2048 + k * 1024); } while (0)
#define PG8_LDB(dst, b, h) do { _Pragma("unroll") for (int n = 0; n < 2; ++n) _Pragma("unroll") for (int k = 0; k < 2; ++k) dst[n][k] = *(const LAS bf16x8*)(lds + PG8_SB(b, h) + boff + n * 2048 + k * 1024); } while (0)
#define PG8_MMA(ai, bj, At, Bt) do { __builtin_amdgcn_s_setprio(1); _Pragma("unroll") for (int m = 0; m < 4; ++m) _Pragma("unroll") for (int n = 0; n < 2; ++n) _Pragma("unroll") for (int k = 0; k < 2; ++k) \
        acc[ai][bj][m][n] = __builtin_amdgcn_mfma_f32_16x16x32_bf16(Bt[n][k], At[m][k], acc[ai][bj][m][n], 0, 0, 0); __builtin_amdgcn_s_setprio(0); } while (0)
#define PG8_WAIT_V(n) asm volatile("s_waitcnt vmcnt(" #n ")" ::: "memory")
#define PG8_WAIT_L(n) asm volatile("s_waitcnt lgkmcnt(" #n ")" ::: "memory")
#define PG8_BAR __builtin_amdgcn_s_barrier()
#define PG8_SCHED __builtin_amdgcn_sched_barrier(0)
#define PG8_VOFF(dst, u) do { int t_ = tid; if (GATHER) asm volatile("" : "+v"(t_));   \
        _Pragma("unroll") for (int i_ = 0; i_ < 2; ++i_) { int R_, C_; stage_rc(t_ * 16 + i_ * 8192, R_, C_); _Pragma("unroll") for (int h_ = 0; h_ < 2; ++h_) \
        dst[h_][i_] = GATHER ? (unsigned)(S.a_row(u, h_ * HALF + R_) * K + C_) * 2u : (unsigned)(R_ * K + C_) * 2u; } } while (0)
    Unit cur, nxt; int ui = 0;
    if (!S.next(0, cur)) return;
    f32x4 acc[2][2][4][2];
#pragma unroll
    for (int a = 0; a < 2; ++a)
#pragma unroll
        for (int b = 0; b < 2; ++b)
#pragma unroll
            for (int m = 0; m < 4; ++m)
#pragma unroll
                for (int n = 0; n < 2; ++n) acc[a][b][m][n] = (f32x4){0.f, 0.f, 0.f, 0.f};
    bf16x8 At[4][2], B0[2][2], B1[2][2];
    unsigned vC[2][2], vN[2][2], vX[2][2];
    PG8_VOFF(vC, cur);
    const char* cA = S.a_base(g, cur); const char* cB = S.b_base(g, cur);
    PG8_STAGE(PG8_SB(0, 0), cB, voffB); PG8_STAGE(PG8_SB(0, 1), cB + hstep, voffB); PG8_STAGE(PG8_SA(0, 0), cA, vC[0]); PG8_STAGE(PG8_SA(0, 1), cA + hsA, vC[1]);
    if (wr == 1) PG8_BAR;
    PG8_WAIT_V(2); PG8_BAR;
    PG8_STAGE(PG8_SB(1, 0), cB + kstep, voffB); PG8_STAGE(PG8_SA(1, 0), cA + kstep, vC[0]); PG8_STAGE(PG8_SB(1, 1), cB + hstep + kstep, voffB);
    PG8_WAIT_V(6); PG8_BAR;
    for (;;) {
        const bool has_next = S.next(ui + 1, nxt);
        const char* nA = has_next ? S.a_base(g, nxt) : cA; const char* nB = has_next ? S.b_base(g, nxt) : cB;
        if (GATHER && has_next) { PG8_VOFF(vN, nxt); }
        else {
#pragma unroll
            for (int h_ = 0; h_ < 2; ++h_)
#pragma unroll
                for (int i_ = 0; i_ < 2; ++i_) vN[h_][i_] = vC[h_][i_]; }
#pragma unroll 1
        for (int t = 0; t < nt; t += 2) {
            const bool last = (t == nt - 2);
            const char* a1 = cA + (size_t)(t + 1) * kstep;
            const char* a2 = last ? nA : cA + (size_t)(t + 2) * kstep; const char* b2 = last ? nB : cB + (size_t)(t + 2) * kstep;
            const char* a3 = a2 + kstep; const char* b3 = b2 + kstep;
#pragma unroll
            for (int h_ = 0; h_ < 2; ++h_)
#pragma unroll
                for (int i_ = 0; i_ < 2; ++i_) vX[h_][i_] = (GATHER && last) ? vN[h_][i_] : vC[h_][i_];
            PG8_LDB(B0, 0, 0); PG8_LDB(B1, 0, 1); PG8_SCHED; PG8_LDA(At, 0, 0); PG8_STAGE(PG8_SA(1, 1), a1 + hsA, vC[1]);
            PG8_WAIT_V(8); PG8_WAIT_L(0); PG8_BAR; PG8_MMA(0, 0, At, B0); PG8_MMA(0, 1, At, B1); PG8_BAR; PG8_SCHED;
            PG8_LDA(At, 0, 1); PG8_STAGE(PG8_SB(0, 0), b2, voffB); PG8_STAGE(PG8_SB(0, 1), b2 + hstep, voffB); PG8_STAGE(PG8_SA(0, 0), a2, vX[0]);
            PG8_WAIT_V(8); PG8_WAIT_L(0); PG8_BAR; PG8_MMA(1, 0, At, B0); PG8_MMA(1, 1, At, B1); PG8_BAR; PG8_SCHED;
            PG8_LDB(B0, 1, 0); PG8_LDB(B1, 1, 1); PG8_SCHED; PG8_LDA(At, 1, 0); PG8_STAGE(PG8_SA(0, 1), a2 + hsA, vX[1]);
            PG8_WAIT_V(8); PG8_WAIT_L(0); PG8_BAR; PG8_MMA(0, 0, At, B0); PG8_MMA(0, 1, At, B1); PG8_BAR; PG8_SCHED;
            PG8_LDA(At, 1, 1); PG8_STAGE(PG8_SB(1, 0), b3, voffB); PG8_STAGE(PG8_SB(1, 1), b3 + hstep, voffB); PG8_STAGE(PG8_SA(1, 0), a3, vX[0]);
            PG8_WAIT_V(8); PG8_WAIT_L(0); PG8_BAR; PG8_MMA(1, 0, At, B0); PG8_MMA(1, 1, At, B1); PG8_BAR; PG8_SCHED;
        }
        if constexpr (ALIGN_EPI) { if (wr == 0) PG8_BAR; }
        E(acc, cur, wr, wc, fr, fq);
        if (!has_next) break;
#pragma unroll
        for (int a = 0; a < 2; ++a)
#pragma unroll
            for (int b = 0; b < 2; ++b)
#pragma unroll
                for (int m = 0; m < 4; ++m)
#pragma unroll
                    for (int n = 0; n < 2; ++n) acc[a][b][m][n] = (f32x4){0.f, 0.f, 0.f, 0.f};
        cur = nxt; cA = nA; cB = nB; ++ui;
#pragma unroll
        for (int h_ = 0; h_ < 2; ++h_)
#pragma unroll
            for (int i_ = 0; i_ < 2; ++i_) vC[h_][i_] = vN[h_][i_];
        if constexpr (ALIGN_EPI) { if (wr == 1) PG8_BAR; }
    }
    PG8_WAIT_V(0);
    if constexpr (!ALIGN_EPI) { if (wr == 0) PG8_BAR; }
    PG8_BAR;
#undef PG8_SA
#undef PG8_SB
#undef PG8_STAGE
#undef PG8_LDA
#undef PG8_LDB
#undef PG8_MMA
#undef PG8_WAIT_V
#undef PG8_WAIT_L
#undef PG8_BAR
#undef PG8_SCHED
#undef PG8_VOFF
}
}

__device__ __forceinline__ float gelu_fast(float v) { const float y = 0.7978845608028654f * (v + 0.044715f * v * v * v); return v * __builtin_amdgcn_rcpf(1.f + __expf(-2.f * y)); }
__device__ __forceinline__ float sigmoid_fast(float v) { return __builtin_amdgcn_rcpf(1.f + __expf(-v)); }

struct EpiZ {
    static constexpr bool PERM = true;
    bf16* R1; const float* gq; const float* gk;
    __device__ __forceinline__ void operator()(const f32x4 (&acc)[2][2][4][2], const pg8::Unit& u, int wr, int wc, int fr, int fq) const {
        const int seg = u.pn >> 1;
        bf16* base = R1 + (size_t)seg * T * 512 + (size_t)(u.pm * 256 + wr * 64 + fr) * 512 + (u.pn & 1) * 256 + wc * 64 + 8 * fq;
        if (seg == 2 || seg == 3) {
            const float* g = seg == 2 ? gq : gk; const float sc = seg == 2 ? C2 : 1.f;
            f32x4 gv[2][2];
#pragma unroll
            for (int bj = 0; bj < 2; ++bj)
#pragma unroll
                for (int n = 0; n < 2; ++n) gv[bj][n] = *(const f32x4*)(g + 32 * bj + 8 * fq + 4 * n);
#pragma unroll
            for (int ai = 0; ai < 2; ++ai)
#pragma unroll
                for (int m = 0; m < 4; ++m) {
                    float s = 0.f;
#pragma unroll
                    for (int bj = 0; bj < 2; ++bj)
#pragma unroll
                        for (int n = 0; n < 2; ++n) { const f32x4 x = acc[ai][bj][m][n]; s += (x[0] * x[0] + x[1] * x[1]) + (x[2] * x[2] + x[3] * x[3]); }
                    s += lane_xor<16>(s); s = half_sum32(s);
                    const float rs = rsqrtf(s * (1.f / 64.f) + EPS) * sc;
#pragma unroll
                    for (int bj = 0; bj < 2; ++bj) { const f32x4 v0 = acc[ai][bj][m][0] * rs * gv[bj][0], v1 = acc[ai][bj][m][1] * rs * gv[bj][1];
                        v4u w; w.x = pg8::cvt_pk_bf16(v0[0], v0[1]); w.y = pg8::cvt_pk_bf16(v0[2], v0[3]); w.z = pg8::cvt_pk_bf16(v1[0], v1[1]); w.w = pg8::cvt_pk_bf16(v1[2], v1[3]);
                        *(v4u*)(base + (size_t)(ai * 128 + m * 16) * 512 + 32 * bj) = w; }
                }
        } else {
#pragma unroll
            for (int ai = 0; ai < 2; ++ai)
#pragma unroll
                for (int m = 0; m < 4; ++m)
#pragma unroll
                    for (int bj = 0; bj < 2; ++bj) { f32x4 v0 = acc[ai][bj][m][0], v1 = acc[ai][bj][m][1];
                        if (seg == 1) { v0 = (f32x4){gelu_fast(v0[0]), gelu_fast(v0[1]), gelu_fast(v0[2]), gelu_fast(v0[3])}; v1 = (f32x4){gelu_fast(v1[0]), gelu_fast(v1[1]), gelu_fast(v1[2]), gelu_fast(v1[3])}; }
                        v4u w; w.x = pg8::cvt_pk_bf16(v0[0], v0[1]); w.y = pg8::cvt_pk_bf16(v0[2], v0[3]); w.z = pg8::cvt_pk_bf16(v1[0], v1[1]); w.w = pg8::cvt_pk_bf16(v1[2], v1[3]);
                        *(v4u*)(base + (size_t)(ai * 128 + m * 16) * 512 + 32 * bj) = w; }
        }
    }
};
__device__ __forceinline__ void phase_gemm1_fast(Ctx& C, KA AR, int l) {
    phase_cumsum_fast(C, AR);
    pg8::Gemm g{(const bf16*)(C.ws + WS_XN), (const bf16*)(C.ws + WS_WIN) + (size_t)l * NZ * D, D};
    pg8::StaticOrder S; S.init(T, NZ, gridDim.x, blockIdx.x);
    EpiZ E{(bf16*)(C.ws + WS_R1), AR->in[I_QN] + l * HD, AR->in[I_KN] + l * HD};
    pg8::gemm_phase<EpiZ, pg8::StaticOrder, true, false>(C.lds, g, S, E, C.tid);
}
struct EpiRes {
    static constexpr bool PERM = false;
    const float* xs; float* X;
    __device__ __forceinline__ void operator()(const f32x4 (&acc)[2][2][4][2], const pg8::Unit& u, int wr, int wc, int fr, int fq) const {
        const size_t off0 = (size_t)(u.pm * 256 + wr * 64 + fr) * D + u.pn * 256 + wc * 32 + 4 * fq;
#pragma unroll
        for (int ai = 0; ai < 2; ++ai)
#pragma unroll
            for (int mh = 0; mh < 2; ++mh) { f32x4 r[2][2][2];
#pragma unroll
                for (int mm = 0; mm < 2; ++mm)
#pragma unroll
                    for (int bj = 0; bj < 2; ++bj)
#pragma unroll
                        for (int n = 0; n < 2; ++n) r[mm][bj][n] = *(const f32x4*)(xs + off0 + (size_t)(ai * 128 + (2 * mh + mm) * 16) * D + bj * 128 + n * 16);
#pragma unroll
                for (int mm = 0; mm < 2; ++mm)
#pragma unroll
                    for (int bj = 0; bj < 2; ++bj)
#pragma unroll
                        for (int n = 0; n < 2; ++n) *(f32x4*)(X + off0 + (size_t)(ai * 128 + (2 * mh + mm) * 16) * D + bj * 128 + n * 16) = r[mm][bj][n] + acc[ai][bj][2 * mh + mm][n]; }
    }
};
__device__ __forceinline__ void phase_wo_fast(Ctx& C, KA AR, int l) {
    pg8::Gemm g{(const bf16*)(C.ws + WS_R2 + 16 * MiB), (const bf16*)(C.ws + WS_WOUT) + (size_t)l * D * D, D};
    pg8::StaticOrder S; S.init(T, D, gridDim.x, blockIdx.x);
    EpiRes E{l == 0 ? AR->in[I_X] : (const float*)(C.ws + WS_X), (float*)(C.ws + WS_X)};
    pg8::gemm_phase<EpiRes, pg8::StaticOrder, true, false>(C.lds, g, S, E, C.tid);
}
struct EpiProj {
    static constexpr bool PERM = true;
    bf16* PR;
    __device__ __forceinline__ void operator()(const f32x4 (&acc)[2][2][4][2], const pg8::Unit& u, int wr, int wc, int fr, int fq) const {
        bf16* base = PR + (size_t)(u.pm * 256 + wr * 64 + fr) * D + u.pn * 256 + wc * 32 + 8 * fq;
#pragma unroll
        for (int ai = 0; ai < 2; ++ai)
#pragma unroll
            for (int m = 0; m < 4; ++m)
#pragma unroll
                for (int bj = 0; bj < 2; ++bj) { const f32x4 v0 = acc[ai][bj][m][0], v1 = acc[ai][bj][m][1];
                    v4u w; w.x = pg8::cvt_pk_bf16(v0[0], v0[1]); w.y = pg8::cvt_pk_bf16(v0[2], v0[3]); w.z = pg8::cvt_pk_bf16(v1[0], v1[1]); w.w = pg8::cvt_pk_bf16(v1[2], v1[3]);
                    *(v4u*)(base + (size_t)(ai * 128 + m * 16) * D + bj * 128) = w; }
    }
};
__device__ __forceinline__ void phase_proj_fast(Ctx& C, KA AR, int l) {
    pg8::Gemm g{(const bf16*)(C.ws + WS_PB) + (size_t)l * T * PLE, (const bf16*)(C.ws + WS_WPP) + (size_t)l * D * PLE, PLE};
    pg8::StaticOrder S;
    { const int G = gridDim.x, hb = G / 2; if ((int)blockIdx.x >= hb) S.init(T, D, G - hb, (int)blockIdx.x - hb); else S.init(T, D, G - hb, T); }
    EpiProj E{(bf16*)(C.ws + WS_PROJ)};
    pg8::gemm_phase<EpiProj, pg8::StaticOrder, true, false>(C.lds, g, S, E, C.tid);
}
struct EpiPle {
    static constexpr bool PERM = false;
    const float* X; const bf16* PR; const float* bias; float* dst; float pscale;
    __device__ __forceinline__ void operator()(const f32x4 (&acc)[2][2][4][2], const pg8::Unit& u, int wr, int wc, int fr, int fq) const {
        const int col0 = u.pn * 256 + wc * 32 + 4 * fq;
        const size_t off0 = (size_t)(u.pm * 256 + wr * 64 + fr) * D + col0;
        f32x4 bv[2][2];
#pragma unroll
        for (int bj = 0; bj < 2; ++bj)
#pragma unroll
            for (int n = 0; n < 2; ++n) bv[bj][n] = *(const f32x4*)(bias + col0 + bj * 128 + n * 16);
#pragma unroll
        for (int ai = 0; ai < 2; ++ai)
#pragma unroll
            for (int mh = 0; mh < 2; ++mh) { f32x4 xr[2][2][2]; v2u pr[2][2][2];
#pragma unroll
                for (int mm = 0; mm < 2; ++mm)
#pragma unroll
                    for (int bj = 0; bj < 2; ++bj)
#pragma unroll
                        for (int n = 0; n < 2; ++n) { const size_t o = off0 + (size_t)(ai * 128 + (2 * mh + mm) * 16) * D + bj * 128 + n * 16; xr[mm][bj][n] = *(const f32x4*)(X + o); pr[mm][bj][n] = *(const v2u*)(PR + o); }
#pragma unroll
                for (int mm = 0; mm < 2; ++mm)
#pragma unroll
                    for (int bj = 0; bj < 2; ++bj)
#pragma unroll
                        for (int n = 0; n < 2; ++n) { const size_t o = off0 + (size_t)(ai * 128 + (2 * mh + mm) * 16) * D + bj * 128 + n * 16;
                            const v2u pw = pr[mm][bj][n]; const f32x4 a = acc[ai][bj][2 * mh + mm][n] + bv[bj][n]; const f32x4 x = xr[mm][bj][n];
                            f32x4 r; r[0] = x[0] + bflo(pw.x) * sigmoid_fast(a[0]); r[1] = x[1] + bfhi(pw.x) * sigmoid_fast(a[1]); r[2] = x[2] + bflo(pw.y) * sigmoid_fast(a[2]); r[3] = x[3] + bfhi(pw.y) * sigmoid_fast(a[3]);
                            if (PROBE_TIMING) r = r * pscale;
                            *(f32x4*)(dst + o) = r; } }
    }
};
__device__ __forceinline__ void phase_ple_fast(Ctx& C, KA AR, int l) {
    pg8::Gemm g{(const bf16*)(C.ws + WS_XN), (const bf16*)(C.ws + WS_WPG) + (size_t)l * D * D, D};
    pg8::StaticOrder S; S.init(T, D, gridDim.x, blockIdx.x);
    float pscale = 1.f;
    if (PROBE_TIMING && l == DEPTH - 1) { const unsigned long long* ts = (const unsigned long long*)((const unsigned*)(C.ws + WS_CTL) + CW_TS); pscale = 1.f + (float)(ts[PROBE_HI] - ts[PROBE_LO]) * 1.5e-6f; }
    EpiPle E{(const float*)(C.ws + WS_X), (const bf16*)(C.ws + WS_PROJ), AR->in[I_BPG] + l * D, l == DEPTH - 1 ? AR->out : (float*)(C.ws + WS_X), pscale};
    pg8::gemm_phase<EpiPle, pg8::StaticOrder, true, false>(C.lds, g, S, E, C.tid);
}
constexpr int TAB_OFF = MISC_OFF - 4096;
struct GroupOrder {
    const LAS int* tab; int G, c; const int* rowpair; const char* hbase; bool is_g2;
    __device__ bool next(int i, pg8::Unit& u) const {
        int j = i * (G >> 3) + (c >> 3);
#pragma unroll
        for (int q = 0; q < 4; ++q) { const int e = (c & 7) + 8 * q;
            const int t0 = __builtin_amdgcn_readfirstlane(tab[64 + e]), t1 = __builtin_amdgcn_readfirstlane(tab[64 + e + 1]), nu = (t1 - t0) * 4;
            if (j < nu) { const int mt = j >> 2; const int ne = __builtin_amdgcn_readfirstlane(tab[e]), ho = __builtin_amdgcn_readfirstlane(tab[32 + e]);
                int nv = ne - 256 * mt; nv = nv > 256 ? 256 : nv;
                u.pm = ho + 256 * mt; u.pn = j & 3; u.e = e; u.aux = nv; u.mt = mt; return true; }
            j -= nu; }
        return false;
    }
    __device__ __forceinline__ const char* a_base(const pg8::Gemm& g, const pg8::Unit& u) const { return is_g2 ? (const char*)g.A + (size_t)u.pm * 2 * g.K : (const char*)g.A; }
    __device__ __forceinline__ const char* b_base(const pg8::Gemm& g, const pg8::Unit& u) const { return (const char*)g.Bt + (size_t)(u.e * 1024 + u.pn * 256) * 2 * g.K; }
    __device__ __forceinline__ int a_row(const pg8::Unit& u, int r) const { return r < u.aux ? (rowpair[(size_t)u.e * CAP + u.mt * 256 + r] >> 1) : 0; }
};
__device__ __forceinline__ void build_exptab256(Ctx& C, int l, LAS int* tab) {
    __syncthreads();
    if (C.tid < NE) { const unsigned* cnt = (const unsigned*)(C.ws + WS_CTL) + CW_CNT + 32 * CNT_STRIDE * l;
        tab[C.tid] = (int)__hip_atomic_load(cnt + C.tid * CNT_STRIDE, __ATOMIC_RELAXED, __HIP_MEMORY_SCOPE_AGENT); }
    __syncthreads();
    if (C.tid == 0) { int ho = 0, tt = 0;
        for (int e = 0; e < NE; ++e) { const int n = tab[e]; tab[32 + e] = ho; tab[64 + e] = tt;
            const int nt = (n + 255) >> 8; for (int j = 0; j < nt; ++j) tab[128 + tt + j] = e | (j << 8); ho += nt << 8; tt += nt; }
        tab[64 + NE] = tt; }
    __syncthreads();
}
struct EpiG1 {
    static constexpr bool PERM = true;
    bf16* Hb;
    __device__ __forceinline__ void operator()(const f32x4 (&acc)[2][2][4][2], const pg8::Unit& u, int wr, int wc, int fr, int fq) const {
        bf16* base = Hb + (size_t)(u.pm + wr * 64 + fr) * DE + u.pn * 128 + wc * 32 + 8 * fq;
#pragma unroll
        for (int ai = 0; ai < 2; ++ai)
#pragma unroll
            for (int m = 0; m < 4; ++m) { const int rl = ai * 128 + wr * 64 + m * 16 + fr;
                f32x4 h0, h1;
#pragma unroll
                for (int e = 0; e < 4; ++e) { const float g0 = acc[ai][0][m][0][e], g1 = acc[ai][0][m][1][e]; h0[e] = g0 * sigmoid_fast(g0) * acc[ai][1][m][0][e]; h1[e] = g1 * sigmoid_fast(g1) * acc[ai][1][m][1][e]; }
                v4u w; w.x = pg8::cvt_pk_bf16(h0[0], h0[1]); w.y = pg8::cvt_pk_bf16(h0[2], h0[3]); w.z = pg8::cvt_pk_bf16(h1[0], h1[1]); w.w = pg8::cvt_pk_bf16(h1[2], h1[3]);
                if (rl < u.aux) *(v4u*)(base + (size_t)(ai * 128 + m * 16) * DE) = w; }
    }
};
__device__ __forceinline__ void phase_g1_fast(Ctx& C, KA AR, int l) {
    LAS int* tab = (LAS int*)(C.lds + TAB_OFF); build_exptab256(C, l, tab);
    pg8::Gemm g{(const bf16*)(C.ws + WS_XN), (const bf16*)(C.ws + WS_WGU) + (size_t)l * NE * 1024 * D, D};
    GroupOrder S{tab, (int)gridDim.x, (int)blockIdx.x, (const int*)(C.ws + WS_ROWPAIR), nullptr, false};
    EpiG1 E{(bf16*)(C.ws + WS_R2)};
    pg8::gemm_phase<EpiG1, GroupOrder, true, true>(C.lds, g, S, E, C.tid);
}
struct EpiG2 {
    static constexpr bool PERM = true;
    bf16* Y2; const int* rowpair; const float* pairw;
    __device__ __forceinline__ void operator()(const f32x4 (&acc)[2][2][4][2], const pg8::Unit& u, int wr, int wc, int fr, int fq) const {
        const int* rp = rowpair + (size_t)u.e * CAP + u.mt * 256; const int col0 = u.pn * 256 + wc * 32 + 8 * fq;
        int pr[2][4]; float wv[2][4];
#pragma unroll
        for (int ai = 0; ai < 2; ++ai)
#pragma unroll
            for (int m = 0; m < 4; ++m) { const int rl = ai * 128 + wr * 64 + m * 16 + fr; pr[ai][m] = rl < u.aux ? rp[rl] : 0; }
#pragma unroll
        for (int ai = 0; ai < 2; ++ai)
#pragma unroll
            for (int m = 0; m < 4; ++m) wv[ai][m] = pairw[pr[ai][m]];
#pragma unroll
        for (int ai = 0; ai < 2; ++ai)
#pragma unroll
            for (int m = 0; m < 4; ++m) { const int rl = ai * 128 + wr * 64 + m * 16 + fr;
                if (rl < u.aux) { const float w8 = wv[ai][m]; bf16* row = Y2 + (size_t)pr[ai][m] * D + col0;
#pragma unroll
                    for (int bj = 0; bj < 2; ++bj) { const f32x4 v0 = acc[ai][bj][m][0] * w8, v1 = acc[ai][bj][m][1] * w8;
                        v4u w; w.x = pg8::cvt_pk_bf16(v0[0], v0[1]); w.y = pg8::cvt_pk_bf16(v0[2], v0[3]); w.z = pg8::cvt_pk_bf16(v1[0], v1[1]); w.w = pg8::cvt_pk_bf16(v1[2], v1[3]);
                        *(v4u*)(row + bj * 128) = w; } } }
    }
};
__device__ __forceinline__ void phase_g2_fast(Ctx& C, KA AR, int l) {
    LAS int* tab = (LAS int*)(C.lds + TAB_OFF); build_exptab256(C, l, tab);
    pg8::Gemm g{(const bf16*)(C.ws + WS_R2), (const bf16*)(C.ws + WS_WDN) + (size_t)l * NE * D * DE, DE};
    GroupOrder S{tab, (int)gridDim.x, (int)blockIdx.x, (const int*)(C.ws + WS_ROWPAIR), nullptr, true};
    EpiG2 E{(bf16*)(C.ws + WS_R1), (const int*)(C.ws + WS_ROWPAIR), (const float*)(C.ws + WS_PAIRW)};
    pg8::gemm_phase<EpiG2, GroupOrder, true, false>(C.lds, g, S, E, C.tid);
}

#define SBAR() __builtin_amdgcn_sched_barrier(0)
namespace attn_body {
using bf16=__hip_bfloat16;
using bf16x8=__attribute__((ext_vector_type(8)))short;
using s16x4=__attribute__((ext_vector_type(4)))short;
using f32x16=__attribute__((ext_vector_type(16)))float;
using u32x4=__attribute__((ext_vector_type(4)))unsigned;
constexpr int BATCH=4,NHEAD=8,SEQ=4096,D=64,DM=NHEAD*D;
constexpr int NW=8,QBLK=32,QB=QBLK*NW,KVBLK=64,NQB=SEQ/QB;
constexpr int ATTN_PITCH=DM, ATTN_UNIT_ROWS=QB;
__device__ __forceinline__ int crow(int r,int hi){return (r&3)+8*(r>>2)+4*hi;}
#define SBAR() __builtin_amdgcn_sched_barrier(0)
__device__ __forceinline__ void cmask(f32x16&p0,f32x16&p1,int jb,int qrel,int hi){
  const float NEG=-INFINITY; int kb=64*jb+4*hi;
  #pragma unroll
  for(int r=0;r<16;++r){int kv=kb+(r&3)+8*(r>>2); if(kv>qrel)p0[r]=NEG; if(kv+32>qrel)p1[r]=NEG;}
}

constexpr int NSLOT=3, SLOTB=8192;
constexpr int LDS_K=0, LDS_V=NSLOT*SLOTB, LDS_WS=2*NSLOT*SLOTB, LDS_OST=LDS_WS+NW*64*4, LDS_CK=LDS_OST+NW*4096, LDS_BYTES=LDS_CK+SEQ*4;
constexpr float C2=0.125f*1.4426950408889634f;
__device__ __forceinline__ void glds16(const void*gsrc,unsigned lds_dst){unsigned keep;
  asm volatile("s_mov_b32 %0, m0\n\ts_mov_b32 m0, %2\n\ts_nop 0\n\tglobal_load_lds_dwordx4 %1, off\n\ts_mov_b32 m0, %0":"=&s"(keep):"v"(gsrc),"s"(lds_dst):"memory");}
__device__ __forceinline__ float max3f(float a,float b,float c){float r;asm("v_max3_f32 %0, %1, %2, %3":"=v"(r):"v"(a),"v"(b),"v"(c));return r;}
__device__ __forceinline__ float max2f(float a,float b){float r;asm("v_max_f32_e32 %0, %1, %2":"=v"(r):"v"(a),"v"(b));return r;}
__device__ __forceinline__ float fadd_s(float a,float b){float r;asm("v_add_f32_e32 %0, %1, %2":"=v"(r):"v"(a),"v"(b));return r;}
__device__ __forceinline__ float fsub_s(float a,float b){float r;asm("v_sub_f32_e32 %0, %1, %2":"=v"(r):"v"(a),"v"(b));return r;}
typedef float f32x2_t __attribute__((ext_vector_type(2))); typedef __bf16 bf16x2_t __attribute__((ext_vector_type(2)));
__device__ __forceinline__ unsigned cvtpk_s(float lo,float hi){f32x2_t v={lo,hi};bf16x2_t b=__builtin_convertvector(v,bf16x2_t);return __builtin_bit_cast(unsigned,b);}
#define WAIT_BAR(N) asm volatile("s_waitcnt vmcnt(" #N ") lgkmcnt(0)\n\ts_barrier":::"memory")

__device__ __forceinline__ void qkt(f32x16&p0,f32x16&p1,const char*Kslot,const bf16x8*qr,const f32x16&negm,int r32,int hi){
  const char*kb=Kslot+hi*1024+r32*16;
  #pragma unroll
  for(int d0=0;d0<4;++d0){
    const bf16x8 b0=*reinterpret_cast<const bf16x8*>(kb+d0*2048);
    const bf16x8 b1=*reinterpret_cast<const bf16x8*>(kb+d0*2048+512);
    if(d0==0){p0=__builtin_amdgcn_mfma_f32_32x32x16_bf16(b0,qr[0],negm,0,0,0);p1=__builtin_amdgcn_mfma_f32_32x32x16_bf16(b1,qr[0],negm,0,0,0);}
    else{p0=__builtin_amdgcn_mfma_f32_32x32x16_bf16(b0,qr[d0],p0,0,0,0);p1=__builtin_amdgcn_mfma_f32_32x32x16_bf16(b1,qr[d0],p1,0,0,0);}}
}
typedef __attribute__((address_space(3))) const char* lds_cptr;
typedef short v4i16_t __attribute__((ext_vector_type(4)));
__device__ __forceinline__ void kload8(bf16x8*kf,lds_cptr kp){
  kf[0]=*(const __attribute__((address_space(3))) bf16x8*)(kp);      kf[1]=*(const __attribute__((address_space(3))) bf16x8*)(kp+512);
  kf[2]=*(const __attribute__((address_space(3))) bf16x8*)(kp+2048); kf[3]=*(const __attribute__((address_space(3))) bf16x8*)(kp+2560);
  kf[4]=*(const __attribute__((address_space(3))) bf16x8*)(kp+4096); kf[5]=*(const __attribute__((address_space(3))) bf16x8*)(kp+4608);
  kf[6]=*(const __attribute__((address_space(3))) bf16x8*)(kp+6144); kf[7]=*(const __attribute__((address_space(3))) bf16x8*)(kp+6656);
}
__device__ __forceinline__ void kload2(bf16x8*kf,lds_cptr kp,int j){ kf[2*j]=*(const __attribute__((address_space(3))) bf16x8*)(kp+j*2048); kf[2*j+1]=*(const __attribute__((address_space(3))) bf16x8*)(kp+j*2048+512); }
__device__ __forceinline__ s16x4 vtr(lds_cptr p){ return __builtin_bit_cast(s16x4,__builtin_amdgcn_ds_read_tr16_b64_v4i16((__attribute__((address_space(3))) v4i16_t*)p)); }
__device__ __forceinline__ float rowmax(const f32x16&p0,const f32x16&p1){
  float a=max3f(p0[0],p0[1],p1[0]),b=max3f(p0[2],p0[3],p1[1]);a=max3f(a,p1[2],p1[3]);
  #pragma unroll
  for(int r=4;r<16;r+=4){a=max3f(a,p0[r],p0[r+1]);b=max3f(b,p0[r+2],p0[r+3]);a=max3f(a,p1[r],p1[r+1]);b=max3f(b,p1[r+2],p1[r+3]);}
  const float m=max2f(a,b);
  auto rr=__builtin_amdgcn_permlane32_swap(__float_as_uint(m),__float_as_uint(m),false,false);
  return max2f(__uint_as_float(rr[0]),__uint_as_float(rr[1]));
}
__device__ __forceinline__ void pv(f32x16*o,int vb,bf16x8 pa0,bf16x8 pa1,bf16x8 pa2,bf16x8 pa3){
  #pragma unroll
  for(int d0=0;d0<2;++d0){s16x4 lo[4],hi[4];
    #pragma unroll
    for(int ks=0;ks<4;++ks){
      asm volatile("ds_read_b64_tr_b16 %0,%1 offset:%c2":"=&v"(lo[ks]):"v"(vb),"i"(d0*4096+ks*1024):"memory");
      asm volatile("ds_read_b64_tr_b16 %0,%1 offset:%c2":"=&v"(hi[ks]):"v"(vb),"i"(d0*4096+ks*1024+512):"memory");}
    asm volatile("s_waitcnt lgkmcnt(0)":::"memory");SBAR();
    #define PK(k) (bf16x8){lo[k][0],lo[k][1],lo[k][2],lo[k][3],hi[k][0],hi[k][1],hi[k][2],hi[k][3]}
    o[d0]=__builtin_amdgcn_mfma_f32_32x32x16_bf16(pa0,PK(0),o[d0],0,0,0);
    o[d0]=__builtin_amdgcn_mfma_f32_32x32x16_bf16(pa1,PK(1),o[d0],0,0,0);
    o[d0]=__builtin_amdgcn_mfma_f32_32x32x16_bf16(pa2,PK(2),o[d0],0,0,0);
    o[d0]=__builtin_amdgcn_mfma_f32_32x32x16_bf16(pa3,PK(3),o[d0],0,0,0);
    #undef PK
  }
}

#ifndef ATTN_STORE16
#define ATTN_STORE16(p,v) (*(u32x4*)(p)=(v))
#endif
template<int THRL> __device__ __forceinline__ void attn_unit(int b,int h,int qb,const bf16*Q,const bf16*__restrict__ K,const bf16*__restrict__ V,bf16*O,const float*__restrict__ C2K,const float thr2,char*shm,const int tid){
  const int lane=tid&63,r32=lane&31,hi=lane>>5; const int wid=__builtin_amdgcn_readfirstlane(tid>>6);
  const long rowbase=(long)b*SEQ; const int q0=qb*QB;
  const bf16*Qw=Q+(rowbase+q0+wid*QBLK)*DM+h*D;
  const int NT0=(q0+QB)/KVBLK;
  const float*ckg0=C2K+(long)(b*NHEAD+h)*SEQ; float base=ckg0[q0+(tid>>6)*QBLK+r32];
  int ts; { const float cl=lane<NT0?ckg0[KVBLK*lane+KVBLK-1]:ckg0[q0]; const unsigned long long mk=__builtin_amdgcn_ballot_w64(lane<NT0&&(ckg0[q0]-cl>=-thr2));
    ts=mk?(int)__builtin_ctzll(mk):NT0-4; ts&=~1; ts=ts>NT0-4?NT0-4:ts; ts=__builtin_amdgcn_readfirstlane(ts); }
  const int NT=NT0-ts;
  const bf16*Kh=K+(rowbase+(long)ts*KVBLK)*DM+h*D,*Vh=V+(rowbase+(long)ts*KVBLK)*DM+h*D; const float*ckg=ckg0+ts*KVBLK;
  typedef __attribute__((address_space(3))) float lds_f32; typedef float f32x4_t __attribute__((ext_vector_type(4)));
  lds_f32*const nbl=(lds_f32*)((__attribute__((address_space(3))) char*)shm+LDS_CK);
  for(int i=tid;i<NT*KVBLK;i+=NW*64)nbl[i]=-ckg[i];
  const unsigned lds0=(unsigned)(uintptr_t)shm;
  float*wsf=(float*)(shm+LDS_WS)+wid*64;
  const bf16*ksrc=Kh+(long)lane*DM+wid*8;
  const bf16*vsrc=Vh+(long)(16*(wid&3)+(lane>>2))*DM+(wid>>2)*32+(lane&3)*8;
  const unsigned kdst=lds0+LDS_K+wid*1024, vdst=lds0+LDS_V+wid*1024;
  #define DMA_K(t,slot) glds16(ksrc+(long)(t)*KVBLK*DM,(unsigned)__builtin_amdgcn_readfirstlane(kdst+(slot)))
  #define DMA_V(t,slot) glds16(vsrc+(long)(t)*KVBLK*DM,(unsigned)__builtin_amdgcn_readfirstlane(vdst+(slot)))
  const int vb0=(int)(lds0+LDS_V)+((lane>>4)&1)*32+(lane&3)*8+(4*hi+((lane&15)>>2))*64;
  const char*Kbase=shm+LDS_K; bf16x8 kf[8];
  const lds_cptr shm3=(lds_cptr)shm; const lds_cptr kp0=shm3+LDS_K+hi*1024+r32*16; const lds_cptr vp0=shm3+LDS_V+((lane>>4)&1)*32+(lane&3)*8+(4*hi+((lane&15)>>2))*64;
  DMA_K(0,0);DMA_V(0,0);DMA_K(1,SLOTB);
  bf16x8 qr[4];
  #pragma unroll
  for(int d0=0;d0<4;++d0)qr[d0]=*reinterpret_cast<const bf16x8*>(&Qw[(long)r32*DM+d0*16+hi*8]);
  float l_reg=0.f;f32x16 o[2];o[0]=f32x16{};o[1]=f32x16{};const f32x16 negm=f32x16{};
  const int qrel=wid*QBLK+r32;
  #define CMASK(P0,P1,t) do{int jb_=(t)-(NT-4); if(jb_>=0)cmask(P0,P1,jb_,qrel,hi);}while(0)
  #define KBIAS(P0,P1,t) do{ const lds_f32*nb_=nbl+64*(t)+4*hi; _Pragma("unroll") for(int g_=0;g_<4;++g_){ \
    { const f32x4_t b0_=*(const __attribute__((address_space(3))) f32x4_t*)(nb_+8*g_); _Pragma("unroll") for(int j_=0;j_<4;++j_)P0[4*g_+j_]+=(b0_[j_]+base); } SBAR(); \
    { const f32x4_t b1_=*(const __attribute__((address_space(3))) f32x4_t*)(nb_+32+8*g_); _Pragma("unroll") for(int j_=0;j_<4;++j_)P1[4*g_+j_]+=(b1_[j_]+base); } SBAR(); } }while(0)
  bool resc=false;
  #define START(P0,P1) do{ const float rm=rowmax(P0,P1); resc=false; \
    { const float dl=rm; base=fsub_s(base,dl); \
      _Pragma("unroll") for(int r=0;r<16;++r){P0[r]=fsub_s(P0[r],dl);P1[r]=fsub_s(P1[r],dl);} \
      } \
    _Pragma("unroll") for(int r=0;r<16;++r)P0[r]=__builtin_amdgcn_exp2f(P0[r]); }while(0)
  #define RESC() do{ if(resc){ asm volatile("s_waitcnt lgkmcnt(0)":::"memory"); \
      _Pragma("unroll") for(int d_=0;d_<2;++d_) _Pragma("unroll") for(int r=0;r<16;++r)o[d_][r]*=wsf[crow(r,hi)]; } }while(0)
  f32x16 pA0,pA1,pB0,pB1;
  int sl_prev=0,sl_cur=0,sl_next=SLOTB;
  #define ROT() do{sl_prev=sl_cur;sl_cur=sl_next;sl_next=(sl_next==(NSLOT-1)*SLOTB)?0:sl_next+SLOTB;}while(0)
  DMA_K(2,2*SLOTB);
  WAIT_BAR(3);
  qkt(pA0,pA1,Kbase,qr,negm,r32,hi);asm volatile("s_nop 15\n\ts_nop 7":"+v"(pA0),"+v"(pA1));KBIAS(pA0,pA1,0);CMASK(pA0,pA1,0);
  START(pA0,pA1);
  _Pragma("unroll") for(int r=0;r<16;++r)pA1[r]=__builtin_amdgcn_exp2f(pA1[r]);
  WAIT_BAR(0);
  DMA_K(3,0);DMA_V(1,SLOTB);
  ROT();
  kload8(kf,kp0+sl_cur);
  WAIT_BAR(2);
  s16x4 vlo[8],vhi[8]; u32x4 pw0,pw1,pw2,pw3;
  #define PKW(P,B) cvtpk_s(P[B],P[B+1])
  #define PAF(k) __builtin_bit_cast(bf16x8,pw##k)
  #define VFR(i) (bf16x8){vlo[i][0],vlo[i][1],vlo[i][2],vlo[i][3],vhi[i][0],vhi[i][1],vhi[i][2],vhi[i][3]}
  #define PIN(x) asm volatile("":"+v"(x))
  #define MX3(a,b,c) __builtin_fmaxf(__builtin_fmaxf((a),(b)),(c))
  #define GAPA(MF,A0,A1,A2,A3,W0,W1,PW) do{ MF; sacc+=A0; sacc+=A1; sacc+=A2; sacc+=A3; PIN(sacc); W0; W1; PIN(PW); SBAR(); }while(0)
  #define EX(v) __builtin_amdgcn_exp2f(v)
  #define GAPB(MF,X,B) do{ MF; X[B]=EX(X[B]); X[B+1]=EX(X[B+1]); X[B+2]=EX(X[B+2]); X[B+3]=EX(X[B+3]); PIN(X); SBAR(); }while(0)
  #define VRD(i) do{ vlo[i]=vtr(vp_+(((i)>>2)*4096+((i)&3)*1024)); vhi[i]=vtr(vp_+(((i)>>2)*4096+((i)&3)*1024+512)); }while(0)
  #define KRD(G,j) do{ if(G){ kload2(kf,kp0+sl_next,j); SBAR(); } }while(0)
  #define STEP(C0,C1,P0,P1,t,GK,GV,GL) do{ SBAR(); \
    const lds_cptr vp_=vp0+sl_prev; \
    VRD(0); SBAR(); float sacc=(P0[0]+P0[1]); \
    GAPA(C0=__builtin_amdgcn_mfma_f32_32x32x16_bf16(kf[0],qr[0],negm,0,0,0), P0[2],P0[3],P0[4],P0[5],     pw0[0]=PKW(P0,0), pw0[1]=PKW(P0,2), pw0); \
    VRD(4); SBAR(); GAPA(C1=__builtin_amdgcn_mfma_f32_32x32x16_bf16(kf[1],qr[0],negm,0,0,0), P0[6],P0[7],P0[8],P0[9],     pw0[2]=PKW(P0,4), pw0[3]=PKW(P0,6), pw0); \
    VRD(1); SBAR(); GAPA(C0=__builtin_amdgcn_mfma_f32_32x32x16_bf16(kf[2],qr[1],C0,0,0,0),   P0[10],P0[11],P0[12],P0[13], pw1[0]=PKW(P0,8), pw1[1]=PKW(P0,10), pw1); \
    VRD(5); SBAR(); GAPA(C1=__builtin_amdgcn_mfma_f32_32x32x16_bf16(kf[3],qr[1],C1,0,0,0),   P0[14],P0[15],P1[0],P1[1],   pw1[2]=PKW(P0,12),pw1[3]=PKW(P0,14), pw1); \
    VRD(2); SBAR(); GAPA(C0=__builtin_amdgcn_mfma_f32_32x32x16_bf16(kf[4],qr[2],C0,0,0,0),   P1[2],P1[3],P1[4],P1[5],     pw2[0]=PKW(P1,0), pw2[1]=PKW(P1,2), pw2); \
    VRD(6); SBAR(); GAPA(C1=__builtin_amdgcn_mfma_f32_32x32x16_bf16(kf[5],qr[2],C1,0,0,0),   P1[6],P1[7],P1[8],P1[9],     pw2[2]=PKW(P1,4), pw2[3]=PKW(P1,6), pw2); \
    VRD(3); SBAR(); GAPA(C0=__builtin_amdgcn_mfma_f32_32x32x16_bf16(kf[6],qr[3],C0,0,0,0),   P1[10],P1[11],P1[12],P1[13], pw3[0]=PKW(P1,8), pw3[1]=PKW(P1,10), pw3); \
    VRD(7); SBAR(); GAPA(C1=__builtin_amdgcn_mfma_f32_32x32x16_bf16(kf[7],qr[3],C1,0,0,0),   P1[14],P1[15],0.f,0.f,       pw3[2]=PKW(P1,12),pw3[3]=PKW(P1,14), pw3); \
    l_reg+=sacc; \
    if(GK){DMA_K((t)+3,sl_cur);} if(GV){DMA_V((t)+1,sl_next);} \
    KBIAS(C0,C1,t); \
    CMASK(C0,C1,t); \
    { float a=MX3(C0[0],C0[1],C1[0]),b=MX3(C0[2],C0[3],C1[1]); a=MX3(a,C1[2],C1[3]); \
      _Pragma("unroll") for(int r=4;r<16;r+=4){a=MX3(a,C0[r],C0[r+1]);b=MX3(b,C0[r+2],C0[r+3]);a=MX3(a,C1[r],C1[r+1]);b=MX3(b,C1[r+2],C1[r+3]);} \
      float rm=__builtin_fmaxf(a,b); { auto rr=__builtin_amdgcn_permlane32_swap(__float_as_uint(rm),__float_as_uint(rm),false,false); rm=__builtin_fmaxf(__uint_as_float(rr[0]),__uint_as_float(rr[1])); } \
      resc=false; \
      if(__builtin_expect(__any(rm>(float)THRL),0)){ const float dl=__builtin_fmaxf(rm,0.f); base-=dl; \
        _Pragma("unroll") for(int r=0;r<16;++r){C0[r]-=dl;C1[r]-=dl;} \
        const float f=__builtin_amdgcn_exp2f(-dl); l_reg*=f; if(hi==0)wsf[r32]=f; resc=true; } } \
    SBAR(); \
    GAPB(o[0]=__builtin_amdgcn_mfma_f32_32x32x16_bf16(PAF(0),VFR(0),o[0],0,0,0), C0,0); \
    GAPB(o[1]=__builtin_amdgcn_mfma_f32_32x32x16_bf16(PAF(0),VFR(4),o[1],0,0,0), C0,4); \
    KRD(GL,0); GAPB(o[0]=__builtin_amdgcn_mfma_f32_32x32x16_bf16(PAF(1),VFR(1),o[0],0,0,0), C0,8); \
    KRD(GL,1); GAPB(o[1]=__builtin_amdgcn_mfma_f32_32x32x16_bf16(PAF(1),VFR(5),o[1],0,0,0), C0,12); \
    KRD(GL,2); GAPB(o[0]=__builtin_amdgcn_mfma_f32_32x32x16_bf16(PAF(2),VFR(2),o[0],0,0,0), C1,0); \
    KRD(GL,3); GAPB(o[1]=__builtin_amdgcn_mfma_f32_32x32x16_bf16(PAF(2),VFR(6),o[1],0,0,0), C1,4); \
    GAPB(o[0]=__builtin_amdgcn_mfma_f32_32x32x16_bf16(PAF(3),VFR(3),o[0],0,0,0), C1,8); \
    GAPB(o[1]=__builtin_amdgcn_mfma_f32_32x32x16_bf16(PAF(3),VFR(7),o[1],0,0,0), C1,12); \
    }while(0)
  int t=1;
  #undef CMASK
  #define CMASK(P0,P1,t) do{}while(0)
  for(;t+5<NT;t+=2){
    STEP(pB0,pB1,pA0,pA1,t,true,true,true);     WAIT_BAR(2); RESC(); ROT();
    STEP(pA0,pA1,pB0,pB1,t+1,true,true,true);   WAIT_BAR(2); RESC(); ROT();
  }
  #undef CMASK
  #define CMASK(P0,P1,t) do{int jb_=(t)-(NT-4); if(jb_>=0)cmask(P0,P1,jb_,qrel,hi);}while(0)
  #define ENDW(tt) do{ if((tt)+3<NT){WAIT_BAR(2);} else if((tt)+2<NT){WAIT_BAR(1);} else {WAIT_BAR(0);} }while(0)
  for(;t+1<NT;t+=2){
    STEP(pB0,pB1,pA0,pA1,t,(t+3<NT),(t+1<NT),(t+1<NT));       ENDW(t);   RESC(); ROT();
    STEP(pA0,pA1,pB0,pB1,t+1,(t+4<NT),(t+2<NT),(t+2<NT));     ENDW(t+1); RESC(); ROT();
  }
  STEP(pB0,pB1,pA0,pA1,NT-1,false,false,false); RESC();
  { float sacc=pB0[0]+pB0[1]; _Pragma("unroll") for(int r=2;r<16;++r)sacc+=pB0[r]; _Pragma("unroll") for(int r=0;r<16;++r)sacc+=pB1[r]; l_reg+=sacc;
    pw0=(u32x4){PKW(pB0,0),PKW(pB0,2),PKW(pB0,4),PKW(pB0,6)};pw1=(u32x4){PKW(pB0,8),PKW(pB0,10),PKW(pB0,12),PKW(pB0,14)};pw2=(u32x4){PKW(pB1,0),PKW(pB1,2),PKW(pB1,4),PKW(pB1,6)};pw3=(u32x4){PKW(pB1,8),PKW(pB1,10),PKW(pB1,12),PKW(pB1,14)};
    SBAR(); pv(o,vb0+sl_cur,PAF(0),PAF(1),PAF(2),PAF(3)); }
  #undef PKW
  #undef PAF
  #undef VFR
  #undef PIN
  #undef MX3
  #undef GAPA
  #undef GAPB
  #undef EX
  #undef VRD
  #undef KRD
  #undef STEP
  #undef ENDW
  {auto rr=__builtin_amdgcn_permlane32_swap(__float_as_uint(l_reg),__float_as_uint(l_reg),false,false);l_reg=__uint_as_float(rr[0])+__uint_as_float(rr[1]);}
  if(hi==0)wsf[32+r32]=l_reg;asm volatile("s_waitcnt lgkmcnt(0)":::"memory");
  float rli[16];
  #pragma unroll
  for(int r=0;r<16;++r)rli[r]=__builtin_amdgcn_rcpf(wsf[32+crow(r,hi)]);
  bf16*Ow=O+(rowbase+q0+wid*QBLK)*DM+h*D;
  { bf16*stg=(bf16*)(shm+LDS_OST)+wid*2048;
    #pragma unroll
    for(int r=0;r<16;++r){const int orow=crow(r,hi);
      #pragma unroll
      for(int d0=0;d0<2;++d0)stg[orow*64+d0*32+r32]=__float2bfloat16(o[d0][r]*rli[r]);}
    asm volatile("s_waitcnt lgkmcnt(0)":::"memory");
    #pragma unroll
    for(int i=0;i<4;++i){const int row=i*8+(lane>>3),ch=lane&7; const u32x4 v=*(const u32x4*)(stg+row*64+ch*8); ATTN_STORE16(Ow+(long)row*DM+ch*8,v);} }
  asm volatile("s_waitcnt lgkmcnt(0)\n\ts_barrier":::"memory");
  #undef DMA_K
  #undef DMA_V
  #undef CMASK
  #undef KBIAS
  #undef START
  #undef RESC
  #undef ROT
}
constexpr int ATTN_LDS_BYTES=LDS_BYTES;
struct AttnTensors { const bf16* Q; const bf16* K; const bf16* V; bf16* O; const float* C2K; float thr2; };
struct AttnUnit { int bh; int qb; };
struct StaticOrder {
  int vcu;
  __device__ __forceinline__ explicit StaticOrder(int grid,int block):vcu((block%8)*(grid/8)+block/8){}
  __device__ __forceinline__ bool next(int i,AttnUnit&u)const{ if(i>=2||vcu>=256)return false; const int s=vcu&7; u.bh=vcu>>3; u.qb=(i==0)?s:15-s; return true; }
  __device__ __forceinline__ void a_ready(const AttnUnit&)const{}
  __device__ __forceinline__ void done(const AttnUnit&)const{}
};
template<class Sched,int THRL=8> __device__ __forceinline__ void attn_phase(char*lds,const AttnTensors&T,const Sched&S,const int tid){
  AttnUnit u;
  for(int i=0;S.next(i,u);++i){ S.a_ready(u); attn_unit<THRL>(u.bh/NHEAD,u.bh%NHEAD,u.qb,T.Q,T.K,T.V,T.O,T.C2K,T.thr2,lds,tid); S.done(u); }
}
#undef SBAR
#undef WAIT_BAR
}
__device__ __forceinline__ void phase_attn_fast(Ctx& C, KA AR, int l, char* ldsg) {
    const attn_body::bf16* Q = (const attn_body::bf16*)(C.ws + WS_R1) + (size_t)2 * T * 512;
    const float bq = 64.f * C2 * wave_max(fabsf(AR->in[I_QN][l * HD + C.lane])) * wave_max(fabsf(AR->in[I_KN][l * HD + C.lane]));
    const attn_body::AttnTensors AT{Q, Q + (size_t)T * 512, Q + (size_t)2 * T * 512, (attn_body::bf16*)(C.ws + WS_R2), (const float*)(C.ws + WS_C2K), 2.f * bq + 40.f};
    unsigned* qctr = (unsigned*)(C.ws + WS_CTL) + CW_ATT + 64 * l;
    volatile LAS unsigned* slot = (volatile LAS unsigned*)(C.lds + MISC_OFF) + 16;
    for (;;) {
        __syncthreads();
        if (C.tid == 0) slot[0] = atomicAdd(qctr, 1u);
        __syncthreads();
        const int idx = __builtin_amdgcn_readfirstlane((int)slot[0]);
        if (idx >= NB * NH * 16) break;
        const int qb = 15 - (idx >> 5), bh = idx & 31;
        attn_body::attn_unit<8>(bh >> 3, bh & 7, qb, AT.Q, AT.K, AT.V, AT.O, AT.C2K, AT.thr2, ldsg, C.tid);
    }
}

constexpr int RCH = 32, NCH = S / RCH;
__device__ __forceinline__ float one_minus_sq_exp(float la, float a) {
    const float x = 2.f * la;
    float p = 1.f / 5040.f; p = p * x + 1.f / 720.f; p = p * x + 1.f / 120.f; p = p * x + 1.f / 24.f; p = p * x + 1.f / 6.f; p = p * x + 0.5f; p = p * x + 1.f; p = -(p * x);
    return x > -0.25f ? p : 1.f - a * a;
}
template <int MODE>
__device__ __forceinline__ void phase_rnn_fast(Ctx& C, KA AR, int l) {
    typedef short bf16x8 __attribute__((ext_vector_type(8)));
    const int blk = C.wave, lane = C.lane, fr = lane & 15, fq = lane >> 4;
    LAS float* Ab = (LAS float*)C.lds + C.wave * 4096; LAS float* Ub = Ab + 2048;
    LAS float* SS = (LAS float*)(C.lds + TAB_OFF); LAS float* RSW = SS + 256 + C.wave * 32;
    const bf16* ZX = (const bf16*)(C.ws + WS_R1); const bf16* ZG = ZX + (size_t)T * 512;
    float* SA = (float*)(C.ws + WS_SA); float* SH = (float*)(C.ws + WS_SH);
    const bf16* O = (const bf16*)(C.ws + WS_R2); bf16* YM = (bf16*)(C.ws + WS_R2 + 16 * MiB);
    const float* cw = AR->in[I_CONVW] + l * 4 * DR; const float* cb = AR->in[I_CONVB] + l * DR;
    const float* wr = AR->in[I_WR] + (size_t)(l * 8 + blk) * 64 * 64; const float* wi = AR->in[I_WI] + (size_t)(l * 8 + blk) * 64 * 64;
    bf16x8 Br[4][2], Bi[4][2]; float brj[4], bij[4], spj[4];
    { float lm[4];
#pragma unroll
      for (int n = 0; n < 4; ++n) { const int ch = blk * 64 + n * 16 + fr; brj[n] = AR->in[I_BR][l * DR + ch]; bij[n] = AR->in[I_BI][l * DR + ch]; lm[n] = AR->in[I_LAM][l * DR + ch]; }
#pragma unroll
      for (int n = 0; n < 4; ++n) { const float e = __expf(-lm[n]); spj[n] = e < 1e-3f ? e * (1.f - 0.5f * e + 0.33333334f * e * e) : __logf(1.f + e); } }
#pragma unroll
    for (int g = 0; g < 2; ++g) { const float* wsrc = g == 0 ? wr : wi; f32x4 t[16];
#pragma unroll
        for (int i = 0; i < 16; ++i) t[i] = *(const f32x4*)(wsrc + 4 * (lane + 64 * i));
#pragma unroll
        for (int i = 0; i < 16; ++i) *(LAS f32x4*)(Ab + 4 * (lane + 64 * i)) = t[i];
        asm volatile("s_waitcnt lgkmcnt(0)" ::: "memory");
#pragma unroll
        for (int n = 0; n < 4; ++n)
#pragma unroll
            for (int ks = 0; ks < 2; ++ks)
#pragma unroll
                for (int e = 0; e < 8; ++e) { const short v = (short)f2bf(Ab[(ks * 32 + fq * 8 + e) * 64 + n * 16 + fr]); if (g == 0) Br[n][ks][e] = v; else Bi[n][ks][e] = v; }
        asm volatile("s_waitcnt lgkmcnt(0)" ::: "memory"); }
    for (int u = blockIdx.x; u < NB * NCH; u += gridDim.x) {
        const int b = u / NCH; int c = u % NCH; if (MODE == 1 && ((u / (int)gridDim.x) & 1)) c = NCH - 1 - c;
        const int t0 = c * RCH;
        if (MODE == 1) __syncthreads();
        bf16x8 Af[2][2];
#pragma unroll
        for (int ks = 0; ks < 2; ++ks) {
            const int ch0 = blk * 64 + ks * 32 + fq * 8;
            f32x4 w[4][2], bb[2];
#pragma unroll
            for (int j = 0; j < 4; ++j) { w[j][0] = *(const f32x4*)(cw + j * DR + ch0); w[j][1] = *(const f32x4*)(cw + j * DR + ch0 + 4); }
            bb[0] = *(const f32x4*)(cb + ch0); bb[1] = *(const f32x4*)(cb + ch0 + 4);
#pragma unroll
            for (int m = 0; m < 2; ++m) {
                const int tok = m * 16 + fr, tg = t0 + tok;
                f32x4 x0 = bb[0], x1 = bb[1]; v4u zz[4];
#pragma unroll
                for (int j = 0; j < 4; ++j) { const int tt = tg - 3 + j; zz[j] = *(const v4u*)(ZX + (size_t)(b * S + (tt < 0 ? 0 : tt)) * 512 + ch0); }
#pragma unroll
                for (int j = 0; j < 4; ++j) { const float ok = (tg - 3 + j) >= 0 ? 1.f : 0.f; const v4u z = zz[j]; const f32x4 wa = w[j][0] * ok, wb = w[j][1] * ok;
                        x0[0] += wa[0] * bflo(z.x); x0[1] += wa[1] * bfhi(z.x); x0[2] += wa[2] * bflo(z.y); x0[3] += wa[3] * bfhi(z.y);
                        x1[0] += wb[0] * bflo(z.z); x1[1] += wb[1] * bfhi(z.z); x1[2] += wb[2] * bflo(z.w); x1[3] += wb[3] * bfhi(z.w); }
                *(LAS f32x4*)(Ub + tok * 64 + ks * 32 + fq * 8) = x0; *(LAS f32x4*)(Ub + tok * 64 + ks * 32 + fq * 8 + 4) = x1;
                v4u pk; pk.x = pk2(x0[0], x0[1]); pk.y = pk2(x0[2], x0[3]); pk.z = pk2(x1[0], x1[1]); pk.w = pk2(x1[2], x1[3]);
                Af[m][ks] = __builtin_bit_cast(bf16x8, pk);
            }
        }
        f32x4 aR[2][4], aI[2][4];
#pragma unroll
        for (int m = 0; m < 2; ++m)
#pragma unroll
            for (int n = 0; n < 4; ++n) { aR[m][n] = (f32x4){0.f, 0.f, 0.f, 0.f}; aI[m][n] = (f32x4){0.f, 0.f, 0.f, 0.f};
#pragma unroll
                for (int ks = 0; ks < 2; ++ks) { aR[m][n] = __builtin_amdgcn_mfma_f32_16x16x32_bf16(Af[m][ks], Br[n][ks], aR[m][n], 0, 0, 0); aI[m][n] = __builtin_amdgcn_mfma_f32_16x16x32_bf16(Af[m][ks], Bi[n][ks], aI[m][n], 0, 0, 0); } }
        asm volatile("s_waitcnt lgkmcnt(0)" ::: "memory");
#pragma unroll
        for (int m = 0; m < 2; ++m)
#pragma unroll
            for (int n = 0; n < 4; ++n)
#pragma unroll
                for (int i = 0; i < 4; ++i) { const int idx = (m * 16 + 4 * fq + i) * 64 + n * 16 + fr;
                    const float xcv = Ub[idx], r = sigmoid_fast(aR[m][n][i] + brj[n]), ig = sigmoid_fast(aI[m][n][i] + bij[n]);
                    const float la = -8.f * r * spj[n], a = __expf(la);
                    Ab[idx] = a; Ub[idx] = sqrtf(one_minus_sq_exp(la, a)) * (ig * xcv); }
        asm volatile("s_waitcnt lgkmcnt(0)" ::: "memory");
        const int ch = blk * 64 + lane;
        if (MODE == 0) { float At = 1.f, h = 0.f;
#pragma unroll 8
            for (int t = 0; t < RCH; ++t) { const float a = Ab[t * 64 + lane]; h = a * h + Ub[t * 64 + lane]; At *= a; }
            SA[(size_t)(b * NCH + c) * 512 + ch] = At; SH[(size_t)(b * NCH + c) * 512 + ch] = h;
        } else {
            float h = 0.f;
            { const float* sa = SA + (size_t)b * NCH * 512 + ch; const float* sh = SH + (size_t)b * NCH * 512 + ch; int c2 = 0;
              for (; c2 + 16 <= c; c2 += 16) { float a8[16], h8[16];
#pragma unroll
                  for (int q = 0; q < 16; ++q) { a8[q] = sa[(size_t)(c2 + q) * 512]; h8[q] = sh[(size_t)(c2 + q) * 512]; }
#pragma unroll
                  for (int q = 0; q < 16; ++q) h = a8[q] * h + h8[q]; }
              for (; c2 < c; ++c2) h = sa[(size_t)c2 * 512] * h + sh[(size_t)c2 * 512]; }
            const bf16* zg = ZG + (size_t)(b * S + t0) * 512 + ch;
#pragma unroll 8
            for (int t = 0; t < RCH; ++t) { h = Ab[t * 64 + lane] * h + Ub[t * 64 + lane]; Ab[t * 64 + lane] = h * bf2f(zg[(size_t)t * 512]); }
            asm volatile("s_waitcnt lgkmcnt(0)" ::: "memory");
            { const int t = lane & 31, hf = lane >> 5; float s = 0.f;
#pragma unroll 8
              for (int k = 0; k < 32; ++k) { const float y = Ab[t * 64 + hf * 32 + ((k + t) & 31)]; s += y * y; }
              s = half_sum32(s); if (lane < 32) SS[C.wave * 32 + lane] = s; }
            __syncthreads();
            { const int t = lane & 31; float tot = 0.f;
#pragma unroll
              for (int w8 = 0; w8 < 8; ++w8) tot += SS[w8 * 32 + t];
              RSW[t] = rsqrtf(tot * (1.f / 512.f) + EPS); }
            asm volatile("s_waitcnt lgkmcnt(0)" ::: "memory");
            { const int oct = lane & 7; const float* g1 = AR->in[I_LRUN] + l * DR + blk * 64 + oct * 8; const f32x4 ga = *(const f32x4*)g1, gb = *(const f32x4*)(g1 + 4);
#pragma unroll
              for (int q = 0; q < 4; ++q) { const int t = q * 8 + (lane >> 3); const float rs = RSW[t];
                  const f32x4 y0 = *(const LAS f32x4*)(Ab + t * 64 + oct * 8) * rs * ga, y1 = *(const LAS f32x4*)(Ab + t * 64 + oct * 8 + 4) * rs * gb;
                  v4u pk; pk.x = pk2(y0[0], y0[1]); pk.y = pk2(y0[2], y0[3]); pk.z = pk2(y1[0], y1[1]); pk.w = pk2(y1[2], y1[3]);
                  *(v4u*)(YM + (size_t)(b * S + t0 + t) * D + blk * 64 + oct * 8) = pk; } }
            { const float* g2 = AR->in[I_ATTN] + l * DA + 8 * lane; const f32x4 ga = *(const f32x4*)g2, gb = *(const f32x4*)(g2 + 4);
              const size_t row0 = (size_t)(b * S + t0 + C.wave * 4); v4u w4[4];
#pragma unroll
              for (int q = 0; q < 4; ++q) w4[q] = *(const v4u*)(O + (row0 + q) * 512 + 8 * lane);
#pragma unroll
              for (int q = 0; q < 4; ++q) { const v4u w = w4[q];
                  f32x4 x0 = {bflo(w.x), bfhi(w.x), bflo(w.y), bfhi(w.y)}, x1 = {bflo(w.z), bfhi(w.z), bflo(w.w), bfhi(w.w)};
                  float s = (x0[0] * x0[0] + x0[1] * x0[1]) + (x0[2] * x0[2] + x0[3] * x0[3]) + (x1[0] * x1[0] + x1[1] * x1[1]) + (x1[2] * x1[2] + x1[3] * x1[3]);
                  const float rs = rsqrtf(wave_sum(s) * (1.f / 512.f) + EPS);
                  x0 = x0 * rs * ga; x1 = x1 * rs * gb;
                  v4u pk; pk.x = pk2(x0[0], x0[1]); pk.y = pk2(x0[2], x0[3]); pk.z = pk2(x1[0], x1[1]); pk.w = pk2(x1[2], x1[3]);
                  *(v4u*)(YM + (row0 + q) * D + 512 + 8 * lane) = pk; } }
        }
    }
}

template <int NT, class WF>
__device__ __forceinline__ void norm_proj_tile(const float* X, const float* gain, bf16* xn, int t0, WF wf, LAS float* Lw, int lane, int kh) {
    const int fr = lane & 15, fq = lane >> 4;
    f32x4 acc[NT];
#pragma unroll
    for (int n = 0; n < NT; ++n) acc[n] = (f32x4){0.f, 0.f, 0.f, 0.f};
    float ssq = 0.f;
    const float* xr = X + (size_t)(t0 + fr) * D + 4 * fq; const float* gr = gain + 4 * fq;
    for (int sb = 2 * kh; sb < 2 * kh + 2; ++sb) {
        f32x4 xv[16];
#pragma unroll
        for (int i = 0; i < 16; ++i) xv[i] = *(const f32x4*)(xr + 16 * (16 * sb + i));
#pragma unroll
        for (int i = 0; i < 16; ++i) { const int s = 16 * sb + i; const f32x4 gv = *(const f32x4*)(gr + 16 * s);
            ssq += (xv[i][0] * xv[i][0] + xv[i][1] * xv[i][1]) + (xv[i][2] * xv[i][2] + xv[i][3] * xv[i][3]);
            const f32x4 xg = xv[i] * gv;
#pragma unroll
            for (int e = 0; e < 4; ++e)
#pragma unroll
                for (int n = 0; n < NT; ++n) acc[n] = __builtin_amdgcn_mfma_f32_16x16x4f32(wf(n, 16 * s + 4 * fq + e, fr), xg[e], acc[n], 0, 0, 0); }
    }
    constexpr int PW = 4 * NT + 1;
    if (kh == 1) {
#pragma unroll
        for (int n = 0; n < NT; ++n)
#pragma unroll
            for (int r = 0; r < 4; ++r) Lw[lane * PW + 4 * n + r] = acc[n][r];
        Lw[lane * PW + 4 * NT] = ssq;
    }
    __syncthreads();
    if (kh == 0) {
#pragma unroll
        for (int n = 0; n < NT; ++n)
#pragma unroll
            for (int r = 0; r < 4; ++r) acc[n][r] += Lw[lane * PW + 4 * n + r];
        ssq += Lw[lane * PW + 4 * NT];
        ssq += lane_xor<16>(ssq); ssq = half_sum32(ssq);
        const float rs = rsqrtf(ssq * (1.f / D) + EPS);
        asm volatile("s_waitcnt lgkmcnt(0)" ::: "memory");
#pragma unroll
        for (int n = 0; n < NT; ++n)
#pragma unroll
            for (int r = 0; r < 4; ++r) Lw[fr * (16 * NT) + 16 * n + 4 * fq + r] = acc[n][r] * rs;
        if (lane < 16) Lw[16 * 16 * NT + lane] = rs;
    }
    __syncthreads();
#pragma unroll
    for (int q4 = 0; q4 < 8; q4 += 4) { f32x4 v[4][4];
#pragma unroll
        for (int q = 0; q < 4; ++q) load_row(X + (size_t)(t0 + 8 * kh + q4 + q) * D, lane, v[q]);
#pragma unroll
        for (int q = 0; q < 4; ++q) { const int tok = 8 * kh + q4 + q; const float rst = Lw[16 * 16 * NT + tok]; scale_row(v[q], rst, gain, lane); store_row_bf16(xn + (size_t)(t0 + tok) * D, lane, v[q]); } }
}
__device__ __forceinline__ void phase_norm1_fast(Ctx& C, KA AR, int l) {
    const float* xs = l == 0 ? AR->in[I_X] : (const float*)(C.ws + WS_X);
    const float* gain = AR->in[I_MIXN] + l * D; const float* wf = AR->in[I_WIN] + (size_t)l * D * DIN + NZ; const float* bfg = AR->in[I_BF] + l * NH;
    bf16* xn = (bf16*)(C.ws + WS_XN); float* logf = (float*)(C.ws + WS_LOGF);
    LAS float* Wl = (LAS float*)C.lds; LAS float* Lw = (LAS float*)(C.lds + 32768 + 1024) + (C.wave & 3) * 1024; const int kh = C.wave >> 2;
    { f32x4 t[4];
#pragma unroll
      for (int j = 0; j < 4; ++j) { const int i = C.tid + 512 * j; t[j] = *(const f32x4*)(wf + (size_t)(i >> 1) * DIN + 4 * (i & 1)); }
#pragma unroll
      for (int j = 0; j < 4; ++j) *(LAS f32x4*)(Wl + 4 * (C.tid + 512 * j)) = t[j]; }
    if (C.tid < 8) Wl[D * 8 + C.tid] = 0.f;
    __syncthreads();
        for (int tile = blockIdx.x * 4 + (C.wave & 3); tile < T / 16; tile += gridDim.x * 4) {
            const int t0 = 16 * tile;
            __syncthreads();
            norm_proj_tile<1>(xs, gain, xn, t0, [=](int, int k, int i) { return Wl[k * 8 + i]; }, Lw, C.lane, kh);
            if (kh == 0) {
            const int tok = C.lane & 15, h0 = (C.lane >> 4) * 2;
            { const int r = t0 + tok, bb = r / S, tt = r % S;
              logf[(size_t)(bb * NH + h0) * S + tt] = log_sigmoid(Lw[tok * 16 + h0] + bfg[h0]); logf[(size_t)(bb * NH + h0 + 1) * S + tt] = log_sigmoid(Lw[tok * 16 + h0 + 1] + bfg[h0 + 1]); }
            }
            asm volatile("s_waitcnt lgkmcnt(0)" ::: "memory");
        }
}
__device__ __forceinline__ void phase_router_fast(Ctx& C, KA AR, int l) {
    const float* X = (const float*)(C.ws + WS_X); bf16* xn = (bf16*)(C.ws + WS_XN);
    const float* gain = AR->in[I_FFNN] + l * D; const float* wg = AR->in[I_WG] + (size_t)l * D * 4; const float* bg = AR->in[I_BG] + l * 4;
    const float* wr = AR->in[I_WRT] + (size_t)l * D * NE; const float* brt = AR->in[I_BRT] + l * NE;
    unsigned* cnt = (unsigned*)(C.ws + WS_CTL) + CW_CNT + 32 * CNT_STRIDE * l; int* rowpair = (int*)(C.ws + WS_ROWPAIR); float* pairw = (float*)(C.ws + WS_PAIRW);
    LAS float* Wl = (LAS float*)C.lds; LAS float* Lw = (LAS float*)(C.lds + WPROJ_BYTES + 64) + (C.wave & 3) * 832; const int kh = C.wave >> 2;
    { f32x4 t[16], u[2];
#pragma unroll
      for (int j = 0; j < 16; ++j) t[j] = *(const f32x4*)(wr + 4 * (C.tid + 512 * j));
#pragma unroll
      for (int j = 0; j < 2; ++j) u[j] = *(const f32x4*)(wg + 4 * (C.tid + 512 * j));
#pragma unroll
      for (int j = 0; j < 16; ++j) { const int i = C.tid + 512 * j; *(LAS f32x4*)(Wl + (i >> 3) * 36 + 4 * (i & 7)) = t[j]; }
#pragma unroll
      for (int j = 0; j < 2; ++j) *(LAS f32x4*)(Wl + (C.tid + 512 * j) * 36 + 32) = u[j]; }
    if (C.tid < 16) Wl[D * 36 + C.tid] = 0.f;
    volatile LAS unsigned* lcnt = (volatile LAS unsigned*)(C.lds + MISC_OFF - 512);
    if (C.tid < 64) lcnt[C.tid] = 0u;
    __syncthreads();
        for (int tile = blockIdx.x * 4 + (C.wave & 3); tile < T / 16; tile += gridDim.x * 4) {
            const int t0 = 16 * tile;
            __syncthreads();
            norm_proj_tile<3>(X, gain, xn, t0, [=](int n, int k, int i) { return Wl[k * 36 + 16 * n + i]; }, Lw, C.lane, kh);
            int e0 = 0, e1 = 0; unsigned lp0 = 0, lp1 = 0; float w0r = 0.f, w1r = 0.f;
            if (kh == 0 && C.lane < 16) {
                const LAS float* L = Lw + C.lane * 48;
                float gl[4];
#pragma unroll
                for (int i = 0; i < 4; ++i) gl[i] = L[32 + i] + bg[i];
                int gi = 0; float gm = gl[0];
#pragma unroll
                for (int i = 1; i < 4; ++i) if (gl[i] > gm) { gm = gl[i]; gi = i; }
                float gs = 0.f;
#pragma unroll
                for (int i = 0; i < 4; ++i) gs += __expf(gl[i] - gm);
                const float gp = 1.f / gs;
                float ev[8];
#pragma unroll
                for (int i = 0; i < 8; ++i) ev[i] = L[gi * 8 + i] + brt[gi * 8 + i];
                int i0 = 0; float t0v = ev[0];
#pragma unroll
                for (int i = 1; i < 8; ++i) if (ev[i] > t0v) { t0v = ev[i]; i0 = i; }
                int i1 = -1; float t1v = -INFINITY;
#pragma unroll
                for (int i = 0; i < 8; ++i) if (i != i0 && ev[i] > t1v) { t1v = ev[i]; i1 = i; }
                const float ex = __expf(t1v - t0v), w0 = gp / (1.f + ex), w1 = gp * ex / (1.f + ex);
                e0 = gi * 8 + i0; e1 = gi * 8 + i1; w0r = w0; w1r = w1;
                lp0 = __hip_atomic_fetch_add((LAS unsigned*)lcnt + e0, 1u, __ATOMIC_RELAXED, __HIP_MEMORY_SCOPE_WORKGROUP); lp1 = __hip_atomic_fetch_add((LAS unsigned*)lcnt + e1, 1u, __ATOMIC_RELAXED, __HIP_MEMORY_SCOPE_WORKGROUP);
            }
            __syncthreads();
            if (C.wave == 0 && C.lane < NE) { const unsigned n = lcnt[C.lane]; lcnt[32 + C.lane] = n ? atomicAdd(cnt + C.lane * CNT_STRIDE, n) : 0u; }
            __syncthreads();
            if (kh == 0 && C.lane < 16) { const int t = t0 + C.lane; const unsigned p0 = lcnt[32 + e0] + lp0, p1 = lcnt[32 + e1] + lp1;
                rowpair[(size_t)e0 * CAP + p0] = 2 * t; rowpair[(size_t)e1 * CAP + p1] = 2 * t + 1; pairw[2 * t] = w0r; pairw[2 * t + 1] = w1r; }
            __syncthreads();
            if (C.tid < 64) lcnt[C.tid] = 0u;
            asm volatile("s_waitcnt lgkmcnt(0)" ::: "memory");
        }
}

constexpr int NPH = 14;
constexpr int NPHASES = 1 + DEPTH * NPH;
__global__ void __launch_bounds__(512, 2) fwd_kernel(Args args) {
    extern __shared__ __attribute__((aligned(16))) unsigned char lds[];
    Ctx C;
    C.lds = (LAS unsigned char*)lds;
    C.wave0 = __builtin_amdgcn_readfirstlane((int)threadIdx.x >> 6); asm volatile("" : "+s"(C.wave0));
    C.tid = threadIdx.x; C.lane = C.tid & 63; C.wave = C.wave0;
    C.gw = blockIdx.x * 8 + C.wave; C.ngw = gridDim.x * 8;
    C.ws = args.ws;
    volatile LAS unsigned* MISC = (volatile LAS unsigned*)(C.lds + MISC_OFF);
    if (C.tid < 32) MISC[C.tid] = 0u;
    __syncthreads();
    XcdBarrier bar; bar.bar = (unsigned*)(C.ws + WS_CTL) + CW_BAR; bar.x = 0; bar.st = nullptr;
    if (args.ph_hi - args.ph_lo > 1) bar = xcd_barrier_post((unsigned*)(C.ws + WS_CTL) + CW_BAR, MISC + 8);
#ifndef ONLY
#define ONLY -1
#endif
#define PHON(k) (ONLY < 0 || ONLY == (k))
#if MK_MULTI
#define IN(k) (fresh_args()->ph_lo <= (k) && (k) < fresh_args()->ph_hi)
#else
#define IN(k) true
#endif
    if (PROBE_TIMING && blockIdx.x == 0 && threadIdx.x == 0) ((unsigned long long*)((unsigned*)(args.ws + WS_CTL) + CW_TS))[0] = __builtin_amdgcn_s_memrealtime();
#define SEAM(k) do { if (IN(k) && IN((k) + 1)) { XcdBarrier b_; b_.bar = (unsigned*)(fresh_args()->ws + WS_CTL) + CW_BAR; b_.x = xb_xcc_id(); b_.st = (volatile LAS unsigned*)(C.lds + MISC_OFF) + 8;     \
        xcd_barrier(b_, C.tid == 0); if (PROBE_TIMING && blockIdx.x == 0 && C.tid == 0) { ((unsigned long long*)((unsigned*)(fresh_args()->ws + WS_CTL) + CW_TS))[(k) + 1] = __builtin_amdgcn_s_memrealtime(); } } } while (0)
    for (int rp_ = 0; rp_ < REPS(99); ++rp_) { if (PHON(99) && IN(0)) { KA A_ = fresh_args(); enter_phase(C, A_); phase_prologue(C, A_); } SEAM(0); }
    for (int l = 0; l < DEPTH; ++l) {
        const int pb = 1 + l * NPH;
        for (int rp_ = 0; rp_ < REPSL(0); ++rp_) { if (PHON(0) && IN(pb + 0)) { KA A_ = fresh_args(); enter_phase(C, A_); if (FAST_NORM) phase_norm1_fast(C, A_, l); else phase_norm1(C, A_, l); } SEAM(pb + 0); }
        for (int rp_ = 0; rp_ < REPSL(1); ++rp_) { if (PHON(1) && IN(pb + 1)) { KA A_ = fresh_args(); enter_phase(C, A_); if (FAST_GEMM1) { phase_gemm1_fast(C, A_, l); phase_proj_fast(C, A_, l); } else phase_gemm1_naive(C, A_, l); } SEAM(pb + 1); }
        for (int rp_ = 0; rp_ < REPSL(2); ++rp_) { if (!FAST_GEMM1 && PHON(2) && IN(pb + 2)) { KA A_ = fresh_args(); enter_phase(C, A_); phase_qknorm_naive(C, A_, l); } if (!FAST_GEMM1) SEAM(pb + 2); }
        for (int rp_ = 0; rp_ < REPSL(3); ++rp_) { if (!(FAST_RNN && FAST_ATTN) && PHON(3) && IN(pb + 3)) { KA A_ = fresh_args(); enter_phase(C, A_); if (FAST_RNN) phase_rnn_fast<0>(C, A_, l); else phase_rnn_naive<0>(C, A_, l); } if (!(FAST_RNN && FAST_ATTN)) SEAM(pb + 3); }
        for (int rp_ = 0; rp_ < REPSL(4); ++rp_) { if (PHON(4) && IN(pb + 4)) { KA A_ = fresh_args(); enter_phase(C, A_); if (FAST_RNN && FAST_ATTN) { phase_rnn_fast<0>(C, A_, l); __syncthreads(); } if (FAST_ATTN) phase_attn_fast(C, A_, l, (char*)lds); else phase_attn_naive(C, A_, l); } SEAM(pb + 4); }
        for (int rp_ = 0; rp_ < REPSL(5); ++rp_) { if (PHON(5) && IN(pb + 5)) { KA A_ = fresh_args(); enter_phase(C, A_); if (FAST_RNN) phase_rnn_fast<1>(C, A_, l); else phase_rnn_naive<1>(C, A_, l); } SEAM(pb + 5); }
        for (int rp_ = 0; rp_ < REPSL(6); ++rp_) { if (!FAST_RNN && PHON(6) && IN(pb + 6)) { KA A_ = fresh_args(); enter_phase(C, A_); phase_mixnorm_naive(C, A_, l); } if (!FAST_RNN) SEAM(pb + 6); }
        for (int rp_ = 0; rp_ < REPSL(7); ++rp_) { if (PHON(7) && IN(pb + 7)) { KA A_ = fresh_args(); enter_phase(C, A_); if (FAST_DENSE) phase_wo_fast(C, A_, l); else phase_wo_naive(C, A_, l); } SEAM(pb + 7); }
        for (int rp_ = 0; rp_ < REPSL(8); ++rp_) { if (PHON(8) && IN(pb + 8)) { KA A_ = fresh_args(); enter_phase(C, A_); if (FAST_NORM) phase_router_fast(C, A_, l); else phase_router(C, A_, l); } SEAM(pb + 8); }
        for (int rp_ = 0; rp_ < REPSL(9); ++rp_) { if (PHON(9) && IN(pb + 9)) { KA A_ = fresh_args(); enter_phase(C, A_); if (FAST_MOE) phase_g1_fast(C, A_, l); else phase_g1_naive(C, A_, l); } SEAM(pb + 9); }
        for (int rp_ = 0; rp_ < REPSL(10); ++rp_) { if (PHON(10) && IN(pb + 10)) { KA A_ = fresh_args(); enter_phase(C, A_); if (FAST_MOE) phase_g2_fast(C, A_, l); else phase_g2_naive(C, A_, l); } SEAM(pb + 10); }
        for (int rp_ = 0; rp_ < REPSL(11); ++rp_) { if (PHON(11) && IN(pb + 11)) { KA A_ = fresh_args(); enter_phase(C, A_); phase_combine(C, A_, l); } SEAM(pb + 11); }
        for (int rp_ = 0; rp_ < REPSL(12); ++rp_) { if (!FAST_GEMM1 && PHON(12) && IN(pb + 12)) { KA A_ = fresh_args(); enter_phase(C, A_); if (FAST_DENSE) phase_proj_fast(C, A_, l); else phase_proj_naive(C, A_, l); } if (!FAST_GEMM1) SEAM(pb + 12); }
        for (int rp_ = 0; rp_ < REPSL(13); ++rp_) { if (PHON(13) && IN(pb + 13)) { KA A_ = fresh_args(); enter_phase(C, A_); if (FAST_DENSE) phase_ple_fast(C, A_, l); else phase_ple_naive(C, A_, l); } if (l + 1 < DEPTH) SEAM(pb + 13); }
    }
#undef IN
#undef SEAM
}

extern "C" void kernel_launch(void* const* d_in, const int* in_sizes, int n_in, void* d_out, int out_size, void* d_ws, size_t ws_size, hipStream_t stream) {
    static int grid = 0;
    if (grid == 0) {
        if (n_in != 29 || out_size != T * D || ws_size < WS_END) { fprintf(stderr, "kernel_launch: unexpected problem (n_in %d, out %d, ws %zu)\n", n_in, out_size, ws_size); grid = -1; return; }
        int dev = 0, cus = 0, per_cu = 0;
        if (hipGetDevice(&dev) != hipSuccess || hipDeviceGetAttribute(&cus, hipDeviceAttributeMultiprocessorCount, dev) != hipSuccess) { grid = -1; return; }
        if (hipFuncSetAttribute((const void*)fwd_kernel, hipFuncAttributeMaxDynamicSharedMemorySize, LDS_BYTES) != hipSuccess) { fprintf(stderr, "kernel_launch: hipFuncSetAttribute failed\n"); grid = -1; return; }
        if (hipOccupancyMaxActiveBlocksPerMultiprocessor(&per_cu, (const void*)fwd_kernel, 512, LDS_BYTES) != hipSuccess || per_cu < 1) { fprintf(stderr, "kernel_launch: occupancy query says %d\n", per_cu); grid = -1; return; }
        (void)hipGetLastError();
        grid = cus;
    }
    if (grid < 0) return;
    hipMemsetAsync((char*)d_ws + WS_CTL, 0, CTL_ZERO_BYTES, stream);
    Args a{};
    for (int i = 0; i < 29; ++i) a.in[i] = (const float*)d_in[i];
    a.out = (float*)d_out; a.ws = (unsigned char*)d_ws;
#if MK_MULTI
    for (int ph = 0; ph < NPHASES; ++ph) { a.ph_lo = ph; a.ph_hi = ph + 1; hipLaunchKernelGGL(fwd_kernel, dim3(grid), dim3(512), LDS_BYTES, stream, a); }
#else
    a.ph_lo = 0; a.ph_hi = NPHASES;
    hipLaunchKernelGGL(fwd_kernel, dim3(grid), dim3(512), LDS_BYTES, stream, a);
#endif
}
```

```cpp
#include <hip/hip_runtime.h>
#include <cstdio>
#include <cstdint>
#include <cmath>
#include <hip/hip_bf16.h>

#define FAST_GEMM1 1
#define FAST_DENSE 1
#define FAST_MOE 1
#define FAST_ATTN 1
#define FAST_RNN 1
#define FAST_NORM 1
#ifndef PROBE_TIMING
#define PROBE_TIMING 0
#endif
#ifndef PROBE_LO
#define PROBE_LO 0
#define PROBE_HI 1
#endif
#ifndef PROBE_REP
#define PROBE_REP -1
#define PROBE_REPN 0
#endif
#define REPS(k) ((PROBE_REP == (k)) ? (1 + PROBE_REPN) : 1)
#define REPSL(k) ((((k) == 7 && l != 0) || ((k) == 13 && l != DEPTH - 1)) ? 1 : REPS(k))
#ifndef MK_MULTI
#define MK_MULTI 0
#endif

#define GAS __attribute__((address_space(1)))
#define LAS __attribute__((address_space(3)))
typedef unsigned short bf16;
typedef unsigned v4u __attribute__((ext_vector_type(4)));
typedef unsigned v2u __attribute__((ext_vector_type(2)));
typedef float f32x4 __attribute__((ext_vector_type(4)));

constexpr int NB = 4, S = 4096, T = NB * S, D = 1024, DIN = 2568, DR = 512, DA = 512, NH = 8, HD = 64;
constexpr int NE = 32, DE = 512, PLE = 256, DEPTH = 2, NZ = 2560;
constexpr float EPS = 1e-6f, LOG2E = 1.4426950408889634f, C2 = 0.125f * 1.4426950408889634f;
constexpr int CAP = 16384;
constexpr int HROWS = 40960;

constexpr size_t MiB = 1u << 20;
constexpr size_t WS_CTL = 0, CTL_ZERO_BYTES = 1 * MiB;
constexpr size_t WS_LOGF = 1 * MiB;
constexpr size_t WS_C2K = WS_LOGF + MiB / 2;
constexpr size_t WS_SA = 6 * MiB, WS_SH = 7 * MiB;
constexpr size_t WS_PAIRW = 3 * MiB;
constexpr size_t WS_ROWPAIR = 4 * MiB;
constexpr size_t WS_WIN = 8 * MiB;
constexpr size_t WS_WOUT = 18 * MiB;
constexpr size_t WS_WPG = 22 * MiB;
constexpr size_t WS_WPP = 26 * MiB;
constexpr size_t WS_WGU = 28 * MiB;
constexpr size_t WS_WDN = 156 * MiB;
constexpr size_t WS_PB = 220 * MiB;
constexpr size_t WS_XN = 236 * MiB;
constexpr size_t WS_X = 268 * MiB;
constexpr size_t WS_R1 = 332 * MiB;
constexpr size_t WS_R2 = 412 * MiB;
constexpr size_t WS_PROJ = 460 * MiB;
constexpr size_t WS_END = 492 * MiB;
constexpr int CW_BAR = 4096;
constexpr int CW_TS = 20480;
constexpr int CW_ATT = 16384;
constexpr int CW_CNT = 8192, CNT_STRIDE = 64;

constexpr int RING_BYTES = 131072;
constexpr int LDS_BYTES = 163840;
constexpr int MISC_OFF = LDS_BYTES - 1024;
constexpr int WPROJ_BYTES = 147456;

__device__ __forceinline__ unsigned f2bf(float f) { unsigned u = __builtin_bit_cast(unsigned, f); return (u + 0x7fffu + ((u >> 16) & 1u)) >> 16; }
__device__ __forceinline__ unsigned pk2(float lo, float hi) { return f2bf(lo) | (f2bf(hi) << 16); }
__device__ __forceinline__ float bf2f(unsigned u) { return __builtin_bit_cast(float, u << 16); }
__device__ __forceinline__ float bflo(unsigned w) { return __builtin_bit_cast(float, w << 16); }
__device__ __forceinline__ float bfhi(unsigned w) { return __builtin_bit_cast(float, w & 0xffff0000u); }
template <int O> __device__ __forceinline__ float lane_xor(float v) {
    if constexpr (O == 32) { const unsigned u = __builtin_bit_cast(unsigned, v); auto rr = __builtin_amdgcn_permlane32_swap(u, u, false, false);
        const unsigned a = rr[0], b = rr[1]; return __builtin_bit_cast(float, a == u ? b : a); }
    else return __builtin_bit_cast(float, __builtin_amdgcn_ds_swizzle(__builtin_bit_cast(int, v), (O << 10) | 0x1f));
}
__device__ __forceinline__ float wave_sum(float v) {
    v += lane_xor<1>(v); v += lane_xor<2>(v); v += lane_xor<4>(v); v += lane_xor<8>(v); v += lane_xor<16>(v);
    { const unsigned u = __builtin_bit_cast(unsigned, v); auto rr = __builtin_amdgcn_permlane32_swap(u, u, false, false); v = __builtin_bit_cast(float, (unsigned)rr[0]) + __builtin_bit_cast(float, (unsigned)rr[1]); }
    return v;
}
__device__ __forceinline__ float wave_max(float v) {
    v = fmaxf(v, lane_xor<1>(v)); v = fmaxf(v, lane_xor<2>(v)); v = fmaxf(v, lane_xor<4>(v)); v = fmaxf(v, lane_xor<8>(v)); v = fmaxf(v, lane_xor<16>(v));
    { const unsigned u = __builtin_bit_cast(unsigned, v); auto rr = __builtin_amdgcn_permlane32_swap(u, u, false, false); v = fmaxf(__builtin_bit_cast(float, (unsigned)rr[0]), __builtin_bit_cast(float, (unsigned)rr[1])); }
    return v;
}
__device__ __forceinline__ float half_sum32(float v) {
    const unsigned u = __builtin_bit_cast(unsigned, v); auto rr = __builtin_amdgcn_permlane32_swap(u, u, false, false); return __builtin_bit_cast(float, (unsigned)rr[0]) + __builtin_bit_cast(float, (unsigned)rr[1]);
}
__device__ __forceinline__ float sigmoidf_(float v) { return 1.f / (1.f + __expf(-v)); }
__device__ __forceinline__ float gelu_tanh(float v) { return 0.5f * v * (1.f + tanhf(0.7978845608028654f * (v + 0.044715f * v * v * v))); }
__device__ __forceinline__ float log_sigmoid(float v) { return v >= 0.f ? -log1pf(__expf(-v)) : v - log1pf(__expf(v)); }

#define XB_TMO      128
#define XB_XCNT(j)  (256  + 64 * (j))
#define XB_XSUB(j)  (1280 + 64 * (j))
#define XB_XGEN(j)  (2304 + 64 * (j))
#define XB_TOP      3328
#define XB_TOPGEN   3392
#define XCD_BAR_WORDS 3456
#define XB_SPIN_CAP (1u << 26)
__device__ __forceinline__ unsigned xb_ld(unsigned* p)              { return __hip_atomic_load(p, __ATOMIC_RELAXED, __HIP_MEMORY_SCOPE_AGENT); }
__device__ __forceinline__ unsigned xb_add(unsigned* p, unsigned v) { return __hip_atomic_fetch_add(p, v, __ATOMIC_RELAXED, __HIP_MEMORY_SCOPE_AGENT); }
__device__ __forceinline__ unsigned xb_xcc_id() { return (unsigned)__builtin_amdgcn_s_getreg((3 << 11) | 20) & 0xFu; }
#define XB_SPIN(cond, bar) do { unsigned _sp = 0; while (cond) { __builtin_amdgcn_s_sleep(1); \
    if ((++_sp & 255u) == 0u) { if (xb_ld(&(bar)[XB_TMO])) break; if (_sp > XB_SPIN_CAP) { atomicAdd(&(bar)[XB_TMO], 1u); break; } } } } while (0)
struct XcdBarrier { unsigned* bar; unsigned x; volatile LAS unsigned* st; };
__device__ __forceinline__ XcdBarrier xcd_barrier_post(unsigned* bar, volatile LAS unsigned* st) {
    XcdBarrier b; b.bar = bar; b.x = xb_xcc_id(); b.st = st;
    if (threadIdx.x == 0) (void)xb_add(&bar[XB_XCNT(b.x)], 1u);
    return b;
}
__device__ __forceinline__ void xcd_barrier_complete(unsigned* bar, unsigned x, unsigned& nloc, unsigned& nx) {
    const unsigned G = gridDim.x * gridDim.y * gridDim.z;
    unsigned sum, cnt, mine, sp = 0u;
    for (;;) {
        sum = 0u; cnt = 0u; mine = 0u;
#pragma unroll
        for (unsigned j = 0; j < 16; ++j) { const unsigned c = xb_ld(&bar[XB_XCNT(j)]); sum += c; cnt += (c > 0u) ? 1u : 0u; mine = (j == x) ? c : mine; }
        if (sum == G) break;
        __builtin_amdgcn_s_sleep(1);
        if ((++sp & 255u) == 0u) { if (xb_ld(&bar[XB_TMO])) break; if (sp > XB_SPIN_CAP) { atomicAdd(&bar[XB_TMO], 1u); break; } }
    }
    nloc = mine > 0u ? mine : 1u; nx = cnt > 0u ? cnt : 1u;
}
__device__ __forceinline__ void xcd_barrier(const XcdBarrier& b, const bool leader  ) {
    asm volatile("s_waitcnt vmcnt(0)" ::: "memory");
    __syncthreads();
    if (leader) {
        unsigned* bar = b.bar;
        __builtin_amdgcn_s_waitcnt(0);
        unsigned nloc = b.st[0], nx = b.st[1];
        if (nloc == 0u) { xcd_barrier_complete(bar, b.x, nloc, nx); b.st[0] = nloc; b.st[1] = nx; }
        const unsigned old = xb_add(&bar[XB_XSUB(b.x)], 1u);
        const unsigned gen = old / nloc;
        if (old + 1u == (gen + 1u) * nloc) {
            __builtin_amdgcn_fence(__ATOMIC_RELEASE, "agent");
            asm volatile("s_waitcnt vmcnt(0)" ::: "memory");
            const unsigned og = xb_add(&bar[XB_TOP], 1u);
            const unsigned tg = og / nx;
            if (og + 1u == (tg + 1u) * nx) xb_add(&bar[XB_TOPGEN], 1u);
            else XB_SPIN(xb_ld(&bar[XB_TOPGEN]) == tg, bar);
            __builtin_amdgcn_fence(__ATOMIC_ACQUIRE, "agent");
            xb_add(&bar[XB_XGEN(b.x)], 1u);
            asm volatile("s_waitcnt vmcnt(0)" ::: "memory");
        } else {
            XB_SPIN(xb_ld(&bar[XB_XGEN(b.x)]) == gen, bar);
            __builtin_amdgcn_fence(__ATOMIC_ACQUIRE, "agent");
            asm volatile("s_waitcnt vmcnt(0)" ::: "memory");
        }
    }
    __syncthreads();
}

struct Args { const float* in[29]; float* out; unsigned char* ws; int ph_lo, ph_hi; };
typedef const __attribute__((address_space(4))) Args* KA;
__device__ __forceinline__ KA fresh_args() { KA p = (KA)__builtin_amdgcn_kernarg_segment_ptr(); asm volatile("" : "+s"(p)); return p; }
struct Ctx;
struct Ctx {
    LAS unsigned char* lds;
    int tid, lane, wave, gw, ngw;
    int wave0;
    unsigned char* ws;
};
__device__ __forceinline__ void enter_phase(Ctx& C, KA A) {
    int t; asm volatile("v_mbcnt_lo_u32_b32 %0, -1, 0\n\tv_mbcnt_hi_u32_b32 %0, -1, %0" : "=v"(t)); t += C.wave0 * 64; C.tid = t; C.lane = t & 63; C.wave = __builtin_amdgcn_readfirstlane(t >> 6);
    C.gw = blockIdx.x * 8 + C.wave; C.ngw = gridDim.x * 8; C.ws = A->ws; }
enum { I_X = 0, I_P, I_MIXN, I_WIN, I_BF, I_CONVW, I_CONVB, I_WR, I_BR, I_WI, I_BI, I_LAM, I_QN, I_KN, I_LRUN, I_ATTN, I_WOUT, I_FFNN,
       I_WG, I_BG, I_WRT, I_BRT, I_WEG, I_WEU, I_WED, I_PLEN, I_WPG, I_BPG, I_WPP };

__device__ __forceinline__ void transpose_item(const float* W, int ldw, int K, bf16* WT, int k0, int n0, int c0, LAS float* scr, int lane) {
    { float t[32];
#pragma unroll
      for (int i = 0; i < 32; ++i) t[i] = W[(size_t)(k0 + 2 * i + (lane >> 5)) * ldw + c0 + (lane & 31)];
#pragma unroll
      for (int i = 0; i < 32; ++i) scr[(2 * i + (lane >> 5)) * 33 + (lane & 31)] = t[i]; }
    asm volatile("s_waitcnt lgkmcnt(0)" ::: "memory");
    const int c = lane & 7;
#pragma unroll
    for (int j = 0; j < 4; ++j) { const int n = (lane >> 3) + 8 * j; const LAS float* s = scr + (8 * c) * 33 + n;
        v4u o; o.x = pk2(s[0 * 33], s[1 * 33]); o.y = pk2(s[2 * 33], s[3 * 33]); o.z = pk2(s[4 * 33], s[5 * 33]); o.w = pk2(s[6 * 33], s[7 * 33]);
        *(v4u*)(WT + (size_t)(n0 + n) * K + k0 + 8 * c) = o; }
    asm volatile("s_waitcnt lgkmcnt(0)" ::: "memory");
}
__device__ __forceinline__ void phase_prologue(Ctx& C, KA AR) {
    LAS float* scr = (LAS float*)(C.lds + C.wave * 16384);
    constexpr int I_IN = 16 * 80, I_OUT = 16 * 32, I_GU = 32 * 16 * 32, I_DN = 32 * 8 * 32, I_PG = 16 * 32, I_PP = 4 * 32;
    constexpr int PER_L = I_IN + I_OUT + I_GU + I_DN + I_PG + I_PP;
    for (int it = C.gw; it < DEPTH * PER_L; it += C.ngw) {
        const int l = it / PER_L; int r = it % PER_L;
        if (r < I_IN) {
            const int kb = r / 80, nb = r % 80, n0 = 32 * nb, pn = n0 >> 8, jl = n0 & 255, bj = jl >> 7, wc = (jl >> 5) & 3;
            transpose_item(AR->in[I_WIN] + (size_t)l * D * DIN, DIN, D, (bf16*)(C.ws + WS_WIN) + (size_t)l * NZ * D, 64 * kb, n0, 256 * pn + 64 * wc + 32 * bj, scr, C.lane); continue; }
        r -= I_IN;
        if (r < I_OUT) { const int kb = r / 32, nb = r % 32;
            transpose_item(AR->in[I_WOUT] + (size_t)l * D * D, D, D, (bf16*)(C.ws + WS_WOUT) + (size_t)l * D * D, 64 * kb, 32 * nb, 32 * nb, scr, C.lane); continue; }
        r -= I_OUT;
        if (r < I_GU) {
            const int e = r / 512, q = r % 512, kb = q / 32, nb = q % 32, n0 = 32 * nb, pn = n0 >> 8, jl = n0 & 255;
            const float* src = (jl < 128 ? AR->in[I_WEG] : AR->in[I_WEU]) + (size_t)(l * NE + e) * D * DE;
            transpose_item(src, DE, D, (bf16*)(C.ws + WS_WGU) + (size_t)(l * NE + e) * 1024 * D, 64 * kb, n0, 128 * pn + (jl & 127), scr, C.lane); continue; }
        r -= I_GU;
        if (r < I_DN) { const int e = r / 256, q = r % 256, kb = q / 32, nb = q % 32;
            transpose_item(AR->in[I_WED] + (size_t)(l * NE + e) * DE * D, D, DE, (bf16*)(C.ws + WS_WDN) + (size_t)(l * NE + e) * D * DE, 64 * kb, 32 * nb, 32 * nb, scr, C.lane); continue; }
        r -= I_DN;
        if (r < I_PG) { const int kb = r / 32, nb = r % 32;
            transpose_item(AR->in[I_WPG] + (size_t)l * D * D, D, D, (bf16*)(C.ws + WS_WPG) + (size_t)l * D * D, 64 * kb, 32 * nb, 32 * nb, scr, C.lane); continue; }
        r -= I_PG;
        { const int kb = r / 32, nb = r % 32;
            transpose_item(AR->in[I_WPP] + (size_t)l * PLE * D, D, PLE, (bf16*)(C.ws + WS_WPP) + (size_t)l * D * PLE, 64 * kb, 32 * nb, 32 * nb, scr, C.lane); }
    }
    const f32x4* ps = (const f32x4*)AR->in[I_P]; v2u* pd = (v2u*)(C.ws + WS_PB);
    const size_t n4 = (size_t)DEPTH * T * PLE / 4;
    { const size_t st = (size_t)gridDim.x * 512; size_t i = (size_t)blockIdx.x * 512 + C.tid;
      for (; i + 7 * st < n4; i += 8 * st) { f32x4 v[8];
#pragma unroll
          for (int q = 0; q < 8; ++q) v[q] = ps[i + q * st];
#pragma unroll
          for (int q = 0; q < 8; ++q) { v2u o; o.x = pk2(v[q].x, v[q].y); o.y = pk2(v[q].z, v[q].w); pd[i + q * st] = o; } }
      for (; i < n4; i += st) { const f32x4 v = ps[i]; v2u o; o.x = pk2(v.x, v.y); o.y = pk2(v.z, v.w); pd[i] = o; } }
}

__device__ __forceinline__ void load_row(const float* row, int lane, f32x4 (&v)[4]) {
    const f32x4* xr = (const f32x4*)row + lane;
#pragma unroll
    for (int j = 0; j < 4; ++j) v[j] = xr[64 * j];
}
__device__ __forceinline__ float row_rs(const f32x4 (&v)[4]) {
    float s = 0.f;
#pragma unroll
    for (int j = 0; j < 4; ++j) s += (v[j].x * v[j].x + v[j].y * v[j].y) + (v[j].z * v[j].z + v[j].w * v[j].w);
    return rsqrtf(wave_sum(s) * (1.f / D) + EPS);
}
__device__ __forceinline__ void scale_row(f32x4 (&v)[4], float rs, const float* gain, int lane) {
    const f32x4* g = (const f32x4*)gain + lane;
#pragma unroll
    for (int j = 0; j < 4; ++j) v[j] = v[j] * rs * g[64 * j];
}
__device__ __forceinline__ void store_row_bf16(bf16* row, int lane, const f32x4 (&v)[4]) {
    v2u* o = (v2u*)row + lane;
#pragma unroll
    for (int j = 0; j < 4; ++j) { v2u w; w.x = pk2(v[j].x, v[j].y); w.y = pk2(v[j].z, v[j].w); o[64 * j] = w; }
}

__device__ __forceinline__ void phase_norm1(Ctx& C, KA AR, int l) {
    const float* xs = l == 0 ? AR->in[I_X] : (const float*)(C.ws + WS_X);
    const float* gain = AR->in[I_MIXN] + l * D;
    const float* wf = AR->in[I_WIN] + (size_t)l * D * DIN + NZ;
    const float* bfg = AR->in[I_BF] + l * NH;
    bf16* xn = (bf16*)(C.ws + WS_XN); float* logf = (float*)(C.ws + WS_LOGF);
    for (int t = C.gw; t < T; t += C.ngw) {
        f32x4 v[4]; load_row(xs + (size_t)t * D, C.lane, v);
        const float rs = row_rs(v); scale_row(v, rs, gain, C.lane);
        store_row_bf16(xn + (size_t)t * D, C.lane, v);
        float z[8] = {0.f, 0.f, 0.f, 0.f, 0.f, 0.f, 0.f, 0.f};
#pragma unroll
        for (int j = 0; j < 4; ++j)
#pragma unroll
            for (int e = 0; e < 4; ++e) { const int k = 256 * j + 4 * C.lane + e; const f32x4 w0 = *(const f32x4*)(wf + (size_t)k * DIN), w1 = *(const f32x4*)(wf + (size_t)k * DIN + 4);
                const float a = v[j][e]; z[0] += a * w0.x; z[1] += a * w0.y; z[2] += a * w0.z; z[3] += a * w0.w; z[4] += a * w1.x; z[5] += a * w1.y; z[6] += a * w1.z; z[7] += a * w1.w; }
#pragma unroll
        for (int h = 0; h < 8; ++h) z[h] = wave_sum(z[h]);
        float mine = 0.f;
#pragma unroll
        for (int h = 0; h < 8; ++h) mine = (C.lane == h) ? z[h] : mine;
        if (C.lane < 8) logf[(size_t)t * 8 + C.lane] = log_sigmoid(mine + bfg[C.lane]);
    }
}

template <int NACC, class AR, class BR, class EP>
__device__ __forceinline__ void ngemm_tile(LAS float* sm, int K, AR arow, BR brow, EP epi, const int tid) {
    LAS float* As = sm; LAS float* Bs = sm + 32 * 68;
    const int ty = tid >> 4, tx = tid & 15, lr = tid >> 3, lk = (tid & 7) * 4;
    float acc[NACC][2][4];
#pragma unroll
    for (int a = 0; a < NACC; ++a)
#pragma unroll
        for (int i = 0; i < 2; ++i)
#pragma unroll
            for (int j = 0; j < 4; ++j) acc[a][i][j] = 0.f;
    const bf16* ap = arow(lr); const bf16* bp0 = brow(lr, 0); const bf16* bp1 = NACC > 1 ? brow(lr, 1) : bp0;
    for (int k0 = 0; k0 < K; k0 += 32) {
        __syncthreads();
        { v2u av; av.x = 0u; av.y = 0u; if (ap) av = *(const v2u*)(ap + k0 + lk);
          As[(lk + 0) * 68 + lr] = bflo(av.x); As[(lk + 1) * 68 + lr] = bfhi(av.x); As[(lk + 2) * 68 + lr] = bflo(av.y); As[(lk + 3) * 68 + lr] = bfhi(av.y); }
        { const v2u bv = *(const v2u*)(bp0 + k0 + lk);
          Bs[(lk + 0) * 68 + lr] = bflo(bv.x); Bs[(lk + 1) * 68 + lr] = bfhi(bv.x); Bs[(lk + 2) * 68 + lr] = bflo(bv.y); Bs[(lk + 3) * 68 + lr] = bfhi(bv.y); }
        if (NACC > 1) { const v2u bv = *(const v2u*)(bp1 + k0 + lk); LAS float* B1 = Bs + 32 * 68;
          B1[(lk + 0) * 68 + lr] = bflo(bv.x); B1[(lk + 1) * 68 + lr] = bfhi(bv.x); B1[(lk + 2) * 68 + lr] = bflo(bv.y); B1[(lk + 3) * 68 + lr] = bfhi(bv.y); }
        __syncthreads();
#pragma unroll 8
        for (int kk = 0; kk < 32; ++kk) {
            const float a0 = As[kk * 68 + ty * 2], a1 = As[kk * 68 + ty * 2 + 1];
#pragma unroll
            for (int a = 0; a < NACC; ++a) { const f32x4 b = *(const LAS f32x4*)(Bs + a * 32 * 68 + kk * 68 + tx * 4);
#pragma unroll
                for (int j = 0; j < 4; ++j) { acc[a][0][j] += a0 * b[j]; acc[a][1][j] += a1 * b[j]; } }
        }
    }
#pragma unroll
    for (int i = 0; i < 2; ++i)
#pragma unroll
        for (int j = 0; j < 4; ++j) epi(ty * 2 + i, tx * 4 + j, acc[0][i][j], NACC > 1 ? acc[1][i][j] : 0.f);
}

__device__ __forceinline__ void phase_cumsum(Ctx& C, KA AR) {
    if (C.gw < NB * NH) {
        const int b = C.gw / NH, h = C.gw % NH;
        const float* logf = (const float*)(C.ws + WS_LOGF) + (size_t)b * S * 8 + h; float* c2k = (float*)(C.ws + WS_C2K) + (size_t)C.gw * S;
        float s = 0.f;
        for (int i = 0; i < 64; ++i) s += logf[(size_t)(64 * C.lane + i) * 8];
        float inc = s;
#pragma unroll
        for (int o = 1; o < 64; o <<= 1) { const float v = __builtin_bit_cast(float, __builtin_amdgcn_ds_bpermute((C.lane - o) << 2, __builtin_bit_cast(int, inc))); if (C.lane >= o) inc += v; }
        float run = inc - s;
        for (int i = 0; i < 64; ++i) { run += logf[(size_t)(64 * C.lane + i) * 8]; c2k[64 * C.lane + i] = run * LOG2E; }
    }
}
__device__ __forceinline__ void phase_cumsum_fast(Ctx& C, KA AR) {
    const int row = (int)blockIdx.x - (int)gridDim.x / 2;
    if (C.wave == 0 && row >= 0 && row < NB * NH) {
        const float* src = (const float*)(C.ws + WS_LOGF) + (size_t)row * S + C.lane; float* dst = (float*)(C.ws + WS_C2K) + (size_t)row * S + C.lane;
        float run = 0.f;
        for (int it = 0; it < S / 64; it += 8) {
            float v[8];
#pragma unroll
            for (int q = 0; q < 8; ++q) v[q] = src[(it + q) * 64];
#pragma unroll
            for (int q = 0; q < 8; ++q) { float x = v[q];
#pragma unroll
                for (int o = 1; o < 64; o <<= 1) { const float y = __builtin_bit_cast(float, __builtin_amdgcn_ds_bpermute((C.lane - o) << 2, __builtin_bit_cast(int, x))); if (C.lane >= o) x += y; }
                dst[(it + q) * 64] = (run + x) * LOG2E;
                run += __builtin_bit_cast(float, __builtin_amdgcn_readlane(__builtin_bit_cast(int, x), 63)); }
        }
    }
}
__device__ __forceinline__ void phase_gemm1_naive(Ctx& C, KA AR, int l) {
    phase_cumsum(C, AR);
    const bf16* A = (const bf16*)(C.ws + WS_XN); const bf16* Bt = (const bf16*)(C.ws + WS_WIN) + (size_t)l * NZ * D;
    bf16* R1 = (bf16*)(C.ws + WS_R1);
    for (int u = blockIdx.x; u < (T / 64) * (NZ / 64); u += gridDim.x) {
        const int mt = u / (NZ / 64), nt = u % (NZ / 64), m0 = 64 * mt, n0 = 64 * nt;
        ngemm_tile<1>((LAS float*)C.lds, D, [=](int r) { return A + (size_t)(m0 + r) * D; }, [=](int c, int) { return Bt + (size_t)(n0 + c) * D; },
            [=](int r, int c, float v, float) {
                const int j = n0 + c, pn = j >> 8, jl = j & 255, bj = jl >> 7, wc = (jl >> 5) & 3, col = 256 * pn + 64 * wc + 32 * bj + (jl & 31);
                const int seg = col >> 9, cc = col & 511;
                const float o = seg == 1 ? gelu_tanh(v) : v;
                R1[(size_t)seg * T * 512 + (size_t)(m0 + r) * 512 + cc] = (bf16)f2bf(o);
            }, C.tid);
    }
}
__device__ __forceinline__ void phase_qknorm_naive(Ctx& C, KA AR, int l) {
    bf16* Q = (bf16*)(C.ws + WS_R1) + (size_t)2 * T * 512; bf16* Kb = Q + (size_t)T * 512;
    const float* gq = AR->in[I_QN] + l * HD; const float* gk = AR->in[I_KN] + l * HD;
    for (int i = C.gw; i < 2 * T; i += C.ngw) {
        const int t = i >> 1, isk = i & 1; bf16* row = (isk ? Kb : Q) + (size_t)t * 512; const float* g = isk ? gk : gq;
        const v4u w = *(const v4u*)(row + 8 * C.lane);
        float x[8] = {bflo(w.x), bfhi(w.x), bflo(w.y), bfhi(w.y), bflo(w.z), bfhi(w.z), bflo(w.w), bfhi(w.w)};
        float s = 0.f;
#pragma unroll
        for (int e = 0; e < 8; ++e) s += x[e] * x[e];
        s += lane_xor<1>(s); s += lane_xor<2>(s); s += lane_xor<4>(s);
        const float rs = rsqrtf(s * (1.f / 64.f) + EPS) * (isk ? 1.f : C2);
        const int d0 = 8 * (C.lane & 7);
#pragma unroll
        for (int e = 0; e < 8; ++e) x[e] = x[e] * rs * g[d0 + e];
        v4u o; o.x = pk2(x[0], x[1]); o.y = pk2(x[2], x[3]); o.z = pk2(x[4], x[5]); o.w = pk2(x[6], x[7]);
        *(v4u*)(row + 8 * C.lane) = o;
    }
}

template <int MODE>
__device__ __forceinline__ void phase_rnn_naive(Ctx& C, KA AR, int l) {
    LAS float* xcs = (LAS float*)C.lds; LAS float* as = xcs + 64 * 65; LAS float* us = as + 64 * 64;
    const bf16* ZX = (const bf16*)(C.ws + WS_R1); const bf16* ZG = ZX + (size_t)T * 512;
    float* SA = (float*)(C.ws + WS_SA); float* SH = (float*)(C.ws + WS_SH); float* YR = (float*)(C.ws + WS_PROJ);
    const float* cw = AR->in[I_CONVW] + l * 4 * DR; const float* cb = AR->in[I_CONVB] + l * DR;
    const float* wr = AR->in[I_WR] + (size_t)l * 8 * 64 * 64; const float* wi = AR->in[I_WI] + (size_t)l * 8 * 64 * 64;
    const float* br = AR->in[I_BR] + l * DR; const float* bi = AR->in[I_BI] + l * DR; const float* lam = AR->in[I_LAM] + l * DR;
    for (int u = blockIdx.x; u < NB * 64 * 8; u += gridDim.x) {
        const int b = u >> 9, cidx = (u >> 3) & 63, blk = u & 7;
        __syncthreads();
#pragma unroll
        for (int i = 0; i < 8; ++i) { const int e = C.tid + 512 * i, t = e >> 6, c = e & 63, ch = blk * 64 + c, tg = cidx * 64 + t;
            float xc = cb[ch];
#pragma unroll
            for (int j = 0; j < 4; ++j) { const int tt = tg - 3 + j; if (tt >= 0) xc += cw[j * DR + ch] * bf2f(ZX[(size_t)(b * S + tt) * 512 + ch]); }
            xcs[t * 65 + c] = xc; }
        __syncthreads();
#pragma unroll
        for (int i = 0; i < 8; ++i) { const int e = C.tid + 512 * i, t = e >> 6, j = e & 63, ch = blk * 64 + j;
            float ar = br[ch], ai = bi[ch];
            for (int k = 0; k < 64; ++k) { const float x = xcs[t * 65 + k]; ar += x * wr[(size_t)(blk * 64 + k) * 64 + j]; ai += x * wi[(size_t)(blk * 64 + k) * 64 + j]; }
            const float r = sigmoidf_(ar), ig = sigmoidf_(ai);
            const float la = -8.f * r * log1pf(__expf(-lam[ch]));
            as[t * 64 + j] = __expf(la); us[t * 64 + j] = sqrtf(-expm1f(2.f * la)) * (ig * xcs[t * 65 + j]); }
        __syncthreads();
        if (C.tid < 64) { const int j = C.tid, ch = blk * 64 + j;
            if (MODE == 0) { float A = 1.f, H = 0.f;
                for (int t = 0; t < 64; ++t) { const float a = as[t * 64 + j]; H = a * H + us[t * 64 + j]; A *= a; }
                SA[(size_t)(b * 64 + cidx) * 512 + ch] = A; SH[(size_t)(b * 64 + cidx) * 512 + ch] = H;
            } else { float h = 0.f;
                for (int c2 = 0; c2 < cidx; ++c2) h = SA[(size_t)(b * 64 + c2) * 512 + ch] * h + SH[(size_t)(b * 64 + c2) * 512 + ch];
                for (int t = 0; t < 64; ++t) { h = as[t * 64 + j] * h + us[t * 64 + j]; as[t * 64 + j] = h; } } }
        if (MODE == 1) { __syncthreads();
#pragma unroll
            for (int i = 0; i < 8; ++i) { const int e = C.tid + 512 * i, t = e >> 6, c = e & 63, ch = blk * 64 + c; const size_t row = (size_t)(b * S + cidx * 64 + t);
                YR[row * 512 + ch] = as[t * 64 + c] * bf2f(ZG[row * 512 + ch]); } }
    }
}

__device__ __forceinline__ void phase_attn_naive(Ctx& C, KA AR, int l) {
    LAS float* Ks = (LAS float*)C.lds; LAS float* Vs = Ks + 64 * 65; LAS float* Qs = Vs + 64 * 65; LAS float* Ps = Qs + 64 * 64; LAS float* cks = Ps + 8 * 64;
    const bf16* Q = (const bf16*)(C.ws + WS_R1) + (size_t)2 * T * 512; const bf16* Kb = Q + (size_t)T * 512; const bf16* Vb = Kb + (size_t)T * 512;
    bf16* O = (bf16*)(C.ws + WS_R2); const float* c2k = (const float*)(C.ws + WS_C2K);
    for (int u = blockIdx.x; u < NB * NH * 64; u += gridDim.x) {
        const int qt = 63 - (u >> 5), bh = u & 31, b = bh >> 3, h = bh & 7, q0 = 64 * qt;
        const float* ck = c2k + (size_t)bh * S;
        __syncthreads();
        for (int e = C.tid; e < 64 * 64; e += 512) { const int r = e >> 6, d = e & 63; Qs[r * 64 + d] = bf2f(Q[(size_t)(b * S + q0 + r) * 512 + h * 64 + d]); }
        float m[8], lsum[8], o[8], cq[8];
#pragma unroll
        for (int i = 0; i < 8; ++i) { m[i] = -INFINITY; lsum[i] = 0.f; o[i] = 0.f; cq[i] = ck[q0 + C.wave * 8 + i]; }
        for (int kt = 0; kt <= qt; ++kt) {
            const int k0 = 64 * kt;
            __syncthreads();
            for (int e = C.tid; e < 64 * 64; e += 512) { const int r = e >> 6, d = e & 63; const size_t g = (size_t)(b * S + k0 + r) * 512 + h * 64 + d; Ks[r * 65 + d] = bf2f(Kb[g]); Vs[r * 65 + d] = bf2f(Vb[g]); }
            if (C.tid < 64) cks[C.tid] = ck[k0 + C.tid];
            __syncthreads();
#pragma unroll
            for (int i = 0; i < 8; ++i) {
                const int q = C.wave * 8 + i, qg = q0 + q;
                float dot = 0.f;
#pragma unroll 16
                for (int d = 0; d < 64; ++d) dot += Qs[q * 64 + d] * Ks[C.lane * 65 + d];
                float s = dot + cq[i] - cks[C.lane];
                if (k0 + C.lane > qg) s = -INFINITY;
                const float mn = fmaxf(m[i], wave_max(s));
                const float alpha = exp2f(m[i] - mn), p = exp2f(s - mn);
                lsum[i] = lsum[i] * alpha + wave_sum(p); m[i] = mn;
                Ps[C.wave * 64 + C.lane] = p;
                asm volatile("s_waitcnt lgkmcnt(0)" ::: "memory");
                float acc = 0.f;
#pragma unroll 16
                for (int k = 0; k < 64; ++k) acc += Ps[C.wave * 64 + k] * Vs[k * 65 + C.lane];
                o[i] = o[i] * alpha + acc;
                asm volatile("s_waitcnt lgkmcnt(0)" ::: "memory");
            }
        }
#pragma unroll
        for (int i = 0; i < 8; ++i) O[(size_t)(b * S + q0 + C.wave * 8 + i) * 512 + h * 64 + C.lane] = (bf16)f2bf(o[i] / lsum[i]);
    }
}

__device__ __forceinline__ void phase_mixnorm_naive(Ctx& C, KA AR, int l) {
    const float* YR = (const float*)(C.ws + WS_PROJ); const bf16* O = (const bf16*)(C.ws + WS_R2); bf16* YM = (bf16*)(C.ws + WS_R2 + 16 * MiB);
    const float* g1 = AR->in[I_LRUN] + l * DR; const float* g2 = AR->in[I_ATTN] + l * DA;
    for (int t = C.gw; t < T; t += C.ngw) {
        f32x4 a[2]; float s = 0.f;
#pragma unroll
        for (int j = 0; j < 2; ++j) { a[j] = *((const f32x4*)(YR + (size_t)t * 512) + C.lane + 64 * j); s += (a[j].x * a[j].x + a[j].y * a[j].y) + (a[j].z * a[j].z + a[j].w * a[j].w); }
        float rs = rsqrtf(wave_sum(s) * (1.f / 512.f) + EPS);
#pragma unroll
        for (int j = 0; j < 2; ++j) { const f32x4 g = *((const f32x4*)g1 + C.lane + 64 * j); const f32x4 v = a[j] * rs * g; v2u w; w.x = pk2(v.x, v.y); w.y = pk2(v.z, v.w);
            *((v2u*)(YM + (size_t)t * D) + C.lane + 64 * j) = w; }
        const v4u w = *(const v4u*)(O + (size_t)t * 512 + 8 * C.lane);
        float x[8] = {bflo(w.x), bfhi(w.x), bflo(w.y), bfhi(w.y), bflo(w.z), bfhi(w.z), bflo(w.w), bfhi(w.w)};
        s = 0.f;
#pragma unroll
        for (int e = 0; e < 8; ++e) s += x[e] * x[e];
        rs = rsqrtf(wave_sum(s) * (1.f / 512.f) + EPS);
#pragma unroll
        for (int e = 0; e < 8; ++e) x[e] = x[e] * rs * g2[8 * C.lane + e];
        v4u o; o.x = pk2(x[0], x[1]); o.y = pk2(x[2], x[3]); o.z = pk2(x[4], x[5]); o.w = pk2(x[6], x[7]);
        *(v4u*)(YM + (size_t)t * D + 512 + 8 * C.lane) = o;
    }
}

__device__ __forceinline__ void phase_wo_naive(Ctx& C, KA AR, int l) {
    const bf16* A = (const bf16*)(C.ws + WS_R2 + 16 * MiB); const bf16* Bt = (const bf16*)(C.ws + WS_WOUT) + (size_t)l * D * D;
    const float* xs = l == 0 ? AR->in[I_X] : (const float*)(C.ws + WS_X); float* X = (float*)(C.ws + WS_X);
    for (int u = blockIdx.x; u < (T / 64) * (D / 64); u += gridDim.x) {
        const int m0 = 64 * (u / (D / 64)), n0 = 64 * (u % (D / 64));
        ngemm_tile<1>((LAS float*)C.lds, D, [=](int r) { return A + (size_t)(m0 + r) * D; }, [=](int c, int) { return Bt + (size_t)(n0 + c) * D; },
            [=](int r, int c, float v, float) { const size_t i = (size_t)(m0 + r) * D + n0 + c; X[i] = xs[i] + v; }, C.tid);
    }
}

__device__ __forceinline__ void phase_router(Ctx& C, KA AR, int l) {
    const float* X = (const float*)(C.ws + WS_X); bf16* xn = (bf16*)(C.ws + WS_XN);
    const float* gain = AR->in[I_FFNN] + l * D; const float* wg = AR->in[I_WG] + (size_t)l * D * 4; const float* bg = AR->in[I_BG] + l * 4;
    const float* wr = AR->in[I_WRT] + (size_t)l * D * NE; const float* brt = AR->in[I_BRT] + l * NE;
    unsigned* cnt = (unsigned*)(C.ws + WS_CTL) + CW_CNT + 32 * CNT_STRIDE * l; int* rowpair = (int*)(C.ws + WS_ROWPAIR); float* pairw = (float*)(C.ws + WS_PAIRW);
    for (int t = C.gw; t < T; t += C.ngw) {
        f32x4 v[4]; load_row(X + (size_t)t * D, C.lane, v);
        const float rs = row_rs(v); scale_row(v, rs, gain, C.lane);
        store_row_bf16(xn + (size_t)t * D, C.lane, v);
        LAS float* rowl = (LAS float*)C.lds + C.wave * 1024;
#pragma unroll
        for (int j = 0; j < 4; ++j) *((LAS f32x4*)rowl + C.lane + 64 * j) = v[j];
        asm volatile("s_waitcnt lgkmcnt(0)" ::: "memory");
        float acc = 0.f;
        if (C.lane < 36) {
            const float* wp = C.lane < 32 ? wr + C.lane : wg + (C.lane - 32); const int st = C.lane < 32 ? NE : 4;
#pragma unroll 8
            for (int k = 0; k < D; ++k) acc += rowl[k] * wp[(size_t)k * st];
            acc += C.lane < 32 ? brt[C.lane] : bg[C.lane - 32];
        }
        asm volatile("s_waitcnt lgkmcnt(0)" ::: "memory");
        float gl[4];
#pragma unroll
        for (int i = 0; i < 4; ++i) gl[i] = __builtin_bit_cast(float, __builtin_amdgcn_readlane(__builtin_bit_cast(int, acc), 32 + i));
        int gi = 0; float gm = gl[0];
#pragma unroll
        for (int i = 1; i < 4; ++i) if (gl[i] > gm) { gm = gl[i]; gi = i; }
        float gs = 0.f;
#pragma unroll
        for (int i = 0; i < 4; ++i) gs += __expf(gl[i] - gm);
        const float gp = 1.f / gs;
        float ev[8];
#pragma unroll
        for (int i = 0; i < 8; ++i) ev[i] = __builtin_bit_cast(float, __builtin_amdgcn_readlane(__builtin_bit_cast(int, acc), __builtin_amdgcn_readfirstlane(gi) * 8 + i));
        int i0 = 0; float t0 = ev[0];
#pragma unroll
        for (int i = 1; i < 8; ++i) if (ev[i] > t0) { t0 = ev[i]; i0 = i; }
        int i1 = -1; float t1 = -INFINITY;
#pragma unroll
        for (int i = 0; i < 8; ++i) if (i != i0 && ev[i] > t1) { t1 = ev[i]; i1 = i; }
        const float ex = __expf(t1 - t0), w0 = gp / (1.f + ex), w1 = gp * ex / (1.f + ex);
        if (C.lane < 2) { const int e = gi * 8 + (C.lane == 0 ? i0 : i1); const unsigned pos = atomicAdd(cnt + e * CNT_STRIDE, 1u);
            rowpair[(size_t)e * CAP + pos] = 2 * t + C.lane; pairw[2 * t + C.lane] = C.lane == 0 ? w0 : w1; }
    }
}

struct ExpTab { int n[NE], hoff[NE], t0[NE + 1]; };
__device__ __forceinline__ void build_exptab(Ctx& C, int l, LAS int* tab) {
    __syncthreads();
    if (C.tid == 0) { const unsigned* cnt = (const unsigned*)(C.ws + WS_CTL) + CW_CNT + 32 * CNT_STRIDE * l; int ho = 0, tt = 0;
        for (int e = 0; e < NE; ++e) { const int n = (int)__hip_atomic_load(cnt + e * CNT_STRIDE, __ATOMIC_RELAXED, __HIP_MEMORY_SCOPE_AGENT); tab[e] = n; tab[32 + e] = ho; tab[64 + e] = tt; ho += (n + 255) & ~255; tt += (n + 63) >> 6; }
        tab[64 + NE] = tt; }
    __syncthreads();
}
__device__ __forceinline__ void phase_g1_naive(Ctx& C, KA AR, int l) {
    LAS int* tab = (LAS int*)(C.lds + 65536); build_exptab(C, l, tab);
    const bf16* xn = (const bf16*)(C.ws + WS_XN); const int* rowpair = (const int*)(C.ws + WS_ROWPAIR); bf16* Hb = (bf16*)(C.ws + WS_R2);
    const int nmt = tab[64 + NE];
    for (int u = blockIdx.x; u < nmt * 8; u += gridDim.x) {
        const int mtg = u >> 3, nt = u & 7; int e = 0;
        for (int i = 1; i < NE; ++i) if (tab[64 + i] <= mtg) e = i;
        const int mt = mtg - tab[64 + e], ne = tab[e], ho = tab[32 + e], p0 = 64 * mt, c0 = 64 * nt;
        const bf16* Bt = (const bf16*)(C.ws + WS_WGU) + (size_t)(l * NE + e) * 1024 * D; const int* rp = rowpair + (size_t)e * CAP;
        ngemm_tile<2>((LAS float*)C.lds, D,
            [=](int r) { return (p0 + r < ne) ? xn + (size_t)(rp[p0 + r] >> 1) * D : (const bf16*)nullptr; },
            [=](int c, int a) { const int cc = c0 + c; return Bt + (size_t)((cc >> 7) * 256 + (cc & 127) + a * 128) * D; },
            [=](int r, int c, float g, float uu) { if (p0 + r < ne) Hb[(size_t)(ho + p0 + r) * DE + c0 + c] = (bf16)f2bf(g / (1.f + __expf(-g)) * uu); }, C.tid);
    }
}
__device__ __forceinline__ void phase_g2_naive(Ctx& C, KA AR, int l) {
    LAS int* tab = (LAS int*)(C.lds + 65536); build_exptab(C, l, tab);
    const int* rowpair = (const int*)(C.ws + WS_ROWPAIR); const float* pairw = (const float*)(C.ws + WS_PAIRW); const bf16* Hb = (const bf16*)(C.ws + WS_R2); bf16* Y2 = (bf16*)(C.ws + WS_R1);
    const int nmt = tab[64 + NE];
    for (int u = blockIdx.x; u < nmt * 16; u += gridDim.x) {
        const int mtg = u >> 4, nt = u & 15; int e = 0;
        for (int i = 1; i < NE; ++i) if (tab[64 + i] <= mtg) e = i;
        const int mt = mtg - tab[64 + e], ne = tab[e], ho = tab[32 + e], p0 = 64 * mt, c0 = 64 * nt;
        const bf16* Bt = (const bf16*)(C.ws + WS_WDN) + (size_t)(l * NE + e) * D * DE; const int* rp = rowpair + (size_t)e * CAP;
        ngemm_tile<1>((LAS float*)C.lds, DE,
            [=](int r) { return (p0 + r < ne) ? Hb + (size_t)(ho + p0 + r) * DE : (const bf16*)nullptr; },
            [=](int c, int) { return Bt + (size_t)(c0 + c) * DE; },
            [=](int r, int c, float v, float) { if (p0 + r < ne) { const int p = rp[p0 + r]; Y2[(size_t)p * D + c0 + c] = (bf16)f2bf(v * pairw[p]); } }, C.tid);
    }
}

__device__ __forceinline__ void phase_combine(Ctx& C, KA AR, int l) {
    float* X = (float*)(C.ws + WS_X); const bf16* Y2 = (const bf16*)(C.ws + WS_R1); bf16* xn = (bf16*)(C.ws + WS_XN); const float* gain = AR->in[I_PLEN] + l * D;
    for (int t = 2 * C.gw; t < T; t += 2 * C.ngw) {
        f32x4 v[2][4]; v2u ya[2][4], yb[2][4];
#pragma unroll
        for (int q = 0; q < 2; ++q) { load_row(X + (size_t)(t + q) * D, C.lane, v[q]);
#pragma unroll
            for (int j = 0; j < 4; ++j) { ya[q][j] = *((const v2u*)(Y2 + (size_t)(2 * (t + q)) * D) + C.lane + 64 * j); yb[q][j] = *((const v2u*)(Y2 + (size_t)(2 * (t + q) + 1) * D) + C.lane + 64 * j); } }
#pragma unroll
        for (int q = 0; q < 2; ++q) {
#pragma unroll
            for (int j = 0; j < 4; ++j) { const v2u a = ya[q][j], b = yb[q][j];
                v[q][j].x += bflo(a.x) + bflo(b.x); v[q][j].y += bfhi(a.x) + bfhi(b.x); v[q][j].z += bflo(a.y) + bflo(b.y); v[q][j].w += bfhi(a.y) + bfhi(b.y);
                *((f32x4*)(X + (size_t)(t + q) * D) + C.lane + 64 * j) = v[q][j]; }
            const float rs = row_rs(v[q]); scale_row(v[q], rs, gain, C.lane);
            store_row_bf16(xn + (size_t)(t + q) * D, C.lane, v[q]); }
    }
}

__device__ __forceinline__ void phase_proj_naive(Ctx& C, KA AR, int l) {
    const bf16* A = (const bf16*)(C.ws + WS_PB) + (size_t)l * T * PLE; const bf16* Bt = (const bf16*)(C.ws + WS_WPP) + (size_t)l * D * PLE; bf16* PR = (bf16*)(C.ws + WS_PROJ);
    for (int u = blockIdx.x; u < (T / 64) * (D / 64); u += gridDim.x) {
        const int m0 = 64 * (u / (D / 64)), n0 = 64 * (u % (D / 64));
        ngemm_tile<1>((LAS float*)C.lds, PLE, [=](int r) { return A + (size_t)(m0 + r) * PLE; }, [=](int c, int) { return Bt + (size_t)(n0 + c) * PLE; },
            [=](int r, int c, float v, float) { PR[(size_t)(m0 + r) * D + n0 + c] = (bf16)f2bf(v); }, C.tid);
    }
}
__device__ __forceinline__ void phase_ple_naive(Ctx& C, KA AR, int l) {
    const bf16* A = (const bf16*)(C.ws + WS_XN); const bf16* Bt = (const bf16*)(C.ws + WS_WPG) + (size_t)l * D * D; const bf16* PR = (const bf16*)(C.ws + WS_PROJ);
    const float* X = (const float*)(C.ws + WS_X); float* dst = l == DEPTH - 1 ? AR->out : (float*)(C.ws + WS_X); const float* bias = AR->in[I_BPG] + l * D;
    for (int u = blockIdx.x; u < (T / 64) * (D / 64); u += gridDim.x) {
        const int m0 = 64 * (u / (D / 64)), n0 = 64 * (u % (D / 64));
        ngemm_tile<1>((LAS float*)C.lds, D, [=](int r) { return A + (size_t)(m0 + r) * D; }, [=](int c, int) { return Bt + (size_t)(n0 + c) * D; },
            [=](int r, int c, float v, float) { const size_t i = (size_t)(m0 + r) * D + n0 + c; dst[i] = X[i] + bf2f(PR[i]) * sigmoidf_(v + bias[n0 + c]); }, C.tid);
    }
}

namespace pg8 {
typedef unsigned short bf16_t;
typedef short bf16x8 __attribute__((ext_vector_type(8)));
typedef unsigned u32x4 __attribute__((ext_vector_type(4)));
constexpr int BM = 256, BK = 64, HALF = 128, HTB = HALF * BK * 2, STAGE_BYTES = 8 * HTB, NXCD = 8, WGM = 8;
__device__ __forceinline__ int lds_byte(int r, int c) { const int st = (r >> 4) * 2 + (c >> 5), rr = r & 15, cc = c & 31, ob = rr * 64 + cc * 2; return st * 1024 + (ob ^ (((ob >> 9) & 1) << 5)); }
__device__ __forceinline__ void stage_rc(int b, int& R, int& C) { const int st = b / 1024, sb = b % 1024, swz = sb ^ (((sb >> 9) & 1) << 5); R = (st >> 1) * 16 + swz / 64; C = (st & 1) * 32 + (swz % 64) / 2; }
__device__ __forceinline__ int perm32(int rho) { const int n = rho >> 4, i = rho & 15; return 8 * (i >> 2) + 4 * n + (i & 3); }
struct Unit { int pm, pn, e, aux, mt; };
struct Gemm { const bf16_t* A; const bf16_t* Bt; int K; };
struct StaticOrder {
    int nM, nN, nwg, G, c;
    __device__ void init(int M, int N, int G_, int c_) { nM = M / BM; nN = N / BM; nwg = nM * nN; G = G_; c = c_; }
    __device__ bool next(int i, Unit& u) const {
        const long L = (long)i * G + c; if (L >= nwg) return false;
        int wgid = (int)L; { const int q = nwg / NXCD, r = nwg % NXCD, xcd = wgid % NXCD, off = wgid / NXCD; wgid = (xcd < r ? xcd * (q + 1) : r * (q + 1) + (xcd - r) * q) + off; }
        const int nig = WGM * nN, gid = wgid / nig, fm = gid * WGM, gsz = (nM - fm) < WGM ? (nM - fm) : WGM;
        u.pm = fm + ((wgid % nig) % gsz); u.pn = (wgid % nig) / gsz; u.e = 0; u.aux = 256; u.mt = 0; return true;
    }
    __device__ __forceinline__ const char* a_base(const Gemm& g, const Unit& u) const { return (const char*)g.A + (size_t)u.pm * 512 * g.K; }
    __device__ __forceinline__ const char* b_base(const Gemm& g, const Unit& u) const { return (const char*)g.Bt + (size_t)u.pn * 512 * g.K; }
    __device__ __forceinline__ int a_row(const Unit&, int) const { return 0; }
};
__device__ __forceinline__ unsigned cvt_pk_bf16(float lo, float hi) { unsigned r; asm volatile("v_cvt_pk_bf16_f32 %0, %1, %2" : "=v"(r) : "v"(lo), "v"(hi)); return r; }

template <class Epi, class Sched, bool ALIGN_EPI, bool GATHER>
__device__ __forceinline__ void gemm_phase(LAS unsigned char* lds, const Gemm g, const Sched& S, const Epi& E, const int tid) {
    const int wid = __builtin_amdgcn_readfirstlane(tid >> 6), lane = tid & 63, wr = wid >> 2, wc = wid & 3, fr = lane & 15, fq = lane >> 4;
    const int K = g.K, nt = K / BK;
    unsigned voffB[2];
#pragma unroll
    for (int i = 0; i < 2; ++i) { int R, C; stage_rc(tid * 16 + i * 8192, R, C); const int Rb = Epi::PERM ? ((R & ~31) + perm32(R & 31)) : R; voffB[i] = (unsigned)(Rb * K + C) * 2u; }
    const size_t kstep = (size_t)(BK * 2);
    const size_t hstep = (size_t)HALF * K * 2;
    const size_t hsA = GATHER ? 0 : hstep;
    const unsigned ldsw = (unsigned)wid * 1024u;
    const int aoff = lds_byte(wr * 64 + fr, fq * 8), boff = lds_byte(wc * 32 + fr, fq * 8);
#define PG8_SA(b, h) (((b) * 2 + (h)) * HTB)
#define PG8_SB(b, h) ((4 + (b) * 2 + (h)) * HTB)
#define PG8_STAGE(bufoff, gbase, voff) do { _Pragma("unroll") for (int _i = 0; _i < 2; ++_i) \
        __builtin_amdgcn_global_load_lds((const unsigned*)((const char*)(gbase) + (voff)[_i]), (LAS unsigned*)(lds + (bufoff) + ldsw + _i * 8192), 16, 0, 0); } while (0)
#define PG8_LDA(dst, b, h) do { _Pragma("unroll") for (int m = 0; m < 4; ++m) _Pragma("unroll") for (int k = 0; k < 2; ++k) dst[m][k] = *(const LAS bf16x8*)(lds + PG8_SA(b, h) + aoff + m * 2048 + k * 1024); } while (0)
#define PG8_LDB(dst, b, h) do { _Pragma("unroll") for (int n = 0; n < 2; ++n) _Pragma("unroll") for (int k = 0; k < 2; ++k) dst[n][k] = *(const LAS bf16x8*)(lds + PG8_SB(b, h) + boff + n * 2048 + k * 1024); } while (0)
#define PG8_MMA(ai, bj, At, Bt) do { __builtin_amdgcn_s_setprio(1); _Pragma("unroll") for (int m = 0; m < 4; ++m) _Pragma("unroll") for (int n = 0; n < 2; ++n) _Pragma("unroll") for (int k = 0; k < 2; ++k) \
        acc[ai][bj][m][n] = __builtin_amdgcn_mfma_f32_16x16x32_bf16(Bt[n][k], At[m][k], acc[ai][bj][m][n], 0, 0, 0); __builtin_amdgcn_s_setprio(0); } while (0)
#define PG8_WAIT_V(n) asm volatile("s_waitcnt vmcnt(" #n ")" ::: "memory")
#define PG8_WAIT_L(n) asm volatile("s_waitcnt lgkmcnt(" #n ")" ::: "memory")
#define PG8_BAR __builtin_amdgcn_s_barrier()
#define PG8_SCHED __builtin_amdgcn_sched_barrier(0)
#define PG8_VOFF(dst, u) do { int t_ = tid; if (GATHER) asm volatile("" : "+v"(t_));   \
        _Pragma("unroll") for (int i_ = 0; i_ < 2; ++i_) { int R_, C_; stage_rc(t_ * 16 + i_ * 8192, R_, C_); _Pragma("unroll") for (int h_ = 0; h_ < 2; ++h_) \
        dst[h_][i_] = GATHER ? (unsigned)(S.a_row(u, h_ * HALF + R_) * K + C_) * 2u : (unsigned)(R_ * K + C_) * 2u; } } while (0)
    Unit cur, nxt; int ui = 0;
    if (!S.next(0, cur)) return;
    f32x4 acc[2][2][4][2];
#pragma unroll
    for (int a = 0; a < 2; ++a)
#pragma unroll
        for (int b = 0; b < 2; ++b)
#pragma unroll
            for (int m = 0; m < 4; ++m)
#pragma unroll
                for (int n = 0; n < 2; ++n) acc[a][b][m][n] = (f32x4){0.f, 0.f, 0.f, 0.f};
    if constexpr (Epi::INIT) E.init(acc, cur, wr, wc, fr, fq);
    bf16x8 At[4][2], B0[2][2], B1[2][2];
    unsigned vC[2][2], vN[2][2], vX[2][2];
    PG8_VOFF(vC, cur);
    const char* cA = S.a_base(g, cur); const char* cB = S.b_base(g, cur);
    PG8_STAGE(PG8_SB(0, 0), cB, voffB); PG8_STAGE(PG8_SB(0, 1), cB + hstep, voffB); PG8_STAGE(PG8_SA(0, 0), cA, vC[0]); PG8_STAGE(PG8_SA(0, 1), cA + hsA, vC[1]);
    if (wr == 1) PG8_BAR;
    PG8_WAIT_V(2); PG8_BAR;
    PG8_STAGE(PG8_SB(1, 0), cB + kstep, voffB); PG8_STAGE(PG8_SA(1, 0), cA + kstep, vC[0]); PG8_STAGE(PG8_SB(1, 1), cB + hstep + kstep, voffB);
    PG8_WAIT_V(6); PG8_BAR;
    for (;;) {
        const bool has_next = S.next(ui + 1, nxt);
        const char* nA = has_next ? S.a_base(g, nxt) : cA; const char* nB = has_next ? S.b_base(g, nxt) : cB;
        if (GATHER && has_next) { PG8_VOFF(vN, nxt); }
        else {
#pragma unroll
            for (int h_ = 0; h_ < 2; ++h_)
#pragma unroll
                for (int i_ = 0; i_ < 2; ++i_) vN[h_][i_] = vC[h_][i_]; }
#pragma unroll 1
        for (int t = 0; t < nt; t += 2) {
            const bool last = (t == nt - 2);
            const char* a1 = cA + (size_t)(t + 1) * kstep;
            const char* a2 = last ? nA : cA + (size_t)(t + 2) * kstep; const char* b2 = last ? nB : cB + (size_t)(t + 2) * kstep;
            const char* a3 = a2 + kstep; const char* b3 = b2 + kstep;
#pragma unroll
            for (int h_ = 0; h_ < 2; ++h_)
#pragma unroll
                for (int i_ = 0; i_ < 2; ++i_) vX[h_][i_] = (GATHER && last) ? vN[h_][i_] : vC[h_][i_];
            PG8_LDB(B0, 0, 0); PG8_LDB(B1, 0, 1); PG8_SCHED; PG8_LDA(At, 0, 0); PG8_STAGE(PG8_SA(1, 1), a1 + hsA, vC[1]);
            PG8_WAIT_V(8); PG8_WAIT_L(0); PG8_BAR; PG8_MMA(0, 0, At, B0); PG8_MMA(0, 1, At, B1); PG8_BAR; PG8_SCHED;
            PG8_LDA(At, 0, 1); PG8_STAGE(PG8_SB(0, 0), b2, voffB); PG8_STAGE(PG8_SB(0, 1), b2 + hstep, voffB); PG8_STAGE(PG8_SA(0, 0), a2, vX[0]);
            PG8_WAIT_V(8); PG8_WAIT_L(0); PG8_BAR; PG8_MMA(1, 0, At, B0); PG8_MMA(1, 1, At, B1); PG8_BAR; PG8_SCHED;
            PG8_LDB(B0, 1, 0); PG8_LDB(B1, 1, 1); PG8_SCHED; PG8_LDA(At, 1, 0); PG8_STAGE(PG8_SA(0, 1), a2 + hsA, vX[1]);
            PG8_WAIT_V(8); PG8_WAIT_L(0); PG8_BAR; PG8_MMA(0, 0, At, B0); PG8_MMA(0, 1, At, B1); PG8_BAR; PG8_SCHED;
            PG8_LDA(At, 1, 1); PG8_STAGE(PG8_SB(1, 0), b3, voffB); PG8_STAGE(PG8_SB(1, 1), b3 + hstep, voffB); PG8_STAGE(PG8_SA(1, 0), a3, vX[0]);
            PG8_WAIT_V(8); PG8_WAIT_L(0); PG8_BAR; PG8_MMA(1, 0, At, B0); PG8_MMA(1, 1, At, B1); PG8_BAR; PG8_SCHED;
        }
        if constexpr (ALIGN_EPI) { if (wr == 0) PG8_BAR; }
        E(acc, cur, wr, wc, fr, fq);
        if (!has_next) break;
#pragma unroll
        for (int a = 0; a < 2; ++a)
#pragma unroll
            for (int b = 0; b < 2; ++b)
#pragma unroll
                for (int m = 0; m < 4; ++m)
#pragma unroll
                    for (int n = 0; n < 2; ++n) acc[a][b][m][n] = (f32x4){0.f, 0.f, 0.f, 0.f};
        if constexpr (Epi::INIT) E.init(acc, nxt, wr, wc, fr, fq);
        cur = nxt; cA = nA; cB = nB; ++ui;
#pragma unroll
        for (int h_ = 0; h_ < 2; ++h_)
#pragma unroll
            for (int i_ = 0; i_ < 2; ++i_) vC[h_][i_] = vN[h_][i_];
        if constexpr (ALIGN_EPI) { if (wr == 1) PG8_BAR; }
    }
    PG8_WAIT_V(0);
    if constexpr (!ALIGN_EPI) { if (wr == 0) PG8_BAR; }
    PG8_BAR;
#undef PG8_SA
#undef PG8_SB
#undef PG8_STAGE
#undef PG8_LDA
#undef PG8_LDB
#undef PG8_MMA
#undef PG8_WAIT_V
#undef PG8_WAIT_L
#undef PG8_BAR
#undef PG8_SCHED
#undef PG8_VOFF
}
}

__device__ __forceinline__ float gelu_fast(float v) { const float y = 0.7978845608028654f * (v + 0.044715f * v * v * v); return v * __builtin_amdgcn_rcpf(1.f + __expf(-2.f * y)); }
__device__ __forceinline__ float sigmoid_fast(float v) { return __builtin_amdgcn_rcpf(1.f + __expf(-v)); }

struct EpiZ {
    static constexpr bool PERM = true, INIT = false;
    bf16* R1; const float* gq; const float* gk;
    __device__ __forceinline__ void operator()(const f32x4 (&acc)[2][2][4][2], const pg8::Unit& u, int wr, int wc, int fr, int fq) const {
        const int seg = u.pn >> 1;
        bf16* base = R1 + (size_t)seg * T * 512 + (size_t)(u.pm * 256 + wr * 64 + fr) * 512 + (u.pn & 1) * 256 + wc * 64 + 8 * fq;
        if (seg == 2 || seg == 3) {
            const float* g = seg == 2 ? gq : gk; const float sc = seg == 2 ? C2 : 1.f;
            f32x4 gv[2][2];
#pragma unroll
            for (int bj = 0; bj < 2; ++bj)
#pragma unroll
                for (int n = 0; n < 2; ++n) gv[bj][n] = *(const f32x4*)(g + 32 * bj + 8 * fq + 4 * n);
#pragma unroll
            for (int ai = 0; ai < 2; ++ai)
#pragma unroll
                for (int m = 0; m < 4; ++m) {
                    float s = 0.f;
#pragma unroll
                    for (int bj = 0; bj < 2; ++bj)
#pragma unroll
                        for (int n = 0; n < 2; ++n) { const f32x4 x = acc[ai][bj][m][n]; s += (x[0] * x[0] + x[1] * x[1]) + (x[2] * x[2] + x[3] * x[3]); }
                    s += lane_xor<16>(s); s = half_sum32(s);
                    const float rs = rsqrtf(s * (1.f / 64.f) + EPS) * sc;
#pragma unroll
                    for (int bj = 0; bj < 2; ++bj) { const f32x4 v0 = acc[ai][bj][m][0] * rs * gv[bj][0], v1 = acc[ai][bj][m][1] * rs * gv[bj][1];
                        v4u w; w.x = pg8::cvt_pk_bf16(v0[0], v0[1]); w.y = pg8::cvt_pk_bf16(v0[2], v0[3]); w.z = pg8::cvt_pk_bf16(v1[0], v1[1]); w.w = pg8::cvt_pk_bf16(v1[2], v1[3]);
                        *(v4u*)(base + (size_t)(ai * 128 + m * 16) * 512 + 32 * bj) = w; }
                }
        } else {
#pragma unroll
            for (int ai = 0; ai < 2; ++ai)
#pragma unroll
                for (int m = 0; m < 4; ++m)
#pragma unroll
                    for (int bj = 0; bj < 2; ++bj) { f32x4 v0 = acc[ai][bj][m][0], v1 = acc[ai][bj][m][1];
                        if (seg == 1) { v0 = (f32x4){gelu_fast(v0[0]), gelu_fast(v0[1]), gelu_fast(v0[2]), gelu_fast(v0[3])}; v1 = (f32x4){gelu_fast(v1[0]), gelu_fast(v1[1]), gelu_fast(v1[2]), gelu_fast(v1[3])}; }
                        v4u w; w.x = pg8::cvt_pk_bf16(v0[0], v0[1]); w.y = pg8::cvt_pk_bf16(v0[2], v0[3]); w.z = pg8::cvt_pk_bf16(v1[0], v1[1]); w.w = pg8::cvt_pk_bf16(v1[2], v1[3]);
                        *(v4u*)(base + (size_t)(ai * 128 + m * 16) * 512 + 32 * bj) = w; }
        }
    }
};
__device__ __forceinline__ void phase_gemm1_fast(Ctx& C, KA AR, int l) {
    phase_cumsum_fast(C, AR);
    pg8::Gemm g{(const bf16*)(C.ws + WS_XN), (const bf16*)(C.ws + WS_WIN) + (size_t)l * NZ * D, D};
    pg8::StaticOrder S; S.init(T, NZ, gridDim.x, blockIdx.x);
    EpiZ E{(bf16*)(C.ws + WS_R1), AR->in[I_QN] + l * HD, AR->in[I_KN] + l * HD};
    pg8::gemm_phase<EpiZ, pg8::StaticOrder, true, false>(C.lds, g, S, E, C.tid);
}
struct EpiRes {
    static constexpr bool PERM = false, INIT = true;
    const float* xs; float* X;
    __device__ __forceinline__ void init(f32x4 (&acc)[2][2][4][2], const pg8::Unit& u, int wr, int wc, int fr, int fq) const {
        const size_t off0 = (size_t)(u.pm * 256 + wr * 64 + fr) * D + u.pn * 256 + wc * 32 + 4 * fq;
#pragma unroll
        for (int ai = 0; ai < 2; ++ai)
#pragma unroll
            for (int m = 0; m < 4; ++m)
#pragma unroll
                for (int bj = 0; bj < 2; ++bj)
#pragma unroll
                    for (int n = 0; n < 2; ++n) acc[ai][bj][m][n] = *(const f32x4*)(xs + off0 + (size_t)(ai * 128 + m * 16) * D + bj * 128 + n * 16);
    }
    __device__ __forceinline__ void operator()(const f32x4 (&acc)[2][2][4][2], const pg8::Unit& u, int wr, int wc, int fr, int fq) const {
        const size_t off0 = (size_t)(u.pm * 256 + wr * 64 + fr) * D + u.pn * 256 + wc * 32 + 4 * fq;
#pragma unroll
        for (int ai = 0; ai < 2; ++ai)
#pragma unroll
            for (int m = 0; m < 4; ++m)
#pragma unroll
                for (int bj = 0; bj < 2; ++bj)
#pragma unroll
                    for (int n = 0; n < 2; ++n) *(f32x4*)(X + off0 + (size_t)(ai * 128 + m * 16) * D + bj * 128 + n * 16) = acc[ai][bj][m][n];
    }
};
__device__ __forceinline__ void phase_wo_fast(Ctx& C, KA AR, int l) {
    pg8::Gemm g{(const bf16*)(C.ws + WS_R2 + 16 * MiB), (const bf16*)(C.ws + WS_WOUT) + (size_t)l * D * D, D};
    pg8::StaticOrder S; S.init(T, D, gridDim.x, blockIdx.x);
    EpiRes E{l == 0 ? AR->in[I_X] : (const float*)(C.ws + WS_X), (float*)(C.ws + WS_X)};
    pg8::gemm_phase<EpiRes, pg8::StaticOrder, true, false>(C.lds, g, S, E, C.tid);
}
struct EpiProj {
    static constexpr bool PERM = true, INIT = false;
    bf16* PR;
    __device__ __forceinline__ void operator()(const f32x4 (&acc)[2][2][4][2], const pg8::Unit& u, int wr, int wc, int fr, int fq) const {
        bf16* base = PR + (size_t)(u.pm * 256 + wr * 64 + fr) * D + u.pn * 256 + wc * 32 + 8 * fq;
#pragma unroll
        for (int ai = 0; ai < 2; ++ai)
#pragma unroll
            for (int m = 0; m < 4; ++m)
#pragma unroll
                for (int bj = 0; bj < 2; ++bj) { const f32x4 v0 = acc[ai][bj][m][0], v1 = acc[ai][bj][m][1];
                    v4u w; w.x = pg8::cvt_pk_bf16(v0[0], v0[1]); w.y = pg8::cvt_pk_bf16(v0[2], v0[3]); w.z = pg8::cvt_pk_bf16(v1[0], v1[1]); w.w = pg8::cvt_pk_bf16(v1[2], v1[3]);
                    *(v4u*)(base + (size_t)(ai * 128 + m * 16) * D + bj * 128) = w; }
    }
};
__device__ __forceinline__ void phase_proj_fast(Ctx& C, KA AR, int l) {
    pg8::Gemm g{(const bf16*)(C.ws + WS_PB) + (size_t)l * T * PLE, (const bf16*)(C.ws + WS_WPP) + (size_t)l * D * PLE, PLE};
    pg8::StaticOrder S;
    { const int G = gridDim.x, hb = G / 2; if ((int)blockIdx.x >= hb) S.init(T, D, G - hb, (int)blockIdx.x - hb); else S.init(T, D, G - hb, T); }
    EpiProj E{(bf16*)(C.ws + WS_PROJ)};
    pg8::gemm_phase<EpiProj, pg8::StaticOrder, true, false>(C.lds, g, S, E, C.tid);
}
struct EpiPle {
    static constexpr bool PERM = false, INIT = false;
    const float* X; const bf16* PR; const float* bias; float* dst; float pscale;
    __device__ __forceinline__ void operator()(const f32x4 (&acc)[2][2][4][2], const pg8::Unit& u, int wr, int wc, int fr, int fq) const {
        const int col0 = u.pn * 256 + wc * 32 + 4 * fq;
        const size_t off0 = (size_t)(u.pm * 256 + wr * 64 + fr) * D + col0;
        f32x4 bv[2][2];
#pragma unroll
        for (int bj = 0; bj < 2; ++bj)
#pragma unroll
            for (int n = 0; n < 2; ++n) bv[bj][n] = *(const f32x4*)(bias + col0 + bj * 128 + n * 16);
#pragma unroll
        for (int ai = 0; ai < 2; ++ai)
#pragma unroll
            for (int mh = 0; mh < 2; ++mh) { f32x4 xr[2][2][2]; v2u pr[2][2][2];
#pragma unroll
                for (int mm = 0; mm < 2; ++mm)
#pragma unroll
                    for (int bj = 0; bj < 2; ++bj)
#pragma unroll
                        for (int n = 0; n < 2; ++n) { const size_t o = off0 + (size_t)(ai * 128 + (2 * mh + mm) * 16) * D + bj * 128 + n * 16; xr[mm][bj][n] = *(const f32x4*)(X + o); pr[mm][bj][n] = *(const v2u*)(PR + o); }
#pragma unroll
                for (int mm = 0; mm < 2; ++mm)
#pragma unroll
                    for (int bj = 0; bj < 2; ++bj)
#pragma unroll
                        for (int n = 0; n < 2; ++n) { const size_t o = off0 + (size_t)(ai * 128 + (2 * mh + mm) * 16) * D + bj * 128 + n * 16;
                            const v2u pw = pr[mm][bj][n]; const f32x4 a = acc[ai][bj][2 * mh + mm][n] + bv[bj][n]; const f32x4 x = xr[mm][bj][n];
                            f32x4 r; r[0] = x[0] + bflo(pw.x) * sigmoid_fast(a[0]); r[1] = x[1] + bfhi(pw.x) * sigmoid_fast(a[1]); r[2] = x[2] + bflo(pw.y) * sigmoid_fast(a[2]); r[3] = x[3] + bfhi(pw.y) * sigmoid_fast(a[3]);
                            if (PROBE_TIMING) r = r * pscale;
                            *(f32x4*)(dst + o) = r; } }
    }
};
__device__ __forceinline__ void phase_ple_fast(Ctx& C, KA AR, int l) {
    pg8::Gemm g{(const bf16*)(C.ws + WS_XN), (const bf16*)(C.ws + WS_WPG) + (size_t)l * D * D, D};
    pg8::StaticOrder S; S.init(T, D, gridDim.x, blockIdx.x);
    float pscale = 1.f;
    if (PROBE_TIMING && l == DEPTH - 1) { const unsigned long long* ts = (const unsigned long long*)((const unsigned*)(C.ws + WS_CTL) + CW_TS); pscale = 1.f + (float)(ts[PROBE_HI] - ts[PROBE_LO]) * 1.5e-6f; }
    EpiPle E{(const float*)(C.ws + WS_X), (const bf16*)(C.ws + WS_PROJ), AR->in[I_BPG] + l * D, l == DEPTH - 1 ? AR->out : (float*)(C.ws + WS_X), pscale};
    pg8::gemm_phase<EpiPle, pg8::StaticOrder, true, false>(C.lds, g, S, E, C.tid);
}
constexpr int TAB_OFF = MISC_OFF - 4096;
struct GroupOrder {
    const LAS int* tab; int G, c; const int* rowpair; const char* hbase; bool is_g2;
    __device__ bool next(int i, pg8::Unit& u) const {
        int j = i * (G >> 3) + (c >> 3);
#pragma unroll
        for (int q = 0; q < 4; ++q) { const int e = (c & 7) + 8 * q;
            const int t0 = __builtin_amdgcn_readfirstlane(tab[64 + e]), t1 = __builtin_amdgcn_readfirstlane(tab[64 + e + 1]), nu = (t1 - t0) * 4;
            if (j < nu) { const int mt = j >> 2; const int ne = __builtin_amdgcn_readfirstlane(tab[e]), ho = __builtin_amdgcn_readfirstlane(tab[32 + e]);
                int nv = ne - 256 * mt; nv = nv > 256 ? 256 : nv;
                u.pm = ho + 256 * mt; u.pn = j & 3; u.e = e; u.aux = nv; u.mt = mt; return true; }
            j -= nu; }
        return false;
    }
    __device__ __forceinline__ const char* a_base(const pg8::Gemm& g, const pg8::Unit& u) const { return is_g2 ? (const char*)g.A + (size_t)u.pm * 2 * g.K : (const char*)g.A; }
    __device__ __forceinline__ const char* b_base(const pg8::Gemm& g, const pg8::Unit& u) const { return (const char*)g.Bt + (size_t)(u.e * 1024 + u.pn * 256) * 2 * g.K; }
    __device__ __forceinline__ int a_row(const pg8::Unit& u, int r) const { return r < u.aux ? (rowpair[(size_t)u.e * CAP + u.mt * 256 + r] >> 1) : 0; }
};
__device__ __forceinline__ void build_exptab256(Ctx& C, int l, LAS int* tab) {
    __syncthreads();
    if (C.tid < NE) { const unsigned* cnt = (const unsigned*)(C.ws + WS_CTL) + CW_CNT + 32 * CNT_STRIDE * l;
        tab[C.tid] = (int)__hip_atomic_load(cnt + C.tid * CNT_STRIDE, __ATOMIC_RELAXED, __HIP_MEMORY_SCOPE_AGENT); }
    __syncthreads();
    if (C.tid == 0) { int ho = 0, tt = 0;
        for (int e = 0; e < NE; ++e) { const int n = tab[e]; tab[32 + e] = ho; tab[64 + e] = tt;
            const int nt = (n + 255) >> 8; for (int j = 0; j < nt; ++j) tab[128 + tt + j] = e | (j << 8); ho += nt << 8; tt += nt; }
        tab[64 + NE] = tt; }
    __syncthreads();
}
struct EpiG1 {
    static constexpr bool PERM = true, INIT = false;
    bf16* Hb;
    __device__ __forceinline__ void operator()(const f32x4 (&acc)[2][2][4][2], const pg8::Unit& u, int wr, int wc, int fr, int fq) const {
        bf16* base = Hb + (size_t)(u.pm + wr * 64 + fr) * DE + u.pn * 128 + wc * 32 + 8 * fq;
#pragma unroll
        for (int ai = 0; ai < 2; ++ai)
#pragma unroll
            for (int m = 0; m < 4; ++m) { const int rl = ai * 128 + wr * 64 + m * 16 + fr;
                f32x4 h0, h1;
#pragma unroll
                for (int e = 0; e < 4; ++e) { const float g0 = acc[ai][0][m][0][e], g1 = acc[ai][0][m][1][e]; h0[e] = g0 * sigmoid_fast(g0) * acc[ai][1][m][0][e]; h1[e] = g1 * sigmoid_fast(g1) * acc[ai][1][m][1][e]; }
                v4u w; w.x = pg8::cvt_pk_bf16(h0[0], h0[1]); w.y = pg8::cvt_pk_bf16(h0[2], h0[3]); w.z = pg8::cvt_pk_bf16(h1[0], h1[1]); w.w = pg8::cvt_pk_bf16(h1[2], h1[3]);
                if (rl < u.aux) *(v4u*)(base + (size_t)(ai * 128 + m * 16) * DE) = w; }
    }
};
__device__ __forceinline__ void phase_g1_fast(Ctx& C, KA AR, int l) {
    LAS int* tab = (LAS int*)(C.lds + TAB_OFF); build_exptab256(C, l, tab);
    pg8::Gemm g{(const bf16*)(C.ws + WS_XN), (const bf16*)(C.ws + WS_WGU) + (size_t)l * NE * 1024 * D, D};
    GroupOrder S{tab, (int)gridDim.x, (int)blockIdx.x, (const int*)(C.ws + WS_ROWPAIR), nullptr, false};
    EpiG1 E{(bf16*)(C.ws + WS_R2)};
    pg8::gemm_phase<EpiG1, GroupOrder, true, true>(C.lds, g, S, E, C.tid);
}
struct EpiG2 {
    static constexpr bool PERM = true, INIT = false;
    bf16* Y2; const int* rowpair; const float* pairw;
    __device__ __forceinline__ void operator()(const f32x4 (&acc)[2][2][4][2], const pg8::Unit& u, int wr, int wc, int fr, int fq) const {
        const int* rp = rowpair + (size_t)u.e * CAP + u.mt * 256; const int col0 = u.pn * 256 + wc * 32 + 8 * fq;
        int pr[2][4]; float wv[2][4];
#pragma unroll
        for (int ai = 0; ai < 2; ++ai)
#pragma unroll
            for (int m = 0; m < 4; ++m) { const int rl = ai * 128 + wr * 64 + m * 16 + fr; pr[ai][m] = rl < u.aux ? rp[rl] : 0; }
#pragma unroll
        for (int ai = 0; ai < 2; ++ai)
#pragma unroll
            for (int m = 0; m < 4; ++m) wv[ai][m] = pairw[pr[ai][m]];
#pragma unroll
        for (int ai = 0; ai < 2; ++ai)
#pragma unroll
            for (int m = 0; m < 4; ++m) { const int rl = ai * 128 + wr * 64 + m * 16 + fr;
                if (rl < u.aux) { const float w8 = wv[ai][m]; bf16* row = Y2 + (size_t)pr[ai][m] * D + col0;
#pragma unroll
                    for (int bj = 0; bj < 2; ++bj) { const f32x4 v0 = acc[ai][bj][m][0] * w8, v1 = acc[ai][bj][m][1] * w8;
                        v4u w; w.x = pg8::cvt_pk_bf16(v0[0], v0[1]); w.y = pg8::cvt_pk_bf16(v0[2], v0[3]); w.z = pg8::cvt_pk_bf16(v1[0], v1[1]); w.w = pg8::cvt_pk_bf16(v1[2], v1[3]);
                        *(v4u*)(row + bj * 128) = w; } } }
    }
};
__device__ __forceinline__ void phase_g2_fast(Ctx& C, KA AR, int l) {
    LAS int* tab = (LAS int*)(C.lds + TAB_OFF); build_exptab256(C, l, tab);
    pg8::Gemm g{(const bf16*)(C.ws + WS_R2), (const bf16*)(C.ws + WS_WDN) + (size_t)l * NE * D * DE, DE};
    GroupOrder S{tab, (int)gridDim.x, (int)blockIdx.x, (const int*)(C.ws + WS_ROWPAIR), nullptr, true};
    EpiG2 E{(bf16*)(C.ws + WS_R1), (const int*)(C.ws + WS_ROWPAIR), (const float*)(C.ws + WS_PAIRW)};
    pg8::gemm_phase<EpiG2, GroupOrder, true, false>(C.lds, g, S, E, C.tid);
}

#define SBAR() __builtin_amdgcn_sched_barrier(0)
namespace attn_body {
using bf16=__hip_bfloat16;
using bf16x8=__attribute__((ext_vector_type(8)))short;
using s16x4=__attribute__((ext_vector_type(4)))short;
using f32x16=__attribute__((ext_vector_type(16)))float;
using u32x4=__attribute__((ext_vector_type(4)))unsigned;
constexpr int BATCH=4,NHEAD=8,SEQ=4096,D=64,DM=NHEAD*D;
constexpr int NW=8,QBLK=32,QB=QBLK*NW,KVBLK=64,NQB=SEQ/QB;
constexpr int ATTN_PITCH=DM, ATTN_UNIT_ROWS=QB;
__device__ __forceinline__ int crow(int r,int hi){return (r&3)+8*(r>>2)+4*hi;}
#define SBAR() __builtin_amdgcn_sched_barrier(0)
__device__ __forceinline__ void cmask(f32x16&p0,f32x16&p1,int jb,int qrel,int hi){
  const float NEG=-INFINITY; int kb=64*jb+4*hi;
  #pragma unroll
  for(int r=0;r<16;++r){int kv=kb+(r&3)+8*(r>>2); if(kv>qrel)p0[r]=NEG; if(kv+32>qrel)p1[r]=NEG;}
}

constexpr int NSLOT=3, SLOTB=8192;
constexpr int LDS_K=0, LDS_V=NSLOT*SLOTB, LDS_WS=2*NSLOT*SLOTB, LDS_OST=LDS_WS+NW*64*4, LDS_CK=LDS_OST+NW*4096, LDS_BYTES=LDS_CK+SEQ*4;
constexpr float C2=0.125f*1.4426950408889634f;
__device__ __forceinline__ void glds16(const void*gsrc,unsigned lds_dst){unsigned keep;
  asm volatile("s_mov_b32 %0, m0\n\ts_mov_b32 m0, %2\n\ts_nop 0\n\tglobal_load_lds_dwordx4 %1, off\n\ts_mov_b32 m0, %0":"=&s"(keep):"v"(gsrc),"s"(lds_dst):"memory");}
__device__ __forceinline__ float max3f(float a,float b,float c){float r;asm("v_max3_f32 %0, %1, %2, %3":"=v"(r):"v"(a),"v"(b),"v"(c));return r;}
__device__ __forceinline__ float max2f(float a,float b){float r;asm("v_max_f32_e32 %0, %1, %2":"=v"(r):"v"(a),"v"(b));return r;}
__device__ __forceinline__ float fadd_s(float a,float b){float r;asm("v_add_f32_e32 %0, %1, %2":"=v"(r):"v"(a),"v"(b));return r;}
__device__ __forceinline__ float fsub_s(float a,float b){float r;asm("v_sub_f32_e32 %0, %1, %2":"=v"(r):"v"(a),"v"(b));return r;}
typedef float f32x2_t __attribute__((ext_vector_type(2))); typedef __bf16 bf16x2_t __attribute__((ext_vector_type(2)));
__device__ __forceinline__ unsigned cvtpk_s(float lo,float hi){f32x2_t v={lo,hi};bf16x2_t b=__builtin_convertvector(v,bf16x2_t);return __builtin_bit_cast(unsigned,b);}
#define WAIT_BAR(N) asm volatile("s_waitcnt vmcnt(" #N ") lgkmcnt(0)\n\ts_barrier":::"memory")

__device__ __forceinline__ void qkt(f32x16&p0,f32x16&p1,const char*Kslot,const bf16x8*qr,const f32x16&negm,int r32,int hi){
  const char*kb=Kslot+hi*1024+r32*16;
  #pragma unroll
  for(int d0=0;d0<4;++d0){
    const bf16x8 b0=*reinterpret_cast<const bf16x8*>(kb+d0*2048);
    const bf16x8 b1=*reinterpret_cast<const bf16x8*>(kb+d0*2048+512);
    if(d0==0){p0=__builtin_amdgcn_mfma_f32_32x32x16_bf16(b0,qr[0],negm,0,0,0);p1=__builtin_amdgcn_mfma_f32_32x32x16_bf16(b1,qr[0],negm,0,0,0);}
    else{p0=__builtin_amdgcn_mfma_f32_32x32x16_bf16(b0,qr[d0],p0,0,0,0);p1=__builtin_amdgcn_mfma_f32_32x32x16_bf16(b1,qr[d0],p1,0,0,0);}}
}
typedef __attribute__((address_space(3))) const char* lds_cptr;
typedef short v4i16_t __attribute__((ext_vector_type(4)));
__device__ __forceinline__ void kload8(bf16x8*kf,lds_cptr kp){
  kf[0]=*(const __attribute__((address_space(3))) bf16x8*)(kp);      kf[1]=*(const __attribute__((address_space(3))) bf16x8*)(kp+512);
  kf[2]=*(const __attribute__((address_space(3))) bf16x8*)(kp+2048); kf[3]=*(const __attribute__((address_space(3))) bf16x8*)(kp+2560);
  kf[4]=*(const __attribute__((address_space(3))) bf16x8*)(kp+4096); kf[5]=*(const __attribute__((address_space(3))) bf16x8*)(kp+4608);
  kf[6]=*(const __attribute__((address_space(3))) bf16x8*)(kp+6144); kf[7]=*(const __attribute__((address_space(3))) bf16x8*)(kp+6656);
}
__device__ __forceinline__ void kload2(bf16x8*kf,lds_cptr kp,int j){ kf[2*j]=*(const __attribute__((address_space(3))) bf16x8*)(kp+j*2048); kf[2*j+1]=*(const __attribute__((address_space(3))) bf16x8*)(kp+j*2048+512); }
__device__ __forceinline__ s16x4 vtr(lds_cptr p){ return __builtin_bit_cast(s16x4,__builtin_amdgcn_ds_read_tr16_b64_v4i16((__attribute__((address_space(3))) v4i16_t*)p)); }
__device__ __forceinline__ float rowmax(const f32x16&p0,const f32x16&p1){
  float a=max3f(p0[0],p0[1],p1[0]),b=max3f(p0[2],p0[3],p1[1]);a=max3f(a,p1[2],p1[3]);
  #pragma unroll
  for(int r=4;r<16;r+=4){a=max3f(a,p0[r],p0[r+1]);b=max3f(b,p0[r+2],p0[r+3]);a=max3f(a,p1[r],p1[r+1]);b=max3f(b,p1[r+2],p1[r+3]);}
  const float m=max2f(a,b);
  auto rr=__builtin_amdgcn_permlane32_swap(__float_as_uint(m),__float_as_uint(m),false,false);
  return max2f(__uint_as_float(rr[0]),__uint_as_float(rr[1]));
}
__device__ __forceinline__ void pv(f32x16*o,int vb,bf16x8 pa0,bf16x8 pa1,bf16x8 pa2,bf16x8 pa3){
  #pragma unroll
  for(int d0=0;d0<2;++d0){s16x4 lo[4],hi[4];
    #pragma unroll
    for(int ks=0;ks<4;++ks){
      asm volatile("ds_read_b64_tr_b16 %0,%1 offset:%c2":"=&v"(lo[ks]):"v"(vb),"i"(d0*4096+ks*1024):"memory");
      asm volatile("ds_read_b64_tr_b16 %0,%1 offset:%c2":"=&v"(hi[ks]):"v"(vb),"i"(d0*4096+ks*1024+512):"memory");}
    asm volatile("s_waitcnt lgkmcnt(0)":::"memory");SBAR();
    #define PK(k) (bf16x8){lo[k][0],lo[k][1],lo[k][2],lo[k][3],hi[k][0],hi[k][1],hi[k][2],hi[k][3]}
    o[d0]=__builtin_amdgcn_mfma_f32_32x32x16_bf16(pa0,PK(0),o[d0],0,0,0);
    o[d0]=__builtin_amdgcn_mfma_f32_32x32x16_bf16(pa1,PK(1),o[d0],0,0,0);
    o[d0]=__builtin_amdgcn_mfma_f32_32x32x16_bf16(pa2,PK(2),o[d0],0,0,0);
    o[d0]=__builtin_amdgcn_mfma_f32_32x32x16_bf16(pa3,PK(3),o[d0],0,0,0);
    #undef PK
  }
}

#ifndef ATTN_STORE16
#define ATTN_STORE16(p,v) (*(u32x4*)(p)=(v))
#endif
template<int THRL> __device__ __forceinline__ void attn_unit(int b,int h,int qb,const bf16*Q,const bf16*__restrict__ K,const bf16*__restrict__ V,bf16*O,const float*__restrict__ C2K,const float thr2,char*shm,const int tid){
  const int lane=tid&63,r32=lane&31,hi=lane>>5; const int wid=__builtin_amdgcn_readfirstlane(tid>>6);
  const long rowbase=(long)b*SEQ; const int q0=qb*QB;
  const bf16*Qw=Q+(rowbase+q0+wid*QBLK)*DM+h*D;
  const int NT0=(q0+QB)/KVBLK;
  const float*ckg0=C2K+(long)(b*NHEAD+h)*SEQ; float base=ckg0[q0+(tid>>6)*QBLK+r32];
  int ts; { const float cl=lane<NT0?ckg0[KVBLK*lane+KVBLK-1]:ckg0[q0]; const unsigned long long mk=__builtin_amdgcn_ballot_w64(lane<NT0&&(ckg0[q0]-cl>=-thr2));
    ts=mk?(int)__builtin_ctzll(mk):NT0-4; ts&=~1; ts=ts>NT0-4?NT0-4:ts; ts=__builtin_amdgcn_readfirstlane(ts); }
  const int NT=NT0-ts;
  const bf16*Kh=K+(rowbase+(long)ts*KVBLK)*DM+h*D,*Vh=V+(rowbase+(long)ts*KVBLK)*DM+h*D; const float*ckg=ckg0+ts*KVBLK;
  typedef __attribute__((address_space(3))) float lds_f32; typedef float f32x4_t __attribute__((ext_vector_type(4)));
  lds_f32*const nbl=(lds_f32*)((__attribute__((address_space(3))) char*)shm+LDS_CK);
  for(int i=tid;i<NT*KVBLK;i+=NW*64)nbl[i]=-ckg[i];
  const unsigned lds0=(unsigned)(uintptr_t)shm;
  float*wsf=(float*)(shm+LDS_WS)+wid*64;
  const bf16*ksrc=Kh+(long)lane*DM+wid*8;
  const bf16*vsrc=Vh+(long)(16*(wid&3)+(lane>>2))*DM+(wid>>2)*32+(lane&3)*8;
  const unsigned kdst=lds0+LDS_K+wid*1024, vdst=lds0+LDS_V+wid*1024;
  #define DMA_K(t,slot) glds16(ksrc+(long)(t)*KVBLK*DM,(unsigned)__builtin_amdgcn_readfirstlane(kdst+(slot)))
  #define DMA_V(t,slot) glds16(vsrc+(long)(t)*KVBLK*DM,(unsigned)__builtin_amdgcn_readfirstlane(vdst+(slot)))
  const int vb0=(int)(lds0+LDS_V)+((lane>>4)&1)*32+(lane&3)*8+(4*hi+((lane&15)>>2))*64;
  const char*Kbase=shm+LDS_K; bf16x8 kf[8];
  const lds_cptr shm3=(lds_cptr)shm; const lds_cptr kp0=shm3+LDS_K+hi*1024+r32*16; const lds_cptr vp0=shm3+LDS_V+((lane>>4)&1)*32+(lane&3)*8+(4*hi+((lane&15)>>2))*64;
  DMA_K(0,0);DMA_V(0,0);DMA_K(1,SLOTB);
  bf16x8 qr[4];
  #pragma unroll
  for(int d0=0;d0<4;++d0)qr[d0]=*reinterpret_cast<const bf16x8*>(&Qw[(long)r32*DM+d0*16+hi*8]);
  float l_reg=0.f;f32x16 o[2];o[0]=f32x16{};o[1]=f32x16{};const f32x16 negm=f32x16{};
  const int qrel=wid*QBLK+r32;
  #define CMASK(P0,P1,t) do{int jb_=(t)-(NT-4); if(jb_>=0)cmask(P0,P1,jb_,qrel,hi);}while(0)
  #define KBIAS(P0,P1,t) do{ const lds_f32*nb_=nbl+64*(t)+4*hi; _Pragma("unroll") for(int g_=0;g_<4;++g_){ \
    { const f32x4_t b0_=*(const __attribute__((address_space(3))) f32x4_t*)(nb_+8*g_); _Pragma("unroll") for(int j_=0;j_<4;++j_)P0[4*g_+j_]+=(b0_[j_]+base); } SBAR(); \
    { const f32x4_t b1_=*(const __attribute__((address_space(3))) f32x4_t*)(nb_+32+8*g_); _Pragma("unroll") for(int j_=0;j_<4;++j_)P1[4*g_+j_]+=(b1_[j_]+base); } SBAR(); } }while(0)
  bool resc=false;
  #define START(P0,P1) do{ const float rm=rowmax(P0,P1); resc=false; \
    { const float dl=rm; base=fsub_s(base,dl); \
      _Pragma("unroll") for(int r=0;r<16;++r){P0[r]=fsub_s(P0[r],dl);P1[r]=fsub_s(P1[r],dl);} \
      } \
    _Pragma("unroll") for(int r=0;r<16;++r)P0[r]=__builtin_amdgcn_exp2f(P0[r]); }while(0)
  #define RESC() do{ if(resc){ asm volatile("s_waitcnt lgkmcnt(0)":::"memory"); \
      _Pragma("unroll") for(int d_=0;d_<2;++d_) _Pragma("unroll") for(int r=0;r<16;++r)o[d_][r]*=wsf[crow(r,hi)]; } }while(0)
  f32x16 pA0,pA1,pB0,pB1;
  int sl_prev=0,sl_cur=0,sl_next=SLOTB;
  #define ROT() do{sl_prev=sl_cur;sl_cur=sl_next;sl_next=(sl_next==(NSLOT-1)*SLOTB)?0:sl_next+SLOTB;}while(0)
  DMA_K(2,2*SLOTB);
  WAIT_BAR(3);
  qkt(pA0,pA1,Kbase,qr,negm,r32,hi);asm volatile("s_nop 15\n\ts_nop 7":"+v"(pA0),"+v"(pA1));KBIAS(pA0,pA1,0);CMASK(pA0,pA1,0);
  START(pA0,pA1);
  _Pragma("unroll") for(int r=0;r<16;++r)pA1[r]=__builtin_amdgcn_exp2f(pA1[r]);
  WAIT_BAR(0);
  DMA_K(3,0);DMA_V(1,SLOTB);
  ROT();
  kload8(kf,kp0+sl_cur);
  WAIT_BAR(2);
  s16x4 vlo[8],vhi[8]; u32x4 pw0,pw1,pw2,pw3;
  #define PKW(P,B) cvtpk_s(P[B],P[B+1])
  #define PAF(k) __builtin_bit_cast(bf16x8,pw##k)
  #define VFR(i) (bf16x8){vlo[i][0],vlo[i][1],vlo[i][2],vlo[i][3],vhi[i][0],vhi[i][1],vhi[i][2],vhi[i][3]}
  #define PIN(x) asm volatile("":"+v"(x))
  #define MX3(a,b,c) __builtin_fmaxf(__builtin_fmaxf((a),(b)),(c))
  #define GAPA(MF,A0,A1,A2,A3,W0,W1,PW) do{ MF; sacc+=A0; sacc+=A1; sacc+=A2; sacc+=A3; PIN(sacc); W0; W1; PIN(PW); SBAR(); }while(0)
  #define EX(v) __builtin_amdgcn_exp2f(v)
  #define GAPB(MF,X,B) do{ MF; X[B]=EX(X[B]); X[B+1]=EX(X[B+1]); X[B+2]=EX(X[B+2]); X[B+3]=EX(X[B+3]); PIN(X); SBAR(); }while(0)
  #define VRD(i) do{ vlo[i]=vtr(vp_+(((i)>>2)*4096+((i)&3)*1024)); vhi[i]=vtr(vp_+(((i)>>2)*4096+((i)&3)*1024+512)); }while(0)
  #define KRD(G,j) do{ if(G){ kload2(kf,kp0+sl_next,j); SBAR(); } }while(0)
  #define STEP(C0,C1,P0,P1,t,GK,GV,GL) do{ SBAR(); \
    const lds_cptr vp_=vp0+sl_prev; \
    VRD(0); SBAR(); float sacc=(P0[0]+P0[1]); \
    GAPA(C0=__builtin_amdgcn_mfma_f32_32x32x16_bf16(kf[0],qr[0],negm,0,0,0), P0[2],P0[3],P0[4],P0[5],     pw0[0]=PKW(P0,0), pw0[1]=PKW(P0,2), pw0); \
    VRD(4); SBAR(); GAPA(C1=__builtin_amdgcn_mfma_f32_32x32x16_bf16(kf[1],qr[0],negm,0,0,0), P0[6],P0[7],P0[8],P0[9],     pw0[2]=PKW(P0,4), pw0[3]=PKW(P0,6), pw0); \
    VRD(1); SBAR(); GAPA(C0=__builtin_amdgcn_mfma_f32_32x32x16_bf16(kf[2],qr[1],C0,0,0,0),   P0[10],P0[11],P0[12],P0[13], pw1[0]=PKW(P0,8), pw1[1]=PKW(P0,10), pw1); \
    VRD(5); SBAR(); GAPA(C1=__builtin_amdgcn_mfma_f32_32x32x16_bf16(kf[3],qr[1],C1,0,0,0),   P0[14],P0[15],P1[0],P1[1],   pw1[2]=PKW(P0,12),pw1[3]=PKW(P0,14), pw1); \
    VRD(2); SBAR(); GAPA(C0=__builtin_amdgcn_mfma_f32_32x32x16_bf16(kf[4],qr[2],C0,0,0,0),   P1[2],P1[3],P1[4],P1[5],     pw2[0]=PKW(P1,0), pw2[1]=PKW(P1,2), pw2); \
    VRD(6); SBAR(); GAPA(C1=__builtin_amdgcn_mfma_f32_32x32x16_bf16(kf[5],qr[2],C1,0,0,0),   P1[6],P1[7],P1[8],P1[9],     pw2[2]=PKW(P1,4), pw2[3]=PKW(P1,6), pw2); \
    VRD(3); SBAR(); GAPA(C0=__builtin_amdgcn_mfma_f32_32x32x16_bf16(kf[6],qr[3],C0,0,0,0),   P1[10],P1[11],P1[12],P1[13], pw3[0]=PKW(P1,8), pw3[1]=PKW(P1,10), pw3); \
    VRD(7); SBAR(); GAPA(C1=__builtin_amdgcn_mfma_f32_32x32x16_bf16(kf[7],qr[3],C1,0,0,0),   P1[14],P1[15],0.f,0.f,       pw3[2]=PKW(P1,12),pw3[3]=PKW(P1,14), pw3); \
    l_reg+=sacc; \
    if(GK){DMA_K((t)+3,sl_cur);} if(GV){DMA_V((t)+1,sl_next);} \
    KBIAS(C0,C1,t); \
    CMASK(C0,C1,t); \
    { float a=MX3(C0[0],C0[1],C1[0]),b=MX3(C0[2],C0[3],C1[1]); a=MX3(a,C1[2],C1[3]); \
      _Pragma("unroll") for(int r=4;r<16;r+=4){a=MX3(a,C0[r],C0[r+1]);b=MX3(b,C0[r+2],C0[r+3]);a=MX3(a,C1[r],C1[r+1]);b=MX3(b,C1[r+2],C1[r+3]);} \
      float rm=__builtin_fmaxf(a,b); { auto rr=__builtin_amdgcn_permlane32_swap(__float_as_uint(rm),__float_as_uint(rm),false,false); rm=__builtin_fmaxf(__uint_as_float(rr[0]),__uint_as_float(rr[1])); } \
      resc=false; \
      if(__builtin_expect(__any(rm>(float)THRL),0)){ const float dl=__builtin_fmaxf(rm,0.f); base-=dl; \
        _Pragma("unroll") for(int r=0;r<16;++r){C0[r]-=dl;C1[r]-=dl;} \
        const float f=__builtin_amdgcn_exp2f(-dl); l_reg*=f; if(hi==0)wsf[r32]=f; resc=true; } } \
    SBAR(); \
    GAPB(o[0]=__builtin_amdgcn_mfma_f32_32x32x16_bf16(PAF(0),VFR(0),o[0],0,0,0), C0,0); \
    GAPB(o[1]=__builtin_amdgcn_mfma_f32_32x32x16_bf16(PAF(0),VFR(4),o[1],0,0,0), C0,4); \
    KRD(GL,0); GAPB(o[0]=__builtin_amdgcn_mfma_f32_32x32x16_bf16(PAF(1),VFR(1),o[0],0,0,0), C0,8); \
    KRD(GL,1); GAPB(o[1]=__builtin_amdgcn_mfma_f32_32x32x16_bf16(PAF(1),VFR(5),o[1],0,0,0), C0,12); \
    KRD(GL,2); GAPB(o[0]=__builtin_amdgcn_mfma_f32_32x32x16_bf16(PAF(2),VFR(2),o[0],0,0,0), C1,0); \
    KRD(GL,3); GAPB(o[1]=__builtin_amdgcn_mfma_f32_32x32x16_bf16(PAF(2),VFR(6),o[1],0,0,0), C1,4); \
    GAPB(o[0]=__builtin_amdgcn_mfma_f32_32x32x16_bf16(PAF(3),VFR(3),o[0],0,0,0), C1,8); \
    GAPB(o[1]=__builtin_amdgcn_mfma_f32_32x32x16_bf16(PAF(3),VFR(7),o[1],0,0,0), C1,12); \
    }while(0)
  int t=1;
  #undef CMASK
  #define CMASK(P0,P1,t) do{}while(0)
  for(;t+5<NT;t+=2){
    STEP(pB0,pB1,pA0,pA1,t,true,true,true);     WAIT_BAR(2); RESC(); ROT();
    STEP(pA0,pA1,pB0,pB1,t+1,true,true,true);   WAIT_BAR(2); RESC(); ROT();
  }
  #undef CMASK
  #define CMASK(P0,P1,t) do{int jb_=(t)-(NT-4); if(jb_>=0)cmask(P0,P1,jb_,qrel,hi);}while(0)
  #define ENDW(tt) do{ if((tt)+3<NT){WAIT_BAR(2);} else if((tt)+2<NT){WAIT_BAR(1);} else {WAIT_BAR(0);} }while(0)
  for(;t+1<NT;t+=2){
    STEP(pB0,pB1,pA0,pA1,t,(t+3<NT),(t+1<NT),(t+1<NT));       ENDW(t);   RESC(); ROT();
    STEP(pA0,pA1,pB0,pB1,t+1,(t+4<NT),(t+2<NT),(t+2<NT));     ENDW(t+1); RESC(); ROT();
  }
  STEP(pB0,pB1,pA0,pA1,NT-1,false,false,false); RESC();
  { float sacc=pB0[0]+pB0[1]; _Pragma("unroll") for(int r=2;r<16;++r)sacc+=pB0[r]; _Pragma("unroll") for(int r=0;r<16;++r)sacc+=pB1[r]; l_reg+=sacc;
    pw0=(u32x4){PKW(pB0,0),PKW(pB0,2),PKW(pB0,4),PKW(pB0,6)};pw1=(u32x4){PKW(pB0,8),PKW(pB0,10),PKW(pB0,12),PKW(pB0,14)};pw2=(u32x4){PKW(pB1,0),PKW(pB1,2),PKW(pB1,4),PKW(pB1,6)};pw3=(u32x4){PKW(pB1,8),PKW(pB1,10),PKW(pB1,12),PKW(pB1,14)};
    SBAR(); pv(o,vb0+sl_cur,PAF(0),PAF(1),PAF(2),PAF(3)); }
  #undef PKW
  #undef PAF
  #undef VFR
  #undef PIN
  #undef MX3
  #undef GAPA
  #undef GAPB
  #undef EX
  #undef VRD
  #undef KRD
  #undef STEP
  #undef ENDW
  {auto rr=__builtin_amdgcn_permlane32_swap(__float_as_uint(l_reg),__float_as_uint(l_reg),false,false);l_reg=__uint_as_float(rr[0])+__uint_as_float(rr[1]);}
  if(hi==0)wsf[32+r32]=l_reg;asm volatile("s_waitcnt lgkmcnt(0)":::"memory");
  float rli[16];
  #pragma unroll
  for(int r=0;r<16;++r)rli[r]=__builtin_amdgcn_rcpf(wsf[32+crow(r,hi)]);
  bf16*Ow=O+(rowbase+q0+wid*QBLK)*DM+h*D;
  { bf16*stg=(bf16*)(shm+LDS_OST)+wid*2048;
    #pragma unroll
    for(int r=0;r<16;++r){const int orow=crow(r,hi);
      #pragma unroll
      for(int d0=0;d0<2;++d0)stg[orow*64+d0*32+r32]=__float2bfloat16(o[d0][r]*rli[r]);}
    asm volatile("s_waitcnt lgkmcnt(0)":::"memory");
    #pragma unroll
    for(int i=0;i<4;++i){const int row=i*8+(lane>>3),ch=lane&7; const u32x4 v=*(const u32x4*)(stg+row*64+ch*8); ATTN_STORE16(Ow+(long)row*DM+ch*8,v);} }
  asm volatile("s_waitcnt lgkmcnt(0)\n\ts_barrier":::"memory");
  #undef DMA_K
  #undef DMA_V
  #undef CMASK
  #undef KBIAS
  #undef START
  #undef RESC
  #undef ROT
}
constexpr int ATTN_LDS_BYTES=LDS_BYTES;
struct AttnTensors { const bf16* Q; const bf16* K; const bf16* V; bf16* O; const float* C2K; float thr2; };
struct AttnUnit { int bh; int qb; };
struct StaticOrder {
  int vcu;
  __device__ __forceinline__ explicit StaticOrder(int grid,int block):vcu((block%8)*(grid/8)+block/8){}
  __device__ __forceinline__ bool next(int i,AttnUnit&u)const{ if(i>=2||vcu>=256)return false; const int s=vcu&7; u.bh=vcu>>3; u.qb=(i==0)?s:15-s; return true; }
  __device__ __forceinline__ void a_ready(const AttnUnit&)const{}
  __device__ __forceinline__ void done(const AttnUnit&)const{}
};
template<class Sched,int THRL=8> __device__ __forceinline__ void attn_phase(char*lds,const AttnTensors&T,const Sched&S,const int tid){
  AttnUnit u;
  for(int i=0;S.next(i,u);++i){ S.a_ready(u); attn_unit<THRL>(u.bh/NHEAD,u.bh%NHEAD,u.qb,T.Q,T.K,T.V,T.O,T.C2K,T.thr2,lds,tid); S.done(u); }
}
#undef SBAR
#undef WAIT_BAR
}
__device__ __forceinline__ void phase_attn_fast(Ctx& C, KA AR, int l, char* ldsg) {
    const attn_body::bf16* Q = (const attn_body::bf16*)(C.ws + WS_R1) + (size_t)2 * T * 512;
    const float bq = 64.f * C2 * wave_max(fabsf(AR->in[I_QN][l * HD + C.lane])) * wave_max(fabsf(AR->in[I_KN][l * HD + C.lane]));
    const attn_body::AttnTensors AT{Q, Q + (size_t)T * 512, Q + (size_t)2 * T * 512, (attn_body::bf16*)(C.ws + WS_R2), (const float*)(C.ws + WS_C2K), 2.f * bq + 40.f};
    unsigned* qctr = (unsigned*)(C.ws + WS_CTL) + CW_ATT + 64 * l;
    volatile LAS unsigned* slot = (volatile LAS unsigned*)(C.lds + MISC_OFF) + 16;
    for (;;) {
        __syncthreads();
        if (C.tid == 0) slot[0] = atomicAdd(qctr, 1u);
        __syncthreads();
        const int idx = __builtin_amdgcn_readfirstlane((int)slot[0]);
        if (idx >= NB * NH * 16) break;
        const int qb = 15 - (idx >> 5), bh = idx & 31;
        attn_body::attn_unit<8>(bh >> 3, bh & 7, qb, AT.Q, AT.K, AT.V, AT.O, AT.C2K, AT.thr2, ldsg, C.tid);
    }
}

constexpr int RCH = 32, NCH = S / RCH;
__device__ __forceinline__ float one_minus_sq_exp(float la, float a) {
    const float x = 2.f * la;
    float p = 1.f / 5040.f; p = p * x + 1.f / 720.f; p = p * x + 1.f / 120.f; p = p * x + 1.f / 24.f; p = p * x + 1.f / 6.f; p = p * x + 0.5f; p = p * x + 1.f; p = -(p * x);
    return x > -0.25f ? p : 1.f - a * a;
}
template <int MODE>
__device__ __forceinline__ void phase_rnn_fast(Ctx& C, KA AR, int l) {
    typedef short bf16x8 __attribute__((ext_vector_type(8)));
    const int blk = C.wave, lane = C.lane, fr = lane & 15, fq = lane >> 4;
    LAS float* Ab = (LAS float*)C.lds + C.wave * 4096; LAS float* Ub = Ab + 2048;
    LAS float* SS = (LAS float*)(C.lds + TAB_OFF); LAS float* RSW = SS + 256 + C.wave * 32;
    const bf16* ZX = (const bf16*)(C.ws + WS_R1); const bf16* ZG = ZX + (size_t)T * 512;
    float* SA = (float*)(C.ws + WS_SA); float* SH = (float*)(C.ws + WS_SH);
    const bf16* O = (const bf16*)(C.ws + WS_R2); bf16* YM = (bf16*)(C.ws + WS_R2 + 16 * MiB);
    const float* cw = AR->in[I_CONVW] + l * 4 * DR; const float* cb = AR->in[I_CONVB] + l * DR;
    const float* wr = AR->in[I_WR] + (size_t)(l * 8 + blk) * 64 * 64; const float* wi = AR->in[I_WI] + (size_t)(l * 8 + blk) * 64 * 64;
    bf16x8 Br[4][2], Bi[4][2]; float brj[4], bij[4], spj[4];
    { float lm[4];
#pragma unroll
      for (int n = 0; n < 4; ++n) { const int ch = blk * 64 + n * 16 + fr; brj[n] = AR->in[I_BR][l * DR + ch]; bij[n] = AR->in[I_BI][l * DR + ch]; lm[n] = AR->in[I_LAM][l * DR + ch]; }
#pragma unroll
      for (int n = 0; n < 4; ++n) { const float e = __expf(-lm[n]); spj[n] = e < 1e-3f ? e * (1.f - 0.5f * e + 0.33333334f * e * e) : __logf(1.f + e); } }
#pragma unroll
    for (int g = 0; g < 2; ++g) { const float* wsrc = g == 0 ? wr : wi; f32x4 t[16];
#pragma unroll
        for (int i = 0; i < 16; ++i) t[i] = *(const f32x4*)(wsrc + 4 * (lane + 64 * i));
#pragma unroll
        for (int i = 0; i < 16; ++i) *(LAS f32x4*)(Ab + 4 * (lane + 64 * i)) = t[i];
        asm volatile("s_waitcnt lgkmcnt(0)" ::: "memory");
#pragma unroll
        for (int n = 0; n < 4; ++n)
#pragma unroll
            for (int ks = 0; ks < 2; ++ks)
#pragma unroll
                for (int e = 0; e < 8; ++e) { const short v = (short)f2bf(Ab[(ks * 32 + fq * 8 + e) * 64 + n * 16 + fr]); if (g == 0) Br[n][ks][e] = v; else Bi[n][ks][e] = v; }
        asm volatile("s_waitcnt lgkmcnt(0)" ::: "memory"); }
    for (int u = blockIdx.x; u < NB * NCH; u += gridDim.x) {
        const int b = u / NCH; int c = u % NCH; if (MODE == 1 && ((u / (int)gridDim.x) & 1)) c = NCH - 1 - c;
        const int t0 = c * RCH;
        if (MODE == 1) __syncthreads();
        bf16x8 Af[2][2];
#pragma unroll
        for (int ks = 0; ks < 2; ++ks) {
            const int ch0 = blk * 64 + ks * 32 + fq * 8;
            f32x4 w[4][2], bb[2];
#pragma unroll
            for (int j = 0; j < 4; ++j) { w[j][0] = *(const f32x4*)(cw + j * DR + ch0); w[j][1] = *(const f32x4*)(cw + j * DR + ch0 + 4); }
            bb[0] = *(const f32x4*)(cb + ch0); bb[1] = *(const f32x4*)(cb + ch0 + 4);
#pragma unroll
            for (int m = 0; m < 2; ++m) {
                const int tok = m * 16 + fr, tg = t0 + tok;
                f32x4 x0 = bb[0], x1 = bb[1]; v4u zz[4];
#pragma unroll
                for (int j = 0; j < 4; ++j) { const int tt = tg - 3 + j; zz[j] = *(const v4u*)(ZX + (size_t)(b * S + (tt < 0 ? 0 : tt)) * 512 + ch0); }
#pragma unroll
                for (int j = 0; j < 4; ++j) { const float ok = (tg - 3 + j) >= 0 ? 1.f : 0.f; const v4u z = zz[j]; const f32x4 wa = w[j][0] * ok, wb = w[j][1] * ok;
                        x0[0] += wa[0] * bflo(z.x); x0[1] += wa[1] * bfhi(z.x); x0[2] += wa[2] * bflo(z.y); x0[3] += wa[3] * bfhi(z.y);
                        x1[0] += wb[0] * bflo(z.z); x1[1] += wb[1] * bfhi(z.z); x1[2] += wb[2] * bflo(z.w); x1[3] += wb[3] * bfhi(z.w); }
                *(LAS f32x4*)(Ub + tok * 64 + ks * 32 + fq * 8) = x0; *(LAS f32x4*)(Ub + tok * 64 + ks * 32 + fq * 8 + 4) = x1;
                v4u pk; pk.x = pk2(x0[0], x0[1]); pk.y = pk2(x0[2], x0[3]); pk.z = pk2(x1[0], x1[1]); pk.w = pk2(x1[2], x1[3]);
                Af[m][ks] = __builtin_bit_cast(bf16x8, pk);
            }
        }
        f32x4 aR[2][4], aI[2][4];
#pragma unroll
        for (int m = 0; m < 2; ++m)
#pragma unroll
            for (int n = 0; n < 4; ++n) { aR[m][n] = (f32x4){0.f, 0.f, 0.f, 0.f}; aI[m][n] = (f32x4){0.f, 0.f, 0.f, 0.f};
#pragma unroll
                for (int ks = 0; ks < 2; ++ks) { aR[m][n] = __builtin_amdgcn_mfma_f32_16x16x32_bf16(Af[m][ks], Br[n][ks], aR[m][n], 0, 0, 0); aI[m][n] = __builtin_amdgcn_mfma_f32_16x16x32_bf16(Af[m][ks], Bi[n][ks], aI[m][n], 0, 0, 0); } }
        asm volatile("s_waitcnt lgkmcnt(0)" ::: "memory");
#pragma unroll
        for (int m = 0; m < 2; ++m)
#pragma unroll
            for (int n = 0; n < 4; ++n)
#pragma unroll
                for (int i = 0; i < 4; ++i) { const int idx = (m * 16 + 4 * fq + i) * 64 + n * 16 + fr;
                    const float xcv = Ub[idx], r = sigmoid_fast(aR[m][n][i] + brj[n]), ig = sigmoid_fast(aI[m][n][i] + bij[n]);
                    const float la = -8.f * r * spj[n], a = __expf(la);
                    Ab[idx] = a; Ub[idx] = sqrtf(one_minus_sq_exp(la, a)) * (ig * xcv); }
        asm volatile("s_waitcnt lgkmcnt(0)" ::: "memory");
        const int ch = blk * 64 + lane;
        if (MODE == 0) { float At = 1.f, h = 0.f;
#pragma unroll 8
            for (int t = 0; t < RCH; ++t) { const float a = Ab[t * 64 + lane]; h = a * h + Ub[t * 64 + lane]; At *= a; }
            SA[(size_t)(b * NCH + c) * 512 + ch] = At; SH[(size_t)(b * NCH + c) * 512 + ch] = h;
        } else {
            float h = 0.f;
            { const float* sa = SA + (size_t)b * NCH * 512 + ch; const float* sh = SH + (size_t)b * NCH * 512 + ch; int c2 = 0;
              for (; c2 + 32 <= c; c2 += 32) { float a8[32], h8[32];
#pragma unroll
                  for (int q = 0; q < 32; ++q) { a8[q] = sa[(size_t)(c2 + q) * 512]; h8[q] = sh[(size_t)(c2 + q) * 512]; }
#pragma unroll
                  for (int q = 0; q < 32; ++q) h = a8[q] * h + h8[q]; }
              for (; c2 + 8 <= c; c2 += 8) { float a8[8], h8[8];
#pragma unroll
                  for (int q = 0; q < 8; ++q) { a8[q] = sa[(size_t)(c2 + q) * 512]; h8[q] = sh[(size_t)(c2 + q) * 512]; }
#pragma unroll
                  for (int q = 0; q < 8; ++q) h = a8[q] * h + h8[q]; }
              for (; c2 < c; ++c2) h = sa[(size_t)c2 * 512] * h + sh[(size_t)c2 * 512]; }
            const bf16* zg = ZG + (size_t)(b * S + t0) * 512 + ch;
#pragma unroll 8
            for (int t = 0; t < RCH; ++t) { h = Ab[t * 64 + lane] * h + Ub[t * 64 + lane]; Ab[t * 64 + lane] = h * bf2f(zg[(size_t)t * 512]); }
            asm volatile("s_waitcnt lgkmcnt(0)" ::: "memory");
            { const int t = lane & 31, hf = lane >> 5; float s = 0.f;
#pragma unroll 8
              for (int k = 0; k < 32; ++k) { const float y = Ab[t * 64 + hf * 32 + ((k + t) & 31)]; s += y * y; }
              s = half_sum32(s); if (lane < 32) SS[C.wave * 32 + lane] = s; }
            __syncthreads();
            { const int t = lane & 31; float tot = 0.f;
#pragma unroll
              for (int w8 = 0; w8 < 8; ++w8) tot += SS[w8 * 32 + t];
              RSW[t] = rsqrtf(tot * (1.f / 512.f) + EPS); }
            asm volatile("s_waitcnt lgkmcnt(0)" ::: "memory");
            { const int oct = lane & 7; const float* g1 = AR->in[I_LRUN] + l * DR + blk * 64 + oct * 8; const f32x4 ga = *(const f32x4*)g1, gb = *(const f32x4*)(g1 + 4);
#pragma unroll
              for (int q = 0; q < 4; ++q) { const int t = q * 8 + (lane >> 3); const float rs = RSW[t];
                  const f32x4 y0 = *(const LAS f32x4*)(Ab + t * 64 + oct * 8) * rs * ga, y1 = *(const LAS f32x4*)(Ab + t * 64 + oct * 8 + 4) * rs * gb;
                  v4u pk; pk.x = pk2(y0[0], y0[1]); pk.y = pk2(y0[2], y0[3]); pk.z = pk2(y1[0], y1[1]); pk.w = pk2(y1[2], y1[3]);
                  *(v4u*)(YM + (size_t)(b * S + t0 + t) * D + blk * 64 + oct * 8) = pk; } }
            { const float* g2 = AR->in[I_ATTN] + l * DA + 8 * lane; const f32x4 ga = *(const f32x4*)g2, gb = *(const f32x4*)(g2 + 4);
              const size_t row0 = (size_t)(b * S + t0 + C.wave * 4); v4u w4[4];
#pragma unroll
              for (int q = 0; q < 4; ++q) w4[q] = *(const v4u*)(O + (row0 + q) * 512 + 8 * lane);
#pragma unroll
              for (int q = 0; q < 4; ++q) { const v4u w = w4[q];
                  f32x4 x0 = {bflo(w.x), bfhi(w.x), bflo(w.y), bfhi(w.y)}, x1 = {bflo(w.z), bfhi(w.z), bflo(w.w), bfhi(w.w)};
                  float s = (x0[0] * x0[0] + x0[1] * x0[1]) + (x0[2] * x0[2] + x0[3] * x0[3]) + (x1[0] * x1[0] + x1[1] * x1[1]) + (x1[2] * x1[2] + x1[3] * x1[3]);
                  const float rs = rsqrtf(wave_sum(s) * (1.f / 512.f) + EPS);
                  x0 = x0 * rs * ga; x1 = x1 * rs * gb;
                  v4u pk; pk.x = pk2(x0[0], x0[1]); pk.y = pk2(x0[2], x0[3]); pk.z = pk2(x1[0], x1[1]); pk.w = pk2(x1[2], x1[3]);
                  *(v4u*)(YM + (row0 + q) * D + 512 + 8 * lane) = pk; } }
        }
    }
}

template <int NT, class WF>
__device__ __forceinline__ void norm_proj_tile(const float* X, const float* gain, bf16* xn, int t0, WF wf, LAS float* Lw, int lane, int kh) {
    const int fr = lane & 15, fq = lane >> 4;
    f32x4 acc[NT];
#pragma unroll
    for (int n = 0; n < NT; ++n) acc[n] = (f32x4){0.f, 0.f, 0.f, 0.f};
    float ssq = 0.f;
    const float* xr = X + (size_t)(t0 + fr) * D + 4 * fq; const float* gr = gain + 4 * fq;
    for (int sb = 2 * kh; sb < 2 * kh + 2; ++sb) {
        f32x4 xv[16];
#pragma unroll
        for (int i = 0; i < 16; ++i) xv[i] = *(const f32x4*)(xr + 16 * (16 * sb + i));
#pragma unroll
        for (int i = 0; i < 16; ++i) { const int s = 16 * sb + i; const f32x4 gv = *(const f32x4*)(gr + 16 * s);
            ssq += (xv[i][0] * xv[i][0] + xv[i][1] * xv[i][1]) + (xv[i][2] * xv[i][2] + xv[i][3] * xv[i][3]);
            const f32x4 xg = xv[i] * gv;
#pragma unroll
            for (int e = 0; e < 4; ++e)
#pragma unroll
                for (int n = 0; n < NT; ++n) acc[n] = __builtin_amdgcn_mfma_f32_16x16x4f32(wf(n, 16 * s + 4 * fq + e, fr), xg[e], acc[n], 0, 0, 0); }
    }
    constexpr int PW = 4 * NT + 1;
    if (kh == 1) {
#pragma unroll
        for (int n = 0; n < NT; ++n)
#pragma unroll
            for (int r = 0; r < 4; ++r) Lw[lane * PW + 4 * n + r] = acc[n][r];
        Lw[lane * PW + 4 * NT] = ssq;
    }
    __syncthreads();
    if (kh == 0) {
#pragma unroll
        for (int n = 0; n < NT; ++n)
#pragma unroll
            for (int r = 0; r < 4; ++r) acc[n][r] += Lw[lane * PW + 4 * n + r];
        ssq += Lw[lane * PW + 4 * NT];
        ssq += lane_xor<16>(ssq); ssq = half_sum32(ssq);
        const float rs = rsqrtf(ssq * (1.f / D) + EPS);
        asm volatile("s_waitcnt lgkmcnt(0)" ::: "memory");
#pragma unroll
        for (int n = 0; n < NT; ++n)
#pragma unroll
            for (int r = 0; r < 4; ++r) Lw[fr * (16 * NT) + 16 * n + 4 * fq + r] = acc[n][r] * rs;
        if (lane < 16) Lw[16 * 16 * NT + lane] = rs;
    }
    __syncthreads();
#pragma unroll
    for (int q4 = 0; q4 < 8; q4 += 4) { f32x4 v[4][4];
#pragma unroll
        for (int q = 0; q < 4; ++q) load_row(X + (size_t)(t0 + 8 * kh + q4 + q) * D, lane, v[q]);
#pragma unroll
        for (int q = 0; q < 4; ++q) { const int tok = 8 * kh + q4 + q; const float rst = Lw[16 * 16 * NT + tok]; scale_row(v[q], rst, gain, lane); store_row_bf16(xn + (size_t)(t0 + tok) * D, lane, v[q]); } }
}
__device__ __forceinline__ void phase_norm1_fast(Ctx& C, KA AR, int l) {
    const float* xs = l == 0 ? AR->in[I_X] : (const float*)(C.ws + WS_X);
    const float* gain = AR->in[I_MIXN] + l * D; const float* wf = AR->in[I_WIN] + (size_t)l * D * DIN + NZ; const float* bfg = AR->in[I_BF] + l * NH;
    bf16* xn = (bf16*)(C.ws + WS_XN); float* logf = (float*)(C.ws + WS_LOGF);
    LAS float* Wl = (LAS float*)C.lds; LAS float* Lw = (LAS float*)(C.lds + 32768 + 1024) + (C.wave & 3) * 1024; const int kh = C.wave >> 2;
    { f32x4 t[4];
#pragma unroll
      for (int j = 0; j < 4; ++j) { const int i = C.tid + 512 * j; t[j] = *(const f32x4*)(wf + (size_t)(i >> 1) * DIN + 4 * (i & 1)); }
#pragma unroll
      for (int j = 0; j < 4; ++j) *(LAS f32x4*)(Wl + 4 * (C.tid + 512 * j)) = t[j]; }
    if (C.tid < 8) Wl[D * 8 + C.tid] = 0.f;
    __syncthreads();
        for (int tile = blockIdx.x * 4 + (C.wave & 3); tile < T / 16; tile += gridDim.x * 4) {
            const int t0 = 16 * tile;
            __syncthreads();
            norm_proj_tile<1>(xs, gain, xn, t0, [=](int, int k, int i) { return Wl[k * 8 + i]; }, Lw, C.lane, kh);
            if (kh == 0) {
            const int tok = C.lane & 15, h0 = (C.lane >> 4) * 2;
            { const int r = t0 + tok, bb = r / S, tt = r % S;
              logf[(size_t)(bb * NH + h0) * S + tt] = log_sigmoid(Lw[tok * 16 + h0] + bfg[h0]); logf[(size_t)(bb * NH + h0 + 1) * S + tt] = log_sigmoid(Lw[tok * 16 + h0 + 1] + bfg[h0 + 1]); }
            }
            asm volatile("s_waitcnt lgkmcnt(0)" ::: "memory");
        }
}
__device__ __forceinline__ void phase_router_fast(Ctx& C, KA AR, int l) {
    const float* X = (const float*)(C.ws + WS_X); bf16* xn = (bf16*)(C.ws + WS_XN);
    const float* gain = AR->in[I_FFNN] + l * D; const float* wg = AR->in[I_WG] + (size_t)l * D * 4; const float* bg = AR->in[I_BG] + l * 4;
    const float* wr = AR->in[I_WRT] + (size_t)l * D * NE; const float* brt = AR->in[I_BRT] + l * NE;
    unsigned* cnt = (unsigned*)(C.ws + WS_CTL) + CW_CNT + 32 * CNT_STRIDE * l; int* rowpair = (int*)(C.ws + WS_ROWPAIR); float* pairw = (float*)(C.ws + WS_PAIRW);
    LAS float* Wl = (LAS float*)C.lds; LAS float* Lw = (LAS float*)(C.lds + WPROJ_BYTES + 64) + (C.wave & 3) * 832; const int kh = C.wave >> 2;
    { f32x4 t[16], u[2];
#pragma unroll
      for (int j = 0; j < 16; ++j) t[j] = *(const f32x4*)(wr + 4 * (C.tid + 512 * j));
#pragma unroll
      for (int j = 0; j < 2; ++j) u[j] = *(const f32x4*)(wg + 4 * (C.tid + 512 * j));
#pragma unroll
      for (int j = 0; j < 16; ++j) { const int i = C.tid + 512 * j; *(LAS f32x4*)(Wl + (i >> 3) * 36 + 4 * (i & 7)) = t[j]; }
#pragma unroll
      for (int j = 0; j < 2; ++j) *(LAS f32x4*)(Wl + (C.tid + 512 * j) * 36 + 32) = u[j]; }
    if (C.tid < 16) Wl[D * 36 + C.tid] = 0.f;
    volatile LAS unsigned* lcnt = (volatile LAS unsigned*)(C.lds + MISC_OFF - 512);
    if (C.tid < 64) lcnt[C.tid] = 0u;
    __syncthreads();
        for (int tile = blockIdx.x * 4 + (C.wave & 3); tile < T / 16; tile += gridDim.x * 4) {
            const int t0 = 16 * tile;
            __syncthreads();
            norm_proj_tile<3>(X, gain, xn, t0, [=](int n, int k, int i) { return Wl[k * 36 + 16 * n + i]; }, Lw, C.lane, kh);
            int e0 = 0, e1 = 0; unsigned lp0 = 0, lp1 = 0; float w0r = 0.f, w1r = 0.f;
            if (kh == 0 && C.lane < 16) {
                const LAS float* L = Lw + C.lane * 48;
                float gl[4];
#pragma unroll
                for (int i = 0; i < 4; ++i) gl[i] = L[32 + i] + bg[i];
                int gi = 0; float gm = gl[0];
#pragma unroll
                for (int i = 1; i < 4; ++i) if (gl[i] > gm) { gm = gl[i]; gi = i; }
                float gs = 0.f;
#pragma unroll
                for (int i = 0; i < 4; ++i) gs += __expf(gl[i] - gm);
                const float gp = 1.f / gs;
                float ev[8];
#pragma unroll
                for (int i = 0; i < 8; ++i) ev[i] = L[gi * 8 + i] + brt[gi * 8 + i];
                int i0 = 0; float t0v = ev[0];
#pragma unroll
                for (int i = 1; i < 8; ++i) if (ev[i] > t0v) { t0v = ev[i]; i0 = i; }
                int i1 = -1; float t1v = -INFINITY;
#pragma unroll
                for (int i = 0; i < 8; ++i) if (i != i0 && ev[i] > t1v) { t1v = ev[i]; i1 = i; }
                const float ex = __expf(t1v - t0v), w0 = gp / (1.f + ex), w1 = gp * ex / (1.f + ex);
                e0 = gi * 8 + i0; e1 = gi * 8 + i1; w0r = w0; w1r = w1;
                lp0 = __hip_atomic_fetch_add((LAS unsigned*)lcnt + e0, 1u, __ATOMIC_RELAXED, __HIP_MEMORY_SCOPE_WORKGROUP); lp1 = __hip_atomic_fetch_add((LAS unsigned*)lcnt + e1, 1u, __ATOMIC_RELAXED, __HIP_MEMORY_SCOPE_WORKGROUP);
            }
            __syncthreads();
            if (C.wave == 0 && C.lane < NE) { const unsigned n = lcnt[C.lane]; lcnt[32 + C.lane] = n ? atomicAdd(cnt + C.lane * CNT_STRIDE, n) : 0u; }
            __syncthreads();
            if (kh == 0 && C.lane < 16) { const int t = t0 + C.lane; const unsigned p0 = lcnt[32 + e0] + lp0, p1 = lcnt[32 + e1] + lp1;
                rowpair[(size_t)e0 * CAP + p0] = 2 * t; rowpair[(size_t)e1 * CAP + p1] = 2 * t + 1; pairw[2 * t] = w0r; pairw[2 * t + 1] = w1r; }
            __syncthreads();
            if (C.tid < 64) lcnt[C.tid] = 0u;
            asm volatile("s_waitcnt lgkmcnt(0)" ::: "memory");
        }
}

constexpr int NPH = 14;
constexpr int NPHASES = 1 + DEPTH * NPH;
__global__ void __launch_bounds__(512, 2) fwd_kernel(Args args) {
    extern __shared__ __attribute__((aligned(16))) unsigned char lds[];
    Ctx C;
    C.lds = (LAS unsigned char*)lds;
    C.wave0 = __builtin_amdgcn_readfirstlane((int)threadIdx.x >> 6); asm volatile("" : "+s"(C.wave0));
    C.tid = threadIdx.x; C.lane = C.tid & 63; C.wave = C.wave0;
    C.gw = blockIdx.x * 8 + C.wave; C.ngw = gridDim.x * 8;
    C.ws = args.ws;
    volatile LAS unsigned* MISC = (volatile LAS unsigned*)(C.lds + MISC_OFF);
    if (C.tid < 32) MISC[C.tid] = 0u;
    __syncthreads();
    XcdBarrier bar; bar.bar = (unsigned*)(C.ws + WS_CTL) + CW_BAR; bar.x = 0; bar.st = nullptr;
    if (args.ph_hi - args.ph_lo > 1) bar = xcd_barrier_post((unsigned*)(C.ws + WS_CTL) + CW_BAR, MISC + 8);
#ifndef ONLY
#define ONLY -1
#endif
#define PHON(k) (ONLY < 0 || ONLY == (k))
#if MK_MULTI
#define IN(k) (fresh_args()->ph_lo <= (k) && (k) < fresh_args()->ph_hi)
#else
#define IN(k) true
#endif
    if (PROBE_TIMING && blockIdx.x == 0 && threadIdx.x == 0) ((unsigned long long*)((unsigned*)(args.ws + WS_CTL) + CW_TS))[0] = __builtin_amdgcn_s_memrealtime();
#define SEAM(k) do { if (IN(k) && IN((k) + 1)) { XcdBarrier b_; b_.bar = (unsigned*)(fresh_args()->ws + WS_CTL) + CW_BAR; b_.x = xb_xcc_id(); b_.st = (volatile LAS unsigned*)(C.lds + MISC_OFF) + 8;     \
        xcd_barrier(b_, C.tid == 0); if (PROBE_TIMING && blockIdx.x == 0 && C.tid == 0) { ((unsigned long long*)((unsigned*)(fresh_args()->ws + WS_CTL) + CW_TS))[(k) + 1] = __builtin_amdgcn_s_memrealtime(); } } } while (0)
    for (int rp_ = 0; rp_ < REPS(99); ++rp_) { if (PHON(99) && IN(0)) { KA A_ = fresh_args(); enter_phase(C, A_); phase_prologue(C, A_); } SEAM(0); }
    for (int l = 0; l < DEPTH; ++l) {
        const int pb = 1 + l * NPH;
        for (int rp_ = 0; rp_ < REPSL(0); ++rp_) { if (PHON(0) && IN(pb + 0)) { KA A_ = fresh_args(); enter_phase(C, A_); if (FAST_NORM) phase_norm1_fast(C, A_, l); else phase_norm1(C, A_, l); } SEAM(pb + 0); }
        for (int rp_ = 0; rp_ < REPSL(1); ++rp_) { if (PHON(1) && IN(pb + 1)) { KA A_ = fresh_args(); enter_phase(C, A_); if (FAST_GEMM1) { phase_gemm1_fast(C, A_, l); phase_proj_fast(C, A_, l); } else phase_gemm1_naive(C, A_, l); } SEAM(pb + 1); }
        for (int rp_ = 0; rp_ < REPSL(2); ++rp_) { if (!FAST_GEMM1 && PHON(2) && IN(pb + 2)) { KA A_ = fresh_args(); enter_phase(C, A_); phase_qknorm_naive(C, A_, l); } if (!FAST_GEMM1) SEAM(pb + 2); }
        for (int rp_ = 0; rp_ < REPSL(3); ++rp_) { if (!(FAST_RNN && FAST_ATTN) && PHON(3) && IN(pb + 3)) { KA A_ = fresh_args(); enter_phase(C, A_); if (FAST_RNN) phase_rnn_fast<0>(C, A_, l); else phase_rnn_naive<0>(C, A_, l); } if (!(FAST_RNN && FAST_ATTN)) SEAM(pb + 3); }
        for (int rp_ = 0; rp_ < REPSL(4); ++rp_) { if (PHON(4) && IN(pb + 4)) { KA A_ = fresh_args(); enter_phase(C, A_); if (FAST_RNN && FAST_ATTN) { phase_rnn_fast<0>(C, A_, l); __syncthreads(); } if (FAST_ATTN) phase_attn_fast(C, A_, l, (char*)lds); else phase_attn_naive(C, A_, l); } SEAM(pb + 4); }
        for (int rp_ = 0; rp_ < REPSL(5); ++rp_) { if (PHON(5) && IN(pb + 5)) { KA A_ = fresh_args(); enter_phase(C, A_); if (FAST_RNN) phase_rnn_fast<1>(C, A_, l); else phase_rnn_naive<1>(C, A_, l); } SEAM(pb + 5); }
        for (int rp_ = 0; rp_ < REPSL(6); ++rp_) { if (!FAST_RNN && PHON(6) && IN(pb + 6)) { KA A_ = fresh_args(); enter_phase(C, A_); phase_mixnorm_naive(C, A_, l); } if (!FAST_RNN) SEAM(pb + 6); }
        for (int rp_ = 0; rp_ < REPSL(7); ++rp_) { if (PHON(7) && IN(pb + 7)) { KA A_ = fresh_args(); enter_phase(C, A_); if (FAST_DENSE) phase_wo_fast(C, A_, l); else phase_wo_naive(C, A_, l); } SEAM(pb + 7); }
        for (int rp_ = 0; rp_ < REPSL(8); ++rp_) { if (PHON(8) && IN(pb + 8)) { KA A_ = fresh_args(); enter_phase(C, A_); if (FAST_NORM) phase_router_fast(C, A_, l); else phase_router(C, A_, l); } SEAM(pb + 8); }
        for (int rp_ = 0; rp_ < REPSL(9); ++rp_) { if (PHON(9) && IN(pb + 9)) { KA A_ = fresh_args(); enter_phase(C, A_); if (FAST_MOE) phase_g1_fast(C, A_, l); else phase_g1_naive(C, A_, l); } SEAM(pb + 9); }
        for (int rp_ = 0; rp_ < REPSL(10); ++rp_) { if (PHON(10) && IN(pb + 10)) { KA A_ = fresh_args(); enter_phase(C, A_); if (FAST_MOE) phase_g2_fast(C, A_, l); else phase_g2_naive(C, A_, l); } SEAM(pb + 10); }
        for (int rp_ = 0; rp_ < REPSL(11); ++rp_) { if (PHON(11) && IN(pb + 11)) { KA A_ = fresh_args(); enter_phase(C, A_); phase_combine(C, A_, l); } SEAM(pb + 11); }
        for (int rp_ = 0; rp_ < REPSL(12); ++rp_) { if (!FAST_GEMM1 && PHON(12) && IN(pb + 12)) { KA A_ = fresh_args(); enter_phase(C, A_); if (FAST_DENSE) phase_proj_fast(C, A_, l); else phase_proj_naive(C, A_, l); } if (!FAST_GEMM1) SEAM(pb + 12); }
        for (int rp_ = 0; rp_ < REPSL(13); ++rp_) { if (PHON(13) && IN(pb + 13)) { KA A_ = fresh_args(); enter_phase(C, A_); if (FAST_DENSE) phase_ple_fast(C, A_, l); else phase_ple_naive(C, A_, l); } if (l + 1 < DEPTH) SEAM(pb + 13); }
    }
#undef IN
#undef SEAM
}

extern "C" void kernel_launch(void* const* d_in, const int* in_sizes, int n_in, void* d_out, int out_size, void* d_ws, size_t ws_size, hipStream_t stream) {
    static int grid = 0;
    if (grid == 0) {
        if (n_in != 29 || out_size != T * D || ws_size < WS_END) { fprintf(stderr, "kernel_launch: unexpected problem (n_in %d, out %d, ws %zu)\n", n_in, out_size, ws_size); grid = -1; return; }
        int dev = 0, cus = 0, per_cu = 0;
        if (hipGetDevice(&dev) != hipSuccess || hipDeviceGetAttribute(&cus, hipDeviceAttributeMultiprocessorCount, dev) != hipSuccess) { grid = -1; return; }
        if (hipFuncSetAttribute((const void*)fwd_kernel, hipFuncAttributeMaxDynamicSharedMemorySize, LDS_BYTES) != hipSuccess) { fprintf(stderr, "kernel_launch: hipFuncSetAttribute failed\n"); grid = -1; return; }
        if (hipOccupancyMaxActiveBlocksPerMultiprocessor(&per_cu, (const void*)fwd_kernel, 512, LDS_BYTES) != hipSuccess || per_cu < 1) { fprintf(stderr, "kernel_launch: occupancy query says %d\n", per_cu); grid = -1; return; }
        (void)hipGetLastError();
        grid = cus;
    }
    if (grid < 0) return;
    hipMemsetAsync((char*)d_ws + WS_CTL, 0, CTL_ZERO_BYTES, stream);
    Args a{};
    for (int i = 0; i < 29; ++i) a.in[i] = (const float*)d_in[i];
    a.out = (float*)d_out; a.ws = (unsigned char*)d_ws;
#if MK_MULTI
    for (int ph = 0; ph < NPHASES; ++ph) { a.ph_lo = ph; a.ph_hi = ph + 1; hipLaunchKernelGGL(fwd_kernel, dim3(grid), dim3(512), LDS_BYTES, stream, a); }
#else
    a.ph_lo = 0; a.ph_hi = NPHASES;
    hipLaunchKernelGGL(fwd_kernel, dim3(grid), dim3(512), LDS_BYTES, stream, a);
#endif
}
```

```cpp
#include <hip/hip_runtime.h>
#include <cstdio>
#include <cstdint>
#include <cmath>
#include <hip/hip_bf16.h>

#define FAST_GEMM1 1
#define FAST_DENSE 1
#define FAST_MOE 1
#define FAST_ATTN 1
#define FAST_RNN 1
#define FAST_NORM 1
#ifndef PROBE_TIMING
#define PROBE_TIMING 0
#endif
#ifndef PROBE_LO
#define PROBE_LO 0
#define PROBE_HI 1
#endif
#ifndef PROBE_REP
#define PROBE_REP -1
#define PROBE_REPN 0
#endif
#define REPS(k) ((PROBE_REP == (k)) ? (1 + PROBE_REPN) : 1)
#define REPSL(k) ((((k) == 7 && l != 0) || ((k) == 13 && l != DEPTH - 1)) ? 1 : REPS(k))
#ifndef MK_MULTI
#define MK_MULTI 0
#endif

#define GAS __attribute__((address_space(1)))
#define LAS __attribute__((address_space(3)))
typedef unsigned short bf16;
typedef unsigned v4u __attribute__((ext_vector_type(4)));
typedef unsigned v2u __attribute__((ext_vector_type(2)));
typedef float f32x4 __attribute__((ext_vector_type(4)));

constexpr int NB = 4, S = 4096, T = NB * S, D = 1024, DIN = 2568, DR = 512, DA = 512, NH = 8, HD = 64;
constexpr int NE = 32, DE = 512, PLE = 256, DEPTH = 2, NZ = 2560;
constexpr float EPS = 1e-6f, LOG2E = 1.4426950408889634f, C2 = 0.125f * 1.4426950408889634f;
constexpr int CAP = 16384;
constexpr int HROWS = 40960;

constexpr size_t MiB = 1u << 20;
constexpr size_t WS_CTL = 0, CTL_ZERO_BYTES = 128 * 1024;
constexpr size_t WS_LOGF = 1 * MiB;
constexpr size_t WS_C2K = WS_LOGF + MiB / 2;
constexpr size_t WS_SA = 6 * MiB, WS_SH = 7 * MiB;
constexpr size_t WS_PAIRW = 3 * MiB;
constexpr size_t WS_ROWPAIR = 4 * MiB;
constexpr size_t WS_WIN = 8 * MiB;
constexpr size_t WS_WOUT = 18 * MiB;
constexpr size_t WS_WPG = 22 * MiB;
constexpr size_t WS_WPP = 26 * MiB;
constexpr size_t WS_WGU = 28 * MiB;
constexpr size_t WS_WDN = 156 * MiB;
constexpr size_t WS_PB = 220 * MiB;
constexpr size_t WS_XN = 236 * MiB;
constexpr size_t WS_X = 268 * MiB;
constexpr size_t WS_R1 = 332 * MiB;
constexpr size_t WS_R2 = 412 * MiB;
constexpr size_t WS_PROJ = 460 * MiB;
constexpr size_t WS_END = 492 * MiB;
constexpr int CW_BAR = 4096;
constexpr int CW_TS = 20480;
constexpr int CW_ATT = 16384;
constexpr int CW_CNT = 8192, CNT_STRIDE = 64;

constexpr int RING_BYTES = 131072;
constexpr int LDS_BYTES = 163840;
constexpr int MISC_OFF = LDS_BYTES - 1024;
constexpr int WPROJ_BYTES = 147456;

__device__ __forceinline__ unsigned f2bf(float f) { unsigned u = __builtin_bit_cast(unsigned, f); return (u + 0x7fffu + ((u >> 16) & 1u)) >> 16; }
__device__ __forceinline__ unsigned pk2(float lo, float hi) { return f2bf(lo) | (f2bf(hi) << 16); }
__device__ __forceinline__ float bf2f(unsigned u) { return __builtin_bit_cast(float, u << 16); }
__device__ __forceinline__ float bflo(unsigned w) { return __builtin_bit_cast(float, w << 16); }
__device__ __forceinline__ float bfhi(unsigned w) { return __builtin_bit_cast(float, w & 0xffff0000u); }
template <int O> __device__ __forceinline__ float lane_xor(float v) {
    if constexpr (O == 32) { const unsigned u = __builtin_bit_cast(unsigned, v); auto rr = __builtin_amdgcn_permlane32_swap(u, u, false, false);
        const unsigned a = rr[0], b = rr[1]; return __builtin_bit_cast(float, a == u ? b : a); }
    else return __builtin_bit_cast(float, __builtin_amdgcn_ds_swizzle(__builtin_bit_cast(int, v), (O << 10) | 0x1f));
}
__device__ __forceinline__ float wave_sum(float v) {
    v += lane_xor<1>(v); v += lane_xor<2>(v); v += lane_xor<4>(v); v += lane_xor<8>(v); v += lane_xor<16>(v);
    { const unsigned u = __builtin_bit_cast(unsigned, v); auto rr = __builtin_amdgcn_permlane32_swap(u, u, false, false); v = __builtin_bit_cast(float, (unsigned)rr[0]) + __builtin_bit_cast(float, (unsigned)rr[1]); }
    return v;
}
__device__ __forceinline__ float wave_max(float v) {
    v = fmaxf(v, lane_xor<1>(v)); v = fmaxf(v, lane_xor<2>(v)); v = fmaxf(v, lane_xor<4>(v)); v = fmaxf(v, lane_xor<8>(v)); v = fmaxf(v, lane_xor<16>(v));
    { const unsigned u = __builtin_bit_cast(unsigned, v); auto rr = __builtin_amdgcn_permlane32_swap(u, u, false, false); v = fmaxf(__builtin_bit_cast(float, (unsigned)rr[0]), __builtin_bit_cast(float, (unsigned)rr[1])); }
    return v;
}
__device__ __forceinline__ float half_sum32(float v) {
    const unsigned u = __builtin_bit_cast(unsigned, v); auto rr = __builtin_amdgcn_permlane32_swap(u, u, false, false); return __builtin_bit_cast(float, (unsigned)rr[0]) + __builtin_bit_cast(float, (unsigned)rr[1]);
}
__device__ __forceinline__ float sigmoidf_(float v) { return 1.f / (1.f + __expf(-v)); }
__device__ __forceinline__ float gelu_tanh(float v) { return 0.5f * v * (1.f + tanhf(0.7978845608028654f * (v + 0.044715f * v * v * v))); }
__device__ __forceinline__ float log_sigmoid(float v) { return v >= 0.f ? -log1pf(__expf(-v)) : v - log1pf(__expf(v)); }

#define XB_TMO      128
#define XB_XCNT(j)  (256  + 64 * (j))
#define XB_XSUB(j)  (1280 + 64 * (j))
#define XB_XGEN(j)  (2304 + 64 * (j))
#define XB_TOP      3328
#define XB_TOPGEN   3392
#define XCD_BAR_WORDS 3456
#define XB_SPIN_CAP (1u << 26)
__device__ __forceinline__ unsigned xb_ld(unsigned* p)              { return __hip_atomic_load(p, __ATOMIC_RELAXED, __HIP_MEMORY_SCOPE_AGENT); }
__device__ __forceinline__ unsigned xb_add(unsigned* p, unsigned v) { return __hip_atomic_fetch_add(p, v, __ATOMIC_RELAXED, __HIP_MEMORY_SCOPE_AGENT); }
__device__ __forceinline__ unsigned xb_xcc_id() { return (unsigned)__builtin_amdgcn_s_getreg((3 << 11) | 20) & 0xFu; }
#define XB_SPIN(cond, bar) do { unsigned _sp = 0; while (cond) { __builtin_amdgcn_s_sleep(1); \
    if ((++_sp & 255u) == 0u) { if (xb_ld(&(bar)[XB_TMO])) break; if (_sp > XB_SPIN_CAP) { atomicAdd(&(bar)[XB_TMO], 1u); break; } } } } while (0)
struct XcdBarrier { unsigned* bar; unsigned x; volatile LAS unsigned* st; };
__device__ __forceinline__ XcdBarrier xcd_barrier_post(unsigned* bar, volatile LAS unsigned* st) {
    XcdBarrier b; b.bar = bar; b.x = xb_xcc_id(); b.st = st;
    if (threadIdx.x == 0) (void)xb_add(&bar[XB_XCNT(b.x)], 1u);
    return b;
}
__device__ __forceinline__ void xcd_barrier_complete(unsigned* bar, unsigned x, unsigned& nloc, unsigned& nx) {
    const unsigned G = gridDim.x * gridDim.y * gridDim.z;
    unsigned sum, cnt, mine, sp = 0u;
    for (;;) {
        sum = 0u; cnt = 0u; mine = 0u;
#pragma unroll
        for (unsigned j = 0; j < 16; ++j) { const unsigned c = xb_ld(&bar[XB_XCNT(j)]); sum += c; cnt += (c > 0u) ? 1u : 0u; mine = (j == x) ? c : mine; }
        if (sum == G) break;
        __builtin_amdgcn_s_sleep(1);
        if ((++sp & 255u) == 0u) { if (xb_ld(&bar[XB_TMO])) break; if (sp > XB_SPIN_CAP) { atomicAdd(&bar[XB_TMO], 1u); break; } }
    }
    nloc = mine > 0u ? mine : 1u; nx = cnt > 0u ? cnt : 1u;
}
__device__ __forceinline__ void xcd_barrier(const XcdBarrier& b, const bool leader  ) {
    asm volatile("s_waitcnt vmcnt(0)" ::: "memory");
    __syncthreads();
    if (leader) {
        unsigned* bar = b.bar;
        __builtin_amdgcn_s_waitcnt(0);
        unsigned nloc = b.st[0], nx = b.st[1];
        if (nloc == 0u) { xcd_barrier_complete(bar, b.x, nloc, nx); b.st[0] = nloc; b.st[1] = nx; }
        const unsigned old = xb_add(&bar[XB_XSUB(b.x)], 1u);
        const unsigned gen = old / nloc;
        if (old + 1u == (gen + 1u) * nloc) {
            __builtin_amdgcn_fence(__ATOMIC_RELEASE, "agent");
            asm volatile("s_waitcnt vmcnt(0)" ::: "memory");
            const unsigned og = xb_add(&bar[XB_TOP], 1u);
            const unsigned tg = og / nx;
            if (og + 1u == (tg + 1u) * nx) xb_add(&bar[XB_TOPGEN], 1u);
            else XB_SPIN(xb_ld(&bar[XB_TOPGEN]) == tg, bar);
            __builtin_amdgcn_fence(__ATOMIC_ACQUIRE, "agent");
            xb_add(&bar[XB_XGEN(b.x)], 1u);
            asm volatile("s_waitcnt vmcnt(0)" ::: "memory");
        } else {
            XB_SPIN(xb_ld(&bar[XB_XGEN(b.x)]) == gen, bar);
            __builtin_amdgcn_fence(__ATOMIC_ACQUIRE, "agent");
            asm volatile("s_waitcnt vmcnt(0)" ::: "memory");
        }
    }
    __syncthreads();
}

struct Args { const float* in[29]; float* out; unsigned char* ws; int ph_lo, ph_hi; };
typedef const __attribute__((address_space(4))) Args* KA;
__device__ __forceinline__ KA fresh_args() { KA p = (KA)__builtin_amdgcn_kernarg_segment_ptr(); asm volatile("" : "+s"(p)); return p; }
struct Ctx;
struct Ctx {
    LAS unsigned char* lds;
    int tid, lane, wave, gw, ngw;
    int wave0;
    unsigned char* ws;
};
__device__ __forceinline__ void enter_phase(Ctx& C, KA A) {
    int t; asm volatile("v_mbcnt_lo_u32_b32 %0, -1, 0\n\tv_mbcnt_hi_u32_b32 %0, -1, %0" : "=v"(t)); t += C.wave0 * 64; C.tid = t; C.lane = t & 63; C.wave = __builtin_amdgcn_readfirstlane(t >> 6);
    C.gw = blockIdx.x * 8 + C.wave; C.ngw = gridDim.x * 8; C.ws = A->ws; }
enum { I_X = 0, I_P, I_MIXN, I_WIN, I_BF, I_CONVW, I_CONVB, I_WR, I_BR, I_WI, I_BI, I_LAM, I_QN, I_KN, I_LRUN, I_ATTN, I_WOUT, I_FFNN,
       I_WG, I_BG, I_WRT, I_BRT, I_WEG, I_WEU, I_WED, I_PLEN, I_WPG, I_BPG, I_WPP };

__device__ __forceinline__ void transpose_item(const float* W, int ldw, int K, bf16* WT, int k0, int n0, int c0, LAS float* scr, int lane) {
    { float t[32];
#pragma unroll
      for (int i = 0; i < 32; ++i) t[i] = W[(size_t)(k0 + 2 * i + (lane >> 5)) * ldw + c0 + (lane & 31)];
#pragma unroll
      for (int i = 0; i < 32; ++i) scr[(2 * i + (lane >> 5)) * 33 + (lane & 31)] = t[i]; }
    asm volatile("s_waitcnt lgkmcnt(0)" ::: "memory");
    const int c = lane & 7;
#pragma unroll
    for (int j = 0; j < 4; ++j) { const int n = (lane >> 3) + 8 * j; const LAS float* s = scr + (8 * c) * 33 + n;
        v4u o; o.x = pk2(s[0 * 33], s[1 * 33]); o.y = pk2(s[2 * 33], s[3 * 33]); o.z = pk2(s[4 * 33], s[5 * 33]); o.w = pk2(s[6 * 33], s[7 * 33]);
        *(v4u*)(WT + (size_t)(n0 + n) * K + k0 + 8 * c) = o; }
    asm volatile("s_waitcnt lgkmcnt(0)" ::: "memory");
}
__device__ __forceinline__ void phase_prologue(Ctx& C, KA AR) {
    LAS float* scr = (LAS float*)(C.lds + C.wave * 16384);
    constexpr int I_IN = 16 * 80, I_OUT = 16 * 32, I_GU = 32 * 16 * 32, I_DN = 32 * 8 * 32, I_PG = 16 * 32, I_PP = 4 * 32;
    constexpr int PER_L = I_IN + I_OUT + I_GU + I_DN + I_PG + I_PP;
    for (int it = C.gw; it < DEPTH * PER_L; it += C.ngw) {
        const int l = it / PER_L; int r = it % PER_L;
        if (r < I_IN) {
            const int kb = r / 80, nb = r % 80, n0 = 32 * nb, pn = n0 >> 8, jl = n0 & 255, bj = jl >> 7, wc = (jl >> 5) & 3;
            transpose_item(AR->in[I_WIN] + (size_t)l * D * DIN, DIN, D, (bf16*)(C.ws + WS_WIN) + (size_t)l * NZ * D, 64 * kb, n0, 256 * pn + 64 * wc + 32 * bj, scr, C.lane); continue; }
        r -= I_IN;
        if (r < I_OUT) { const int kb = r / 32, nb = r % 32;
            transpose_item(AR->in[I_WOUT] + (size_t)l * D * D, D, D, (bf16*)(C.ws + WS_WOUT) + (size_t)l * D * D, 64 * kb, 32 * nb, 32 * nb, scr, C.lane); continue; }
        r -= I_OUT;
        if (r < I_GU) {
            const int e = r / 512, q = r % 512, kb = q / 32, nb = q % 32, n0 = 32 * nb, pn = n0 >> 8, jl = n0 & 255;
            const float* src = (jl < 128 ? AR->in[I_WEG] : AR->in[I_WEU]) + (size_t)(l * NE + e) * D * DE;
            transpose_item(src, DE, D, (bf16*)(C.ws + WS_WGU) + (size_t)(l * NE + e) * 1024 * D, 64 * kb, n0, 128 * pn + (jl & 127), scr, C.lane); continue; }
        r -= I_GU;
        if (r < I_DN) { const int e = r / 256, q = r % 256, kb = q / 32, nb = q % 32;
            transpose_item(AR->in[I_WED] + (size_t)(l * NE + e) * DE * D, D, DE, (bf16*)(C.ws + WS_WDN) + (size_t)(l * NE + e) * D * DE, 64 * kb, 32 * nb, 32 * nb, scr, C.lane); continue; }
        r -= I_DN;
        if (r < I_PG) { const int kb = r / 32, nb = r % 32;
            transpose_item(AR->in[I_WPG] + (size_t)l * D * D, D, D, (bf16*)(C.ws + WS_WPG) + (size_t)l * D * D, 64 * kb, 32 * nb, 32 * nb, scr, C.lane); continue; }
        r -= I_PG;
        { const int kb = r / 32, nb = r % 32;
            transpose_item(AR->in[I_WPP] + (size_t)l * PLE * D, D, PLE, (bf16*)(C.ws + WS_WPP) + (size_t)l * D * PLE, 64 * kb, 32 * nb, 32 * nb, scr, C.lane); }
    }
    const f32x4* ps = (const f32x4*)AR->in[I_P]; v2u* pd = (v2u*)(C.ws + WS_PB);
    const size_t n4 = (size_t)DEPTH * T * PLE / 4;
    { const size_t st = (size_t)gridDim.x * 512; size_t i = (size_t)blockIdx.x * 512 + C.tid;
      for (; i + 7 * st < n4; i += 8 * st) { f32x4 v[8];
#pragma unroll
          for (int q = 0; q < 8; ++q) v[q] = ps[i + q * st];
#pragma unroll
          for (int q = 0; q < 8; ++q) { v2u o; o.x = pk2(v[q].x, v[q].y); o.y = pk2(v[q].z, v[q].w); pd[i + q * st] = o; } }
      for (; i < n4; i += st) { const f32x4 v = ps[i]; v2u o; o.x = pk2(v.x, v.y); o.y = pk2(v.z, v.w); pd[i] = o; } }
}

__device__ __forceinline__ void load_row(const float* row, int lane, f32x4 (&v)[4]) {
    const f32x4* xr = (const f32x4*)row + lane;
#pragma unroll
    for (int j = 0; j < 4; ++j) v[j] = xr[64 * j];
}
__device__ __forceinline__ float row_rs(const f32x4 (&v)[4]) {
    float s = 0.f;
#pragma unroll
    for (int j = 0; j < 4; ++j) s += (v[j].x * v[j].x + v[j].y * v[j].y) + (v[j].z * v[j].z + v[j].w * v[j].w);
    return rsqrtf(wave_sum(s) * (1.f / D) + EPS);
}
__device__ __forceinline__ void scale_row(f32x4 (&v)[4], float rs, const float* gain, int lane) {
    const f32x4* g = (const f32x4*)gain + lane;
#pragma unroll
    for (int j = 0; j < 4; ++j) v[j] = v[j] * rs * g[64 * j];
}
__device__ __forceinline__ void store_row_bf16(bf16* row, int lane, const f32x4 (&v)[4]) {
    v2u* o = (v2u*)row + lane;
#pragma unroll
    for (int j = 0; j < 4; ++j) { v2u w; w.x = pk2(v[j].x, v[j].y); w.y = pk2(v[j].z, v[j].w); o[64 * j] = w; }
}

__device__ __forceinline__ void phase_norm1(Ctx& C, KA AR, int l) {
    const float* xs = l == 0 ? AR->in[I_X] : (const float*)(C.ws + WS_X);
    const float* gain = AR->in[I_MIXN] + l * D;
    const float* wf = AR->in[I_WIN] + (size_t)l * D * DIN + NZ;
    const float* bfg = AR->in[I_BF] + l * NH;
    bf16* xn = (bf16*)(C.ws + WS_XN); float* logf = (float*)(C.ws + WS_LOGF);
    for (int t = C.gw; t < T; t += C.ngw) {
        f32x4 v[4]; load_row(xs + (size_t)t * D, C.lane, v);
        const float rs = row_rs(v); scale_row(v, rs, gain, C.lane);
        store_row_bf16(xn + (size_t)t * D, C.lane, v);
        float z[8] = {0.f, 0.f, 0.f, 0.f, 0.f, 0.f, 0.f, 0.f};
#pragma unroll
        for (int j = 0; j < 4; ++j)
#pragma unroll
            for (int e = 0; e < 4; ++e) { const int k = 256 * j + 4 * C.lane + e; const f32x4 w0 = *(const f32x4*)(wf + (size_t)k * DIN), w1 = *(const f32x4*)(wf + (size_t)k * DIN + 4);
                const float a = v[j][e]; z[0] += a * w0.x; z[1] += a * w0.y; z[2] += a * w0.z; z[3] += a * w0.w; z[4] += a * w1.x; z[5] += a * w1.y; z[6] += a * w1.z; z[7] += a * w1.w; }
#pragma unroll
        for (int h = 0; h < 8; ++h) z[h] = wave_sum(z[h]);
        float mine = 0.f;
#pragma unroll
        for (int h = 0; h < 8; ++h) mine = (C.lane == h) ? z[h] : mine;
        if (C.lane < 8) logf[(size_t)t * 8 + C.lane] = log_sigmoid(mine + bfg[C.lane]);
    }
}

template <int NACC, class AR, class BR, class EP>
__device__ __forceinline__ void ngemm_tile(LAS float* sm, int K, AR arow, BR brow, EP epi, const int tid) {
    LAS float* As = sm; LAS float* Bs = sm + 32 * 68;
    const int ty = tid >> 4, tx = tid & 15, lr = tid >> 3, lk = (tid & 7) * 4;
    float acc[NACC][2][4];
#pragma unroll
    for (int a = 0; a < NACC; ++a)
#pragma unroll
        for (int i = 0; i < 2; ++i)
#pragma unroll
            for (int j = 0; j < 4; ++j) acc[a][i][j] = 0.f;
    const bf16* ap = arow(lr); const bf16* bp0 = brow(lr, 0); const bf16* bp1 = NACC > 1 ? brow(lr, 1) : bp0;
    for (int k0 = 0; k0 < K; k0 += 32) {
        __syncthreads();
        { v2u av; av.x = 0u; av.y = 0u; if (ap) av = *(const v2u*)(ap + k0 + lk);
          As[(lk + 0) * 68 + lr] = bflo(av.x); As[(lk + 1) * 68 + lr] = bfhi(av.x); As[(lk + 2) * 68 + lr] = bflo(av.y); As[(lk + 3) * 68 + lr] = bfhi(av.y); }
        { const v2u bv = *(const v2u*)(bp0 + k0 + lk);
          Bs[(lk + 0) * 68 + lr] = bflo(bv.x); Bs[(lk + 1) * 68 + lr] = bfhi(bv.x); Bs[(lk + 2) * 68 + lr] = bflo(bv.y); Bs[(lk + 3) * 68 + lr] = bfhi(bv.y); }
        if (NACC > 1) { const v2u bv = *(const v2u*)(bp1 + k0 + lk); LAS float* B1 = Bs + 32 * 68;
          B1[(lk + 0) * 68 + lr] = bflo(bv.x); B1[(lk + 1) * 68 + lr] = bfhi(bv.x); B1[(lk + 2) * 68 + lr] = bflo(bv.y); B1[(lk + 3) * 68 + lr] = bfhi(bv.y); }
        __syncthreads();
#pragma unroll 8
        for (int kk = 0; kk < 32; ++kk) {
            const float a0 = As[kk * 68 + ty * 2], a1 = As[kk * 68 + ty * 2 + 1];
#pragma unroll
            for (int a = 0; a < NACC; ++a) { const f32x4 b = *(const LAS f32x4*)(Bs + a * 32 * 68 + kk * 68 + tx * 4);
#pragma unroll
                for (int j = 0; j < 4; ++j) { acc[a][0][j] += a0 * b[j]; acc[a][1][j] += a1 * b[j]; } }
        }
    }
#pragma unroll
    for (int i = 0; i < 2; ++i)
#pragma unroll
        for (int j = 0; j < 4; ++j) epi(ty * 2 + i, tx * 4 + j, acc[0][i][j], NACC > 1 ? acc[1][i][j] : 0.f);
}

__device__ __forceinline__ void phase_cumsum(Ctx& C, KA AR) {
    if (C.gw < NB * NH) {
        const int b = C.gw / NH, h = C.gw % NH;
        const float* logf = (const float*)(C.ws + WS_LOGF) + (size_t)b * S * 8 + h; float* c2k = (float*)(C.ws + WS_C2K) + (size_t)C.gw * S;
        float s = 0.f;
        for (int i = 0; i < 64; ++i) s += logf[(size_t)(64 * C.lane + i) * 8];
        float inc = s;
#pragma unroll
        for (int o = 1; o < 64; o <<= 1) { const float v = __builtin_bit_cast(float, __builtin_amdgcn_ds_bpermute((C.lane - o) << 2, __builtin_bit_cast(int, inc))); if (C.lane >= o) inc += v; }
        float run = inc - s;
        for (int i = 0; i < 64; ++i) { run += logf[(size_t)(64 * C.lane + i) * 8]; c2k[64 * C.lane + i] = run * LOG2E; }
    }
}
__device__ __forceinline__ void phase_cumsum_fast(Ctx& C, KA AR) {
    const int row = (int)blockIdx.x - (int)gridDim.x / 2;
    if (C.wave == 0 && row >= 0 && row < NB * NH) {
        const float* src = (const float*)(C.ws + WS_LOGF) + (size_t)row * S + C.lane; float* dst = (float*)(C.ws + WS_C2K) + (size_t)row * S + C.lane;
        float run = 0.f;
        for (int it = 0; it < S / 64; it += 8) {
            float v[8];
#pragma unroll
            for (int q = 0; q < 8; ++q) v[q] = src[(it + q) * 64];
#pragma unroll
            for (int q = 0; q < 8; ++q) { float x = v[q];
#pragma unroll
                for (int o = 1; o < 64; o <<= 1) { const float y = __builtin_bit_cast(float, __builtin_amdgcn_ds_bpermute((C.lane - o) << 2, __builtin_bit_cast(int, x))); if (C.lane >= o) x += y; }
                dst[(it + q) * 64] = (run + x) * LOG2E;
                run += __builtin_bit_cast(float, __builtin_amdgcn_readlane(__builtin_bit_cast(int, x), 63)); }
        }
    }
}
__device__ __forceinline__ void phase_gemm1_naive(Ctx& C, KA AR, int l) {
    phase_cumsum(C, AR);
    const bf16* A = (const bf16*)(C.ws + WS_XN); const bf16* Bt = (const bf16*)(C.ws + WS_WIN) + (size_t)l * NZ * D;
    bf16* R1 = (bf16*)(C.ws + WS_R1);
    for (int u = blockIdx.x; u < (T / 64) * (NZ / 64); u += gridDim.x) {
        const int mt = u / (NZ / 64), nt = u % (NZ / 64), m0 = 64 * mt, n0 = 64 * nt;
        ngemm_tile<1>((LAS float*)C.lds, D, [=](int r) { return A + (size_t)(m0 + r) * D; }, [=](int c, int) { return Bt + (size_t)(n0 + c) * D; },
            [=](int r, int c, float v, float) {
                const int j = n0 + c, pn = j >> 8, jl = j & 255, bj = jl >> 7, wc = (jl >> 5) & 3, col = 256 * pn + 64 * wc + 32 * bj + (jl & 31);
                const int seg = col >> 9, cc = col & 511;
                const float o = seg == 1 ? gelu_tanh(v) : v;
                R1[(size_t)seg * T * 512 + (size_t)(m0 + r) * 512 + cc] = (bf16)f2bf(o);
            }, C.tid);
    }
}
__device__ __forceinline__ void phase_qknorm_naive(Ctx& C, KA AR, int l) {
    bf16* Q = (bf16*)(C.ws + WS_R1) + (size_t)2 * T * 512; bf16* Kb = Q + (size_t)T * 512;
    const float* gq = AR->in[I_QN] + l * HD; const float* gk = AR->in[I_KN] + l * HD;
    for (int i = C.gw; i < 2 * T; i += C.ngw) {
        const int t = i >> 1, isk = i & 1; bf16* row = (isk ? Kb : Q) + (size_t)t * 512; const float* g = isk ? gk : gq;
        const v4u w = *(const v4u*)(row + 8 * C.lane);
        float x[8] = {bflo(w.x), bfhi(w.x), bflo(w.y), bfhi(w.y), bflo(w.z), bfhi(w.z), bflo(w.w), bfhi(w.w)};
        float s = 0.f;
#pragma unroll
        for (int e = 0; e < 8; ++e) s += x[e] * x[e];
        s += lane_xor<1>(s); s += lane_xor<2>(s); s += lane_xor<4>(s);
        const float rs = rsqrtf(s * (1.f / 64.f) + EPS) * (isk ? 1.f : C2);
        const int d0 = 8 * (C.lane & 7);
#pragma unroll
        for (int e = 0; e < 8; ++e) x[e] = x[e] * rs * g[d0 + e];
        v4u o; o.x = pk2(x[0], x[1]); o.y = pk2(x[2], x[3]); o.z = pk2(x[4], x[5]); o.w = pk2(x[6], x[7]);
        *(v4u*)(row + 8 * C.lane) = o;
    }
}

template <int MODE>
__device__ __forceinline__ void phase_rnn_naive(Ctx& C, KA AR, int l) {
    LAS float* xcs = (LAS float*)C.lds; LAS float* as = xcs + 64 * 65; LAS float* us = as + 64 * 64;
    const bf16* ZX = (const bf16*)(C.ws + WS_R1); const bf16* ZG = ZX + (size_t)T * 512;
    float* SA = (float*)(C.ws + WS_SA); float* SH = (float*)(C.ws + WS_SH); float* YR = (float*)(C.ws + WS_PROJ);
    const float* cw = AR->in[I_CONVW] + l * 4 * DR; const float* cb = AR->in[I_CONVB] + l * DR;
    const float* wr = AR->in[I_WR] + (size_t)l * 8 * 64 * 64; const float* wi = AR->in[I_WI] + (size_t)l * 8 * 64 * 64;
    const float* br = AR->in[I_BR] + l * DR; const float* bi = AR->in[I_BI] + l * DR; const float* lam = AR->in[I_LAM] + l * DR;
    for (int u = blockIdx.x; u < NB * 64 * 8; u += gridDim.x) {
        const int b = u >> 9, cidx = (u >> 3) & 63, blk = u & 7;
        __syncthreads();
#pragma unroll
        for (int i = 0; i < 8; ++i) { const int e = C.tid + 512 * i, t = e >> 6, c = e & 63, ch = blk * 64 + c, tg = cidx * 64 + t;
            float xc = cb[ch];
#pragma unroll
            for (int j = 0; j < 4; ++j) { const int tt = tg - 3 + j; if (tt >= 0) xc += cw[j * DR + ch] * bf2f(ZX[(size_t)(b * S + tt) * 512 + ch]); }
            xcs[t * 65 + c] = xc; }
        __syncthreads();
#pragma unroll
        for (int i = 0; i < 8; ++i) { const int e = C.tid + 512 * i, t = e >> 6, j = e & 63, ch = blk * 64 + j;
            float ar = br[ch], ai = bi[ch];
            for (int k = 0; k < 64; ++k) { const float x = xcs[t * 65 + k]; ar += x * wr[(size_t)(blk * 64 + k) * 64 + j]; ai += x * wi[(size_t)(blk * 64 + k) * 64 + j]; }
            const float r = sigmoidf_(ar), ig = sigmoidf_(ai);
            const float la = -8.f * r * log1pf(__expf(-lam[ch]));
            as[t * 64 + j] = __expf(la); us[t * 64 + j] = sqrtf(-expm1f(2.f * la)) * (ig * xcs[t * 65 + j]); }
        __syncthreads();
        if (C.tid < 64) { const int j = C.tid, ch = blk * 64 + j;
            if (MODE == 0) { float A = 1.f, H = 0.f;
                for (int t = 0; t < 64; ++t) { const float a = as[t * 64 + j]; H = a * H + us[t * 64 + j]; A *= a; }
                SA[(size_t)(b * 64 + cidx) * 512 + ch] = A; SH[(size_t)(b * 64 + cidx) * 512 + ch] = H;
            } else { float h = 0.f;
                for (int c2 = 0; c2 < cidx; ++c2) h = SA[(size_t)(b * 64 + c2) * 512 + ch] * h + SH[(size_t)(b * 64 + c2) * 512 + ch];
                for (int t = 0; t < 64; ++t) { h = as[t * 64 + j] * h + us[t * 64 + j]; as[t * 64 + j] = h; } } }
        if (MODE == 1) { __syncthreads();
#pragma unroll
            for (int i = 0; i < 8; ++i) { const int e = C.tid + 512 * i, t = e >> 6, c = e & 63, ch = blk * 64 + c; const size_t row = (size_t)(b * S + cidx * 64 + t);
                YR[row * 512 + ch] = as[t * 64 + c] * bf2f(ZG[row * 512 + ch]); } }
    }
}

__device__ __forceinline__ void phase_attn_naive(Ctx& C, KA AR, int l) {
    LAS float* Ks = (LAS float*)C.lds; LAS float* Vs = Ks + 64 * 65; LAS float* Qs = Vs + 64 * 65; LAS float* Ps = Qs + 64 * 64; LAS float* cks = Ps + 8 * 64;
    const bf16* Q = (const bf16*)(C.ws + WS_R1) + (size_t)2 * T * 512; const bf16* Kb = Q + (size_t)T * 512; const bf16* Vb = Kb + (size_t)T * 512;
    bf16* O = (bf16*)(C.ws + WS_R2); const float* c2k = (const float*)(C.ws + WS_C2K);
    for (int u = blockIdx.x; u < NB * NH * 64; u += gridDim.x) {
        const int qt = 63 - (u >> 5), bh = u & 31, b = bh >> 3, h = bh & 7, q0 = 64 * qt;
        const float* ck = c2k + (size_t)bh * S;
        __syncthreads();
        for (int e = C.tid; e < 64 * 64; e += 512) { const int r = e >> 6, d = e & 63; Qs[r * 64 + d] = bf2f(Q[(size_t)(b * S + q0 + r) * 512 + h * 64 + d]); }
        float m[8], lsum[8], o[8], cq[8];
#pragma unroll
        for (int i = 0; i < 8; ++i) { m[i] = -INFINITY; lsum[i] = 0.f; o[i] = 0.f; cq[i] = ck[q0 + C.wave * 8 + i]; }
        for (int kt = 0; kt <= qt; ++kt) {
            const int k0 = 64 * kt;
            __syncthreads();
            for (int e = C.tid; e < 64 * 64; e += 512) { const int r = e >> 6, d = e & 63; const size_t g = (size_t)(b * S + k0 + r) * 512 + h * 64 + d; Ks[r * 65 + d] = bf2f(Kb[g]); Vs[r * 65 + d] = bf2f(Vb[g]); }
            if (C.tid < 64) cks[C.tid] = ck[k0 + C.tid];
            __syncthreads();
#pragma unroll
            for (int i = 0; i < 8; ++i) {
                const int q = C.wave * 8 + i, qg = q0 + q;
                float dot = 0.f;
#pragma unroll 16
                for (int d = 0; d < 64; ++d) dot += Qs[q * 64 + d] * Ks[C.lane * 65 + d];
                float s = dot + cq[i] - cks[C.lane];
                if (k0 + C.lane > qg) s = -INFINITY;
                const float mn = fmaxf(m[i], wave_max(s));
                const float alpha = exp2f(m[i] - mn), p = exp2f(s - mn);
                lsum[i] = lsum[i] * alpha + wave_sum(p); m[i] = mn;
                Ps[C.wave * 64 + C.lane] = p;
                asm volatile("s_waitcnt lgkmcnt(0)" ::: "memory");
                float acc = 0.f;
#pragma unroll 16
                for (int k = 0; k < 64; ++k) acc += Ps[C.wave * 64 + k] * Vs[k * 65 + C.lane];
                o[i] = o[i] * alpha + acc;
                asm volatile("s_waitcnt lgkmcnt(0)" ::: "memory");
            }
        }
#pragma unroll
        for (int i = 0; i < 8; ++i) O[(size_t)(b * S + q0 + C.wave * 8 + i) * 512 + h * 64 + C.lane] = (bf16)f2bf(o[i] / lsum[i]);
    }
}

__device__ __forceinline__ void phase_mixnorm_naive(Ctx& C, KA AR, int l) {
    const float* YR = (const float*)(C.ws + WS_PROJ); const bf16* O = (const bf16*)(C.ws + WS_R2); bf16* YM = (bf16*)(C.ws + WS_R2 + 16 * MiB);
    const float* g1 = AR->in[I_LRUN] + l * DR; const float* g2 = AR->in[I_ATTN] + l * DA;
    for (int t = C.gw; t < T; t += C.ngw) {
        f32x4 a[2]; float s = 0.f;
#pragma unroll
        for (int j = 0; j < 2; ++j) { a[j] = *((const f32x4*)(YR + (size_t)t * 512) + C.lane + 64 * j); s += (a[j].x * a[j].x + a[j].y * a[j].y) + (a[j].z * a[j].z + a[j].w * a[j].w); }
        float rs = rsqrtf(wave_sum(s) * (1.f / 512.f) + EPS);
#pragma unroll
        for (int j = 0; j < 2; ++j) { const f32x4 g = *((const f32x4*)g1 + C.lane + 64 * j); const f32x4 v = a[j] * rs * g; v2u w; w.x = pk2(v.x, v.y); w.y = pk2(v.z, v.w);
            *((v2u*)(YM + (size_t)t * D) + C.lane + 64 * j) = w; }
        const v4u w = *(const v4u*)(O + (size_t)t * 512 + 8 * C.lane);
        float x[8] = {bflo(w.x), bfhi(w.x), bflo(w.y), bfhi(w.y), bflo(w.z), bfhi(w.z), bflo(w.w), bfhi(w.w)};
        s = 0.f;
#pragma unroll
        for (int e = 0; e < 8; ++e) s += x[e] * x[e];
        rs = rsqrtf(wave_sum(s) * (1.f / 512.f) + EPS);
#pragma unroll
        for (int e = 0; e < 8; ++e) x[e] = x[e] * rs * g2[8 * C.lane + e];
        v4u o; o.x = pk2(x[0], x[1]); o.y = pk2(x[2], x[3]); o.z = pk2(x[4], x[5]); o.w = pk2(x[6], x[7]);
        *(v4u*)(YM + (size_t)t * D + 512 + 8 * C.lane) = o;
    }
}

__device__ __forceinline__ void phase_wo_naive(Ctx& C, KA AR, int l) {
    const bf16* A = (const bf16*)(C.ws + WS_R2 + 16 * MiB); const bf16* Bt = (const bf16*)(C.ws + WS_WOUT) + (size_t)l * D * D;
    const float* xs = l == 0 ? AR->in[I_X] : (const float*)(C.ws + WS_X); float* X = (float*)(C.ws + WS_X);
    for (int u = blockIdx.x; u < (T / 64) * (D / 64); u += gridDim.x) {
        const int m0 = 64 * (u / (D / 64)), n0 = 64 * (u % (D / 64));
        ngemm_tile<1>((LAS float*)C.lds, D, [=](int r) { return A + (size_t)(m0 + r) * D; }, [=](int c, int) { return Bt + (size_t)(n0 + c) * D; },
            [=](int r, int c, float v, float) { const size_t i = (size_t)(m0 + r) * D + n0 + c; X[i] = xs[i] + v; }, C.tid);
    }
}

__device__ __forceinline__ void phase_router(Ctx& C, KA AR, int l) {
    const float* X = (const float*)(C.ws + WS_X); bf16* xn = (bf16*)(C.ws + WS_XN);
    const float* gain = AR->in[I_FFNN] + l * D; const float* wg = AR->in[I_WG] + (size_t)l * D * 4; const float* bg = AR->in[I_BG] + l * 4;
    const float* wr = AR->in[I_WRT] + (size_t)l * D * NE; const float* brt = AR->in[I_BRT] + l * NE;
    unsigned* cnt = (unsigned*)(C.ws + WS_CTL) + CW_CNT + 32 * CNT_STRIDE * l; int* rowpair = (int*)(C.ws + WS_ROWPAIR); float* pairw = (float*)(C.ws + WS_PAIRW);
    for (int t = C.gw; t < T; t += C.ngw) {
        f32x4 v[4]; load_row(X + (size_t)t * D, C.lane, v);
        const float rs = row_rs(v); scale_row(v, rs, gain, C.lane);
        store_row_bf16(xn + (size_t)t * D, C.lane, v);
        LAS float* rowl = (LAS float*)C.lds + C.wave * 1024;
#pragma unroll
        for (int j = 0; j < 4; ++j) *((LAS f32x4*)rowl + C.lane + 64 * j) = v[j];
        asm volatile("s_waitcnt lgkmcnt(0)" ::: "memory");
        float acc = 0.f;
        if (C.lane < 36) {
            const float* wp = C.lane < 32 ? wr + C.lane : wg + (C.lane - 32); const int st = C.lane < 32 ? NE : 4;
#pragma unroll 8
            for (int k = 0; k < D; ++k) acc += rowl[k] * wp[(size_t)k * st];
            acc += C.lane < 32 ? brt[C.lane] : bg[C.lane - 32];
        }
        asm volatile("s_waitcnt lgkmcnt(0)" ::: "memory");
        float gl[4];
#pragma unroll
        for (int i = 0; i < 4; ++i) gl[i] = __builtin_bit_cast(float, __builtin_amdgcn_readlane(__builtin_bit_cast(int, acc), 32 + i));
        int gi = 0; float gm = gl[0];
#pragma unroll
        for (int i = 1; i < 4; ++i) if (gl[i] > gm) { gm = gl[i]; gi = i; }
        float gs = 0.f;
#pragma unroll
        for (int i = 0; i < 4; ++i) gs += __expf(gl[i] - gm);
        const float gp = 1.f / gs;
        float ev[8];
#pragma unroll
        for (int i = 0; i < 8; ++i) ev[i] = __builtin_bit_cast(float, __builtin_amdgcn_readlane(__builtin_bit_cast(int, acc), __builtin_amdgcn_readfirstlane(gi) * 8 + i));
        int i0 = 0; float t0 = ev[0];
#pragma unroll
        for (int i = 1; i < 8; ++i) if (ev[i] > t0) { t0 = ev[i]; i0 = i; }
        int i1 = -1; float t1 = -INFINITY;
#pragma unroll
        for (int i = 0; i < 8; ++i) if (i != i0 && ev[i] > t1) { t1 = ev[i]; i1 = i; }
        const float ex = __expf(t1 - t0), w0 = gp / (1.f + ex), w1 = gp * ex / (1.f + ex);
        if (C.lane < 2) { const int e = gi * 8 + (C.lane == 0 ? i0 : i1); const unsigned pos = atomicAdd(cnt + e * CNT_STRIDE, 1u);
            rowpair[(size_t)e * CAP + pos] = 2 * t + C.lane; pairw[2 * t + C.lane] = C.lane == 0 ? w0 : w1; }
    }
}

struct ExpTab { int n[NE], hoff[NE], t0[NE + 1]; };
__device__ __forceinline__ void build_exptab(Ctx& C, int l, LAS int* tab) {
    __syncthreads();
    if (C.tid == 0) { const unsigned* cnt = (const unsigned*)(C.ws + WS_CTL) + CW_CNT + 32 * CNT_STRIDE * l; int ho = 0, tt = 0;
        for (int e = 0; e < NE; ++e) { const int n = (int)__hip_atomic_load(cnt + e * CNT_STRIDE, __ATOMIC_RELAXED, __HIP_MEMORY_SCOPE_AGENT); tab[e] = n; tab[32 + e] = ho; tab[64 + e] = tt; ho += (n + 255) & ~255; tt += (n + 63) >> 6; }
        tab[64 + NE] = tt; }
    __syncthreads();
}
__device__ __forceinline__ void phase_g1_naive(Ctx& C, KA AR, int l) {
    LAS int* tab = (LAS int*)(C.lds + 65536); build_exptab(C, l, tab);
    const bf16* xn = (const bf16*)(C.ws + WS_XN); const int* rowpair = (const int*)(C.ws + WS_ROWPAIR); bf16* Hb = (bf16*)(C.ws + WS_R2);
    const int nmt = tab[64 + NE];
    for (int u = blockIdx.x; u < nmt * 8; u += gridDim.x) {
        const int mtg = u >> 3, nt = u & 7; int e = 0;
        for (int i = 1; i < NE; ++i) if (tab[64 + i] <= mtg) e = i;
        const int mt = mtg - tab[64 + e], ne = tab[e], ho = tab[32 + e], p0 = 64 * mt, c0 = 64 * nt;
        const bf16* Bt = (const bf16*)(C.ws + WS_WGU) + (size_t)(l * NE + e) * 1024 * D; const int* rp = rowpair + (size_t)e * CAP;
        ngemm_tile<2>((LAS float*)C.lds, D,
            [=](int r) { return (p0 + r < ne) ? xn + (size_t)(rp[p0 + r] >> 1) * D : (const bf16*)nullptr; },
            [=](int c, int a) { const int cc = c0 + c; return Bt + (size_t)((cc >> 7) * 256 + (cc & 127) + a * 128) * D; },
            [=](int r, int c, float g, float uu) { if (p0 + r < ne) Hb[(size_t)(ho + p0 + r) * DE + c0 + c] = (bf16)f2bf(g / (1.f + __expf(-g)) * uu); }, C.tid);
    }
}
__device__ __forceinline__ void phase_g2_naive(Ctx& C, KA AR, int l) {
    LAS int* tab = (LAS int*)(C.lds + 65536); build_exptab(C, l, tab);
    const int* rowpair = (const int*)(C.ws + WS_ROWPAIR); const float* pairw = (const float*)(C.ws + WS_PAIRW); const bf16* Hb = (const bf16*)(C.ws + WS_R2); bf16* Y2 = (bf16*)(C.ws + WS_R1);
    const int nmt = tab[64 + NE];
    for (int u = blockIdx.x; u < nmt * 16; u += gridDim.x) {
        const int mtg = u >> 4, nt = u & 15; int e = 0;
        for (int i = 1; i < NE; ++i) if (tab[64 + i] <= mtg) e = i;
        const int mt = mtg - tab[64 + e], ne = tab[e], ho = tab[32 + e], p0 = 64 * mt, c0 = 64 * nt;
        const bf16* Bt = (const bf16*)(C.ws + WS_WDN) + (size_t)(l * NE + e) * D * DE; const int* rp = rowpair + (size_t)e * CAP;
        ngemm_tile<1>((LAS float*)C.lds, DE,
            [=](int r) { return (p0 + r < ne) ? Hb + (size_t)(ho + p0 + r) * DE : (const bf16*)nullptr; },
            [=](int c, int) { return Bt + (size_t)(c0 + c) * DE; },
            [=](int r, int c, float v, float) { if (p0 + r < ne) { const int p = rp[p0 + r]; Y2[(size_t)p * D + c0 + c] = (bf16)f2bf(v * pairw[p]); } }, C.tid);
    }
}

__device__ __forceinline__ void phase_combine(Ctx& C, KA AR, int l) {
    float* X = (float*)(C.ws + WS_X); const bf16* Y2 = (const bf16*)(C.ws + WS_R1); bf16* xn = (bf16*)(C.ws + WS_XN); const float* gain = AR->in[I_PLEN] + l * D;
    for (int t = 2 * C.gw; t < T; t += 2 * C.ngw) {
        f32x4 v[2][4]; v2u ya[2][4], yb[2][4];
#pragma unroll
        for (int q = 0; q < 2; ++q) { load_row(X + (size_t)(t + q) * D, C.lane, v[q]);
#pragma unroll
            for (int j = 0; j < 4; ++j) { ya[q][j] = *((const v2u*)(Y2 + (size_t)(2 * (t + q)) * D) + C.lane + 64 * j); yb[q][j] = *((const v2u*)(Y2 + (size_t)(2 * (t + q) + 1) * D) + C.lane + 64 * j); } }
#pragma unroll
        for (int q = 0; q < 2; ++q) {
#pragma unroll
            for (int j = 0; j < 4; ++j) { const v2u a = ya[q][j], b = yb[q][j];
                v[q][j].x += bflo(a.x) + bflo(b.x); v[q][j].y += bfhi(a.x) + bfhi(b.x); v[q][j].z += bflo(a.y) + bflo(b.y); v[q][j].w += bfhi(a.y) + bfhi(b.y);
                *((f32x4*)(X + (size_t)(t + q) * D) + C.lane + 64 * j) = v[q][j]; }
            const float rs = row_rs(v[q]); scale_row(v[q], rs, gain, C.lane);
            store_row_bf16(xn + (size_t)(t + q) * D, C.lane, v[q]); }
    }
}

__device__ __forceinline__ void phase_proj_naive(Ctx& C, KA AR, int l) {
    const bf16* A = (const bf16*)(C.ws + WS_PB) + (size_t)l * T * PLE; const bf16* Bt = (const bf16*)(C.ws + WS_WPP) + (size_t)l * D * PLE; bf16* PR = (bf16*)(C.ws + WS_PROJ);
    for (int u = blockIdx.x; u < (T / 64) * (D / 64); u += gridDim.x) {
        const int m0 = 64 * (u / (D / 64)), n0 = 64 * (u % (D / 64));
        ngemm_tile<1>((LAS float*)C.lds, PLE, [=](int r) { return A + (size_t)(m0 + r) * PLE; }, [=](int c, int) { return Bt + (size_t)(n0 + c) * PLE; },
            [=](int r, int c, float v, float) { PR[(size_t)(m0 + r) * D + n0 + c] = (bf16)f2bf(v); }, C.tid);
    }
}
__device__ __forceinline__ void phase_ple_naive(Ctx& C, KA AR, int l) {
    const bf16* A = (const bf16*)(C.ws + WS_XN); const bf16* Bt = (const bf16*)(C.ws + WS_WPG) + (size_t)l * D * D; const bf16* PR = (const bf16*)(C.ws + WS_PROJ);
    const float* X = (const float*)(C.ws + WS_X); float* dst = l == DEPTH - 1 ? AR->out : (float*)(C.ws + WS_X); const float* bias = AR->in[I_BPG] + l * D;
    for (int u = blockIdx.x; u < (T / 64) * (D / 64); u += gridDim.x) {
        const int m0 = 64 * (u / (D / 64)), n0 = 64 * (u % (D / 64));
        ngemm_tile<1>((LAS float*)C.lds, D, [=](int r) { return A + (size_t)(m0 + r) * D; }, [=](int c, int) { return Bt + (size_t)(n0 + c) * D; },
            [=](int r, int c, float v, float) { const size_t i = (size_t)(m0 + r) * D + n0 + c; dst[i] = X[i] + bf2f(PR[i]) * sigmoidf_(v + bias[n0 + c]); }, C.tid);
    }
}

namespace pg8 {
typedef unsigned short bf16_t;
typedef short bf16x8 __attribute__((ext_vector_type(8)));
typedef unsigned u32x4 __attribute__((ext_vector_type(4)));
constexpr int BM = 256, BK = 64, HALF = 128, HTB = HALF * BK * 2, STAGE_BYTES = 8 * HTB, NXCD = 8, WGM = 8;
__device__ __forceinline__ int lds_byte(int r, int c) { const int st = (r >> 4) * 2 + (c >> 5), rr = r & 15, cc = c & 31, ob = rr * 64 + cc * 2; return st * 1024 + (ob ^ (((ob >> 9) & 1) << 5)); }
__device__ __forceinline__ void stage_rc(int b, int& R, int& C) { const int st = b / 1024, sb = b % 1024, swz = sb ^ (((sb >> 9) & 1) << 5); R = (st >> 1) * 16 + swz / 64; C = (st & 1) * 32 + (swz % 64) / 2; }
__device__ __forceinline__ int perm32(int rho) { const int n = rho >> 4, i = rho & 15; return 8 * (i >> 2) + 4 * n + (i & 3); }
struct Unit { int pm, pn, e, aux, mt; };
struct Gemm { const bf16_t* A; const bf16_t* Bt; int K; };
struct StaticOrder {
    int nM, nN, nwg, G, c;
    __device__ void init(int M, int N, int G_, int c_) { nM = M / BM; nN = N / BM; nwg = nM * nN; G = G_; c = c_; }
    __device__ bool next(int i, Unit& u) const {
        const long L = (long)i * G + c; if (L >= nwg) return false;
        int wgid = (int)L; { const int q = nwg / NXCD, r = nwg % NXCD, xcd = wgid % NXCD, off = wgid / NXCD; wgid = (xcd < r ? xcd * (q + 1) : r * (q + 1) + (xcd - r) * q) + off; }
        const int nig = WGM * nN, gid = wgid / nig, fm = gid * WGM, gsz = (nM - fm) < WGM ? (nM - fm) : WGM;
        u.pm = fm + ((wgid % nig) % gsz); u.pn = (wgid % nig) / gsz; u.e = 0; u.aux = 256; u.mt = 0; return true;
    }
    __device__ __forceinline__ const char* a_base(const Gemm& g, const Unit& u) const { return (const char*)g.A + (size_t)u.pm * 512 * g.K; }
    __device__ __forceinline__ const char* b_base(const Gemm& g, const Unit& u) const { return (const char*)g.Bt + (size_t)u.pn * 512 * g.K; }
    __device__ __forceinline__ int a_row(const Unit&, int) const { return 0; }
};
__device__ __forceinline__ unsigned cvt_pk_bf16(float lo, float hi) { unsigned r; asm volatile("v_cvt_pk_bf16_f32 %0, %1, %2" : "=v"(r) : "v"(lo), "v"(hi)); return r; }

template <class Epi, class Sched, bool ALIGN_EPI, bool GATHER>
__device__ __forceinline__ void gemm_phase(LAS unsigned char* lds, const Gemm g, const Sched& S, const Epi& E, const int tid) {
    const int wid = __builtin_amdgcn_readfirstlane(tid >> 6), lane = tid & 63, wr = wid >> 2, wc = wid & 3, fr = lane & 15, fq = lane >> 4;
    const int K = g.K, nt = K / BK;
    unsigned voffB[2];
#pragma unroll
    for (int i = 0; i < 2; ++i) { int R, C; stage_rc(tid * 16 + i * 8192, R, C); const int Rb = Epi::PERM ? ((R & ~31) + perm32(R & 31)) : R; voffB[i] = (unsigned)(Rb * K + C) * 2u; }
    const size_t kstep = (size_t)(BK * 2);
    const size_t hstep = (size_t)HALF * K * 2;
    const size_t hsA = GATHER ? 0 : hstep;
    const unsigned ldsw = (unsigned)wid * 1024u;
    const int aoff = lds_byte(wr * 64 + fr, fq * 8), boff = lds_byte(wc * 32 + fr, fq * 8);
#define PG8_SA(b, h) (((b) * 2 + (h)) * HTB)
#define PG8_SB(b, h) ((4 + (b) * 2 + (h)) * HTB)
#define PG8_STAGE(bufoff, gbase, voff) do { _Pragma("unroll") for (int _i = 0; _i < 2; ++_i) \
        __builtin_amdgcn_global_load_lds((const unsigned*)((const char*)(gbase) + (voff)[_i]), (LAS unsigned*)(lds + (bufoff) + ldsw + _i * 8192), 16, 0, 0); } while (0)
#define PG8_LDA(dst, b, h) do { _Pragma("unroll") for (int m = 0; m < 4; ++m) _Pragma("unroll") for (int k = 0; k < 2; ++k) dst[m][k] = *(const LAS bf16x8*)(lds + PG8_SA(b, h) + aoff + m * 2048 + k * 1024); } while (0)
#define PG8_LDB(dst, b, h) do { _Pragma("unroll") for (int n = 0; n < 2; ++n) _Pragma("unroll") for (int k = 0; k < 2; ++k) dst[n][k] = *(const LAS bf16x8*)(lds + PG8_SB(b, h) + boff + n * 2048 + k * 1024); } while (0)
#define PG8_MMA(ai, bj, At, Bt) do { __builtin_amdgcn_s_setprio(1); _Pragma("unroll") for (int m = 0; m < 4; ++m) _Pragma("unroll") for (int n = 0; n < 2; ++n) _Pragma("unroll") for (int k = 0; k < 2; ++k) \
        acc[ai][bj][m][n] = __builtin_amdgcn_mfma_f32_16x16x32_bf16(Bt[n][k], At[m][k], acc[ai][bj][m][n], 0, 0, 0); __builtin_amdgcn_s_setprio(0); } while (0)
#define PG8_WAIT_V(n) asm volatile("s_waitcnt vmcnt(" #n ")" ::: "memory")
#define PG8_WAIT_L(n) asm volatile("s_waitcnt lgkmcnt(" #n ")" ::: "memory")
#define PG8_BAR __builtin_amdgcn_s_barrier()
#define PG8_SCHED __builtin_amdgcn_sched_barrier(0)
#define PG8_VOFF(dst, u) do { int t_ = tid; if (GATHER) asm volatile("" : "+v"(t_));   \
        _Pragma("unroll") for (int i_ = 0; i_ < 2; ++i_) { int R_, C_; stage_rc(t_ * 16 + i_ * 8192, R_, C_); _Pragma("unroll") for (int h_ = 0; h_ < 2; ++h_) \
        dst[h_][i_] = GATHER ? (unsigned)(S.a_row(u, h_ * HALF + R_) * K + C_) * 2u : (unsigned)(R_ * K + C_) * 2u; } } while (0)
    Unit cur, nxt; int ui = 0;
    if (!S.next(0, cur)) return;
    f32x4 acc[2][2][4][2];
#pragma unroll
    for (int a = 0; a < 2; ++a)
#pragma unroll
        for (int b = 0; b < 2; ++b)
#pragma unroll
            for (int m = 0; m < 4; ++m)
#pragma unroll
                for (int n = 0; n < 2; ++n) acc[a][b][m][n] = (f32x4){0.f, 0.f, 0.f, 0.f};
    if constexpr (Epi::INIT) E.init(acc, cur, wr, wc, fr, fq);
    bf16x8 At[4][2], B0[2][2], B1[2][2];
    unsigned vC[2][2], vN[2][2], vX[2][2];
    PG8_VOFF(vC, cur);
    const char* cA = S.a_base(g, cur); const char* cB = S.b_base(g, cur);
    PG8_STAGE(PG8_SB(0, 0), cB, voffB); PG8_STAGE(PG8_SB(0, 1), cB + hstep, voffB); PG8_STAGE(PG8_SA(0, 0), cA, vC[0]); PG8_STAGE(PG8_SA(0, 1), cA + hsA, vC[1]);
    if (wr == 1) PG8_BAR;
    PG8_WAIT_V(2); PG8_BAR;
    PG8_STAGE(PG8_SB(1, 0), cB + kstep, voffB); PG8_STAGE(PG8_SA(1, 0), cA + kstep, vC[0]); PG8_STAGE(PG8_SB(1, 1), cB + hstep + kstep, voffB);
    PG8_WAIT_V(6); PG8_BAR;
    for (;;) {
        const bool has_next = S.next(ui + 1, nxt);
        const char* nA = has_next ? S.a_base(g, nxt) : cA; const char* nB = has_next ? S.b_base(g, nxt) : cB;
        if (GATHER && has_next) { PG8_VOFF(vN, nxt); }
        else {
#pragma unroll
            for (int h_ = 0; h_ < 2; ++h_)
#pragma unroll
                for (int i_ = 0; i_ < 2; ++i_) vN[h_][i_] = vC[h_][i_]; }
#pragma unroll 1
        for (int t = 0; t < nt; t += 2) {
            const bool last = (t == nt - 2);
            const char* a1 = cA + (size_t)(t + 1) * kstep;
            const char* a2 = last ? nA : cA + (size_t)(t + 2) * kstep; const char* b2 = last ? nB : cB + (size_t)(t + 2) * kstep;
            const char* a3 = a2 + kstep; const char* b3 = b2 + kstep;
#pragma unroll
            for (int h_ = 0; h_ < 2; ++h_)
#pragma unroll
                for (int i_ = 0; i_ < 2; ++i_) vX[h_][i_] = (GATHER && last) ? vN[h_][i_] : vC[h_][i_];
            PG8_LDB(B0, 0, 0); PG8_LDB(B1, 0, 1); PG8_SCHED; PG8_LDA(At, 0, 0); PG8_STAGE(PG8_SA(1, 1), a1 + hsA, vC[1]);
            PG8_WAIT_V(8); PG8_WAIT_L(0); PG8_BAR; PG8_MMA(0, 0, At, B0); PG8_MMA(0, 1, At, B1); PG8_BAR; PG8_SCHED;
            PG8_LDA(At, 0, 1); PG8_STAGE(PG8_SB(0, 0), b2, voffB); PG8_STAGE(PG8_SB(0, 1), b2 + hstep, voffB); PG8_STAGE(PG8_SA(0, 0), a2, vX[0]);
            PG8_WAIT_V(8); PG8_WAIT_L(0); PG8_BAR; PG8_MMA(1, 0, At, B0); PG8_MMA(1, 1, At, B1); PG8_BAR; PG8_SCHED;
            PG8_LDB(B0, 1, 0); PG8_LDB(B1, 1, 1); PG8_SCHED; PG8_LDA(At, 1, 0); PG8_STAGE(PG8_SA(0, 1), a2 + hsA, vX[1]);
            PG8_WAIT_V(8); PG8_WAIT_L(0); PG8_BAR; PG8_MMA(0, 0, At, B0); PG8_MMA(0, 1, At, B1); PG8_BAR; PG8_SCHED;
            PG8_LDA(At, 1, 1); PG8_STAGE(PG8_SB(1, 0), b3, voffB); PG8_STAGE(PG8_SB(1, 1), b3 + hstep, voffB); PG8_STAGE(PG8_SA(1, 0), a3, vX[0]);
            PG8_WAIT_V(8); PG8_WAIT_L(0); PG8_BAR; PG8_MMA(1, 0, At, B0); PG8_MMA(1, 1, At, B1); PG8_BAR; PG8_SCHED;
        }
        if constexpr (ALIGN_EPI) { if (wr == 0) PG8_BAR; }
        E(acc, cur, wr, wc, fr, fq);
        if (!has_next) break;
#pragma unroll
        for (int a = 0; a < 2; ++a)
#pragma unroll
            for (int b = 0; b < 2; ++b)
#pragma unroll
                for (int m = 0; m < 4; ++m)
#pragma unroll
                    for (int n = 0; n < 2; ++n) acc[a][b][m][n] = (f32x4){0.f, 0.f, 0.f, 0.f};
        if constexpr (Epi::INIT) E.init(acc, nxt, wr, wc, fr, fq);
        cur = nxt; cA = nA; cB = nB; ++ui;
#pragma unroll
        for (int h_ = 0; h_ < 2; ++h_)
#pragma unroll
            for (int i_ = 0; i_ < 2; ++i_) vC[h_][i_] = vN[h_][i_];
        if constexpr (ALIGN_EPI) { if (wr == 1) PG8_BAR; }
    }
    PG8_WAIT_V(0);
    if constexpr (!ALIGN_EPI) { if (wr == 0) PG8_BAR; }
    PG8_BAR;
#undef PG8_SA
#undef PG8_SB
#undef PG8_STAGE
#undef PG8_LDA
#undef PG8_LDB
#undef PG8_MMA
#undef PG8_WAIT_V
#undef PG8_WAIT_L
#undef PG8_BAR
#undef PG8_SCHED
#undef PG8_VOFF
}
}

__device__ __forceinline__ float gelu_fast(float v) { const float y = 0.7978845608028654f * (v + 0.044715f * v * v * v); return v * __builtin_amdgcn_rcpf(1.f + __expf(-2.f * y)); }
__device__ __forceinline__ float sigmoid_fast(float v) { return __builtin_amdgcn_rcpf(1.f + __expf(-v)); }

struct EpiZ {
    static constexpr bool PERM = true, INIT = false;
    bf16* R1; const float* gq; const float* gk;
    __device__ __forceinline__ void operator()(const f32x4 (&acc)[2][2][4][2], const pg8::Unit& u, int wr, int wc, int fr, int fq) const {
        const int seg = u.pn >> 1;
        bf16* base = R1 + (size_t)seg * T * 512 + (size_t)(u.pm * 256 + wr * 64 + fr) * 512 + (u.pn & 1) * 256 + wc * 64 + 8 * fq;
        if (seg == 2 || seg == 3) {
            const float* g = seg == 2 ? gq : gk; const float sc = seg == 2 ? C2 : 1.f;
            f32x4 gv[2][2];
#pragma unroll
            for (int bj = 0; bj < 2; ++bj)
#pragma unroll
                for (int n = 0; n < 2; ++n) gv[bj][n] = *(const f32x4*)(g + 32 * bj + 8 * fq + 4 * n);
#pragma unroll
            for (int ai = 0; ai < 2; ++ai)
#pragma unroll
                for (int m = 0; m < 4; ++m) {
                    float s = 0.f;
#pragma unroll
                    for (int bj = 0; bj < 2; ++bj)
#pragma unroll
                        for (int n = 0; n < 2; ++n) { const f32x4 x = acc[ai][bj][m][n]; s += (x[0] * x[0] + x[1] * x[1]) + (x[2] * x[2] + x[3] * x[3]); }
                    s += lane_xor<16>(s); s = half_sum32(s);
                    const float rs = rsqrtf(s * (1.f / 64.f) + EPS) * sc;
#pragma unroll
                    for (int bj = 0; bj < 2; ++bj) { const f32x4 v0 = acc[ai][bj][m][0] * rs * gv[bj][0], v1 = acc[ai][bj][m][1] * rs * gv[bj][1];
                        v4u w; w.x = pg8::cvt_pk_bf16(v0[0], v0[1]); w.y = pg8::cvt_pk_bf16(v0[2], v0[3]); w.z = pg8::cvt_pk_bf16(v1[0], v1[1]); w.w = pg8::cvt_pk_bf16(v1[2], v1[3]);
                        *(v4u*)(base + (size_t)(ai * 128 + m * 16) * 512 + 32 * bj) = w; }
                }
        } else {
#pragma unroll
            for (int ai = 0; ai < 2; ++ai)
#pragma unroll
                for (int m = 0; m < 4; ++m)
#pragma unroll
                    for (int bj = 0; bj < 2; ++bj) { f32x4 v0 = acc[ai][bj][m][0], v1 = acc[ai][bj][m][1];
                        if (seg == 1) { v0 = (f32x4){gelu_fast(v0[0]), gelu_fast(v0[1]), gelu_fast(v0[2]), gelu_fast(v0[3])}; v1 = (f32x4){gelu_fast(v1[0]), gelu_fast(v1[1]), gelu_fast(v1[2]), gelu_fast(v1[3])}; }
                        v4u w; w.x = pg8::cvt_pk_bf16(v0[0], v0[1]); w.y = pg8::cvt_pk_bf16(v0[2], v0[3]); w.z = pg8::cvt_pk_bf16(v1[0], v1[1]); w.w = pg8::cvt_pk_bf16(v1[2], v1[3]);
                        *(v4u*)(base + (size_t)(ai * 128 + m * 16) * 512 + 32 * bj) = w; }
        }
    }
};
__device__ __forceinline__ void phase_gemm1_fast(Ctx& C, KA AR, int l) {
    phase_cumsum_fast(C, AR);
    pg8::Gemm g{(const bf16*)(C.ws + WS_XN), (const bf16*)(C.ws + WS_WIN) + (size_t)l * NZ * D, D};
    pg8::StaticOrder S; S.init(T, NZ, gridDim.x, blockIdx.x);
    EpiZ E{(bf16*)(C.ws + WS_R1), AR->in[I_QN] + l * HD, AR->in[I_KN] + l * HD};
    pg8::gemm_phase<EpiZ, pg8::StaticOrder, true, false>(C.lds, g, S, E, C.tid);
}
struct EpiRes {
    static constexpr bool PERM = false, INIT = true;
    const float* xs; float* X;
    __device__ __forceinline__ void init(f32x4 (&acc)[2][2][4][2], const pg8::Unit& u, int wr, int wc, int fr, int fq) const {
        const size_t off0 = (size_t)(u.pm * 256 + wr * 64 + fr) * D + u.pn * 256 + wc * 32 + 4 * fq;
#pragma unroll
        for (int ai = 0; ai < 2; ++ai)
#pragma unroll
            for (int m = 0; m < 4; ++m)
#pragma unroll
                for (int bj = 0; bj < 2; ++bj)
#pragma unroll
                    for (int n = 0; n < 2; ++n) acc[ai][bj][m][n] = *(const f32x4*)(xs + off0 + (size_t)(ai * 128 + m * 16) * D + bj * 128 + n * 16);
    }
    __device__ __forceinline__ void operator()(const f32x4 (&acc)[2][2][4][2], const pg8::Unit& u, int wr, int wc, int fr, int fq) const {
        const size_t off0 = (size_t)(u.pm * 256 + wr * 64 + fr) * D + u.pn * 256 + wc * 32 + 4 * fq;
#pragma unroll
        for (int ai = 0; ai < 2; ++ai)
#pragma unroll
            for (int m = 0; m < 4; ++m)
#pragma unroll
                for (int bj = 0; bj < 2; ++bj)
#pragma unroll
                    for (int n = 0; n < 2; ++n) *(f32x4*)(X + off0 + (size_t)(ai * 128 + m * 16) * D + bj * 128 + n * 16) = acc[ai][bj][m][n];
    }
};
__device__ __forceinline__ void phase_wo_fast(Ctx& C, KA AR, int l) {
    pg8::Gemm g{(const bf16*)(C.ws + WS_R2 + 16 * MiB), (const bf16*)(C.ws + WS_WOUT) + (size_t)l * D * D, D};
    pg8::StaticOrder S; S.init(T, D, gridDim.x, blockIdx.x);
    EpiRes E{l == 0 ? AR->in[I_X] : (const float*)(C.ws + WS_X), (float*)(C.ws + WS_X)};
    pg8::gemm_phase<EpiRes, pg8::StaticOrder, true, false>(C.lds, g, S, E, C.tid);
}
struct EpiProj {
    static constexpr bool PERM = true, INIT = false;
    bf16* PR;
    __device__ __forceinline__ void operator()(const f32x4 (&acc)[2][2][4][2], const pg8::Unit& u, int wr, int wc, int fr, int fq) const {
        bf16* base = PR + (size_t)(u.pm * 256 + wr * 64 + fr) * D + u.pn * 256 + wc * 32 + 8 * fq;
#pragma unroll
        for (int ai = 0; ai < 2; ++ai)
#pragma unroll
            for (int m = 0; m < 4; ++m)
#pragma unroll
                for (int bj = 0; bj < 2; ++bj) { const f32x4 v0 = acc[ai][bj][m][0], v1 = acc[ai][bj][m][1];
                    v4u w; w.x = pg8::cvt_pk_bf16(v0[0], v0[1]); w.y = pg8::cvt_pk_bf16(v0[2], v0[3]); w.z = pg8::cvt_pk_bf16(v1[0], v1[1]); w.w = pg8::cvt_pk_bf16(v1[2], v1[3]);
                    *(v4u*)(base + (size_t)(ai * 128 + m * 16) * D + bj * 128) = w; }
    }
};
__device__ __forceinline__ void phase_proj_fast(Ctx& C, KA AR, int l) {
    pg8::Gemm g{(const bf16*)(C.ws + WS_PB) + (size_t)l * T * PLE, (const bf16*)(C.ws + WS_WPP) + (size_t)l * D * PLE, PLE};
    pg8::StaticOrder S;
    { const int G = gridDim.x, hb = G / 2; if ((int)blockIdx.x >= hb) S.init(T, D, G - hb, (int)blockIdx.x - hb); else S.init(T, D, G - hb, T); }
    EpiProj E{(bf16*)(C.ws + WS_PROJ)};
    pg8::gemm_phase<EpiProj, pg8::StaticOrder, true, false>(C.lds, g, S, E, C.tid);
}
struct EpiPle {
    static constexpr bool PERM = false, INIT = false;
    const float* X; const bf16* PR; const float* bias; float* dst; float pscale;
    __device__ __forceinline__ void operator()(const f32x4 (&acc)[2][2][4][2], const pg8::Unit& u, int wr, int wc, int fr, int fq) const {
        const int col0 = u.pn * 256 + wc * 32 + 4 * fq;
        const size_t off0 = (size_t)(u.pm * 256 + wr * 64 + fr) * D + col0;
        f32x4 bv[2][2];
#pragma unroll
        for (int bj = 0; bj < 2; ++bj)
#pragma unroll
            for (int n = 0; n < 2; ++n) bv[bj][n] = *(const f32x4*)(bias + col0 + bj * 128 + n * 16);
#pragma unroll
        for (int ai = 0; ai < 2; ++ai)
#pragma unroll
            for (int mh = 0; mh < 2; ++mh) { f32x4 xr[2][2][2]; v2u pr[2][2][2];
#pragma unroll
                for (int mm = 0; mm < 2; ++mm)
#pragma unroll
                    for (int bj = 0; bj < 2; ++bj)
#pragma unroll
                        for (int n = 0; n < 2; ++n) { const size_t o = off0 + (size_t)(ai * 128 + (2 * mh + mm) * 16) * D + bj * 128 + n * 16; xr[mm][bj][n] = *(const f32x4*)(X + o); pr[mm][bj][n] = *(const v2u*)(PR + o); }
#pragma unroll
                for (int mm = 0; mm < 2; ++mm)
#pragma unroll
                    for (int bj = 0; bj < 2; ++bj)
#pragma unroll
                        for (int n = 0; n < 2; ++n) { const size_t o = off0 + (size_t)(ai * 128 + (2 * mh + mm) * 16) * D + bj * 128 + n * 16;
                            const v2u pw = pr[mm][bj][n]; const f32x4 a = acc[ai][bj][2 * mh + mm][n] + bv[bj][n]; const f32x4 x = xr[mm][bj][n];
                            f32x4 r; r[0] = x[0] + bflo(pw.x) * sigmoid_fast(a[0]); r[1] = x[1] + bfhi(pw.x) * sigmoid_fast(a[1]); r[2] = x[2] + bflo(pw.y) * sigmoid_fast(a[2]); r[3] = x[3] + bfhi(pw.y) * sigmoid_fast(a[3]);
                            if (PROBE_TIMING) r = r * pscale;
                            *(f32x4*)(dst + o) = r; } }
    }
};
__device__ __forceinline__ void phase_ple_fast(Ctx& C, KA AR, int l) {
    pg8::Gemm g{(const bf16*)(C.ws + WS_XN), (const bf16*)(C.ws + WS_WPG) + (size_t)l * D * D, D};
    pg8::StaticOrder S; S.init(T, D, gridDim.x, blockIdx.x);
    float pscale = 1.f;
    if (PROBE_TIMING && l == DEPTH - 1) { const unsigned long long* ts = (const unsigned long long*)((const unsigned*)(C.ws + WS_CTL) + CW_TS); pscale = 1.f + (float)(ts[PROBE_HI] - ts[PROBE_LO]) * 1.5e-6f; }
    EpiPle E{(const float*)(C.ws + WS_X), (const bf16*)(C.ws + WS_PROJ), AR->in[I_BPG] + l * D, l == DEPTH - 1 ? AR->out : (float*)(C.ws + WS_X), pscale};
    pg8::gemm_phase<EpiPle, pg8::StaticOrder, true, false>(C.lds, g, S, E, C.tid);
}
constexpr int TAB_OFF = MISC_OFF - 4096;
struct GroupOrder {
    const LAS int* tab; int G, c; const int* rowpair; const char* hbase; bool is_g2;
    __device__ bool next(int i, pg8::Unit& u) const {
        int j = i * (G >> 3) + (c >> 3);
#pragma unroll
        for (int q = 0; q < 4; ++q) { const int e = (c & 7) + 8 * q;
            const int t0 = __builtin_amdgcn_readfirstlane(tab[64 + e]), t1 = __builtin_amdgcn_readfirstlane(tab[64 + e + 1]), nu = (t1 - t0) * 4;
            if (j < nu) { const int mt = j >> 2; const int ne = __builtin_amdgcn_readfirstlane(tab[e]), ho = __builtin_amdgcn_readfirstlane(tab[32 + e]);
                int nv = ne - 256 * mt; nv = nv > 256 ? 256 : nv;
                u.pm = ho + 256 * mt; u.pn = j & 3; u.e = e; u.aux = nv; u.mt = mt; return true; }
            j -= nu; }
        return false;
    }
    __device__ __forceinline__ const char* a_base(const pg8::Gemm& g, const pg8::Unit& u) const { return is_g2 ? (const char*)g.A + (size_t)u.pm * 2 * g.K : (const char*)g.A; }
    __device__ __forceinline__ const char* b_base(const pg8::Gemm& g, const pg8::Unit& u) const { return (const char*)g.Bt + (size_t)(u.e * 1024 + u.pn * 256) * 2 * g.K; }
    __device__ __forceinline__ int a_row(const pg8::Unit& u, int r) const { return r < u.aux ? (rowpair[(size_t)u.e * CAP + u.mt * 256 + r] >> 1) : 0; }
};
__device__ __forceinline__ void build_exptab256(Ctx& C, int l, LAS int* tab) {
    __syncthreads();
    if (C.tid < NE) { const unsigned* cnt = (const unsigned*)(C.ws + WS_CTL) + CW_CNT + 32 * CNT_STRIDE * l;
        tab[C.tid] = (int)__hip_atomic_load(cnt + C.tid * CNT_STRIDE, __ATOMIC_RELAXED, __HIP_MEMORY_SCOPE_AGENT); }
    __syncthreads();
    if (C.tid == 0) { int ho = 0, tt = 0;
        for (int e = 0; e < NE; ++e) { const int n = tab[e]; tab[32 + e] = ho; tab[64 + e] = tt;
            const int nt = (n + 255) >> 8; for (int j = 0; j < nt; ++j) tab[128 + tt + j] = e | (j << 8); ho += nt << 8; tt += nt; }
        tab[64 + NE] = tt; }
    __syncthreads();
}
struct EpiG1 {
    static constexpr bool PERM = true, INIT = false;
    bf16* Hb;
    __device__ __forceinline__ void operator()(const f32x4 (&acc)[2][2][4][2], const pg8::Unit& u, int wr, int wc, int fr, int fq) const {
        bf16* base = Hb + (size_t)(u.pm + wr * 64 + fr) * DE + u.pn * 128 + wc * 32 + 8 * fq;
#pragma unroll
        for (int ai = 0; ai < 2; ++ai)
#pragma unroll
            for (int m = 0; m < 4; ++m) { const int rl = ai * 128 + wr * 64 + m * 16 + fr;
                f32x4 h0, h1;
#pragma unroll
                for (int e = 0; e < 4; ++e) { const float g0 = acc[ai][0][m][0][e], g1 = acc[ai][0][m][1][e]; h0[e] = g0 * sigmoid_fast(g0) * acc[ai][1][m][0][e]; h1[e] = g1 * sigmoid_fast(g1) * acc[ai][1][m][1][e]; }
                v4u w; w.x = pg8::cvt_pk_bf16(h0[0], h0[1]); w.y = pg8::cvt_pk_bf16(h0[2], h0[3]); w.z = pg8::cvt_pk_bf16(h1[0], h1[1]); w.w = pg8::cvt_pk_bf16(h1[2], h1[3]);
                if (rl < u.aux) *(v4u*)(base + (size_t)(ai * 128 + m * 16) * DE) = w; }
    }
};
__device__ __forceinline__ void phase_g1_fast(Ctx& C, KA AR, int l) {
    LAS int* tab = (LAS int*)(C.lds + TAB_OFF); build_exptab256(C, l, tab);
    pg8::Gemm g{(const bf16*)(C.ws + WS_XN), (const bf16*)(C.ws + WS_WGU) + (size_t)l * NE * 1024 * D, D};
    GroupOrder S{tab, (int)gridDim.x, (int)blockIdx.x, (const int*)(C.ws + WS_ROWPAIR), nullptr, false};
    EpiG1 E{(bf16*)(C.ws + WS_R2)};
    pg8::gemm_phase<EpiG1, GroupOrder, true, true>(C.lds, g, S, E, C.tid);
}
struct EpiG2 {
    static constexpr bool PERM = true, INIT = false;
    bf16* Y2; const int* rowpair; const float* pairw;
    __device__ __forceinline__ void operator()(const f32x4 (&acc)[2][2][4][2], const pg8::Unit& u, int wr, int wc, int fr, int fq) const {
        const int* rp = rowpair + (size_t)u.e * CAP + u.mt * 256; const int col0 = u.pn * 256 + wc * 32 + 8 * fq;
        int pr[2][4]; float wv[2][4];
#pragma unroll
        for (int ai = 0; ai < 2; ++ai)
#pragma unroll
            for (int m = 0; m < 4; ++m) { const int rl = ai * 128 + wr * 64 + m * 16 + fr; pr[ai][m] = rl < u.aux ? rp[rl] : 0; }
#pragma unroll
        for (int ai = 0; ai < 2; ++ai)
#pragma unroll
            for (int m = 0; m < 4; ++m) wv[ai][m] = pairw[pr[ai][m]];
#pragma unroll
        for (int ai = 0; ai < 2; ++ai)
#pragma unroll
            for (int m = 0; m < 4; ++m) { const int rl = ai * 128 + wr * 64 + m * 16 + fr;
                if (rl < u.aux) { const float w8 = wv[ai][m]; bf16* row = Y2 + (size_t)pr[ai][m] * D + col0;
#pragma unroll
                    for (int bj = 0; bj < 2; ++bj) { const f32x4 v0 = acc[ai][bj][m][0] * w8, v1 = acc[ai][bj][m][1] * w8;
                        v4u w; w.x = pg8::cvt_pk_bf16(v0[0], v0[1]); w.y = pg8::cvt_pk_bf16(v0[2], v0[3]); w.z = pg8::cvt_pk_bf16(v1[0], v1[1]); w.w = pg8::cvt_pk_bf16(v1[2], v1[3]);
                        *(v4u*)(row + bj * 128) = w; } } }
    }
};
__device__ __forceinline__ void phase_g2_fast(Ctx& C, KA AR, int l) {
    LAS int* tab = (LAS int*)(C.lds + TAB_OFF); build_exptab256(C, l, tab);
    pg8::Gemm g{(const bf16*)(C.ws + WS_R2), (const bf16*)(C.ws + WS_WDN) + (size_t)l * NE * D * DE, DE};
    GroupOrder S{tab, (int)gridDim.x, (int)blockIdx.x, (const int*)(C.ws + WS_ROWPAIR), nullptr, true};
    EpiG2 E{(bf16*)(C.ws + WS_R1), (const int*)(C.ws + WS_ROWPAIR), (const float*)(C.ws + WS_PAIRW)};
    pg8::gemm_phase<EpiG2, GroupOrder, true, false>(C.lds, g, S, E, C.tid);
}

#define SBAR() __builtin_amdgcn_sched_barrier(0)
namespace attn_body {
using bf16=__hip_bfloat16;
using bf16x8=__attribute__((ext_vector_type(8)))short;
using s16x4=__attribute__((ext_vector_type(4)))short;
using f32x16=__attribute__((ext_vector_type(16)))float;
using u32x4=__attribute__((ext_vector_type(4)))unsigned;
constexpr int BATCH=4,NHEAD=8,SEQ=4096,D=64,DM=NHEAD*D;
constexpr int NW=8,QBLK=32,QB=QBLK*NW,KVBLK=64,NQB=SEQ/QB;
constexpr int ATTN_PITCH=DM, ATTN_UNIT_ROWS=QB;
__device__ __forceinline__ int crow(int r,int hi){return (r&3)+8*(r>>2)+4*hi;}
#define SBAR() __builtin_amdgcn_sched_barrier(0)
__device__ __forceinline__ void cmask(f32x16&p0,f32x16&p1,int jb,int qrel,int hi){
  const float NEG=-INFINITY; int kb=64*jb+4*hi;
  #pragma unroll
  for(int r=0;r<16;++r){int kv=kb+(r&3)+8*(r>>2); if(kv>qrel)p0[r]=NEG; if(kv+32>qrel)p1[r]=NEG;}
}

constexpr int NSLOT=3, SLOTB=8192;
constexpr int LDS_K=0, LDS_V=NSLOT*SLOTB, LDS_WS=2*NSLOT*SLOTB, LDS_OST=LDS_WS+NW*64*4, LDS_CK=LDS_OST+NW*4096, LDS_BYTES=LDS_CK+SEQ*4;
constexpr float C2=0.125f*1.4426950408889634f;
__device__ __forceinline__ void glds16(const void*gsrc,unsigned lds_dst){unsigned keep;
  asm volatile("s_mov_b32 %0, m0\n\ts_mov_b32 m0, %2\n\ts_nop 0\n\tglobal_load_lds_dwordx4 %1, off\n\ts_mov_b32 m0, %0":"=&s"(keep):"v"(gsrc),"s"(lds_dst):"memory");}
__device__ __forceinline__ float max3f(float a,float b,float c){float r;asm("v_max3_f32 %0, %1, %2, %3":"=v"(r):"v"(a),"v"(b),"v"(c));return r;}
__device__ __forceinline__ float max2f(float a,float b){float r;asm("v_max_f32_e32 %0, %1, %2":"=v"(r):"v"(a),"v"(b));return r;}
__device__ __forceinline__ float fadd_s(float a,float b){float r;asm("v_add_f32_e32 %0, %1, %2":"=v"(r):"v"(a),"v"(b));return r;}
__device__ __forceinline__ float fsub_s(float a,float b){float r;asm("v_sub_f32_e32 %0, %1, %2":"=v"(r):"v"(a),"v"(b));return r;}
typedef float f32x2_t __attribute__((ext_vector_type(2))); typedef __bf16 bf16x2_t __attribute__((ext_vector_type(2)));
__device__ __forceinline__ unsigned cvtpk_s(float lo,float hi){f32x2_t v={lo,hi};bf16x2_t b=__builtin_convertvector(v,bf16x2_t);return __builtin_bit_cast(unsigned,b);}
#define WAIT_BAR(N) asm volatile("s_waitcnt vmcnt(" #N ") lgkmcnt(0)\n\ts_barrier":::"memory")

__device__ __forceinline__ void qkt(f32x16&p0,f32x16&p1,const char*Kslot,const bf16x8*qr,const f32x16&negm,int r32,int hi){
  const char*kb=Kslot+hi*1024+r32*16;
  #pragma unroll
  for(int d0=0;d0<4;++d0){
    const bf16x8 b0=*reinterpret_cast<const bf16x8*>(kb+d0*2048);
    const bf16x8 b1=*reinterpret_cast<const bf16x8*>(kb+d0*2048+512);
    if(d0==0){p0=__builtin_amdgcn_mfma_f32_32x32x16_bf16(b0,qr[0],negm,0,0,0);p1=__builtin_amdgcn_mfma_f32_32x32x16_bf16(b1,qr[0],negm,0,0,0);}
    else{p0=__builtin_amdgcn_mfma_f32_32x32x16_bf16(b0,qr[d0],p0,0,0,0);p1=__builtin_amdgcn_mfma_f32_32x32x16_bf16(b1,qr[d0],p1,0,0,0);}}
}
typedef __attribute__((address_space(3))) const char* lds_cptr;
typedef short v4i16_t __attribute__((ext_vector_type(4)));
__device__ __forceinline__ void kload8(bf16x8*kf,lds_cptr kp){
  kf[0]=*(const __attribute__((address_space(3))) bf16x8*)(kp);      kf[1]=*(const __attribute__((address_space(3))) bf16x8*)(kp+512);
  kf[2]=*(const __attribute__((address_space(3))) bf16x8*)(kp+2048); kf[3]=*(const __attribute__((address_space(3))) bf16x8*)(kp+2560);
  kf[4]=*(const __attribute__((address_space(3))) bf16x8*)(kp+4096); kf[5]=*(const __attribute__((address_space(3))) bf16x8*)(kp+4608);
  kf[6]=*(const __attribute__((address_space(3))) bf16x8*)(kp+6144); kf[7]=*(const __attribute__((address_space(3))) bf16x8*)(kp+6656);
}
__device__ __forceinline__ void kload2(bf16x8*kf,lds_cptr kp,int j){ kf[2*j]=*(const __attribute__((address_space(3))) bf16x8*)(kp+j*2048); kf[2*j+1]=*(const __attribute__((address_space(3))) bf16x8*)(kp+j*2048+512); }
__device__ __forceinline__ s16x4 vtr(lds_cptr p){ return __builtin_bit_cast(s16x4,__builtin_amdgcn_ds_read_tr16_b64_v4i16((__attribute__((address_space(3))) v4i16_t*)p)); }
__device__ __forceinline__ float rowmax(const f32x16&p0,const f32x16&p1){
  float a=max3f(p0[0],p0[1],p1[0]),b=max3f(p0[2],p0[3],p1[1]);a=max3f(a,p1[2],p1[3]);
  #pragma unroll
  for(int r=4;r<16;r+=4){a=max3f(a,p0[r],p0[r+1]);b=max3f(b,p0[r+2],p0[r+3]);a=max3f(a,p1[r],p1[r+1]);b=max3f(b,p1[r+2],p1[r+3]);}
  const float m=max2f(a,b);
  auto rr=__builtin_amdgcn_permlane32_swap(__float_as_uint(m),__float_as_uint(m),false,false);
  return max2f(__uint_as_float(rr[0]),__uint_as_float(rr[1]));
}
__device__ __forceinline__ void pv(f32x16*o,int vb,bf16x8 pa0,bf16x8 pa1,bf16x8 pa2,bf16x8 pa3){
  #pragma unroll
  for(int d0=0;d0<2;++d0){s16x4 lo[4],hi[4];
    #pragma unroll
    for(int ks=0;ks<4;++ks){
      asm volatile("ds_read_b64_tr_b16 %0,%1 offset:%c2":"=&v"(lo[ks]):"v"(vb),"i"(d0*4096+ks*1024):"memory");
      asm volatile("ds_read_b64_tr_b16 %0,%1 offset:%c2":"=&v"(hi[ks]):"v"(vb),"i"(d0*4096+ks*1024+512):"memory");}
    asm volatile("s_waitcnt lgkmcnt(0)":::"memory");SBAR();
    #define PK(k) (bf16x8){lo[k][0],lo[k][1],lo[k][2],lo[k][3],hi[k][0],hi[k][1],hi[k][2],hi[k][3]}
    o[d0]=__builtin_amdgcn_mfma_f32_32x32x16_bf16(pa0,PK(0),o[d0],0,0,0);
    o[d0]=__builtin_amdgcn_mfma_f32_32x32x16_bf16(pa1,PK(1),o[d0],0,0,0);
    o[d0]=__builtin_amdgcn_mfma_f32_32x32x16_bf16(pa2,PK(2),o[d0],0,0,0);
    o[d0]=__builtin_amdgcn_mfma_f32_32x32x16_bf16(pa3,PK(3),o[d0],0,0,0);
    #undef PK
  }
}

#ifndef ATTN_STORE16
#define ATTN_STORE16(p,v) (*(u32x4*)(p)=(v))
#endif
template<int THRL> __device__ __forceinline__ void attn_unit(int b,int h,int qb,const bf16*Q,const bf16*__restrict__ K,const bf16*__restrict__ V,bf16*O,const float*__restrict__ C2K,const float thr2,char*shm,const int tid){
  const int lane=tid&63,r32=lane&31,hi=lane>>5; const int wid=__builtin_amdgcn_readfirstlane(tid>>6);
  const long rowbase=(long)b*SEQ; const int q0=qb*QB;
  const bf16*Qw=Q+(rowbase+q0+wid*QBLK)*DM+h*D;
  const int NT0=(q0+QB)/KVBLK;
  const float*ckg0=C2K+(long)(b*NHEAD+h)*SEQ; float base=ckg0[q0+(tid>>6)*QBLK+r32];
  int ts; { const float cl=lane<NT0?ckg0[KVBLK*lane+KVBLK-1]:ckg0[q0]; const unsigned long long mk=__builtin_amdgcn_ballot_w64(lane<NT0&&(ckg0[q0]-cl>=-thr2));
    ts=mk?(int)__builtin_ctzll(mk):NT0-4; ts&=~1; ts=ts>NT0-4?NT0-4:ts; ts=__builtin_amdgcn_readfirstlane(ts); }
  const int NT=NT0-ts;
  const bf16*Kh=K+(rowbase+(long)ts*KVBLK)*DM+h*D,*Vh=V+(rowbase+(long)ts*KVBLK)*DM+h*D; const float*ckg=ckg0+ts*KVBLK;
  typedef __attribute__((address_space(3))) float lds_f32; typedef float f32x4_t __attribute__((ext_vector_type(4)));
  lds_f32*const nbl=(lds_f32*)((__attribute__((address_space(3))) char*)shm+LDS_CK);
  for(int i=tid;i<NT*KVBLK;i+=NW*64)nbl[i]=-ckg[i];
  const unsigned lds0=(unsigned)(uintptr_t)shm;
  float*wsf=(float*)(shm+LDS_WS)+wid*64;
  const bf16*ksrc=Kh+(long)lane*DM+wid*8;
  const bf16*vsrc=Vh+(long)(16*(wid&3)+(lane>>2))*DM+(wid>>2)*32+(lane&3)*8;
  const unsigned kdst=lds0+LDS_K+wid*1024, vdst=lds0+LDS_V+wid*1024;
  #define DMA_K(t,slot) glds16(ksrc+(long)(t)*KVBLK*DM,(unsigned)__builtin_amdgcn_readfirstlane(kdst+(slot)))
  #define DMA_V(t,slot) glds16(vsrc+(long)(t)*KVBLK*DM,(unsigned)__builtin_amdgcn_readfirstlane(vdst+(slot)))
  const int vb0=(int)(lds0+LDS_V)+((lane>>4)&1)*32+(lane&3)*8+(4*hi+((lane&15)>>2))*64;
  const char*Kbase=shm+LDS_K; bf16x8 kf[8];
  const lds_cptr shm3=(lds_cptr)shm; const lds_cptr kp0=shm3+LDS_K+hi*1024+r32*16; const lds_cptr vp0=shm3+LDS_V+((lane>>4)&1)*32+(lane&3)*8+(4*hi+((lane&15)>>2))*64;
  DMA_K(0,0);DMA_V(0,0);DMA_K(1,SLOTB);
  bf16x8 qr[4];
  #pragma unroll
  for(int d0=0;d0<4;++d0)qr[d0]=*reinterpret_cast<const bf16x8*>(&Qw[(long)r32*DM+d0*16+hi*8]);
  float l_reg=0.f;f32x16 o[2];o[0]=f32x16{};o[1]=f32x16{};const f32x16 negm=f32x16{};
  const int qrel=wid*QBLK+r32;
  #define CMASK(P0,P1,t) do{int jb_=(t)-(NT-4); if(jb_>=0)cmask(P0,P1,jb_,qrel,hi);}while(0)
  #define KBIAS(P0,P1,t) do{ const lds_f32*nb_=nbl+64*(t)+4*hi; _Pragma("unroll") for(int g_=0;g_<4;++g_){ \
    { const f32x4_t b0_=*(const __attribute__((address_space(3))) f32x4_t*)(nb_+8*g_); _Pragma("unroll") for(int j_=0;j_<4;++j_)P0[4*g_+j_]+=(b0_[j_]+base); } SBAR(); \
    { const f32x4_t b1_=*(const __attribute__((address_space(3))) f32x4_t*)(nb_+32+8*g_); _Pragma("unroll") for(int j_=0;j_<4;++j_)P1[4*g_+j_]+=(b1_[j_]+base); } SBAR(); } }while(0)
  bool resc=false;
  #define START(P0,P1) do{ const float rm=rowmax(P0,P1); resc=false; \
    { const float dl=rm; base=fsub_s(base,dl); \
      _Pragma("unroll") for(int r=0;r<16;++r){P0[r]=fsub_s(P0[r],dl);P1[r]=fsub_s(P1[r],dl);} \
      } \
    _Pragma("unroll") for(int r=0;r<16;++r)P0[r]=__builtin_amdgcn_exp2f(P0[r]); }while(0)
  #define RESC() do{ if(resc){ asm volatile("s_waitcnt lgkmcnt(0)":::"memory"); \
      _Pragma("unroll") for(int d_=0;d_<2;++d_) _Pragma("unroll") for(int r=0;r<16;++r)o[d_][r]*=wsf[crow(r,hi)]; } }while(0)
  f32x16 pA0,pA1,pB0,pB1;
  int sl_prev=0,sl_cur=0,sl_next=SLOTB;
  #define ROT() do{sl_prev=sl_cur;sl_cur=sl_next;sl_next=(sl_next==(NSLOT-1)*SLOTB)?0:sl_next+SLOTB;}while(0)
  DMA_K(2,2*SLOTB);
  WAIT_BAR(3);
  qkt(pA0,pA1,Kbase,qr,negm,r32,hi);asm volatile("s_nop 15\n\ts_nop 7":"+v"(pA0),"+v"(pA1));KBIAS(pA0,pA1,0);CMASK(pA0,pA1,0);
  START(pA0,pA1);
  _Pragma("unroll") for(int r=0;r<16;++r)pA1[r]=__builtin_amdgcn_exp2f(pA1[r]);
  WAIT_BAR(0);
  DMA_K(3,0);DMA_V(1,SLOTB);
  ROT();
  kload8(kf,kp0+sl_cur);
  WAIT_BAR(2);
  s16x4 vlo[8],vhi[8]; u32x4 pw0,pw1,pw2,pw3;
  #define PKW(P,B) cvtpk_s(P[B],P[B+1])
  #define PAF(k) __builtin_bit_cast(bf16x8,pw##k)
  #define VFR(i) (bf16x8){vlo[i][0],vlo[i][1],vlo[i][2],vlo[i][3],vhi[i][0],vhi[i][1],vhi[i][2],vhi[i][3]}
  #define PIN(x) asm volatile("":"+v"(x))
  #define MX3(a,b,c) __builtin_fmaxf(__builtin_fmaxf((a),(b)),(c))
  #define GAPA(MF,A0,A1,A2,A3,W0,W1,PW) do{ MF; sacc+=A0; sacc+=A1; sacc+=A2; sacc+=A3; PIN(sacc); W0; W1; PIN(PW); SBAR(); }while(0)
  #define EX(v) __builtin_amdgcn_exp2f(v)
  #define GAPB(MF,X,B) do{ MF; X[B]=EX(X[B]); X[B+1]=EX(X[B+1]); X[B+2]=EX(X[B+2]); X[B+3]=EX(X[B+3]); PIN(X); SBAR(); }while(0)
  #define VRD(i) do{ vlo[i]=vtr(vp_+(((i)>>2)*4096+((i)&3)*1024)); vhi[i]=vtr(vp_+(((i)>>2)*4096+((i)&3)*1024+512)); }while(0)
  #define KRD(G,j) do{ if(G){ kload2(kf,kp0+sl_next,j); SBAR(); } }while(0)
  #define STEP(C0,C1,P0,P1,t,GK,GV,GL) do{ SBAR(); \
    const lds_cptr vp_=vp0+sl_prev; \
    VRD(0); SBAR(); float sacc=(P0[0]+P0[1]); \
    GAPA(C0=__builtin_amdgcn_mfma_f32_32x32x16_bf16(kf[0],qr[0],negm,0,0,0), P0[2],P0[3],P0[4],P0[5],     pw0[0]=PKW(P0,0), pw0[1]=PKW(P0,2), pw0); \
    VRD(4); SBAR(); GAPA(C1=__builtin_amdgcn_mfma_f32_32x32x16_bf16(kf[1],qr[0],negm,0,0,0), P0[6],P0[7],P0[8],P0[9],     pw0[2]=PKW(P0,4), pw0[3]=PKW(P0,6), pw0); \
    VRD(1); SBAR(); GAPA(C0=__builtin_amdgcn_mfma_f32_32x32x16_bf16(kf[2],qr[1],C0,0,0,0),   P0[10],P0[11],P0[12],P0[13], pw1[0]=PKW(P0,8), pw1[1]=PKW(P0,10), pw1); \
    VRD(5); SBAR(); GAPA(C1=__builtin_amdgcn_mfma_f32_32x32x16_bf16(kf[3],qr[1],C1,0,0,0),   P0[14],P0[15],P1[0],P1[1],   pw1[2]=PKW(P0,12),pw1[3]=PKW(P0,14), pw1); \
    VRD(2); SBAR(); GAPA(C0=__builtin_amdgcn_mfma_f32_32x32x16_bf16(kf[4],qr[2],C0,0,0,0),   P1[2],P1[3],P1[4],P1[5],     pw2[0]=PKW(P1,0), pw2[1]=PKW(P1,2), pw2); \
    VRD(6); SBAR(); GAPA(C1=__builtin_amdgcn_mfma_f32_32x32x16_bf16(kf[5],qr[2],C1,0,0,0),   P1[6],P1[7],P1[8],P1[9],     pw2[2]=PKW(P1,4), pw2[3]=PKW(P1,6), pw2); \
    VRD(3); SBAR(); GAPA(C0=__builtin_amdgcn_mfma_f32_32x32x16_bf16(kf[6],qr[3],C0,0,0,0),   P1[10],P1[11],P1[12],P1[13], pw3[0]=PKW(P1,8), pw3[1]=PKW(P1,10), pw3); \
    VRD(7); SBAR(); GAPA(C1=__builtin_amdgcn_mfma_f32_32x32x16_bf16(kf[7],qr[3],C1,0,0,0),   P1[14],P1[15],0.f,0.f,       pw3[2]=PKW(P1,12),pw3[3]=PKW(P1,14), pw3); \
    l_reg+=sacc; \
    if(GK){DMA_K((t)+3,sl_cur);} if(GV){DMA_V((t)+1,sl_next);} \
    KBIAS(C0,C1,t); \
    CMASK(C0,C1,t); \
    { float a=MX3(C0[0],C0[1],C1[0]),b=MX3(C0[2],C0[3],C1[1]); a=MX3(a,C1[2],C1[3]); \
      _Pragma("unroll") for(int r=4;r<16;r+=4){a=MX3(a,C0[r],C0[r+1]);b=MX3(b,C0[r+2],C0[r+3]);a=MX3(a,C1[r],C1[r+1]);b=MX3(b,C1[r+2],C1[r+3]);} \
      float rm=__builtin_fmaxf(a,b); { auto rr=__builtin_amdgcn_permlane32_swap(__float_as_uint(rm),__float_as_uint(rm),false,false); rm=__builtin_fmaxf(__uint_as_float(rr[0]),__uint_as_float(rr[1])); } \
      resc=false; \
      if(__builtin_expect(__any(rm>(float)THRL),0)){ const float dl=__builtin_fmaxf(rm,0.f); base-=dl; \
        _Pragma("unroll") for(int r=0;r<16;++r){C0[r]-=dl;C1[r]-=dl;} \
        const float f=__builtin_amdgcn_exp2f(-dl); l_reg*=f; if(hi==0)wsf[r32]=f; resc=true; } } \
    SBAR(); \
    GAPB(o[0]=__builtin_amdgcn_mfma_f32_32x32x16_bf16(PAF(0),VFR(0),o[0],0,0,0), C0,0); \
    GAPB(o[1]=__builtin_amdgcn_mfma_f32_32x32x16_bf16(PAF(0),VFR(4),o[1],0,0,0), C0,4); \
    KRD(GL,0); GAPB(o[0]=__builtin_amdgcn_mfma_f32_32x32x16_bf16(PAF(1),VFR(1),o[0],0,0,0), C0,8); \
    KRD(GL,1); GAPB(o[1]=__builtin_amdgcn_mfma_f32_32x32x16_bf16(PAF(1),VFR(5),o[1],0,0,0), C0,12); \
    KRD(GL,2); GAPB(o[0]=__builtin_amdgcn_mfma_f32_32x32x16_bf16(PAF(2),VFR(2),o[0],0,0,0), C1,0); \
    KRD(GL,3); GAPB(o[1]=__builtin_amdgcn_mfma_f32_32x32x16_bf16(PAF(2),VFR(6),o[1],0,0,0), C1,4); \
    GAPB(o[0]=__builtin_amdgcn_mfma_f32_32x32x16_bf16(PAF(3),VFR(3),o[0],0,0,0), C1,8); \
    GAPB(o[1]=__builtin_amdgcn_mfma_f32_32x32x16_bf16(PAF(3),VFR(7),o[1],0,0,0), C1,12); \
    }while(0)
  int t=1;
  #undef CMASK
  #define CMASK(P0,P1,t) do{}while(0)
  for(;t+5<NT;t+=2){
    STEP(pB0,pB1,pA0,pA1,t,true,true,true);     WAIT_BAR(2); RESC(); ROT();
    STEP(pA0,pA1,pB0,pB1,t+1,true,true,true);   WAIT_BAR(2); RESC(); ROT();
  }
  #undef CMASK
  #define CMASK(P0,P1,t) do{int jb_=(t)-(NT-4); if(jb_>=0)cmask(P0,P1,jb_,qrel,hi);}while(0)
  #define ENDW(tt) do{ if((tt)+3<NT){WAIT_BAR(2);} else if((tt)+2<NT){WAIT_BAR(1);} else {WAIT_BAR(0);} }while(0)
  for(;t+1<NT;t+=2){
    STEP(pB0,pB1,pA0,pA1,t,(t+3<NT),(t+1<NT),(t+1<NT));       ENDW(t);   RESC(); ROT();
    STEP(pA0,pA1,pB0,pB1,t+1,(t+4<NT),(t+2<NT),(t+2<NT));     ENDW(t+1); RESC(); ROT();
  }
  STEP(pB0,pB1,pA0,pA1,NT-1,false,false,false); RESC();
  { float sacc=pB0[0]+pB0[1]; _Pragma("unroll") for(int r=2;r<16;++r)sacc+=pB0[r]; _Pragma("unroll") for(int r=0;r<16;++r)sacc+=pB1[r]; l_reg+=sacc;
    pw0=(u32x4){PKW(pB0,0),PKW(pB0,2),PKW(pB0,4),PKW(pB0,6)};pw1=(u32x4){PKW(pB0,8),PKW(pB0,10),PKW(pB0,12),PKW(pB0,14)};pw2=(u32x4){PKW(pB1,0),PKW(pB1,2),PKW(pB1,4),PKW(pB1,6)};pw3=(u32x4){PKW(pB1,8),PKW(pB1,10),PKW(pB1,12),PKW(pB1,14)};
    SBAR(); pv(o,vb0+sl_cur,PAF(0),PAF(1),PAF(2),PAF(3)); }
  #undef PKW
  #undef PAF
  #undef VFR
  #undef PIN
  #undef MX3
  #undef GAPA
  #undef GAPB
  #undef EX
  #undef VRD
  #undef KRD
  #undef STEP
  #undef ENDW
  {auto rr=__builtin_amdgcn_permlane32_swap(__float_as_uint(l_reg),__float_as_uint(l_reg),false,false);l_reg=__uint_as_float(rr[0])+__uint_as_float(rr[1]);}
  if(hi==0)wsf[32+r32]=l_reg;asm volatile("s_waitcnt lgkmcnt(0)":::"memory");
  float rli[16];
  #pragma unroll
  for(int r=0;r<16;++r)rli[r]=__builtin_amdgcn_rcpf(wsf[32+crow(r,hi)]);
  bf16*Ow=O+(rowbase+q0+wid*QBLK)*DM+h*D;
  { bf16*stg=(bf16*)(shm+LDS_OST)+wid*2048;
    #pragma unroll
    for(int r=0;r<16;++r){const int orow=crow(r,hi);
      #pragma unroll
      for(int d0=0;d0<2;++d0)stg[orow*64+d0*32+r32]=__float2bfloat16(o[d0][r]*rli[r]);}
    asm volatile("s_waitcnt lgkmcnt(0)":::"memory");
    #pragma unroll
    for(int i=0;i<4;++i){const int row=i*8+(lane>>3),ch=lane&7; const u32x4 v=*(const u32x4*)(stg+row*64+ch*8); ATTN_STORE16(Ow+(long)row*DM+ch*8,v);} }
  asm volatile("s_waitcnt lgkmcnt(0)\n\ts_barrier":::"memory");
  #undef DMA_K
  #undef DMA_V
  #undef CMASK
  #undef KBIAS
  #undef START
  #undef RESC
  #undef ROT
}
constexpr int ATTN_LDS_BYTES=LDS_BYTES;
struct AttnTensors { const bf16* Q; const bf16* K; const bf16* V; bf16* O; const float* C2K; float thr2; };
struct AttnUnit { int bh; int qb; };
struct StaticOrder {
  int vcu;
  __device__ __forceinline__ explicit StaticOrder(int grid,int block):vcu((block%8)*(grid/8)+block/8){}
  __device__ __forceinline__ bool next(int i,AttnUnit&u)const{ if(i>=2||vcu>=256)return false; const int s=vcu&7; u.bh=vcu>>3; u.qb=(i==0)?s:15-s; return true; }
  __device__ __forceinline__ void a_ready(const AttnUnit&)const{}
  __device__ __forceinline__ void done(const AttnUnit&)const{}
};
template<class Sched,int THRL=8> __device__ __forceinline__ void attn_phase(char*lds,const AttnTensors&T,const Sched&S,const int tid){
  AttnUnit u;
  for(int i=0;S.next(i,u);++i){ S.a_ready(u); attn_unit<THRL>(u.bh/NHEAD,u.bh%NHEAD,u.qb,T.Q,T.K,T.V,T.O,T.C2K,T.thr2,lds,tid); S.done(u); }
}
#undef SBAR
#undef WAIT_BAR
}
__device__ __forceinline__ void phase_attn_fast(Ctx& C, KA AR, int l, char* ldsg) {
    const attn_body::bf16* Q = (const attn_body::bf16*)(C.ws + WS_R1) + (size_t)2 * T * 512;
    const float bq = 64.f * C2 * wave_max(fabsf(AR->in[I_QN][l * HD + C.lane])) * wave_max(fabsf(AR->in[I_KN][l * HD + C.lane]));
    const attn_body::AttnTensors AT{Q, Q + (size_t)T * 512, Q + (size_t)2 * T * 512, (attn_body::bf16*)(C.ws + WS_R2), (const float*)(C.ws + WS_C2K), 2.f * bq + 40.f};
    unsigned* qctr = (unsigned*)(C.ws + WS_CTL) + CW_ATT + 64 * l;
    volatile LAS unsigned* slot = (volatile LAS unsigned*)(C.lds + MISC_OFF) + 16;
    for (;;) {
        __syncthreads();
        if (C.tid == 0) slot[0] = atomicAdd(qctr, 1u);
        __syncthreads();
        const int idx = __builtin_amdgcn_readfirstlane((int)slot[0]);
        if (idx >= NB * NH * 16) break;
        const int qb = 15 - (idx >> 5), bh = idx & 31;
        attn_body::attn_unit<8>(bh >> 3, bh & 7, qb, AT.Q, AT.K, AT.V, AT.O, AT.C2K, AT.thr2, ldsg, C.tid);
    }
}

constexpr int RCH = 32, NCH = S / RCH;
__device__ __forceinline__ float one_minus_sq_exp(float la, float a) {
    const float x = 2.f * la;
    float p = 1.f / 5040.f; p = p * x + 1.f / 720.f; p = p * x + 1.f / 120.f; p = p * x + 1.f / 24.f; p = p * x + 1.f / 6.f; p = p * x + 0.5f; p = p * x + 1.f; p = -(p * x);
    return x > -0.25f ? p : 1.f - a * a;
}
template <int MODE>
__device__ __forceinline__ void phase_rnn_fast(Ctx& C, KA AR, int l) {
    typedef short bf16x8 __attribute__((ext_vector_type(8)));
    const int blk = C.wave, lane = C.lane, fr = lane & 15, fq = lane >> 4;
    LAS float* Ab = (LAS float*)C.lds + C.wave * 4096; LAS float* Ub = Ab + 2048;
    LAS float* SS = (LAS float*)(C.lds + TAB_OFF); LAS float* RSW = SS + 256 + C.wave * 32;
    const bf16* ZX = (const bf16*)(C.ws + WS_R1); const bf16* ZG = ZX + (size_t)T * 512;
    float* SA = (float*)(C.ws + WS_SA); float* SH = (float*)(C.ws + WS_SH);
    const bf16* O = (const bf16*)(C.ws + WS_R2); bf16* YM = (bf16*)(C.ws + WS_R2 + 16 * MiB);
    const float* cw = AR->in[I_CONVW] + l * 4 * DR; const float* cb = AR->in[I_CONVB] + l * DR;
    const float* wr = AR->in[I_WR] + (size_t)(l * 8 + blk) * 64 * 64; const float* wi = AR->in[I_WI] + (size_t)(l * 8 + blk) * 64 * 64;
    bf16x8 Br[4][2], Bi[4][2]; float brj[4], bij[4], spj[4];
    { float lm[4];
#pragma unroll
      for (int n = 0; n < 4; ++n) { const int ch = blk * 64 + n * 16 + fr; brj[n] = AR->in[I_BR][l * DR + ch]; bij[n] = AR->in[I_BI][l * DR + ch]; lm[n] = AR->in[I_LAM][l * DR + ch]; }
#pragma unroll
      for (int n = 0; n < 4; ++n) { const float e = __expf(-lm[n]); spj[n] = e < 1e-3f ? e * (1.f - 0.5f * e + 0.33333334f * e * e) : __logf(1.f + e); } }
#pragma unroll
    for (int g = 0; g < 2; ++g) { const float* wsrc = g == 0 ? wr : wi; f32x4 t[16];
#pragma unroll
        for (int i = 0; i < 16; ++i) t[i] = *(const f32x4*)(wsrc + 4 * (lane + 64 * i));
#pragma unroll
        for (int i = 0; i < 16; ++i) *(LAS f32x4*)(Ab + 4 * (lane + 64 * i)) = t[i];
        asm volatile("s_waitcnt lgkmcnt(0)" ::: "memory");
#pragma unroll
        for (int n = 0; n < 4; ++n)
#pragma unroll
            for (int ks = 0; ks < 2; ++ks)
#pragma unroll
                for (int e = 0; e < 8; ++e) { const short v = (short)f2bf(Ab[(ks * 32 + fq * 8 + e) * 64 + n * 16 + fr]); if (g == 0) Br[n][ks][e] = v; else Bi[n][ks][e] = v; }
        asm volatile("s_waitcnt lgkmcnt(0)" ::: "memory"); }
    for (int u = blockIdx.x; u < NB * NCH; u += gridDim.x) {
        const int b = u / NCH; int c = u % NCH; if (MODE == 1 && ((u / (int)gridDim.x) & 1)) c = NCH - 1 - c;
        const int t0 = c * RCH;
        if (MODE == 1) __syncthreads();
        bf16x8 Af[2][2];
#pragma unroll
        for (int ks = 0; ks < 2; ++ks) {
            const int ch0 = blk * 64 + ks * 32 + fq * 8;
            f32x4 w[4][2], bb[2];
#pragma unroll
            for (int j = 0; j < 4; ++j) { w[j][0] = *(const f32x4*)(cw + j * DR + ch0); w[j][1] = *(const f32x4*)(cw + j * DR + ch0 + 4); }
            bb[0] = *(const f32x4*)(cb + ch0); bb[1] = *(const f32x4*)(cb + ch0 + 4);
#pragma unroll
            for (int m = 0; m < 2; ++m) {
                const int tok = m * 16 + fr, tg = t0 + tok;
                f32x4 x0 = bb[0], x1 = bb[1]; v4u zz[4];
#pragma unroll
                for (int j = 0; j < 4; ++j) { const int tt = tg - 3 + j; zz[j] = *(const v4u*)(ZX + (size_t)(b * S + (tt < 0 ? 0 : tt)) * 512 + ch0); }
#pragma unroll
                for (int j = 0; j < 4; ++j) { const float ok = (tg - 3 + j) >= 0 ? 1.f : 0.f; const v4u z = zz[j]; const f32x4 wa = w[j][0] * ok, wb = w[j][1] * ok;
                        x0[0] += wa[0] * bflo(z.x); x0[1] += wa[1] * bfhi(z.x); x0[2] += wa[2] * bflo(z.y); x0[3] += wa[3] * bfhi(z.y);
                        x1[0] += wb[0] * bflo(z.z); x1[1] += wb[1] * bfhi(z.z); x1[2] += wb[2] * bflo(z.w); x1[3] += wb[3] * bfhi(z.w); }
                *(LAS f32x4*)(Ub + tok * 64 + ks * 32 + fq * 8) = x0; *(LAS f32x4*)(Ub + tok * 64 + ks * 32 + fq * 8 + 4) = x1;
                v4u pk; pk.x = pk2(x0[0], x0[1]); pk.y = pk2(x0[2], x0[3]); pk.z = pk2(x1[0], x1[1]); pk.w = pk2(x1[2], x1[3]);
                Af[m][ks] = __builtin_bit_cast(bf16x8, pk);
            }
        }
        f32x4 aR[2][4], aI[2][4];
#pragma unroll
        for (int m = 0; m < 2; ++m)
#pragma unroll
            for (int n = 0; n < 4; ++n) { aR[m][n] = (f32x4){0.f, 0.f, 0.f, 0.f}; aI[m][n] = (f32x4){0.f, 0.f, 0.f, 0.f};
#pragma unroll
                for (int ks = 0; ks < 2; ++ks) { aR[m][n] = __builtin_amdgcn_mfma_f32_16x16x32_bf16(Af[m][ks], Br[n][ks], aR[m][n], 0, 0, 0); aI[m][n] = __builtin_amdgcn_mfma_f32_16x16x32_bf16(Af[m][ks], Bi[n][ks], aI[m][n], 0, 0, 0); } }
        asm volatile("s_waitcnt lgkmcnt(0)" ::: "memory");
#pragma unroll
        for (int m = 0; m < 2; ++m)
#pragma unroll
            for (int n = 0; n < 4; ++n)
#pragma unroll
                for (int i = 0; i < 4; ++i) { const int idx = (m * 16 + 4 * fq + i) * 64 + n * 16 + fr;
                    const float xcv = Ub[idx], r = sigmoid_fast(aR[m][n][i] + brj[n]), ig = sigmoid_fast(aI[m][n][i] + bij[n]);
                    const float la = -8.f * r * spj[n], a = __expf(la);
                    Ab[idx] = a; Ub[idx] = sqrtf(one_minus_sq_exp(la, a)) * (ig * xcv); }
        asm volatile("s_waitcnt lgkmcnt(0)" ::: "memory");
        const int ch = blk * 64 + lane;
        if (MODE == 0) { float At = 1.f, h = 0.f;
#pragma unroll 8
            for (int t = 0; t < RCH; ++t) { const float a = Ab[t * 64 + lane]; h = a * h + Ub[t * 64 + lane]; At *= a; }
            SA[(size_t)(b * NCH + c) * 512 + ch] = At; SH[(size_t)(b * NCH + c) * 512 + ch] = h;
        } else {
            float h = 0.f;
            { const float* sa = SA + (size_t)b * NCH * 512 + ch; const float* sh = SH + (size_t)b * NCH * 512 + ch; int c2 = 0;
              for (; c2 + 32 <= c; c2 += 32) { float a8[32], h8[32];
#pragma unroll
                  for (int q = 0; q < 32; ++q) { a8[q] = sa[(size_t)(c2 + q) * 512]; h8[q] = sh[(size_t)(c2 + q) * 512]; }
#pragma unroll
                  for (int q = 0; q < 32; ++q) h = a8[q] * h + h8[q]; }
              for (; c2 + 8 <= c; c2 += 8) { float a8[8], h8[8];
#pragma unroll
                  for (int q = 0; q < 8; ++q) { a8[q] = sa[(size_t)(c2 + q) * 512]; h8[q] = sh[(size_t)(c2 + q) * 512]; }
#pragma unroll
                  for (int q = 0; q < 8; ++q) h = a8[q] * h + h8[q]; }
              for (; c2 < c; ++c2) h = sa[(size_t)c2 * 512] * h + sh[(size_t)c2 * 512]; }
            const bf16* zg = ZG + (size_t)(b * S + t0) * 512 + ch;
#pragma unroll 8
            for (int t = 0; t < RCH; ++t) { h = Ab[t * 64 + lane] * h + Ub[t * 64 + lane]; Ab[t * 64 + lane] = h * bf2f(zg[(size_t)t * 512]); }
            asm volatile("s_waitcnt lgkmcnt(0)" ::: "memory");
            { const int t = lane & 31, hf = lane >> 5; float s = 0.f;
#pragma unroll 8
              for (int k = 0; k < 32; ++k) { const float y = Ab[t * 64 + hf * 32 + ((k + t) & 31)]; s += y * y; }
              s = half_sum32(s); if (lane < 32) SS[C.wave * 32 + lane] = s; }
            __syncthreads();
            { const int t = lane & 31; float tot = 0.f;
#pragma unroll
              for (int w8 = 0; w8 < 8; ++w8) tot += SS[w8 * 32 + t];
              RSW[t] = rsqrtf(tot * (1.f / 512.f) + EPS); }
            asm volatile("s_waitcnt lgkmcnt(0)" ::: "memory");
            { const int oct = lane & 7; const float* g1 = AR->in[I_LRUN] + l * DR + blk * 64 + oct * 8; const f32x4 ga = *(const f32x4*)g1, gb = *(const f32x4*)(g1 + 4);
#pragma unroll
              for (int q = 0; q < 4; ++q) { const int t = q * 8 + (lane >> 3); const float rs = RSW[t];
                  const f32x4 y0 = *(const LAS f32x4*)(Ab + t * 64 + oct * 8) * rs * ga, y1 = *(const LAS f32x4*)(Ab + t * 64 + oct * 8 + 4) * rs * gb;
                  v4u pk; pk.x = pk2(y0[0], y0[1]); pk.y = pk2(y0[2], y0[3]); pk.z = pk2(y1[0], y1[1]); pk.w = pk2(y1[2], y1[3]);
                  *(v4u*)(YM + (size_t)(b * S + t0 + t) * D + blk * 64 + oct * 8) = pk; } }
            { const float* g2 = AR->in[I_ATTN] + l * DA + 8 * lane; const f32x4 ga = *(const f32x4*)g2, gb = *(const f32x4*)(g2 + 4);
              const size_t row0 = (size_t)(b * S + t0 + C.wave * 4); v4u w4[4];
#pragma unroll
              for (int q = 0; q < 4; ++q) w4[q] = *(const v4u*)(O + (row0 + q) * 512 + 8 * lane);
#pragma unroll
              for (int q = 0; q < 4; ++q) { const v4u w = w4[q];
                  f32x4 x0 = {bflo(w.x), bfhi(w.x), bflo(w.y), bfhi(w.y)}, x1 = {bflo(w.z), bfhi(w.z), bflo(w.w), bfhi(w.w)};
                  float s = (x0[0] * x0[0] + x0[1] * x0[1]) + (x0[2] * x0[2] + x0[3] * x0[3]) + (x1[0] * x1[0] + x1[1] * x1[1]) + (x1[2] * x1[2] + x1[3] * x1[3]);
                  const float rs = rsqrtf(wave_sum(s) * (1.f / 512.f) + EPS);
                  x0 = x0 * rs * ga; x1 = x1 * rs * gb;
                  v4u pk; pk.x = pk2(x0[0], x0[1]); pk.y = pk2(x0[2], x0[3]); pk.z = pk2(x1[0], x1[1]); pk.w = pk2(x1[2], x1[3]);
                  *(v4u*)(YM + (row0 + q) * D + 512 + 8 * lane) = pk; } }
        }
    }
}

template <int NT, class WF>
__device__ __forceinline__ void norm_proj_tile(const float* X, const float* gain, bf16* xn, int t0, WF wf, LAS float* Lw, int lane, int kh) {
    const int fr = lane & 15, fq = lane >> 4;
    f32x4 acc[NT];
#pragma unroll
    for (int n = 0; n < NT; ++n) acc[n] = (f32x4){0.f, 0.f, 0.f, 0.f};
    float ssq = 0.f;
    const float* xr = X + (size_t)(t0 + fr) * D + 4 * fq; const float* gr = gain + 4 * fq;
    for (int sb = 2 * kh; sb < 2 * kh + 2; ++sb) {
        f32x4 xv[16];
#pragma unroll
        for (int i = 0; i < 16; ++i) xv[i] = *(const f32x4*)(xr + 16 * (16 * sb + i));
#pragma unroll
        for (int i = 0; i < 16; ++i) { const int s = 16 * sb + i; const f32x4 gv = *(const f32x4*)(gr + 16 * s);
            ssq += (xv[i][0] * xv[i][0] + xv[i][1] * xv[i][1]) + (xv[i][2] * xv[i][2] + xv[i][3] * xv[i][3]);
            const f32x4 xg = xv[i] * gv;
#pragma unroll
            for (int e = 0; e < 4; ++e)
#pragma unroll
                for (int n = 0; n < NT; ++n) acc[n] = __builtin_amdgcn_mfma_f32_16x16x4f32(wf(n, 16 * s + 4 * fq + e, fr), xg[e], acc[n], 0, 0, 0); }
    }
    constexpr int PW = 4 * NT + 1;
    if (kh == 1) {
#pragma unroll
        for (int n = 0; n < NT; ++n)
#pragma unroll
            for (int r = 0; r < 4; ++r) Lw[lane * PW + 4 * n + r] = acc[n][r];
        Lw[lane * PW + 4 * NT] = ssq;
    }
    __syncthreads();
    if (kh == 0) {
#pragma unroll
        for (int n = 0; n < NT; ++n)
#pragma unroll
            for (int r = 0; r < 4; ++r) acc[n][r] += Lw[lane * PW + 4 * n + r];
        ssq += Lw[lane * PW + 4 * NT];
        ssq += lane_xor<16>(ssq); ssq = half_sum32(ssq);
        const float rs = rsqrtf(ssq * (1.f / D) + EPS);
        asm volatile("s_waitcnt lgkmcnt(0)" ::: "memory");
#pragma unroll
        for (int n = 0; n < NT; ++n)
#pragma unroll
            for (int r = 0; r < 4; ++r) Lw[fr * (16 * NT) + 16 * n + 4 * fq + r] = acc[n][r] * rs;
        if (lane < 16) Lw[16 * 16 * NT + lane] = rs;
    }
    __syncthreads();
#pragma unroll
    for (int q4 = 0; q4 < 8; q4 += 4) { f32x4 v[4][4];
#pragma unroll
        for (int q = 0; q < 4; ++q) load_row(X + (size_t)(t0 + 8 * kh + q4 + q) * D, lane, v[q]);
#pragma unroll
        for (int q = 0; q < 4; ++q) { const int tok = 8 * kh + q4 + q; const float rst = Lw[16 * 16 * NT + tok]; scale_row(v[q], rst, gain, lane); store_row_bf16(xn + (size_t)(t0 + tok) * D, lane, v[q]); } }
}
__device__ __forceinline__ void phase_norm1_fast(Ctx& C, KA AR, int l) {
    const float* xs = l == 0 ? AR->in[I_X] : (const float*)(C.ws + WS_X);
    const float* gain = AR->in[I_MIXN] + l * D; const float* wf = AR->in[I_WIN] + (size_t)l * D * DIN + NZ; const float* bfg = AR->in[I_BF] + l * NH;
    bf16* xn = (bf16*)(C.ws + WS_XN); float* logf = (float*)(C.ws + WS_LOGF);
    LAS float* Wl = (LAS float*)C.lds; LAS float* Lw = (LAS float*)(C.lds + 32768 + 1024) + (C.wave & 3) * 1024; const int kh = C.wave >> 2;
    { f32x4 t[4];
#pragma unroll
      for (int j = 0; j < 4; ++j) { const int i = C.tid + 512 * j; t[j] = *(const f32x4*)(wf + (size_t)(i >> 1) * DIN + 4 * (i & 1)); }
#pragma unroll
      for (int j = 0; j < 4; ++j) *(LAS f32x4*)(Wl + 4 * (C.tid + 512 * j)) = t[j]; }
    if (C.tid < 8) Wl[D * 8 + C.tid] = 0.f;
    __syncthreads();
        for (int tile = blockIdx.x * 4 + (C.wave & 3); tile < T / 16; tile += gridDim.x * 4) {
            const int t0 = 16 * tile;
            __syncthreads();
            norm_proj_tile<1>(xs, gain, xn, t0, [=](int, int k, int i) { return Wl[k * 8 + i]; }, Lw, C.lane, kh);
            if (kh == 0) {
            const int tok = C.lane & 15, h0 = (C.lane >> 4) * 2;
            { const int r = t0 + tok, bb = r / S, tt = r % S;
              logf[(size_t)(bb * NH + h0) * S + tt] = log_sigmoid(Lw[tok * 16 + h0] + bfg[h0]); logf[(size_t)(bb * NH + h0 + 1) * S + tt] = log_sigmoid(Lw[tok * 16 + h0 + 1] + bfg[h0 + 1]); }
            }
            asm volatile("s_waitcnt lgkmcnt(0)" ::: "memory");
        }
}
__device__ __forceinline__ void phase_router_fast(Ctx& C, KA AR, int l) {
    const float* X = (const float*)(C.ws + WS_X); bf16* xn = (bf16*)(C.ws + WS_XN);
    const float* gain = AR->in[I_FFNN] + l * D; const float* wg = AR->in[I_WG] + (size_t)l * D * 4; const float* bg = AR->in[I_BG] + l * 4;
    const float* wr = AR->in[I_WRT] + (size_t)l * D * NE; const float* brt = AR->in[I_BRT] + l * NE;
    unsigned* cnt = (unsigned*)(C.ws + WS_CTL) + CW_CNT + 32 * CNT_STRIDE * l; int* rowpair = (int*)(C.ws + WS_ROWPAIR); float* pairw = (float*)(C.ws + WS_PAIRW);
    LAS float* Wl = (LAS float*)C.lds; LAS float* Lw = (LAS float*)(C.lds + WPROJ_BYTES + 64) + (C.wave & 3) * 832; const int kh = C.wave >> 2;
    { f32x4 t[16], u[2];
#pragma unroll
      for (int j = 0; j < 16; ++j) t[j] = *(const f32x4*)(wr + 4 * (C.tid + 512 * j));
#pragma unroll
      for (int j = 0; j < 2; ++j) u[j] = *(const f32x4*)(wg + 4 * (C.tid + 512 * j));
#pragma unroll
      for (int j = 0; j < 16; ++j) { const int i = C.tid + 512 * j; *(LAS f32x4*)(Wl + (i >> 3) * 36 + 4 * (i & 7)) = t[j]; }
#pragma unroll
      for (int j = 0; j < 2; ++j) *(LAS f32x4*)(Wl + (C.tid + 512 * j) * 36 + 32) = u[j]; }
    if (C.tid < 16) Wl[D * 36 + C.tid] = 0.f;
    volatile LAS unsigned* lcnt = (volatile LAS unsigned*)(C.lds + MISC_OFF - 512);
    if (C.tid < 64) lcnt[C.tid] = 0u;
    __syncthreads();
        for (int tile = blockIdx.x * 4 + (C.wave & 3); tile < T / 16; tile += gridDim.x * 4) {
            const int t0 = 16 * tile;
            __syncthreads();
            norm_proj_tile<3>(X, gain, xn, t0, [=](int n, int k, int i) { return Wl[k * 36 + 16 * n + i]; }, Lw, C.lane, kh);
            int e0 = 0, e1 = 0; unsigned lp0 = 0, lp1 = 0; float w0r = 0.f, w1r = 0.f;
            if (kh == 0 && C.lane < 16) {
                const LAS float* L = Lw + C.lane * 48;
                float gl[4];
#pragma unroll
                for (int i = 0; i < 4; ++i) gl[i] = L[32 + i] + bg[i];
                int gi = 0; float gm = gl[0];
#pragma unroll
                for (int i = 1; i < 4; ++i) if (gl[i] > gm) { gm = gl[i]; gi = i; }
                float gs = 0.f;
#pragma unroll
                for (int i = 0; i < 4; ++i) gs += __expf(gl[i] - gm);
                const float gp = 1.f / gs;
                float ev[8];
#pragma unroll
                for (int i = 0; i < 8; ++i) ev[i] = L[gi * 8 + i] + brt[gi * 8 + i];
                int i0 = 0; float t0v = ev[0];
#pragma unroll
                for (int i = 1; i < 8; ++i) if (ev[i] > t0v) { t0v = ev[i]; i0 = i; }
                int i1 = -1; float t1v = -INFINITY;
#pragma unroll
                for (int i = 0; i < 8; ++i) if (i != i0 && ev[i] > t1v) { t1v = ev[i]; i1 = i; }
                const float ex = __expf(t1v - t0v), w0 = gp / (1.f + ex), w1 = gp * ex / (1.f + ex);
                e0 = gi * 8 + i0; e1 = gi * 8 + i1; w0r = w0; w1r = w1;
                lp0 = __hip_atomic_fetch_add((LAS unsigned*)lcnt + e0, 1u, __ATOMIC_RELAXED, __HIP_MEMORY_SCOPE_WORKGROUP); lp1 = __hip_atomic_fetch_add((LAS unsigned*)lcnt + e1, 1u, __ATOMIC_RELAXED, __HIP_MEMORY_SCOPE_WORKGROUP);
            }
            __syncthreads();
            if (C.wave == 0 && C.lane < NE) { const unsigned n = lcnt[C.lane]; lcnt[32 + C.lane] = n ? atomicAdd(cnt + C.lane * CNT_STRIDE, n) : 0u; }
            __syncthreads();
            if (kh == 0 && C.lane < 16) { const int t = t0 + C.lane; const unsigned p0 = lcnt[32 + e0] + lp0, p1 = lcnt[32 + e1] + lp1;
                rowpair[(size_t)e0 * CAP + p0] = 2 * t; rowpair[(size_t)e1 * CAP + p1] = 2 * t + 1; pairw[2 * t] = w0r; pairw[2 * t + 1] = w1r; }
            __syncthreads();
            if (C.tid < 64) lcnt[C.tid] = 0u;
            asm volatile("s_waitcnt lgkmcnt(0)" ::: "memory");
        }
}

constexpr int NPH = 14;
constexpr int NPHASES = 1 + DEPTH * NPH;
__global__ void __launch_bounds__(512, 2) fwd_kernel(Args args) {
    extern __shared__ __attribute__((aligned(16))) unsigned char lds[];
    Ctx C;
    C.lds = (LAS unsigned char*)lds;
    C.wave0 = __builtin_amdgcn_readfirstlane((int)threadIdx.x >> 6); asm volatile("" : "+s"(C.wave0));
    C.tid = threadIdx.x; C.lane = C.tid & 63; C.wave = C.wave0;
    C.gw = blockIdx.x * 8 + C.wave; C.ngw = gridDim.x * 8;
    C.ws = args.ws;
    volatile LAS unsigned* MISC = (volatile LAS unsigned*)(C.lds + MISC_OFF);
    if (C.tid < 32) MISC[C.tid] = 0u;
    __syncthreads();
    XcdBarrier bar; bar.bar = (unsigned*)(C.ws + WS_CTL) + CW_BAR; bar.x = 0; bar.st = nullptr;
    if (args.ph_hi - args.ph_lo > 1) bar = xcd_barrier_post((unsigned*)(C.ws + WS_CTL) + CW_BAR, MISC + 8);
#ifndef ONLY
#define ONLY -1
#endif
#define PHON(k) (ONLY < 0 || ONLY == (k))
#if MK_MULTI
#define IN(k) (fresh_args()->ph_lo <= (k) && (k) < fresh_args()->ph_hi)
#else
#define IN(k) true
#endif
    if (PROBE_TIMING && blockIdx.x == 0 && threadIdx.x == 0) ((unsigned long long*)((unsigned*)(args.ws + WS_CTL) + CW_TS))[0] = __builtin_amdgcn_s_memrealtime();
#define SEAM(k) do { if (IN(k) && IN((k) + 1)) { XcdBarrier b_; b_.bar = (unsigned*)(fresh_args()->ws + WS_CTL) + CW_BAR; b_.x = xb_xcc_id(); b_.st = (volatile LAS unsigned*)(C.lds + MISC_OFF) + 8;     \
        xcd_barrier(b_, C.tid == 0); if (PROBE_TIMING && blockIdx.x == 0 && C.tid == 0) { ((unsigned long long*)((unsigned*)(fresh_args()->ws + WS_CTL) + CW_TS))[(k) + 1] = __builtin_amdgcn_s_memrealtime(); } } } while (0)
    for (int rp_ = 0; rp_ < REPS(99); ++rp_) { if (PHON(99) && IN(0)) { KA A_ = fresh_args(); enter_phase(C, A_); phase_prologue(C, A_); } SEAM(0); }
    for (int l = 0; l < DEPTH; ++l) {
        const int pb = 1 + l * NPH;
        for (int rp_ = 0; rp_ < REPSL(0); ++rp_) { if (PHON(0) && IN(pb + 0)) { KA A_ = fresh_args(); enter_phase(C, A_); if (FAST_NORM) phase_norm1_fast(C, A_, l); else phase_norm1(C, A_, l); } SEAM(pb + 0); }
        for (int rp_ = 0; rp_ < REPSL(1); ++rp_) { if (PHON(1) && IN(pb + 1)) { KA A_ = fresh_args(); enter_phase(C, A_); if (FAST_GEMM1) { phase_gemm1_fast(C, A_, l); phase_proj_fast(C, A_, l); } else phase_gemm1_naive(C, A_, l); } SEAM(pb + 1); }
        for (int rp_ = 0; rp_ < REPSL(2); ++rp_) { if (!FAST_GEMM1 && PHON(2) && IN(pb + 2)) { KA A_ = fresh_args(); enter_phase(C, A_); phase_qknorm_naive(C, A_, l); } if (!FAST_GEMM1) SEAM(pb + 2); }
        for (int rp_ = 0; rp_ < REPSL(3); ++rp_) { if (!(FAST_RNN && FAST_ATTN) && PHON(3) && IN(pb + 3)) { KA A_ = fresh_args(); enter_phase(C, A_); if (FAST_RNN) phase_rnn_fast<0>(C, A_, l); else phase_rnn_naive<0>(C, A_, l); } if (!(FAST_RNN && FAST_ATTN)) SEAM(pb + 3); }
        for (int rp_ = 0; rp_ < REPSL(4); ++rp_) { if (PHON(4) && IN(pb + 4)) { KA A_ = fresh_args(); enter_phase(C, A_); if (FAST_RNN && FAST_ATTN) { phase_rnn_fast<0>(C, A_, l); __syncthreads(); } if (FAST_ATTN) phase_attn_fast(C, A_, l, (char*)lds); else phase_attn_naive(C, A_, l); } SEAM(pb + 4); }
        for (int rp_ = 0; rp_ < REPSL(5); ++rp_) { if (PHON(5) && IN(pb + 5)) { KA A_ = fresh_args(); enter_phase(C, A_); if (FAST_RNN) phase_rnn_fast<1>(C, A_, l); else phase_rnn_naive<1>(C, A_, l); } SEAM(pb + 5); }
        for (int rp_ = 0; rp_ < REPSL(6); ++rp_) { if (!FAST_RNN && PHON(6) && IN(pb + 6)) { KA A_ = fresh_args(); enter_phase(C, A_); phase_mixnorm_naive(C, A_, l); } if (!FAST_RNN) SEAM(pb + 6); }
        for (int rp_ = 0; rp_ < REPSL(7); ++rp_) { if (PHON(7) && IN(pb + 7)) { KA A_ = fresh_args(); enter_phase(C, A_); if (FAST_DENSE) phase_wo_fast(C, A_, l); else phase_wo_naive(C, A_, l); } SEAM(pb + 7); }
        for (int rp_ = 0; rp_ < REPSL(8); ++rp_) { if (PHON(8) && IN(pb + 8)) { KA A_ = fresh_args(); enter_phase(C, A_); if (FAST_NORM) phase_router_fast(C, A_, l); else phase_router(C, A_, l); } SEAM(pb + 8); }
        for (int rp_ = 0; rp_ < REPSL(9); ++rp_) { if (PHON(9) && IN(pb + 9)) { KA A_ = fresh_args(); enter_phase(C, A_); if (FAST_MOE) phase_g1_fast(C, A_, l); else phase_g1_naive(C, A_, l); } SEAM(pb + 9); }
        for (int rp_ = 0; rp_ < REPSL(10); ++rp_) { if (PHON(10) && IN(pb + 10)) { KA A_ = fresh_args(); enter_phase(C, A_); if (FAST_MOE) phase_g2_fast(C, A_, l); else phase_g2_naive(C, A_, l); } SEAM(pb + 10); }
        for (int rp_ = 0; rp_ < REPSL(11); ++rp_) { if (PHON(11) && IN(pb + 11)) { KA A_ = fresh_args(); enter_phase(C, A_); phase_combine(C, A_, l); } SEAM(pb + 11); }
        for (int rp_ = 0; rp_ < REPSL(12); ++rp_) { if (!FAST_GEMM1 && PHON(12) && IN(pb + 12)) { KA A_ = fresh_args(); enter_phase(C, A_); if (FAST_DENSE) phase_proj_fast(C, A_, l); else phase_proj_naive(C, A_, l); } if (!FAST_GEMM1) SEAM(pb + 12); }
        for (int rp_ = 0; rp_ < REPSL(13); ++rp_) { if (PHON(13) && IN(pb + 13)) { KA A_ = fresh_args(); enter_phase(C, A_); if (FAST_DENSE) phase_ple_fast(C, A_, l); else phase_ple_naive(C, A_, l); } if (l + 1 < DEPTH) SEAM(pb + 13); }
    }
#undef IN
#undef SEAM
}

extern "C" void kernel_launch(void* const* d_in, const int* in_sizes, int n_in, void* d_out, int out_size, void* d_ws, size_t ws_size, hipStream_t stream) {
    static int grid = 0;
    if (grid == 0) {
        if (n_in != 29 || out_size != T * D || ws_size < WS_END) { fprintf(stderr, "kernel_launch: unexpected problem (n_in %d, out %d, ws %zu)\n", n_in, out_size, ws_size); grid = -1; return; }
        int dev = 0, cus = 0, per_cu = 0;
        if (hipGetDevice(&dev) != hipSuccess || hipDeviceGetAttribute(&cus, hipDeviceAttributeMultiprocessorCount, dev) != hipSuccess) { grid = -1; return; }
        if (hipFuncSetAttribute((const void*)fwd_kernel, hipFuncAttributeMaxDynamicSharedMemorySize, LDS_BYTES) != hipSuccess) { fprintf(stderr, "kernel_launch: hipFuncSetAttribute failed\n"); grid = -1; return; }
        if (hipOccupancyMaxActiveBlocksPerMultiprocessor(&per_cu, (const void*)fwd_kernel, 512, LDS_BYTES) != hipSuccess || per_cu < 1) { fprintf(stderr, "kernel_launch: occupancy query says %d\n", per_cu); grid = -1; return; }
        (void)hipGetLastError();
        grid = cus;
    }
    if (grid < 0) return;
    hipMemsetAsync((char*)d_ws + WS_CTL, 0, CTL_ZERO_BYTES, stream);
    Args a{};
    for (int i = 0; i < 29; ++i) a.in[i] = (const float*)d_in[i];
    a.out = (float*)d_out; a.ws = (unsigned char*)d_ws;
#if MK_MULTI
    for (int ph = 0; ph < NPHASES; ++ph) { a.ph_lo = ph; a.ph_hi = ph + 1; hipLaunchKernelGGL(fwd_kernel, dim3(grid), dim3(512), LDS_BYTES, stream, a); }
#else
    a.ph_lo = 0; a.ph_hi = NPHASES;
    hipLaunchKernelGGL(fwd_kernel, dim3(grid), dim3(512), LDS_BYTES, stream, a);
#endif
}
```

```cpp
#include <hip/hip_runtime.h>
#include <cstdio>
#include <cstdint>
#include <cmath>
#include <hip/hip_bf16.h>

#define FAST_GEMM1 1
#define FAST_DENSE 1
#define FAST_MOE 1
#define FAST_ATTN 1
#define FAST_RNN 1
#define FAST_NORM 1
static_assert(FAST_GEMM1 && FAST_DENSE && FAST_MOE && FAST_ATTN && FAST_RNN && FAST_NORM, "the residual stream is bf16 between the phases: the early VALU phase bodies (f32 stream) are kept for reference only");
#ifndef PROBE_TIMING
#define PROBE_TIMING 0
#endif
#ifndef PROBE_LO
#define PROBE_LO 0
#define PROBE_HI 1
#endif
#ifndef PROBE_REP
#define PROBE_REP -1
#define PROBE_REPN 0
#endif
#define REPS(k) ((PROBE_REP == (k)) ? (1 + PROBE_REPN) : 1)
#define REPSL(k) ((((k) == 7 && l != 0) || ((k) == 13 && l != DEPTH - 1)) ? 1 : REPS(k))
#ifndef MK_MULTI
#define MK_MULTI 0
#endif

#define GAS __attribute__((address_space(1)))
#define LAS __attribute__((address_space(3)))
typedef unsigned short bf16;
typedef unsigned v4u __attribute__((ext_vector_type(4)));
typedef unsigned v2u __attribute__((ext_vector_type(2)));
typedef float f32x4 __attribute__((ext_vector_type(4)));

constexpr int NB = 4, S = 4096, T = NB * S, D = 1024, DIN = 2568, DR = 512, DA = 512, NH = 8, HD = 64;
constexpr int NE = 32, DE = 512, PLE = 256, DEPTH = 2, NZ = 2560;
constexpr float EPS = 1e-6f, LOG2E = 1.4426950408889634f, C2 = 0.125f * 1.4426950408889634f;
constexpr int CAP = 16384;
constexpr int HROWS = 40960;

constexpr size_t MiB = 1u << 20;
constexpr size_t WS_CTL = 0, CTL_ZERO_BYTES = 128 * 1024;
constexpr size_t WS_LOGF = 1 * MiB;
constexpr size_t WS_C2K = WS_LOGF + MiB / 2;
constexpr size_t WS_SA = 6 * MiB, WS_SH = 7 * MiB;
constexpr size_t WS_PAIRW = 3 * MiB;
constexpr size_t WS_ROWPAIR = 4 * MiB;
constexpr size_t WS_WIN = 8 * MiB;
constexpr size_t WS_WOUT = 18 * MiB;
constexpr size_t WS_WPG = 22 * MiB;
constexpr size_t WS_WPP = 26 * MiB;
constexpr size_t WS_WGU = 28 * MiB;
constexpr size_t WS_WDN = 156 * MiB;
constexpr size_t WS_PB = 220 * MiB;
constexpr size_t WS_XN = 236 * MiB;
constexpr size_t WS_X = 268 * MiB;
constexpr size_t WS_R1 = 332 * MiB;
constexpr size_t WS_R2 = 412 * MiB;
constexpr size_t WS_PROJ = 460 * MiB;
constexpr size_t WS_END = 492 * MiB;
constexpr int CW_BAR = 4096;
constexpr int CW_TS = 20480;
constexpr int CW_ATT = 16384;
constexpr int CW_CNT = 8192, CNT_STRIDE = 64;

constexpr int RING_BYTES = 131072;
constexpr int LDS_BYTES = 163840;
constexpr int MISC_OFF = LDS_BYTES - 1024;
constexpr int WPROJ_BYTES = 147456;

__device__ __forceinline__ unsigned f2bf(float f) { unsigned u = __builtin_bit_cast(unsigned, f); return (u + 0x7fffu + ((u >> 16) & 1u)) >> 16; }
__device__ __forceinline__ unsigned pk2(float lo, float hi) { return f2bf(lo) | (f2bf(hi) << 16); }
__device__ __forceinline__ float bf2f(unsigned u) { return __builtin_bit_cast(float, u << 16); }
__device__ __forceinline__ float bflo(unsigned w) { return __builtin_bit_cast(float, w << 16); }
__device__ __forceinline__ float bfhi(unsigned w) { return __builtin_bit_cast(float, w & 0xffff0000u); }
template <int O> __device__ __forceinline__ float lane_xor(float v) {
    if constexpr (O == 32) { const unsigned u = __builtin_bit_cast(unsigned, v); auto rr = __builtin_amdgcn_permlane32_swap(u, u, false, false);
        const unsigned a = rr[0], b = rr[1]; return __builtin_bit_cast(float, a == u ? b : a); }
    else return __builtin_bit_cast(float, __builtin_amdgcn_ds_swizzle(__builtin_bit_cast(int, v), (O << 10) | 0x1f));
}
__device__ __forceinline__ float wave_sum(float v) {
    v += lane_xor<1>(v); v += lane_xor<2>(v); v += lane_xor<4>(v); v += lane_xor<8>(v); v += lane_xor<16>(v);
    { const unsigned u = __builtin_bit_cast(unsigned, v); auto rr = __builtin_amdgcn_permlane32_swap(u, u, false, false); v = __builtin_bit_cast(float, (unsigned)rr[0]) + __builtin_bit_cast(float, (unsigned)rr[1]); }
    return v;
}
__device__ __forceinline__ float wave_max(float v) {
    v = fmaxf(v, lane_xor<1>(v)); v = fmaxf(v, lane_xor<2>(v)); v = fmaxf(v, lane_xor<4>(v)); v = fmaxf(v, lane_xor<8>(v)); v = fmaxf(v, lane_xor<16>(v));
    { const unsigned u = __builtin_bit_cast(unsigned, v); auto rr = __builtin_amdgcn_permlane32_swap(u, u, false, false); v = fmaxf(__builtin_bit_cast(float, (unsigned)rr[0]), __builtin_bit_cast(float, (unsigned)rr[1])); }
    return v;
}
__device__ __forceinline__ float half_sum32(float v) {
    const unsigned u = __builtin_bit_cast(unsigned, v); auto rr = __builtin_amdgcn_permlane32_swap(u, u, false, false); return __builtin_bit_cast(float, (unsigned)rr[0]) + __builtin_bit_cast(float, (unsigned)rr[1]);
}
__device__ __forceinline__ float sigmoidf_(float v) { return 1.f / (1.f + __expf(-v)); }
__device__ __forceinline__ float gelu_tanh(float v) { return 0.5f * v * (1.f + tanhf(0.7978845608028654f * (v + 0.044715f * v * v * v))); }
__device__ __forceinline__ float log_sigmoid(float v) { return v >= 0.f ? -log1pf(__expf(-v)) : v - log1pf(__expf(v)); }

#define XB_TMO      128
#define XB_XCNT(j)  (256  + 64 * (j))
#define XB_XSUB(j)  (1280 + 64 * (j))
#define XB_XGEN(j)  (2304 + 64 * (j))
#define XB_TOP      3328
#define XB_TOPGEN   3392
#define XCD_BAR_WORDS 3456
#define XB_SPIN_CAP (1u << 26)
__device__ __forceinline__ unsigned xb_ld(unsigned* p)              { return __hip_atomic_load(p, __ATOMIC_RELAXED, __HIP_MEMORY_SCOPE_AGENT); }
__device__ __forceinline__ unsigned xb_add(unsigned* p, unsigned v) { return __hip_atomic_fetch_add(p, v, __ATOMIC_RELAXED, __HIP_MEMORY_SCOPE_AGENT); }
__device__ __forceinline__ unsigned xb_xcc_id() { return (unsigned)__builtin_amdgcn_s_getreg((3 << 11) | 20) & 0xFu; }
#define XB_SPIN(cond, bar) do { unsigned _sp = 0; while (cond) { __builtin_amdgcn_s_sleep(1); \
    if ((++_sp & 255u) == 0u) { if (xb_ld(&(bar)[XB_TMO])) break; if (_sp > XB_SPIN_CAP) { atomicAdd(&(bar)[XB_TMO], 1u); break; } } } } while (0)
struct XcdBarrier { unsigned* bar; unsigned x; volatile LAS unsigned* st; };
__device__ __forceinline__ XcdBarrier xcd_barrier_post(unsigned* bar, volatile LAS unsigned* st) {
    XcdBarrier b; b.bar = bar; b.x = xb_xcc_id(); b.st = st;
    if (threadIdx.x == 0) (void)xb_add(&bar[XB_XCNT(b.x)], 1u);
    return b;
}
__device__ __forceinline__ void xcd_barrier_complete(unsigned* bar, unsigned x, unsigned& nloc, unsigned& nx) {
    const unsigned G = gridDim.x * gridDim.y * gridDim.z;
    unsigned sum, cnt, mine, sp = 0u;
    for (;;) {
        sum = 0u; cnt = 0u; mine = 0u;
#pragma unroll
        for (unsigned j = 0; j < 16; ++j) { const unsigned c = xb_ld(&bar[XB_XCNT(j)]); sum += c; cnt += (c > 0u) ? 1u : 0u; mine = (j == x) ? c : mine; }
        if (sum == G) break;
        __builtin_amdgcn_s_sleep(1);
        if ((++sp & 255u) == 0u) { if (xb_ld(&bar[XB_TMO])) break; if (sp > XB_SPIN_CAP) { atomicAdd(&bar[XB_TMO], 1u); break; } }
    }
    nloc = mine > 0u ? mine : 1u; nx = cnt > 0u ? cnt : 1u;
}
__device__ __forceinline__ void xcd_barrier(const XcdBarrier& b, const bool leader  ) {
    asm volatile("s_waitcnt vmcnt(0)" ::: "memory");
    __syncthreads();
    if (leader) {
        unsigned* bar = b.bar;
        __builtin_amdgcn_s_waitcnt(0);
        unsigned nloc = b.st[0], nx = b.st[1];
        if (nloc == 0u) { xcd_barrier_complete(bar, b.x, nloc, nx); b.st[0] = nloc; b.st[1] = nx; }
        const unsigned old = xb_add(&bar[XB_XSUB(b.x)], 1u);
        const unsigned gen = old / nloc;
        if (old + 1u == (gen + 1u) * nloc) {
            __builtin_amdgcn_fence(__ATOMIC_RELEASE, "agent");
            asm volatile("s_waitcnt vmcnt(0)" ::: "memory");
            const unsigned og = xb_add(&bar[XB_TOP], 1u);
            const unsigned tg = og / nx;
            if (og + 1u == (tg + 1u) * nx) xb_add(&bar[XB_TOPGEN], 1u);
            else XB_SPIN(xb_ld(&bar[XB_TOPGEN]) == tg, bar);
            __builtin_amdgcn_fence(__ATOMIC_ACQUIRE, "agent");
            xb_add(&bar[XB_XGEN(b.x)], 1u);
            asm volatile("s_waitcnt vmcnt(0)" ::: "memory");
        } else {
            XB_SPIN(xb_ld(&bar[XB_XGEN(b.x)]) == gen, bar);
            __builtin_amdgcn_fence(__ATOMIC_ACQUIRE, "agent");
            asm volatile("s_waitcnt vmcnt(0)" ::: "memory");
        }
    }
    __syncthreads();
}

struct Args { const float* in[29]; float* out; unsigned char* ws; int ph_lo, ph_hi; };
typedef const __attribute__((address_space(4))) Args* KA;
__device__ __forceinline__ KA fresh_args() { KA p = (KA)__builtin_amdgcn_kernarg_segment_ptr(); asm volatile("" : "+s"(p)); return p; }
struct Ctx;
struct Ctx {
    LAS unsigned char* lds;
    int tid, lane, wave, gw, ngw;
    int wave0;
    unsigned char* ws;
};
__device__ __forceinline__ void enter_phase(Ctx& C, KA A) {
    int t; asm volatile("v_mbcnt_lo_u32_b32 %0, -1, 0\n\tv_mbcnt_hi_u32_b32 %0, -1, %0" : "=v"(t)); t += C.wave0 * 64; C.tid = t; C.lane = t & 63; C.wave = __builtin_amdgcn_readfirstlane(t >> 6);
    C.gw = blockIdx.x * 8 + C.wave; C.ngw = gridDim.x * 8; C.ws = A->ws; }
enum { I_X = 0, I_P, I_MIXN, I_WIN, I_BF, I_CONVW, I_CONVB, I_WR, I_BR, I_WI, I_BI, I_LAM, I_QN, I_KN, I_LRUN, I_ATTN, I_WOUT, I_FFNN,
       I_WG, I_BG, I_WRT, I_BRT, I_WEG, I_WEU, I_WED, I_PLEN, I_WPG, I_BPG, I_WPP };

__device__ __forceinline__ void transpose_item(const float* W, int ldw, int K, bf16* WT, int k0, int n0, int c0, LAS float* scr, int lane) {
    { float t[32];
#pragma unroll
      for (int i = 0; i < 32; ++i) t[i] = W[(size_t)(k0 + 2 * i + (lane >> 5)) * ldw + c0 + (lane & 31)];
#pragma unroll
      for (int i = 0; i < 32; ++i) scr[(2 * i + (lane >> 5)) * 33 + (lane & 31)] = t[i]; }
    asm volatile("s_waitcnt lgkmcnt(0)" ::: "memory");
    const int c = lane & 7;
#pragma unroll
    for (int j = 0; j < 4; ++j) { const int n = (lane >> 3) + 8 * j; const LAS float* s = scr + (8 * c) * 33 + n;
        v4u o; o.x = pk2(s[0 * 33], s[1 * 33]); o.y = pk2(s[2 * 33], s[3 * 33]); o.z = pk2(s[4 * 33], s[5 * 33]); o.w = pk2(s[6 * 33], s[7 * 33]);
        *(v4u*)(WT + (size_t)(n0 + n) * K + k0 + 8 * c) = o; }
    asm volatile("s_waitcnt lgkmcnt(0)" ::: "memory");
}
__device__ __forceinline__ void phase_prologue(Ctx& C, KA AR) {
    LAS float* scr = (LAS float*)(C.lds + C.wave * 16384);
    constexpr int I_IN = 16 * 80, I_OUT = 16 * 32, I_GU = 32 * 16 * 32, I_DN = 32 * 8 * 32, I_PG = 16 * 32, I_PP = 4 * 32;
    constexpr int PER_L = I_IN + I_OUT + I_GU + I_DN + I_PG + I_PP;
    for (int it = C.gw; it < DEPTH * PER_L; it += C.ngw) {
        const int l = it / PER_L; int r = it % PER_L;
        if (r < I_IN) {
            const int kb = r / 80, nb = r % 80, n0 = 32 * nb, pn = n0 >> 8, jl = n0 & 255, bj = jl >> 7, wc = (jl >> 5) & 3;
            transpose_item(AR->in[I_WIN] + (size_t)l * D * DIN, DIN, D, (bf16*)(C.ws + WS_WIN) + (size_t)l * NZ * D, 64 * kb, n0, 256 * pn + 64 * wc + 32 * bj, scr, C.lane); continue; }
        r -= I_IN;
        if (r < I_OUT) { const int kb = r / 32, nb = r % 32;
            transpose_item(AR->in[I_WOUT] + (size_t)l * D * D, D, D, (bf16*)(C.ws + WS_WOUT) + (size_t)l * D * D, 64 * kb, 32 * nb, 32 * nb, scr, C.lane); continue; }
        r -= I_OUT;
        if (r < I_GU) {
            const int e = r / 512, q = r % 512, kb = q / 32, nb = q % 32, n0 = 32 * nb, pn = n0 >> 8, jl = n0 & 255;
            const float* src = (jl < 128 ? AR->in[I_WEG] : AR->in[I_WEU]) + (size_t)(l * NE + e) * D * DE;
            transpose_item(src, DE, D, (bf16*)(C.ws + WS_WGU) + (size_t)(l * NE + e) * 1024 * D, 64 * kb, n0, 128 * pn + (jl & 127), scr, C.lane); continue; }
        r -= I_GU;
        if (r < I_DN) { const int e = r / 256, q = r % 256, kb = q / 32, nb = q % 32;
            transpose_item(AR->in[I_WED] + (size_t)(l * NE + e) * DE * D, D, DE, (bf16*)(C.ws + WS_WDN) + (size_t)(l * NE + e) * D * DE, 64 * kb, 32 * nb, 32 * nb, scr, C.lane); continue; }
        r -= I_DN;
        if (r < I_PG) { const int kb = r / 32, nb = r % 32;
            transpose_item(AR->in[I_WPG] + (size_t)l * D * D, D, D, (bf16*)(C.ws + WS_WPG) + (size_t)l * D * D, 64 * kb, 32 * nb, 32 * nb, scr, C.lane); continue; }
        r -= I_PG;
        { const int kb = r / 32, nb = r % 32;
            transpose_item(AR->in[I_WPP] + (size_t)l * PLE * D, D, PLE, (bf16*)(C.ws + WS_WPP) + (size_t)l * D * PLE, 64 * kb, 32 * nb, 32 * nb, scr, C.lane); }
    }
    const f32x4* ps = (const f32x4*)AR->in[I_P]; v2u* pd = (v2u*)(C.ws + WS_PB);
    const size_t n4 = (size_t)DEPTH * T * PLE / 4;
    { const size_t st = (size_t)gridDim.x * 512; size_t i = (size_t)blockIdx.x * 512 + C.tid;
      for (; i + 7 * st < n4; i += 8 * st) { f32x4 v[8];
#pragma unroll
          for (int q = 0; q < 8; ++q) v[q] = ps[i + q * st];
#pragma unroll
          for (int q = 0; q < 8; ++q) { v2u o; o.x = pk2(v[q].x, v[q].y); o.y = pk2(v[q].z, v[q].w); pd[i + q * st] = o; } }
      for (; i < n4; i += st) { const f32x4 v = ps[i]; v2u o; o.x = pk2(v.x, v.y); o.y = pk2(v.z, v.w); pd[i] = o; } }
}

__device__ __forceinline__ void load_row(const float* row, int lane, f32x4 (&v)[4]) {
    const f32x4* xr = (const f32x4*)row + lane;
#pragma unroll
    for (int j = 0; j < 4; ++j) v[j] = xr[64 * j];
}
__device__ __forceinline__ void load_row_bf(const bf16* row, int lane, f32x4 (&v)[4]) {
    const v2u* xr = (const v2u*)row + lane;
#pragma unroll
    for (int j = 0; j < 4; ++j) { const v2u w = xr[64 * j]; v[j] = (f32x4){bflo(w.x), bfhi(w.x), bflo(w.y), bfhi(w.y)}; }
}
__device__ __forceinline__ float row_rs(const f32x4 (&v)[4]) {
    float s = 0.f;
#pragma unroll
    for (int j = 0; j < 4; ++j) s += (v[j].x * v[j].x + v[j].y * v[j].y) + (v[j].z * v[j].z + v[j].w * v[j].w);
    return rsqrtf(wave_sum(s) * (1.f / D) + EPS);
}
__device__ __forceinline__ void scale_row(f32x4 (&v)[4], float rs, const float* gain, int lane) {
    const f32x4* g = (const f32x4*)gain + lane;
#pragma unroll
    for (int j = 0; j < 4; ++j) v[j] = v[j] * rs * g[64 * j];
}
__device__ __forceinline__ void store_row_bf16(bf16* row, int lane, const f32x4 (&v)[4]) {
    v2u* o = (v2u*)row + lane;
#pragma unroll
    for (int j = 0; j < 4; ++j) { v2u w; w.x = pk2(v[j].x, v[j].y); w.y = pk2(v[j].z, v[j].w); o[64 * j] = w; }
}

__device__ __forceinline__ void phase_norm1(Ctx& C, KA AR, int l) {
    const float* xs = l == 0 ? AR->in[I_X] : (const float*)(C.ws + WS_X);
    const float* gain = AR->in[I_MIXN] + l * D;
    const float* wf = AR->in[I_WIN] + (size_t)l * D * DIN + NZ;
    const float* bfg = AR->in[I_BF] + l * NH;
    bf16* xn = (bf16*)(C.ws + WS_XN); float* logf = (float*)(C.ws + WS_LOGF);
    for (int t = C.gw; t < T; t += C.ngw) {
        f32x4 v[4]; load_row(xs + (size_t)t * D, C.lane, v);
        const float rs = row_rs(v); scale_row(v, rs, gain, C.lane);
        store_row_bf16(xn + (size_t)t * D, C.lane, v);
        float z[8] = {0.f, 0.f, 0.f, 0.f, 0.f, 0.f, 0.f, 0.f};
#pragma unroll
        for (int j = 0; j < 4; ++j)
#pragma unroll
            for (int e = 0; e < 4; ++e) { const int k = 256 * j + 4 * C.lane + e; const f32x4 w0 = *(const f32x4*)(wf + (size_t)k * DIN), w1 = *(const f32x4*)(wf + (size_t)k * DIN + 4);
                const float a = v[j][e]; z[0] += a * w0.x; z[1] += a * w0.y; z[2] += a * w0.z; z[3] += a * w0.w; z[4] += a * w1.x; z[5] += a * w1.y; z[6] += a * w1.z; z[7] += a * w1.w; }
#pragma unroll
        for (int h = 0; h < 8; ++h) z[h] = wave_sum(z[h]);
        float mine = 0.f;
#pragma unroll
        for (int h = 0; h < 8; ++h) mine = (C.lane == h) ? z[h] : mine;
        if (C.lane < 8) logf[(size_t)t * 8 + C.lane] = log_sigmoid(mine + bfg[C.lane]);
    }
}

template <int NACC, class AR, class BR, class EP>
__device__ __forceinline__ void ngemm_tile(LAS float* sm, int K, AR arow, BR brow, EP epi, const int tid) {
    LAS float* As = sm; LAS float* Bs = sm + 32 * 68;
    const int ty = tid >> 4, tx = tid & 15, lr = tid >> 3, lk = (tid & 7) * 4;
    float acc[NACC][2][4];
#pragma unroll
    for (int a = 0; a < NACC; ++a)
#pragma unroll
        for (int i = 0; i < 2; ++i)
#pragma unroll
            for (int j = 0; j < 4; ++j) acc[a][i][j] = 0.f;
    const bf16* ap = arow(lr); const bf16* bp0 = brow(lr, 0); const bf16* bp1 = NACC > 1 ? brow(lr, 1) : bp0;
    for (int k0 = 0; k0 < K; k0 += 32) {
        __syncthreads();
        { v2u av; av.x = 0u; av.y = 0u; if (ap) av = *(const v2u*)(ap + k0 + lk);
          As[(lk + 0) * 68 + lr] = bflo(av.x); As[(lk + 1) * 68 + lr] = bfhi(av.x); As[(lk + 2) * 68 + lr] = bflo(av.y); As[(lk + 3) * 68 + lr] = bfhi(av.y); }
        { const v2u bv = *(const v2u*)(bp0 + k0 + lk);
          Bs[(lk + 0) * 68 + lr] = bflo(bv.x); Bs[(lk + 1) * 68 + lr] = bfhi(bv.x); Bs[(lk + 2) * 68 + lr] = bflo(bv.y); Bs[(lk + 3) * 68 + lr] = bfhi(bv.y); }
        if (NACC > 1) { const v2u bv = *(const v2u*)(bp1 + k0 + lk); LAS float* B1 = Bs + 32 * 68;
          B1[(lk + 0) * 68 + lr] = bflo(bv.x); B1[(lk + 1) * 68 + lr] = bfhi(bv.x); B1[(lk + 2) * 68 + lr] = bflo(bv.y); B1[(lk + 3) * 68 + lr] = bfhi(bv.y); }
        __syncthreads();
#pragma unroll 8
        for (int kk = 0; kk < 32; ++kk) {
            const float a0 = As[kk * 68 + ty * 2], a1 = As[kk * 68 + ty * 2 + 1];
#pragma unroll
            for (int a = 0; a < NACC; ++a) { const f32x4 b = *(const LAS f32x4*)(Bs + a * 32 * 68 + kk * 68 + tx * 4);
#pragma unroll
                for (int j = 0; j < 4; ++j) { acc[a][0][j] += a0 * b[j]; acc[a][1][j] += a1 * b[j]; } }
        }
    }
#pragma unroll
    for (int i = 0; i < 2; ++i)
#pragma unroll
        for (int j = 0; j < 4; ++j) epi(ty * 2 + i, tx * 4 + j, acc[0][i][j], NACC > 1 ? acc[1][i][j] : 0.f);
}

__device__ __forceinline__ void phase_cumsum(Ctx& C, KA AR) {
    if (C.gw < NB * NH) {
        const int b = C.gw / NH, h = C.gw % NH;
        const float* logf = (const float*)(C.ws + WS_LOGF) + (size_t)b * S * 8 + h; float* c2k = (float*)(C.ws + WS_C2K) + (size_t)C.gw * S;
        float s = 0.f;
        for (int i = 0; i < 64; ++i) s += logf[(size_t)(64 * C.lane + i) * 8];
        float inc = s;
#pragma unroll
        for (int o = 1; o < 64; o <<= 1) { const float v = __builtin_bit_cast(float, __builtin_amdgcn_ds_bpermute((C.lane - o) << 2, __builtin_bit_cast(int, inc))); if (C.lane >= o) inc += v; }
        float run = inc - s;
        for (int i = 0; i < 64; ++i) { run += logf[(size_t)(64 * C.lane + i) * 8]; c2k[64 * C.lane + i] = run * LOG2E; }
    }
}
__device__ __forceinline__ void phase_cumsum_fast(Ctx& C, KA AR) {
    const int row = (int)blockIdx.x - (int)gridDim.x / 2;
    if (C.wave == 0 && row >= 0 && row < NB * NH) {
        const float* src = (const float*)(C.ws + WS_LOGF) + (size_t)row * S + C.lane; float* dst = (float*)(C.ws + WS_C2K) + (size_t)row * S + C.lane;
        float run = 0.f;
        for (int it = 0; it < S / 64; it += 8) {
            float v[8];
#pragma unroll
            for (int q = 0; q < 8; ++q) v[q] = src[(it + q) * 64];
#pragma unroll
            for (int q = 0; q < 8; ++q) { float x = v[q];
#pragma unroll
                for (int o = 1; o < 64; o <<= 1) { const float y = __builtin_bit_cast(float, __builtin_amdgcn_ds_bpermute((C.lane - o) << 2, __builtin_bit_cast(int, x))); if (C.lane >= o) x += y; }
                dst[(it + q) * 64] = (run + x) * LOG2E;
                run += __builtin_bit_cast(float, __builtin_amdgcn_readlane(__builtin_bit_cast(int, x), 63)); }
        }
    }
}
__device__ __forceinline__ void phase_gemm1_naive(Ctx& C, KA AR, int l) {
    phase_cumsum(C, AR);
    const bf16* A = (const bf16*)(C.ws + WS_XN); const bf16* Bt = (const bf16*)(C.ws + WS_WIN) + (size_t)l * NZ * D;
    bf16* R1 = (bf16*)(C.ws + WS_R1);
    for (int u = blockIdx.x; u < (T / 64) * (NZ / 64); u += gridDim.x) {
        const int mt = u / (NZ / 64), nt = u % (NZ / 64), m0 = 64 * mt, n0 = 64 * nt;
        ngemm_tile<1>((LAS float*)C.lds, D, [=](int r) { return A + (size_t)(m0 + r) * D; }, [=](int c, int) { return Bt + (size_t)(n0 + c) * D; },
            [=](int r, int c, float v, float) {
                const int j = n0 + c, pn = j >> 8, jl = j & 255, bj = jl >> 7, wc = (jl >> 5) & 3, col = 256 * pn + 64 * wc + 32 * bj + (jl & 31);
                const int seg = col >> 9, cc = col & 511;
                const float o = seg == 1 ? gelu_tanh(v) : v;
                R1[(size_t)seg * T * 512 + (size_t)(m0 + r) * 512 + cc] = (bf16)f2bf(o);
            }, C.tid);
    }
}
__device__ __forceinline__ void phase_qknorm_naive(Ctx& C, KA AR, int l) {
    bf16* Q = (bf16*)(C.ws + WS_R1) + (size_t)2 * T * 512; bf16* Kb = Q + (size_t)T * 512;
    const float* gq = AR->in[I_QN] + l * HD; const float* gk = AR->in[I_KN] + l * HD;
    for (int i = C.gw; i < 2 * T; i += C.ngw) {
        const int t = i >> 1, isk = i & 1; bf16* row = (isk ? Kb : Q) + (size_t)t * 512; const float* g = isk ? gk : gq;
        const v4u w = *(const v4u*)(row + 8 * C.lane);
        float x[8] = {bflo(w.x), bfhi(w.x), bflo(w.y), bfhi(w.y), bflo(w.z), bfhi(w.z), bflo(w.w), bfhi(w.w)};
        float s = 0.f;
#pragma unroll
        for (int e = 0; e < 8; ++e) s += x[e] * x[e];
        s += lane_xor<1>(s); s += lane_xor<2>(s); s += lane_xor<4>(s);
        const float rs = rsqrtf(s * (1.f / 64.f) + EPS) * (isk ? 1.f : C2);
        const int d0 = 8 * (C.lane & 7);
#pragma unroll
        for (int e = 0; e < 8; ++e) x[e] = x[e] * rs * g[d0 + e];
        v4u o; o.x = pk2(x[0], x[1]); o.y = pk2(x[2], x[3]); o.z = pk2(x[4], x[5]); o.w = pk2(x[6], x[7]);
        *(v4u*)(row + 8 * C.lane) = o;
    }
}

template <int MODE>
__device__ __forceinline__ void phase_rnn_naive(Ctx& C, KA AR, int l) {
    LAS float* xcs = (LAS float*)C.lds; LAS float* as = xcs + 64 * 65; LAS float* us = as + 64 * 64;
    const bf16* ZX = (const bf16*)(C.ws + WS_R1); const bf16* ZG = ZX + (size_t)T * 512;
    float* SA = (float*)(C.ws + WS_SA); float* SH = (float*)(C.ws + WS_SH); float* YR = (float*)(C.ws + WS_PROJ);
    const float* cw = AR->in[I_CONVW] + l * 4 * DR; const float* cb = AR->in[I_CONVB] + l * DR;
    const float* wr = AR->in[I_WR] + (size_t)l * 8 * 64 * 64; const float* wi = AR->in[I_WI] + (size_t)l * 8 * 64 * 64;
    const float* br = AR->in[I_BR] + l * DR; const float* bi = AR->in[I_BI] + l * DR; const float* lam = AR->in[I_LAM] + l * DR;
    for (int u = blockIdx.x; u < NB * 64 * 8; u += gridDim.x) {
        const int b = u >> 9, cidx = (u >> 3) & 63, blk = u & 7;
        __syncthreads();
#pragma unroll
        for (int i = 0; i < 8; ++i) { const int e = C.tid + 512 * i, t = e >> 6, c = e & 63, ch = blk * 64 + c, tg = cidx * 64 + t;
            float xc = cb[ch];
#pragma unroll
            for (int j = 0; j < 4; ++j) { const int tt = tg - 3 + j; if (tt >= 0) xc += cw[j * DR + ch] * bf2f(ZX[(size_t)(b * S + tt) * 512 + ch]); }
            xcs[t * 65 + c] = xc; }
        __syncthreads();
#pragma unroll
        for (int i = 0; i < 8; ++i) { const int e = C.tid + 512 * i, t = e >> 6, j = e & 63, ch = blk * 64 + j;
            float ar = br[ch], ai = bi[ch];
            for (int k = 0; k < 64; ++k) { const float x = xcs[t * 65 + k]; ar += x * wr[(size_t)(blk * 64 + k) * 64 + j]; ai += x * wi[(size_t)(blk * 64 + k) * 64 + j]; }
            const float r = sigmoidf_(ar), ig = sigmoidf_(ai);
            const float la = -8.f * r * log1pf(__expf(-lam[ch]));
            as[t * 64 + j] = __expf(la); us[t * 64 + j] = sqrtf(-expm1f(2.f * la)) * (ig * xcs[t * 65 + j]); }
        __syncthreads();
        if (C.tid < 64) { const int j = C.tid, ch = blk * 64 + j;
            if (MODE == 0) { float A = 1.f, H = 0.f;
                for (int t = 0; t < 64; ++t) { const float a = as[t * 64 + j]; H = a * H + us[t * 64 + j]; A *= a; }
                SA[(size_t)(b * 64 + cidx) * 512 + ch] = A; SH[(size_t)(b * 64 + cidx) * 512 + ch] = H;
            } else { float h = 0.f;
                for (int c2 = 0; c2 < cidx; ++c2) h = SA[(size_t)(b * 64 + c2) * 512 + ch] * h + SH[(size_t)(b * 64 + c2) * 512 + ch];
                for (int t = 0; t < 64; ++t) { h = as[t * 64 + j] * h + us[t * 64 + j]; as[t * 64 + j] = h; } } }
        if (MODE == 1) { __syncthreads();
#pragma unroll
            for (int i = 0; i < 8; ++i) { const int e = C.tid + 512 * i, t = e >> 6, c = e & 63, ch = blk * 64 + c; const size_t row = (size_t)(b * S + cidx * 64 + t);
                YR[row * 512 + ch] = as[t * 64 + c] * bf2f(ZG[row * 512 + ch]); } }
    }
}

__device__ __forceinline__ void phase_attn_naive(Ctx& C, KA AR, int l) {
    LAS float* Ks = (LAS float*)C.lds; LAS float* Vs = Ks + 64 * 65; LAS float* Qs = Vs + 64 * 65; LAS float* Ps = Qs + 64 * 64; LAS float* cks = Ps + 8 * 64;
    const bf16* Q = (const bf16*)(C.ws + WS_R1) + (size_t)2 * T * 512; const bf16* Kb = Q + (size_t)T * 512; const bf16* Vb = Kb + (size_t)T * 512;
    bf16* O = (bf16*)(C.ws + WS_R2); const float* c2k = (const float*)(C.ws + WS_C2K);
    for (int u = blockIdx.x; u < NB * NH * 64; u += gridDim.x) {
        const int qt = 63 - (u >> 5), bh = u & 31, b = bh >> 3, h = bh & 7, q0 = 64 * qt;
        const float* ck = c2k + (size_t)bh * S;
        __syncthreads();
        for (int e = C.tid; e < 64 * 64; e += 512) { const int r = e >> 6, d = e & 63; Qs[r * 64 + d] = bf2f(Q[(size_t)(b * S + q0 + r) * 512 + h * 64 + d]); }
        float m[8], lsum[8], o[8], cq[8];
#pragma unroll
        for (int i = 0; i < 8; ++i) { m[i] = -INFINITY; lsum[i] = 0.f; o[i] = 0.f; cq[i] = ck[q0 + C.wave * 8 + i]; }
        for (int kt = 0; kt <= qt; ++kt) {
            const int k0 = 64 * kt;
            __syncthreads();
            for (int e = C.tid; e < 64 * 64; e += 512) { const int r = e >> 6, d = e & 63; const size_t g = (size_t)(b * S + k0 + r) * 512 + h * 64 + d; Ks[r * 65 + d] = bf2f(Kb[g]); Vs[r * 65 + d] = bf2f(Vb[g]); }
            if (C.tid < 64) cks[C.tid] = ck[k0 + C.tid];
            __syncthreads();
#pragma unroll
            for (int i = 0; i < 8; ++i) {
                const int q = C.wave * 8 + i, qg = q0 + q;
                float dot = 0.f;
#pragma unroll 16
                for (int d = 0; d < 64; ++d) dot += Qs[q * 64 + d] * Ks[C.lane * 65 + d];
                float s = dot + cq[i] - cks[C.lane];
                if (k0 + C.lane > qg) s = -INFINITY;
                const float mn = fmaxf(m[i], wave_max(s));
                const float alpha = exp2f(m[i] - mn), p = exp2f(s - mn);
                lsum[i] = lsum[i] * alpha + wave_sum(p); m[i] = mn;
                Ps[C.wave * 64 + C.lane] = p;
                asm volatile("s_waitcnt lgkmcnt(0)" ::: "memory");
                float acc = 0.f;
#pragma unroll 16
                for (int k = 0; k < 64; ++k) acc += Ps[C.wave * 64 + k] * Vs[k * 65 + C.lane];
                o[i] = o[i] * alpha + acc;
                asm volatile("s_waitcnt lgkmcnt(0)" ::: "memory");
            }
        }
#pragma unroll
        for (int i = 0; i < 8; ++i) O[(size_t)(b * S + q0 + C.wave * 8 + i) * 512 + h * 64 + C.lane] = (bf16)f2bf(o[i] / lsum[i]);
    }
}

__device__ __forceinline__ void phase_mixnorm_naive(Ctx& C, KA AR, int l) {
    const float* YR = (const float*)(C.ws + WS_PROJ); const bf16* O = (const bf16*)(C.ws + WS_R2); bf16* YM = (bf16*)(C.ws + WS_R2 + 16 * MiB);
    const float* g1 = AR->in[I_LRUN] + l * DR; const float* g2 = AR->in[I_ATTN] + l * DA;
    for (int t = C.gw; t < T; t += C.ngw) {
        f32x4 a[2]; float s = 0.f;
#pragma unroll
        for (int j = 0; j < 2; ++j) { a[j] = *((const f32x4*)(YR + (size_t)t * 512) + C.lane + 64 * j); s += (a[j].x * a[j].x + a[j].y * a[j].y) + (a[j].z * a[j].z + a[j].w * a[j].w); }
        float rs = rsqrtf(wave_sum(s) * (1.f / 512.f) + EPS);
#pragma unroll
        for (int j = 0; j < 2; ++j) { const f32x4 g = *((const f32x4*)g1 + C.lane + 64 * j); const f32x4 v = a[j] * rs * g; v2u w; w.x = pk2(v.x, v.y); w.y = pk2(v.z, v.w);
            *((v2u*)(YM + (size_t)t * D) + C.lane + 64 * j) = w; }
        const v4u w = *(const v4u*)(O + (size_t)t * 512 + 8 * C.lane);
        float x[8] = {bflo(w.x), bfhi(w.x), bflo(w.y), bfhi(w.y), bflo(w.z), bfhi(w.z), bflo(w.w), bfhi(w.w)};
        s = 0.f;
#pragma unroll
        for (int e = 0; e < 8; ++e) s += x[e] * x[e];
        rs = rsqrtf(wave_sum(s) * (1.f / 512.f) + EPS);
#pragma unroll
        for (int e = 0; e < 8; ++e) x[e] = x[e] * rs * g2[8 * C.lane + e];
        v4u o; o.x = pk2(x[0], x[1]); o.y = pk2(x[2], x[3]); o.z = pk2(x[4], x[5]); o.w = pk2(x[6], x[7]);
        *(v4u*)(YM + (size_t)t * D + 512 + 8 * C.lane) = o;
    }
}

__device__ __forceinline__ void phase_wo_naive(Ctx& C, KA AR, int l) {
    const bf16* A = (const bf16*)(C.ws + WS_R2 + 16 * MiB); const bf16* Bt = (const bf16*)(C.ws + WS_WOUT) + (size_t)l * D * D;
    const float* xs = l == 0 ? AR->in[I_X] : (const float*)(C.ws + WS_X); float* X = (float*)(C.ws + WS_X);
    for (int u = blockIdx.x; u < (T / 64) * (D / 64); u += gridDim.x) {
        const int m0 = 64 * (u / (D / 64)), n0 = 64 * (u % (D / 64));
        ngemm_tile<1>((LAS float*)C.lds, D, [=](int r) { return A + (size_t)(m0 + r) * D; }, [=](int c, int) { return Bt + (size_t)(n0 + c) * D; },
            [=](int r, int c, float v, float) { const size_t i = (size_t)(m0 + r) * D + n0 + c; X[i] = xs[i] + v; }, C.tid);
    }
}

__device__ __forceinline__ void phase_router(Ctx& C, KA AR, int l) {
    const float* X = (const float*)(C.ws + WS_X); bf16* xn = (bf16*)(C.ws + WS_XN);
    const float* gain = AR->in[I_FFNN] + l * D; const float* wg = AR->in[I_WG] + (size_t)l * D * 4; const float* bg = AR->in[I_BG] + l * 4;
    const float* wr = AR->in[I_WRT] + (size_t)l * D * NE; const float* brt = AR->in[I_BRT] + l * NE;
    unsigned* cnt = (unsigned*)(C.ws + WS_CTL) + CW_CNT + 32 * CNT_STRIDE * l; int* rowpair = (int*)(C.ws + WS_ROWPAIR); float* pairw = (float*)(C.ws + WS_PAIRW);
    for (int t = C.gw; t < T; t += C.ngw) {
        f32x4 v[4]; load_row(X + (size_t)t * D, C.lane, v);
        const float rs = row_rs(v); scale_row(v, rs, gain, C.lane);
        store_row_bf16(xn + (size_t)t * D, C.lane, v);
        LAS float* rowl = (LAS float*)C.lds + C.wave * 1024;
#pragma unroll
        for (int j = 0; j < 4; ++j) *((LAS f32x4*)rowl + C.lane + 64 * j) = v[j];
        asm volatile("s_waitcnt lgkmcnt(0)" ::: "memory");
        float acc = 0.f;
        if (C.lane < 36) {
            const float* wp = C.lane < 32 ? wr + C.lane : wg + (C.lane - 32); const int st = C.lane < 32 ? NE : 4;
#pragma unroll 8
            for (int k = 0; k < D; ++k) acc += rowl[k] * wp[(size_t)k * st];
            acc += C.lane < 32 ? brt[C.lane] : bg[C.lane - 32];
        }
        asm volatile("s_waitcnt lgkmcnt(0)" ::: "memory");
        float gl[4];
#pragma unroll
        for (int i = 0; i < 4; ++i) gl[i] = __builtin_bit_cast(float, __builtin_amdgcn_readlane(__builtin_bit_cast(int, acc), 32 + i));
        int gi = 0; float gm = gl[0];
#pragma unroll
        for (int i = 1; i < 4; ++i) if (gl[i] > gm) { gm = gl[i]; gi = i; }
        float gs = 0.f;
#pragma unroll
        for (int i = 0; i < 4; ++i) gs += __expf(gl[i] - gm);
        const float gp = 1.f / gs;
        float ev[8];
#pragma unroll
        for (int i = 0; i < 8; ++i) ev[i] = __builtin_bit_cast(float, __builtin_amdgcn_readlane(__builtin_bit_cast(int, acc), __builtin_amdgcn_readfirstlane(gi) * 8 + i));
        int i0 = 0; float t0 = ev[0];
#pragma unroll
        for (int i = 1; i < 8; ++i) if (ev[i] > t0) { t0 = ev[i]; i0 = i; }
        int i1 = -1; float t1 = -INFINITY;
#pragma unroll
        for (int i = 0; i < 8; ++i) if (i != i0 && ev[i] > t1) { t1 = ev[i]; i1 = i; }
        const float ex = __expf(t1 - t0), w0 = gp / (1.f + ex), w1 = gp * ex / (1.f + ex);
        if (C.lane < 2) { const int e = gi * 8 + (C.lane == 0 ? i0 : i1); const unsigned pos = atomicAdd(cnt + e * CNT_STRIDE, 1u);
            rowpair[(size_t)e * CAP + pos] = 2 * t + C.lane; pairw[2 * t + C.lane] = C.lane == 0 ? w0 : w1; }
    }
}

struct ExpTab { int n[NE], hoff[NE], t0[NE + 1]; };
__device__ __forceinline__ void build_exptab(Ctx& C, int l, LAS int* tab) {
    __syncthreads();
    if (C.tid == 0) { const unsigned* cnt = (const unsigned*)(C.ws + WS_CTL) + CW_CNT + 32 * CNT_STRIDE * l; int ho = 0, tt = 0;
        for (int e = 0; e < NE; ++e) { const int n = (int)__hip_atomic_load(cnt + e * CNT_STRIDE, __ATOMIC_RELAXED, __HIP_MEMORY_SCOPE_AGENT); tab[e] = n; tab[32 + e] = ho; tab[64 + e] = tt; ho += (n + 255) & ~255; tt += (n + 63) >> 6; }
        tab[64 + NE] = tt; }
    __syncthreads();
}
__device__ __forceinline__ void phase_g1_naive(Ctx& C, KA AR, int l) {
    LAS int* tab = (LAS int*)(C.lds + 65536); build_exptab(C, l, tab);
    const bf16* xn = (const bf16*)(C.ws + WS_XN); const int* rowpair = (const int*)(C.ws + WS_ROWPAIR); bf16* Hb = (bf16*)(C.ws + WS_R2);
    const int nmt = tab[64 + NE];
    for (int u = blockIdx.x; u < nmt * 8; u += gridDim.x) {
        const int mtg = u >> 3, nt = u & 7; int e = 0;
        for (int i = 1; i < NE; ++i) if (tab[64 + i] <= mtg) e = i;
        const int mt = mtg - tab[64 + e], ne = tab[e], ho = tab[32 + e], p0 = 64 * mt, c0 = 64 * nt;
        const bf16* Bt = (const bf16*)(C.ws + WS_WGU) + (size_t)(l * NE + e) * 1024 * D; const int* rp = rowpair + (size_t)e * CAP;
        ngemm_tile<2>((LAS float*)C.lds, D,
            [=](int r) { return (p0 + r < ne) ? xn + (size_t)(rp[p0 + r] >> 1) * D : (const bf16*)nullptr; },
            [=](int c, int a) { const int cc = c0 + c; return Bt + (size_t)((cc >> 7) * 256 + (cc & 127) + a * 128) * D; },
            [=](int r, int c, float g, float uu) { if (p0 + r < ne) Hb[(size_t)(ho + p0 + r) * DE + c0 + c] = (bf16)f2bf(g / (1.f + __expf(-g)) * uu); }, C.tid);
    }
}
__device__ __forceinline__ void phase_g2_naive(Ctx& C, KA AR, int l) {
    LAS int* tab = (LAS int*)(C.lds + 65536); build_exptab(C, l, tab);
    const int* rowpair = (const int*)(C.ws + WS_ROWPAIR); const float* pairw = (const float*)(C.ws + WS_PAIRW); const bf16* Hb = (const bf16*)(C.ws + WS_R2); bf16* Y2 = (bf16*)(C.ws + WS_R1);
    const int nmt = tab[64 + NE];
    for (int u = blockIdx.x; u < nmt * 16; u += gridDim.x) {
        const int mtg = u >> 4, nt = u & 15; int e = 0;
        for (int i = 1; i < NE; ++i) if (tab[64 + i] <= mtg) e = i;
        const int mt = mtg - tab[64 + e], ne = tab[e], ho = tab[32 + e], p0 = 64 * mt, c0 = 64 * nt;
        const bf16* Bt = (const bf16*)(C.ws + WS_WDN) + (size_t)(l * NE + e) * D * DE; const int* rp = rowpair + (size_t)e * CAP;
        ngemm_tile<1>((LAS float*)C.lds, DE,
            [=](int r) { return (p0 + r < ne) ? Hb + (size_t)(ho + p0 + r) * DE : (const bf16*)nullptr; },
            [=](int c, int) { return Bt + (size_t)(c0 + c) * DE; },
            [=](int r, int c, float v, float) { if (p0 + r < ne) { const int p = rp[p0 + r]; Y2[(size_t)p * D + c0 + c] = (bf16)f2bf(v * pairw[p]); } }, C.tid);
    }
}

__device__ __forceinline__ void phase_combine(Ctx& C, KA AR, int l) {
    bf16* X = (bf16*)(C.ws + WS_X); const bf16* Y2 = (const bf16*)(C.ws + WS_R1); bf16* xn = (bf16*)(C.ws + WS_XN); const float* gain = AR->in[I_PLEN] + l * D;
    for (int t = 2 * C.gw; t < T; t += 2 * C.ngw) {
        v2u xa[2][4], ya[2][4], yb[2][4];
#pragma unroll
        for (int q = 0; q < 2; ++q)
#pragma unroll
            for (int j = 0; j < 4; ++j) { xa[q][j] = *((const v2u*)(X + (size_t)(t + q) * D) + C.lane + 64 * j);
                ya[q][j] = *((const v2u*)(Y2 + (size_t)(2 * (t + q)) * D) + C.lane + 64 * j); yb[q][j] = *((const v2u*)(Y2 + (size_t)(2 * (t + q) + 1) * D) + C.lane + 64 * j); }
#pragma unroll
        for (int q = 0; q < 2; ++q) { f32x4 v[4];
#pragma unroll
            for (int j = 0; j < 4; ++j) { const v2u x = xa[q][j], a = ya[q][j], b = yb[q][j];
                v[j].x = bflo(x.x) + (bflo(a.x) + bflo(b.x)); v[j].y = bfhi(x.x) + (bfhi(a.x) + bfhi(b.x)); v[j].z = bflo(x.y) + (bflo(a.y) + bflo(b.y)); v[j].w = bfhi(x.y) + (bfhi(a.y) + bfhi(b.y)); }
            store_row_bf16(X + (size_t)(t + q) * D, C.lane, v);
            const float rs = row_rs(v); scale_row(v, rs, gain, C.lane);
            store_row_bf16(xn + (size_t)(t + q) * D, C.lane, v); }
    }
}

__device__ __forceinline__ void phase_proj_naive(Ctx& C, KA AR, int l) {
    const bf16* A = (const bf16*)(C.ws + WS_PB) + (size_t)l * T * PLE; const bf16* Bt = (const bf16*)(C.ws + WS_WPP) + (size_t)l * D * PLE; bf16* PR = (bf16*)(C.ws + WS_PROJ);
    for (int u = blockIdx.x; u < (T / 64) * (D / 64); u += gridDim.x) {
        const int m0 = 64 * (u / (D / 64)), n0 = 64 * (u % (D / 64));
        ngemm_tile<1>((LAS float*)C.lds, PLE, [=](int r) { return A + (size_t)(m0 + r) * PLE; }, [=](int c, int) { return Bt + (size_t)(n0 + c) * PLE; },
            [=](int r, int c, float v, float) { PR[(size_t)(m0 + r) * D + n0 + c] = (bf16)f2bf(v); }, C.tid);
    }
}
__device__ __forceinline__ void phase_ple_naive(Ctx& C, KA AR, int l) {
    const bf16* A = (const bf16*)(C.ws + WS_XN); const bf16* Bt = (const bf16*)(C.ws + WS_WPG) + (size_t)l * D * D; const bf16* PR = (const bf16*)(C.ws + WS_PROJ);
    const float* X = (const float*)(C.ws + WS_X); float* dst = l == DEPTH - 1 ? AR->out : (float*)(C.ws + WS_X); const float* bias = AR->in[I_BPG] + l * D;
    for (int u = blockIdx.x; u < (T / 64) * (D / 64); u += gridDim.x) {
        const int m0 = 64 * (u / (D / 64)), n0 = 64 * (u % (D / 64));
        ngemm_tile<1>((LAS float*)C.lds, D, [=](int r) { return A + (size_t)(m0 + r) * D; }, [=](int c, int) { return Bt + (size_t)(n0 + c) * D; },
            [=](int r, int c, float v, float) { const size_t i = (size_t)(m0 + r) * D + n0 + c; dst[i] = X[i] + bf2f(PR[i]) * sigmoidf_(v + bias[n0 + c]); }, C.tid);
    }
}

namespace pg8 {
typedef unsigned short bf16_t;
typedef short bf16x8 __attribute__((ext_vector_type(8)));
typedef unsigned u32x4 __attribute__((ext_vector_type(4)));
constexpr int BM = 256, BK = 64, HALF = 128, HTB = HALF * BK * 2, STAGE_BYTES = 8 * HTB, NXCD = 8, WGM = 8;
__device__ __forceinline__ int lds_byte(int r, int c) { const int st = (r >> 4) * 2 + (c >> 5), rr = r & 15, cc = c & 31, ob = rr * 64 + cc * 2; return st * 1024 + (ob ^ (((ob >> 9) & 1) << 5)); }
__device__ __forceinline__ void stage_rc(int b, int& R, int& C) { const int st = b / 1024, sb = b % 1024, swz = sb ^ (((sb >> 9) & 1) << 5); R = (st >> 1) * 16 + swz / 64; C = (st & 1) * 32 + (swz % 64) / 2; }
__device__ __forceinline__ int perm32(int rho) { const int n = rho >> 4, i = rho & 15; return 8 * (i >> 2) + 4 * n + (i & 3); }
struct Unit { int pm, pn, e, aux, mt; };
struct Gemm { const bf16_t* A; const bf16_t* Bt; int K; };
struct StaticOrder {
    int nM, nN, nwg, G, c;
    __device__ void init(int M, int N, int G_, int c_) { nM = M / BM; nN = N / BM; nwg = nM * nN; G = G_; c = c_; }
    __device__ bool next(int i, Unit& u) const {
        const long L = (long)i * G + c; if (L >= nwg) return false;
        int wgid = (int)L; { const int q = nwg / NXCD, r = nwg % NXCD, xcd = wgid % NXCD, off = wgid / NXCD; wgid = (xcd < r ? xcd * (q + 1) : r * (q + 1) + (xcd - r) * q) + off; }
        const int nig = WGM * nN, gid = wgid / nig, fm = gid * WGM, gsz = (nM - fm) < WGM ? (nM - fm) : WGM;
        u.pm = fm + ((wgid % nig) % gsz); u.pn = (wgid % nig) / gsz; u.e = 0; u.aux = 256; u.mt = 0; return true;
    }
    __device__ __forceinline__ const char* a_base(const Gemm& g, const Unit& u) const { return (const char*)g.A + (size_t)u.pm * 512 * g.K; }
    __device__ __forceinline__ const char* b_base(const Gemm& g, const Unit& u) const { return (const char*)g.Bt + (size_t)u.pn * 512 * g.K; }
    __device__ __forceinline__ int a_row(const Unit&, int) const { return 0; }
};
__device__ __forceinline__ unsigned cvt_pk_bf16(float lo, float hi) { unsigned r; asm volatile("v_cvt_pk_bf16_f32 %0, %1, %2" : "=v"(r) : "v"(lo), "v"(hi)); return r; }

template <class Epi, class Sched, bool ALIGN_EPI, bool GATHER>
__device__ __forceinline__ void gemm_phase(LAS unsigned char* lds, const Gemm g, const Sched& S, const Epi& E, const int tid) {
    const int wid = __builtin_amdgcn_readfirstlane(tid >> 6), lane = tid & 63, wr = wid >> 2, wc = wid & 3, fr = lane & 15, fq = lane >> 4;
    const int K = g.K, nt = K / BK;
    unsigned voffB[2];
#pragma unroll
    for (int i = 0; i < 2; ++i) { int R, C; stage_rc(tid * 16 + i * 8192, R, C); const int Rb = Epi::PERM ? ((R & ~31) + perm32(R & 31)) : R; voffB[i] = (unsigned)(Rb * K + C) * 2u; }
    const size_t kstep = (size_t)(BK * 2);
    const size_t hstep = (size_t)HALF * K * 2;
    const size_t hsA = GATHER ? 0 : hstep;
    const unsigned ldsw = (unsigned)wid * 1024u;
    const int aoff = lds_byte(wr * 64 + fr, fq * 8), boff = lds_byte(wc * 32 + fr, fq * 8);
#define PG8_SA(b, h) (((b) * 2 + (h)) * HTB)
#define PG8_SB(b, h) ((4 + (b) * 2 + (h)) * HTB)
#define PG8_STAGE(bufoff, gbase, voff) do { _Pragma("unroll") for (int _i = 0; _i < 2; ++_i) \
        __builtin_amdgcn_global_load_lds((const unsigned*)((const char*)(gbase) + (voff)[_i]), (LAS unsigned*)(lds + (bufoff) + ldsw + _i * 8192), 16, 0, 0); } while (0)
#define PG8_LDA(dst, b, h) do { _Pragma("unroll") for (int m = 0; m < 4; ++m) _Pragma("unroll") for (int k = 0; k < 2; ++k) dst[m][k] = *(const LAS bf16x8*)(lds + PG8_SA(b, h) + aoff + m * 2048 + k * 1024); } while (0)
#define PG8_LDB(dst, b, h) do { _Pragma("unroll") for (int n = 0; n < 2; ++n) _Pragma("unroll") for (int k = 0; k < 2; ++k) dst[n][k] = *(const LAS bf16x8*)(lds + PG8_SB(b, h) + boff + n * 2048 + k * 1024); } while (0)
#define PG8_MMA(ai, bj, At, Bt) do { __builtin_amdgcn_s_setprio(1); _Pragma("unroll") for (int m = 0; m < 4; ++m) _Pragma("unroll") for (int n = 0; n < 2; ++n) _Pragma("unroll") for (int k = 0; k < 2; ++k) \
        acc[ai][bj][m][n] = __builtin_amdgcn_mfma_f32_16x16x32_bf16(Bt[n][k], At[m][k], acc[ai][bj][m][n], 0, 0, 0); __builtin_amdgcn_s_setprio(0); } while (0)
#define PG8_WAIT_V(n) asm volatile("s_waitcnt vmcnt(" #n ")" ::: "memory")
#define PG8_WAIT_L(n) asm volatile("s_waitcnt lgkmcnt(" #n ")" ::: "memory")
#define PG8_BAR __builtin_amdgcn_s_barrier()
#define PG8_SCHED __builtin_amdgcn_sched_barrier(0)
#define PG8_VOFF(dst, u) do { int t_ = tid; if (GATHER) asm volatile("" : "+v"(t_));   \
        _Pragma("unroll") for (int i_ = 0; i_ < 2; ++i_) { int R_, C_; stage_rc(t_ * 16 + i_ * 8192, R_, C_); _Pragma("unroll") for (int h_ = 0; h_ < 2; ++h_) \
        dst[h_][i_] = GATHER ? (unsigned)(S.a_row(u, h_ * HALF + R_) * K + C_) * 2u : (unsigned)(R_ * K + C_) * 2u; } } while (0)
    Unit cur, nxt; int ui = 0;
    if (!S.next(0, cur)) return;
    f32x4 acc[2][2][4][2];
#pragma unroll
    for (int a = 0; a < 2; ++a)
#pragma unroll
        for (int b = 0; b < 2; ++b)
#pragma unroll
            for (int m = 0; m < 4; ++m)
#pragma unroll
                for (int n = 0; n < 2; ++n) acc[a][b][m][n] = (f32x4){0.f, 0.f, 0.f, 0.f};
    if constexpr (Epi::INIT) E.init(acc, cur, wr, wc, fr, fq);
    bf16x8 At[4][2], B0[2][2], B1[2][2];
    unsigned vC[2][2], vN[2][2], vX[2][2];
    PG8_VOFF(vC, cur);
    const char* cA = S.a_base(g, cur); const char* cB = S.b_base(g, cur);
    PG8_STAGE(PG8_SB(0, 0), cB, voffB); PG8_STAGE(PG8_SB(0, 1), cB + hstep, voffB); PG8_STAGE(PG8_SA(0, 0), cA, vC[0]); PG8_STAGE(PG8_SA(0, 1), cA + hsA, vC[1]);
    if (wr == 1) PG8_BAR;
    PG8_WAIT_V(2); PG8_BAR;
    PG8_STAGE(PG8_SB(1, 0), cB + kstep, voffB); PG8_STAGE(PG8_SA(1, 0), cA + kstep, vC[0]); PG8_STAGE(PG8_SB(1, 1), cB + hstep + kstep, voffB);
    PG8_WAIT_V(6); PG8_BAR;
    for (;;) {
        const bool has_next = S.next(ui + 1, nxt);
        const char* nA = has_next ? S.a_base(g, nxt) : cA; const char* nB = has_next ? S.b_base(g, nxt) : cB;
        if (GATHER && has_next) { PG8_VOFF(vN, nxt); }
        else {
#pragma unroll
            for (int h_ = 0; h_ < 2; ++h_)
#pragma unroll
                for (int i_ = 0; i_ < 2; ++i_) vN[h_][i_] = vC[h_][i_]; }
#pragma unroll 1
        for (int t = 0; t < nt; t += 2) {
            const bool last = (t == nt - 2);
            const char* a1 = cA + (size_t)(t + 1) * kstep;
            const char* a2 = last ? nA : cA + (size_t)(t + 2) * kstep; const char* b2 = last ? nB : cB + (size_t)(t + 2) * kstep;
            const char* a3 = a2 + kstep; const char* b3 = b2 + kstep;
#pragma unroll
            for (int h_ = 0; h_ < 2; ++h_)
#pragma unroll
                for (int i_ = 0; i_ < 2; ++i_) vX[h_][i_] = (GATHER && last) ? vN[h_][i_] : vC[h_][i_];
            PG8_LDB(B0, 0, 0); PG8_LDB(B1, 0, 1); PG8_SCHED; PG8_LDA(At, 0, 0); PG8_STAGE(PG8_SA(1, 1), a1 + hsA, vC[1]);
            PG8_WAIT_V(8); PG8_WAIT_L(0); PG8_BAR; PG8_MMA(0, 0, At, B0); PG8_MMA(0, 1, At, B1); PG8_BAR; PG8_SCHED;
            PG8_LDA(At, 0, 1); PG8_STAGE(PG8_SB(0, 0), b2, voffB); PG8_STAGE(PG8_SB(0, 1), b2 + hstep, voffB); PG8_STAGE(PG8_SA(0, 0), a2, vX[0]);
            PG8_WAIT_V(8); PG8_WAIT_L(0); PG8_BAR; PG8_MMA(1, 0, At, B0); PG8_MMA(1, 1, At, B1); PG8_BAR; PG8_SCHED;
            PG8_LDB(B0, 1, 0); PG8_LDB(B1, 1, 1); PG8_SCHED; PG8_LDA(At, 1, 0); PG8_STAGE(PG8_SA(0, 1), a2 + hsA, vX[1]);
            PG8_WAIT_V(8); PG8_WAIT_L(0); PG8_BAR; PG8_MMA(0, 0, At, B0); PG8_MMA(0, 1, At, B1); PG8_BAR; PG8_SCHED;
            PG8_LDA(At, 1, 1); PG8_STAGE(PG8_SB(1, 0), b3, voffB); PG8_STAGE(PG8_SB(1, 1), b3 + hstep, voffB); PG8_STAGE(PG8_SA(1, 0), a3, vX[0]);
            PG8_WAIT_V(8); PG8_WAIT_L(0); PG8_BAR; PG8_MMA(1, 0, At, B0); PG8_MMA(1, 1, At, B1); PG8_BAR; PG8_SCHED;
        }
        if constexpr (ALIGN_EPI) { if (wr == 0) PG8_BAR; }
        E(acc, cur, wr, wc, fr, fq);
        if (!has_next) break;
#pragma unroll
        for (int a = 0; a < 2; ++a)
#pragma unroll
            for (int b = 0; b < 2; ++b)
#pragma unroll
                for (int m = 0; m < 4; ++m)
#pragma unroll
                    for (int n = 0; n < 2; ++n) acc[a][b][m][n] = (f32x4){0.f, 0.f, 0.f, 0.f};
        if constexpr (Epi::INIT) E.init(acc, nxt, wr, wc, fr, fq);
        cur = nxt; cA = nA; cB = nB; ++ui;
#pragma unroll
        for (int h_ = 0; h_ < 2; ++h_)
#pragma unroll
            for (int i_ = 0; i_ < 2; ++i_) vC[h_][i_] = vN[h_][i_];
        if constexpr (ALIGN_EPI) { if (wr == 1) PG8_BAR; }
    }
    PG8_WAIT_V(0);
    if constexpr (!ALIGN_EPI) { if (wr == 0) PG8_BAR; }
    PG8_BAR;
#undef PG8_SA
#undef PG8_SB
#undef PG8_STAGE
#undef PG8_LDA
#undef PG8_LDB
#undef PG8_MMA
#undef PG8_WAIT_V
#undef PG8_WAIT_L
#undef PG8_BAR
#undef PG8_SCHED
#undef PG8_VOFF
}
}

__device__ __forceinline__ float gelu_fast(float v) { const float y = 0.7978845608028654f * (v + 0.044715f * v * v * v); return v * __builtin_amdgcn_rcpf(1.f + __expf(-2.f * y)); }
__device__ __forceinline__ float sigmoid_fast(float v) { return __builtin_amdgcn_rcpf(1.f + __expf(-v)); }

struct EpiZ {
    static constexpr bool PERM = true, INIT = false;
    bf16* R1; const float* gq; const float* gk;
    __device__ __forceinline__ void operator()(const f32x4 (&acc)[2][2][4][2], const pg8::Unit& u, int wr, int wc, int fr, int fq) const {
        const int seg = u.pn >> 1;
        bf16* base = R1 + (size_t)seg * T * 512 + (size_t)(u.pm * 256 + wr * 64 + fr) * 512 + (u.pn & 1) * 256 + wc * 64 + 8 * fq;
        if (seg == 2 || seg == 3) {
            const float* g = seg == 2 ? gq : gk; const float sc = seg == 2 ? C2 : 1.f;
            f32x4 gv[2][2];
#pragma unroll
            for (int bj = 0; bj < 2; ++bj)
#pragma unroll
                for (int n = 0; n < 2; ++n) gv[bj][n] = *(const f32x4*)(g + 32 * bj + 8 * fq + 4 * n);
#pragma unroll
            for (int ai = 0; ai < 2; ++ai)
#pragma unroll
                for (int m = 0; m < 4; ++m) {
                    float s = 0.f;
#pragma unroll
                    for (int bj = 0; bj < 2; ++bj)
#pragma unroll
                        for (int n = 0; n < 2; ++n) { const f32x4 x = acc[ai][bj][m][n]; s += (x[0] * x[0] + x[1] * x[1]) + (x[2] * x[2] + x[3] * x[3]); }
                    s += lane_xor<16>(s); s = half_sum32(s);
                    const float rs = rsqrtf(s * (1.f / 64.f) + EPS) * sc;
#pragma unroll
                    for (int bj = 0; bj < 2; ++bj) { const f32x4 v0 = acc[ai][bj][m][0] * rs * gv[bj][0], v1 = acc[ai][bj][m][1] * rs * gv[bj][1];
                        v4u w; w.x = pg8::cvt_pk_bf16(v0[0], v0[1]); w.y = pg8::cvt_pk_bf16(v0[2], v0[3]); w.z = pg8::cvt_pk_bf16(v1[0], v1[1]); w.w = pg8::cvt_pk_bf16(v1[2], v1[3]);
                        *(v4u*)(base + (size_t)(ai * 128 + m * 16) * 512 + 32 * bj) = w; }
                }
        } else {
#pragma unroll
            for (int ai = 0; ai < 2; ++ai)
#pragma unroll
                for (int m = 0; m < 4; ++m)
#pragma unroll
                    for (int bj = 0; bj < 2; ++bj) { f32x4 v0 = acc[ai][bj][m][0], v1 = acc[ai][bj][m][1];
                        if (seg == 1) { v0 = (f32x4){gelu_fast(v0[0]), gelu_fast(v0[1]), gelu_fast(v0[2]), gelu_fast(v0[3])}; v1 = (f32x4){gelu_fast(v1[0]), gelu_fast(v1[1]), gelu_fast(v1[2]), gelu_fast(v1[3])}; }
                        v4u w; w.x = pg8::cvt_pk_bf16(v0[0], v0[1]); w.y = pg8::cvt_pk_bf16(v0[2], v0[3]); w.z = pg8::cvt_pk_bf16(v1[0], v1[1]); w.w = pg8::cvt_pk_bf16(v1[2], v1[3]);
                        *(v4u*)(base + (size_t)(ai * 128 + m * 16) * 512 + 32 * bj) = w; }
        }
    }
};
__device__ __forceinline__ void phase_gemm1_fast(Ctx& C, KA AR, int l) {
    phase_cumsum_fast(C, AR);
    pg8::Gemm g{(const bf16*)(C.ws + WS_XN), (const bf16*)(C.ws + WS_WIN) + (size_t)l * NZ * D, D};
    pg8::StaticOrder S; S.init(T, NZ, gridDim.x, blockIdx.x);
    EpiZ E{(bf16*)(C.ws + WS_R1), AR->in[I_QN] + l * HD, AR->in[I_KN] + l * HD};
    pg8::gemm_phase<EpiZ, pg8::StaticOrder, true, false>(C.lds, g, S, E, C.tid);
}
struct EpiRes {
    static constexpr bool PERM = true, INIT = true;
    const float* xs32; const bf16* xs16; bf16* X;
    __device__ __forceinline__ void init(f32x4 (&acc)[2][2][4][2], const pg8::Unit& u, int wr, int wc, int fr, int fq) const {
        const size_t off0 = (size_t)(u.pm * 256 + wr * 64 + fr) * D + u.pn * 256 + wc * 32 + 8 * fq;
#pragma unroll
        for (int ai = 0; ai < 2; ++ai)
#pragma unroll
            for (int m = 0; m < 4; ++m)
#pragma unroll
                for (int bj = 0; bj < 2; ++bj) { const size_t o = off0 + (size_t)(ai * 128 + m * 16) * D + bj * 128;
                    if (xs16) { const v4u w = *(const v4u*)(xs16 + o); acc[ai][bj][m][0] = (f32x4){bflo(w.x), bfhi(w.x), bflo(w.y), bfhi(w.y)}; acc[ai][bj][m][1] = (f32x4){bflo(w.z), bfhi(w.z), bflo(w.w), bfhi(w.w)}; }
                    else { acc[ai][bj][m][0] = *(const f32x4*)(xs32 + o); acc[ai][bj][m][1] = *(const f32x4*)(xs32 + o + 4); } }
    }
    __device__ __forceinline__ void operator()(const f32x4 (&acc)[2][2][4][2], const pg8::Unit& u, int wr, int wc, int fr, int fq) const {
        const size_t off0 = (size_t)(u.pm * 256 + wr * 64 + fr) * D + u.pn * 256 + wc * 32 + 8 * fq;
#pragma unroll
        for (int ai = 0; ai < 2; ++ai)
#pragma unroll
            for (int m = 0; m < 4; ++m)
#pragma unroll
                for (int bj = 0; bj < 2; ++bj) { const f32x4 v0 = acc[ai][bj][m][0], v1 = acc[ai][bj][m][1];
                    v4u w; w.x = pg8::cvt_pk_bf16(v0[0], v0[1]); w.y = pg8::cvt_pk_bf16(v0[2], v0[3]); w.z = pg8::cvt_pk_bf16(v1[0], v1[1]); w.w = pg8::cvt_pk_bf16(v1[2], v1[3]);
                    *(v4u*)(X + off0 + (size_t)(ai * 128 + m * 16) * D + bj * 128) = w; }
    }
};
__device__ __forceinline__ void phase_wo_fast(Ctx& C, KA AR, int l) {
    pg8::Gemm g{(const bf16*)(C.ws + WS_R2 + 16 * MiB), (const bf16*)(C.ws + WS_WOUT) + (size_t)l * D * D, D};
    pg8::StaticOrder S; S.init(T, D, gridDim.x, blockIdx.x);
    EpiRes E{l == 0 ? AR->in[I_X] : (const float*)nullptr, l == 0 ? (const bf16*)nullptr : (const bf16*)(C.ws + WS_X), (bf16*)(C.ws + WS_X)};
    pg8::gemm_phase<EpiRes, pg8::StaticOrder, true, false>(C.lds, g, S, E, C.tid);
}
struct EpiProj {
    static constexpr bool PERM = true, INIT = false;
    bf16* PR;
    __device__ __forceinline__ void operator()(const f32x4 (&acc)[2][2][4][2], const pg8::Unit& u, int wr, int wc, int fr, int fq) const {
        bf16* base = PR + (size_t)(u.pm * 256 + wr * 64 + fr) * D + u.pn * 256 + wc * 32 + 8 * fq;
#pragma unroll
        for (int ai = 0; ai < 2; ++ai)
#pragma unroll
            for (int m = 0; m < 4; ++m)
#pragma unroll
                for (int bj = 0; bj < 2; ++bj) { const f32x4 v0 = acc[ai][bj][m][0], v1 = acc[ai][bj][m][1];
                    v4u w; w.x = pg8::cvt_pk_bf16(v0[0], v0[1]); w.y = pg8::cvt_pk_bf16(v0[2], v0[3]); w.z = pg8::cvt_pk_bf16(v1[0], v1[1]); w.w = pg8::cvt_pk_bf16(v1[2], v1[3]);
                    *(v4u*)(base + (size_t)(ai * 128 + m * 16) * D + bj * 128) = w; }
    }
};
__device__ __forceinline__ void phase_proj_fast(Ctx& C, KA AR, int l) {
    pg8::Gemm g{(const bf16*)(C.ws + WS_PB) + (size_t)l * T * PLE, (const bf16*)(C.ws + WS_WPP) + (size_t)l * D * PLE, PLE};
    pg8::StaticOrder S;
    { const int G = gridDim.x, hb = G / 2; if ((int)blockIdx.x >= hb) S.init(T, D, G - hb, (int)blockIdx.x - hb); else S.init(T, D, G - hb, T); }
    EpiProj E{(bf16*)(C.ws + WS_PROJ)};
    pg8::gemm_phase<EpiProj, pg8::StaticOrder, true, false>(C.lds, g, S, E, C.tid);
}
struct EpiPle {
    static constexpr bool PERM = true, INIT = false;
    const bf16* X; const bf16* PR; const float* bias; bf16* dst16; float* dst32; float pscale;
    __device__ __forceinline__ void operator()(const f32x4 (&acc)[2][2][4][2], const pg8::Unit& u, int wr, int wc, int fr, int fq) const {
        const int col0 = u.pn * 256 + wc * 32 + 8 * fq;
        const size_t off0 = (size_t)(u.pm * 256 + wr * 64 + fr) * D + col0;
        f32x4 bv[2][2];
#pragma unroll
        for (int bj = 0; bj < 2; ++bj)
#pragma unroll
            for (int n = 0; n < 2; ++n) bv[bj][n] = *(const f32x4*)(bias + col0 + bj * 128 + 4 * n);
#pragma unroll
        for (int ai = 0; ai < 2; ++ai)
#pragma unroll
            for (int mh = 0; mh < 2; ++mh) { v4u xr[2][2], pr[2][2];
#pragma unroll
                for (int mm = 0; mm < 2; ++mm)
#pragma unroll
                    for (int bj = 0; bj < 2; ++bj) { const size_t o = off0 + (size_t)(ai * 128 + (2 * mh + mm) * 16) * D + bj * 128; xr[mm][bj] = *(const v4u*)(X + o); pr[mm][bj] = *(const v4u*)(PR + o); }
#pragma unroll
                for (int mm = 0; mm < 2; ++mm)
#pragma unroll
                    for (int bj = 0; bj < 2; ++bj) { const size_t o = off0 + (size_t)(ai * 128 + (2 * mh + mm) * 16) * D + bj * 128;
                        const v4u xw = xr[mm][bj], pw = pr[mm][bj]; const f32x4 a0 = acc[ai][bj][2 * mh + mm][0] + bv[bj][0], a1 = acc[ai][bj][2 * mh + mm][1] + bv[bj][1];
                        f32x4 r0, r1;
                        r0[0] = bflo(xw.x) + bflo(pw.x) * sigmoid_fast(a0[0]); r0[1] = bfhi(xw.x) + bfhi(pw.x) * sigmoid_fast(a0[1]); r0[2] = bflo(xw.y) + bflo(pw.y) * sigmoid_fast(a0[2]); r0[3] = bfhi(xw.y) + bfhi(pw.y) * sigmoid_fast(a0[3]);
                        r1[0] = bflo(xw.z) + bflo(pw.z) * sigmoid_fast(a1[0]); r1[1] = bfhi(xw.z) + bfhi(pw.z) * sigmoid_fast(a1[1]); r1[2] = bflo(xw.w) + bflo(pw.w) * sigmoid_fast(a1[2]); r1[3] = bfhi(xw.w) + bfhi(pw.w) * sigmoid_fast(a1[3]);
                        if (PROBE_TIMING) { r0 = r0 * pscale; r1 = r1 * pscale; }
                        if (dst16) { v4u w; w.x = pg8::cvt_pk_bf16(r0[0], r0[1]); w.y = pg8::cvt_pk_bf16(r0[2], r0[3]); w.z = pg8::cvt_pk_bf16(r1[0], r1[1]); w.w = pg8::cvt_pk_bf16(r1[2], r1[3]); *(v4u*)(dst16 + o) = w; }
                        else { *(f32x4*)(dst32 + o) = r0; *(f32x4*)(dst32 + o + 4) = r1; } } }
    }
};
__device__ __forceinline__ void phase_ple_fast(Ctx& C, KA AR, int l) {
    pg8::Gemm g{(const bf16*)(C.ws + WS_XN), (const bf16*)(C.ws + WS_WPG) + (size_t)l * D * D, D};
    pg8::StaticOrder S; S.init(T, D, gridDim.x, blockIdx.x);
    float pscale = 1.f;
    if (PROBE_TIMING && l == DEPTH - 1) { const unsigned long long* ts = (const unsigned long long*)((const unsigned*)(C.ws + WS_CTL) + CW_TS); pscale = 1.f + (float)(ts[PROBE_HI] - ts[PROBE_LO]) * 1.5e-6f; }
    EpiPle E{(const bf16*)(C.ws + WS_X), (const bf16*)(C.ws + WS_PROJ), AR->in[I_BPG] + l * D, l == DEPTH - 1 ? (bf16*)nullptr : (bf16*)(C.ws + WS_X), l == DEPTH - 1 ? AR->out : (float*)nullptr, pscale};
    pg8::gemm_phase<EpiPle, pg8::StaticOrder, true, false>(C.lds, g, S, E, C.tid);
}
constexpr int TAB_OFF = MISC_OFF - 4096;
struct GroupOrder {
    const LAS int* tab; int G, c; const int* rowpair; const char* hbase; bool is_g2;
    __device__ bool next(int i, pg8::Unit& u) const {
        int j = i * (G >> 3) + (c >> 3);
#pragma unroll
        for (int q = 0; q < 4; ++q) { const int e = (c & 7) + 8 * q;
            const int t0 = __builtin_amdgcn_readfirstlane(tab[64 + e]), t1 = __builtin_amdgcn_readfirstlane(tab[64 + e + 1]), nu = (t1 - t0) * 4;
            if (j < nu) { const int mt = j >> 2; const int ne = __builtin_amdgcn_readfirstlane(tab[e]), ho = __builtin_amdgcn_readfirstlane(tab[32 + e]);
                int nv = ne - 256 * mt; nv = nv > 256 ? 256 : nv;
                u.pm = ho + 256 * mt; u.pn = j & 3; u.e = e; u.aux = nv; u.mt = mt; return true; }
            j -= nu; }
        return false;
    }
    __device__ __forceinline__ const char* a_base(const pg8::Gemm& g, const pg8::Unit& u) const { return is_g2 ? (const char*)g.A + (size_t)u.pm * 2 * g.K : (const char*)g.A; }
    __device__ __forceinline__ const char* b_base(const pg8::Gemm& g, const pg8::Unit& u) const { return (const char*)g.Bt + (size_t)(u.e * 1024 + u.pn * 256) * 2 * g.K; }
    __device__ __forceinline__ int a_row(const pg8::Unit& u, int r) const { return r < u.aux ? (rowpair[(size_t)u.e * CAP + u.mt * 256 + r] >> 1) : 0; }
};
__device__ __forceinline__ void build_exptab256(Ctx& C, int l, LAS int* tab) {
    __syncthreads();
    if (C.tid < NE) { const unsigned* cnt = (const unsigned*)(C.ws + WS_CTL) + CW_CNT + 32 * CNT_STRIDE * l;
        tab[C.tid] = (int)__hip_atomic_load(cnt + C.tid * CNT_STRIDE, __ATOMIC_RELAXED, __HIP_MEMORY_SCOPE_AGENT); }
    __syncthreads();
    if (C.tid == 0) { int ho = 0, tt = 0;
        for (int e = 0; e < NE; ++e) { const int n = tab[e]; tab[32 + e] = ho; tab[64 + e] = tt;
            const int nt = (n + 255) >> 8; for (int j = 0; j < nt; ++j) tab[128 + tt + j] = e | (j << 8); ho += nt << 8; tt += nt; }
        tab[64 + NE] = tt; }
    __syncthreads();
}
struct EpiG1 {
    static constexpr bool PERM = true, INIT = false;
    bf16* Hb;
    __device__ __forceinline__ void operator()(const f32x4 (&acc)[2][2][4][2], const pg8::Unit& u, int wr, int wc, int fr, int fq) const {
        bf16* base = Hb + (size_t)(u.pm + wr * 64 + fr) * DE + u.pn * 128 + wc * 32 + 8 * fq;
#pragma unroll
        for (int ai = 0; ai < 2; ++ai)
#pragma unroll
            for (int m = 0; m < 4; ++m) { const int rl = ai * 128 + wr * 64 + m * 16 + fr;
                f32x4 h0, h1;
#pragma unroll
                for (int e = 0; e < 4; ++e) { const float g0 = acc[ai][0][m][0][e], g1 = acc[ai][0][m][1][e]; h0[e] = g0 * sigmoid_fast(g0) * acc[ai][1][m][0][e]; h1[e] = g1 * sigmoid_fast(g1) * acc[ai][1][m][1][e]; }
                v4u w; w.x = pg8::cvt_pk_bf16(h0[0], h0[1]); w.y = pg8::cvt_pk_bf16(h0[2], h0[3]); w.z = pg8::cvt_pk_bf16(h1[0], h1[1]); w.w = pg8::cvt_pk_bf16(h1[2], h1[3]);
                if (rl < u.aux) *(v4u*)(base + (size_t)(ai * 128 + m * 16) * DE) = w; }
    }
};
__device__ __forceinline__ void phase_g1_fast(Ctx& C, KA AR, int l) {
    LAS int* tab = (LAS int*)(C.lds + TAB_OFF); build_exptab256(C, l, tab);
    pg8::Gemm g{(const bf16*)(C.ws + WS_XN), (const bf16*)(C.ws + WS_WGU) + (size_t)l * NE * 1024 * D, D};
    GroupOrder S{tab, (int)gridDim.x, (int)blockIdx.x, (const int*)(C.ws + WS_ROWPAIR), nullptr, false};
    EpiG1 E{(bf16*)(C.ws + WS_R2)};
    pg8::gemm_phase<EpiG1, GroupOrder, true, true>(C.lds, g, S, E, C.tid);
}
struct EpiG2 {
    static constexpr bool PERM = true, INIT = false;
    bf16* Y2; const int* rowpair; const float* pairw;
    __device__ __forceinline__ void operator()(const f32x4 (&acc)[2][2][4][2], const pg8::Unit& u, int wr, int wc, int fr, int fq) const {
        const int* rp = rowpair + (size_t)u.e * CAP + u.mt * 256; const int col0 = u.pn * 256 + wc * 32 + 8 * fq;
        int pr[2][4]; float wv[2][4];
#pragma unroll
        for (int ai = 0; ai < 2; ++ai)
#pragma unroll
            for (int m = 0; m < 4; ++m) { const int rl = ai * 128 + wr * 64 + m * 16 + fr; pr[ai][m] = rl < u.aux ? rp[rl] : 0; }
#pragma unroll
        for (int ai = 0; ai < 2; ++ai)
#pragma unroll
            for (int m = 0; m < 4; ++m) wv[ai][m] = pairw[pr[ai][m]];
#pragma unroll
        for (int ai = 0; ai < 2; ++ai)
#pragma unroll
            for (int m = 0; m < 4; ++m) { const int rl = ai * 128 + wr * 64 + m * 16 + fr;
                if (rl < u.aux) { const float w8 = wv[ai][m]; bf16* row = Y2 + (size_t)pr[ai][m] * D + col0;
#pragma unroll
                    for (int bj = 0; bj < 2; ++bj) { const f32x4 v0 = acc[ai][bj][m][0] * w8, v1 = acc[ai][bj][m][1] * w8;
                        v4u w; w.x = pg8::cvt_pk_bf16(v0[0], v0[1]); w.y = pg8::cvt_pk_bf16(v0[2], v0[3]); w.z = pg8::cvt_pk_bf16(v1[0], v1[1]); w.w = pg8::cvt_pk_bf16(v1[2], v1[3]);
                        *(v4u*)(row + bj * 128) = w; } } }
    }
};
__device__ __forceinline__ void phase_g2_fast(Ctx& C, KA AR, int l) {
    LAS int* tab = (LAS int*)(C.lds + TAB_OFF); build_exptab256(C, l, tab);
    pg8::Gemm g{(const bf16*)(C.ws + WS_R2), (const bf16*)(C.ws + WS_WDN) + (size_t)l * NE * D * DE, DE};
    GroupOrder S{tab, (int)gridDim.x, (int)blockIdx.x, (const int*)(C.ws + WS_ROWPAIR), nullptr, true};
    EpiG2 E{(bf16*)(C.ws + WS_R1), (const int*)(C.ws + WS_ROWPAIR), (const float*)(C.ws + WS_PAIRW)};
    pg8::gemm_phase<EpiG2, GroupOrder, true, false>(C.lds, g, S, E, C.tid);
}

#define SBAR() __builtin_amdgcn_sched_barrier(0)
namespace attn_body {
using bf16=__hip_bfloat16;
using bf16x8=__attribute__((ext_vector_type(8)))short;
using s16x4=__attribute__((ext_vector_type(4)))short;
using f32x16=__attribute__((ext_vector_type(16)))float;
using u32x4=__attribute__((ext_vector_type(4)))unsigned;
constexpr int BATCH=4,NHEAD=8,SEQ=4096,D=64,DM=NHEAD*D;
constexpr int NW=8,QBLK=32,QB=QBLK*NW,KVBLK=64,NQB=SEQ/QB;
constexpr int ATTN_PITCH=DM, ATTN_UNIT_ROWS=QB;
__device__ __forceinline__ int crow(int r,int hi){return (r&3)+8*(r>>2)+4*hi;}
#define SBAR() __builtin_amdgcn_sched_barrier(0)
__device__ __forceinline__ void cmask(f32x16&p0,f32x16&p1,int jb,int qrel,int hi){
  const float NEG=-INFINITY; int kb=64*jb+4*hi;
  #pragma unroll
  for(int r=0;r<16;++r){int kv=kb+(r&3)+8*(r>>2); if(kv>qrel)p0[r]=NEG; if(kv+32>qrel)p1[r]=NEG;}
}

constexpr int NSLOT=3, SLOTB=8192;
constexpr int LDS_K=0, LDS_V=NSLOT*SLOTB, LDS_WS=2*NSLOT*SLOTB, LDS_OST=LDS_WS+NW*64*4, LDS_CK=LDS_OST+NW*4096, LDS_BYTES=LDS_CK+SEQ*4;
constexpr float C2=0.125f*1.4426950408889634f;
__device__ __forceinline__ void glds16(const void*gsrc,unsigned lds_dst){unsigned keep;
  asm volatile("s_mov_b32 %0, m0\n\ts_mov_b32 m0, %2\n\ts_nop 0\n\tglobal_load_lds_dwordx4 %1, off\n\ts_mov_b32 m0, %0":"=&s"(keep):"v"(gsrc),"s"(lds_dst):"memory");}
__device__ __forceinline__ float max3f(float a,float b,float c){float r;asm("v_max3_f32 %0, %1, %2, %3":"=v"(r):"v"(a),"v"(b),"v"(c));return r;}
__device__ __forceinline__ float max2f(float a,float b){float r;asm("v_max_f32_e32 %0, %1, %2":"=v"(r):"v"(a),"v"(b));return r;}
__device__ __forceinline__ float fadd_s(float a,float b){float r;asm("v_add_f32_e32 %0, %1, %2":"=v"(r):"v"(a),"v"(b));return r;}
__device__ __forceinline__ float fsub_s(float a,float b){float r;asm("v_sub_f32_e32 %0, %1, %2":"=v"(r):"v"(a),"v"(b));return r;}
typedef float f32x2_t __attribute__((ext_vector_type(2))); typedef __bf16 bf16x2_t __attribute__((ext_vector_type(2)));
__device__ __forceinline__ unsigned cvtpk_s(float lo,float hi){f32x2_t v={lo,hi};bf16x2_t b=__builtin_convertvector(v,bf16x2_t);return __builtin_bit_cast(unsigned,b);}
#define WAIT_BAR(N) asm volatile("s_waitcnt vmcnt(" #N ") lgkmcnt(0)\n\ts_barrier":::"memory")

__device__ __forceinline__ void qkt(f32x16&p0,f32x16&p1,const char*Kslot,const bf16x8*qr,const f32x16&negm,int r32,int hi){
  const char*kb=Kslot+hi*1024+r32*16;
  #pragma unroll
  for(int d0=0;d0<4;++d0){
    const bf16x8 b0=*reinterpret_cast<const bf16x8*>(kb+d0*2048);
    const bf16x8 b1=*reinterpret_cast<const bf16x8*>(kb+d0*2048+512);
    if(d0==0){p0=__builtin_amdgcn_mfma_f32_32x32x16_bf16(b0,qr[0],negm,0,0,0);p1=__builtin_amdgcn_mfma_f32_32x32x16_bf16(b1,qr[0],negm,0,0,0);}
    else{p0=__builtin_amdgcn_mfma_f32_32x32x16_bf16(b0,qr[d0],p0,0,0,0);p1=__builtin_amdgcn_mfma_f32_32x32x16_bf16(b1,qr[d0],p1,0,0,0);}}
}
typedef __attribute__((address_space(3))) const char* lds_cptr;
typedef short v4i16_t __attribute__((ext_vector_type(4)));
__device__ __forceinline__ void kload8(bf16x8*kf,lds_cptr kp){
  kf[0]=*(const __attribute__((address_space(3))) bf16x8*)(kp);      kf[1]=*(const __attribute__((address_space(3))) bf16x8*)(kp+512);
  kf[2]=*(const __attribute__((address_space(3))) bf16x8*)(kp+2048); kf[3]=*(const __attribute__((address_space(3))) bf16x8*)(kp+2560);
  kf[4]=*(const __attribute__((address_space(3))) bf16x8*)(kp+4096); kf[5]=*(const __attribute__((address_space(3))) bf16x8*)(kp+4608);
  kf[6]=*(const __attribute__((address_space(3))) bf16x8*)(kp+6144); kf[7]=*(const __attribute__((address_space(3))) bf16x8*)(kp+6656);
}
__device__ __forceinline__ void kload2(bf16x8*kf,lds_cptr kp,int j){ kf[2*j]=*(const __attribute__((address_space(3))) bf16x8*)(kp+j*2048); kf[2*j+1]=*(const __attribute__((address_space(3))) bf16x8*)(kp+j*2048+512); }
__device__ __forceinline__ s16x4 vtr(lds_cptr p){ return __builtin_bit_cast(s16x4,__builtin_amdgcn_ds_read_tr16_b64_v4i16((__attribute__((address_space(3))) v4i16_t*)p)); }
__device__ __forceinline__ float rowmax(const f32x16&p0,const f32x16&p1){
  float a=max3f(p0[0],p0[1],p1[0]),b=max3f(p0[2],p0[3],p1[1]);a=max3f(a,p1[2],p1[3]);
  #pragma unroll
  for(int r=4;r<16;r+=4){a=max3f(a,p0[r],p0[r+1]);b=max3f(b,p0[r+2],p0[r+3]);a=max3f(a,p1[r],p1[r+1]);b=max3f(b,p1[r+2],p1[r+3]);}
  const float m=max2f(a,b);
  auto rr=__builtin_amdgcn_permlane32_swap(__float_as_uint(m),__float_as_uint(m),false,false);
  return max2f(__uint_as_float(rr[0]),__uint_as_float(rr[1]));
}
__device__ __forceinline__ void pv(f32x16*o,int vb,bf16x8 pa0,bf16x8 pa1,bf16x8 pa2,bf16x8 pa3){
  #pragma unroll
  for(int d0=0;d0<2;++d0){s16x4 lo[4],hi[4];
    #pragma unroll
    for(int ks=0;ks<4;++ks){
      asm volatile("ds_read_b64_tr_b16 %0,%1 offset:%c2":"=&v"(lo[ks]):"v"(vb),"i"(d0*4096+ks*1024):"memory");
      asm volatile("ds_read_b64_tr_b16 %0,%1 offset:%c2":"=&v"(hi[ks]):"v"(vb),"i"(d0*4096+ks*1024+512):"memory");}
    asm volatile("s_waitcnt lgkmcnt(0)":::"memory");SBAR();
    #define PK(k) (bf16x8){lo[k][0],lo[k][1],lo[k][2],lo[k][3],hi[k][0],hi[k][1],hi[k][2],hi[k][3]}
    o[d0]=__builtin_amdgcn_mfma_f32_32x32x16_bf16(pa0,PK(0),o[d0],0,0,0);
    o[d0]=__builtin_amdgcn_mfma_f32_32x32x16_bf16(pa1,PK(1),o[d0],0,0,0);
    o[d0]=__builtin_amdgcn_mfma_f32_32x32x16_bf16(pa2,PK(2),o[d0],0,0,0);
    o[d0]=__builtin_amdgcn_mfma_f32_32x32x16_bf16(pa3,PK(3),o[d0],0,0,0);
    #undef PK
  }
}

#ifndef ATTN_STORE16
#define ATTN_STORE16(p,v) (*(u32x4*)(p)=(v))
#endif
template<int THRL> __device__ __forceinline__ void attn_unit(int b,int h,int qb,const bf16*Q,const bf16*__restrict__ K,const bf16*__restrict__ V,bf16*O,const float*__restrict__ C2K,const float thr2,char*shm,const int tid){
  const int lane=tid&63,r32=lane&31,hi=lane>>5; const int wid=__builtin_amdgcn_readfirstlane(tid>>6);
  const long rowbase=(long)b*SEQ; const int q0=qb*QB;
  const bf16*Qw=Q+(rowbase+q0+wid*QBLK)*DM+h*D;
  const int NT0=(q0+QB)/KVBLK;
  const float*ckg0=C2K+(long)(b*NHEAD+h)*SEQ; float base=ckg0[q0+(tid>>6)*QBLK+r32];
  int ts; { const float cl=lane<NT0?ckg0[KVBLK*lane+KVBLK-1]:ckg0[q0]; const unsigned long long mk=__builtin_amdgcn_ballot_w64(lane<NT0&&(ckg0[q0]-cl>=-thr2));
    ts=mk?(int)__builtin_ctzll(mk):NT0-4; ts&=~1; ts=ts>NT0-4?NT0-4:ts; ts=__builtin_amdgcn_readfirstlane(ts); }
  const int NT=NT0-ts;
  const bf16*Kh=K+(rowbase+(long)ts*KVBLK)*DM+h*D,*Vh=V+(rowbase+(long)ts*KVBLK)*DM+h*D; const float*ckg=ckg0+ts*KVBLK;
  typedef __attribute__((address_space(3))) float lds_f32; typedef float f32x4_t __attribute__((ext_vector_type(4)));
  lds_f32*const nbl=(lds_f32*)((__attribute__((address_space(3))) char*)shm+LDS_CK);
  for(int i=tid;i<NT*KVBLK;i+=NW*64)nbl[i]=-ckg[i];
  const unsigned lds0=(unsigned)(uintptr_t)shm;
  float*wsf=(float*)(shm+LDS_WS)+wid*64;
  const bf16*ksrc=Kh+(long)lane*DM+wid*8;
  const bf16*vsrc=Vh+(long)(16*(wid&3)+(lane>>2))*DM+(wid>>2)*32+(lane&3)*8;
  const unsigned kdst=lds0+LDS_K+wid*1024, vdst=lds0+LDS_V+wid*1024;
  #define DMA_K(t,slot) glds16(ksrc+(long)(t)*KVBLK*DM,(unsigned)__builtin_amdgcn_readfirstlane(kdst+(slot)))
  #define DMA_V(t,slot) glds16(vsrc+(long)(t)*KVBLK*DM,(unsigned)__builtin_amdgcn_readfirstlane(vdst+(slot)))
  const int vb0=(int)(lds0+LDS_V)+((lane>>4)&1)*32+(lane&3)*8+(4*hi+((lane&15)>>2))*64;
  const char*Kbase=shm+LDS_K; bf16x8 kf[8];
  const lds_cptr shm3=(lds_cptr)shm; const lds_cptr kp0=shm3+LDS_K+hi*1024+r32*16; const lds_cptr vp0=shm3+LDS_V+((lane>>4)&1)*32+(lane&3)*8+(4*hi+((lane&15)>>2))*64;
  DMA_K(0,0);DMA_V(0,0);DMA_K(1,SLOTB);
  bf16x8 qr[4];
  #pragma unroll
  for(int d0=0;d0<4;++d0)qr[d0]=*reinterpret_cast<const bf16x8*>(&Qw[(long)r32*DM+d0*16+hi*8]);
  float l_reg=0.f;f32x16 o[2];o[0]=f32x16{};o[1]=f32x16{};const f32x16 negm=f32x16{};
  const int qrel=wid*QBLK+r32;
  #define CMASK(P0,P1,t) do{int jb_=(t)-(NT-4); if(jb_>=0)cmask(P0,P1,jb_,qrel,hi);}while(0)
  #define KBIAS(P0,P1,t) do{ const lds_f32*nb_=nbl+64*(t)+4*hi; _Pragma("unroll") for(int g_=0;g_<4;++g_){ \
    { const f32x4_t b0_=*(const __attribute__((address_space(3))) f32x4_t*)(nb_+8*g_); _Pragma("unroll") for(int j_=0;j_<4;++j_)P0[4*g_+j_]+=(b0_[j_]+base); } SBAR(); \
    { const f32x4_t b1_=*(const __attribute__((address_space(3))) f32x4_t*)(nb_+32+8*g_); _Pragma("unroll") for(int j_=0;j_<4;++j_)P1[4*g_+j_]+=(b1_[j_]+base); } SBAR(); } }while(0)
  bool resc=false;
  #define START(P0,P1) do{ const float rm=rowmax(P0,P1); resc=false; \
    { const float dl=rm; base=fsub_s(base,dl); \
      _Pragma("unroll") for(int r=0;r<16;++r){P0[r]=fsub_s(P0[r],dl);P1[r]=fsub_s(P1[r],dl);} \
      } \
    _Pragma("unroll") for(int r=0;r<16;++r)P0[r]=__builtin_amdgcn_exp2f(P0[r]); }while(0)
  #define RESC() do{ if(resc){ asm volatile("s_waitcnt lgkmcnt(0)":::"memory"); \
      _Pragma("unroll") for(int d_=0;d_<2;++d_) _Pragma("unroll") for(int r=0;r<16;++r)o[d_][r]*=wsf[crow(r,hi)]; } }while(0)
  f32x16 pA0,pA1,pB0,pB1;
  int sl_prev=0,sl_cur=0,sl_next=SLOTB;
  #define ROT() do{sl_prev=sl_cur;sl_cur=sl_next;sl_next=(sl_next==(NSLOT-1)*SLOTB)?0:sl_next+SLOTB;}while(0)
  DMA_K(2,2*SLOTB);
  WAIT_BAR(3);
  qkt(pA0,pA1,Kbase,qr,negm,r32,hi);asm volatile("s_nop 15\n\ts_nop 7":"+v"(pA0),"+v"(pA1));KBIAS(pA0,pA1,0);CMASK(pA0,pA1,0);
  START(pA0,pA1);
  _Pragma("unroll") for(int r=0;r<16;++r)pA1[r]=__builtin_amdgcn_exp2f(pA1[r]);
  WAIT_BAR(0);
  DMA_K(3,0);DMA_V(1,SLOTB);
  ROT();
  kload8(kf,kp0+sl_cur);
  WAIT_BAR(2);
  s16x4 vlo[8],vhi[8]; u32x4 pw0,pw1,pw2,pw3;
  #define PKW(P,B) cvtpk_s(P[B],P[B+1])
  #define PAF(k) __builtin_bit_cast(bf16x8,pw##k)
  #define VFR(i) (bf16x8){vlo[i][0],vlo[i][1],vlo[i][2],vlo[i][3],vhi[i][0],vhi[i][1],vhi[i][2],vhi[i][3]}
  #define PIN(x) asm volatile("":"+v"(x))
  #define MX3(a,b,c) __builtin_fmaxf(__builtin_fmaxf((a),(b)),(c))
  #define GAPA(MF,A0,A1,A2,A3,W0,W1,PW) do{ MF; sacc+=A0; sacc+=A1; sacc+=A2; sacc+=A3; PIN(sacc); W0; W1; PIN(PW); SBAR(); }while(0)
  #define EX(v) __builtin_amdgcn_exp2f(v)
  #define GAPB(MF,X,B) do{ MF; X[B]=EX(X[B]); X[B+1]=EX(X[B+1]); X[B+2]=EX(X[B+2]); X[B+3]=EX(X[B+3]); PIN(X); SBAR(); }while(0)
  #define VRD(i) do{ vlo[i]=vtr(vp_+(((i)>>2)*4096+((i)&3)*1024)); vhi[i]=vtr(vp_+(((i)>>2)*4096+((i)&3)*1024+512)); }while(0)
  #define KRD(G,j) do{ if(G){ kload2(kf,kp0+sl_next,j); SBAR(); } }while(0)
  #define STEP(C0,C1,P0,P1,t,GK,GV,GL) do{ SBAR(); \
    const lds_cptr vp_=vp0+sl_prev; \
    VRD(0); SBAR(); float sacc=(P0[0]+P0[1]); \
    GAPA(C0=__builtin_amdgcn_mfma_f32_32x32x16_bf16(kf[0],qr[0],negm,0,0,0), P0[2],P0[3],P0[4],P0[5],     pw0[0]=PKW(P0,0), pw0[1]=PKW(P0,2), pw0); \
    VRD(4); SBAR(); GAPA(C1=__builtin_amdgcn_mfma_f32_32x32x16_bf16(kf[1],qr[0],negm,0,0,0), P0[6],P0[7],P0[8],P0[9],     pw0[2]=PKW(P0,4), pw0[3]=PKW(P0,6), pw0); \
    VRD(1); SBAR(); GAPA(C0=__builtin_amdgcn_mfma_f32_32x32x16_bf16(kf[2],qr[1],C0,0,0,0),   P0[10],P0[11],P0[12],P0[13], pw1[0]=PKW(P0,8), pw1[1]=PKW(P0,10), pw1); \
    VRD(5); SBAR(); GAPA(C1=__builtin_amdgcn_mfma_f32_32x32x16_bf16(kf[3],qr[1],C1,0,0,0),   P0[14],P0[15],P1[0],P1[1],   pw1[2]=PKW(P0,12),pw1[3]=PKW(P0,14), pw1); \
    VRD(2); SBAR(); GAPA(C0=__builtin_amdgcn_mfma_f32_32x32x16_bf16(kf[4],qr[2],C0,0,0,0),   P1[2],P1[3],P1[4],P1[5],     pw2[0]=PKW(P1,0), pw2[1]=PKW(P1,2), pw2); \
    VRD(6); SBAR(); GAPA(C1=__builtin_amdgcn_mfma_f32_32x32x16_bf16(kf[5],qr[2],C1,0,0,0),   P1[6],P1[7],P1[8],P1[9],     pw2[2]=PKW(P1,4), pw2[3]=PKW(P1,6), pw2); \
    VRD(3); SBAR(); GAPA(C0=__builtin_amdgcn_mfma_f32_32x32x16_bf16(kf[6],qr[3],C0,0,0,0),   P1[10],P1[11],P1[12],P1[13], pw3[0]=PKW(P1,8), pw3[1]=PKW(P1,10), pw3); \
    VRD(7); SBAR(); GAPA(C1=__builtin_amdgcn_mfma_f32_32x32x16_bf16(kf[7],qr[3],C1,0,0,0),   P1[14],P1[15],0.f,0.f,       pw3[2]=PKW(P1,12),pw3[3]=PKW(P1,14), pw3); \
    l_reg+=sacc; \
    if(GK){DMA_K((t)+3,sl_cur);} if(GV){DMA_V((t)+1,sl_next);} \
    KBIAS(C0,C1,t); \
    CMASK(C0,C1,t); \
    { float a=MX3(C0[0],C0[1],C1[0]),b=MX3(C0[2],C0[3],C1[1]); a=MX3(a,C1[2],C1[3]); \
      _Pragma("unroll") for(int r=4;r<16;r+=4){a=MX3(a,C0[r],C0[r+1]);b=MX3(b,C0[r+2],C0[r+3]);a=MX3(a,C1[r],C1[r+1]);b=MX3(b,C1[r+2],C1[r+3]);} \
      float rm=__builtin_fmaxf(a,b); { auto rr=__builtin_amdgcn_permlane32_swap(__float_as_uint(rm),__float_as_uint(rm),false,false); rm=__builtin_fmaxf(__uint_as_float(rr[0]),__uint_as_float(rr[1])); } \
      resc=false; \
      if(__builtin_expect(__any(rm>(float)THRL),0)){ const float dl=__builtin_fmaxf(rm,0.f); base-=dl; \
        _Pragma("unroll") for(int r=0;r<16;++r){C0[r]-=dl;C1[r]-=dl;} \
        const float f=__builtin_amdgcn_exp2f(-dl); l_reg*=f; if(hi==0)wsf[r32]=f; resc=true; } } \
    SBAR(); \
    GAPB(o[0]=__builtin_amdgcn_mfma_f32_32x32x16_bf16(PAF(0),VFR(0),o[0],0,0,0), C0,0); \
    GAPB(o[1]=__builtin_amdgcn_mfma_f32_32x32x16_bf16(PAF(0),VFR(4),o[1],0,0,0), C0,4); \
    KRD(GL,0); GAPB(o[0]=__builtin_amdgcn_mfma_f32_32x32x16_bf16(PAF(1),VFR(1),o[0],0,0,0), C0,8); \
    KRD(GL,1); GAPB(o[1]=__builtin_amdgcn_mfma_f32_32x32x16_bf16(PAF(1),VFR(5),o[1],0,0,0), C0,12); \
    KRD(GL,2); GAPB(o[0]=__builtin_amdgcn_mfma_f32_32x32x16_bf16(PAF(2),VFR(2),o[0],0,0,0), C1,0); \
    KRD(GL,3); GAPB(o[1]=__builtin_amdgcn_mfma_f32_32x32x16_bf16(PAF(2),VFR(6),o[1],0,0,0), C1,4); \
    GAPB(o[0]=__builtin_amdgcn_mfma_f32_32x32x16_bf16(PAF(3),VFR(3),o[0],0,0,0), C1,8); \
    GAPB(o[1]=__builtin_amdgcn_mfma_f32_32x32x16_bf16(PAF(3),VFR(7),o[1],0,0,0), C1,12); \
    }while(0)
  int t=1;
  #undef CMASK
  #define CMASK(P0,P1,t) do{}while(0)
  for(;t+5<NT;t+=2){
    STEP(pB0,pB1,pA0,pA1,t,true,true,true);     WAIT_BAR(2); RESC(); ROT();
    STEP(pA0,pA1,pB0,pB1,t+1,true,true,true);   WAIT_BAR(2); RESC(); ROT();
  }
  #undef CMASK
  #define CMASK(P0,P1,t) do{int jb_=(t)-(NT-4); if(jb_>=0)cmask(P0,P1,jb_,qrel,hi);}while(0)
  #define ENDW(tt) do{ if((tt)+3<NT){WAIT_BAR(2);} else if((tt)+2<NT){WAIT_BAR(1);} else {WAIT_BAR(0);} }while(0)
  for(;t+1<NT;t+=2){
    STEP(pB0,pB1,pA0,pA1,t,(t+3<NT),(t+1<NT),(t+1<NT));       ENDW(t);   RESC(); ROT();
    STEP(pA0,pA1,pB0,pB1,t+1,(t+4<NT),(t+2<NT),(t+2<NT));     ENDW(t+1); RESC(); ROT();
  }
  STEP(pB0,pB1,pA0,pA1,NT-1,false,false,false); RESC();
  { float sacc=pB0[0]+pB0[1]; _Pragma("unroll") for(int r=2;r<16;++r)sacc+=pB0[r]; _Pragma("unroll") for(int r=0;r<16;++r)sacc+=pB1[r]; l_reg+=sacc;
    pw0=(u32x4){PKW(pB0,0),PKW(pB0,2),PKW(pB0,4),PKW(pB0,6)};pw1=(u32x4){PKW(pB0,8),PKW(pB0,10),PKW(pB0,12),PKW(pB0,14)};pw2=(u32x4){PKW(pB1,0),PKW(pB1,2),PKW(pB1,4),PKW(pB1,6)};pw3=(u32x4){PKW(pB1,8),PKW(pB1,10),PKW(pB1,12),PKW(pB1,14)};
    SBAR(); pv(o,vb0+sl_cur,PAF(0),PAF(1),PAF(2),PAF(3)); }
  #undef PKW
  #undef PAF
  #undef VFR
  #undef PIN
  #undef MX3
  #undef GAPA
  #undef GAPB
  #undef EX
  #undef VRD
  #undef KRD
  #undef STEP
  #undef ENDW
  {auto rr=__builtin_amdgcn_permlane32_swap(__float_as_uint(l_reg),__float_as_uint(l_reg),false,false);l_reg=__uint_as_float(rr[0])+__uint_as_float(rr[1]);}
  if(hi==0)wsf[32+r32]=l_reg;asm volatile("s_waitcnt lgkmcnt(0)":::"memory");
  float rli[16];
  #pragma unroll
  for(int r=0;r<16;++r)rli[r]=__builtin_amdgcn_rcpf(wsf[32+crow(r,hi)]);
  bf16*Ow=O+(rowbase+q0+wid*QBLK)*DM+h*D;
  { bf16*stg=(bf16*)(shm+LDS_OST)+wid*2048;
    #pragma unroll
    for(int r=0;r<16;++r){const int orow=crow(r,hi);
      #pragma unroll
      for(int d0=0;d0<2;++d0)stg[orow*64+d0*32+r32]=__float2bfloat16(o[d0][r]*rli[r]);}
    asm volatile("s_waitcnt lgkmcnt(0)":::"memory");
    #pragma unroll
    for(int i=0;i<4;++i){const int row=i*8+(lane>>3),ch=lane&7; const u32x4 v=*(const u32x4*)(stg+row*64+ch*8); ATTN_STORE16(Ow+(long)row*DM+ch*8,v);} }
  asm volatile("s_waitcnt lgkmcnt(0)\n\ts_barrier":::"memory");
  #undef DMA_K
  #undef DMA_V
  #undef CMASK
  #undef KBIAS
  #undef START
  #undef RESC
  #undef ROT
}
constexpr int ATTN_LDS_BYTES=LDS_BYTES;
struct AttnTensors { const bf16* Q; const bf16* K; const bf16* V; bf16* O; const float* C2K; float thr2; };
struct AttnUnit { int bh; int qb; };
struct StaticOrder {
  int vcu;
  __device__ __forceinline__ explicit StaticOrder(int grid,int block):vcu((block%8)*(grid/8)+block/8){}
  __device__ __forceinline__ bool next(int i,AttnUnit&u)const{ if(i>=2||vcu>=256)return false; const int s=vcu&7; u.bh=vcu>>3; u.qb=(i==0)?s:15-s; return true; }
  __device__ __forceinline__ void a_ready(const AttnUnit&)const{}
  __device__ __forceinline__ void done(const AttnUnit&)const{}
};
template<class Sched,int THRL=8> __device__ __forceinline__ void attn_phase(char*lds,const AttnTensors&T,const Sched&S,const int tid){
  AttnUnit u;
  for(int i=0;S.next(i,u);++i){ S.a_ready(u); attn_unit<THRL>(u.bh/NHEAD,u.bh%NHEAD,u.qb,T.Q,T.K,T.V,T.O,T.C2K,T.thr2,lds,tid); S.done(u); }
}
#undef SBAR
#undef WAIT_BAR
}
__device__ __forceinline__ void phase_attn_fast(Ctx& C, KA AR, int l, char* ldsg) {
    const attn_body::bf16* Q = (const attn_body::bf16*)(C.ws + WS_R1) + (size_t)2 * T * 512;
    const float bq = 64.f * C2 * wave_max(fabsf(AR->in[I_QN][l * HD + C.lane])) * wave_max(fabsf(AR->in[I_KN][l * HD + C.lane]));
    const attn_body::AttnTensors AT{Q, Q + (size_t)T * 512, Q + (size_t)2 * T * 512, (attn_body::bf16*)(C.ws + WS_R2), (const float*)(C.ws + WS_C2K), 2.f * bq + 40.f};
    unsigned* qctr = (unsigned*)(C.ws + WS_CTL) + CW_ATT + 64 * l;
    volatile LAS unsigned* slot = (volatile LAS unsigned*)(C.lds + MISC_OFF) + 16;
    for (;;) {
        __syncthreads();
        if (C.tid == 0) slot[0] = atomicAdd(qctr, 1u);
        __syncthreads();
        const int idx = __builtin_amdgcn_readfirstlane((int)slot[0]);
        if (idx >= NB * NH * 16) break;
        const int qb = 15 - (idx >> 5), bh = idx & 31;
        attn_body::attn_unit<8>(bh >> 3, bh & 7, qb, AT.Q, AT.K, AT.V, AT.O, AT.C2K, AT.thr2, ldsg, C.tid);
    }
}

constexpr int RCH = 32, NCH = S / RCH;
__device__ __forceinline__ float one_minus_sq_exp(float la, float a) {
    const float x = 2.f * la;
    float p = 1.f / 5040.f; p = p * x + 1.f / 720.f; p = p * x + 1.f / 120.f; p = p * x + 1.f / 24.f; p = p * x + 1.f / 6.f; p = p * x + 0.5f; p = p * x + 1.f; p = -(p * x);
    return x > -0.25f ? p : 1.f - a * a;
}
template <int MODE>
__device__ __forceinline__ void phase_rnn_fast(Ctx& C, KA AR, int l) {
    typedef short bf16x8 __attribute__((ext_vector_type(8)));
    const int blk = C.wave, lane = C.lane, fr = lane & 15, fq = lane >> 4;
    LAS float* Ab = (LAS float*)C.lds + C.wave * 4096; LAS float* Ub = Ab + 2048;
    LAS float* SS = (LAS float*)(C.lds + TAB_OFF); LAS float* RSW = SS + 256 + C.wave * 32;
    const bf16* ZX = (const bf16*)(C.ws + WS_R1); const bf16* ZG = ZX + (size_t)T * 512;
    float* SA = (float*)(C.ws + WS_SA); float* SH = (float*)(C.ws + WS_SH);
    const bf16* O = (const bf16*)(C.ws + WS_R2); bf16* YM = (bf16*)(C.ws + WS_R2 + 16 * MiB);
    const float* cw = AR->in[I_CONVW] + l * 4 * DR; const float* cb = AR->in[I_CONVB] + l * DR;
    const float* wr = AR->in[I_WR] + (size_t)(l * 8 + blk) * 64 * 64; const float* wi = AR->in[I_WI] + (size_t)(l * 8 + blk) * 64 * 64;
    bf16x8 Br[4][2], Bi[4][2]; float brj[4], bij[4], spj[4];
    { float lm[4];
#pragma unroll
      for (int n = 0; n < 4; ++n) { const int ch = blk * 64 + n * 16 + fr; brj[n] = AR->in[I_BR][l * DR + ch]; bij[n] = AR->in[I_BI][l * DR + ch]; lm[n] = AR->in[I_LAM][l * DR + ch]; }
#pragma unroll
      for (int n = 0; n < 4; ++n) { const float e = __expf(-lm[n]); spj[n] = e < 1e-3f ? e * (1.f - 0.5f * e + 0.33333334f * e * e) : __logf(1.f + e); } }
#pragma unroll
    for (int g = 0; g < 2; ++g) { const float* wsrc = g == 0 ? wr : wi; f32x4 t[16];
#pragma unroll
        for (int i = 0; i < 16; ++i) t[i] = *(const f32x4*)(wsrc + 4 * (lane + 64 * i));
#pragma unroll
        for (int i = 0; i < 16; ++i) *(LAS f32x4*)(Ab + 4 * (lane + 64 * i)) = t[i];
        asm volatile("s_waitcnt lgkmcnt(0)" ::: "memory");
#pragma unroll
        for (int n = 0; n < 4; ++n)
#pragma unroll
            for (int ks = 0; ks < 2; ++ks)
#pragma unroll
                for (int e = 0; e < 8; ++e) { const short v = (short)f2bf(Ab[(ks * 32 + fq * 8 + e) * 64 + n * 16 + fr]); if (g == 0) Br[n][ks][e] = v; else Bi[n][ks][e] = v; }
        asm volatile("s_waitcnt lgkmcnt(0)" ::: "memory"); }
    for (int u = blockIdx.x; u < NB * NCH; u += gridDim.x) {
        const int b = u / NCH; int c = u % NCH; if (MODE == 1 && ((u / (int)gridDim.x) & 1)) c = NCH - 1 - c;
        const int t0 = c * RCH;
        if (MODE == 1) __syncthreads();
        bf16x8 Af[2][2];
#pragma unroll
        for (int ks = 0; ks < 2; ++ks) {
            const int ch0 = blk * 64 + ks * 32 + fq * 8;
            f32x4 w[4][2], bb[2];
#pragma unroll
            for (int j = 0; j < 4; ++j) { w[j][0] = *(const f32x4*)(cw + j * DR + ch0); w[j][1] = *(const f32x4*)(cw + j * DR + ch0 + 4); }
            bb[0] = *(const f32x4*)(cb + ch0); bb[1] = *(const f32x4*)(cb + ch0 + 4);
#pragma unroll
            for (int m = 0; m < 2; ++m) {
                const int tok = m * 16 + fr, tg = t0 + tok;
                f32x4 x0 = bb[0], x1 = bb[1]; v4u zz[4];
#pragma unroll
                for (int j = 0; j < 4; ++j) { const int tt = tg - 3 + j; zz[j] = *(const v4u*)(ZX + (size_t)(b * S + (tt < 0 ? 0 : tt)) * 512 + ch0); }
#pragma unroll
                for (int j = 0; j < 4; ++j) { const float ok = (tg - 3 + j) >= 0 ? 1.f : 0.f; const v4u z = zz[j]; const f32x4 wa = w[j][0] * ok, wb = w[j][1] * ok;
                        x0[0] += wa[0] * bflo(z.x); x0[1] += wa[1] * bfhi(z.x); x0[2] += wa[2] * bflo(z.y); x0[3] += wa[3] * bfhi(z.y);
                        x1[0] += wb[0] * bflo(z.z); x1[1] += wb[1] * bfhi(z.z); x1[2] += wb[2] * bflo(z.w); x1[3] += wb[3] * bfhi(z.w); }
                *(LAS f32x4*)(Ub + tok * 64 + ks * 32 + fq * 8) = x0; *(LAS f32x4*)(Ub + tok * 64 + ks * 32 + fq * 8 + 4) = x1;
                v4u pk; pk.x = pk2(x0[0], x0[1]); pk.y = pk2(x0[2], x0[3]); pk.z = pk2(x1[0], x1[1]); pk.w = pk2(x1[2], x1[3]);
                Af[m][ks] = __builtin_bit_cast(bf16x8, pk);
            }
        }
        f32x4 aR[2][4], aI[2][4];
#pragma unroll
        for (int m = 0; m < 2; ++m)
#pragma unroll
            for (int n = 0; n < 4; ++n) { aR[m][n] = (f32x4){0.f, 0.f, 0.f, 0.f}; aI[m][n] = (f32x4){0.f, 0.f, 0.f, 0.f};
#pragma unroll
                for (int ks = 0; ks < 2; ++ks) { aR[m][n] = __builtin_amdgcn_mfma_f32_16x16x32_bf16(Af[m][ks], Br[n][ks], aR[m][n], 0, 0, 0); aI[m][n] = __builtin_amdgcn_mfma_f32_16x16x32_bf16(Af[m][ks], Bi[n][ks], aI[m][n], 0, 0, 0); } }
        asm volatile("s_waitcnt lgkmcnt(0)" ::: "memory");
#pragma unroll
        for (int m = 0; m < 2; ++m)
#pragma unroll
            for (int n = 0; n < 4; ++n)
#pragma unroll
                for (int i = 0; i < 4; ++i) { const int idx = (m * 16 + 4 * fq + i) * 64 + n * 16 + fr;
                    const float xcv = Ub[idx], r = sigmoid_fast(aR[m][n][i] + brj[n]), ig = sigmoid_fast(aI[m][n][i] + bij[n]);
                    const float la = -8.f * r * spj[n], a = __expf(la);
                    Ab[idx] = a; Ub[idx] = sqrtf(one_minus_sq_exp(la, a)) * (ig * xcv); }
        asm volatile("s_waitcnt lgkmcnt(0)" ::: "memory");
        const int ch = blk * 64 + lane;
        if (MODE == 0) { float At = 1.f, h = 0.f;
#pragma unroll 8
            for (int t = 0; t < RCH; ++t) { const float a = Ab[t * 64 + lane]; h = a * h + Ub[t * 64 + lane]; At *= a; }
            SA[(size_t)(b * NCH + c) * 512 + ch] = At; SH[(size_t)(b * NCH + c) * 512 + ch] = h;
        } else {
            float h = 0.f;
            { const float* sa = SA + (size_t)b * NCH * 512 + ch; const float* sh = SH + (size_t)b * NCH * 512 + ch; int c2 = 0;
              for (; c2 + 32 <= c; c2 += 32) { float a8[32], h8[32];
#pragma unroll
                  for (int q = 0; q < 32; ++q) { a8[q] = sa[(size_t)(c2 + q) * 512]; h8[q] = sh[(size_t)(c2 + q) * 512]; }
#pragma unroll
                  for (int q = 0; q < 32; ++q) h = a8[q] * h + h8[q]; }
              for (; c2 + 8 <= c; c2 += 8) { float a8[8], h8[8];
#pragma unroll
                  for (int q = 0; q < 8; ++q) { a8[q] = sa[(size_t)(c2 + q) * 512]; h8[q] = sh[(size_t)(c2 + q) * 512]; }
#pragma unroll
                  for (int q = 0; q < 8; ++q) h = a8[q] * h + h8[q]; }
              for (; c2 < c; ++c2) h = sa[(size_t)c2 * 512] * h + sh[(size_t)c2 * 512]; }
            const bf16* zg = ZG + (size_t)(b * S + t0) * 512 + ch;
#pragma unroll 8
            for (int t = 0; t < RCH; ++t) { h = Ab[t * 64 + lane] * h + Ub[t * 64 + lane]; Ab[t * 64 + lane] = h * bf2f(zg[(size_t)t * 512]); }
            asm volatile("s_waitcnt lgkmcnt(0)" ::: "memory");
            { const int t = lane & 31, hf = lane >> 5; float s = 0.f;
#pragma unroll 8
              for (int k = 0; k < 32; ++k) { const float y = Ab[t * 64 + hf * 32 + ((k + t) & 31)]; s += y * y; }
              s = half_sum32(s); if (lane < 32) SS[C.wave * 32 + lane] = s; }
            __syncthreads();
            { const int t = lane & 31; float tot = 0.f;
#pragma unroll
              for (int w8 = 0; w8 < 8; ++w8) tot += SS[w8 * 32 + t];
              RSW[t] = rsqrtf(tot * (1.f / 512.f) + EPS); }
            asm volatile("s_waitcnt lgkmcnt(0)" ::: "memory");
            { const int oct = lane & 7; const float* g1 = AR->in[I_LRUN] + l * DR + blk * 64 + oct * 8; const f32x4 ga = *(const f32x4*)g1, gb = *(const f32x4*)(g1 + 4);
#pragma unroll
              for (int q = 0; q < 4; ++q) { const int t = q * 8 + (lane >> 3); const float rs = RSW[t];
                  const f32x4 y0 = *(const LAS f32x4*)(Ab + t * 64 + oct * 8) * rs * ga, y1 = *(const LAS f32x4*)(Ab + t * 64 + oct * 8 + 4) * rs * gb;
                  v4u pk; pk.x = pk2(y0[0], y0[1]); pk.y = pk2(y0[2], y0[3]); pk.z = pk2(y1[0], y1[1]); pk.w = pk2(y1[2], y1[3]);
                  *(v4u*)(YM + (size_t)(b * S + t0 + t) * D + blk * 64 + oct * 8) = pk; } }
            { const float* g2 = AR->in[I_ATTN] + l * DA + 8 * lane; const f32x4 ga = *(const f32x4*)g2, gb = *(const f32x4*)(g2 + 4);
              const size_t row0 = (size_t)(b * S + t0 + C.wave * 4); v4u w4[4];
#pragma unroll
              for (int q = 0; q < 4; ++q) w4[q] = *(const v4u*)(O + (row0 + q) * 512 + 8 * lane);
#pragma unroll
              for (int q = 0; q < 4; ++q) { const v4u w = w4[q];
                  f32x4 x0 = {bflo(w.x), bfhi(w.x), bflo(w.y), bfhi(w.y)}, x1 = {bflo(w.z), bfhi(w.z), bflo(w.w), bfhi(w.w)};
                  float s = (x0[0] * x0[0] + x0[1] * x0[1]) + (x0[2] * x0[2] + x0[3] * x0[3]) + (x1[0] * x1[0] + x1[1] * x1[1]) + (x1[2] * x1[2] + x1[3] * x1[3]);
                  const float rs = rsqrtf(wave_sum(s) * (1.f / 512.f) + EPS);
                  x0 = x0 * rs * ga; x1 = x1 * rs * gb;
                  v4u pk; pk.x = pk2(x0[0], x0[1]); pk.y = pk2(x0[2], x0[3]); pk.z = pk2(x1[0], x1[1]); pk.w = pk2(x1[2], x1[3]);
                  *(v4u*)(YM + (row0 + q) * D + 512 + 8 * lane) = pk; } }
        }
    }
}

template <int NT, bool XBF, class WF>
__device__ __forceinline__ void norm_proj_tile(const void* Xv, const float* gain, bf16* xn, int t0, WF wf, LAS float* Lw, int lane, int kh) {
    const float* X = (const float*)Xv; const bf16* Xb = (const bf16*)Xv;
    const int fr = lane & 15, fq = lane >> 4;
    f32x4 acc[NT];
#pragma unroll
    for (int n = 0; n < NT; ++n) acc[n] = (f32x4){0.f, 0.f, 0.f, 0.f};
    float ssq = 0.f;
    const float* xr = X + (size_t)(t0 + fr) * D + 4 * fq; const bf16* xrb = Xb + (size_t)(t0 + fr) * D + 4 * fq; const float* gr = gain + 4 * fq;
    for (int sb = 2 * kh; sb < 2 * kh + 2; ++sb) {
        f32x4 xv[16];
#pragma unroll
        for (int i = 0; i < 16; ++i) { if constexpr (XBF) { const v2u w = *(const v2u*)(xrb + 16 * (16 * sb + i)); xv[i] = (f32x4){bflo(w.x), bfhi(w.x), bflo(w.y), bfhi(w.y)}; } else xv[i] = *(const f32x4*)(xr + 16 * (16 * sb + i)); }
#pragma unroll
        for (int i = 0; i < 16; ++i) { const int s = 16 * sb + i; const f32x4 gv = *(const f32x4*)(gr + 16 * s);
            ssq += (xv[i][0] * xv[i][0] + xv[i][1] * xv[i][1]) + (xv[i][2] * xv[i][2] + xv[i][3] * xv[i][3]);
            const f32x4 xg = xv[i] * gv;
#pragma unroll
            for (int e = 0; e < 4; ++e)
#pragma unroll
                for (int n = 0; n < NT; ++n) acc[n] = __builtin_amdgcn_mfma_f32_16x16x4f32(wf(n, 16 * s + 4 * fq + e, fr), xg[e], acc[n], 0, 0, 0); }
    }
    constexpr int PW = 4 * NT + 1;
    if (kh == 1) {
#pragma unroll
        for (int n = 0; n < NT; ++n)
#pragma unroll
            for (int r = 0; r < 4; ++r) Lw[lane * PW + 4 * n + r] = acc[n][r];
        Lw[lane * PW + 4 * NT] = ssq;
    }
    __syncthreads();
    if (kh == 0) {
#pragma unroll
        for (int n = 0; n < NT; ++n)
#pragma unroll
            for (int r = 0; r < 4; ++r) acc[n][r] += Lw[lane * PW + 4 * n + r];
        ssq += Lw[lane * PW + 4 * NT];
        ssq += lane_xor<16>(ssq); ssq = half_sum32(ssq);
        const float rs = rsqrtf(ssq * (1.f / D) + EPS);
        asm volatile("s_waitcnt lgkmcnt(0)" ::: "memory");
#pragma unroll
        for (int n = 0; n < NT; ++n)
#pragma unroll
            for (int r = 0; r < 4; ++r) Lw[fr * (16 * NT) + 16 * n + 4 * fq + r] = acc[n][r] * rs;
        if (lane < 16) Lw[16 * 16 * NT + lane] = rs;
    }
    __syncthreads();
#pragma unroll
    for (int q4 = 0; q4 < 8; q4 += 4) { f32x4 v[4][4];
#pragma unroll
        for (int q = 0; q < 4; ++q) { if constexpr (XBF) load_row_bf(Xb + (size_t)(t0 + 8 * kh + q4 + q) * D, lane, v[q]); else load_row(X + (size_t)(t0 + 8 * kh + q4 + q) * D, lane, v[q]); }
#pragma unroll
        for (int q = 0; q < 4; ++q) { const int tok = 8 * kh + q4 + q; const float rst = Lw[16 * 16 * NT + tok]; scale_row(v[q], rst, gain, lane); store_row_bf16(xn + (size_t)(t0 + tok) * D, lane, v[q]); } }
}
__device__ __forceinline__ void phase_norm1_fast(Ctx& C, KA AR, int l) {
    const void* xs = l == 0 ? (const void*)AR->in[I_X] : (const void*)(C.ws + WS_X);
    const float* gain = AR->in[I_MIXN] + l * D; const float* wf = AR->in[I_WIN] + (size_t)l * D * DIN + NZ; const float* bfg = AR->in[I_BF] + l * NH;
    bf16* xn = (bf16*)(C.ws + WS_XN); float* logf = (float*)(C.ws + WS_LOGF);
    LAS float* Wl = (LAS float*)C.lds; LAS float* Lw = (LAS float*)(C.lds + 32768 + 1024) + (C.wave & 3) * 1024; const int kh = C.wave >> 2;
    { f32x4 t[4];
#pragma unroll
      for (int j = 0; j < 4; ++j) { const int i = C.tid + 512 * j; t[j] = *(const f32x4*)(wf + (size_t)(i >> 1) * DIN + 4 * (i & 1)); }
#pragma unroll
      for (int j = 0; j < 4; ++j) *(LAS f32x4*)(Wl + 4 * (C.tid + 512 * j)) = t[j]; }
    if (C.tid < 8) Wl[D * 8 + C.tid] = 0.f;
    __syncthreads();
        for (int tile = blockIdx.x * 4 + (C.wave & 3); tile < T / 16; tile += gridDim.x * 4) {
            const int t0 = 16 * tile;
            __syncthreads();
            if (l == 0) norm_proj_tile<1, false>(xs, gain, xn, t0, [=](int, int k, int i) { return Wl[k * 8 + i]; }, Lw, C.lane, kh);
            else norm_proj_tile<1, true>(xs, gain, xn, t0, [=](int, int k, int i) { return Wl[k * 8 + i]; }, Lw, C.lane, kh);
            if (kh == 0) {
            const int tok = C.lane & 15, h0 = (C.lane >> 4) * 2;
            { const int r = t0 + tok, bb = r / S, tt = r % S;
              logf[(size_t)(bb * NH + h0) * S + tt] = log_sigmoid(Lw[tok * 16 + h0] + bfg[h0]); logf[(size_t)(bb * NH + h0 + 1) * S + tt] = log_sigmoid(Lw[tok * 16 + h0 + 1] + bfg[h0 + 1]); }
            }
            asm volatile("s_waitcnt lgkmcnt(0)" ::: "memory");
        }
}
__device__ __forceinline__ void phase_router_fast(Ctx& C, KA AR, int l) {
    const void* X = (const void*)(C.ws + WS_X); bf16* xn = (bf16*)(C.ws + WS_XN);
    const float* gain = AR->in[I_FFNN] + l * D; const float* wg = AR->in[I_WG] + (size_t)l * D * 4; const float* bg = AR->in[I_BG] + l * 4;
    const float* wr = AR->in[I_WRT] + (size_t)l * D * NE; const float* brt = AR->in[I_BRT] + l * NE;
    unsigned* cnt = (unsigned*)(C.ws + WS_CTL) + CW_CNT + 32 * CNT_STRIDE * l; int* rowpair = (int*)(C.ws + WS_ROWPAIR); float* pairw = (float*)(C.ws + WS_PAIRW);
    LAS float* Wl = (LAS float*)C.lds; LAS float* Lw = (LAS float*)(C.lds + WPROJ_BYTES + 64) + (C.wave & 3) * 832; const int kh = C.wave >> 2;
    { f32x4 t[16], u[2];
#pragma unroll
      for (int j = 0; j < 16; ++j) t[j] = *(const f32x4*)(wr + 4 * (C.tid + 512 * j));
#pragma unroll
      for (int j = 0; j < 2; ++j) u[j] = *(const f32x4*)(wg + 4 * (C.tid + 512 * j));
#pragma unroll
      for (int j = 0; j < 16; ++j) { const int i = C.tid + 512 * j; *(LAS f32x4*)(Wl + (i >> 3) * 36 + 4 * (i & 7)) = t[j]; }
#pragma unroll
      for (int j = 0; j < 2; ++j) *(LAS f32x4*)(Wl + (C.tid + 512 * j) * 36 + 32) = u[j]; }
    if (C.tid < 16) Wl[D * 36 + C.tid] = 0.f;
    volatile LAS unsigned* lcnt = (volatile LAS unsigned*)(C.lds + MISC_OFF - 512);
    if (C.tid < 64) lcnt[C.tid] = 0u;
    __syncthreads();
        for (int tile = blockIdx.x * 4 + (C.wave & 3); tile < T / 16; tile += gridDim.x * 4) {
            const int t0 = 16 * tile;
            __syncthreads();
            norm_proj_tile<3, true>(X, gain, xn, t0, [=](int n, int k, int i) { return Wl[k * 36 + 16 * n + i]; }, Lw, C.lane, kh);
            int e0 = 0, e1 = 0; unsigned lp0 = 0, lp1 = 0; float w0r = 0.f, w1r = 0.f;
            if (kh == 0 && C.lane < 16) {
                const LAS float* L = Lw + C.lane * 48;
                float gl[4];
#pragma unroll
                for (int i = 0; i < 4; ++i) gl[i] = L[32 + i] + bg[i];
                int gi = 0; float gm = gl[0];
#pragma unroll
                for (int i = 1; i < 4; ++i) if (gl[i] > gm) { gm = gl[i]; gi = i; }
                float gs = 0.f;
#pragma unroll
                for (int i = 0; i < 4; ++i) gs += __expf(gl[i] - gm);
                const float gp = 1.f / gs;
                float ev[8];
#pragma unroll
                for (int i = 0; i < 8; ++i) ev[i] = L[gi * 8 + i] + brt[gi * 8 + i];
                int i0 = 0; float t0v = ev[0];
#pragma unroll
                for (int i = 1; i < 8; ++i) if (ev[i] > t0v) { t0v = ev[i]; i0 = i; }
                int i1 = -1; float t1v = -INFINITY;
#pragma unroll
                for (int i = 0; i < 8; ++i) if (i != i0 && ev[i] > t1v) { t1v = ev[i]; i1 = i; }
                const float ex = __expf(t1v - t0v), w0 = gp / (1.f + ex), w1 = gp * ex / (1.f + ex);
                e0 = gi * 8 + i0; e1 = gi * 8 + i1; w0r = w0; w1r = w1;
                lp0 = __hip_atomic_fetch_add((LAS unsigned*)lcnt + e0, 1u, __ATOMIC_RELAXED, __HIP_MEMORY_SCOPE_WORKGROUP); lp1 = __hip_atomic_fetch_add((LAS unsigned*)lcnt + e1, 1u, __ATOMIC_RELAXED, __HIP_MEMORY_SCOPE_WORKGROUP);
            }
            __syncthreads();
            if (C.wave == 0 && C.lane < NE) { const unsigned n = lcnt[C.lane]; lcnt[32 + C.lane] = n ? atomicAdd(cnt + C.lane * CNT_STRIDE, n) : 0u; }
            __syncthreads();
            if (kh == 0 && C.lane < 16) { const int t = t0 + C.lane; const unsigned p0 = lcnt[32 + e0] + lp0, p1 = lcnt[32 + e1] + lp1;
                rowpair[(size_t)e0 * CAP + p0] = 2 * t; rowpair[(size_t)e1 * CAP + p1] = 2 * t + 1; pairw[2 * t] = w0r; pairw[2 * t + 1] = w1r; }
            __syncthreads();
            if (C.tid < 64) lcnt[C.tid] = 0u;
            asm volatile("s_waitcnt lgkmcnt(0)" ::: "memory");
        }
}

constexpr int NPH = 14;
constexpr int NPHASES = 1 + DEPTH * NPH;
__global__ void __launch_bounds__(512, 2) fwd_kernel(Args args) {
    extern __shared__ __attribute__((aligned(16))) unsigned char lds[];
    Ctx C;
    C.lds = (LAS unsigned char*)lds;
    C.wave0 = __builtin_amdgcn_readfirstlane((int)threadIdx.x >> 6); asm volatile("" : "+s"(C.wave0));
    C.tid = threadIdx.x; C.lane = C.tid & 63; C.wave = C.wave0;
    C.gw = blockIdx.x * 8 + C.wave; C.ngw = gridDim.x * 8;
    C.ws = args.ws;
    volatile LAS unsigned* MISC = (volatile LAS unsigned*)(C.lds + MISC_OFF);
    if (C.tid < 32) MISC[C.tid] = 0u;
    __syncthreads();
    XcdBarrier bar; bar.bar = (unsigned*)(C.ws + WS_CTL) + CW_BAR; bar.x = 0; bar.st = nullptr;
    if (args.ph_hi - args.ph_lo > 1) bar = xcd_barrier_post((unsigned*)(C.ws + WS_CTL) + CW_BAR, MISC + 8);
#ifndef ONLY
#define ONLY -1
#endif
#define PHON(k) (ONLY < 0 || ONLY == (k))
#if MK_MULTI
#define IN(k) (fresh_args()->ph_lo <= (k) && (k) < fresh_args()->ph_hi)
#else
#define IN(k) true
#endif
    if (PROBE_TIMING && blockIdx.x == 0 && threadIdx.x == 0) ((unsigned long long*)((unsigned*)(args.ws + WS_CTL) + CW_TS))[0] = __builtin_amdgcn_s_memrealtime();
#define SEAM(k) do { if (IN(k) && IN((k) + 1)) { XcdBarrier b_; b_.bar = (unsigned*)(fresh_args()->ws + WS_CTL) + CW_BAR; b_.x = xb_xcc_id(); b_.st = (volatile LAS unsigned*)(C.lds + MISC_OFF) + 8;     \
        xcd_barrier(b_, C.tid == 0); if (PROBE_TIMING && blockIdx.x == 0 && C.tid == 0) { ((unsigned long long*)((unsigned*)(fresh_args()->ws + WS_CTL) + CW_TS))[(k) + 1] = __builtin_amdgcn_s_memrealtime(); } } } while (0)
    for (int rp_ = 0; rp_ < REPS(99); ++rp_) { if (PHON(99) && IN(0)) { KA A_ = fresh_args(); enter_phase(C, A_); phase_prologue(C, A_); } SEAM(0); }
    for (int l = 0; l < DEPTH; ++l) {
        const int pb = 1 + l * NPH;
        for (int rp_ = 0; rp_ < REPSL(0); ++rp_) { if (PHON(0) && IN(pb + 0)) { KA A_ = fresh_args(); enter_phase(C, A_); if (FAST_NORM) phase_norm1_fast(C, A_, l); else phase_norm1(C, A_, l); } SEAM(pb + 0); }
        for (int rp_ = 0; rp_ < REPSL(1); ++rp_) { if (PHON(1) && IN(pb + 1)) { KA A_ = fresh_args(); enter_phase(C, A_); if (FAST_GEMM1) { phase_gemm1_fast(C, A_, l); phase_proj_fast(C, A_, l); } else phase_gemm1_naive(C, A_, l); } SEAM(pb + 1); }
        for (int rp_ = 0; rp_ < REPSL(2); ++rp_) { if (!FAST_GEMM1 && PHON(2) && IN(pb + 2)) { KA A_ = fresh_args(); enter_phase(C, A_); phase_qknorm_naive(C, A_, l); } if (!FAST_GEMM1) SEAM(pb + 2); }
        for (int rp_ = 0; rp_ < REPSL(3); ++rp_) { if (!(FAST_RNN && FAST_ATTN) && PHON(3) && IN(pb + 3)) { KA A_ = fresh_args(); enter_phase(C, A_); if (FAST_RNN) phase_rnn_fast<0>(C, A_, l); else phase_rnn_naive<0>(C, A_, l); } if (!(FAST_RNN && FAST_ATTN)) SEAM(pb + 3); }
        for (int rp_ = 0; rp_ < REPSL(4); ++rp_) { if (PHON(4) && IN(pb + 4)) { KA A_ = fresh_args(); enter_phase(C, A_); if (FAST_RNN && FAST_ATTN) { phase_rnn_fast<0>(C, A_, l); __syncthreads(); } if (FAST_ATTN) phase_attn_fast(C, A_, l, (char*)lds); else phase_attn_naive(C, A_, l); } SEAM(pb + 4); }
        for (int rp_ = 0; rp_ < REPSL(5); ++rp_) { if (PHON(5) && IN(pb + 5)) { KA A_ = fresh_args(); enter_phase(C, A_); if (FAST_RNN) phase_rnn_fast<1>(C, A_, l); else phase_rnn_naive<1>(C, A_, l); } SEAM(pb + 5); }
        for (int rp_ = 0; rp_ < REPSL(6); ++rp_) { if (!FAST_RNN && PHON(6) && IN(pb + 6)) { KA A_ = fresh_args(); enter_phase(C, A_); phase_mixnorm_naive(C, A_, l); } if (!FAST_RNN) SEAM(pb + 6); }
        for (int rp_ = 0; rp_ < REPSL(7); ++rp_) { if (PHON(7) && IN(pb + 7)) { KA A_ = fresh_args(); enter_phase(C, A_); if (FAST_DENSE) phase_wo_fast(C, A_, l); else phase_wo_naive(C, A_, l); } SEAM(pb + 7); }
        for (int rp_ = 0; rp_ < REPSL(8); ++rp_) { if (PHON(8) && IN(pb + 8)) { KA A_ = fresh_args(); enter_phase(C, A_); if (FAST_NORM) phase_router_fast(C, A_, l); else phase_router(C, A_, l); } SEAM(pb + 8); }
        for (int rp_ = 0; rp_ < REPSL(9); ++rp_) { if (PHON(9) && IN(pb + 9)) { KA A_ = fresh_args(); enter_phase(C, A_); if (FAST_MOE) phase_g1_fast(C, A_, l); else phase_g1_naive(C, A_, l); } SEAM(pb + 9); }
        for (int rp_ = 0; rp_ < REPSL(10); ++rp_) { if (PHON(10) && IN(pb + 10)) { KA A_ = fresh_args(); enter_phase(C, A_); if (FAST_MOE) phase_g2_fast(C, A_, l); else phase_g2_naive(C, A_, l); } SEAM(pb + 10); }
        for (int rp_ = 0; rp_ < REPSL(11); ++rp_) { if (PHON(11) && IN(pb + 11)) { KA A_ = fresh_args(); enter_phase(C, A_); phase_combine(C, A_, l); } SEAM(pb + 11); }
        for (int rp_ = 0; rp_ < REPSL(12); ++rp_) { if (!FAST_GEMM1 && PHON(12) && IN(pb + 12)) { KA A_ = fresh_args(); enter_phase(C, A_); if (FAST_DENSE) phase_proj_fast(C, A_, l); else phase_proj_naive(C, A_, l); } if (!FAST_GEMM1) SEAM(pb + 12); }
        for (int rp_ = 0; rp_ < REPSL(13); ++rp_) { if (PHON(13) && IN(pb + 13)) { KA A_ = fresh_args(); enter_phase(C, A_); if (FAST_DENSE) phase_ple_fast(C, A_, l); else phase_ple_naive(C, A_, l); } if (l + 1 < DEPTH) SEAM(pb + 13); }
    }
#undef IN
#undef SEAM
}

extern "C" void kernel_launch(void* const* d_in, const int* in_sizes, int n_in, void* d_out, int out_size, void* d_ws, size_t ws_size, hipStream_t stream) {
    static int grid = 0;
    if (grid == 0) {
        if (n_in != 29 || out_size != T * D || ws_size < WS_END) { fprintf(stderr, "kernel_launch: unexpected problem (n_in %d, out %d, ws %zu)\n", n_in, out_size, ws_size); grid = -1; return; }
        int dev = 0, cus = 0, per_cu = 0;
        if (hipGetDevice(&dev) != hipSuccess || hipDeviceGetAttribute(&cus, hipDeviceAttributeMultiprocessorCount, dev) != hipSuccess) { grid = -1; return; }
        if (hipFuncSetAttribute((const void*)fwd_kernel, hipFuncAttributeMaxDynamicSharedMemorySize, LDS_BYTES) != hipSuccess) { fprintf(stderr, "kernel_launch: hipFuncSetAttribute failed\n"); grid = -1; return; }
        if (hipOccupancyMaxActiveBlocksPerMultiprocessor(&per_cu, (const void*)fwd_kernel, 512, LDS_BYTES) != hipSuccess || per_cu < 1) { fprintf(stderr, "kernel_launch: occupancy query says %d\n", per_cu); grid = -1; return; }
        (void)hipGetLastError();
        grid = cus;
    }
    if (grid < 0) return;
    hipMemsetAsync((char*)d_ws + WS_CTL, 0, CTL_ZERO_BYTES, stream);
    Args a{};
    for (int i = 0; i < 29; ++i) a.in[i] = (const float*)d_in[i];
    a.out = (float*)d_out; a.ws = (unsigned char*)d_ws;
#if MK_MULTI
    for (int ph = 0; ph < NPHASES; ++ph) { a.ph_lo = ph; a.ph_hi = ph + 1; hipLaunchKernelGGL(fwd_kernel, dim3(grid), dim3(512), LDS_BYTES, stream, a); }
#else
    a.ph_lo = 0; a.ph_hi = NPHASES;
    hipLaunchKernelGGL(fwd_kernel, dim3(grid), dim3(512), LDS_BYTES, stream, a);
#endif
}
```
